# Optimizing an MI355X kernel written in HIP

```python
import math
import jax
import jax.numpy as jnp
from jax import lax
import numpy as np

D_MODEL = 1024
BATCH = 2
SEQ = 8192
DEPTH = 1

HEAD_DIM = 64
N_ATTN_HEADS = 8
N_KV_HEADS = 2
GQA_SIZE = N_ATTN_HEADS // N_KV_HEADS
D_ATTN = N_ATTN_HEADS * HEAD_DIM
D_MIX = D_MODEL
D_RNN = D_MIX - D_ATTN
N_RNN_BLOCKS = 8
RNN_BLOCK = D_RNN // N_RNN_BLOCKS
CONV_WIDTH = 4
LRU_C = 8.0
CMP_LEN = 32
CMP_STRIDE = 16
SLC_LEN = 64
SLC_TOP = 16
WINDOW = 512
Q_BLOCK = 128
N_BRANCH = 3
REL_BUCKETS = 32
REL_MAX_DIST = 1024
N_EXPERTS = 256
TOP_K = 8
N_EXPERT_GROUPS = 8
TOP_GROUPS = 4
D_EXPERT = 256
ROUTED_SCALE = 2.5
MOE_BLOCK = 128
EPS = 1e-6
KV_W = N_KV_HEADS * HEAD_DIM
N_GATE = N_BRANCH * N_ATTN_HEADS
SPLITS = (D_ATTN, D_ATTN + 6 * KV_W, D_ATTN + 6 * KV_W + N_GATE, D_ATTN + 6 * KV_W + N_GATE + D_RNN)
N_IN_COLS = SPLITS[-1] + D_RNN

kernel_name = 'hybrid_nsa_rglru_moe_block'


def rmsnorm(x, w):
    xf = x.astype(jnp.float32)
    y = xf * lax.rsqrt(jnp.mean(xf * xf, axis=-1, keepdims=True) + EPS)
    return (y * w.astype(jnp.float32)).astype(x.dtype)


def t5_bucket(dist):
    n = jnp.maximum(dist, 0)
    max_exact = REL_BUCKETS // 2
    nf = jnp.maximum(n, 1).astype(jnp.float32)
    large = max_exact + (jnp.log(nf / max_exact) / math.log(REL_MAX_DIST / max_exact)
                         * (REL_BUCKETS - max_exact)).astype(jnp.int32)
    large = jnp.minimum(large, REL_BUCKETS - 1)
    return jnp.where(n < max_exact, n, large)


def masked_softmax(logits, mask):
    logits = jnp.where(mask, logits, -jnp.inf)
    m = jnp.max(logits, axis=-1, keepdims=True)
    m = jnp.where(jnp.isfinite(m), m, 0.0)
    p = jnp.where(mask, jnp.exp(logits - m), 0.0)
    return p / jnp.maximum(jnp.sum(p, axis=-1, keepdims=True), 1e-30)


def nsa_mixer(q, k_c, v_c, k_s, v_s, k_w, v_w, gates, cmp_pos, cmp_k_w1, cmp_k_w2, cmp_v_w1, cmp_v_w2, rel_table):
    f32 = jnp.float32
    B, S = q.shape[0], q.shape[1]
    G, Q, Dh = N_KV_HEADS, GQA_SIZE, HEAD_DIM
    q = q.astype(f32) * (Dh ** -0.5)
    k_c, v_c, k_s, v_s, k_w, v_w = (t.astype(f32) for t in (k_c, v_c, k_s, v_s, k_w, v_w))

    n_cmp = (S - CMP_LEN) // CMP_STRIDE + 1
    cmp_idx = CMP_STRIDE * jnp.arange(n_cmp)[:, None] + jnp.arange(CMP_LEN)[None, :]
    cmp_end = cmp_idx[:, -1]
    pos = cmp_pos.astype(f32)[None, None, :, None, :]

    def compress(t, w1, w2):
        blk = t[:, cmp_idx] + pos
        blk = jnp.swapaxes(blk, 2, 3).reshape(B, n_cmp, G, CMP_LEN * Dh)
        return jax.nn.gelu(blk @ w1.astype(f32)) @ w2.astype(f32)

    kc = compress(k_c, cmp_k_w1, cmp_k_w2)
    vc = compress(v_c, cmp_v_w1, cmp_v_w2)

    n_slc = S // SLC_LEN
    n_top = min(SLC_TOP, n_slc)
    c_start = CMP_STRIDE * jnp.arange(n_cmp)[:, None]
    s_start = SLC_LEN * jnp.arange(n_slc)[None, :]
    overlap = ((c_start < s_start + SLC_LEN) & (c_start + CMP_LEN > s_start)).astype(f32)
    ks_blk = jnp.moveaxis(k_s.reshape(B, n_slc, SLC_LEN, G, Dh), 3, 1)
    vs_blk = jnp.moveaxis(v_s.reshape(B, n_slc, SLC_LEN, G, Dh), 3, 1)
    kw_pad = jnp.pad(k_w, ((0, 0), (WINDOW, 0), (0, 0), (0, 0)))
    vw_pad = jnp.pad(v_w, ((0, 0), (WINDOW, 0), (0, 0), (0, 0)))
    bi = jnp.arange(B)[:, None, None, None]
    gi = jnp.arange(G)[None, :, None, None]
    tbl_g = rel_table.astype(f32).reshape(REL_BUCKETS, G, Q)
    slc_off = jnp.arange(SLC_LEN)
    blk_ids = jnp.arange(n_slc)

    def grid_bias(dist):
        return jnp.moveaxis(tbl_g[t5_bucket(dist)], (2, 3), (0, 1))

    def block(i):
        q0 = i * Q_BLOCK
        tpos = q0 + jnp.arange(Q_BLOCK)
        qb = lax.dynamic_slice_in_dim(q, q0, Q_BLOCK, axis=1).reshape(B, Q_BLOCK, G, Q, Dh)
        gb = lax.dynamic_slice_in_dim(gates, q0, Q_BLOCK, axis=1).astype(f32).reshape(B, Q_BLOCK, G, Q, N_BRANCH)

        dist_c = tpos[:, None] - cmp_end[None, :]
        p_c = masked_softmax(jnp.einsum('btgqd,bngd->bgqtn', qb, kc) + grid_bias(dist_c), dist_c >= 0)
        o_c = jnp.einsum('bgqtn,bngd->btgqd', p_c, vc)

        score = jnp.einsum('bgqtn,nj->bgtj', p_c, overlap)
        cur = (tpos // SLC_LEN)[:, None]
        forced = (blk_ids == 0) | (blk_ids == cur) | (blk_ids == cur - 1)
        score = jnp.where(forced, jnp.inf, jnp.where(blk_ids <= cur, score, -jnp.inf))
        sel = lax.top_k(score, n_top)[1]
        ksel = ks_blk[bi, gi, sel].reshape(B, G, Q_BLOCK, n_top * SLC_LEN, Dh)
        vsel = vs_blk[bi, gi, sel].reshape(B, G, Q_BLOCK, n_top * SLC_LEN, Dh)
        kpos = (sel[..., None] * SLC_LEN + slc_off).reshape(B, G, Q_BLOCK, n_top * SLC_LEN)
        dist_s = tpos[:, None] - kpos
        bias_s = jnp.moveaxis(tbl_g[t5_bucket(dist_s), gi], -1, 2)
        p_s = masked_softmax(jnp.einsum('btgqd,bgtkd->bgqtk', qb, ksel) + bias_s, (dist_s >= 0)[:, :, None])
        o_s = jnp.einsum('bgqtk,bgtkd->btgqd', p_s, vsel)

        kwb = lax.dynamic_slice_in_dim(kw_pad, q0, WINDOW + Q_BLOCK, axis=1)
        vwb = lax.dynamic_slice_in_dim(vw_pad, q0, WINDOW + Q_BLOCK, axis=1)
        kpos_w = q0 - WINDOW + jnp.arange(WINDOW + Q_BLOCK)
        dist_w = tpos[:, None] - kpos_w[None, :]
        mask_w = (dist_w >= 0) & (dist_w < WINDOW) & (kpos_w >= 0)[None, :]
        p_w = masked_softmax(jnp.einsum('btgqd,bkgd->bgqtk', qb, kwb) + grid_bias(dist_w), mask_w)
        o_w = jnp.einsum('bgqtk,bkgd->btgqd', p_w, vwb)

        o = gb[..., 0:1] * o_c + gb[..., 1:2] * o_s + gb[..., 2:3] * o_w
        return o.reshape(B, Q_BLOCK, G * Q * Dh)

    out = lax.map(block, jnp.arange(S // Q_BLOCK))
    return jnp.swapaxes(out, 0, 1).reshape(B, S, D_ATTN)


def _linear_recurrence(left, right):
    a_l, b_l = left
    a_r, b_r = right
    return a_l * a_r, a_r * b_l + b_r


def rglru_mixer(xr, gr, conv_w, conv_b, wa, ba, wx, bx, lam):
    f32 = jnp.float32
    B, S, C = xr.shape
    xc = lax.conv_general_dilated(xr.astype(f32), conv_w.astype(f32), window_strides=(1,),
                                  padding=[(CONV_WIDTH - 1, 0)], dimension_numbers=('NWC', 'WIO', 'NWC'),
                                  feature_group_count=C) + conv_b.astype(f32)
    xb = xc.reshape(B, S, N_RNN_BLOCKS, RNN_BLOCK)
    r = jax.nn.sigmoid(jnp.einsum('bshi,hij->bshj', xb, wa.astype(f32)).reshape(B, S, C) + ba.astype(f32))
    i = jax.nn.sigmoid(jnp.einsum('bshi,hij->bshj', xb, wx.astype(f32)).reshape(B, S, C) + bx.astype(f32))
    log_a = -LRU_C * r * jax.nn.softplus(-lam.astype(f32))
    a = jnp.exp(log_a)
    u = jnp.sqrt(-jnp.expm1(2.0 * log_a)) * (i * xc)
    _, hs = lax.associative_scan(_linear_recurrence, (a, u), axis=1)
    return hs * jax.nn.gelu(gr.astype(f32))


def hybrid_mixer(h, w_in, cmp_pos, cmp_k_w1, cmp_k_w2, cmp_v_w1, cmp_v_w2, rel_table, conv_w, conv_b,
                 lru_wa, lru_ba, lru_wx, lru_bx, lru_lambda, gnorm_attn_w, gnorm_rnn_w, w_out):
    B, S, _ = h.shape
    proj = h @ w_in
    q, kv, g, xr, gr = jnp.split(proj, SPLITS, axis=-1)
    q = q.reshape(B, S, N_ATTN_HEADS, HEAD_DIM)
    kv = kv.reshape(B, S, 6, N_KV_HEADS, HEAD_DIM)
    k_c, v_c, k_s, v_s, k_w, v_w = (kv[:, :, j] for j in range(6))
    gates = jax.nn.sigmoid(g.astype(jnp.float32)).reshape(B, S, N_ATTN_HEADS, N_BRANCH)
    o_attn = nsa_mixer(q, k_c, v_c, k_s, v_s, k_w, v_w, gates, cmp_pos, cmp_k_w1, cmp_k_w2,
                       cmp_v_w1, cmp_v_w2, rel_table)
    o_rnn = rglru_mixer(xr, gr, conv_w, conv_b, lru_wa, lru_ba, lru_wx, lru_bx, lru_lambda)
    y = jnp.concatenate([rmsnorm(o_attn, gnorm_attn_w), rmsnorm(o_rnn, gnorm_rnn_w)], axis=-1)
    return y.astype(h.dtype) @ w_out


def moe_ffn(h, w_router, b_router, w1, w3, w2, ws1, ws3, ws2):
    f32 = jnp.float32
    B, S, D = h.shape
    N = B * S
    xt = h.reshape(N, D)
    s = jax.nn.sigmoid((xt @ w_router).astype(f32))
    s_sel = s + b_router.astype(f32)
    per_group = N_EXPERTS // N_EXPERT_GROUPS
    grp_score = lax.top_k(s_sel.reshape(N, N_EXPERT_GROUPS, per_group), 2)[0].sum(-1)
    top_grp = lax.top_k(grp_score, TOP_GROUPS)[1]
    grp_ok = jnp.any(top_grp[:, :, None] == jnp.arange(N_EXPERT_GROUPS), axis=1)
    s_sel = jnp.where(jnp.repeat(grp_ok, per_group, axis=1), s_sel, -jnp.inf)
    eid = lax.top_k(s_sel, TOP_K)[1]
    s_top = jnp.take_along_axis(s, eid, axis=1)
    wgt = ROUTED_SCALE * s_top / jnp.sum(s_top, axis=-1, keepdims=True)

    NK = N * TOP_K
    e_flat = eid.reshape(NK)
    order = jnp.argsort(e_flat)
    e_sorted = e_flat[order]
    counts = jnp.bincount(e_flat, length=N_EXPERTS)
    padded = (counts + MOE_BLOCK - 1) // MOE_BLOCK * MOE_BLOCK
    pend = jnp.cumsum(padded)
    dest = (pend - padded)[e_sorted] + jnp.arange(NK) - (jnp.cumsum(counts) - counts)[e_sorted]
    n_blk = -(-(NK + N_EXPERTS * (MOE_BLOCK - 1)) // MOE_BLOCK)
    P = n_blk * MOE_BLOCK
    slot_tok = jnp.zeros((P,), jnp.int32).at[dest].set((order // TOP_K).astype(jnp.int32))
    slot_w = jnp.zeros((P,), f32).at[dest].set(wgt.reshape(NK)[order])
    blk_e = jnp.minimum(jnp.searchsorted(pend, jnp.arange(n_blk) * MOE_BLOCK, side='right'), N_EXPERTS - 1)

    def expert_block(args):
        tok, e, w = args
        xb = xt[tok]
        hid = jax.nn.silu(xb @ w1[e]) * (xb @ w3[e])
        return (hid @ w2[e]) * w[:, None]

    out = lax.map(expert_block, (slot_tok.reshape(n_blk, MOE_BLOCK), blk_e, slot_w.reshape(n_blk, MOE_BLOCK)))
    routed = jax.ops.segment_sum(out.reshape(P, D), slot_tok, num_segments=N)
    shared = (jax.nn.silu(xt @ ws1) * (xt @ ws3)) @ ws2
    return (routed + shared).astype(h.dtype).reshape(B, S, D)


def setup_inputs(seed: int = 0) -> dict:
    key = jax.random.key(seed)
    ks = jax.random.split(key, 32)
    f32 = jnp.float32
    L = DEPTH

    def nrm(k, shape, scale):
        return jax.random.normal(k, shape, f32) * scale

    def gain(k, shape):
        return 1.0 + 0.05 * jax.random.normal(k, shape, f32)

    a_c = jax.random.uniform(ks[20], (L, D_RNN), f32, minval=0.9, maxval=0.999)
    a = a_c ** (1.0 / LRU_C)
    return {
        'x': nrm(ks[0], (BATCH, SEQ, D_MODEL), 1.0),
        'c': nrm(ks[1], (BATCH, D_MODEL), 1.0),
        'w_ada': nrm(ks[2], (L, D_MODEL, 6 * D_MODEL), 0.5 * D_MODEL ** -0.5),
        'b_ada': nrm(ks[3], (L, 6 * D_MODEL), 0.02),
        'norm1_w': gain(ks[4], (L, D_MODEL)),
        'w_in': nrm(ks[5], (L, D_MODEL, N_IN_COLS), D_MODEL ** -0.5),
        'cmp_pos': nrm(ks[6], (L, CMP_LEN, HEAD_DIM), 0.5),
        'cmp_k_w1': nrm(ks[7], (L, CMP_LEN * HEAD_DIM, HEAD_DIM), (CMP_LEN * HEAD_DIM) ** -0.5),
        'cmp_k_w2': nrm(ks[8], (L, HEAD_DIM, HEAD_DIM), HEAD_DIM ** -0.5),
        'cmp_v_w1': nrm(ks[9], (L, CMP_LEN * HEAD_DIM, HEAD_DIM), (CMP_LEN * HEAD_DIM) ** -0.5),
        'cmp_v_w2': nrm(ks[10], (L, HEAD_DIM, HEAD_DIM), HEAD_DIM ** -0.5),
        'rel_table': nrm(ks[11], (REL_BUCKETS, N_ATTN_HEADS), 0.5),
        'conv_w': nrm(ks[12], (L, CONV_WIDTH, 1, D_RNN), CONV_WIDTH ** -0.5),
        'conv_b': nrm(ks[13], (L, D_RNN), 0.02),
        'lru_wa': nrm(ks[14], (L, N_RNN_BLOCKS, RNN_BLOCK, RNN_BLOCK), RNN_BLOCK ** -0.5),
        'lru_ba': nrm(ks[15], (L, D_RNN), 0.02),
        'lru_wx': nrm(ks[16], (L, N_RNN_BLOCKS, RNN_BLOCK, RNN_BLOCK), RNN_BLOCK ** -0.5),
        'lru_bx': nrm(ks[17], (L, D_RNN), 0.02),
        'lru_lambda': jnp.log(a) - jnp.log1p(-a),
        'gnorm_attn_w': gain(ks[18], (L, D_ATTN)),
        'gnorm_rnn_w': gain(ks[19], (L, D_RNN)),
        'w_out': nrm(ks[21], (L, D_MIX, D_MODEL), D_MIX ** -0.5),
        'norm2_w': gain(ks[22], (L, D_MODEL)),
        'w_router': nrm(ks[23], (L, D_MODEL, N_EXPERTS), D_MODEL ** -0.5),
        'b_router': nrm(ks[24], (L, N_EXPERTS), 0.01),
        'w1': nrm(ks[25], (L, N_EXPERTS, D_MODEL, D_EXPERT), D_MODEL ** -0.5),
        'w3': nrm(ks[26], (L, N_EXPERTS, D_MODEL, D_EXPERT), D_MODEL ** -0.5),
        'w2': nrm(ks[27], (L, N_EXPERTS, D_EXPERT, D_MODEL), D_EXPERT ** -0.5),
        'ws1': nrm(ks[28], (L, D_MODEL, D_EXPERT), D_MODEL ** -0.5),
        'ws3': nrm(ks[29], (L, D_MODEL, D_EXPERT), D_MODEL ** -0.5),
        'ws2': nrm(ks[30], (L, D_EXPERT, D_MODEL), D_EXPERT ** -0.5),
        'final_norm_w': gain(ks[31], (D_MODEL,)),
    }


def reference(x, c, w_ada, b_ada, norm1_w, w_in, cmp_pos, cmp_k_w1, cmp_k_w2, cmp_v_w1, cmp_v_w2, rel_table,
              conv_w, conv_b, lru_wa, lru_ba, lru_wx, lru_bx, lru_lambda, gnorm_attn_w, gnorm_rnn_w, w_out,
              norm2_w, w_router, b_router, w1, w3, w2, ws1, ws3, ws2, final_norm_w):
    for l in range(DEPTH):
        mod = (jax.nn.silu(c) @ w_ada[l] + b_ada[l])[:, None, :]
        sh1, sc1, g1, sh2, sc2, g2 = jnp.split(mod, 6, axis=-1)
        h = rmsnorm(x, norm1_w[l]) * (1.0 + sc1) + sh1
        x = x + g1 * hybrid_mixer(h, w_in[l], cmp_pos[l], cmp_k_w1[l], cmp_k_w2[l], cmp_v_w1[l], cmp_v_w2[l],
                                  rel_table, conv_w[l], conv_b[l], lru_wa[l], lru_ba[l], lru_wx[l], lru_bx[l],
                                  lru_lambda[l], gnorm_attn_w[l], gnorm_rnn_w[l], w_out[l])
        h = rmsnorm(x, norm2_w[l]) * (1.0 + sc2) + sh2
        x = x + g2 * moe_ffn(h, w_router[l], b_router[l], w1[l], w3[l], w2[l], ws1[l], ws3[l], ws2[l])
    return rmsnorm(x, final_norm_w)
```

```cpp
#include <hip/hip_runtime.h>
#include <stdint.h>

#ifndef FUSED
#define FUSED 0
#endif

#define MTOK 16384
#define SEQ 8192
#define DM 1024
#define NCOLS 2328
#define COL_KC 512
#define COL_KS 768
#define COL_VS 896
#define COL_KW 1024
#define COL_VW 1152
#define COL_G 1280
#define COL_XR 1304
#define COL_GR 1816
#define NCMP 511
#define NEXP 256
#define NK 131072

#define MiB (1048576ull)
#define WS_CTL 0ull
#define CTL_BYTES (1 * MiB)
#define CW_CNT 8192
#define WS_MOD (1 * MiB)
#define WS_LUT (1 * MiB + 65536)
#define WS_KC (2 * MiB)
#define WS_VC (3 * MiB)
#define WS_AEND (4 * MiB)
#define WS_HEND (5 * MiB)
#define WS_EID (6 * MiB)
#define WS_POS (7 * MiB)
#define WS_WGT (8 * MiB)
#define WS_SLOTTOK (9 * MiB)
#define WS_SLOTW (10 * MiB)
#define WS_CARRY (11 * MiB)
#define WS_LOGITS (16 * MiB)
#define WS_H1 (32 * MiB)
#define WS_PROJ (96 * MiB)
#define WS_HL (256 * MiB)
#define WS_AP (288 * MiB)
#define WS_X1 (320 * MiB)
#define WS_ACC (384 * MiB)
#define WS_HID (448 * MiB)
#define WS_Y (592 * MiB)
#define WS_H2 (656 * MiB)

struct Params {
    const float* in[32];
    float* out;
    unsigned char* ws;
};

#define SMEM_BYTES 49152
#define INF __builtin_huge_valf()

__device__ __forceinline__ float wave_sum(float v) {
#pragma unroll
    for (int o = 32; o; o >>= 1) v += __shfl_xor(v, o);
    return v;
}
__device__ __forceinline__ float wave_max(float v) {
#pragma unroll
    for (int o = 32; o; o >>= 1) v = fmaxf(v, __shfl_xor(v, o));
    return v;
}
__device__ __forceinline__ float sigm(float x) { return 1.f / (1.f + expf(-x)); }
__device__ __forceinline__ float gelu_t(float x) { return 0.5f * x * (1.f + tanhf(0.7978845608028654f * (x + 0.044715f * x * x * x))); }
__device__ __forceinline__ float softplus_(float z) { return fmaxf(z, 0.f) + log1pf(expf(-fabsf(z))); }

template <class ARow, class Epi>
__device__ __forceinline__ void gemm64(float* smem, ARow arow, int mrows, const float* __restrict__ B, int ldb, int n0, int N, int K, Epi epi) {
    float (*sA)[68] = (float (*)[68])smem;
    float (*sB)[68] = (float (*)[68])(smem + 16 * 68);
    const int tid = threadIdx.x;
    const int tx = tid & 15, ty = tid >> 4;
    float acc[4][4];
#pragma unroll
    for (int i = 0; i < 4; ++i)
#pragma unroll
        for (int j = 0; j < 4; ++j) acc[i][j] = 0.f;
    const int ar = tid >> 2, ac = (tid & 3) * 4;
    const float* ap = (ar < mrows) ? arow(ar) : nullptr;
    const int bk = tid >> 4, bn = (tid & 15) * 4;
    const bool bok = (n0 + bn + 3) < N;
    for (int k0 = 0; k0 < K; k0 += 16) {
        float4 av = ap ? *(const float4*)(ap + k0 + ac) : make_float4(0.f, 0.f, 0.f, 0.f);
        float4 bv = bok ? *(const float4*)(B + (size_t)(k0 + bk) * ldb + n0 + bn) : make_float4(0.f, 0.f, 0.f, 0.f);
        __syncthreads();
        sA[ac + 0][ar] = av.x; sA[ac + 1][ar] = av.y; sA[ac + 2][ar] = av.z; sA[ac + 3][ar] = av.w;
        *(float4*)&sB[bk][bn] = bv;
        __syncthreads();
#pragma unroll
        for (int k = 0; k < 16; ++k) {
            const float4 a = *(const float4*)&sA[k][ty * 4];
            const float4 b = *(const float4*)&sB[k][tx * 4];
            acc[0][0] += a.x * b.x; acc[0][1] += a.x * b.y; acc[0][2] += a.x * b.z; acc[0][3] += a.x * b.w;
            acc[1][0] += a.y * b.x; acc[1][1] += a.y * b.y; acc[1][2] += a.y * b.z; acc[1][3] += a.y * b.w;
            acc[2][0] += a.z * b.x; acc[2][1] += a.z * b.y; acc[2][2] += a.z * b.z; acc[2][3] += a.z * b.w;
            acc[3][0] += a.w * b.x; acc[3][1] += a.w * b.y; acc[3][2] += a.w * b.z; acc[3][3] += a.w * b.w;
        }
    }
#pragma unroll
    for (int i = 0; i < 4; ++i)
#pragma unroll
        for (int j = 0; j < 4; ++j) {
            const int r = ty * 4 + i, n = n0 + tx * 4 + j;
            if (r < mrows && n < N) epi(r, n, acc[i][j]);
        }
}

__device__ __forceinline__ void phase0(const Params& p, int bid, int nb) {
    const float* c = p.in[1]; const float* w_ada = p.in[2]; const float* b_ada = p.in[3];
    float* mod = (float*)(p.ws + WS_MOD);
    for (int idx = bid * 256 + threadIdx.x; idx < 2 * 6144; idx += nb * 256) {
        const int b = idx / 6144, j = idx % 6144;
        float acc = 0.f;
        for (int k = 0; k < 1024; ++k) { const float cv = c[b * 1024 + k]; acc += (cv / (1.f + expf(-cv))) * w_ada[(size_t)k * 6144 + j]; }
        mod[idx] = acc + b_ada[j];
    }
    float* lut = (float*)(p.ws + WS_LUT); const float* rel = p.in[11];
    for (int idx = bid * 256 + threadIdx.x; idx < 8 * 1024; idx += nb * 256) {
        const int h = idx >> 10, d = idx & 1023;
        int bucket;
        if (d < 16) bucket = d;
        else { const int l = 16 + (int)(logf((float)d / 16.0f) / 4.1588830833596715f * 16.0f); bucket = l < 31 ? l : 31; }
        lut[idx] = rel[bucket * 8 + h];
    }
    float4* acc4 = (float4*)(p.ws + WS_ACC);
    for (size_t i = (size_t)bid * 256 + threadIdx.x; i < (size_t)MTOK * 1024 / 4; i += (size_t)nb * 256) acc4[i] = make_float4(0.f, 0.f, 0.f, 0.f);
}

__device__ __forceinline__ void phase_modnorm(const Params& p, int bid, int nb, const float* src, const float* nw, int sh_off, int sc_off, float* dst) {
    const float* mod = (const float*)(p.ws + WS_MOD);
    const int wave = threadIdx.x >> 6, lane = threadIdx.x & 63;
    for (int row = bid * 4 + wave; row < MTOK; row += nb * 4) {
        const int b = row >> 13;
        const float* xr = src + (size_t)row * 1024;
        float v[16]; float ss = 0.f;
#pragma unroll
        for (int i = 0; i < 16; ++i) { v[i] = xr[lane + 64 * i]; ss += v[i] * v[i]; }
        ss = wave_sum(ss);
        const float rstd = 1.0f / sqrtf(ss * (1.f / 1024.f) + 1e-6f);
#pragma unroll
        for (int i = 0; i < 16; ++i) {
            const int ci = lane + 64 * i;
            const float sh = mod[b * 6144 + sh_off + ci], sc = mod[b * 6144 + sc_off + ci];
            dst[(size_t)row * 1024 + ci] = v[i] * rstd * nw[ci] * (1.f + sc) + sh;
        }
    }
}

__device__ __forceinline__ void phase2(const Params& p, int bid, int nb, float* smem) {
    const float* H = (const float*)(p.ws + WS_H1); const float* w_in = p.in[5];
    float* PROJ = (float*)(p.ws + WS_PROJ);
    for (int u = bid; u < 256 * 37; u += nb) {
        const int mt = u / 37, nt = u % 37, m0 = mt * 64, n0 = nt * 64;
        gemm64(smem, [&](int r) { return H + (size_t)(m0 + r) * 1024; }, 64, w_in, NCOLS, n0, NCOLS, 1024,
               [&](int r, int n, float v) { PROJ[(size_t)(m0 + r) * NCOLS + n] = v; });
    }
}

__device__ __forceinline__ void phase3a(const Params& p, int bid, int nb, float* smem) {
    const float* PROJ = (const float*)(p.ws + WS_PROJ);
    const float* pos = p.in[6];
    float* blk = smem; float* hid = smem + 32 * 256;
    const int tid = threadIdx.x;
    for (int u = bid; u < 2 * NCMP; u += nb) {
        const int b = u / NCMP, n = u % NCMP;
        __syncthreads();
        for (int i = tid; i < 32 * 256; i += 256) {
            const int l = i >> 8, cc = i & 255;
            blk[i] = PROJ[(size_t)(b * SEQ + 16 * n + l) * NCOLS + COL_KC + cc] + pos[l * 64 + (cc & 63)];
        }
        __syncthreads();
        const int kv = tid >> 7, g = (tid >> 6) & 1, j = tid & 63;
        const float* w1 = kv ? p.in[9] : p.in[7];
        const int colbase = kv * 128 + g * 64;
        float acc = 0.f;
#pragma unroll 1
        for (int l = 0; l < 32; ++l) {
#pragma unroll 8
            for (int d = 0; d < 64; ++d) acc += blk[l * 256 + colbase + d] * w1[(size_t)(l * 64 + d) * 64 + j];
        }
        hid[tid] = gelu_t(acc);
        __syncthreads();
        const float* w2 = kv ? p.in[10] : p.in[8];
        float acc2 = 0.f;
#pragma unroll 8
        for (int i = 0; i < 64; ++i) acc2 += hid[(tid & ~63) + i] * w2[i * 64 + j];
        float* outp = (float*)(p.ws + (kv ? WS_VC : WS_KC));
        outp[(size_t)((b * NCMP + n) * 2 + g) * 64 + j] = acc2;
    }
}

__device__ __forceinline__ void phase3b(const Params& p, int bid, int nb, float* smem) {
    const float* PROJ = (const float*)(p.ws + WS_PROJ);
    const float* conv_w = p.in[12]; const float* conv_b = p.in[13];
    const float* wa = p.in[14]; const float* ba = p.in[15]; const float* wx = p.in[16]; const float* bx = p.in[17]; const float* lam = p.in[18];
    float* HL = (float*)(p.ws + WS_HL); float* AP = (float*)(p.ws + WS_AP);
    float* AEND = (float*)(p.ws + WS_AEND); float* HEND = (float*)(p.ws + WS_HEND);
    float* xc = smem; float* aa = smem + 8 * 512; float* uu = smem + 16 * 512;
    const int tid = threadIdx.x;
    for (int u = bid; u < 2 * 128; u += nb) {
        const int b = u >> 7, chunk = u & 127;
        float hA0 = 1.f, hA1 = 1.f, hH0 = 0.f, hH1 = 0.f;
        for (int sub = 0; sub < 8; ++sub) {
            const int t0 = chunk * 64 + sub * 8;
            __syncthreads();
            for (int i = tid; i < 8 * 512; i += 256) {
                const int tt = i >> 9, c = i & 511, t = t0 + tt;
                float acc = conv_b[c];
#pragma unroll
                for (int w = 0; w < 4; ++w) { const int ts = t - 3 + w; if (ts >= 0) acc += conv_w[w * 512 + c] * PROJ[(size_t)(b * SEQ + ts) * NCOLS + COL_XR + c]; }
                xc[i] = acc;
            }
            __syncthreads();
            for (int i = tid; i < 8 * 512; i += 256) {
                const int tt = i >> 9, c = i & 511, hb = c >> 6, j = c & 63;
                float ra = ba[c], ia = bx[c];
#pragma unroll 8
                for (int q = 0; q < 64; ++q) { const float xv = xc[tt * 512 + hb * 64 + q]; ra += xv * wa[(hb * 64 + q) * 64 + j]; ia += xv * wx[(hb * 64 + q) * 64 + j]; }
                const float r = sigm(ra), ig = sigm(ia);
                const float log_a = -8.0f * r * softplus_(-lam[c]);
                const float a = expf(log_a);
                const float uq = sqrtf(fmaxf(-expm1f(2.0f * log_a), 0.f)) * (ig * xc[i]);
                aa[i] = a; uu[i] = uq;
            }
            __syncthreads();
#pragma unroll
            for (int tt = 0; tt < 8; ++tt) {
                { const int c = tid; const float a = aa[tt * 512 + c]; hH0 = a * hH0 + uu[tt * 512 + c]; hA0 *= a;
                  HL[(size_t)(b * SEQ + t0 + tt) * 512 + c] = hH0; AP[(size_t)(b * SEQ + t0 + tt) * 512 + c] = hA0; }
                { const int c = tid + 256; const float a = aa[tt * 512 + c]; hH1 = a * hH1 + uu[tt * 512 + c]; hA1 *= a;
                  HL[(size_t)(b * SEQ + t0 + tt) * 512 + c] = hH1; AP[(size_t)(b * SEQ + t0 + tt) * 512 + c] = hA1; }
            }
        }
        AEND[(size_t)(b * 128 + chunk) * 512 + tid] = hA0; HEND[(size_t)(b * 128 + chunk) * 512 + tid] = hH0;
        AEND[(size_t)(b * 128 + chunk) * 512 + tid + 256] = hA1; HEND[(size_t)(b * 128 + chunk) * 512 + tid + 256] = hH1;
    }
}

__device__ __forceinline__ void phase3c(const Params& p, int bid, int nb) {
    const float* AEND = (const float*)(p.ws + WS_AEND); const float* HEND = (const float*)(p.ws + WS_HEND);
    float* CARRY = (float*)(p.ws + WS_CARRY);
    for (int idx = bid * 256 + threadIdx.x; idx < 2 * 512; idx += nb * 256) {
        const int b = idx >> 9, c = idx & 511;
        float carry = 0.f;
        for (int k = 0; k < 128; ++k) {
            CARRY[(size_t)(b * 128 + k) * 512 + c] = carry;
            carry = AEND[(size_t)(b * 128 + k) * 512 + c] * carry + HEND[(size_t)(b * 128 + k) * 512 + c];
        }
    }
}

template <class KP, class VP>
__device__ __forceinline__ void attend_block(const float* qh, float* pb, int lane, bool valid, float biasv, KP kptr, VP vptr, int kcount, float& m, float& l, float& o) {
    float logit = -INF;
    if (valid) {
        const float4* kr = (const float4*)kptr(lane);
        float dot = 0.f;
#pragma unroll
        for (int d4 = 0; d4 < 16; ++d4) { const float4 kk = kr[d4]; const float4 qq = *(const float4*)(qh + d4 * 4); dot += qq.x * kk.x + qq.y * kk.y + qq.z * kk.z + qq.w * kk.w; }
        logit = dot + biasv;
    }
    const float bm = wave_max(logit);
    if (bm == -INF) return;
    const float mnew = fmaxf(m, bm);
    const float scale = expf(m - mnew);
    const float pv = valid ? expf(logit - mnew) : 0.f;
    __builtin_amdgcn_wave_barrier();
    pb[lane] = pv;
    __builtin_amdgcn_wave_barrier();
    l = l * scale + wave_sum(pv);
    float acc = 0.f;
    for (int k = 0; k < kcount; ++k) acc += pb[k] * vptr(k)[lane];
    o = o * scale + acc;
    m = mnew;
    __builtin_amdgcn_wave_barrier();
}

__device__ __forceinline__ void phase4(const Params& p, int bid, int nb, float* smem) {
    const float* PROJ = (const float*)(p.ws + WS_PROJ);
    const float* KC = (const float*)(p.ws + WS_KC); const float* VC = (const float*)(p.ws + WS_VC);
    const float* lut = (const float*)(p.ws + WS_LUT);
    const float* HL = (const float*)(p.ws + WS_HL); const float* AP = (const float*)(p.ws + WS_AP); const float* CARRY = (const float*)(p.ws + WS_CARRY);
    const float* gaw = p.in[19]; const float* grw = p.in[20];
    float* Y = (float*)(p.ws + WS_Y);
    const int wave = threadIdx.x >> 6, lane = threadIdx.x & 63;
    float* wsm = smem + wave * 2048;
    float* qs = wsm;
    float* lg = wsm + 256;
    float* psum = wsm + 768;
    float* sc = wsm + 1288;
    float* oatt = wsm + 1416;
    for (int tok = bid * 4 + wave; tok < MTOK; tok += nb * 4) {
        const int b = tok >> 13, t = tok & 8191;
        const float* prow = PROJ + (size_t)tok * NCOLS;
        const int cur = t >> 6;
        const int nvalid = t >= 31 ? ((t - 31) >> 4) + 1 : 0;
        for (int g = 0; g < 2; ++g) {
            __builtin_amdgcn_wave_barrier();
#pragma unroll
            for (int qi = 0; qi < 4; ++qi) qs[qi * 64 + lane] = prow[(g * 4 + qi) * 64 + lane] * 0.125f;
            for (int i = lane; i < 520; i += 64) psum[i] = 0.f;
            __builtin_amdgcn_wave_barrier();
            float oc[4], os[4], ow[4];
#pragma unroll
            for (int qi = 0; qi < 4; ++qi) {
                const int h = g * 4 + qi;
                float mx = -INF;
                for (int r = 0; r < 8; ++r) {
                    const int n = r * 64 + lane; float l = -INF;
                    if (n < nvalid) {
                        const float4* kr = (const float4*)(KC + (size_t)((b * NCMP + n) * 2 + g) * 64);
                        float dot = 0.f;
#pragma unroll
                        for (int d4 = 0; d4 < 16; ++d4) { const float4 kk = kr[d4]; const float4 qq = *(const float4*)(qs + qi * 64 + d4 * 4); dot += qq.x * kk.x + qq.y * kk.y + qq.z * kk.z + qq.w * kk.w; }
                        int dist = t - (16 * n + 31); dist = dist < 1023 ? dist : 1023;
                        l = dot + lut[h * 1024 + dist];
                    }
                    lg[n] = l; mx = fmaxf(mx, l);
                }
                mx = wave_max(mx); if (mx == -INF) mx = 0.f;
                float sum = 0.f;
                for (int r = 0; r < 8; ++r) { const int n = r * 64 + lane; const float pv = (n < nvalid) ? expf(lg[n] - mx) : 0.f; lg[n] = pv; sum += pv; }
                sum = wave_sum(sum);
                const float inv = 1.f / fmaxf(sum, 1e-30f);
                for (int r = 0; r < 8; ++r) { const int n = r * 64 + lane; const float pv = lg[n] * inv; lg[n] = pv; psum[4 + n] += pv; }
                __builtin_amdgcn_wave_barrier();
                float o = 0.f;
                for (int n = 0; n < nvalid; ++n) o += lg[n] * VC[(size_t)((b * NCMP + n) * 2 + g) * 64 + lane];
                oc[qi] = o;
                __builtin_amdgcn_wave_barrier();
            }
            for (int r = 0; r < 2; ++r) {
                const int j = r * 64 + lane; float s = 0.f;
#pragma unroll
                for (int n = 4 * j - 1; n <= 4 * j + 3; ++n) s += psum[4 + n];
                const bool forced = (j == 0) || (j == cur) || (j == cur - 1);
                s = forced ? INF : (j <= cur ? s : -INF);
                sc[j] = s;
            }
            __builtin_amdgcn_wave_barrier();
            bool sel0, sel1;
            {
                const int j0 = lane, j1 = lane + 64; const float s0 = sc[j0], s1 = sc[j1]; int r0 = 0, r1 = 0;
                for (int j2 = 0; j2 < 128; ++j2) { const float s2 = sc[j2]; r0 += (s2 > s0) || (s2 == s0 && j2 < j0); r1 += (s2 > s1) || (s2 == s1 && j2 < j1); }
                sel0 = (r0 < 16) && (j0 <= cur); sel1 = (r1 < 16) && (j1 <= cur);
            }
            const unsigned long long m0 = __ballot(sel0), m1 = __ballot(sel1);
#pragma unroll
            for (int qi = 0; qi < 4; ++qi) {
                const int h = g * 4 + qi;
                float m = -INF, l = 0.f, o = 0.f;
                for (int half = 0; half < 2; ++half) {
                    unsigned long long mm = half ? m1 : m0;
                    while (mm) {
                        const int j = (int)__builtin_ctzll(mm) + half * 64; mm &= mm - 1;
                        const int kpos = 64 * j + lane; const bool valid = kpos <= t;
                        int dist = t - kpos; dist = dist < 1023 ? dist : 1023; dist = dist > 0 ? dist : 0;
                        const float* kb = PROJ + (size_t)(b * SEQ + 64 * j) * NCOLS;
                        attend_block(qs + qi * 64, lg, lane, valid, lut[h * 1024 + dist],
                                     [&](int k) { return kb + (size_t)k * NCOLS + COL_KS + g * 64; },
                                     [&](int k) { return kb + (size_t)k * NCOLS + COL_VS + g * 64; }, 64, m, l, o);
                    }
                }
                os[qi] = o / fmaxf(l, 1e-30f);
            }
#pragma unroll
            for (int qi = 0; qi < 4; ++qi) {
                const int h = g * 4 + qi;
                float m = -INF, l = 0.f, o = 0.f;
                for (int r = 0; r < 8; ++r) {
                    const int k0 = t - 511 + 64 * r;
                    if (k0 + 63 < 0) continue;
                    const int kpos = k0 + lane; const bool valid = kpos >= 0;
                    const int dist = valid ? t - kpos : 0;
                    const int kfirst = k0 < 0 ? -k0 : 0;
                    const float* kb = PROJ + (size_t)(b * SEQ) * NCOLS;
                    float logit = -INF;
                    if (valid) {
                        const float4* kr = (const float4*)(kb + (size_t)kpos * NCOLS + COL_KW + g * 64);
                        float dot = 0.f;
#pragma unroll
                        for (int d4 = 0; d4 < 16; ++d4) { const float4 kk = kr[d4]; const float4 qq = *(const float4*)(qs + qi * 64 + d4 * 4); dot += qq.x * kk.x + qq.y * kk.y + qq.z * kk.z + qq.w * kk.w; }
                        logit = dot + lut[h * 1024 + dist];
                    }
                    const float bm = wave_max(logit);
                    const float mnew = fmaxf(m, bm);
                    const float scale = expf(m - mnew);
                    const float pv = valid ? expf(logit - mnew) : 0.f;
                    __builtin_amdgcn_wave_barrier();
                    lg[lane] = pv;
                    __builtin_amdgcn_wave_barrier();
                    l = l * scale + wave_sum(pv);
                    float acc = 0.f;
                    for (int k = kfirst; k < 64; ++k) acc += lg[k] * kb[(size_t)(k0 + k) * NCOLS + COL_VW + g * 64 + lane];
                    o = o * scale + acc;
                    m = mnew;
                    __builtin_amdgcn_wave_barrier();
                }
                ow[qi] = o / fmaxf(l, 1e-30f);
            }
#pragma unroll
            for (int qi = 0; qi < 4; ++qi) {
                const int h = g * 4 + qi;
                const float gc = sigm(prow[COL_G + h * 3 + 0]), gs = sigm(prow[COL_G + h * 3 + 1]), gw = sigm(prow[COL_G + h * 3 + 2]);
                oatt[h * 64 + lane] = gc * oc[qi] + gs * os[qi] + gw * ow[qi];
            }
        }
        __builtin_amdgcn_wave_barrier();
        {
            float v[8]; float ss = 0.f;
#pragma unroll
            for (int i = 0; i < 8; ++i) { v[i] = oatt[lane + 64 * i]; ss += v[i] * v[i]; }
            ss = wave_sum(ss);
            const float rstd = 1.0f / sqrtf(ss * (1.f / 512.f) + 1e-6f);
#pragma unroll
            for (int i = 0; i < 8; ++i) Y[(size_t)tok * 1024 + lane + 64 * i] = v[i] * rstd * gaw[lane + 64 * i];
        }
        {
            const int chunk = t >> 6;
            float v[8]; float ss = 0.f;
#pragma unroll
            for (int i = 0; i < 8; ++i) {
                const int c = lane + 64 * i;
                const float carry = CARRY[(size_t)(b * 128 + chunk) * 512 + c];
                const float hs = HL[(size_t)tok * 512 + c] + AP[(size_t)tok * 512 + c] * carry;
                v[i] = hs * gelu_t(prow[COL_GR + c]); ss += v[i] * v[i];
            }
            ss = wave_sum(ss);
            const float rstd = 1.0f / sqrtf(ss * (1.f / 512.f) + 1e-6f);
#pragma unroll
            for (int i = 0; i < 8; ++i) Y[(size_t)tok * 1024 + 512 + lane + 64 * i] = v[i] * rstd * grw[lane + 64 * i];
        }
        __builtin_amdgcn_wave_barrier();
    }
}

__device__ __forceinline__ void phase5(const Params& p, int bid, int nb, float* smem) {
    const float* Y = (const float*)(p.ws + WS_Y); const float* w_out = p.in[21]; const float* x = p.in[0];
    const float* mod = (const float*)(p.ws + WS_MOD);
    float* X1 = (float*)(p.ws + WS_X1);
    for (int u = bid; u < 256 * 16; u += nb) {
        const int mt = u / 16, nt = u % 16, m0 = mt * 64, n0 = nt * 64;
        const int b = m0 >> 13;
        gemm64(smem, [&](int r) { return Y + (size_t)(m0 + r) * 1024; }, 64, w_out, 1024, n0, 1024, 1024,
               [&](int r, int n, float v) { const size_t o = (size_t)(m0 + r) * 1024 + n; X1[o] = x[o] + mod[b * 6144 + 2048 + n] * v; });
    }
}

__device__ __forceinline__ void phase7(const Params& p, int bid, int nb, float* smem) {
    const float* H2 = (const float*)(p.ws + WS_H2); const float* wr = p.in[23];
    float* LOG = (float*)(p.ws + WS_LOGITS);
    for (int u = bid; u < 256 * 4; u += nb) {
        const int mt = u / 4, nt = u % 4, m0 = mt * 64, n0 = nt * 64;
        gemm64(smem, [&](int r) { return H2 + (size_t)(m0 + r) * 1024; }, 64, wr, 256, n0, 256, 1024,
               [&](int r, int n, float v) { LOG[(size_t)(m0 + r) * 256 + n] = v; });
    }
}

__device__ __forceinline__ void phase8(const Params& p, int bid, int nb, float* smem) {
    const float* LOG = (const float*)(p.ws + WS_LOGITS); const float* brt = p.in[24];
    unsigned* cnt = (unsigned*)(p.ws + WS_CTL) + CW_CNT;
    int* EID = (int*)(p.ws + WS_EID); int* POS = (int*)(p.ws + WS_POS); float* WGT = (float*)(p.ws + WS_WGT);
    const int wave = threadIdx.x >> 6, lane = threadIdx.x & 63;
    float* s = smem + wave * 512; float* ssel = s + 256;
    for (int tok = bid * 4 + wave; tok < MTOK; tok += nb * 4) {
        __builtin_amdgcn_wave_barrier();
#pragma unroll
        for (int r = 0; r < 4; ++r) { const int e = r * 64 + lane; const float sv = sigm(LOG[(size_t)tok * 256 + e]); s[e] = sv; ssel[e] = sv + brt[e]; }
        __builtin_amdgcn_wave_barrier();
        float gsc = -INF;
        if (lane < 8) {
            float m1 = -INF, m2 = -INF;
            for (int i = 0; i < 32; ++i) { const float v = ssel[lane * 32 + i]; if (v > m1) { m2 = m1; m1 = v; } else if (v > m2) m2 = v; }
            gsc = m1 + m2;
        }
        int grank = 0;
#pragma unroll
        for (int g2 = 0; g2 < 8; ++g2) { const float v2 = __shfl(gsc, g2); grank += (v2 > gsc) || (v2 == gsc && g2 < lane); }
        const bool gok = (lane < 8) && (grank < 4);
        const unsigned long long gmask = __ballot(gok);
        float cv0, cv1, cv2, cv3;
        { const int e = lane;        cv0 = ((gmask >> (e >> 5)) & 1ull) ? ssel[e] : -INF; }
        { const int e = 64 + lane;   cv1 = ((gmask >> (e >> 5)) & 1ull) ? ssel[e] : -INF; }
        { const int e = 128 + lane;  cv2 = ((gmask >> (e >> 5)) & 1ull) ? ssel[e] : -INF; }
        { const int e = 192 + lane;  cv3 = ((gmask >> (e >> 5)) & 1ull) ? ssel[e] : -INF; }
        int my_e = 0; float my_s = 0.f;
#pragma unroll
        for (int k = 0; k < 8; ++k) {
            float bv = cv0; int bi = lane;
            if (cv1 > bv) { bv = cv1; bi = 64 + lane; }
            if (cv2 > bv) { bv = cv2; bi = 128 + lane; }
            if (cv3 > bv) { bv = cv3; bi = 192 + lane; }
#pragma unroll
            for (int o = 32; o; o >>= 1) { const float ov = __shfl_xor(bv, o); const int oi = __shfl_xor(bi, o); if (ov > bv || (ov == bv && oi < bi)) { bv = ov; bi = oi; } }
            if (bi == lane) cv0 = -INF;
            if (bi == 64 + lane) cv1 = -INF;
            if (bi == 128 + lane) cv2 = -INF;
            if (bi == 192 + lane) cv3 = -INF;
            if (lane == k) { my_e = bi; my_s = s[bi]; }
        }
        const float ssum = wave_sum(lane < 8 ? my_s : 0.f);
        if (lane < 8) {
            const unsigned ps = atomicAdd(&cnt[my_e], 1u);
            EID[tok * 8 + lane] = my_e; POS[tok * 8 + lane] = (int)ps; WGT[tok * 8 + lane] = 2.5f * my_s / ssum;
        }
    }
}

__device__ __forceinline__ void expert_tables(const Params& p, int* off, int* tp) {
    const unsigned* cnt = (const unsigned*)(p.ws + WS_CTL) + CW_CNT;
    __syncthreads();
    if (threadIdx.x == 0) {
        int o = 0, t = 0;
        for (int e = 0; e < 256; ++e) { off[e] = o; tp[e] = t; const int c = (int)cnt[e]; o += c; t += (c + 63) >> 6; }
        off[256] = o; tp[256] = t; tp[257] = t + 256;
    }
    __syncthreads();
}

__device__ __forceinline__ void phase9(const Params& p, int bid, int nb, float* smem) {
    int* off = (int*)smem; int* tp = off + 272;
    expert_tables(p, off, tp);
    const int* EID = (const int*)(p.ws + WS_EID); const int* POS = (const int*)(p.ws + WS_POS); const float* WGT = (const float*)(p.ws + WS_WGT);
    int* ST = (int*)(p.ws + WS_SLOTTOK); float* SW = (float*)(p.ws + WS_SLOTW);
    for (int idx = bid * 256 + threadIdx.x; idx < NK; idx += nb * 256) {
        const int slot = off[EID[idx]] + POS[idx];
        ST[slot] = idx >> 3; SW[slot] = WGT[idx];
    }
}

__device__ __forceinline__ int find_expert(const int* tp, int rt) {
    int lo = 0, hi = 256;
    while (lo < hi) { const int mid = (lo + hi + 1) >> 1; if (tp[mid] <= rt) lo = mid; else hi = mid - 1; }
    return lo;
}

__device__ __forceinline__ void phase10(const Params& p, int bid, int nb, float* smem) {
    int* off = (int*)(smem + 2 * 16 * 68); int* tp = off + 272;
    expert_tables(p, off, tp);
    const unsigned* cnt = (const unsigned*)(p.ws + WS_CTL) + CW_CNT;
    const float* H2 = (const float*)(p.ws + WS_H2); const int* ST = (const int*)(p.ws + WS_SLOTTOK);
    float* HID = (float*)(p.ws + WS_HID);
    const int total = tp[257] * 4;
    for (int u = bid; u < total; u += nb) {
        const int rt = u >> 2, ct = u & 3;
        const int e = find_expert(tp, rt);
        const int rows_e = e < 256 ? (int)cnt[e] : MTOK;
        const int r0 = (rt - tp[e]) * 64;
        const int mrows = (rows_e - r0) < 64 ? (rows_e - r0) : 64;
        const int slot0 = (e < 256 ? off[e] : NK) + r0;
        const float* B1 = e < 256 ? p.in[25] + (size_t)e * 1024 * 256 : p.in[28];
        const float* B3 = e < 256 ? p.in[26] + (size_t)e * 1024 * 256 : p.in[29];
        auto arow = [&](int r) { const int slot = slot0 + r; const int tok = slot < NK ? ST[slot] : slot - NK; return H2 + (size_t)tok * 1024; };
        gemm64(smem, arow, mrows, B1, 256, ct * 64, 256, 1024, [&](int r, int n, float v) { HID[(size_t)(slot0 + r) * 256 + n] = v; });
        gemm64(smem, arow, mrows, B3, 256, ct * 64, 256, 1024, [&](int r, int n, float v) { const size_t o = (size_t)(slot0 + r) * 256 + n; const float a = HID[o]; HID[o] = (a / (1.f + expf(-a))) * v; });
    }
}

__device__ __forceinline__ void phase11(const Params& p, int bid, int nb, float* smem) {
    int* off = (int*)(smem + 2 * 16 * 68); int* tp = off + 272;
    expert_tables(p, off, tp);
    const unsigned* cnt = (const unsigned*)(p.ws + WS_CTL) + CW_CNT;
    const float* HID = (const float*)(p.ws + WS_HID); const int* ST = (const int*)(p.ws + WS_SLOTTOK); const float* SW = (const float*)(p.ws + WS_SLOTW);
    float* ACC = (float*)(p.ws + WS_ACC);
    const int total = tp[257] * 16;
    for (int u = bid; u < total; u += nb) {
        const int rt = u >> 4, ct = u & 15;
        const int e = find_expert(tp, rt);
        const int rows_e = e < 256 ? (int)cnt[e] : MTOK;
        const int r0 = (rt - tp[e]) * 64;
        const int mrows = (rows_e - r0) < 64 ? (rows_e - r0) : 64;
        const int slot0 = (e < 256 ? off[e] : NK) + r0;
        const float* B2 = e < 256 ? p.in[27] + (size_t)e * 256 * 1024 : p.in[30];
        gemm64(smem, [&](int r) { return HID + (size_t)(slot0 + r) * 256; }, mrows, B2, 1024, ct * 64, 1024, 256,
               [&](int r, int n, float v) { const int slot = slot0 + r; const int tok = slot < NK ? ST[slot] : slot - NK; const float w = slot < NK ? SW[slot] : 1.f;
                                            atomicAdd(&ACC[(size_t)tok * 1024 + n], v * w); });
    }
}

__device__ __forceinline__ void phase12(const Params& p, int bid, int nb) {
    const float* X1 = (const float*)(p.ws + WS_X1); const float* ACC = (const float*)(p.ws + WS_ACC);
    const float* mod = (const float*)(p.ws + WS_MOD); const float* fw = p.in[31];
    const int wave = threadIdx.x >> 6, lane = threadIdx.x & 63;
    for (int row = bid * 4 + wave; row < MTOK; row += nb * 4) {
        const int b = row >> 13;
        float v[16]; float ss = 0.f;
#pragma unroll
        for (int i = 0; i < 16; ++i) { const int ci = lane + 64 * i; v[i] = X1[(size_t)row * 1024 + ci] + mod[b * 6144 + 5120 + ci] * ACC[(size_t)row * 1024 + ci]; ss += v[i] * v[i]; }
        ss = wave_sum(ss);
        const float rstd = 1.0f / sqrtf(ss * (1.f / 1024.f) + 1e-6f);
#pragma unroll
        for (int i = 0; i < 16; ++i) { const int ci = lane + 64 * i; p.out[(size_t)row * 1024 + ci] = v[i] * rstd * fw[ci]; }
    }
}

template <int PH>
__global__ void __launch_bounds__(256, 2) k_phase(Params p) {
    __shared__ __attribute__((aligned(16))) float smem[SMEM_BYTES / 4];
    const int bid = blockIdx.x, nb = gridDim.x;
    if (PH == 0) phase0(p, bid, nb);
    if (PH == 1) phase_modnorm(p, bid, nb, p.in[0], p.in[4], 0, 1024, (float*)(p.ws + WS_H1));
    if (PH == 2) phase2(p, bid, nb, smem);
    if (PH == 3) { phase3a(p, bid, nb, smem); phase3b(p, bid, nb, smem); }
    if (PH == 4) phase3c(p, bid, nb);
    if (PH == 5) phase4(p, bid, nb, smem);
    if (PH == 6) phase5(p, bid, nb, smem);
    if (PH == 7) phase_modnorm(p, bid, nb, (const float*)(p.ws + WS_X1), p.in[22], 3072, 4096, (float*)(p.ws + WS_H2));
    if (PH == 8) phase7(p, bid, nb, smem);
    if (PH == 9) phase8(p, bid, nb, smem);
    if (PH == 10) phase9(p, bid, nb, smem);
    if (PH == 11) phase10(p, bid, nb, smem);
    if (PH == 12) phase11(p, bid, nb, smem);
    if (PH == 13) phase12(p, bid, nb);
}

extern "C" void kernel_launch(void* const* d_in, const int* in_sizes, int n_in, void* d_out, int out_size, void* d_ws, size_t ws_size, hipStream_t stream) {
    Params p{};
    for (int i = 0; i < 32; ++i) p.in[i] = (const float*)d_in[i];
    p.out = (float*)d_out; p.ws = (unsigned char*)d_ws;
    hipMemsetAsync((char*)d_ws + WS_CTL, 0, CTL_BYTES, stream);
    const dim3 grid(1024), blk(256);
    hipLaunchKernelGGL(k_phase<0>, grid, blk, 0, stream, p);
    hipLaunchKernelGGL(k_phase<1>, grid, blk, 0, stream, p);
    hipLaunchKernelGGL(k_phase<2>, grid, blk, 0, stream, p);
    hipLaunchKernelGGL(k_phase<3>, grid, blk, 0, stream, p);
    hipLaunchKernelGGL(k_phase<4>, grid, blk, 0, stream, p);
    hipLaunchKernelGGL(k_phase<5>, grid, blk, 0, stream, p);
    hipLaunchKernelGGL(k_phase<6>, grid, blk, 0, stream, p);
    hipLaunchKernelGGL(k_phase<7>, grid, blk, 0, stream, p);
    hipLaunchKernelGGL(k_phase<8>, grid, blk, 0, stream, p);
    hipLaunchKernelGGL(k_phase<9>, grid, blk, 0, stream, p);
    hipLaunchKernelGGL(k_phase<10>, grid, blk, 0, stream, p);
    hipLaunchKernelGGL(k_phase<11>, grid, blk, 0, stream, p);
    hipLaunchKernelGGL(k_phase<12>, grid, blk, 0, stream, p);
    hipLaunchKernelGGL(k_phase<13>, grid, blk, 0, stream, p);
}
```

```cpp
#include <hip/hip_runtime.h>
#include <stdint.h>
#include <type_traits>


#define MTOK 16384
#define SEQ 8192
#define SEQP 8195
#define DM 1024
#define NCOLS 2328
#define COL_KC 512
#define COL_KS 768
#define COL_VS 896
#define COL_KW 1024
#define COL_VW 1152
#define COL_G 1280
#define COL_XR 1304
#define COL_GR 1816
#define NCMP 511
#define NEXP 256
#define NK 131072

#define MiB (1048576ull)
#define WS_CTL 0ull
#define CTL_BYTES (1 * MiB)
#define CW_CNT 8192
#define CW_RANK 12288
#define WS_MOD (1 * MiB)
#define WS_LUT (1 * MiB + 65536)
#define WS_KC (2 * MiB)
#define WS_VC (3 * MiB)
#define WS_AEND (4 * MiB)
#define WS_HEND (5 * MiB)
#define WS_EID (6 * MiB)
#define WS_POS (7 * MiB)
#define WS_WGT (8 * MiB)
#define WS_SLOTTOK (9 * MiB)
#define WS_SLOTW (10 * MiB)
#define WS_CARRY (11 * MiB)
#define WS_SLOTOF (12 * MiB)
#define WS_HIST (13 * MiB)
#define WS_LOGITS (16 * MiB)
#define WS_H1 (32 * MiB)
#define WS_PROJ (96 * MiB)
#define WS_HL (256 * MiB)
#define WS_AP (288 * MiB)
#define WS_ACC (320 * MiB)
#define WS_HID (384 * MiB)
#define WS_Y (528 * MiB)
#define WS_H2 (592 * MiB)
#define WS_X1 (656 * MiB)
#define WS_H1B (720 * MiB)
#define WS_YB (752 * MiB)
#define WS_H2B (784 * MiB)
#define WS_HIDB (816 * MiB)
#define WS_QB (896 * MiB)
#define WS_KV6 (912 * MiB)
#define WS_GATE (936 * MiB)
#define WS_KCB (938 * MiB)
#define WS_VCB (939 * MiB)
#define WS_OATT (940 * MiB)
#define WS_BG (14 * MiB)
#define WS_GBIAS (15 * MiB)
#define WS_CBIAS (15 * MiB + 8192)
#define WS_XRB (972 * MiB)
#define WS_GRG (990 * MiB)
#define WS_CPART (1007 * MiB)
#define WS_ALRU (256 * MiB)
#define WS_ULRU (288 * MiB)
#define WS_WINB (1012 * MiB)
#define WS_WOUTB (1017 * MiB)
#define WS_WRB (1020 * MiB)
#define WS_WINT (1012 * MiB)
#define WS_WOUTT (1017 * MiB)
#define WS_WRT (1019 * MiB)
#define WS_SLOTOUT (32 * MiB)

#ifndef REP
#define REP 0
#endif
#ifndef USE_MFMA
#define USE_MFMA 31
#endif

struct Params {
    const float* in[32];
    float* out;
    unsigned char* ws;
};

#define NT 512
#define NW 8
#define LDS_BYTES 151552
#define LDS_MISC 131072
#define INF __builtin_huge_valf()
#define LOG2E 1.4426950408889634f

__device__ __forceinline__ float wave_sum(float v) {
#define WS_DPP(ctrl, rmask) __builtin_bit_cast(float, __builtin_amdgcn_update_dpp(0, __builtin_bit_cast(int, v), (ctrl), (rmask), 0xf, true))
    v += WS_DPP(0x111, 0xf);
    v += WS_DPP(0x112, 0xf);
    v += WS_DPP(0x114, 0xf);
    v += WS_DPP(0x118, 0xf);
    v += WS_DPP(0x142, 0xa);
    v += WS_DPP(0x143, 0xc);
#undef WS_DPP
    return __builtin_bit_cast(float, __builtin_amdgcn_readlane(__builtin_bit_cast(int, v), 63));
}
__device__ __forceinline__ float wave_max(float v) {
#pragma unroll
    for (int o = 32; o; o >>= 1) v = fmaxf(v, __shfl_xor(v, o));
    return v;
}
__device__ __forceinline__ float sigm(float x) { return __builtin_amdgcn_rcpf(1.f + __builtin_amdgcn_exp2f(-1.4426950408889634f * x)); }
__device__ __forceinline__ float tanh_fast(float x) { return 1.f - 2.f * __builtin_amdgcn_rcpf(1.f + __builtin_amdgcn_exp2f(2.8853900817779268f * x)); }
__device__ __forceinline__ float gelu_t(float x) { return 0.5f * x * (1.f + tanh_fast(0.7978845608028654f * (x + 0.044715f * x * x * x))); }
__device__ __forceinline__ float softplus_(float z) { return fmaxf(z, 0.f) + log1pf(expf(-fabsf(z))); }


#define XB_TMO      128
#define XB_XCNT(j)  (256  + 64 * (j))
#define XB_XSUB(j)  (1280 + 64 * (j))
#define XB_XGEN(j)  (2304 + 64 * (j))
#define XB_TOP      3328
#define XB_TOPGEN   3392
#define XCD_BAR_WORDS 3456
#define XB_SPIN_CAP (1u << 18)
#define LAS __attribute__((address_space(3)))

__device__ __forceinline__ unsigned xb_ld(unsigned* p)              { return __hip_atomic_load(p, __ATOMIC_RELAXED, __HIP_MEMORY_SCOPE_AGENT); }
__device__ __forceinline__ unsigned xb_add(unsigned* p, unsigned v) { return __hip_atomic_fetch_add(p, v, __ATOMIC_RELAXED, __HIP_MEMORY_SCOPE_AGENT); }
__device__ __forceinline__ unsigned xb_xcc_id() { return (unsigned)__builtin_amdgcn_s_getreg((3 << 11) | 20) & 0xFu; }
#define XB_SPIN(cond, bar) do { unsigned _sp = 0; while (cond) { __builtin_amdgcn_s_sleep(1); \
    if ((++_sp & 255u) == 0u) { if (xb_ld(&(bar)[XB_TMO])) break; if (_sp > XB_SPIN_CAP) { atomicAdd(&(bar)[XB_TMO], 1u); break; } } } } while (0)

struct XcdBarrier {
    unsigned* bar; unsigned x;
    volatile LAS unsigned* st;
};
__device__ __forceinline__ XcdBarrier xcd_barrier_post(unsigned* bar, volatile LAS unsigned* st) {
    XcdBarrier b; b.bar = bar; b.x = xb_xcc_id(); b.st = st;
    if (threadIdx.x == 0) (void)xb_add(&bar[XB_XCNT(b.x)], 1u);
    return b;
}
__device__ __forceinline__ void xcd_barrier_complete(unsigned* bar, unsigned x, unsigned& nloc, unsigned& nx) {
    const unsigned G = gridDim.x * gridDim.y * gridDim.z;
    unsigned sum, cnt, mine, sp = 0u;
    for (;;) {
        sum = 0u; cnt = 0u; mine = 0u;
#pragma unroll
        for (unsigned j = 0; j < 16; ++j) { const unsigned c = xb_ld(&bar[XB_XCNT(j)]); sum += c; cnt += (c > 0u) ? 1u : 0u; mine = (j == x) ? c : mine; }
        if (sum == G) break;
        __builtin_amdgcn_s_sleep(1);
        if ((++sp & 255u) == 0u) { if (xb_ld(&bar[XB_TMO])) break; if (sp > XB_SPIN_CAP) { atomicAdd(&bar[XB_TMO], 1u); break; } }
    }
    nloc = mine > 0u ? mine : 1u; nx = cnt > 0u ? cnt : 1u;
}
__device__ __forceinline__ void xcd_barrier(const XcdBarrier& b) {
    asm volatile("s_waitcnt vmcnt(0)" ::: "memory");
    __syncthreads();
    if (threadIdx.x == 0) {
        unsigned* bar = b.bar;
        __builtin_amdgcn_s_waitcnt(0);
        unsigned nloc = b.st[0], nx = b.st[1];
        if (nloc == 0u) { xcd_barrier_complete(bar, b.x, nloc, nx); b.st[0] = nloc; b.st[1] = nx; }
        const unsigned old = xb_add(&bar[XB_XSUB(b.x)], 1u);
        const unsigned gen = old / nloc;
        if (old + 1u == (gen + 1u) * nloc) {
            __builtin_amdgcn_fence(__ATOMIC_RELEASE, "agent");
            asm volatile("s_waitcnt vmcnt(0)" ::: "memory");
            const unsigned og = xb_add(&bar[XB_TOP], 1u);
            const unsigned tg = og / nx;
            if (og + 1u == (tg + 1u) * nx) xb_add(&bar[XB_TOPGEN], 1u);
            else XB_SPIN(xb_ld(&bar[XB_TOPGEN]) == tg, bar);
            __builtin_amdgcn_fence(__ATOMIC_ACQUIRE, "agent");
            xb_add(&bar[XB_XGEN(b.x)], 1u);
            asm volatile("s_waitcnt vmcnt(0)" ::: "memory");
        } else {
            XB_SPIN(xb_ld(&bar[XB_XGEN(b.x)]) == gen, bar);
            __builtin_amdgcn_fence(__ATOMIC_ACQUIRE, "agent");
            asm volatile("s_waitcnt vmcnt(0)" ::: "memory");
        }
    }
    __syncthreads();
}

typedef short bf16x8 __attribute__((ext_vector_type(8)));
typedef short s16x4 __attribute__((ext_vector_type(4)));
typedef short v4i16_t __attribute__((ext_vector_type(4)));
typedef float f32x4 __attribute__((ext_vector_type(4)));
typedef float f32x2 __attribute__((ext_vector_type(2)));
typedef __bf16 bf16x2_t __attribute__((ext_vector_type(2)));
typedef unsigned short bf16_t;
typedef unsigned u32x2 __attribute__((ext_vector_type(2)));
typedef unsigned u32x4 __attribute__((ext_vector_type(4)));
__device__ __forceinline__ unsigned pk_bf16(float lo, float hi) { return __builtin_bit_cast(unsigned, __builtin_convertvector((f32x2){lo, hi}, bf16x2_t)); }
__device__ __forceinline__ float bf2f(bf16_t v) { return __uint_as_float(((unsigned)v) << 16); }

__device__ __forceinline__ s16x4 tr_read(LAS unsigned char* pa) { s16x4 r; asm volatile("ds_read_b64_tr_b16 %0, %1" : "=v"(r) : "v"(pa) : "memory"); return r; }
#define TR_WAIT8(a0, a1, a2, a3, a4, a5, a6, a7) asm volatile("s_waitcnt lgkmcnt(0)" : "+v"(a0), "+v"(a1), "+v"(a2), "+v"(a3), "+v"(a4), "+v"(a5), "+v"(a6), "+v"(a7) :: "memory")

#define GEMM_LDS_A 0
#define GEMM_LDS_B 65536
template <bool PAIR, int DEPTH, int MODE = 0, bool TILE_EPI = false, bool BBF16 = false, class ARow, class BCol, class MRows, class Epi>
__device__ __forceinline__ void gemm_stream(LAS unsigned char* lds, const unsigned char* Abase, int npass, int nk, int ldb, ARow arow, BCol bcol, MRows mrowsf, Epi epi) {
    int tid_ = threadIdx.x; asm volatile("" : "+v"(tid_));
    const int tid = tid_, wid = __builtin_amdgcn_readfirstlane(tid >> 6), lane = tid & 63;
    const int wr = wid >> 1, wc = wid & 1, fr = lane & 15, fq = lane >> 4;
    if (npass <= 0) return;
    const int S = npass * nk;
    const int Ccol = ((wid & 1) * 32 + 8 * ((lane & 3) ^ ((lane >> 5) << 1))) * 2;
    const int Rbase = 16 * (wid >> 1) + (lane >> 2);
    unsigned asrc[4];
    const int n4 = tid & 31, kb = tid >> 5;
    typedef typename std::conditional<BBF16, const bf16_t*, const float*>::type bptr_t;
    bptr_t bp;
    const int fB = ((kb & 3) << 2) | ((kb >> 2) & 3);
    const int bwoff = 256 * kb + 16 * ((n4 >> 1) ^ fB) + 8 * (n4 & 1);
    const int aoff = wr * 8192 + ((fr * 64 + fq * 16) ^ ((fr >> 3) << 5));
    const int q = (lane >> 2) & 3, pp = lane & 3;
    const int b0 = (wc * 8 + (pp >> 1)) ^ ((q << 2) | (2 * (fq & 1)));
    const int browoff = 256 * (fq * 8 + q) + 8 * (pp & 1);
#define GS_BOFF(v) (browoff + 16 * (b0 ^ (v)))
    f32x4 acc[4][4];
#pragma unroll
    for (int i = 0; i < 4; ++i)
#pragma unroll
        for (int j = 0; j < 4; ++j) acc[i][j] = (f32x4){0.f, 0.f, 0.f, 0.f};
    float4 bregX[4], bregY[4];
    int aP = 0, aK = 0, bP = 0, bK = 0;
#define GS_SETA() do { _Pragma("unroll") for (int _i = 0; _i < 4; ++_i) asrc[_i] = (unsigned)(arow(aP, Rbase + 64 * _i) + Ccol); } while (0)
#define GS_ISSUE_A(buf) do { _Pragma("unroll") for (int _i = 0; _i < 4; ++_i) \
        __builtin_amdgcn_global_load_lds((const unsigned*)(Abase + (size_t)asrc[_i] + (size_t)aK * 128), (LAS unsigned*)(lds + GEMM_LDS_A + (buf) * 32768 + _i * 8192 + wid * 1024), 16, 0, 0); \
        if (++aK == nk) { aK = 0; ++aP; if (aP < npass) GS_SETA(); } } while (0)
#define GS_LOAD_B(breg) do { _Pragma("unroll") for (int _i = 0; _i < 4; ++_i) { \
            if constexpr (BBF16) { const u32x2 _t = *(const u32x2*)(bp + (size_t)(bK * 64 + kb + 16 * _i) * ldb); breg[_i].x = __uint_as_float(_t.x); breg[_i].y = __uint_as_float(_t.y); } \
            else breg[_i] = *(const float4*)(bp + (size_t)(bK * 64 + kb + 16 * _i) * ldb); } \
        if (++bK == nk) { bK = 0; ++bP; if (bP < npass) bp = bcol(bP, n4); } } while (0)
#define GS_WRITE_B(breg, buf) do { _Pragma("unroll") for (int _i = 0; _i < 4; ++_i) { u32x2 _w; \
            if constexpr (BBF16) { _w.x = __float_as_uint(breg[_i].x); _w.y = __float_as_uint(breg[_i].y); } \
            else { _w.x = pk_bf16(breg[_i].x, breg[_i].y); _w.y = pk_bf16(breg[_i].z, breg[_i].w); } \
        *(LAS u32x2*)(lds + GEMM_LDS_B + (buf) * 16384 + bwoff + 4096 * _i) = _w; } } while (0)
#define GS_COMPUTE(buf) do { _Pragma("unroll") for (int ks = 0; ks < 2; ++ks) { \
            bf16x8 af[4]; s16x4 tl0, tl1, tl2, tl3, th0, th1, th2, th3; \
            LAS unsigned char* bb_ = lds + GEMM_LDS_B + (buf) * 16384 + ks * 8192; \
            tl0 = tr_read(bb_ + GS_BOFF(0)); th0 = tr_read(bb_ + 1024 + GS_BOFF(1)); tl1 = tr_read(bb_ + GS_BOFF(2)); th1 = tr_read(bb_ + 1024 + GS_BOFF(3)); \
            tl2 = tr_read(bb_ + GS_BOFF(4)); th2 = tr_read(bb_ + 1024 + GS_BOFF(5)); tl3 = tr_read(bb_ + GS_BOFF(6)); th3 = tr_read(bb_ + 1024 + GS_BOFF(7)); \
            _Pragma("unroll") for (int mi = 0; mi < 4; ++mi) af[mi] = *(const LAS bf16x8*)(lds + GEMM_LDS_A + (buf) * 32768 + aoff + mi * 2048 + ks * 1024); \
            TR_WAIT8(tl0, th0, tl1, th1, tl2, th2, tl3, th3); \
            bf16x8 bfr[4]; \
            bfr[0] = (bf16x8){tl0[0], tl0[1], tl0[2], tl0[3], th0[0], th0[1], th0[2], th0[3]}; bfr[1] = (bf16x8){tl1[0], tl1[1], tl1[2], tl1[3], th1[0], th1[1], th1[2], th1[3]}; \
            bfr[2] = (bf16x8){tl2[0], tl2[1], tl2[2], tl2[3], th2[0], th2[1], th2[2], th2[3]}; bfr[3] = (bf16x8){tl3[0], tl3[1], tl3[2], tl3[3], th3[0], th3[1], th3[2], th3[3]}; \
            _Pragma("unroll") for (int mi = 0; mi < 4; ++mi) _Pragma("unroll") for (int ni = 0; ni < 4; ++ni) \
                acc[mi][ni] = __builtin_amdgcn_mfma_f32_16x16x32_bf16(bfr[ni], af[mi], acc[mi][ni], 0, 0, 0); } } while (0)
#define GS_STEP(CUR, NXT, BREG_LD, BREG_WR) do { \
        if (MODE != 2 && s + DEPTH < S) GS_LOAD_B(BREG_LD); \
        if (MODE != 3 && s + 1 < S) GS_ISSUE_A(NXT); \
        __builtin_amdgcn_sched_barrier(0); \
        if (MODE != 1 && active) GS_COMPUTE(CUR); \
        __builtin_amdgcn_sched_barrier(0); \
        if (s + 1 < S) GS_WRITE_B(BREG_WR, NXT); \
        const bool pass_end = (cK + 1 == nk); \
        if (++cK == nk) { \
            if constexpr (TILE_EPI) { if (active) epi(cP, wr * 64 + fr, wc * 64 + fq * 4, cm, acc); } else \
            if (active) { \
                _Pragma("unroll") for (int mi = 0; mi < 4; ++mi) { const int r = wr * 64 + mi * 16 + fr; \
                    if (r < cm) { \
                        if constexpr (PAIR) { _Pragma("unroll") for (int ni = 0; ni < 2; ++ni) { epi(cP, r, wc * 64 + ni * 16 + fq * 4, acc[mi][ni], acc[mi][ni + 2]); } } \
                        else { _Pragma("unroll") for (int ni = 0; ni < 4; ++ni) { epi(cP, r, wc * 64 + ni * 16 + fq * 4, acc[mi][ni]); } } } } } \
            _Pragma("unroll") for (int i = 0; i < 4; ++i) _Pragma("unroll") for (int j = 0; j < 4; ++j) acc[i][j] = (f32x4){0.f, 0.f, 0.f, 0.f}; \
            cK = 0; ++cP; if (cP < npass) { cm = mrowsf(cP); active = (wr * 64) < cm; } \
        } \
        asm volatile("s_waitcnt lgkmcnt(0)" ::: "memory"); \
        if (DEPTH >= 2 && (s + DEPTH < S) && !pass_end) asm volatile("s_waitcnt vmcnt(4)" ::: "memory"); else asm volatile("s_waitcnt vmcnt(0)" ::: "memory"); \
        asm volatile("" ::: "memory"); __builtin_amdgcn_s_barrier(); asm volatile("" ::: "memory"); ++s; } while (0)
    int cP = 0, cK = 0, cm = mrowsf(0);
    bool active = (wr * 64) < cm;
    GS_SETA(); bp = bcol(0, n4);
    GS_ISSUE_A(0); GS_LOAD_B(bregX);
    GS_WRITE_B(bregX, 0);
    if constexpr (DEPTH >= 2) { if (1 < S) GS_LOAD_B(bregY); }
    static_assert(DEPTH == 1 || DEPTH == 2, "B prefetch depth");
    asm volatile("s_waitcnt lgkmcnt(0)" ::: "memory");
    asm volatile("s_waitcnt vmcnt(%0)" :: "n"((DEPTH - 1) * 4) : "memory");
    __syncthreads();
    int s = 0;
    if constexpr (DEPTH == 1) {
        while (s < S) { GS_STEP(0, 1, bregX, bregX); if (s >= S) break; GS_STEP(1, 0, bregX, bregX); }
    } else if constexpr (DEPTH == 2) {
        while (s < S) { GS_STEP(0, 1, bregX, bregY); if (s >= S) break; GS_STEP(1, 0, bregY, bregX); }
    }
#undef GS_SETA
#undef GS_BOFF
#undef GS_ISSUE_A
#undef GS_LOAD_B
#undef GS_WRITE_B
#undef GS_COMPUTE
#undef GS_STEP
}


template <class ARow, class BCol, class MRows, class Epi>
__device__ __forceinline__ void gemm_stream_rs(LAS unsigned char* lds, const unsigned char* Abase, int npass, int nk, int ldb, ARow arow, BCol bcol, MRows mrowsf, Epi epi) {
    int tid_ = threadIdx.x; asm volatile("" : "+v"(tid_));
    const int tid = tid_, wid = __builtin_amdgcn_readfirstlane(tid >> 6), lane = tid & 63;
    const int wr = wid >> 1, wc = wid & 1, fr = lane & 15, fq = lane >> 4;
    if (npass <= 0) return;
    const int S = npass * nk;
    const int Ccol = ((wid & 1) * 32 + 8 * ((lane & 3) ^ ((lane >> 5) << 1))) * 2;
    const int Rbase = 16 * (wid >> 1) + (lane >> 2);
    unsigned asrc[4];
    const int n4 = tid & 31, kb = tid >> 5;
    const float* bp;
    const int fB = ((kb & 3) << 2) | ((kb >> 2) & 3);
    const int bwoff = 256 * kb + 16 * ((n4 >> 1) ^ fB) + 8 * (n4 & 1);
    const int awoff = wid * 1024 + lane * 16;
    const int aoff = wr * 8192 + ((fr * 64 + fq * 16) ^ ((fr >> 3) << 5));
    const int q = (lane >> 2) & 3, pp = lane & 3;
    const int b0 = (wc * 8 + (pp >> 1)) ^ ((q << 2) | (2 * (fq & 1)));
    const int browoff = 256 * (fq * 8 + q) + 8 * (pp & 1);
#define RS_BOFF(v) (browoff + 16 * (b0 ^ (v)))
    f32x4 acc[4][4];
#pragma unroll
    for (int i = 0; i < 4; ++i)
#pragma unroll
        for (int j = 0; j < 4; ++j) acc[i][j] = (f32x4){0.f, 0.f, 0.f, 0.f};
    f32x4 bX[4], bY[4]; u32x4 aX[4], aY[4];
    int aP = 0, aK = 0, bP = 0, bK = 0;
#define RS_SETA() do { _Pragma("unroll") for (int _i = 0; _i < 4; ++_i) asrc[_i] = (unsigned)(arow(aP, Rbase + 64 * _i) + Ccol); } while (0)
#define RS_LOAD(AR, BR) do { \
        _Pragma("unroll") for (int _i = 0; _i < 4; ++_i) AR[_i] = *(const u32x4*)(Abase + (size_t)asrc[_i] + (size_t)aK * 128); \
        _Pragma("unroll") for (int _i = 0; _i < 4; ++_i) BR[_i] = *(const f32x4*)(bp + (size_t)(bK * 64 + kb + 16 * _i) * ldb); \
        if (++aK == nk) { aK = 0; if (aP + 1 < npass) { ++aP; RS_SETA(); } } \
        if (++bK == nk) { bK = 0; if (bP + 1 < npass) { ++bP; bp = bcol(bP, n4); } } } while (0)
#define RS_WRITE(AR, BR, buf) do { \
        _Pragma("unroll") for (int _i = 0; _i < 4; ++_i) *(LAS u32x4*)(lds + GEMM_LDS_A + (buf) * 32768 + _i * 8192 + awoff) = AR[_i]; \
        _Pragma("unroll") for (int _i = 0; _i < 4; ++_i) { u32x2 _w; _w.x = pk_bf16(BR[_i][0], BR[_i][1]); _w.y = pk_bf16(BR[_i][2], BR[_i][3]); \
            *(LAS u32x2*)(lds + GEMM_LDS_B + (buf) * 16384 + bwoff + 4096 * _i) = _w; } } while (0)
#define RS_COMPUTE(buf) do { _Pragma("unroll") for (int ks = 0; ks < 2; ++ks) { \
            bf16x8 af[4]; s16x4 tl0, tl1, tl2, tl3, th0, th1, th2, th3; \
            LAS unsigned char* bb_ = lds + GEMM_LDS_B + (buf) * 16384 + ks * 8192; \
            tl0 = tr_read(bb_ + RS_BOFF(0)); th0 = tr_read(bb_ + 1024 + RS_BOFF(1)); tl1 = tr_read(bb_ + RS_BOFF(2)); th1 = tr_read(bb_ + 1024 + RS_BOFF(3)); \
            tl2 = tr_read(bb_ + RS_BOFF(4)); th2 = tr_read(bb_ + 1024 + RS_BOFF(5)); tl3 = tr_read(bb_ + RS_BOFF(6)); th3 = tr_read(bb_ + 1024 + RS_BOFF(7)); \
            _Pragma("unroll") for (int mi = 0; mi < 4; ++mi) af[mi] = *(const LAS bf16x8*)(lds + GEMM_LDS_A + (buf) * 32768 + aoff + mi * 2048 + ks * 1024); \
            TR_WAIT8(tl0, th0, tl1, th1, tl2, th2, tl3, th3); \
            bf16x8 bfr[4]; \
            bfr[0] = (bf16x8){tl0[0], tl0[1], tl0[2], tl0[3], th0[0], th0[1], th0[2], th0[3]}; bfr[1] = (bf16x8){tl1[0], tl1[1], tl1[2], tl1[3], th1[0], th1[1], th1[2], th1[3]}; \
            bfr[2] = (bf16x8){tl2[0], tl2[1], tl2[2], tl2[3], th2[0], th2[1], th2[2], th2[3]}; bfr[3] = (bf16x8){tl3[0], tl3[1], tl3[2], tl3[3], th3[0], th3[1], th3[2], th3[3]}; \
            _Pragma("unroll") for (int mi = 0; mi < 4; ++mi) _Pragma("unroll") for (int ni = 0; ni < 4; ++ni) \
                acc[mi][ni] = __builtin_amdgcn_mfma_f32_16x16x32_bf16(bfr[ni], af[mi], acc[mi][ni], 0, 0, 0); } } while (0)
#define RS_STEP(CUR, NXT, A_LD, B_LD, A_WR, B_WR) do { \
        RS_LOAD(A_LD, B_LD); \
        __builtin_amdgcn_sched_barrier(0); \
        if (active) RS_COMPUTE(CUR); \
        __builtin_amdgcn_sched_barrier(0); \
        RS_WRITE(A_WR, B_WR, NXT); \
        if (++cK == nk) { \
            if (active) epi(cP, wr * 64 + fr, wc * 64 + fq * 4, cm, acc); \
            _Pragma("unroll") for (int i = 0; i < 4; ++i) _Pragma("unroll") for (int j = 0; j < 4; ++j) acc[i][j] = (f32x4){0.f, 0.f, 0.f, 0.f}; \
            cK = 0; ++cP; if (cP < npass) { cm = mrowsf(cP); active = (wr * 64) < cm; } \
        } \
        asm volatile("s_waitcnt lgkmcnt(0)" ::: "memory"); \
        asm volatile("" ::: "memory"); __builtin_amdgcn_s_barrier(); asm volatile("" ::: "memory"); ++s; } while (0)
    int cP = 0, cK = 0, cm = mrowsf(0);
    bool active = (wr * 64) < cm;
    RS_SETA(); bp = bcol(0, n4);
    RS_LOAD(aX, bX); RS_WRITE(aX, bX, 0);
    RS_LOAD(aY, bY);
    asm volatile("s_waitcnt lgkmcnt(0)" ::: "memory");
    __syncthreads();
    int s = 0;
    while (s < S) { RS_STEP(0, 1, aX, bX, aY, bY); if (s >= S) break; RS_STEP(1, 0, aY, bY, aX, bX); }
#undef RS_BOFF
#undef RS_SETA
#undef RS_LOAD
#undef RS_WRITE
#undef RS_COMPUTE
#undef RS_STEP
}

namespace pg8 {
#define PG8_LAS __attribute__((address_space(3)))
typedef unsigned short bf16_t;
typedef short bf16x8 __attribute__((ext_vector_type(8)));
typedef float f32x4 __attribute__((ext_vector_type(4)));
typedef unsigned u32x4 __attribute__((ext_vector_type(4)));
constexpr int BM = 256, BK = 64, HALF = 128, HTB = HALF * BK * 2  , STAGE_BYTES = 8 * HTB, NXCD = 8, WGM = 8;

__host__ __device__ __forceinline__ int lds_byte(int r, int c) { const int st = (r >> 4) * 2 + (c >> 5), rr = r & 15, cc = c & 31, ob = rr * 64 + cc * 2; return st * 1024 + (ob ^ (((ob >> 9) & 1) << 5)); }
__host__ __device__ __forceinline__ void stage_rc(int b, int& R, int& C) { const int st = b / 1024, sb = b % 1024, swz = sb ^ (((sb >> 9) & 1) << 5); R = (st >> 1) * 16 + swz / 64; C = (st & 1) * 32 + (swz % 64) / 2; }
__host__ __device__ __forceinline__ int perm32(int rho) { const int n = rho >> 4, i = rho & 15; return 8 * (i >> 2) + 4 * n + (i & 3); }

struct Unit { int pm, pn; };
struct Gemm { const bf16_t* A; const bf16_t* Bt; int M, N, K; };

struct StaticOrder {
    int nM, nN, nwg, G, c;
    __host__ __device__ void init(int M, int N, int G_, int c_) { nM = M / BM; nN = N / BM; nwg = nM * nN; G = G_; c = c_; }
    __host__ __device__ bool next(int i, Unit& u) const {
        const long L = (long)i * G + c; if (L >= nwg) return false;
        int wgid = (int)L; { const int q = nwg / NXCD, r = nwg % NXCD, xcd = wgid % NXCD, off = wgid / NXCD; wgid = (xcd < r ? xcd * (q + 1) : r * (q + 1) + (xcd - r) * q) + off; }
        const int nig = WGM * nN, gid = wgid / nig, fm = gid * WGM, gsz = (nM - fm) < WGM ? (nM - fm) : WGM;
        u.pm = fm + ((wgid % nig) % gsz); u.pn = (wgid % nig) / gsz; return true;
    }
    __device__ __forceinline__ void a_ready(const Unit&) const {}
    __device__ __forceinline__ void done(const Unit&) const {}
};
template <class Epi, class Sched>
__device__ __forceinline__ void gemm_phase(PG8_LAS unsigned char* lds, const Gemm g, const Sched& S, const Epi& E) {
    int tid_l = threadIdx.x; asm volatile("" : "+v"(tid_l));
    const int tid = tid_l, wid = __builtin_amdgcn_readfirstlane(tid >> 6), lane = tid & 63, wr = wid >> 2, wc = wid & 3, fr = lane & 15, fq = lane >> 4;
    const int K = g.K, nt = K / BK;

    unsigned voffA[2], voffB[2];
#pragma unroll
    for (int i = 0; i < 2; ++i) { int R, C; stage_rc(tid * 16 + i * 8192, R, C); const int Rb = Epi::PERM ? ((R & ~31) + perm32(R & 31)) : R;
        voffA[i] = (unsigned)(R * K + C) * 2u; voffB[i] = (unsigned)(Rb * K + C) * 2u; }
    const size_t kstep = (size_t)(BK * 2);
    const size_t hstep = (size_t)HALF * K * 2;
    const size_t tstep = 2 * hstep;
    const unsigned ldsw = (unsigned)wid * 1024u;
    const int aoff = lds_byte(wr * 64 + fr, fq * 8), boff = lds_byte(wc * 32 + fr, fq * 8);
#define PG8_SA(b, h) (((b) * 2 + (h)) * HTB)
#define PG8_SB(b, h) ((4 + (b) * 2 + (h)) * HTB)
#define PG8_STAGE(bufoff, gbase, voff) do { _Pragma("unroll") for (int _i = 0; _i < 2; ++_i) \
        __builtin_amdgcn_global_load_lds((const unsigned*)((const char*)(gbase) + (voff)[_i]), (PG8_LAS unsigned*)(lds + (bufoff) + ldsw + _i * 8192), 16, 0, 0); } while (0)
#define PG8_LDA(dst, b, h) do { _Pragma("unroll") for (int m = 0; m < 4; ++m) _Pragma("unroll") for (int k = 0; k < 2; ++k) dst[m][k] = *(const PG8_LAS bf16x8*)(lds + PG8_SA(b, h) + aoff + m * 2048 + k * 1024); } while (0)
#define PG8_LDB(dst, b, h) do { _Pragma("unroll") for (int n = 0; n < 2; ++n) _Pragma("unroll") for (int k = 0; k < 2; ++k) dst[n][k] = *(const PG8_LAS bf16x8*)(lds + PG8_SB(b, h) + boff + n * 2048 + k * 1024); } while (0)
#define PG8_MMA(ai, bj, At, Bt) do { __builtin_amdgcn_s_setprio(1); _Pragma("unroll") for (int m = 0; m < 4; ++m) _Pragma("unroll") for (int n = 0; n < 2; ++n) _Pragma("unroll") for (int k = 0; k < 2; ++k) \
        acc[ai][bj][m][n] = __builtin_amdgcn_mfma_f32_16x16x32_bf16(Bt[n][k], At[m][k], acc[ai][bj][m][n], 0, 0, 0); __builtin_amdgcn_s_setprio(0); } while (0)
#define PG8_WAIT_V(n) asm volatile("s_waitcnt vmcnt(" #n ")" ::: "memory")
#define PG8_WAIT_L(n) asm volatile("s_waitcnt lgkmcnt(" #n ")" ::: "memory")
#define PG8_BAR __builtin_amdgcn_s_barrier()
#define PG8_SCHED __builtin_amdgcn_sched_barrier(0)
    Unit cur, nxt; int ui = 0;
    if (!S.next(0, cur)) return;
    f32x4 acc[2][2][4][2];
#pragma unroll
    for (int a = 0; a < 2; ++a)
#pragma unroll
        for (int b = 0; b < 2; ++b)
#pragma unroll
            for (int m = 0; m < 4; ++m)
#pragma unroll
                for (int n = 0; n < 2; ++n) acc[a][b][m][n] = (f32x4){0.f, 0.f, 0.f, 0.f};
    bf16x8 At[4][2], B0[2][2], B1[2][2];
    const char* cA = (const char*)g.A + (size_t)cur.pm * tstep; const char* cB = (const char*)g.Bt + (size_t)cur.pn * tstep;
    S.a_ready(cur);
    PG8_STAGE(PG8_SB(0, 0), cB, voffB); PG8_STAGE(PG8_SA(0, 0), cA, voffA); PG8_STAGE(PG8_SB(0, 1), cB + hstep, voffB); PG8_STAGE(PG8_SA(0, 1), cA + hstep, voffA);
    if (wr == 1) PG8_BAR;
    PG8_WAIT_V(4); PG8_BAR;
    PG8_STAGE(PG8_SB(1, 0), cB + kstep, voffB); PG8_STAGE(PG8_SA(1, 0), cA + kstep, voffA); PG8_STAGE(PG8_SB(1, 1), cB + hstep + kstep, voffB);
    PG8_WAIT_V(6); PG8_BAR;

    for (;;) {
        const bool has_next = S.next(ui + 1, nxt);
        const char* nA = has_next ? (const char*)g.A + (size_t)nxt.pm * tstep : cA; const char* nB = has_next ? (const char*)g.Bt + (size_t)nxt.pn * tstep : cB;
        for (int t = 0; t < nt; t += 2) {
            const bool last = (t == nt - 2);
            const char* a1 = cA + (size_t)(t + 1) * kstep;
            const char* a2 = last ? nA : cA + (size_t)(t + 2) * kstep; const char* b2 = last ? nB : cB + (size_t)(t + 2) * kstep;
            const char* a3 = a2 + kstep; const char* b3 = b2 + kstep;
            if (last && has_next) S.a_ready(nxt);
            PG8_LDB(B0, 0, 0); PG8_SCHED; PG8_LDA(At, 0, 0); PG8_STAGE(PG8_SA(1, 1), a1 + hstep, voffA);
            PG8_WAIT_L(8); PG8_BAR; PG8_WAIT_L(0); PG8_MMA(0, 0, At, B0); PG8_BAR; PG8_SCHED;
            PG8_LDB(B1, 0, 1); PG8_STAGE(PG8_SB(0, 0), b2, voffB);
            PG8_BAR; PG8_WAIT_L(0); PG8_MMA(0, 1, At, B1); PG8_BAR;
            PG8_LDA(At, 0, 1); PG8_STAGE(PG8_SA(0, 0), a2, voffA);
            PG8_BAR; PG8_WAIT_L(0); PG8_MMA(1, 0, At, B0); PG8_BAR; PG8_SCHED;
            PG8_STAGE(PG8_SB(0, 1), b2 + hstep, voffB);
            PG8_WAIT_V(6); PG8_BAR; PG8_MMA(1, 1, At, B1); PG8_BAR;
            PG8_LDB(B0, 1, 0); PG8_SCHED; PG8_LDA(At, 1, 0); PG8_STAGE(PG8_SA(0, 1), a2 + hstep, voffA);
            PG8_WAIT_L(8); PG8_BAR; PG8_WAIT_L(0); PG8_MMA(0, 0, At, B0); PG8_BAR; PG8_SCHED;
            PG8_LDB(B1, 1, 1); PG8_STAGE(PG8_SB(1, 0), b3, voffB);
            PG8_BAR; PG8_WAIT_L(0); PG8_MMA(0, 1, At, B1); PG8_BAR;
            PG8_LDA(At, 1, 1); PG8_STAGE(PG8_SA(1, 0), a3, voffA);
            PG8_BAR; PG8_WAIT_L(0); PG8_MMA(1, 0, At, B0); PG8_BAR; PG8_SCHED;
            PG8_STAGE(PG8_SB(1, 1), b3 + hstep, voffB);
            PG8_WAIT_V(6); PG8_BAR; PG8_MMA(1, 1, At, B1); PG8_BAR;
        }

        if constexpr (!Epi::AFTER_DRAIN) { E(acc, cur, wr, wc, fr, fq); S.done(cur); }

        if (!has_next) break;
#pragma unroll
        for (int a = 0; a < 2; ++a)
#pragma unroll
            for (int b = 0; b < 2; ++b)
#pragma unroll
                for (int m = 0; m < 4; ++m)
#pragma unroll
                    for (int n = 0; n < 2; ++n) acc[a][b][m][n] = (f32x4){0.f, 0.f, 0.f, 0.f};
        cur = nxt; cA = nA; cB = nB; ++ui;
    }
    PG8_WAIT_V(0);
    if (wr == 0) PG8_BAR;
    PG8_BAR;
    if constexpr (Epi::AFTER_DRAIN) { E.fused(acc, cur, wr, wc, fr, fq, lds, wid, lane); S.done(cur); }

#undef PG8_SA
#undef PG8_SB
#undef PG8_STAGE
#undef PG8_LDA
#undef PG8_LDB
#undef PG8_MMA
#undef PG8_WAIT_V
#undef PG8_WAIT_L
#undef PG8_BAR
#undef PG8_SCHED
}
}
template <class F> struct EpiWrap {
    static constexpr bool PERM = false, AFTER_DRAIN = false; F f;
    __device__ __forceinline__ void operator()(const f32x4 (&acc)[2][2][4][2], const pg8::Unit& u, int wr, int wc, int fr, int fq) const { f(acc, u, wr, wc, fr, fq); }
};
template <class F> __device__ __forceinline__ EpiWrap<F> make_epi(F f) { return EpiWrap<F>{f}; }

__device__ __forceinline__ void transpose_item(const float* W, int K, int N, int Npad, bf16_t* WT, LAS float* scr, int item, int lane) {
    const int nblk = Npad / 32, kb = item / nblk, nb_ = item % nblk, k0 = 64 * kb, n0 = 32 * nb_;
#pragma unroll 8
    for (int i = 0; i < 32; ++i) { const int kk = 2 * i + (lane >> 5), n = n0 + (lane & 31); scr[kk * 33 + (lane & 31)] = n < N ? W[(size_t)(k0 + kk) * N + n] : 0.f; }
    asm volatile("s_waitcnt lgkmcnt(0)" ::: "memory");
    const int c = lane & 7;
#pragma unroll
    for (int j = 0; j < 4; ++j) { const int n = (lane >> 3) + 8 * j; const LAS float* sp = scr + (8 * c) * 33 + n;
        u32x4 o; o[0] = pk_bf16(sp[0 * 33], sp[1 * 33]); o[1] = pk_bf16(sp[2 * 33], sp[3 * 33]); o[2] = pk_bf16(sp[4 * 33], sp[5 * 33]); o[3] = pk_bf16(sp[6 * 33], sp[7 * 33]);
        *(u32x4*)(WT + (size_t)(n0 + n) * K + k0 + 8 * c) = o; }
    asm volatile("s_waitcnt lgkmcnt(0)" ::: "memory");
}

template <class ARow, class BCol, class MRows, class Epi>
__device__ __forceinline__ void gemm_stream_ws(LAS unsigned char* lds, const unsigned char* Abase, int npass, int nk, int ldb, ARow arow, BCol bcol, MRows mrowsf, Epi epi) {
    int tid_ = threadIdx.x; asm volatile("" : "+v"(tid_));
    const int tid = tid_, wid = __builtin_amdgcn_readfirstlane(tid >> 6), lane = tid & 63;
    if (npass <= 0) return;
    const int S = npass * nk;
#define WS_BAR() do { asm volatile("s_waitcnt lgkmcnt(0)" ::: "memory"); __builtin_amdgcn_s_barrier(); asm volatile("" ::: "memory"); } while (0)
    if (wid < 4) {
        const int wr2 = wid >> 1, wc = wid & 1, fr = lane & 15, fq = lane >> 4;
        const int aoff = wr2 * 16384 + ((fr * 64 + fq * 16) ^ ((fr >> 3) << 5));
        const int q = (lane >> 2) & 3, pp = lane & 3;
        const int b0 = (wc * 8 + (pp >> 1)) ^ ((q << 2) | (2 * (fq & 1)));
        const int browoff = 256 * (fq * 8 + q) + 8 * (pp & 1);
#define WS_BOFF(v) (browoff + 16 * (b0 ^ (v)))
        f32x4 acc[8][4];
#pragma unroll
        for (int i = 0; i < 8; ++i)
#pragma unroll
            for (int j = 0; j < 4; ++j) acc[i][j] = (f32x4){0.f, 0.f, 0.f, 0.f};
        int cP = 0, cK = 0, cm = mrowsf(0);
        bool active = (wr2 * 128) < cm;
#define WS_COMPUTE(buf) do { _Pragma("unroll") for (int ks = 0; ks < 2; ++ks) { \
            bf16x8 af[8]; s16x4 tl0, tl1, tl2, tl3, th0, th1, th2, th3; \
            LAS unsigned char* bb_ = lds + GEMM_LDS_B + (buf) * 16384 + ks * 8192; \
            tl0 = tr_read(bb_ + WS_BOFF(0)); th0 = tr_read(bb_ + 1024 + WS_BOFF(1)); tl1 = tr_read(bb_ + WS_BOFF(2)); th1 = tr_read(bb_ + 1024 + WS_BOFF(3)); \
            tl2 = tr_read(bb_ + WS_BOFF(4)); th2 = tr_read(bb_ + 1024 + WS_BOFF(5)); tl3 = tr_read(bb_ + WS_BOFF(6)); th3 = tr_read(bb_ + 1024 + WS_BOFF(7)); \
            _Pragma("unroll") for (int mi = 0; mi < 8; ++mi) af[mi] = *(const LAS bf16x8*)(lds + GEMM_LDS_A + (buf) * 32768 + aoff + mi * 2048 + ks * 1024); \
            TR_WAIT8(tl0, th0, tl1, th1, tl2, th2, tl3, th3); \
            bf16x8 bfr[4]; \
            bfr[0] = (bf16x8){tl0[0], tl0[1], tl0[2], tl0[3], th0[0], th0[1], th0[2], th0[3]}; bfr[1] = (bf16x8){tl1[0], tl1[1], tl1[2], tl1[3], th1[0], th1[1], th1[2], th1[3]}; \
            bfr[2] = (bf16x8){tl2[0], tl2[1], tl2[2], tl2[3], th2[0], th2[1], th2[2], th2[3]}; bfr[3] = (bf16x8){tl3[0], tl3[1], tl3[2], tl3[3], th3[0], th3[1], th3[2], th3[3]}; \
            _Pragma("unroll") for (int mi = 0; mi < 8; ++mi) _Pragma("unroll") for (int ni = 0; ni < 4; ++ni) \
                acc[mi][ni] = __builtin_amdgcn_mfma_f32_16x16x32_bf16(bfr[ni], af[mi], acc[mi][ni], 0, 0, 0); } } while (0)
#define WS_CSTEP(CUR) do { \
            if (active) WS_COMPUTE(CUR); \
            if (++cK == nk) { \
                if (active) epi(cP, wr2 * 128 + fr, wc * 64 + fq * 4, cm, acc); \
                _Pragma("unroll") for (int i = 0; i < 8; ++i) _Pragma("unroll") for (int j = 0; j < 4; ++j) acc[i][j] = (f32x4){0.f, 0.f, 0.f, 0.f}; \
                cK = 0; ++cP; if (cP < npass) { cm = mrowsf(cP); active = (wr2 * 128) < cm; } \
            } \
            WS_BAR(); ++s; } while (0)
        WS_BAR();
        int s = 0;
        while (s < S) { WS_CSTEP(0); if (s >= S) break; WS_CSTEP(1); }
#undef WS_BOFF
#undef WS_COMPUTE
#undef WS_CSTEP
    } else {
        const int pt = tid - 256;
        const int Ccol = (((pt >> 6) & 1) * 32 + 8 * ((lane & 3) ^ ((lane >> 5) << 1))) * 2;
        const int Rbase = 16 * (pt >> 7) + (lane >> 2);
        unsigned asrc[8];
        const int n4 = pt & 31, kb8 = pt >> 5;
        const float* bp;
        int bwoff[2];
#pragma unroll
        for (int par = 0; par < 2; ++par) { const int row = kb8 + 8 * par; const int fB = ((row & 3) << 2) | ((row >> 2) & 3); bwoff[par] = 256 * row + 16 * ((n4 >> 1) ^ fB) + 8 * (n4 & 1); }
        const int awoff = pt * 16;
        f32x4 bX[8], bY[8]; u32x4 aX[8], aY[8];
        int aP = 0, aK = 0, bP = 0, bK = 0;
#define WS_SETA() do { _Pragma("unroll") for (int _i = 0; _i < 8; ++_i) asrc[_i] = (unsigned)(arow(aP, Rbase + 32 * _i) + Ccol); } while (0)
#define WS_LOAD(AR, BR) do { \
            _Pragma("unroll") for (int _i = 0; _i < 8; ++_i) AR[_i] = *(const u32x4*)(Abase + (size_t)asrc[_i] + (size_t)aK * 128); \
            _Pragma("unroll") for (int _i = 0; _i < 8; ++_i) BR[_i] = *(const f32x4*)(bp + (size_t)(bK * 64 + kb8 + 8 * _i) * ldb); \
            if (++aK == nk) { aK = 0; if (aP + 1 < npass) { ++aP; WS_SETA(); } } \
            if (++bK == nk) { bK = 0; if (bP + 1 < npass) { ++bP; bp = bcol(bP, n4); } } } while (0)
#define WS_WRITE(AR, BR, buf) do { \
            _Pragma("unroll") for (int _i = 0; _i < 8; ++_i) *(LAS u32x4*)(lds + GEMM_LDS_A + (buf) * 32768 + _i * 4096 + awoff) = AR[_i]; \
            _Pragma("unroll") for (int _i = 0; _i < 8; ++_i) { u32x2 _w; _w.x = pk_bf16(BR[_i][0], BR[_i][1]); _w.y = pk_bf16(BR[_i][2], BR[_i][3]); \
                *(LAS u32x2*)(lds + GEMM_LDS_B + (buf) * 16384 + bwoff[_i & 1] + 4096 * (_i >> 1)) = _w; } } while (0)
#define WS_PSTEP(NXT, A_LD, B_LD, A_WR, B_WR) do { WS_LOAD(A_LD, B_LD); WS_WRITE(A_WR, B_WR, NXT); WS_BAR(); ++s; } while (0)
        WS_SETA(); bp = bcol(0, n4);
        WS_LOAD(aX, bX); WS_WRITE(aX, bX, 0);
        WS_LOAD(aY, bY);
        WS_BAR();
        int s = 0;
        while (s < S) { WS_PSTEP(1, aX, bX, aY, bY); if (s >= S) break; WS_PSTEP(0, aY, bY, aX, bX); }
#undef WS_SETA
#undef WS_LOAD
#undef WS_WRITE
#undef WS_PSTEP
    }
#undef WS_BAR
}

struct XcdDeal { int lo, step, n; };
#define TOPO_OFF (LDS_MISC + 16)
__device__ __forceinline__ XcdDeal xcd_deal(int U, const LAS unsigned char* lds, int nb) {
    const LAS int* tp_ = (const LAS int*)(lds + TOPO_OFF);
    const int px = tp_[0], cx = tp_[1], rank = tp_[2];
    XcdDeal d;
    const int xlo = (int)((long)px * U / nb), xhi = (int)((long)(px + cx) * U / nb);
    d.lo = xlo + rank; d.step = cx; d.n = (xhi - xlo - rank + cx - 1) / cx; if (d.n < 0) d.n = 0;
    return d;
}

__device__ __forceinline__ void phase0(const Params& p, int bid, int nb, float* smem, LAS unsigned char* smem_las) {
    const float* c = p.in[1]; const float* w_ada = p.in[2]; const float* b_ada = p.in[3];
    float* mod = (float*)(p.ws + WS_MOD);
    const int tid = threadIdx.x;
    float* sc = smem;
    float* red = smem + 2048;
    for (int i = tid; i < 2048; i += NT) { const float cv = c[i]; sc[i] = cv / (1.f + expf(-cv)); }
    __syncthreads();
    const int jl = tid & 63, kg = tid >> 6;
    for (int u = bid; u < 96; u += nb) {
        const int j = u * 64 + jl;
        float a0 = 0.f, a1 = 0.f;
#pragma unroll 8
        for (int k = kg * 128; k < kg * 128 + 128; ++k) { const float w = w_ada[(size_t)k * 6144 + j]; a0 += sc[k] * w; a1 += sc[1024 + k] * w; }
        red[(kg * 2 + 0) * 64 + jl] = a0; red[(kg * 2 + 1) * 64 + jl] = a1;
        __syncthreads();
        if (tid < 128) {
            const int bb = tid >> 6; float sacc = 0.f;
#pragma unroll
            for (int g2 = 0; g2 < 8; ++g2) sacc += red[(g2 * 2 + bb) * 64 + jl];
            mod[bb * 6144 + j] = sacc + b_ada[j];
        }
        __syncthreads();
    }
    {
        const float* conv_w = p.in[12]; const float* conv_b = p.in[13]; const float* wa = p.in[14]; const float* ba = p.in[15]; const float* wx = p.in[16]; const float* bx = p.in[17];
        float* BG = (float*)(p.ws + WS_BG); float* GB = (float*)(p.ws + WS_GBIAS);
        for (int idx = bid * NT + tid; idx < 8 * 256 * 128; idx += nb * NT) {
            const int n = idx & 127, k = (idx >> 7) & 255, hb = idx >> 15;
            const int w = k >> 6, i = k & 63, j = (n >> 6) * 32 + ((n >> 4) & 1) * 16 + (n & 15);
            const float* W = ((n >> 5) & 1) ? wx : wa;
            BG[idx] = conv_w[w * 512 + hb * 64 + i] * W[(hb * 64 + i) * 64 + j];
        }
        for (int idx = bid * NT + tid; idx < 8 * 128; idx += nb * NT) {
            const int n = idx & 127, hb = idx >> 7, j = (n >> 6) * 32 + ((n >> 4) & 1) * 16 + (n & 15);
            const bool isx = (n >> 5) & 1; const float* W = isx ? wx : wa;
            float acc = isx ? bx[hb * 64 + j] : ba[hb * 64 + j];
            for (int i = 0; i < 64; ++i) acc += conv_b[hb * 64 + i] * W[(hb * 64 + i) * 64 + j];
            GB[idx] = acc;
        }
        float* CB = (float*)(p.ws + WS_CBIAS); const float* pos = p.in[6];
        for (int idx = bid * NW + (tid >> 6); idx < 128; idx += nb * NW) {
            const int kv = idx >> 6, j = idx & 63; const float* w1 = kv ? p.in[9] : p.in[7];
            float acc = 0.f;
#pragma unroll 8
            for (int k = (tid & 63); k < 2048; k += 64) acc += pos[k] * w1[(size_t)k * 64 + j];
            acc = wave_sum(acc);
            if ((tid & 63) == 0) CB[idx] = acc;
        }
        bf16_t* XRB = (bf16_t*)(p.ws + WS_XRB);
        for (int idx = bid * NT + tid; idx < 16 * 3 * 64; idx += nb * NT) { const int sq = idx / 192, rem = idx % 192; XRB[(size_t)sq * SEQP * 64 + rem] = 0; }
    }
    {
        const f32x4* sp = (const f32x4*)p.in[23]; u32x2* dp = (u32x2*)(p.ws + WS_WRB);
        for (int i = bid * NT + tid; i < 1024 * 256 / 4; i += nb * NT) { const f32x4 v = sp[i]; u32x2 w; w.x = pk_bf16(v[0], v[1]); w.y = pk_bf16(v[2], v[3]); dp[i] = w; }
    }
    {
        LAS float* scr = (LAS float*)((LAS unsigned char*)smem_las + 16384 + (tid >> 6) * 8704);
        const int gw = bid * NW + (tid >> 6), ngw = nb * NW, lane_ = tid & 63;
        const int I1 = 16 * 80, I2 = 16 * 32;
        for (int it = gw; it < I1 + I2; it += ngw) {
            if (it < I1) transpose_item(p.in[5], 1024, NCOLS, 2560, (bf16_t*)(p.ws + WS_WINT), scr, it, lane_);
            else transpose_item(p.in[21], 1024, 1024, 1024, (bf16_t*)(p.ws + WS_WOUTT), scr, it - I1, lane_);
        }
    }
    float* lut = (float*)(p.ws + WS_LUT); const float* rel = p.in[11];
    for (int idx = bid * NT + tid; idx < 8 * 1024; idx += nb * NT) {
        const int h = idx >> 10, d = idx & 1023;
        int bucket;
        if (d < 16) bucket = d;
        else { const int l = 16 + (int)(logf((float)d / 16.0f) / 4.1588830833596715f * 16.0f); bucket = l < 31 ? l : 31; }
        lut[idx] = rel[bucket * 8 + h];
    }
}

__device__ __forceinline__ void phase_modnorm(const Params& p, int bid, int nb, const float* src, const float* nw, int sh_off, int sc_off, float* dst, bf16_t* dstb) {
    const float* mod = (const float*)(p.ws + WS_MOD);
    const int wave = threadIdx.x >> 6, lane = threadIdx.x & 63;
    (void)dst;
    for (int row = bid * NW + wave; row < MTOK; row += nb * NW) {
        const int b = row >> 13;
        const float* xr = src + (size_t)row * 1024 + lane * 16;
        f32x4 v[4]; float ss = 0.f;
#pragma unroll
        for (int i = 0; i < 4; ++i) { v[i] = *(const f32x4*)(xr + 4 * i); ss += (v[i][0] * v[i][0] + v[i][1] * v[i][1]) + (v[i][2] * v[i][2] + v[i][3] * v[i][3]); }
        ss = wave_sum(ss);
        const float rstd = 1.0f / sqrtf(ss * (1.f / 1024.f) + 1e-6f);
        u32x4 o[2];
#pragma unroll
        for (int i = 0; i < 4; ++i) {
            const int ci = lane * 16 + 4 * i;
            const f32x4 sh = *(const f32x4*)(mod + b * 6144 + sh_off + ci), sc = *(const f32x4*)(mod + b * 6144 + sc_off + ci), w = *(const f32x4*)(nw + ci);
            f32x4 h;
#pragma unroll
            for (int j = 0; j < 4; ++j) h[j] = v[i][j] * rstd * w[j] * (1.f + sc[j]) + sh[j];
            o[i >> 1][(i & 1) * 2 + 0] = pk_bf16(h[0], h[1]); o[i >> 1][(i & 1) * 2 + 1] = pk_bf16(h[2], h[3]);
        }
        *(u32x4*)(dstb + (size_t)row * 1024 + lane * 16) = o[0];
        *(u32x4*)(dstb + (size_t)row * 1024 + lane * 16 + 8) = o[1];
    }
}

__device__ __forceinline__ void phase2_e(const Params& p, int bid, int nb, LAS unsigned char* lds) {
    bf16_t* QB = (bf16_t*)(p.ws + WS_QB); bf16_t* KV6 = (bf16_t*)(p.ws + WS_KV6); float* GATE = (float*)(p.ws + WS_GATE);
    bf16_t* XRB = (bf16_t*)(p.ws + WS_XRB); bf16_t* GRG = (bf16_t*)(p.ws + WS_GRG);
    pg8::Gemm g{(const pg8::bf16_t*)(p.ws + WS_H1B), (const pg8::bf16_t*)(p.ws + WS_WINT), MTOK, 2560, 1024};
    pg8::StaticOrder S; S.init(MTOK, 2560, nb, bid);
    auto E = make_epi([=](const f32x4 (&acc)[2][2][4][2], const pg8::Unit& u, int wr, int wc, int fr, int fq) {
#pragma unroll
        for (int ai = 0; ai < 2; ++ai)
#pragma unroll
            for (int mm = 0; mm < 4; ++mm) {
                const int m = u.pm * 256 + ai * 128 + wr * 64 + mm * 16 + fr;
#pragma unroll
                for (int bj = 0; bj < 2; ++bj)
#pragma unroll
                    for (int nn = 0; nn < 2; ++nn) {
                        const int col = u.pn * 256 + bj * 128 + wc * 32 + nn * 16 + fq * 4;
                        const f32x4 v = acc[ai][bj][mm][nn];
                        if (col >= NCOLS) continue;
                        if (col < 512) {
                            const float sc = 0.125f * LOG2E; u32x2 w; w.x = pk_bf16(v[0] * sc, v[1] * sc); w.y = pk_bf16(v[2] * sc, v[3] * sc);
                            *(u32x2*)(QB + (size_t)m * 512 + col) = w;
                        } else if (col >= 1280 && col < 1304) {
                            f32x4 gv; gv[0] = sigm(v[0]); gv[1] = sigm(v[1]); gv[2] = sigm(v[2]); gv[3] = sigm(v[3]);
                            *(f32x4*)(GATE + (size_t)m * 24 + (col - 1280)) = gv;
                        } else if (col < 1280) {
                            const int c2 = col - 512, j6 = c2 >> 7, gg = (c2 >> 6) & 1, d = c2 & 63, bb = m >> 13, t = m & 8191;
                            u32x2 w; w.x = pk_bf16(v[0], v[1]); w.y = pk_bf16(v[2], v[3]);
                            *(u32x2*)(KV6 + (size_t)j6 * 2097152 + ((size_t)((bb * 2 + gg) * SEQ + t)) * 64 + d) = w;
                        } else if (col < 1816) {
                            const int c = col - 1304, hb = c >> 6, bb = m >> 13, t = m & 8191;
                            u32x2 w; w.x = pk_bf16(v[0], v[1]); w.y = pk_bf16(v[2], v[3]);
                            *(u32x2*)(XRB + ((size_t)(bb * 8 + hb) * SEQP + 3 + t) * 64 + (c & 63)) = w;
                        } else {
                            u32x2 w; w.x = pk_bf16(gelu_t(v[0]), gelu_t(v[1])); w.y = pk_bf16(gelu_t(v[2]), gelu_t(v[3]));
                            *(u32x2*)(GRG + (size_t)m * 512 + (col - 1816)) = w;
                        }
                    }
            }
    });
    pg8::gemm_phase(lds, g, S, E);
}

__device__ __forceinline__ void phase5_e(const Params& p, int bid, int nb, LAS unsigned char* lds) {
    const float* x = p.in[0]; const float* mod = (const float*)(p.ws + WS_MOD); float* X1 = (float*)(p.ws + WS_X1);
    pg8::Gemm g{(const pg8::bf16_t*)(p.ws + WS_YB), (const pg8::bf16_t*)(p.ws + WS_WOUTT), MTOK, 1024, 1024};
    pg8::StaticOrder S; S.init(MTOK, 1024, nb, bid);
    auto E = make_epi([=](const f32x4 (&acc)[2][2][4][2], const pg8::Unit& u, int wr, int wc, int fr, int fq) {
        const int c0 = u.pn * 256 + wc * 32 + fq * 4;
        const int bb = (u.pm * 256) >> 13;
        f32x4 gv[2][2];
#pragma unroll
        for (int bj = 0; bj < 2; ++bj)
#pragma unroll
            for (int nn = 0; nn < 2; ++nn) gv[bj][nn] = *(const f32x4*)(mod + bb * 6144 + 2048 + c0 + bj * 128 + nn * 16);
#pragma unroll
        for (int ai = 0; ai < 2; ++ai)
#pragma unroll
            for (int mm = 0; mm < 4; ++mm) {
                const size_t o = (size_t)(u.pm * 256 + ai * 128 + wr * 64 + mm * 16 + fr) * 1024 + c0;
                f32x4 xv[2][2];
#pragma unroll
                for (int bj = 0; bj < 2; ++bj)
#pragma unroll
                    for (int nn = 0; nn < 2; ++nn) xv[bj][nn] = *(const f32x4*)(x + o + bj * 128 + nn * 16);
#pragma unroll
                for (int bj = 0; bj < 2; ++bj)
#pragma unroll
                    for (int nn = 0; nn < 2; ++nn) *(f32x4*)(X1 + o + bj * 128 + nn * 16) = xv[bj][nn] + gv[bj][nn] * acc[ai][bj][mm][nn];
            }
    });
    pg8::gemm_phase(lds, g, S, E);
}

#ifndef A4_PROBE_MASK
#define A4_PROBE_MASK 7
#endif
#define A4_KV 0
#define A4_SCORE 65536
#define A4_LUT 131200
#define LUTP 1156
#define A4_SELM 149760
__device__ __forceinline__ float ex2(float x) { return __builtin_amdgcn_exp2f(x); }

__device__ __forceinline__ float xmax_16_32(float v) {
    { auto r = __builtin_amdgcn_permlane16_swap(__float_as_uint(v), __float_as_uint(v), false, false); v = fmaxf(__uint_as_float(r[0]), __uint_as_float(r[1])); }
    { auto r = __builtin_amdgcn_permlane32_swap(__float_as_uint(v), __float_as_uint(v), false, false); v = fmaxf(__uint_as_float(r[0]), __uint_as_float(r[1])); }
    return v;
}
__device__ __forceinline__ float xsum_16_32(float v) {
    { auto r = __builtin_amdgcn_permlane16_swap(__float_as_uint(v), __float_as_uint(v), false, false); v = __uint_as_float(r[0]) + __uint_as_float(r[1]); }
    { auto r = __builtin_amdgcn_permlane32_swap(__float_as_uint(v), __float_as_uint(v), false, false); v = __uint_as_float(r[0]) + __uint_as_float(r[1]); }
    return v;
}


__device__ __forceinline__ void phase4_mfma(unsigned char* ws, int bid, int nb, LAS unsigned char* lds) {
    int tid_ = threadIdx.x; asm volatile("" : "+v"(tid_));
    const int tid = tid_, wid = __builtin_amdgcn_readfirstlane(tid >> 6), lane = tid & 63;
    const int col = lane & 15, tl = col >> 2, hd = col & 3, g4 = lane >> 4, fr = col;
    const bf16_t* QB = (const bf16_t*)(ws + WS_QB);
    const unsigned char* KV6 = ws + WS_KV6;
    const unsigned char* KCB = ws + WS_KCB; const unsigned char* VCB = ws + WS_VCB;
    const float* lutg = (const float*)(ws + WS_LUT);
    const float* GATE = (const float*)(ws + WS_GATE);
    float* OATT = (float*)(ws + WS_OATT);
    LAS float* lutl = (LAS float*)(lds + A4_LUT);
    LAS float* score = (LAS float*)(lds + A4_SCORE);
    LAS unsigned* selm = (LAS unsigned*)(lds + A4_SELM);
    const int koff0 = fr * 128 + 16 * ((g4) ^ (fr & 7)), koff1 = fr * 128 + 16 * ((4 + g4) ^ (fr & 7));
    const int q4 = (lane >> 2) & 3, pp = lane & 3, xk = (g4 & 1) * 4 + q4;
    int voff[4];
#pragma unroll
    for (int db = 0; db < 4; ++db) voff[db] = (g4 * 4 + q4) * 128 + 16 * ((db * 2 + (pp >> 1)) ^ xk) + 8 * (pp & 1);
    const int dr = tid >> 3, dsrc = dr * 128 + (((tid & 7) ^ (dr & 7)) * 16);

#define A4_ISSUE(kbase, vbase, stage) do { \
        __builtin_amdgcn_global_load_lds((const unsigned*)((kbase) + dsrc), (LAS unsigned*)(lds + A4_KV + (stage) * 16384 + wid * 1024), 16, 0, 0); \
        if (vbase) __builtin_amdgcn_global_load_lds((const unsigned*)((vbase) + dsrc), (LAS unsigned*)(lds + A4_KV + (stage) * 16384 + 8192 + wid * 1024), 16, 0, 0); } while (0)
#define A4_SYNC() do { asm volatile("s_waitcnt vmcnt(0)" ::: "memory"); __syncthreads(); } while (0)
#define A4_SYNC_RING(issued) do { asm volatile("s_waitcnt lgkmcnt(0)" ::: "memory"); if (issued) asm volatile("s_waitcnt vmcnt(2)" ::: "memory"); else asm volatile("s_waitcnt vmcnt(0)" ::: "memory"); \
        asm volatile("" ::: "memory"); __builtin_amdgcn_s_barrier(); asm volatile("" ::: "memory"); } while (0)

    for (int u2 = bid; u2 < 256; u2 += nb)
    for (int hf = 0; hf < 2; ++hf)
    for (int rep4 = 0; rep4 < ((REP & 64) ? 2 : 1); ++rep4) {
        const bool probe = rep4 > 0; const int amask = probe ? A4_PROBE_MASK : 7;
        const int bg = u2 >> 6, b = bg >> 1, g = bg & 1;
        const int T = hf ? 127 - (u2 & 63) : (u2 & 63);
        const int t0 = T * 64;
        const size_t seqbase = (size_t)(b * 2 + g) * SEQ;
        __syncthreads();
        for (int i = tid; i < 4 * 1152; i += NT) { const int hh = i / 1152, dd = i - hh * 1152; lutl[hh * LUTP + dd] = lutg[(g * 4 + hh) * 1024 + (dd < 1023 ? dd : 1023)] * LOG2E; }
        if (!probe) for (int i = tid; i < 8192; i += NT) score[i] = 0.f;
        int tq[2]; tq[0] = t0 + 8 * wid + tl; tq[1] = tq[0] + 4;
        bf16x8 qf[2][2];
#pragma unroll
        for (int ct = 0; ct < 2; ++ct) {
            const size_t m = (size_t)b * SEQ + tq[ct];
#pragma unroll
            for (int h2 = 0; h2 < 2; ++h2) qf[ct][h2] = *(const bf16x8*)(QB + m * 512 + (g * 4 + hd) * 64 + h2 * 32 + g4 * 8);
        }
#define A4_GATEV(ct, br) (GATE[((size_t)b * SEQ + tq[ct]) * 24 + (g * 4 + hd) * 3 + (br)])
        __syncthreads();

        float mrun[2], lrun[2];
        f32x4 O[2][4];
        bf16x8 kf[4][2];
        f32x4 sv[4];
#define A4_LOADK(stage) do { _Pragma("unroll") for (int kt = 0; kt < 4; ++kt) { \
            kf[kt][0] = *(const LAS bf16x8*)(lds + A4_KV + (stage) * 16384 + kt * 2048 + koff0); \
            kf[kt][1] = *(const LAS bf16x8*)(lds + A4_KV + (stage) * 16384 + kt * 2048 + koff1); } } while (0)
#define A4_SCORES(ct) do { _Pragma("unroll") for (int kt = 0; kt < 4; ++kt) { \
            sv[kt] = __builtin_amdgcn_mfma_f32_16x16x32_bf16(kf[kt][0], qf[ct][0], (f32x4){0.f, 0.f, 0.f, 0.f}, 0, 0, 0); \
            sv[kt] = __builtin_amdgcn_mfma_f32_16x16x32_bf16(kf[kt][1], qf[ct][1], sv[kt], 0, 0, 0); } } while (0)
#define A4_VREADS(stage, a, l0, h0, l1, h1, l2, h2, l3, h3) do { \
            LAS unsigned char* vb_ = lds + A4_KV + (stage) * 16384 + 8192 + (a) * 4096; \
            l0 = tr_read(vb_ + voff[0]); h0 = tr_read(vb_ + 2048 + voff[0]); l1 = tr_read(vb_ + voff[1]); h1 = tr_read(vb_ + 2048 + voff[1]); \
            l2 = tr_read(vb_ + voff[2]); h2 = tr_read(vb_ + 2048 + voff[2]); l3 = tr_read(vb_ + voff[3]); h3 = tr_read(vb_ + 2048 + voff[3]); } while (0)
#define A4_PVMMA(ct, a, l0, h0, l1, h1, l2, h2, l3, h3) do { \
            u32x4 pw; pw[0] = pk_bf16(sv[2 * (a)][0], sv[2 * (a)][1]); pw[1] = pk_bf16(sv[2 * (a)][2], sv[2 * (a)][3]); \
            pw[2] = pk_bf16(sv[2 * (a) + 1][0], sv[2 * (a) + 1][1]); pw[3] = pk_bf16(sv[2 * (a) + 1][2], sv[2 * (a) + 1][3]); \
            const bf16x8 pf = __builtin_bit_cast(bf16x8, pw); \
            O[ct][0] = __builtin_amdgcn_mfma_f32_16x16x32_bf16((bf16x8){l0[0], l0[1], l0[2], l0[3], h0[0], h0[1], h0[2], h0[3]}, pf, O[ct][0], 0, 0, 0); \
            O[ct][1] = __builtin_amdgcn_mfma_f32_16x16x32_bf16((bf16x8){l1[0], l1[1], l1[2], l1[3], h1[0], h1[1], h1[2], h1[3]}, pf, O[ct][1], 0, 0, 0); \
            O[ct][2] = __builtin_amdgcn_mfma_f32_16x16x32_bf16((bf16x8){l2[0], l2[1], l2[2], l2[3], h2[0], h2[1], h2[2], h2[3]}, pf, O[ct][2], 0, 0, 0); \
            O[ct][3] = __builtin_amdgcn_mfma_f32_16x16x32_bf16((bf16x8){l3[0], l3[1], l3[2], l3[3], h3[0], h3[1], h3[2], h3[3]}, pf, O[ct][3], 0, 0, 0); } while (0)
#define A4_ONLINE_PV(ct, stage) do { \
            s16x4 va0, va1, va2, va3, va4, va5, va6, va7; \
            A4_VREADS(stage, 0, va0, va1, va2, va3, va4, va5, va6, va7); \
            float mx = fmaxf(fmaxf(sv[0][0], sv[0][1]), fmaxf(sv[0][2], sv[0][3])); \
            _Pragma("unroll") for (int kt = 1; kt < 4; ++kt) _Pragma("unroll") for (int j = 0; j < 4; ++j) mx = fmaxf(mx, sv[kt][j]); \
            mx = xmax_16_32(mx); \
            const float mnew = fmaxf(mrun[ct], mx); const float muse = (mnew == -INF) ? 0.f : mnew; \
            const float scl = ex2(mrun[ct] - muse); mrun[ct] = mnew; \
            const float nmu = -muse; \
            _Pragma("unroll") for (int kt = 0; kt < 4; ++kt) { sv[kt] += nmu; _Pragma("unroll") for (int j = 0; j < 4; ++j) sv[kt][j] = ex2(sv[kt][j]); } \
            const f32x4 ls4 = (sv[0] + sv[1]) + (sv[2] + sv[3]); const float ls = (ls4[0] + ls4[1]) + (ls4[2] + ls4[3]); \
            lrun[ct] = lrun[ct] * scl + ls; \
            if (__builtin_amdgcn_ballot_w64(scl != 1.f) != 0ull) { _Pragma("unroll") for (int db = 0; db < 4; ++db) O[ct][db] *= scl; } \
            TR_WAIT8(va0, va1, va2, va3, va4, va5, va6, va7); \
            s16x4 vb0, vb1, vb2, vb3, vb4, vb5, vb6, vb7; \
            A4_VREADS(stage, 1, vb0, vb1, vb2, vb3, vb4, vb5, vb6, vb7); \
            A4_PVMMA(ct, 0, va0, va1, va2, va3, va4, va5, va6, va7); \
            TR_WAIT8(vb0, vb1, vb2, vb3, vb4, vb5, vb6, vb7); \
            A4_PVMMA(ct, 1, vb0, vb1, vb2, vb3, vb4, vb5, vb6, vb7); } while (0)
#define A4_PV(ct, stage) do { \
            s16x4 va0, va1, va2, va3, va4, va5, va6, va7; \
            A4_VREADS(stage, 0, va0, va1, va2, va3, va4, va5, va6, va7); \
            TR_WAIT8(va0, va1, va2, va3, va4, va5, va6, va7); \
            A4_PVMMA(ct, 0, va0, va1, va2, va3, va4, va5, va6, va7); \
            A4_VREADS(stage, 1, va0, va1, va2, va3, va4, va5, va6, va7); \
            TR_WAIT8(va0, va1, va2, va3, va4, va5, va6, va7); \
            A4_PVMMA(ct, 1, va0, va1, va2, va3, va4, va5, va6, va7); } while (0)
#define A4_RESET() do { _Pragma("unroll") for (int ct = 0; ct < 2; ++ct) { mrun[ct] = -INF; lrun[ct] = 0.f; \
            _Pragma("unroll") for (int db = 0; db < 4; ++db) O[ct][db] = (f32x4){0.f, 0.f, 0.f, 0.f}; } } while (0)
#define A4_FINISH(br, first) do { _Pragma("unroll") for (int ct = 0; ct < 2; ++ct) { \
            float lt = lrun[ct]; lt = xsum_16_32(lt); \
            const float wv = A4_GATEV(ct, br) / fmaxf(lt, 1e-30f); \
            float* op = OATT + ((size_t)b * SEQ + tq[ct]) * 512 + (g * 4 + hd) * 64 + g4 * 4; \
            _Pragma("unroll") for (int db = 0; db < 4; ++db) { f32x4 r = O[ct][db] * wv; if (!(first)) r += *(const f32x4*)(op + db * 16); *(f32x4*)(op + db * 16) = r; } } } while (0)

        if (amask & 1) {
            const unsigned char* KW = KV6 + (size_t)4 * 4194304 + seqbase * 128; const unsigned char* VW = KV6 + (size_t)5 * 4194304 + seqbase * 128;
            A4_RESET();
            const int s0 = T >= 8 ? 0 : 8 - T;
            { const int jb = T - 8 + s0; A4_ISSUE(KW + (size_t)jb * 8192, VW + (size_t)jb * 8192, 0);
              if (s0 < 8) { A4_ISSUE(KW + (size_t)(jb + 1) * 8192, VW + (size_t)(jb + 1) * 8192, 1); asm volatile("s_waitcnt vmcnt(2)" ::: "memory"); } else asm volatile("s_waitcnt vmcnt(0)" ::: "memory");
              __syncthreads(); }
            int stage = 0;
            for (int s = s0; s <= 8; ++s) {
                const int jb = T - 8 + s;
                const bool iss = (s + 2 <= 8);
                if (iss) { const int st2 = stage >= 1 ? stage - 1 : 2; const unsigned char* kn = KW + (size_t)(jb + 2) * 8192; const unsigned char* vn = VW + (size_t)(jb + 2) * 8192; A4_ISSUE(kn, vn, st2); }
#pragma unroll
                for (int ct = 0; ct < 2; ++ct) {
                    A4_LOADK(stage);
                    A4_SCORES(ct);
                    __builtin_amdgcn_sched_barrier(0);
                    const int t = tq[ct];
                    {
                        const int base = t - jb * 64 - g4 * 4;
                        const LAS float* lp = lutl + hd * LUTP + base - 51;
                        const bool edge = (s == 0) || (s == 8);
#pragma unroll
                        for (int kt = 0; kt < 4; ++kt) {
                            f32x4 bs;
#pragma unroll
                            for (int j = 0; j < 4; ++j) bs[j] = lp[51 - kt * 16 - j];
                            asm volatile("" : "+v"(bs));
                            sv[kt] += bs;
                        }
                        if (edge) {
#pragma unroll
                            for (int kt = 0; kt < 4; ++kt)
#pragma unroll
                                for (int j = 0; j < 4; ++j) { const int dist = base - kt * 16 - j; sv[kt][j] = ((dist >= 0) && (dist < 512)) ? sv[kt][j] : -INF; }
                        }
                    }
                    A4_ONLINE_PV(ct, stage);
                    __builtin_amdgcn_sched_barrier(0);
                }
                A4_SYNC_RING(iss);
                stage = stage == 2 ? 0 : stage + 1;
            }
            if (!probe) A4_FINISH(2, true);
        }
        if (amask & 2) {
            const unsigned char* KC = KCB + (size_t)(b * 2 + g) * 512 * 128; const unsigned char* VC = VCB + (size_t)(b * 2 + g) * 512 * 128;
            int ncmp = 4 * T + 3; if (ncmp > NCMP) ncmp = NCMP;
            const int nblk = (ncmp + 63) >> 6;
            A4_RESET();
            A4_ISSUE(KC, (const unsigned char*)nullptr, 0);
            A4_SYNC();
            for (int s = 0; s < nblk; ++s) {
                const int stage = s & 1;
                if (s + 1 < nblk) A4_ISSUE(KC + (size_t)(s + 1) * 8192, (const unsigned char*)nullptr, stage ^ 1);
#pragma unroll
                for (int ct = 0; ct < 2; ++ct) {
                    A4_LOADK(stage);
                    A4_SCORES(ct);
                    __builtin_amdgcn_sched_barrier(0);
                    const int t = tq[ct];
                    float mx = -INF;
#pragma unroll
                    for (int kt = 0; kt < 4; ++kt) {
                        f32x4 bs;
#pragma unroll
                        for (int j = 0; j < 4; ++j) { int dist = t - (16 * (s * 64 + kt * 16 + g4 * 4 + j) + 31); dist = dist < 1023 ? dist : 1023; bs[j] = lutl[hd * LUTP + (dist & 1023)]; }
                        asm volatile("" : "+v"(bs));
#pragma unroll
                        for (int j = 0; j < 4; ++j) {
                            const int n = s * 64 + kt * 16 + g4 * 4 + j; const int dist = t - (16 * n + 31);
                            const bool ok = (dist >= 0) && (n < NCMP);
                            sv[kt][j] = ok ? sv[kt][j] + bs[j] : -INF; mx = fmaxf(mx, sv[kt][j]);
                        }
                    }
                    mx = xmax_16_32(mx);
                    const float mnew = fmaxf(mrun[ct], mx); const float muse = (mnew == -INF) ? 0.f : mnew;
                    const float scl = ex2(mrun[ct] - muse); mrun[ct] = mnew;
                    float ls = 0.f;
#pragma unroll
                    for (int kt = 0; kt < 4; ++kt)
#pragma unroll
                        for (int j = 0; j < 4; ++j) ls += ex2(sv[kt][j] - muse);
                    lrun[ct] = lrun[ct] * scl + ls;
                    __builtin_amdgcn_sched_barrier(0);
                }
                A4_SYNC();
            }
            float mfin[2], linv[2];
#pragma unroll
            for (int ct = 0; ct < 2; ++ct) {
                float lt = lrun[ct]; lt = xsum_16_32(lt);
                linv[ct] = 1.f / fmaxf(lt, 1e-30f); mfin[ct] = (mrun[ct] == -INF) ? 0.f : mrun[ct];
            }
            A4_ISSUE(KC, VC, 0);
            A4_SYNC();
            for (int s = 0; s < nblk; ++s) {
                const int stage = s & 1;
                if (s + 1 < nblk) { const unsigned char* kn = KC + (size_t)(s + 1) * 8192; const unsigned char* vn = VC + (size_t)(s + 1) * 8192; A4_ISSUE(kn, vn, stage ^ 1); }
#pragma unroll
                for (int ct = 0; ct < 2; ++ct) {
                    A4_LOADK(stage);
                    A4_SCORES(ct);
                    __builtin_amdgcn_sched_barrier(0);
                    const int t = tq[ct];
#pragma unroll
                    for (int kt = 0; kt < 4; ++kt) {
                        f32x4 bs;
#pragma unroll
                        for (int j = 0; j < 4; ++j) { int dist = t - (16 * (s * 64 + kt * 16 + g4 * 4 + j) + 31); dist = dist < 1023 ? dist : 1023; bs[j] = lutl[hd * LUTP + (dist & 1023)]; }
                        asm volatile("" : "+v"(bs));
#pragma unroll
                        for (int j = 0; j < 4; ++j) {
                            const int n = s * 64 + kt * 16 + g4 * 4 + j; const int dist = t - (16 * n + 31);
                            const bool ok = (dist >= 0) && (n < NCMP);
                            sv[kt][j] = ok ? ex2(sv[kt][j] + bs[j] - mfin[ct]) * linv[ct] : 0.f;
                        }
                        float s4 = (sv[kt][0] + sv[kt][1]) + (sv[kt][2] + sv[kt][3]); float s3 = sv[kt][3];
                        s4 += __shfl_xor(s4, 1); s4 += __shfl_xor(s4, 2); s3 += __shfl_xor(s3, 1); s3 += __shfl_xor(s3, 2);
                        const int a = s * 16 + kt * 4 + g4;
                        if (hd == 0 && !probe) {
                            LAS float* sp = score + (8 * wid + 4 * ct + tl) * 128 + a;
                            atomicAdd((float*)sp, s4);
                            if (a + 1 < 128) atomicAdd((float*)(sp + 1), s3);
                        }
                    }
                    A4_PV(ct, stage);
                    __builtin_amdgcn_sched_barrier(0);
                }
                A4_SYNC();
            }
            if (!probe)
#pragma unroll
            for (int ct = 0; ct < 2; ++ct) {
                float* op = OATT + ((size_t)b * SEQ + tq[ct]) * 512 + (g * 4 + hd) * 64 + g4 * 4;
#pragma unroll
                for (int db = 0; db < 4; ++db) { const float gcv = A4_GATEV(ct, 0); f32x4 r = O[ct][db] * gcv; r += *(const f32x4*)(op + db * 16); *(f32x4*)(op + db * 16) = r; }
            }
        }
        __syncthreads();
        if (!probe)
        for (int tt = 0; tt < 8; ++tt) {
            const int ti = 8 * wid + tt;
            const int j0 = lane, j1 = lane + 64;
            bool sel0, sel1;
            if (T <= 15) { sel0 = j0 <= T; sel1 = false; }
            else {
                const bool c0 = (j0 >= 1) && (j0 <= T - 2), c1 = (j1 <= T - 2);
                const float s0 = c0 ? score[ti * 128 + j0] : -INF, s1 = c1 ? score[ti * 128 + j1] : -INF;
                int r0 = 0, r1 = 0;
                for (int j2 = 1; j2 <= T - 2; ++j2) { const float v = score[ti * 128 + j2]; r0 += (v > s0) || (v == s0 && j2 < j0); r1 += (v > s1) || (v == s1 && j2 < j1); }
                sel0 = (c0 && r0 < 13) || (j0 == 0) || (j0 == T) || (j0 == T - 1);
                sel1 = (c1 && r1 < 13) || (j1 == T) || (j1 == T - 1);
            }
            const unsigned long long b0 = __ballot(sel0), b1 = __ballot(sel1);
            if (lane == 0) { selm[ti * 4 + 0] = (unsigned)b0; selm[ti * 4 + 1] = (unsigned)(b0 >> 32); selm[ti * 4 + 2] = (unsigned)b1; selm[ti * 4 + 3] = (unsigned)(b1 >> 32); }
        }
        __builtin_amdgcn_wave_barrier();
        asm volatile("s_waitcnt lgkmcnt(0)" ::: "memory");
        if (amask & 4) {
            const unsigned char* KS = KV6 + (size_t)2 * 4194304 + seqbase * 128; const unsigned char* VS = KV6 + (size_t)3 * 4194304 + seqbase * 128;
            unsigned un[2][4];
#pragma unroll
            for (int ct = 0; ct < 2; ++ct)
#pragma unroll
                for (int w = 0; w < 4; ++w) {
                    unsigned uu = selm[(8 * wid + 4 * ct + 0) * 4 + w] | selm[(8 * wid + 4 * ct + 1) * 4 + w] | selm[(8 * wid + 4 * ct + 2) * 4 + w] | selm[(8 * wid + 4 * ct + 3) * 4 + w];
                    un[ct][w] = __builtin_amdgcn_readfirstlane(uu);
                }
            A4_RESET();
            const float cbfar = lutl[hd * LUTP + 1023];
            __syncthreads();
#pragma unroll
            for (int bq = 0; bq < 4; ++bq) if (bq <= T) { const unsigned char* kn = KS + (size_t)bq * 8192; const unsigned char* vn = VS + (size_t)bq * 8192; A4_ISSUE(kn, vn, bq); }
            A4_SYNC();
#pragma unroll
            for (int w = 0; w < 4; ++w) {
                const unsigned selw0 = selm[(8 * wid + tl) * 4 + w], selw1 = selm[(8 * wid + 4 + tl) * 4 + w];
                for (int gg = 0; gg < 8; ++gg) {
                    const int j0 = w * 32 + gg * 4;
                    if (j0 > T) break;
#pragma unroll
                    for (int bq = 0; bq < 4; ++bq) { const int jn = j0 + 4 + bq; if (jn <= T) { const unsigned char* kn = KS + (size_t)jn * 8192; const unsigned char* vn = VS + (size_t)jn * 8192; A4_ISSUE(kn, vn, (jn & 7)); } }
                    for (int bq = 0; bq < 4; ++bq) {
                        const int j = j0 + bq;
                        if (j > T) break;
                        const int jb = gg * 4 + bq, stage = j & 7;
                        const bool need0 = (un[0][w] >> jb) & 1u, need1 = (un[1][w] >> jb) & 1u;
                        if (need0 || need1) {
#pragma unroll
                            for (int ct = 0; ct < 2; ++ct) {
                                if (ct == 0 ? need0 : need1) {
                                    A4_LOADK(stage);
                                    A4_SCORES(ct);
                                    __builtin_amdgcn_sched_barrier(0);
                                    const int t = tq[ct];
                                    const bool csel = ((ct == 0 ? selw0 : selw1) >> jb) & 1u;
                                    if (j * 64 + 63 + 1023 <= t0) {
                                        const float cb = csel ? cbfar : -INF;
#pragma unroll
                                        for (int kt = 0; kt < 4; ++kt)
#pragma unroll
                                            for (int jj = 0; jj < 4; ++jj) sv[kt][jj] += cb;
                                    } else {
                                        const int base = t - j * 64 - g4 * 4;
                                        const LAS float* lp = lutl + hd * LUTP + base - 51;
                                        const float msk = csel ? 0.f : -INF;
#pragma unroll
                                        for (int kt = 0; kt < 4; ++kt) {
                                            f32x4 bs;
#pragma unroll
                                            for (int jj = 0; jj < 4; ++jj) bs[jj] = lp[51 - kt * 16 - jj];
                                            asm volatile("" : "+v"(bs));
                                            sv[kt] += bs + msk;
                                        }
                                        if (j == T) {
#pragma unroll
                                            for (int kt = 0; kt < 4; ++kt)
#pragma unroll
                                                for (int jj = 0; jj < 4; ++jj) { const int dist = base - kt * 16 - jj; sv[kt][jj] = (dist >= 0) ? sv[kt][jj] : -INF; }
                                        }
                                    }
                                    A4_ONLINE_PV(ct, stage);
                                    __builtin_amdgcn_sched_barrier(0);
                                }
                            }
                        }
                    }
                    A4_SYNC();
                }
            }
            if (!probe) A4_FINISH(1, false);
        }
    }
#undef A4_ISSUE
#undef A4_SYNC
#undef A4_SYNC_RING
#undef A4_LOADK
#undef A4_SCORES
#undef A4_ONLINE_PV
#undef A4_PV
#undef A4_VREADS
#undef A4_PVMMA
#undef A4_RESET
#undef A4_FINISH
#undef A4_GATEV
}

__device__ __forceinline__ void phase3_mfma(const Params& p, int bid, int nb, LAS unsigned char* lds) {
    {
        const unsigned char* XRBb = p.ws + WS_XRB; const bf16_t* XRB = (const bf16_t*)(p.ws + WS_XRB);
        const float* BG = (const float*)(p.ws + WS_BG); const float* GB = (const float*)(p.ws + WS_GBIAS);
        const float* conv_w = p.in[12]; const float* conv_b = p.in[13]; const float* lam = p.in[18];
        float* AL = (float*)(p.ws + WS_ALRU); float* UL = (float*)(p.ws + WS_ULRU);
        const XcdDeal dl = xcd_deal(512, lds, nb);
        gemm_stream<true, 1, 0, true>(lds, XRBb, dl.n, 4, 128,
            [&](int ps, int r) { const int u = dl.lo + ps * dl.step; return ((size_t)(u >> 5) * SEQP + (u & 31) * 256 + r) * 128; },
            [&](int ps, int n4) -> const float* { const int u = dl.lo + ps * dl.step; return BG + ((u >> 5) & 7) * 32768 + n4 * 4; },
            [&](int) { return 256; },
            [&](int ps, int rbase, int nbase, int, f32x4 (&acc)[4][4]) {
                const int u = dl.lo + ps * dl.step, sq = u >> 5, hb = sq & 7, bb = sq >> 3, t0 = (u & 31) * 256 + rbase;
#pragma unroll
                for (int ni = 0; ni < 2; ++ni) {
                    const int n = nbase + ni * 16;
                    const int j = (n >> 6) * 32 + ((n >> 4) & 1) * 16 + (n & 15), c = hb * 64 + j;
                    f32x4 cw[4];
#pragma unroll
                    for (int w = 0; w < 4; ++w) cw[w] = *(const f32x4*)(conv_w + w * 512 + c);
                    const f32x4 cbv = *(const f32x4*)(conv_b + c), ga = *(const f32x4*)(GB + hb * 128 + n), gx = *(const f32x4*)(GB + hb * 128 + n + 32), lm = *(const f32x4*)(lam + c);
                    f32x4 spl;
#pragma unroll
                    for (int jj = 0; jj < 4; ++jj) spl[jj] = -8.0f * softplus_(-lm[jj]);
#pragma unroll
                    for (int mi = 0; mi < 4; ++mi) {
                        u32x2 xw[4];
#pragma unroll
                        for (int w = 0; w < 4; ++w) xw[w] = *(const u32x2*)(XRB + ((size_t)sq * SEQP + t0 + mi * 16 + w) * 64 + j);
                        f32x4 xc = cbv;
#pragma unroll
                        for (int w = 0; w < 4; ++w) {
                            xc[0] += cw[w][0] * __uint_as_float(xw[w].x << 16); xc[1] += cw[w][1] * __uint_as_float(xw[w].x & 0xffff0000u);
                            xc[2] += cw[w][2] * __uint_as_float(xw[w].y << 16); xc[3] += cw[w][3] * __uint_as_float(xw[w].y & 0xffff0000u);
                        }
                        f32x4 av, uv;
#pragma unroll
                        for (int jj = 0; jj < 4; ++jj) {
                            const float r_ = sigm(acc[mi][ni][jj] + ga[jj]), ig = sigm(acc[mi][ni + 2][jj] + gx[jj]);
                            const float la = r_ * spl[jj];
                            const float a1 = __builtin_amdgcn_exp2f(la * 1.4426950408889634f);
                            av[jj] = a1; uv[jj] = __builtin_amdgcn_sqrtf(fmaxf(1.f - a1 * a1, 0.f)) * (ig * xc[jj]);
                        }
                        const size_t o = ((size_t)bb * SEQ + t0 + mi * 16) * 512 + c;
                        *(f32x4*)(AL + o) = av; *(f32x4*)(UL + o) = uv;
                        __builtin_amdgcn_sched_barrier(0);
                    }
                } });
    }
    {
        const unsigned char* KV6 = p.ws + WS_KV6; float* CP = (float*)(p.ws + WS_CPART);
        const float* W1k = p.in[7]; const float* W1v = p.in[9];
        const XcdDeal dl = xcd_deal(64, lds, nb);
        gemm_stream<false, 1>(lds, KV6, dl.n, 8, 64,
            [&](int ps, int r) { const int u = dl.lo + ps * dl.step, ks = u >> 4, kv = (u >> 3) & 1, R = (u & 7) * 256 + r;
                                 return (size_t)kv * 4194304 + ((size_t)(R >> 9) * SEQ + 16 * (R & 511)) * 128 + (size_t)ks * 1024; },
            [&](int ps, int n4) -> const float* { const int u = dl.lo + ps * dl.step, ks = u >> 4, kv = (u >> 3) & 1; return (kv ? W1v : W1k) + (size_t)ks * 512 * 64 + ((n4 * 4) & 63); },
            [&](int) { return 256; },
            [&](int ps, int r, int n, f32x4 v) { if (n < 64) { const int u = dl.lo + ps * dl.step; *(f32x4*)(CP + ((size_t)(u >> 3) * 2048 + (u & 7) * 256 + r) * 64 + n) = v; } });
    }
}

__device__ __forceinline__ void phase3b_new(const Params& p, int bid, int nb, float* smem) {
    const int tid = threadIdx.x;
    {
        const float* AL = (const float*)(p.ws + WS_ALRU); const float* UL = (const float*)(p.ws + WS_ULRU);
        float* AEND = (float*)(p.ws + WS_AEND); float* HEND = (float*)(p.ws + WS_HEND);
        for (int u = bid; u < 256; u += nb) {
            const size_t base = ((size_t)(u >> 7) * SEQ + (u & 127) * 64) * 512 + tid;
            float A = 1.f, H = 0.f;
#pragma unroll 8
            for (int tt = 0; tt < 64; ++tt) { const float a = AL[base + (size_t)tt * 512], uu = UL[base + (size_t)tt * 512]; H = a * H + uu; A *= a; }
            AEND[(size_t)u * 512 + tid] = A; HEND[(size_t)u * 512 + tid] = H;
        }
    }
    {
        const float* CP = (const float*)(p.ws + WS_CPART); const float* CB = (const float*)(p.ws + WS_CBIAS);
        float* hid = smem;
        for (int u = bid; u < 64; u += nb) {
            const int kv = u >> 5, R0 = (u & 31) * 64;
            const float* w2 = kv ? p.in[10] : p.in[8];
            bf16_t* ob = (bf16_t*)(p.ws + (kv ? WS_VCB : WS_KCB));
            __syncthreads();
            for (int i = tid; i < 64 * 64; i += NT) {
                const int r = i >> 6, c = i & 63; const size_t o = ((size_t)kv * 2048 + R0 + r) * 64 + c;
                const float v = ((CP[o] + CP[o + 262144]) + (CP[o + 524288] + CP[o + 786432])) + CB[kv * 64 + c];
                hid[r * 65 + c] = gelu_t(v);
            }
            __syncthreads();
            for (int i = tid; i < 64 * 64; i += NT) {
                const int r = i >> 6, j = i & 63; float acc = 0.f;
#pragma unroll 8
                for (int k = 0; k < 64; ++k) acc += hid[r * 65 + k] * w2[k * 64 + j];
                const int R = R0 + r;
                if ((R & 511) == 511) acc = 0.f;
                ob[(size_t)R * 64 + j] = (bf16_t)(pk_bf16(acc, acc) & 0xffffu);
            }
        }
    }
}

__device__ __forceinline__ void phase4b_new(const Params& p, int bid, int nb, float* smem) {
    const float* AL = (const float*)(p.ws + WS_ALRU); const float* UL = (const float*)(p.ws + WS_ULRU);
    const float* AEND = (const float*)(p.ws + WS_AEND); const float* HEND = (const float*)(p.ws + WS_HEND);
    const bf16_t* GRG = (const bf16_t*)(p.ws + WS_GRG); const float* OATT = (const float*)(p.ws + WS_OATT);
    const float* gaw = p.in[19]; const float* grw = p.in[20];
    bf16_t* YB = (bf16_t*)(p.ws + WS_YB);
    const int tid = threadIdx.x, wave = tid >> 6, lane = tid & 63;
    float* ssr = smem;
    float* ssa = smem + 512;
    for (int u = bid; u < 256; u += nb) {
        const int b = u >> 7, chunk = u & 127;
        float carry = 0.f;
        {
            const size_t cb = (size_t)(b * 128) * 512 + tid;
#pragma unroll 32
            for (int k = 0; k < chunk; ++k) carry = AEND[cb + (size_t)k * 512] * carry + HEND[cb + (size_t)k * 512];
        }
        const size_t tok0 = (size_t)b * SEQ + chunk * 64;
        float v[64];
        float h = carry;
        __syncthreads();
#pragma unroll
        for (int tt = 0; tt < 64; ++tt) {
            const size_t o = (tok0 + tt) * 512 + tid;
            h = AL[o] * h + UL[o];
            v[tt] = h * bf2f(GRG[o]);
            const float sq = wave_sum(v[tt] * v[tt]);
            const float av = OATT[o];
            const float sqa = wave_sum(av * av);
            if (lane == 0) { ssr[tt * 8 + wave] = sq; ssa[tt * 8 + wave] = sqa; }
        }
        __syncthreads();
        const float gr_w = grw[tid], ga_w = gaw[tid];
#pragma unroll
        for (int tt = 0; tt < 64; ++tt) {
            float s1 = 0.f, s2 = 0.f;
#pragma unroll
            for (int w = 0; w < 8; ++w) { s1 += ssr[tt * 8 + w]; s2 += ssa[tt * 8 + w]; }
            const float rs1 = 1.0f / sqrtf(s1 * (1.f / 512.f) + 1e-6f), rs2 = 1.0f / sqrtf(s2 * (1.f / 512.f) + 1e-6f);
            const size_t o = (tok0 + tt) * 512 + tid;
            const float ya = OATT[o] * rs2 * ga_w, yr = v[tt] * rs1 * gr_w;
            YB[(tok0 + tt) * 1024 + tid] = (bf16_t)(pk_bf16(ya, ya) & 0xffffu);
            YB[(tok0 + tt) * 1024 + 512 + tid] = (bf16_t)(pk_bf16(yr, yr) & 0xffffu);
        }
    }
}

__device__ __forceinline__ void phase8(const Params& p, int bid, int nb, float* smem) {
    const float* LOG = (const float*)(p.ws + WS_LOGITS); const float* brt = p.in[24];
    unsigned* cnt = (unsigned*)(p.ws + WS_HIST);
    int* EID = (int*)(p.ws + WS_EID); int* POS = (int*)(p.ws + WS_POS); float* WGT = (float*)(p.ws + WS_WGT);
    const int wave = threadIdx.x >> 6, lane = threadIdx.x & 63;
    float* s = smem + wave * 512; float* ssel = s + 256;
    int* lhist = (int*)(smem + 8 * 512);
    if (threadIdx.x < 256) lhist[threadIdx.x] = 0;
    __syncthreads();
    for (int tok = bid * NW + wave; tok < MTOK; tok += nb * NW) {
        __builtin_amdgcn_wave_barrier();
#pragma unroll
        for (int r = 0; r < 4; ++r) { const int e = r * 64 + lane; const float sv = sigm(LOG[(size_t)tok * 256 + e]); s[e] = sv; ssel[e] = sv + brt[e]; }
        __builtin_amdgcn_wave_barrier();
        float gsc = -INF;
        if (lane < 8) {
            float m1 = -INF, m2 = -INF;
            for (int i = 0; i < 32; ++i) { const float v = ssel[lane * 32 + i]; if (v > m1) { m2 = m1; m1 = v; } else if (v > m2) m2 = v; }
            gsc = m1 + m2;
        }
        int grank = 0;
#pragma unroll
        for (int g2 = 0; g2 < 8; ++g2) { const float v2 = __shfl(gsc, g2); grank += (v2 > gsc) || (v2 == gsc && g2 < lane); }
        const bool gok = (lane < 8) && (grank < 4);
        const unsigned long long gmask = __ballot(gok);
        float cv0, cv1, cv2, cv3;
        { const int e = lane;        cv0 = ((gmask >> (e >> 5)) & 1ull) ? ssel[e] : -INF; }
        { const int e = 64 + lane;   cv1 = ((gmask >> (e >> 5)) & 1ull) ? ssel[e] : -INF; }
        { const int e = 128 + lane;  cv2 = ((gmask >> (e >> 5)) & 1ull) ? ssel[e] : -INF; }
        { const int e = 192 + lane;  cv3 = ((gmask >> (e >> 5)) & 1ull) ? ssel[e] : -INF; }
        int my_e = 0; float my_s = 0.f;
#pragma unroll
        for (int k = 0; k < 8; ++k) {
            float bv = cv0; int bi = lane;
            if (cv1 > bv) { bv = cv1; bi = 64 + lane; }
            if (cv2 > bv) { bv = cv2; bi = 128 + lane; }
            if (cv3 > bv) { bv = cv3; bi = 192 + lane; }
#pragma unroll
            for (int o = 32; o; o >>= 1) { const float ov = __shfl_xor(bv, o); const int oi = __shfl_xor(bi, o); if (ov > bv || (ov == bv && oi < bi)) { bv = ov; bi = oi; } }
            if (bi == lane) cv0 = -INF;
            if (bi == 64 + lane) cv1 = -INF;
            if (bi == 128 + lane) cv2 = -INF;
            if (bi == 192 + lane) cv3 = -INF;
            if (lane == k) { my_e = bi; my_s = s[bi]; }
        }
        const float ssum = wave_sum(lane < 8 ? my_s : 0.f);
        if (lane < 8) {
            const int ps = atomicAdd(&lhist[my_e], 1);
            EID[tok * 8 + lane] = my_e; POS[tok * 8 + lane] = ps; WGT[tok * 8 + lane] = 2.5f * my_s / ssum;
        }
    }
    __syncthreads();
    if (threadIdx.x < 256) cnt[bid * 256 + threadIdx.x] = (unsigned)lhist[threadIdx.x];
}

__device__ __forceinline__ void expert_tables(const Params& p, int* off, int* tp, int shift = 6) {
    const unsigned* cnt = (const unsigned*)(p.ws + WS_CTL) + CW_CNT;
    __syncthreads();
    if (threadIdx.x < 256) off[threadIdx.x] = (int)cnt[threadIdx.x];
    __syncthreads();
    if (threadIdx.x == 0) {
        int o = 0, t = 0;
        for (int e = 0; e < 256; ++e) { const int c = off[e]; off[e] = o; tp[e] = t; o += c; t += (c + (1 << shift) - 1) >> shift; }
        off[256] = o; tp[256] = t; tp[257] = t + (MTOK >> shift);
    }
    __syncthreads();
}

__device__ __forceinline__ void phase9(const Params& p, int bid, int nb, float* smem) {
    int* off = (int*)smem; int* blkoff = off + 272; int* tot = off + 800;
    const unsigned* HIST = (const unsigned*)(p.ws + WS_HIST);
    unsigned* cnt = (unsigned*)(p.ws + WS_CTL) + CW_CNT;
    const int tid = threadIdx.x;
    __syncthreads();
    {
        const int e = tid & 255, hb = tid >> 8, b0 = hb * (nb >> 1), b1 = hb ? nb : (nb >> 1);
        int total = 0, pre = 0;
#pragma unroll 16
        for (int bb = b0; bb < b1; ++bb) { const int h = (int)HIST[bb * 256 + e]; total += h; pre += (bb < bid) ? h : 0; }
        if (hb) { tot[256 + e] = total; blkoff[256 + e] = pre; }
        __syncthreads();
        if (!hb) { total += tot[256 + e]; pre += blkoff[256 + e]; }
        __syncthreads();
        if (!hb) { tot[e] = total; blkoff[e] = pre; if (bid == 0) cnt[e] = (unsigned)total; }
    }
    __syncthreads();
    if (tid == 0) { int o = 0; for (int e = 0; e < 256; ++e) { off[e] = o; o += tot[e]; } }
    __syncthreads();
    const int* EID = (const int*)(p.ws + WS_EID); const int* POS = (const int*)(p.ws + WS_POS); const float* WGT = (const float*)(p.ws + WS_WGT);
    int* ST = (int*)(p.ws + WS_SLOTTOK); float* SW = (float*)(p.ws + WS_SLOTW); int* SOF = (int*)(p.ws + WS_SLOTOF);
    const int wave = tid >> 6, lane = tid & 63;
    for (int tok = bid * NW + wave; tok < MTOK; tok += nb * NW) {
        if (lane < 8) {
            const int idx = tok * 8 + lane; const int e = EID[idx];
            const int slot = off[e] + blkoff[e] + POS[idx];
            ST[slot] = tok; SW[slot] = WGT[idx]; SOF[idx] = slot;
        }
    }
}

__device__ __forceinline__ int find_expert(const int* tp, int rt) {
    int lo = 0, hi = 256;
    while (lo < hi) { const int mid = (lo + hi + 1) >> 1; if (tp[mid] <= rt) lo = mid; else hi = mid - 1; }
    return lo;
}

__device__ __forceinline__ void phase7_mfma(const Params& p, int bid, int nb, LAS unsigned char* lds) {
    const unsigned char* H2b = p.ws + WS_H2B; const float* wr = p.in[23];
    float* LOG = (float*)(p.ws + WS_LOGITS);
    const XcdDeal dl = xcd_deal(64 * 2, lds, nb);
    const bf16_t* wrb = (const bf16_t*)(p.ws + WS_WRB);
    gemm_stream<false, 1, 0, false, true>(lds, H2b, dl.n, 16, 256,
        [&](int ps, int r) { const int u = dl.lo + ps * dl.step; return (size_t)((u >> 1) * 256 + r) * 2048; },
        [&](int ps, int n4) -> const bf16_t* { const int u = dl.lo + ps * dl.step; return wrb + (u & 1) * 128 + n4 * 4; },
        [&](int) { return 256; },
        [&](int ps, int r, int n, f32x4 v) { const int u = dl.lo + ps * dl.step; *(f32x4*)(LOG + (size_t)((u >> 1) * 256 + r) * 256 + (u & 1) * 128 + n) = v; });
}

#define ETAB_OFF 24576
#define EDESC_OFF (ETAB_OFF + 1024)
__device__ __forceinline__ int expert_passes(const Params& p, int bid, int nb, const LAS unsigned char* lds, float* smem, int nct, int& npass) {
    int* off = (int*)(smem + ETAB_OFF); int* tp = off + 272; int* desc = (int*)(smem + EDESC_OFF);
    expert_tables(p, off, tp, 8);
    const unsigned* cnt = (const unsigned*)(p.ws + WS_CTL) + CW_CNT;
    const XcdDeal dl = xcd_deal(tp[257] * nct, lds, nb);
    npass = dl.n;
    for (int ps = threadIdx.x; ps < npass; ps += NT) {
        const int u = dl.lo + ps * dl.step;
        const int e = find_expert(tp, u / nct);
        const int nte = tp[e + 1] - tp[e], v = u - tp[e] * nct, ct = v / nte, rtl = v - ct * nte;
        const int rows_e = e < 256 ? (int)cnt[e] : MTOK;
        const int r0 = rtl * 256;
        desc[ps * 4 + 0] = (e < 256 ? off[e] : NK) + r0;
        desc[ps * 4 + 1] = (rows_e - r0) < 256 ? (rows_e - r0) : 256;
        desc[ps * 4 + 2] = e; desc[ps * 4 + 3] = ct;
    }
    __syncthreads();
    return dl.lo;
}

__device__ __forceinline__ void phase10_mfma(const Params& p, int bid, int nb, LAS unsigned char* lds, float* smem) {
    int npass; expert_passes(p, bid, nb, lds, smem, 4, npass);
    const LAS int* desc = (const LAS int*)(lds + EDESC_OFF * 4);
    const unsigned char* H2b = p.ws + WS_H2B; const int* ST = (const int*)(p.ws + WS_SLOTTOK);
    bf16_t* HIDB = (bf16_t*)(p.ws + WS_HIDB);
    const float* W1g = p.in[25]; const float* W3g = p.in[26]; const float* W1s = p.in[28]; const float* W3s = p.in[29];
    const float* SW = (const float*)(p.ws + WS_SLOTW);
    gemm_stream_ws(lds, H2b, npass, 16, 256,
        [&](int ps, int r) { const int slot0 = desc[ps * 4], mr = desc[ps * 4 + 1]; const int rr = r < mr ? r : mr - 1; const int slot = slot0 + rr;
                             const int tok = slot < NK ? ST[slot] : slot - NK; return (size_t)tok * 2048; },
        [&](int ps, int n4) -> const float* { const int e = desc[ps * 4 + 2], hc0 = desc[ps * 4 + 3] * 64; const int n = n4 * 4;
                             const int hc = hc0 + (n >> 6) * 32 + ((n >> 4) & 1) * 16 + (n & 15);
                             const float* W = ((n >> 5) & 1) ? (e < 256 ? W3g + (size_t)e * 262144 : W3s) : (e < 256 ? W1g + (size_t)e * 262144 : W1s); return W + hc; },
        [&](int ps) { return desc[ps * 4 + 1]; },
        [&](int ps, int rbase, int nbase, int mr, f32x4 (&acc)[8][4]) {
            const int slot0 = desc[ps * 4] + rbase, hc0 = desc[ps * 4 + 3] * 64;
            float wv[8];
#pragma unroll
            for (int mi = 0; mi < 8; ++mi) { const int slot = slot0 + mi * 16; const float wl = SW[slot < NK ? slot : 0]; wv[mi] = slot < NK ? wl : 1.f; }
#pragma unroll
            for (int mi = 0; mi < 8; ++mi) {
                if (rbase + mi * 16 < mr) {
#pragma unroll
                    for (int ni = 0; ni < 2; ++ni) {
                        const int n = nbase + ni * 16;
                        const int hc = hc0 + (n >> 6) * 32 + ((n >> 4) & 1) * 16 + (n & 15);
                        const f32x4 a = acc[mi][ni], bq = acc[mi][ni + 2];
                        float h[4];
#pragma unroll
                        for (int jj = 0; jj < 4; ++jj) h[jj] = a[jj] * __builtin_amdgcn_rcpf(1.f + ex2(-a[jj] * LOG2E)) * bq[jj] * wv[mi];
                        u32x2 w; w.x = pk_bf16(h[0], h[1]); w.y = pk_bf16(h[2], h[3]);
                        *(u32x2*)(HIDB + (size_t)(slot0 + mi * 16) * 256 + hc) = w;
                    }
                }
            } });
}

__device__ __forceinline__ void phase11_mfma(const Params& p, int bid, int nb, LAS unsigned char* lds, float* smem) {
    int npass; expert_passes(p, bid, nb, lds, smem, 8, npass);
    const LAS int* desc = (const LAS int*)(lds + EDESC_OFF * 4);
    const unsigned char* HIDB = p.ws + WS_HIDB; const float* SW = (const float*)(p.ws + WS_SLOTW);
    bf16_t* SO = (bf16_t*)(p.ws + WS_SLOTOUT);
    const float* W2g = p.in[27]; const float* W2s = p.in[30];
    gemm_stream_ws(lds, HIDB, npass, 4, 1024,
        [&](int ps, int r) { const int slot0 = desc[ps * 4], mr = desc[ps * 4 + 1]; const int rr = r < mr ? r : mr - 1; return (size_t)(slot0 + rr) * 512; },
        [&](int ps, int n4) -> const float* { const int e = desc[ps * 4 + 2], n0 = desc[ps * 4 + 3] * 128; return (e < 256 ? W2g + (size_t)e * 262144 : W2s) + n0 + n4 * 4; },
        [&](int ps) { return desc[ps * 4 + 1]; },
        [&](int ps, int rbase, int nbase, int mr, f32x4 (&acc)[8][4]) {
            const int slot0 = desc[ps * 4] + rbase, c0 = desc[ps * 4 + 3] * 128 + nbase;
#pragma unroll
            for (int mi = 0; mi < 8; ++mi) {
                if (rbase + mi * 16 < mr) {
                    bf16_t* op = SO + (size_t)(slot0 + mi * 16) * 1024 + c0;
#pragma unroll
                    for (int ni = 0; ni < 4; ++ni) { u32x2 o; o.x = pk_bf16(acc[mi][ni][0], acc[mi][ni][1]); o.y = pk_bf16(acc[mi][ni][2], acc[mi][ni][3]); *(u32x2*)(op + ni * 16) = o; }
                }
            } });
}

__device__ __forceinline__ void phase12_mfma(const Params& p, int bid, int nb) {
    const float* X1 = (const float*)(p.ws + WS_X1); const bf16_t* SO = (const bf16_t*)(p.ws + WS_SLOTOUT); const int* SOF = (const int*)(p.ws + WS_SLOTOF);
    const float* mod = (const float*)(p.ws + WS_MOD); const float* fw = p.in[31];
    const int wave = threadIdx.x >> 6, lane = threadIdx.x & 63;
    for (int row = bid * NW + wave; row < MTOK; row += nb * NW) {
        const int b = row >> 13;
        const int myslot = lane < 8 ? SOF[row * 8 + lane] : NK + row;
        float acc[16];
#pragma unroll
        for (int i = 0; i < 16; ++i) acc[i] = 0.f;
        u32x4 w0[9], w1[9];
#pragma unroll
        for (int k = 0; k < 9; ++k) {
            const int slot = __builtin_amdgcn_readlane(myslot, k);
            const u32x4* rp = (const u32x4*)(SO + (size_t)slot * 1024 + lane * 16);
            w0[k] = rp[0]; w1[k] = rp[1];
        }
#pragma unroll
        for (int k = 0; k < 9; ++k) {
#pragma unroll
            for (int j = 0; j < 4; ++j) {
                acc[2 * j] += __uint_as_float(w0[k][j] << 16); acc[2 * j + 1] += __uint_as_float(w0[k][j] & 0xffff0000u);
                acc[8 + 2 * j] += __uint_as_float(w1[k][j] << 16); acc[8 + 2 * j + 1] += __uint_as_float(w1[k][j] & 0xffff0000u);
            }
        }
        float v[16]; float ss = 0.f;
#pragma unroll
        for (int i4 = 0; i4 < 4; ++i4) {
            const f32x4 xv = *(const f32x4*)(X1 + (size_t)row * 1024 + lane * 16 + i4 * 4);
            const f32x4 gv = *(const f32x4*)(mod + b * 6144 + 5120 + lane * 16 + i4 * 4);
#pragma unroll
            for (int j = 0; j < 4; ++j) { v[i4 * 4 + j] = xv[j] + gv[j] * acc[i4 * 4 + j]; ss += v[i4 * 4 + j] * v[i4 * 4 + j]; }
        }
        ss = wave_sum(ss);
        const float rstd = 1.0f / sqrtf(ss * (1.f / 1024.f) + 1e-6f);
#pragma unroll
        for (int i4 = 0; i4 < 4; ++i4) {
            const f32x4 wv = *(const f32x4*)(fw + lane * 16 + i4 * 4);
            f32x4 o;
#pragma unroll
            for (int j = 0; j < 4; ++j) o[j] = v[i4 * 4 + j] * rstd * wv[j];
            *(f32x4*)(p.out + (size_t)row * 1024 + lane * 16 + i4 * 4) = o;
        }
    }
}

__global__ void __launch_bounds__(NT, 2) k_fused(Params p) {
    extern __shared__ __attribute__((aligned(16))) unsigned char lds_raw[];
    LAS unsigned char* lds = (LAS unsigned char*)lds_raw;
    float* smem = (float*)lds_raw;
    if (threadIdx.x == 0) { *(LAS u32x4*)(lds + LDS_MISC) = (u32x4){0u, 0u, 0u, 0u}; }
    __syncthreads();
    XcdBarrier bar = xcd_barrier_post((unsigned*)(p.ws + WS_CTL), (volatile LAS unsigned*)(lds + LDS_MISC));
    if (threadIdx.x == 0) ((LAS int*)(lds + TOPO_OFF))[2] = (int)xb_add((unsigned*)(p.ws + WS_CTL) + CW_RANK + 64 * bar.x, 1u);
    const int bid = blockIdx.x, nb = gridDim.x;
#define PH(stmt) { stmt; xcd_barrier(bar); }
#define PHR(bit, stmt) { stmt; xcd_barrier(bar); if (REP & (bit)) { stmt; xcd_barrier(bar); } }
    PH(phase0(p, bid, nb, smem, lds))
    if (threadIdx.x == 0) {
        int pre = 0, mine = 0;
        for (unsigned j = 0; j < 16; ++j) { const int c = (int)xb_ld((unsigned*)(p.ws + WS_CTL) + XB_XCNT(j)); if (j < bar.x) pre += c; if (j == bar.x) mine = c; }
        ((LAS int*)(lds + TOPO_OFF))[0] = pre; ((LAS int*)(lds + TOPO_OFF))[1] = mine > 0 ? mine : 1;
    }
    __syncthreads();
    PHR(128, phase_modnorm(p, bid, nb, p.in[0], p.in[4], 0, 1024, (float*)(p.ws + WS_H1), (bf16_t*)(p.ws + WS_H1B)))
    PHR(1, phase2_e(p, bid, nb, lds))
    PH(phase3_mfma(p, bid, nb, lds))
    PH(phase3b_new(p, bid, nb, smem))
    PH(phase4_mfma(p.ws, bid, nb, lds))
    PH(phase4b_new(p, bid, nb, smem))
    PHR(512, phase5_e(p, bid, nb, lds))
    PH(phase_modnorm(p, bid, nb, (const float*)(p.ws + WS_X1), p.in[22], 3072, 4096, (float*)(p.ws + WS_H2), (bf16_t*)(p.ws + WS_H2B)))
    PHR(1024, phase7_mfma(p, bid, nb, lds))
    PH(phase8(p, bid, nb, smem))
    PH(phase9(p, bid, nb, smem))
    PHR(16, phase10_mfma(p, bid, nb, lds, smem))
    PHR(32, phase11_mfma(p, bid, nb, lds, smem))
    phase12_mfma(p, bid, nb);
    if (REP & 2048) { xcd_barrier(bar); phase12_mfma(p, bid, nb); }
    if (REP & 4096) { for (int i = 0; i < 20; ++i) xcd_barrier(bar); }
#undef PH
#undef PHR
}

extern "C" void kernel_launch(void* const* d_in, const int* in_sizes, int n_in, void* d_out, int out_size, void* d_ws, size_t ws_size, hipStream_t stream) {
    static int grid = 0;
    if (!grid) {
        int dev = 0, cus = 0;
        (void)hipGetDevice(&dev);
        (void)hipDeviceGetAttribute(&cus, hipDeviceAttributeMultiprocessorCount, dev);
        (void)hipFuncSetAttribute((const void*)k_fused, hipFuncAttributeMaxDynamicSharedMemorySize, LDS_BYTES);
        if (cus < 1) cus = 256;
        grid = cus;
    }
    Params p{};
    for (int i = 0; i < 32; ++i) p.in[i] = (const float*)d_in[i];
    p.out = (float*)d_out; p.ws = (unsigned char*)d_ws;
    (void)hipMemsetAsync((char*)d_ws + WS_CTL, 0, CTL_BYTES, stream);
    hipLaunchKernelGGL(k_fused, dim3(grid), dim3(NT), LDS_BYTES, stream, p);
}
```

```cpp
#include <hip/hip_runtime.h>
#include <stdint.h>
#include <type_traits>


#define MTOK 16384
#define SEQ 8192
#define SEQP 8195
#define DM 1024
#define NCOLS 2328
#define COL_KC 512
#define COL_KS 768
#define COL_VS 896
#define COL_KW 1024
#define COL_VW 1152
#define COL_G 1280
#define COL_XR 1304
#define COL_GR 1816
#define NCMP 511
#define NEXP 256
#define NK 131072

#define MiB (1048576ull)
#define WS_CTL 0ull
#define CTL_BYTES (1 * MiB)
#define CW_CNT 8192
#define CW_RANK 12288
#define WS_MOD (1 * MiB)
#define WS_LUT (1 * MiB + 65536)
#define WS_KC (2 * MiB)
#define WS_VC (3 * MiB)
#define WS_AEND (4 * MiB)
#define WS_HEND (5 * MiB)
#define WS_EID (6 * MiB)
#define WS_POS (7 * MiB)
#define WS_WGT (8 * MiB)
#define WS_SLOTTOK (9 * MiB)
#define WS_SLOTW (10 * MiB)
#define WS_CARRY (11 * MiB)
#define WS_SLOTOF (12 * MiB)
#define WS_HIST (13 * MiB)
#define WS_LOGITS (16 * MiB)
#define WS_H1 (32 * MiB)
#define WS_PROJ (96 * MiB)
#define WS_HL (256 * MiB)
#define WS_AP (288 * MiB)
#define WS_ACC (320 * MiB)
#define WS_HID (384 * MiB)
#define WS_Y (528 * MiB)
#define WS_H2 (592 * MiB)
#define WS_X1 (656 * MiB)
#define WS_H1B (720 * MiB)
#define WS_YB (752 * MiB)
#define WS_H2B (784 * MiB)
#define WS_HIDB (816 * MiB)
#define WS_QB (896 * MiB)
#define WS_KV6 (912 * MiB)
#define WS_GATE (936 * MiB)
#define WS_KCB (938 * MiB)
#define WS_VCB (939 * MiB)
#define WS_OATT (940 * MiB)
#define WS_BG (14 * MiB)
#define WS_GBIAS (15 * MiB)
#define WS_CBIAS (15 * MiB + 8192)
#define WS_XRB (972 * MiB)
#define WS_GRG (990 * MiB)
#define WS_CPART (1007 * MiB)
#define WS_ALRU (256 * MiB)
#define WS_ULRU (288 * MiB)
#define WS_WINB (1012 * MiB)
#define WS_WOUTB (1017 * MiB)
#define WS_WRB (1020 * MiB)
#define WS_WINT (1012 * MiB)
#define WS_WOUTT (1017 * MiB)
#define WS_WRT (1019 * MiB)
#define WS_SLOTOUT (32 * MiB)

#ifndef REP
#define REP 0
#endif
#ifndef USE_MFMA
#define USE_MFMA 31
#endif

struct Params {
    const float* in[32];
    float* out;
    unsigned char* ws;
};

#define NT 512
#define NW 8
#define LDS_BYTES 151552
#define LDS_MISC 131072
#define INF __builtin_huge_valf()
#define LOG2E 1.4426950408889634f

__device__ __forceinline__ float wave_sum(float v) {
#define WS_DPP(ctrl, rmask) __builtin_bit_cast(float, __builtin_amdgcn_update_dpp(0, __builtin_bit_cast(int, v), (ctrl), (rmask), 0xf, true))
    v += WS_DPP(0x111, 0xf);
    v += WS_DPP(0x112, 0xf);
    v += WS_DPP(0x114, 0xf);
    v += WS_DPP(0x118, 0xf);
    v += WS_DPP(0x142, 0xa);
    v += WS_DPP(0x143, 0xc);
#undef WS_DPP
    return __builtin_bit_cast(float, __builtin_amdgcn_readlane(__builtin_bit_cast(int, v), 63));
}
__device__ __forceinline__ float wave_max(float v) {
#pragma unroll
    for (int o = 32; o; o >>= 1) v = fmaxf(v, __shfl_xor(v, o));
    return v;
}
__device__ __forceinline__ float sigm(float x) { return __builtin_amdgcn_rcpf(1.f + __builtin_amdgcn_exp2f(-1.4426950408889634f * x)); }
__device__ __forceinline__ float tanh_fast(float x) { return 1.f - 2.f * __builtin_amdgcn_rcpf(1.f + __builtin_amdgcn_exp2f(2.8853900817779268f * x)); }
__device__ __forceinline__ float gelu_t(float x) { return 0.5f * x * (1.f + tanh_fast(0.7978845608028654f * (x + 0.044715f * x * x * x))); }
__device__ __forceinline__ float softplus_(float z) { return fmaxf(z, 0.f) + log1pf(expf(-fabsf(z))); }


#define XB_TMO      128
#define XB_XCNT(j)  (256  + 64 * (j))
#define XB_XSUB(j)  (1280 + 64 * (j))
#define XB_XGEN(j)  (2304 + 64 * (j))
#define XB_TOP      3328
#define XB_TOPGEN   3392
#define XCD_BAR_WORDS 3456
#define XB_SPIN_CAP (1u << 18)
#define LAS __attribute__((address_space(3)))

__device__ __forceinline__ unsigned xb_ld(unsigned* p)              { return __hip_atomic_load(p, __ATOMIC_RELAXED, __HIP_MEMORY_SCOPE_AGENT); }
__device__ __forceinline__ unsigned xb_add(unsigned* p, unsigned v) { return __hip_atomic_fetch_add(p, v, __ATOMIC_RELAXED, __HIP_MEMORY_SCOPE_AGENT); }
__device__ __forceinline__ unsigned xb_xcc_id() { return (unsigned)__builtin_amdgcn_s_getreg((3 << 11) | 20) & 0xFu; }
#define XB_SPIN(cond, bar) do { unsigned _sp = 0; while (cond) { __builtin_amdgcn_s_sleep(1); \
    if ((++_sp & 255u) == 0u) { if (xb_ld(&(bar)[XB_TMO])) break; if (_sp > XB_SPIN_CAP) { atomicAdd(&(bar)[XB_TMO], 1u); break; } } } } while (0)

struct XcdBarrier {
    unsigned* bar; unsigned x;
    volatile LAS unsigned* st;
};
__device__ __forceinline__ XcdBarrier xcd_barrier_post(unsigned* bar, volatile LAS unsigned* st) {
    XcdBarrier b; b.bar = bar; b.x = xb_xcc_id(); b.st = st;
    if (threadIdx.x == 0) (void)xb_add(&bar[XB_XCNT(b.x)], 1u);
    return b;
}
__device__ __forceinline__ void xcd_barrier_complete(unsigned* bar, unsigned x, unsigned& nloc, unsigned& nx) {
    const unsigned G = gridDim.x * gridDim.y * gridDim.z;
    unsigned sum, cnt, mine, sp = 0u;
    for (;;) {
        sum = 0u; cnt = 0u; mine = 0u;
#pragma unroll
        for (unsigned j = 0; j < 16; ++j) { const unsigned c = xb_ld(&bar[XB_XCNT(j)]); sum += c; cnt += (c > 0u) ? 1u : 0u; mine = (j == x) ? c : mine; }
        if (sum == G) break;
        __builtin_amdgcn_s_sleep(1);
        if ((++sp & 255u) == 0u) { if (xb_ld(&bar[XB_TMO])) break; if (sp > XB_SPIN_CAP) { atomicAdd(&bar[XB_TMO], 1u); break; } }
    }
    nloc = mine > 0u ? mine : 1u; nx = cnt > 0u ? cnt : 1u;
}
__device__ __forceinline__ void xcd_barrier(const XcdBarrier& b) {
    asm volatile("s_waitcnt vmcnt(0)" ::: "memory");
    __syncthreads();
    if (threadIdx.x == 0) {
        unsigned* bar = b.bar;
        __builtin_amdgcn_s_waitcnt(0);
        unsigned nloc = b.st[0], nx = b.st[1];
        if (nloc == 0u) { xcd_barrier_complete(bar, b.x, nloc, nx); b.st[0] = nloc; b.st[1] = nx; }
        const unsigned old = xb_add(&bar[XB_XSUB(b.x)], 1u);
        const unsigned gen = old / nloc;
        if (old + 1u == (gen + 1u) * nloc) {
            __builtin_amdgcn_fence(__ATOMIC_RELEASE, "agent");
            asm volatile("s_waitcnt vmcnt(0)" ::: "memory");
            const unsigned og = xb_add(&bar[XB_TOP], 1u);
            const unsigned tg = og / nx;
            if (og + 1u == (tg + 1u) * nx) xb_add(&bar[XB_TOPGEN], 1u);
            else XB_SPIN(xb_ld(&bar[XB_TOPGEN]) == tg, bar);
            __builtin_amdgcn_fence(__ATOMIC_ACQUIRE, "agent");
            xb_add(&bar[XB_XGEN(b.x)], 1u);
            asm volatile("s_waitcnt vmcnt(0)" ::: "memory");
        } else {
            XB_SPIN(xb_ld(&bar[XB_XGEN(b.x)]) == gen, bar);
            __builtin_amdgcn_fence(__ATOMIC_ACQUIRE, "agent");
            asm volatile("s_waitcnt vmcnt(0)" ::: "memory");
        }
    }
    __syncthreads();
}

typedef short bf16x8 __attribute__((ext_vector_type(8)));
typedef short s16x4 __attribute__((ext_vector_type(4)));
typedef short v4i16_t __attribute__((ext_vector_type(4)));
typedef float f32x4 __attribute__((ext_vector_type(4)));
typedef float f32x2 __attribute__((ext_vector_type(2)));
typedef __bf16 bf16x2_t __attribute__((ext_vector_type(2)));
typedef unsigned short bf16_t;
typedef unsigned u32x2 __attribute__((ext_vector_type(2)));
typedef unsigned u32x4 __attribute__((ext_vector_type(4)));
__device__ __forceinline__ unsigned pk_bf16(float lo, float hi) { return __builtin_bit_cast(unsigned, __builtin_convertvector((f32x2){lo, hi}, bf16x2_t)); }
__device__ __forceinline__ float bf2f(bf16_t v) { return __uint_as_float(((unsigned)v) << 16); }

__device__ __forceinline__ s16x4 tr_read(LAS unsigned char* pa) { s16x4 r; asm volatile("ds_read_b64_tr_b16 %0, %1" : "=v"(r) : "v"(pa) : "memory"); return r; }
#define TR_WAIT8(a0, a1, a2, a3, a4, a5, a6, a7) asm volatile("s_waitcnt lgkmcnt(0)" : "+v"(a0), "+v"(a1), "+v"(a2), "+v"(a3), "+v"(a4), "+v"(a5), "+v"(a6), "+v"(a7) :: "memory")

#define GEMM_LDS_A 0
#define GEMM_LDS_B 65536
template <bool PAIR, int DEPTH, int MODE = 0, bool TILE_EPI = false, bool BBF16 = false, class ARow, class BCol, class MRows, class Epi>
__device__ __forceinline__ void gemm_stream(LAS unsigned char* lds, const unsigned char* Abase, int npass, int nk, int ldb, ARow arow, BCol bcol, MRows mrowsf, Epi epi) {
    int tid_ = threadIdx.x; asm volatile("" : "+v"(tid_));
    const int tid = tid_, wid = __builtin_amdgcn_readfirstlane(tid >> 6), lane = tid & 63;
    const int wr = wid >> 1, wc = wid & 1, fr = lane & 15, fq = lane >> 4;
    if (npass <= 0) return;
    const int S = npass * nk;
    const int Ccol = ((wid & 1) * 32 + 8 * ((lane & 3) ^ ((lane >> 5) << 1))) * 2;
    const int Rbase = 16 * (wid >> 1) + (lane >> 2);
    unsigned asrc[4];
    const int n4 = tid & 31, kb = tid >> 5;
    typedef typename std::conditional<BBF16, const bf16_t*, const float*>::type bptr_t;
    bptr_t bp;
    const int fB = ((kb & 3) << 2) | ((kb >> 2) & 3);
    const int bwoff = 256 * kb + 16 * ((n4 >> 1) ^ fB) + 8 * (n4 & 1);
    const int aoff = wr * 8192 + ((fr * 64 + fq * 16) ^ ((fr >> 3) << 5));
    const int q = (lane >> 2) & 3, pp = lane & 3;
    const int b0 = (wc * 8 + (pp >> 1)) ^ ((q << 2) | (2 * (fq & 1)));
    const int browoff = 256 * (fq * 8 + q) + 8 * (pp & 1);
#define GS_BOFF(v) (browoff + 16 * (b0 ^ (v)))
    f32x4 acc[4][4];
#pragma unroll
    for (int i = 0; i < 4; ++i)
#pragma unroll
        for (int j = 0; j < 4; ++j) acc[i][j] = (f32x4){0.f, 0.f, 0.f, 0.f};
    float4 bregX[4], bregY[4];
    int aP = 0, aK = 0, bP = 0, bK = 0;
#define GS_SETA() do { _Pragma("unroll") for (int _i = 0; _i < 4; ++_i) asrc[_i] = (unsigned)(arow(aP, Rbase + 64 * _i) + Ccol); } while (0)
#define GS_ISSUE_A(buf) do { _Pragma("unroll") for (int _i = 0; _i < 4; ++_i) \
        __builtin_amdgcn_global_load_lds((const unsigned*)(Abase + (size_t)asrc[_i] + (size_t)aK * 128), (LAS unsigned*)(lds + GEMM_LDS_A + (buf) * 32768 + _i * 8192 + wid * 1024), 16, 0, 0); \
        if (++aK == nk) { aK = 0; ++aP; if (aP < npass) GS_SETA(); } } while (0)
#define GS_LOAD_B(breg) do { _Pragma("unroll") for (int _i = 0; _i < 4; ++_i) { \
            if constexpr (BBF16) { const u32x2 _t = *(const u32x2*)(bp + (size_t)(bK * 64 + kb + 16 * _i) * ldb); breg[_i].x = __uint_as_float(_t.x); breg[_i].y = __uint_as_float(_t.y); } \
            else breg[_i] = *(const float4*)(bp + (size_t)(bK * 64 + kb + 16 * _i) * ldb); } \
        if (++bK == nk) { bK = 0; ++bP; if (bP < npass) bp = bcol(bP, n4); } } while (0)
#define GS_WRITE_B(breg, buf) do { _Pragma("unroll") for (int _i = 0; _i < 4; ++_i) { u32x2 _w; \
            if constexpr (BBF16) { _w.x = __float_as_uint(breg[_i].x); _w.y = __float_as_uint(breg[_i].y); } \
            else { _w.x = pk_bf16(breg[_i].x, breg[_i].y); _w.y = pk_bf16(breg[_i].z, breg[_i].w); } \
        *(LAS u32x2*)(lds + GEMM_LDS_B + (buf) * 16384 + bwoff + 4096 * _i) = _w; } } while (0)
#define GS_COMPUTE(buf) do { _Pragma("unroll") for (int ks = 0; ks < 2; ++ks) { \
            bf16x8 af[4]; s16x4 tl0, tl1, tl2, tl3, th0, th1, th2, th3; \
            LAS unsigned char* bb_ = lds + GEMM_LDS_B + (buf) * 16384 + ks * 8192; \
            tl0 = tr_read(bb_ + GS_BOFF(0)); th0 = tr_read(bb_ + 1024 + GS_BOFF(1)); tl1 = tr_read(bb_ + GS_BOFF(2)); th1 = tr_read(bb_ + 1024 + GS_BOFF(3)); \
            tl2 = tr_read(bb_ + GS_BOFF(4)); th2 = tr_read(bb_ + 1024 + GS_BOFF(5)); tl3 = tr_read(bb_ + GS_BOFF(6)); th3 = tr_read(bb_ + 1024 + GS_BOFF(7)); \
            _Pragma("unroll") for (int mi = 0; mi < 4; ++mi) af[mi] = *(const LAS bf16x8*)(lds + GEMM_LDS_A + (buf) * 32768 + aoff + mi * 2048 + ks * 1024); \
            TR_WAIT8(tl0, th0, tl1, th1, tl2, th2, tl3, th3); \
            bf16x8 bfr[4]; \
            bfr[0] = (bf16x8){tl0[0], tl0[1], tl0[2], tl0[3], th0[0], th0[1], th0[2], th0[3]}; bfr[1] = (bf16x8){tl1[0], tl1[1], tl1[2], tl1[3], th1[0], th1[1], th1[2], th1[3]}; \
            bfr[2] = (bf16x8){tl2[0], tl2[1], tl2[2], tl2[3], th2[0], th2[1], th2[2], th2[3]}; bfr[3] = (bf16x8){tl3[0], tl3[1], tl3[2], tl3[3], th3[0], th3[1], th3[2], th3[3]}; \
            _Pragma("unroll") for (int mi = 0; mi < 4; ++mi) _Pragma("unroll") for (int ni = 0; ni < 4; ++ni) \
                acc[mi][ni] = __builtin_amdgcn_mfma_f32_16x16x32_bf16(bfr[ni], af[mi], acc[mi][ni], 0, 0, 0); } } while (0)
#define GS_STEP(CUR, NXT, BREG_LD, BREG_WR) do { \
        if (MODE != 2 && s + DEPTH < S) GS_LOAD_B(BREG_LD); \
        if (MODE != 3 && s + 1 < S) GS_ISSUE_A(NXT); \
        __builtin_amdgcn_sched_barrier(0); \
        if (MODE != 1 && active) GS_COMPUTE(CUR); \
        __builtin_amdgcn_sched_barrier(0); \
        if (s + 1 < S) GS_WRITE_B(BREG_WR, NXT); \
        const bool pass_end = (cK + 1 == nk); \
        if (++cK == nk) { \
            if constexpr (TILE_EPI) { if (active) epi(cP, wr * 64 + fr, wc * 64 + fq * 4, cm, acc); } else \
            if (active) { \
                _Pragma("unroll") for (int mi = 0; mi < 4; ++mi) { const int r = wr * 64 + mi * 16 + fr; \
                    if (r < cm) { \
                        if constexpr (PAIR) { _Pragma("unroll") for (int ni = 0; ni < 2; ++ni) { epi(cP, r, wc * 64 + ni * 16 + fq * 4, acc[mi][ni], acc[mi][ni + 2]); } } \
                        else { _Pragma("unroll") for (int ni = 0; ni < 4; ++ni) { epi(cP, r, wc * 64 + ni * 16 + fq * 4, acc[mi][ni]); } } } } } \
            _Pragma("unroll") for (int i = 0; i < 4; ++i) _Pragma("unroll") for (int j = 0; j < 4; ++j) acc[i][j] = (f32x4){0.f, 0.f, 0.f, 0.f}; \
            cK = 0; ++cP; if (cP < npass) { cm = mrowsf(cP); active = (wr * 64) < cm; } \
        } \
        asm volatile("s_waitcnt lgkmcnt(0)" ::: "memory"); \
        if (DEPTH >= 2 && (s + DEPTH < S) && !pass_end) asm volatile("s_waitcnt vmcnt(4)" ::: "memory"); else asm volatile("s_waitcnt vmcnt(0)" ::: "memory"); \
        asm volatile("" ::: "memory"); __builtin_amdgcn_s_barrier(); asm volatile("" ::: "memory"); ++s; } while (0)
    int cP = 0, cK = 0, cm = mrowsf(0);
    bool active = (wr * 64) < cm;
    GS_SETA(); bp = bcol(0, n4);
    GS_ISSUE_A(0); GS_LOAD_B(bregX);
    GS_WRITE_B(bregX, 0);
    if constexpr (DEPTH >= 2) { if (1 < S) GS_LOAD_B(bregY); }
    static_assert(DEPTH == 1 || DEPTH == 2, "B prefetch depth");
    asm volatile("s_waitcnt lgkmcnt(0)" ::: "memory");
    asm volatile("s_waitcnt vmcnt(%0)" :: "n"((DEPTH - 1) * 4) : "memory");
    __syncthreads();
    int s = 0;
    if constexpr (DEPTH == 1) {
        while (s < S) { GS_STEP(0, 1, bregX, bregX); if (s >= S) break; GS_STEP(1, 0, bregX, bregX); }
    } else if constexpr (DEPTH == 2) {
        while (s < S) { GS_STEP(0, 1, bregX, bregY); if (s >= S) break; GS_STEP(1, 0, bregY, bregX); }
    }
#undef GS_SETA
#undef GS_BOFF
#undef GS_ISSUE_A
#undef GS_LOAD_B
#undef GS_WRITE_B
#undef GS_COMPUTE
#undef GS_STEP
}


template <class ARow, class BCol, class MRows, class Epi>
__device__ __forceinline__ void gemm_stream_rs(LAS unsigned char* lds, const unsigned char* Abase, int npass, int nk, int ldb, ARow arow, BCol bcol, MRows mrowsf, Epi epi) {
    int tid_ = threadIdx.x; asm volatile("" : "+v"(tid_));
    const int tid = tid_, wid = __builtin_amdgcn_readfirstlane(tid >> 6), lane = tid & 63;
    const int wr = wid >> 1, wc = wid & 1, fr = lane & 15, fq = lane >> 4;
    if (npass <= 0) return;
    const int S = npass * nk;
    const int Ccol = ((wid & 1) * 32 + 8 * ((lane & 3) ^ ((lane >> 5) << 1))) * 2;
    const int Rbase = 16 * (wid >> 1) + (lane >> 2);
    unsigned asrc[4];
    const int n4 = tid & 31, kb = tid >> 5;
    const float* bp;
    const int fB = ((kb & 3) << 2) | ((kb >> 2) & 3);
    const int bwoff = 256 * kb + 16 * ((n4 >> 1) ^ fB) + 8 * (n4 & 1);
    const int awoff = wid * 1024 + lane * 16;
    const int aoff = wr * 8192 + ((fr * 64 + fq * 16) ^ ((fr >> 3) << 5));
    const int q = (lane >> 2) & 3, pp = lane & 3;
    const int b0 = (wc * 8 + (pp >> 1)) ^ ((q << 2) | (2 * (fq & 1)));
    const int browoff = 256 * (fq * 8 + q) + 8 * (pp & 1);
#define RS_BOFF(v) (browoff + 16 * (b0 ^ (v)))
    f32x4 acc[4][4];
#pragma unroll
    for (int i = 0; i < 4; ++i)
#pragma unroll
        for (int j = 0; j < 4; ++j) acc[i][j] = (f32x4){0.f, 0.f, 0.f, 0.f};
    f32x4 bX[4], bY[4]; u32x4 aX[4], aY[4];
    int aP = 0, aK = 0, bP = 0, bK = 0;
#define RS_SETA() do { _Pragma("unroll") for (int _i = 0; _i < 4; ++_i) asrc[_i] = (unsigned)(arow(aP, Rbase + 64 * _i) + Ccol); } while (0)
#define RS_LOAD(AR, BR) do { \
        _Pragma("unroll") for (int _i = 0; _i < 4; ++_i) AR[_i] = *(const u32x4*)(Abase + (size_t)asrc[_i] + (size_t)aK * 128); \
        _Pragma("unroll") for (int _i = 0; _i < 4; ++_i) BR[_i] = *(const f32x4*)(bp + (size_t)(bK * 64 + kb + 16 * _i) * ldb); \
        if (++aK == nk) { aK = 0; if (aP + 1 < npass) { ++aP; RS_SETA(); } } \
        if (++bK == nk) { bK = 0; if (bP + 1 < npass) { ++bP; bp = bcol(bP, n4); } } } while (0)
#define RS_WRITE(AR, BR, buf) do { \
        _Pragma("unroll") for (int _i = 0; _i < 4; ++_i) *(LAS u32x4*)(lds + GEMM_LDS_A + (buf) * 32768 + _i * 8192 + awoff) = AR[_i]; \
        _Pragma("unroll") for (int _i = 0; _i < 4; ++_i) { u32x2 _w; _w.x = pk_bf16(BR[_i][0], BR[_i][1]); _w.y = pk_bf16(BR[_i][2], BR[_i][3]); \
            *(LAS u32x2*)(lds + GEMM_LDS_B + (buf) * 16384 + bwoff + 4096 * _i) = _w; } } while (0)
#define RS_COMPUTE(buf) do { _Pragma("unroll") for (int ks = 0; ks < 2; ++ks) { \
            bf16x8 af[4]; s16x4 tl0, tl1, tl2, tl3, th0, th1, th2, th3; \
            LAS unsigned char* bb_ = lds + GEMM_LDS_B + (buf) * 16384 + ks * 8192; \
            tl0 = tr_read(bb_ + RS_BOFF(0)); th0 = tr_read(bb_ + 1024 + RS_BOFF(1)); tl1 = tr_read(bb_ + RS_BOFF(2)); th1 = tr_read(bb_ + 1024 + RS_BOFF(3)); \
            tl2 = tr_read(bb_ + RS_BOFF(4)); th2 = tr_read(bb_ + 1024 + RS_BOFF(5)); tl3 = tr_read(bb_ + RS_BOFF(6)); th3 = tr_read(bb_ + 1024 + RS_BOFF(7)); \
            _Pragma("unroll") for (int mi = 0; mi < 4; ++mi) af[mi] = *(const LAS bf16x8*)(lds + GEMM_LDS_A + (buf) * 32768 + aoff + mi * 2048 + ks * 1024); \
            TR_WAIT8(tl0, th0, tl1, th1, tl2, th2, tl3, th3); \
            bf16x8 bfr[4]; \
            bfr[0] = (bf16x8){tl0[0], tl0[1], tl0[2], tl0[3], th0[0], th0[1], th0[2], th0[3]}; bfr[1] = (bf16x8){tl1[0], tl1[1], tl1[2], tl1[3], th1[0], th1[1], th1[2], th1[3]}; \
            bfr[2] = (bf16x8){tl2[0], tl2[1], tl2[2], tl2[3], th2[0], th2[1], th2[2], th2[3]}; bfr[3] = (bf16x8){tl3[0], tl3[1], tl3[2], tl3[3], th3[0], th3[1], th3[2], th3[3]}; \
            _Pragma("unroll") for (int mi = 0; mi < 4; ++mi) _Pragma("unroll") for (int ni = 0; ni < 4; ++ni) \
                acc[mi][ni] = __builtin_amdgcn_mfma_f32_16x16x32_bf16(bfr[ni], af[mi], acc[mi][ni], 0, 0, 0); } } while (0)
#define RS_STEP(CUR, NXT, A_LD, B_LD, A_WR, B_WR) do { \
        RS_LOAD(A_LD, B_LD); \
        __builtin_amdgcn_sched_barrier(0); \
        if (active) RS_COMPUTE(CUR); \
        __builtin_amdgcn_sched_barrier(0); \
        RS_WRITE(A_WR, B_WR, NXT); \
        if (++cK == nk) { \
            if (active) epi(cP, wr * 64 + fr, wc * 64 + fq * 4, cm, acc); \
            _Pragma("unroll") for (int i = 0; i < 4; ++i) _Pragma("unroll") for (int j = 0; j < 4; ++j) acc[i][j] = (f32x4){0.f, 0.f, 0.f, 0.f}; \
            cK = 0; ++cP; if (cP < npass) { cm = mrowsf(cP); active = (wr * 64) < cm; } \
        } \
        asm volatile("s_waitcnt lgkmcnt(0)" ::: "memory"); \
        asm volatile("" ::: "memory"); __builtin_amdgcn_s_barrier(); asm volatile("" ::: "memory"); ++s; } while (0)
    int cP = 0, cK = 0, cm = mrowsf(0);
    bool active = (wr * 64) < cm;
    RS_SETA(); bp = bcol(0, n4);
    RS_LOAD(aX, bX); RS_WRITE(aX, bX, 0);
    RS_LOAD(aY, bY);
    asm volatile("s_waitcnt lgkmcnt(0)" ::: "memory");
    __syncthreads();
    int s = 0;
    while (s < S) { RS_STEP(0, 1, aX, bX, aY, bY); if (s >= S) break; RS_STEP(1, 0, aY, bY, aX, bX); }
#undef RS_BOFF
#undef RS_SETA
#undef RS_LOAD
#undef RS_WRITE
#undef RS_COMPUTE
#undef RS_STEP
}

namespace pg8 {
#define PG8_LAS __attribute__((address_space(3)))
typedef unsigned short bf16_t;
typedef short bf16x8 __attribute__((ext_vector_type(8)));
typedef float f32x4 __attribute__((ext_vector_type(4)));
typedef unsigned u32x4 __attribute__((ext_vector_type(4)));
constexpr int BM = 256, BK = 64, HALF = 128, HTB = HALF * BK * 2  , STAGE_BYTES = 8 * HTB, NXCD = 8, WGM = 8;

__host__ __device__ __forceinline__ int lds_byte(int r, int c) { const int st = (r >> 4) * 2 + (c >> 5), rr = r & 15, cc = c & 31, ob = rr * 64 + cc * 2; return st * 1024 + (ob ^ (((ob >> 9) & 1) << 5)); }
__host__ __device__ __forceinline__ void stage_rc(int b, int& R, int& C) { const int st = b / 1024, sb = b % 1024, swz = sb ^ (((sb >> 9) & 1) << 5); R = (st >> 1) * 16 + swz / 64; C = (st & 1) * 32 + (swz % 64) / 2; }
__host__ __device__ __forceinline__ int perm32(int rho) { const int n = rho >> 4, i = rho & 15; return 8 * (i >> 2) + 4 * n + (i & 3); }

struct Unit { int pm, pn; };
struct Gemm { const bf16_t* A; const bf16_t* Bt; int M, N, K; };

struct StaticOrder {
    int nM, nN, nwg, G, c;
    __host__ __device__ void init(int M, int N, int G_, int c_) { nM = M / BM; nN = N / BM; nwg = nM * nN; G = G_; c = c_; }
    __host__ __device__ bool next(int i, Unit& u) const {
        const long L = (long)i * G + c; if (L >= nwg) return false;
        int wgid = (int)L; { const int q = nwg / NXCD, r = nwg % NXCD, xcd = wgid % NXCD, off = wgid / NXCD; wgid = (xcd < r ? xcd * (q + 1) : r * (q + 1) + (xcd - r) * q) + off; }
        const int nig = WGM * nN, gid = wgid / nig, fm = gid * WGM, gsz = (nM - fm) < WGM ? (nM - fm) : WGM;
        u.pm = fm + ((wgid % nig) % gsz); u.pn = (wgid % nig) / gsz; return true;
    }
    __device__ __forceinline__ void a_ready(const Unit&) const {}
    __device__ __forceinline__ void done(const Unit&) const {}
};
template <class Epi, class Sched>
__device__ __forceinline__ void gemm_phase(PG8_LAS unsigned char* lds, const Gemm g, const Sched& S, const Epi& E) {
    int tid_l = threadIdx.x; asm volatile("" : "+v"(tid_l));
    const int tid = tid_l, wid = __builtin_amdgcn_readfirstlane(tid >> 6), lane = tid & 63, wr = wid >> 2, wc = wid & 3, fr = lane & 15, fq = lane >> 4;
    const int K = g.K, nt = K / BK;

    unsigned voffA[2], voffB[2];
#pragma unroll
    for (int i = 0; i < 2; ++i) { int R, C; stage_rc(tid * 16 + i * 8192, R, C); const int Rb = Epi::PERM ? ((R & ~31) + perm32(R & 31)) : R;
        voffA[i] = (unsigned)(R * K + C) * 2u; voffB[i] = (unsigned)(Rb * K + C) * 2u; }
    const size_t kstep = (size_t)(BK * 2);
    const size_t hstep = (size_t)HALF * K * 2;
    const size_t tstep = 2 * hstep;
    const unsigned ldsw = (unsigned)wid * 1024u;
    const int aoff = lds_byte(wr * 64 + fr, fq * 8), boff = lds_byte(wc * 32 + fr, fq * 8);
#define PG8_SA(b, h) (((b) * 2 + (h)) * HTB)
#define PG8_SB(b, h) ((4 + (b) * 2 + (h)) * HTB)
#define PG8_STAGE(bufoff, gbase, voff) do { _Pragma("unroll") for (int _i = 0; _i < 2; ++_i) \
        __builtin_amdgcn_global_load_lds((const unsigned*)((const char*)(gbase) + (voff)[_i]), (PG8_LAS unsigned*)(lds + (bufoff) + ldsw + _i * 8192), 16, 0, 0); } while (0)
#define PG8_LDA(dst, b, h) do { _Pragma("unroll") for (int m = 0; m < 4; ++m) _Pragma("unroll") for (int k = 0; k < 2; ++k) dst[m][k] = *(const PG8_LAS bf16x8*)(lds + PG8_SA(b, h) + aoff + m * 2048 + k * 1024); } while (0)
#define PG8_LDB(dst, b, h) do { _Pragma("unroll") for (int n = 0; n < 2; ++n) _Pragma("unroll") for (int k = 0; k < 2; ++k) dst[n][k] = *(const PG8_LAS bf16x8*)(lds + PG8_SB(b, h) + boff + n * 2048 + k * 1024); } while (0)
#define PG8_MMA(ai, bj, At, Bt) do { __builtin_amdgcn_s_setprio(1); _Pragma("unroll") for (int m = 0; m < 4; ++m) _Pragma("unroll") for (int n = 0; n < 2; ++n) _Pragma("unroll") for (int k = 0; k < 2; ++k) \
        acc[ai][bj][m][n] = __builtin_amdgcn_mfma_f32_16x16x32_bf16(Bt[n][k], At[m][k], acc[ai][bj][m][n], 0, 0, 0); __builtin_amdgcn_s_setprio(0); } while (0)
#define PG8_WAIT_V(n) asm volatile("s_waitcnt vmcnt(" #n ")" ::: "memory")
#define PG8_WAIT_L(n) asm volatile("s_waitcnt lgkmcnt(" #n ")" ::: "memory")
#define PG8_BAR __builtin_amdgcn_s_barrier()
#define PG8_SCHED __builtin_amdgcn_sched_barrier(0)
    Unit cur, nxt; int ui = 0;
    if (!S.next(0, cur)) return;
    f32x4 acc[2][2][4][2];
#pragma unroll
    for (int a = 0; a < 2; ++a)
#pragma unroll
        for (int b = 0; b < 2; ++b)
#pragma unroll
            for (int m = 0; m < 4; ++m)
#pragma unroll
                for (int n = 0; n < 2; ++n) acc[a][b][m][n] = (f32x4){0.f, 0.f, 0.f, 0.f};
    bf16x8 At[4][2], B0[2][2], B1[2][2];
    const char* cA = (const char*)g.A + (size_t)cur.pm * tstep; const char* cB = (const char*)g.Bt + (size_t)cur.pn * tstep;
    S.a_ready(cur);
    PG8_STAGE(PG8_SB(0, 0), cB, voffB); PG8_STAGE(PG8_SA(0, 0), cA, voffA); PG8_STAGE(PG8_SB(0, 1), cB + hstep, voffB); PG8_STAGE(PG8_SA(0, 1), cA + hstep, voffA);
    if (wr == 1) PG8_BAR;
    PG8_WAIT_V(4); PG8_BAR;
    PG8_STAGE(PG8_SB(1, 0), cB + kstep, voffB); PG8_STAGE(PG8_SA(1, 0), cA + kstep, voffA); PG8_STAGE(PG8_SB(1, 1), cB + hstep + kstep, voffB);
    PG8_WAIT_V(6); PG8_BAR;

    for (;;) {
        const bool has_next = S.next(ui + 1, nxt);
        const char* nA = has_next ? (const char*)g.A + (size_t)nxt.pm * tstep : cA; const char* nB = has_next ? (const char*)g.Bt + (size_t)nxt.pn * tstep : cB;
        for (int t = 0; t < nt; t += 2) {
            const bool last = (t == nt - 2);
            const char* a1 = cA + (size_t)(t + 1) * kstep;
            const char* a2 = last ? nA : cA + (size_t)(t + 2) * kstep; const char* b2 = last ? nB : cB + (size_t)(t + 2) * kstep;
            const char* a3 = a2 + kstep; const char* b3 = b2 + kstep;
            if (last && has_next) S.a_ready(nxt);
            PG8_LDB(B0, 0, 0); PG8_SCHED; PG8_LDA(At, 0, 0); PG8_STAGE(PG8_SA(1, 1), a1 + hstep, voffA);
            PG8_WAIT_L(8); PG8_BAR; PG8_WAIT_L(0); PG8_MMA(0, 0, At, B0); PG8_BAR; PG8_SCHED;
            PG8_LDB(B1, 0, 1); PG8_STAGE(PG8_SB(0, 0), b2, voffB);
            PG8_BAR; PG8_WAIT_L(0); PG8_MMA(0, 1, At, B1); PG8_BAR;
            PG8_LDA(At, 0, 1); PG8_STAGE(PG8_SA(0, 0), a2, voffA);
            PG8_BAR; PG8_WAIT_L(0); PG8_MMA(1, 0, At, B0); PG8_BAR; PG8_SCHED;
            PG8_STAGE(PG8_SB(0, 1), b2 + hstep, voffB);
            PG8_WAIT_V(6); PG8_BAR; PG8_MMA(1, 1, At, B1); PG8_BAR;
            PG8_LDB(B0, 1, 0); PG8_SCHED; PG8_LDA(At, 1, 0); PG8_STAGE(PG8_SA(0, 1), a2 + hstep, voffA);
            PG8_WAIT_L(8); PG8_BAR; PG8_WAIT_L(0); PG8_MMA(0, 0, At, B0); PG8_BAR; PG8_SCHED;
            PG8_LDB(B1, 1, 1); PG8_STAGE(PG8_SB(1, 0), b3, voffB);
            PG8_BAR; PG8_WAIT_L(0); PG8_MMA(0, 1, At, B1); PG8_BAR;
            PG8_LDA(At, 1, 1); PG8_STAGE(PG8_SA(1, 0), a3, voffA);
            PG8_BAR; PG8_WAIT_L(0); PG8_MMA(1, 0, At, B0); PG8_BAR; PG8_SCHED;
            PG8_STAGE(PG8_SB(1, 1), b3 + hstep, voffB);
            PG8_WAIT_V(6); PG8_BAR; PG8_MMA(1, 1, At, B1); PG8_BAR;
        }

        if constexpr (!Epi::AFTER_DRAIN) { E(acc, cur, wr, wc, fr, fq); S.done(cur); }

        if (!has_next) break;
#pragma unroll
        for (int a = 0; a < 2; ++a)
#pragma unroll
            for (int b = 0; b < 2; ++b)
#pragma unroll
                for (int m = 0; m < 4; ++m)
#pragma unroll
                    for (int n = 0; n < 2; ++n) acc[a][b][m][n] = (f32x4){0.f, 0.f, 0.f, 0.f};
        cur = nxt; cA = nA; cB = nB; ++ui;
    }
    PG8_WAIT_V(0);
    if (wr == 0) PG8_BAR;
    PG8_BAR;
    if constexpr (Epi::AFTER_DRAIN) { E.fused(acc, cur, wr, wc, fr, fq, lds, wid, lane); S.done(cur); }

#undef PG8_SA
#undef PG8_SB
#undef PG8_STAGE
#undef PG8_LDA
#undef PG8_LDB
#undef PG8_MMA
#undef PG8_WAIT_V
#undef PG8_WAIT_L
#undef PG8_BAR
#undef PG8_SCHED
}
}
template <class F> struct EpiWrap {
    static constexpr bool PERM = false, AFTER_DRAIN = false; F f;
    __device__ __forceinline__ void operator()(const f32x4 (&acc)[2][2][4][2], const pg8::Unit& u, int wr, int wc, int fr, int fq) const { f(acc, u, wr, wc, fr, fq); }
};
template <class F> __device__ __forceinline__ EpiWrap<F> make_epi(F f) { return EpiWrap<F>{f}; }
template <class F> struct EpiWrapP {
    static constexpr bool PERM = true, AFTER_DRAIN = false; F f;
    __device__ __forceinline__ void operator()(const f32x4 (&acc)[2][2][4][2], const pg8::Unit& u, int wr, int wc, int fr, int fq) const { f(acc, u, wr, wc, fr, fq); }
};
template <class F> __device__ __forceinline__ EpiWrapP<F> make_epi_p(F f) { return EpiWrapP<F>{f}; }

__device__ __forceinline__ void transpose_item(const float* W, int K, int N, int Npad, bf16_t* WT, LAS float* scr, int item, int lane) {
    const int nblk = Npad / 32, kb = item / nblk, nb_ = item % nblk, k0 = 64 * kb, n0 = 32 * nb_;
#pragma unroll 8
    for (int i = 0; i < 32; ++i) { const int kk = 2 * i + (lane >> 5), n = n0 + (lane & 31); scr[kk * 33 + (lane & 31)] = n < N ? W[(size_t)(k0 + kk) * N + n] : 0.f; }
    asm volatile("s_waitcnt lgkmcnt(0)" ::: "memory");
    const int c = lane & 7;
#pragma unroll
    for (int j = 0; j < 4; ++j) { const int n = (lane >> 3) + 8 * j; const LAS float* sp = scr + (8 * c) * 33 + n;
        u32x4 o; o[0] = pk_bf16(sp[0 * 33], sp[1 * 33]); o[1] = pk_bf16(sp[2 * 33], sp[3 * 33]); o[2] = pk_bf16(sp[4 * 33], sp[5 * 33]); o[3] = pk_bf16(sp[6 * 33], sp[7 * 33]);
        *(u32x4*)(WT + (size_t)(n0 + n) * K + k0 + 8 * c) = o; }
    asm volatile("s_waitcnt lgkmcnt(0)" ::: "memory");
}

template <class ARow, class BCol, class MRows, class Epi>
__device__ __forceinline__ void gemm_stream_ws(LAS unsigned char* lds, const unsigned char* Abase, int npass, int nk, int ldb, ARow arow, BCol bcol, MRows mrowsf, Epi epi) {
    int tid_ = threadIdx.x; asm volatile("" : "+v"(tid_));
    const int tid = tid_, wid = __builtin_amdgcn_readfirstlane(tid >> 6), lane = tid & 63;
    if (npass <= 0) return;
    const int S = npass * nk;
#define WS_BAR() do { asm volatile("s_waitcnt lgkmcnt(0)" ::: "memory"); __builtin_amdgcn_s_barrier(); asm volatile("" ::: "memory"); } while (0)
    if (wid < 4) {
        const int wr2 = wid >> 1, wc = wid & 1, fr = lane & 15, fq = lane >> 4;
        const int aoff = wr2 * 16384 + ((fr * 64 + fq * 16) ^ ((fr >> 3) << 5));
        const int q = (lane >> 2) & 3, pp = lane & 3;
        const int b0 = (wc * 8 + (pp >> 1)) ^ ((q << 2) | (2 * (fq & 1)));
        const int browoff = 256 * (fq * 8 + q) + 8 * (pp & 1);
#define WS_BOFF(v) (browoff + 16 * (b0 ^ (v)))
        f32x4 acc[8][4];
#pragma unroll
        for (int i = 0; i < 8; ++i)
#pragma unroll
            for (int j = 0; j < 4; ++j) acc[i][j] = (f32x4){0.f, 0.f, 0.f, 0.f};
        int cP = 0, cK = 0, cm = mrowsf(0);
        bool active = (wr2 * 128) < cm;
#define WS_COMPUTE(buf) do { _Pragma("unroll") for (int ks = 0; ks < 2; ++ks) { \
            bf16x8 af[8]; s16x4 tl0, tl1, tl2, tl3, th0, th1, th2, th3; \
            LAS unsigned char* bb_ = lds + GEMM_LDS_B + (buf) * 16384 + ks * 8192; \
            tl0 = tr_read(bb_ + WS_BOFF(0)); th0 = tr_read(bb_ + 1024 + WS_BOFF(1)); tl1 = tr_read(bb_ + WS_BOFF(2)); th1 = tr_read(bb_ + 1024 + WS_BOFF(3)); \
            tl2 = tr_read(bb_ + WS_BOFF(4)); th2 = tr_read(bb_ + 1024 + WS_BOFF(5)); tl3 = tr_read(bb_ + WS_BOFF(6)); th3 = tr_read(bb_ + 1024 + WS_BOFF(7)); \
            _Pragma("unroll") for (int mi = 0; mi < 8; ++mi) af[mi] = *(const LAS bf16x8*)(lds + GEMM_LDS_A + (buf) * 32768 + aoff + mi * 2048 + ks * 1024); \
            TR_WAIT8(tl0, th0, tl1, th1, tl2, th2, tl3, th3); \
            bf16x8 bfr[4]; \
            bfr[0] = (bf16x8){tl0[0], tl0[1], tl0[2], tl0[3], th0[0], th0[1], th0[2], th0[3]}; bfr[1] = (bf16x8){tl1[0], tl1[1], tl1[2], tl1[3], th1[0], th1[1], th1[2], th1[3]}; \
            bfr[2] = (bf16x8){tl2[0], tl2[1], tl2[2], tl2[3], th2[0], th2[1], th2[2], th2[3]}; bfr[3] = (bf16x8){tl3[0], tl3[1], tl3[2], tl3[3], th3[0], th3[1], th3[2], th3[3]}; \
            _Pragma("unroll") for (int mi = 0; mi < 8; ++mi) _Pragma("unroll") for (int ni = 0; ni < 4; ++ni) \
                acc[mi][ni] = __builtin_amdgcn_mfma_f32_16x16x32_bf16(bfr[ni], af[mi], acc[mi][ni], 0, 0, 0); } } while (0)
#define WS_CSTEP(CUR) do { \
            if (active) WS_COMPUTE(CUR); \
            if (++cK == nk) { \
                if (active) epi(cP, wr2 * 128 + fr, wc * 64 + fq * 4, cm, acc); \
                _Pragma("unroll") for (int i = 0; i < 8; ++i) _Pragma("unroll") for (int j = 0; j < 4; ++j) acc[i][j] = (f32x4){0.f, 0.f, 0.f, 0.f}; \
                cK = 0; ++cP; if (cP < npass) { cm = mrowsf(cP); active = (wr2 * 128) < cm; } \
            } \
            WS_BAR(); ++s; } while (0)
        WS_BAR();
        int s = 0;
        while (s < S) { WS_CSTEP(0); if (s >= S) break; WS_CSTEP(1); }
#undef WS_BOFF
#undef WS_COMPUTE
#undef WS_CSTEP
    } else {
        const int pt = tid - 256;
        const int Ccol = (((pt >> 6) & 1) * 32 + 8 * ((lane & 3) ^ ((lane >> 5) << 1))) * 2;
        const int Rbase = 16 * (pt >> 7) + (lane >> 2);
        unsigned asrc[8];
        const int n4 = pt & 31, kb8 = pt >> 5;
        const float* bp;
        int bwoff[2];
#pragma unroll
        for (int par = 0; par < 2; ++par) { const int row = kb8 + 8 * par; const int fB = ((row & 3) << 2) | ((row >> 2) & 3); bwoff[par] = 256 * row + 16 * ((n4 >> 1) ^ fB) + 8 * (n4 & 1); }
        const int awoff = pt * 16;
        f32x4 bX[8], bY[8]; u32x4 aX[8], aY[8];
        int aP = 0, aK = 0, bP = 0, bK = 0;
#define WS_SETA() do { _Pragma("unroll") for (int _i = 0; _i < 8; ++_i) asrc[_i] = (unsigned)(arow(aP, Rbase + 32 * _i) + Ccol); } while (0)
#define WS_LOAD(AR, BR) do { \
            _Pragma("unroll") for (int _i = 0; _i < 8; ++_i) AR[_i] = *(const u32x4*)(Abase + (size_t)asrc[_i] + (size_t)aK * 128); \
            _Pragma("unroll") for (int _i = 0; _i < 8; ++_i) BR[_i] = *(const f32x4*)(bp + (size_t)(bK * 64 + kb8 + 8 * _i) * ldb); \
            if (++aK == nk) { aK = 0; if (aP + 1 < npass) { ++aP; WS_SETA(); } } \
            if (++bK == nk) { bK = 0; if (bP + 1 < npass) { ++bP; bp = bcol(bP, n4); } } } while (0)
#define WS_WRITE(AR, BR, buf) do { \
            _Pragma("unroll") for (int _i = 0; _i < 8; ++_i) *(LAS u32x4*)(lds + GEMM_LDS_A + (buf) * 32768 + _i * 4096 + awoff) = AR[_i]; \
            _Pragma("unroll") for (int _i = 0; _i < 8; ++_i) { u32x2 _w; _w.x = pk_bf16(BR[_i][0], BR[_i][1]); _w.y = pk_bf16(BR[_i][2], BR[_i][3]); \
                *(LAS u32x2*)(lds + GEMM_LDS_B + (buf) * 16384 + bwoff[_i & 1] + 4096 * (_i >> 1)) = _w; } } while (0)
#define WS_PSTEP(NXT, A_LD, B_LD, A_WR, B_WR) do { WS_LOAD(A_LD, B_LD); WS_WRITE(A_WR, B_WR, NXT); WS_BAR(); ++s; } while (0)
        WS_SETA(); bp = bcol(0, n4);
        WS_LOAD(aX, bX); WS_WRITE(aX, bX, 0);
        WS_LOAD(aY, bY);
        WS_BAR();
        int s = 0;
        while (s < S) { WS_PSTEP(1, aX, bX, aY, bY); if (s >= S) break; WS_PSTEP(0, aY, bY, aX, bX); }
#undef WS_SETA
#undef WS_LOAD
#undef WS_WRITE
#undef WS_PSTEP
    }
#undef WS_BAR
}

struct XcdDeal { int lo, step, n; };
#define TOPO_OFF (LDS_MISC + 16)
__device__ __forceinline__ XcdDeal xcd_deal(int U, const LAS unsigned char* lds, int nb) {
    const LAS int* tp_ = (const LAS int*)(lds + TOPO_OFF);
    const int px = tp_[0], cx = tp_[1], rank = tp_[2];
    XcdDeal d;
    const int xlo = (int)((long)px * U / nb), xhi = (int)((long)(px + cx) * U / nb);
    d.lo = xlo + rank; d.step = cx; d.n = (xhi - xlo - rank + cx - 1) / cx; if (d.n < 0) d.n = 0;
    return d;
}

__device__ __forceinline__ void phase0(const Params& p, int bid, int nb, float* smem, LAS unsigned char* smem_las) {
    const float* c = p.in[1]; const float* w_ada = p.in[2]; const float* b_ada = p.in[3];
    float* mod = (float*)(p.ws + WS_MOD);
    const int tid = threadIdx.x;
    float* sc = smem;
    float* red = smem + 2048;
    for (int i = tid; i < 2048; i += NT) { const float cv = c[i]; sc[i] = cv / (1.f + expf(-cv)); }
    __syncthreads();
    const int jl = tid & 63, kg = tid >> 6;
    for (int u = bid; u < 96; u += nb) {
        const int j = u * 64 + jl;
        float a0 = 0.f, a1 = 0.f;
#pragma unroll 8
        for (int k = kg * 128; k < kg * 128 + 128; ++k) { const float w = w_ada[(size_t)k * 6144 + j]; a0 += sc[k] * w; a1 += sc[1024 + k] * w; }
        red[(kg * 2 + 0) * 64 + jl] = a0; red[(kg * 2 + 1) * 64 + jl] = a1;
        __syncthreads();
        if (tid < 128) {
            const int bb = tid >> 6; float sacc = 0.f;
#pragma unroll
            for (int g2 = 0; g2 < 8; ++g2) sacc += red[(g2 * 2 + bb) * 64 + jl];
            mod[bb * 6144 + j] = sacc + b_ada[j];
        }
        __syncthreads();
    }
    {
        const float* conv_w = p.in[12]; const float* conv_b = p.in[13]; const float* wa = p.in[14]; const float* ba = p.in[15]; const float* wx = p.in[16]; const float* bx = p.in[17];
        float* BG = (float*)(p.ws + WS_BG); float* GB = (float*)(p.ws + WS_GBIAS);
        for (int idx = bid * NT + tid; idx < 8 * 256 * 128; idx += nb * NT) {
            const int n = idx & 127, k = (idx >> 7) & 255, hb = idx >> 15;
            const int w = k >> 6, i = k & 63, j = (n >> 6) * 32 + ((n >> 4) & 1) * 16 + (n & 15);
            const float* W = ((n >> 5) & 1) ? wx : wa;
            BG[idx] = conv_w[w * 512 + hb * 64 + i] * W[(hb * 64 + i) * 64 + j];
        }
        for (int idx = bid * NT + tid; idx < 8 * 128; idx += nb * NT) {
            const int n = idx & 127, hb = idx >> 7, j = (n >> 6) * 32 + ((n >> 4) & 1) * 16 + (n & 15);
            const bool isx = (n >> 5) & 1; const float* W = isx ? wx : wa;
            float acc = isx ? bx[hb * 64 + j] : ba[hb * 64 + j];
            for (int i = 0; i < 64; ++i) acc += conv_b[hb * 64 + i] * W[(hb * 64 + i) * 64 + j];
            GB[idx] = acc;
        }
        float* CB = (float*)(p.ws + WS_CBIAS); const float* pos = p.in[6];
        for (int idx = bid * NW + (tid >> 6); idx < 128; idx += nb * NW) {
            const int kv = idx >> 6, j = idx & 63; const float* w1 = kv ? p.in[9] : p.in[7];
            float acc = 0.f;
#pragma unroll 8
            for (int k = (tid & 63); k < 2048; k += 64) acc += pos[k] * w1[(size_t)k * 64 + j];
            acc = wave_sum(acc);
            if ((tid & 63) == 0) CB[idx] = acc;
        }
        bf16_t* XRB = (bf16_t*)(p.ws + WS_XRB);
        for (int idx = bid * NT + tid; idx < 16 * 3 * 64; idx += nb * NT) { const int sq = idx / 192, rem = idx % 192; XRB[(size_t)sq * SEQP * 64 + rem] = 0; }
    }
    {
        const f32x4* sp = (const f32x4*)p.in[23]; u32x2* dp = (u32x2*)(p.ws + WS_WRB);
        for (int i = bid * NT + tid; i < 1024 * 256 / 4; i += nb * NT) { const f32x4 v = sp[i]; u32x2 w; w.x = pk_bf16(v[0], v[1]); w.y = pk_bf16(v[2], v[3]); dp[i] = w; }
    }
    {
        LAS float* scr = (LAS float*)((LAS unsigned char*)smem_las + 16384 + (tid >> 6) * 8704);
        const int gw = bid * NW + (tid >> 6), ngw = nb * NW, lane_ = tid & 63;
        const int I1 = 16 * 80, I2 = 16 * 32;
        for (int it = gw; it < I1 + I2; it += ngw) {
            if (it < I1) transpose_item(p.in[5], 1024, NCOLS, 2560, (bf16_t*)(p.ws + WS_WINT), scr, it, lane_);
            else transpose_item(p.in[21], 1024, 1024, 1024, (bf16_t*)(p.ws + WS_WOUTT), scr, it - I1, lane_);
        }
    }
    float* lut = (float*)(p.ws + WS_LUT); const float* rel = p.in[11];
    for (int idx = bid * NT + tid; idx < 8 * 1024; idx += nb * NT) {
        const int h = idx >> 10, d = idx & 1023;
        int bucket;
        if (d < 16) bucket = d;
        else { const int l = 16 + (int)(logf((float)d / 16.0f) / 4.1588830833596715f * 16.0f); bucket = l < 31 ? l : 31; }
        lut[idx] = rel[bucket * 8 + h];
    }
}

__device__ __forceinline__ void phase_modnorm(const Params& p, int bid, int nb, const float* src, const float* nw, int sh_off, int sc_off, float* dst, bf16_t* dstb) {
    const float* mod = (const float*)(p.ws + WS_MOD);
    const int wave = threadIdx.x >> 6, lane = threadIdx.x & 63;
    (void)dst;
    for (int row = bid * NW + wave; row < MTOK; row += nb * NW) {
        const int b = row >> 13;
        const float* xr = src + (size_t)row * 1024 + lane * 16;
        f32x4 v[4]; float ss = 0.f;
#pragma unroll
        for (int i = 0; i < 4; ++i) { v[i] = *(const f32x4*)(xr + 4 * i); ss += (v[i][0] * v[i][0] + v[i][1] * v[i][1]) + (v[i][2] * v[i][2] + v[i][3] * v[i][3]); }
        ss = wave_sum(ss);
        const float rstd = 1.0f / sqrtf(ss * (1.f / 1024.f) + 1e-6f);
        u32x4 o[2];
#pragma unroll
        for (int i = 0; i < 4; ++i) {
            const int ci = lane * 16 + 4 * i;
            const f32x4 sh = *(const f32x4*)(mod + b * 6144 + sh_off + ci), sc = *(const f32x4*)(mod + b * 6144 + sc_off + ci), w = *(const f32x4*)(nw + ci);
            f32x4 h;
#pragma unroll
            for (int j = 0; j < 4; ++j) h[j] = v[i][j] * rstd * w[j] * (1.f + sc[j]) + sh[j];
            o[i >> 1][(i & 1) * 2 + 0] = pk_bf16(h[0], h[1]); o[i >> 1][(i & 1) * 2 + 1] = pk_bf16(h[2], h[3]);
        }
        *(u32x4*)(dstb + (size_t)row * 1024 + lane * 16) = o[0];
        *(u32x4*)(dstb + (size_t)row * 1024 + lane * 16 + 8) = o[1];
    }
}

__device__ __forceinline__ void phase2_e(const Params& p, int bid, int nb, LAS unsigned char* lds) {
    bf16_t* QB = (bf16_t*)(p.ws + WS_QB); bf16_t* KV6 = (bf16_t*)(p.ws + WS_KV6); float* GATE = (float*)(p.ws + WS_GATE);
    bf16_t* XRB = (bf16_t*)(p.ws + WS_XRB); bf16_t* GRG = (bf16_t*)(p.ws + WS_GRG);
    pg8::Gemm g{(const pg8::bf16_t*)(p.ws + WS_H1B), (const pg8::bf16_t*)(p.ws + WS_WINT), MTOK, 2560, 1024};
    pg8::StaticOrder S; S.init(MTOK, 2560, nb, bid);
    auto E = make_epi_p([=](const f32x4 (&acc)[2][2][4][2], const pg8::Unit& u, int wr, int wc, int fr, int fq) {
#pragma unroll
        for (int ai = 0; ai < 2; ++ai)
#pragma unroll
            for (int mm = 0; mm < 4; ++mm) {
                const int m = u.pm * 256 + ai * 128 + wr * 64 + mm * 16 + fr;
#pragma unroll
                for (int bj = 0; bj < 2; ++bj) {
                    const int col = u.pn * 256 + bj * 128 + wc * 32 + fq * 8;
                    const f32x4 v0 = acc[ai][bj][mm][0], v1 = acc[ai][bj][mm][1];
                    if (col >= NCOLS) continue;
                    if (col < 512) {
                        const float sc = 0.125f * LOG2E; u32x4 w; w[0] = pk_bf16(v0[0] * sc, v0[1] * sc); w[1] = pk_bf16(v0[2] * sc, v0[3] * sc); w[2] = pk_bf16(v1[0] * sc, v1[1] * sc); w[3] = pk_bf16(v1[2] * sc, v1[3] * sc);
                        *(u32x4*)(QB + (size_t)m * 512 + col) = w;
                    } else if (col >= 1280 && col < 1304) {
                        f32x4 g0, g1;
#pragma unroll
                        for (int j = 0; j < 4; ++j) { g0[j] = sigm(v0[j]); g1[j] = sigm(v1[j]); }
                        *(f32x4*)(GATE + (size_t)m * 24 + (col - 1280)) = g0; *(f32x4*)(GATE + (size_t)m * 24 + (col - 1280) + 4) = g1;
                    } else if (col < 1280) {
                        const int c2 = col - 512, j6 = c2 >> 7, gg = (c2 >> 6) & 1, d = c2 & 63, bb = m >> 13, t = m & 8191;
                        u32x4 w; w[0] = pk_bf16(v0[0], v0[1]); w[1] = pk_bf16(v0[2], v0[3]); w[2] = pk_bf16(v1[0], v1[1]); w[3] = pk_bf16(v1[2], v1[3]);
                        *(u32x4*)(KV6 + (size_t)j6 * 2097152 + ((size_t)((bb * 2 + gg) * SEQ + t)) * 64 + d) = w;
                    } else if (col < 1816) {
                        const int c = col - 1304, hb = c >> 6, bb = m >> 13, t = m & 8191;
                        u32x4 w; w[0] = pk_bf16(v0[0], v0[1]); w[1] = pk_bf16(v0[2], v0[3]); w[2] = pk_bf16(v1[0], v1[1]); w[3] = pk_bf16(v1[2], v1[3]);
                        *(u32x4*)(XRB + ((size_t)(bb * 8 + hb) * SEQP + 3 + t) * 64 + (c & 63)) = w;
                    } else {
                        u32x4 w; w[0] = pk_bf16(gelu_t(v0[0]), gelu_t(v0[1])); w[1] = pk_bf16(gelu_t(v0[2]), gelu_t(v0[3])); w[2] = pk_bf16(gelu_t(v1[0]), gelu_t(v1[1])); w[3] = pk_bf16(gelu_t(v1[2]), gelu_t(v1[3]));
                        *(u32x4*)(GRG + (size_t)m * 512 + (col - 1816)) = w;
                    }
                }
            }
    });
    pg8::gemm_phase(lds, g, S, E);
}

__device__ __forceinline__ void phase5_e(const Params& p, int bid, int nb, LAS unsigned char* lds) {
    const float* x = p.in[0]; const float* mod = (const float*)(p.ws + WS_MOD); float* X1 = (float*)(p.ws + WS_X1);
    pg8::Gemm g{(const pg8::bf16_t*)(p.ws + WS_YB), (const pg8::bf16_t*)(p.ws + WS_WOUTT), MTOK, 1024, 1024};
    pg8::StaticOrder S; S.init(MTOK, 1024, nb, bid);
    auto E = make_epi([=](const f32x4 (&acc)[2][2][4][2], const pg8::Unit& u, int wr, int wc, int fr, int fq) {
        const int c0 = u.pn * 256 + wc * 32 + fq * 4;
        const int bb = (u.pm * 256) >> 13;
        f32x4 gv[2][2];
#pragma unroll
        for (int bj = 0; bj < 2; ++bj)
#pragma unroll
            for (int nn = 0; nn < 2; ++nn) gv[bj][nn] = *(const f32x4*)(mod + bb * 6144 + 2048 + c0 + bj * 128 + nn * 16);
#pragma unroll
        for (int ai = 0; ai < 2; ++ai)
#pragma unroll
            for (int mm = 0; mm < 4; ++mm) {
                const size_t o = (size_t)(u.pm * 256 + ai * 128 + wr * 64 + mm * 16 + fr) * 1024 + c0;
                f32x4 xv[2][2];
#pragma unroll
                for (int bj = 0; bj < 2; ++bj)
#pragma unroll
                    for (int nn = 0; nn < 2; ++nn) xv[bj][nn] = *(const f32x4*)(x + o + bj * 128 + nn * 16);
#pragma unroll
                for (int bj = 0; bj < 2; ++bj)
#pragma unroll
                    for (int nn = 0; nn < 2; ++nn) *(f32x4*)(X1 + o + bj * 128 + nn * 16) = xv[bj][nn] + gv[bj][nn] * acc[ai][bj][mm][nn];
            }
    });
    pg8::gemm_phase(lds, g, S, E);
}

#ifndef A4_PROBE_MASK
#define A4_PROBE_MASK 7
#endif
#define A4_KV 0
#define A4_SCORE 65536
#define A4_LUT 131200
#define LUTP 1156
#define A4_SELM 149760
__device__ __forceinline__ float ex2(float x) { return __builtin_amdgcn_exp2f(x); }

__device__ __forceinline__ float xmax_16_32(float v) {
    { auto r = __builtin_amdgcn_permlane16_swap(__float_as_uint(v), __float_as_uint(v), false, false); v = fmaxf(__uint_as_float(r[0]), __uint_as_float(r[1])); }
    { auto r = __builtin_amdgcn_permlane32_swap(__float_as_uint(v), __float_as_uint(v), false, false); v = fmaxf(__uint_as_float(r[0]), __uint_as_float(r[1])); }
    return v;
}
__device__ __forceinline__ float xsum_16_32(float v) {
    { auto r = __builtin_amdgcn_permlane16_swap(__float_as_uint(v), __float_as_uint(v), false, false); v = __uint_as_float(r[0]) + __uint_as_float(r[1]); }
    { auto r = __builtin_amdgcn_permlane32_swap(__float_as_uint(v), __float_as_uint(v), false, false); v = __uint_as_float(r[0]) + __uint_as_float(r[1]); }
    return v;
}


__device__ __forceinline__ void phase4_mfma(unsigned char* ws, int bid, int nb, LAS unsigned char* lds) {
    int tid_ = threadIdx.x; asm volatile("" : "+v"(tid_));
    const int tid = tid_, wid = __builtin_amdgcn_readfirstlane(tid >> 6), lane = tid & 63;
    const int col = lane & 15, tl = col >> 2, hd = col & 3, g4 = lane >> 4, fr = col;
    const bf16_t* QB = (const bf16_t*)(ws + WS_QB);
    const unsigned char* KV6 = ws + WS_KV6;
    const unsigned char* KCB = ws + WS_KCB; const unsigned char* VCB = ws + WS_VCB;
    const float* lutg = (const float*)(ws + WS_LUT);
    const float* GATE = (const float*)(ws + WS_GATE);
    float* OATT = (float*)(ws + WS_OATT);
    LAS float* lutl = (LAS float*)(lds + A4_LUT);
    LAS float* score = (LAS float*)(lds + A4_SCORE);
    LAS unsigned* selm = (LAS unsigned*)(lds + A4_SELM);
    const int koff0 = fr * 128 + 16 * ((g4) ^ (fr & 7)), koff1 = fr * 128 + 16 * ((4 + g4) ^ (fr & 7));
    const int q4 = (lane >> 2) & 3, pp = lane & 3, xk = (g4 & 1) * 4 + q4;
    int voff[4];
#pragma unroll
    for (int db = 0; db < 4; ++db) voff[db] = (g4 * 4 + q4) * 128 + 16 * ((db * 2 + (pp >> 1)) ^ xk) + 8 * (pp & 1);
    const int dr = tid >> 3, dsrc = dr * 128 + (((tid & 7) ^ (dr & 7)) * 16);

#define A4_ISSUE(kbase, vbase, stage) do { \
        __builtin_amdgcn_global_load_lds((const unsigned*)((kbase) + dsrc), (LAS unsigned*)(lds + A4_KV + (stage) * 16384 + wid * 1024), 16, 0, 0); \
        if (vbase) __builtin_amdgcn_global_load_lds((const unsigned*)((vbase) + dsrc), (LAS unsigned*)(lds + A4_KV + (stage) * 16384 + 8192 + wid * 1024), 16, 0, 0); } while (0)
#define A4_SYNC() do { asm volatile("s_waitcnt vmcnt(0)" ::: "memory"); __syncthreads(); } while (0)
#define A4_SYNC_RING(issued) do { asm volatile("s_waitcnt lgkmcnt(0)" ::: "memory"); if (issued) asm volatile("s_waitcnt vmcnt(2)" ::: "memory"); else asm volatile("s_waitcnt vmcnt(0)" ::: "memory"); \
        asm volatile("" ::: "memory"); __builtin_amdgcn_s_barrier(); asm volatile("" ::: "memory"); } while (0)

    for (int u2 = bid; u2 < 256; u2 += nb)
    for (int hf = 0; hf < 2; ++hf)
    for (int rep4 = 0; rep4 < ((REP & 64) ? 2 : 1); ++rep4) {
        const bool probe = rep4 > 0; const int amask = probe ? A4_PROBE_MASK : 7;
        const int bg = u2 >> 6, b = bg >> 1, g = bg & 1;
        const int T = hf ? 127 - (u2 & 63) : (u2 & 63);
        const int t0 = T * 64;
        const size_t seqbase = (size_t)(b * 2 + g) * SEQ;
        __syncthreads();
        for (int i = tid; i < 4 * 1152; i += NT) { const int hh = i / 1152, dd = i - hh * 1152; lutl[hh * LUTP + dd] = lutg[(g * 4 + hh) * 1024 + (dd < 1023 ? dd : 1023)] * LOG2E; }
        if (!probe) for (int i = tid; i < 8192; i += NT) score[i] = 0.f;
        int tq[2]; tq[0] = t0 + 8 * wid + tl; tq[1] = tq[0] + 4;
        bf16x8 qf[2][2];
#pragma unroll
        for (int ct = 0; ct < 2; ++ct) {
            const size_t m = (size_t)b * SEQ + tq[ct];
#pragma unroll
            for (int h2 = 0; h2 < 2; ++h2) qf[ct][h2] = *(const bf16x8*)(QB + m * 512 + (g * 4 + hd) * 64 + h2 * 32 + g4 * 8);
        }
#define A4_GATEV(ct, br) (GATE[((size_t)b * SEQ + tq[ct]) * 24 + (g * 4 + hd) * 3 + (br)])
        __syncthreads();

        float mrun[2], lrun[2];
        f32x4 O[2][4];
        bf16x8 kf[4][2];
        f32x4 sv[4];
#define A4_LOADK(stage) do { _Pragma("unroll") for (int kt = 0; kt < 4; ++kt) { \
            kf[kt][0] = *(const LAS bf16x8*)(lds + A4_KV + (stage) * 16384 + kt * 2048 + koff0); \
            kf[kt][1] = *(const LAS bf16x8*)(lds + A4_KV + (stage) * 16384 + kt * 2048 + koff1); } } while (0)
#define A4_SCORES(ct) do { _Pragma("unroll") for (int kt = 0; kt < 4; ++kt) { \
            sv[kt] = __builtin_amdgcn_mfma_f32_16x16x32_bf16(kf[kt][0], qf[ct][0], (f32x4){0.f, 0.f, 0.f, 0.f}, 0, 0, 0); \
            sv[kt] = __builtin_amdgcn_mfma_f32_16x16x32_bf16(kf[kt][1], qf[ct][1], sv[kt], 0, 0, 0); } } while (0)
#define A4_VREADS(stage, a, l0, h0, l1, h1, l2, h2, l3, h3) do { \
            LAS unsigned char* vb_ = lds + A4_KV + (stage) * 16384 + 8192 + (a) * 4096; \
            l0 = tr_read(vb_ + voff[0]); h0 = tr_read(vb_ + 2048 + voff[0]); l1 = tr_read(vb_ + voff[1]); h1 = tr_read(vb_ + 2048 + voff[1]); \
            l2 = tr_read(vb_ + voff[2]); h2 = tr_read(vb_ + 2048 + voff[2]); l3 = tr_read(vb_ + voff[3]); h3 = tr_read(vb_ + 2048 + voff[3]); } while (0)
#define A4_PVMMA(ct, a, l0, h0, l1, h1, l2, h2, l3, h3) do { \
            u32x4 pw; pw[0] = pk_bf16(sv[2 * (a)][0], sv[2 * (a)][1]); pw[1] = pk_bf16(sv[2 * (a)][2], sv[2 * (a)][3]); \
            pw[2] = pk_bf16(sv[2 * (a) + 1][0], sv[2 * (a) + 1][1]); pw[3] = pk_bf16(sv[2 * (a) + 1][2], sv[2 * (a) + 1][3]); \
            const bf16x8 pf = __builtin_bit_cast(bf16x8, pw); \
            O[ct][0] = __builtin_amdgcn_mfma_f32_16x16x32_bf16((bf16x8){l0[0], l0[1], l0[2], l0[3], h0[0], h0[1], h0[2], h0[3]}, pf, O[ct][0], 0, 0, 0); \
            O[ct][1] = __builtin_amdgcn_mfma_f32_16x16x32_bf16((bf16x8){l1[0], l1[1], l1[2], l1[3], h1[0], h1[1], h1[2], h1[3]}, pf, O[ct][1], 0, 0, 0); \
            O[ct][2] = __builtin_amdgcn_mfma_f32_16x16x32_bf16((bf16x8){l2[0], l2[1], l2[2], l2[3], h2[0], h2[1], h2[2], h2[3]}, pf, O[ct][2], 0, 0, 0); \
            O[ct][3] = __builtin_amdgcn_mfma_f32_16x16x32_bf16((bf16x8){l3[0], l3[1], l3[2], l3[3], h3[0], h3[1], h3[2], h3[3]}, pf, O[ct][3], 0, 0, 0); } while (0)
#define A4_ONLINE_PV(ct, stage) do { \
            s16x4 va0, va1, va2, va3, va4, va5, va6, va7; \
            A4_VREADS(stage, 0, va0, va1, va2, va3, va4, va5, va6, va7); \
            float mx = fmaxf(fmaxf(sv[0][0], sv[0][1]), fmaxf(sv[0][2], sv[0][3])); \
            _Pragma("unroll") for (int kt = 1; kt < 4; ++kt) _Pragma("unroll") for (int j = 0; j < 4; ++j) mx = fmaxf(mx, sv[kt][j]); \
            mx = xmax_16_32(mx); \
            const float mnew = fmaxf(mrun[ct], mx); const float muse = (mnew == -INF) ? 0.f : mnew; \
            const float scl = ex2(mrun[ct] - muse); mrun[ct] = mnew; \
            const float nmu = -muse; \
            _Pragma("unroll") for (int kt = 0; kt < 4; ++kt) { sv[kt] += nmu; _Pragma("unroll") for (int j = 0; j < 4; ++j) sv[kt][j] = ex2(sv[kt][j]); } \
            const f32x4 ls4 = (sv[0] + sv[1]) + (sv[2] + sv[3]); const float ls = (ls4[0] + ls4[1]) + (ls4[2] + ls4[3]); \
            lrun[ct] = lrun[ct] * scl + ls; \
            if (__builtin_amdgcn_ballot_w64(scl != 1.f) != 0ull) { _Pragma("unroll") for (int db = 0; db < 4; ++db) O[ct][db] *= scl; } \
            TR_WAIT8(va0, va1, va2, va3, va4, va5, va6, va7); \
            s16x4 vb0, vb1, vb2, vb3, vb4, vb5, vb6, vb7; \
            A4_VREADS(stage, 1, vb0, vb1, vb2, vb3, vb4, vb5, vb6, vb7); \
            A4_PVMMA(ct, 0, va0, va1, va2, va3, va4, va5, va6, va7); \
            TR_WAIT8(vb0, vb1, vb2, vb3, vb4, vb5, vb6, vb7); \
            A4_PVMMA(ct, 1, vb0, vb1, vb2, vb3, vb4, vb5, vb6, vb7); } while (0)
#define A4_PV(ct, stage) do { \
            s16x4 va0, va1, va2, va3, va4, va5, va6, va7; \
            A4_VREADS(stage, 0, va0, va1, va2, va3, va4, va5, va6, va7); \
            TR_WAIT8(va0, va1, va2, va3, va4, va5, va6, va7); \
            A4_PVMMA(ct, 0, va0, va1, va2, va3, va4, va5, va6, va7); \
            A4_VREADS(stage, 1, va0, va1, va2, va3, va4, va5, va6, va7); \
            TR_WAIT8(va0, va1, va2, va3, va4, va5, va6, va7); \
            A4_PVMMA(ct, 1, va0, va1, va2, va3, va4, va5, va6, va7); } while (0)
#define A4_RESET() do { _Pragma("unroll") for (int ct = 0; ct < 2; ++ct) { mrun[ct] = -INF; lrun[ct] = 0.f; \
            _Pragma("unroll") for (int db = 0; db < 4; ++db) O[ct][db] = (f32x4){0.f, 0.f, 0.f, 0.f}; } } while (0)
#define A4_FINISH(br, first) do { _Pragma("unroll") for (int ct = 0; ct < 2; ++ct) { \
            float lt = lrun[ct]; lt = xsum_16_32(lt); \
            const float wv = A4_GATEV(ct, br) / fmaxf(lt, 1e-30f); \
            float* op = OATT + ((size_t)b * SEQ + tq[ct]) * 512 + (g * 4 + hd) * 64 + g4 * 4; \
            _Pragma("unroll") for (int db = 0; db < 4; ++db) { f32x4 r = O[ct][db] * wv; if (!(first)) r += *(const f32x4*)(op + db * 16); *(f32x4*)(op + db * 16) = r; } } } while (0)

        if (amask & 1) {
            const unsigned char* KW = KV6 + (size_t)4 * 4194304 + seqbase * 128; const unsigned char* VW = KV6 + (size_t)5 * 4194304 + seqbase * 128;
            A4_RESET();
            const int s0 = T >= 8 ? 0 : 8 - T;
            { const int jb = T - 8 + s0; A4_ISSUE(KW + (size_t)jb * 8192, VW + (size_t)jb * 8192, 0);
              if (s0 < 8) { A4_ISSUE(KW + (size_t)(jb + 1) * 8192, VW + (size_t)(jb + 1) * 8192, 1); asm volatile("s_waitcnt vmcnt(2)" ::: "memory"); } else asm volatile("s_waitcnt vmcnt(0)" ::: "memory");
              __syncthreads(); }
            int stage = 0;
            for (int s = s0; s <= 8; ++s) {
                const int jb = T - 8 + s;
                const bool iss = (s + 2 <= 8);
                if (iss) { const int st2 = stage >= 1 ? stage - 1 : 2; const unsigned char* kn = KW + (size_t)(jb + 2) * 8192; const unsigned char* vn = VW + (size_t)(jb + 2) * 8192; A4_ISSUE(kn, vn, st2); }
#pragma unroll
                for (int ct = 0; ct < 2; ++ct) {
                    A4_LOADK(stage);
                    A4_SCORES(ct);
                    __builtin_amdgcn_sched_barrier(0);
                    const int t = tq[ct];
                    {
                        const int base = t - jb * 64 - g4 * 4;
                        const LAS float* lp = lutl + hd * LUTP + base - 51;
                        const bool edge = (s == 0) || (s == 8);
#pragma unroll
                        for (int kt = 0; kt < 4; ++kt) {
                            f32x4 bs;
#pragma unroll
                            for (int j = 0; j < 4; ++j) bs[j] = lp[51 - kt * 16 - j];
                            asm volatile("" : "+v"(bs));
                            sv[kt] += bs;
                        }
                        if (edge) {
#pragma unroll
                            for (int kt = 0; kt < 4; ++kt)
#pragma unroll
                                for (int j = 0; j < 4; ++j) { const int dist = base - kt * 16 - j; sv[kt][j] = ((dist >= 0) && (dist < 512)) ? sv[kt][j] : -INF; }
                        }
                    }
                    A4_ONLINE_PV(ct, stage);
                    __builtin_amdgcn_sched_barrier(0);
                }
                A4_SYNC_RING(iss);
                stage = stage == 2 ? 0 : stage + 1;
            }
            if (!probe) A4_FINISH(2, true);
        }
        if (amask & 2) {
            const unsigned char* KC = KCB + (size_t)(b * 2 + g) * 512 * 128; const unsigned char* VC = VCB + (size_t)(b * 2 + g) * 512 * 128;
            int ncmp = 4 * T + 3; if (ncmp > NCMP) ncmp = NCMP;
            const int nblk = (ncmp + 63) >> 6;
            A4_RESET();
            A4_ISSUE(KC, (const unsigned char*)nullptr, 0);
            A4_SYNC();
            for (int s = 0; s < nblk; ++s) {
                const int stage = s & 1;
                if (s + 1 < nblk) A4_ISSUE(KC + (size_t)(s + 1) * 8192, (const unsigned char*)nullptr, stage ^ 1);
#pragma unroll
                for (int ct = 0; ct < 2; ++ct) {
                    A4_LOADK(stage);
                    A4_SCORES(ct);
                    __builtin_amdgcn_sched_barrier(0);
                    const int t = tq[ct];
                    float mx = -INF;
#pragma unroll
                    for (int kt = 0; kt < 4; ++kt) {
                        f32x4 bs;
#pragma unroll
                        for (int j = 0; j < 4; ++j) { int dist = t - (16 * (s * 64 + kt * 16 + g4 * 4 + j) + 31); dist = dist < 1023 ? dist : 1023; bs[j] = lutl[hd * LUTP + (dist & 1023)]; }
                        asm volatile("" : "+v"(bs));
#pragma unroll
                        for (int j = 0; j < 4; ++j) {
                            const int n = s * 64 + kt * 16 + g4 * 4 + j; const int dist = t - (16 * n + 31);
                            const bool ok = (dist >= 0) && (n < NCMP);
                            sv[kt][j] = ok ? sv[kt][j] + bs[j] : -INF; mx = fmaxf(mx, sv[kt][j]);
                        }
                    }
                    mx = xmax_16_32(mx);
                    const float mnew = fmaxf(mrun[ct], mx); const float muse = (mnew == -INF) ? 0.f : mnew;
                    const float scl = ex2(mrun[ct] - muse); mrun[ct] = mnew;
                    float ls = 0.f;
#pragma unroll
                    for (int kt = 0; kt < 4; ++kt)
#pragma unroll
                        for (int j = 0; j < 4; ++j) ls += ex2(sv[kt][j] - muse);
                    lrun[ct] = lrun[ct] * scl + ls;
                    __builtin_amdgcn_sched_barrier(0);
                }
                A4_SYNC();
            }
            float mfin[2], linv[2];
#pragma unroll
            for (int ct = 0; ct < 2; ++ct) {
                float lt = lrun[ct]; lt = xsum_16_32(lt);
                linv[ct] = 1.f / fmaxf(lt, 1e-30f); mfin[ct] = (mrun[ct] == -INF) ? 0.f : mrun[ct];
            }
            A4_ISSUE(KC, VC, 0);
            A4_SYNC();
            for (int s = 0; s < nblk; ++s) {
                const int stage = s & 1;
                if (s + 1 < nblk) { const unsigned char* kn = KC + (size_t)(s + 1) * 8192; const unsigned char* vn = VC + (size_t)(s + 1) * 8192; A4_ISSUE(kn, vn, stage ^ 1); }
#pragma unroll
                for (int ct = 0; ct < 2; ++ct) {
                    A4_LOADK(stage);
                    A4_SCORES(ct);
                    __builtin_amdgcn_sched_barrier(0);
                    const int t = tq[ct];
#pragma unroll
                    for (int kt = 0; kt < 4; ++kt) {
                        f32x4 bs;
#pragma unroll
                        for (int j = 0; j < 4; ++j) { int dist = t - (16 * (s * 64 + kt * 16 + g4 * 4 + j) + 31); dist = dist < 1023 ? dist : 1023; bs[j] = lutl[hd * LUTP + (dist & 1023)]; }
                        asm volatile("" : "+v"(bs));
#pragma unroll
                        for (int j = 0; j < 4; ++j) {
                            const int n = s * 64 + kt * 16 + g4 * 4 + j; const int dist = t - (16 * n + 31);
                            const bool ok = (dist >= 0) && (n < NCMP);
                            sv[kt][j] = ok ? ex2(sv[kt][j] + bs[j] - mfin[ct]) * linv[ct] : 0.f;
                        }
                        float s4 = (sv[kt][0] + sv[kt][1]) + (sv[kt][2] + sv[kt][3]); float s3 = sv[kt][3];
                        s4 += __shfl_xor(s4, 1); s4 += __shfl_xor(s4, 2); s3 += __shfl_xor(s3, 1); s3 += __shfl_xor(s3, 2);
                        const int a = s * 16 + kt * 4 + g4;
                        if (hd == 0 && !probe) {
                            LAS float* sp = score + (8 * wid + 4 * ct + tl) * 128 + a;
                            atomicAdd((float*)sp, s4);
                            if (a + 1 < 128) atomicAdd((float*)(sp + 1), s3);
                        }
                    }
                    A4_PV(ct, stage);
                    __builtin_amdgcn_sched_barrier(0);
                }
                A4_SYNC();
            }
            if (!probe)
#pragma unroll
            for (int ct = 0; ct < 2; ++ct) {
                float* op = OATT + ((size_t)b * SEQ + tq[ct]) * 512 + (g * 4 + hd) * 64 + g4 * 4;
#pragma unroll
                for (int db = 0; db < 4; ++db) { const float gcv = A4_GATEV(ct, 0); f32x4 r = O[ct][db] * gcv; r += *(const f32x4*)(op + db * 16); *(f32x4*)(op + db * 16) = r; }
            }
        }
        __syncthreads();
        if (!probe)
        for (int tt = 0; tt < 8; ++tt) {
            const int ti = 8 * wid + tt;
            const int j0 = lane, j1 = lane + 64;
            bool sel0, sel1;
            if (T <= 15) { sel0 = j0 <= T; sel1 = false; }
            else {
                const bool c0 = (j0 >= 1) && (j0 <= T - 2), c1 = (j1 <= T - 2);
                const float s0 = c0 ? score[ti * 128 + j0] : -INF, s1 = c1 ? score[ti * 128 + j1] : -INF;
                int r0 = 0, r1 = 0;
                for (int j2 = 1; j2 <= T - 2; ++j2) { const float v = score[ti * 128 + j2]; r0 += (v > s0) || (v == s0 && j2 < j0); r1 += (v > s1) || (v == s1 && j2 < j1); }
                sel0 = (c0 && r0 < 13) || (j0 == 0) || (j0 == T) || (j0 == T - 1);
                sel1 = (c1 && r1 < 13) || (j1 == T) || (j1 == T - 1);
            }
            const unsigned long long b0 = __ballot(sel0), b1 = __ballot(sel1);
            if (lane == 0) { selm[ti * 4 + 0] = (unsigned)b0; selm[ti * 4 + 1] = (unsigned)(b0 >> 32); selm[ti * 4 + 2] = (unsigned)b1; selm[ti * 4 + 3] = (unsigned)(b1 >> 32); }
        }
        __builtin_amdgcn_wave_barrier();
        asm volatile("s_waitcnt lgkmcnt(0)" ::: "memory");
        if (amask & 4) {
            const unsigned char* KS = KV6 + (size_t)2 * 4194304 + seqbase * 128; const unsigned char* VS = KV6 + (size_t)3 * 4194304 + seqbase * 128;
            unsigned un[2][4];
#pragma unroll
            for (int ct = 0; ct < 2; ++ct)
#pragma unroll
                for (int w = 0; w < 4; ++w) {
                    unsigned uu = selm[(8 * wid + 4 * ct + 0) * 4 + w] | selm[(8 * wid + 4 * ct + 1) * 4 + w] | selm[(8 * wid + 4 * ct + 2) * 4 + w] | selm[(8 * wid + 4 * ct + 3) * 4 + w];
                    un[ct][w] = __builtin_amdgcn_readfirstlane(uu);
                }
            A4_RESET();
            const float cbfar = lutl[hd * LUTP + 1023];
            __syncthreads();
#pragma unroll
            for (int bq = 0; bq < 4; ++bq) if (bq <= T) { const unsigned char* kn = KS + (size_t)bq * 8192; const unsigned char* vn = VS + (size_t)bq * 8192; A4_ISSUE(kn, vn, bq); }
            A4_SYNC();
#pragma unroll
            for (int w = 0; w < 4; ++w) {
                const unsigned selw0 = selm[(8 * wid + tl) * 4 + w], selw1 = selm[(8 * wid + 4 + tl) * 4 + w];
                for (int gg = 0; gg < 8; ++gg) {
                    const int j0 = w * 32 + gg * 4;
                    if (j0 > T) break;
#pragma unroll
                    for (int bq = 0; bq < 4; ++bq) { const int jn = j0 + 4 + bq; if (jn <= T) { const unsigned char* kn = KS + (size_t)jn * 8192; const unsigned char* vn = VS + (size_t)jn * 8192; A4_ISSUE(kn, vn, (jn & 7)); } }
                    for (int bq = 0; bq < 4; ++bq) {
                        const int j = j0 + bq;
                        if (j > T) break;
                        const int jb = gg * 4 + bq, stage = j & 7;
                        const bool need0 = (un[0][w] >> jb) & 1u, need1 = (un[1][w] >> jb) & 1u;
                        if (need0 || need1) {
#pragma unroll
                            for (int ct = 0; ct < 2; ++ct) {
                                if (ct == 0 ? need0 : need1) {
                                    A4_LOADK(stage);
                                    A4_SCORES(ct);
                                    __builtin_amdgcn_sched_barrier(0);
                                    const int t = tq[ct];
                                    const bool csel = ((ct == 0 ? selw0 : selw1) >> jb) & 1u;
                                    if (j * 64 + 63 + 1023 <= t0) {
                                        const float cb = csel ? cbfar : -INF;
#pragma unroll
                                        for (int kt = 0; kt < 4; ++kt)
#pragma unroll
                                            for (int jj = 0; jj < 4; ++jj) sv[kt][jj] += cb;
                                    } else {
                                        const int base = t - j * 64 - g4 * 4;
                                        const LAS float* lp = lutl + hd * LUTP + base - 51;
                                        const float msk = csel ? 0.f : -INF;
#pragma unroll
                                        for (int kt = 0; kt < 4; ++kt) {
                                            f32x4 bs;
#pragma unroll
                                            for (int jj = 0; jj < 4; ++jj) bs[jj] = lp[51 - kt * 16 - jj];
                                            asm volatile("" : "+v"(bs));
                                            sv[kt] += bs + msk;
                                        }
                                        if (j == T) {
#pragma unroll
                                            for (int kt = 0; kt < 4; ++kt)
#pragma unroll
                                                for (int jj = 0; jj < 4; ++jj) { const int dist = base - kt * 16 - jj; sv[kt][jj] = (dist >= 0) ? sv[kt][jj] : -INF; }
                                        }
                                    }
                                    A4_ONLINE_PV(ct, stage);
                                    __builtin_amdgcn_sched_barrier(0);
                                }
                            }
                        }
                    }
                    A4_SYNC();
                }
            }
            if (!probe) A4_FINISH(1, false);
        }
    }
#undef A4_ISSUE
#undef A4_SYNC
#undef A4_SYNC_RING
#undef A4_LOADK
#undef A4_SCORES
#undef A4_ONLINE_PV
#undef A4_PV
#undef A4_VREADS
#undef A4_PVMMA
#undef A4_RESET
#undef A4_FINISH
#undef A4_GATEV
}

__device__ __forceinline__ void phase3_mfma(const Params& p, int bid, int nb, LAS unsigned char* lds) {
    {
        const unsigned char* XRBb = p.ws + WS_XRB; const bf16_t* XRB = (const bf16_t*)(p.ws + WS_XRB);
        const float* BG = (const float*)(p.ws + WS_BG); const float* GB = (const float*)(p.ws + WS_GBIAS);
        const float* conv_w = p.in[12]; const float* conv_b = p.in[13]; const float* lam = p.in[18];
        float* AL = (float*)(p.ws + WS_ALRU); float* UL = (float*)(p.ws + WS_ULRU);
        const XcdDeal dl = xcd_deal(512, lds, nb);
        gemm_stream<true, 1, 0, true>(lds, XRBb, dl.n, 4, 128,
            [&](int ps, int r) { const int u = dl.lo + ps * dl.step; return ((size_t)(u >> 5) * SEQP + (u & 31) * 256 + r) * 128; },
            [&](int ps, int n4) -> const float* { const int u = dl.lo + ps * dl.step; return BG + ((u >> 5) & 7) * 32768 + n4 * 4; },
            [&](int) { return 256; },
            [&](int ps, int rbase, int nbase, int, f32x4 (&acc)[4][4]) {
                const int u = dl.lo + ps * dl.step, sq = u >> 5, hb = sq & 7, bb = sq >> 3, t0 = (u & 31) * 256 + rbase;
#pragma unroll
                for (int ni = 0; ni < 2; ++ni) {
                    const int n = nbase + ni * 16;
                    const int j = (n >> 6) * 32 + ((n >> 4) & 1) * 16 + (n & 15), c = hb * 64 + j;
                    f32x4 cw[4];
#pragma unroll
                    for (int w = 0; w < 4; ++w) cw[w] = *(const f32x4*)(conv_w + w * 512 + c);
                    const f32x4 cbv = *(const f32x4*)(conv_b + c), ga = *(const f32x4*)(GB + hb * 128 + n), gx = *(const f32x4*)(GB + hb * 128 + n + 32), lm = *(const f32x4*)(lam + c);
                    f32x4 spl;
#pragma unroll
                    for (int jj = 0; jj < 4; ++jj) spl[jj] = -8.0f * softplus_(-lm[jj]);
#pragma unroll
                    for (int mi = 0; mi < 4; ++mi) {
                        u32x2 xw[4];
#pragma unroll
                        for (int w = 0; w < 4; ++w) xw[w] = *(const u32x2*)(XRB + ((size_t)sq * SEQP + t0 + mi * 16 + w) * 64 + j);
                        f32x4 xc = cbv;
#pragma unroll
                        for (int w = 0; w < 4; ++w) {
                            xc[0] += cw[w][0] * __uint_as_float(xw[w].x << 16); xc[1] += cw[w][1] * __uint_as_float(xw[w].x & 0xffff0000u);
                            xc[2] += cw[w][2] * __uint_as_float(xw[w].y << 16); xc[3] += cw[w][3] * __uint_as_float(xw[w].y & 0xffff0000u);
                        }
                        f32x4 av, uv;
#pragma unroll
                        for (int jj = 0; jj < 4; ++jj) {
                            const float r_ = sigm(acc[mi][ni][jj] + ga[jj]), ig = sigm(acc[mi][ni + 2][jj] + gx[jj]);
                            const float la = r_ * spl[jj];
                            const float a1 = __builtin_amdgcn_exp2f(la * 1.4426950408889634f);
                            av[jj] = a1; uv[jj] = __builtin_amdgcn_sqrtf(fmaxf(1.f - a1 * a1, 0.f)) * (ig * xc[jj]);
                        }
                        const size_t o = ((size_t)bb * SEQ + t0 + mi * 16) * 512 + c;
                        *(f32x4*)(AL + o) = av; *(f32x4*)(UL + o) = uv;
                        __builtin_amdgcn_sched_barrier(0);
                    }
                } });
    }
    {
        const unsigned char* KV6 = p.ws + WS_KV6; float* CP = (float*)(p.ws + WS_CPART);
        const float* W1k = p.in[7]; const float* W1v = p.in[9];
        const XcdDeal dl = xcd_deal(64, lds, nb);
        gemm_stream<false, 1>(lds, KV6, dl.n, 8, 64,
            [&](int ps, int r) { const int u = dl.lo + ps * dl.step, ks = u >> 4, kv = (u >> 3) & 1, R = (u & 7) * 256 + r;
                                 return (size_t)kv * 4194304 + ((size_t)(R >> 9) * SEQ + 16 * (R & 511)) * 128 + (size_t)ks * 1024; },
            [&](int ps, int n4) -> const float* { const int u = dl.lo + ps * dl.step, ks = u >> 4, kv = (u >> 3) & 1; return (kv ? W1v : W1k) + (size_t)ks * 512 * 64 + ((n4 * 4) & 63); },
            [&](int) { return 256; },
            [&](int ps, int r, int n, f32x4 v) { if (n < 64) { const int u = dl.lo + ps * dl.step; *(f32x4*)(CP + ((size_t)(u >> 3) * 2048 + (u & 7) * 256 + r) * 64 + n) = v; } });
    }
}

__device__ __forceinline__ void phase3b_new(const Params& p, int bid, int nb, float* smem) {
    const int tid = threadIdx.x;
    {
        const float* AL = (const float*)(p.ws + WS_ALRU); const float* UL = (const float*)(p.ws + WS_ULRU);
        float* AEND = (float*)(p.ws + WS_AEND); float* HEND = (float*)(p.ws + WS_HEND);
        for (int u = bid; u < 256; u += nb) {
            const size_t base = ((size_t)(u >> 7) * SEQ + (u & 127) * 64) * 512 + tid;
            float A = 1.f, H = 0.f;
#pragma unroll 8
            for (int tt = 0; tt < 64; ++tt) { const float a = AL[base + (size_t)tt * 512], uu = UL[base + (size_t)tt * 512]; H = a * H + uu; A *= a; }
            AEND[(size_t)u * 512 + tid] = A; HEND[(size_t)u * 512 + tid] = H;
        }
    }
    {
        const float* CP = (const float*)(p.ws + WS_CPART); const float* CB = (const float*)(p.ws + WS_CBIAS);
        float* hid = smem;
        for (int u = bid; u < 64; u += nb) {
            const int kv = u >> 5, R0 = (u & 31) * 64;
            const float* w2 = kv ? p.in[10] : p.in[8];
            bf16_t* ob = (bf16_t*)(p.ws + (kv ? WS_VCB : WS_KCB));
            __syncthreads();
            for (int i = tid; i < 64 * 64; i += NT) {
                const int r = i >> 6, c = i & 63; const size_t o = ((size_t)kv * 2048 + R0 + r) * 64 + c;
                const float v = ((CP[o] + CP[o + 262144]) + (CP[o + 524288] + CP[o + 786432])) + CB[kv * 64 + c];
                hid[r * 65 + c] = gelu_t(v);
            }
            __syncthreads();
            for (int i = tid; i < 64 * 64; i += NT) {
                const int r = i >> 6, j = i & 63; float acc = 0.f;
#pragma unroll 8
                for (int k = 0; k < 64; ++k) acc += hid[r * 65 + k] * w2[k * 64 + j];
                const int R = R0 + r;
                if ((R & 511) == 511) acc = 0.f;
                ob[(size_t)R * 64 + j] = (bf16_t)(pk_bf16(acc, acc) & 0xffffu);
            }
        }
    }
}

__device__ __forceinline__ void phase4b_new(const Params& p, int bid, int nb, float* smem) {
    const float* AL = (const float*)(p.ws + WS_ALRU); const float* UL = (const float*)(p.ws + WS_ULRU);
    const float* AEND = (const float*)(p.ws + WS_AEND); const float* HEND = (const float*)(p.ws + WS_HEND);
    const bf16_t* GRG = (const bf16_t*)(p.ws + WS_GRG); const float* OATT = (const float*)(p.ws + WS_OATT);
    const float* gaw = p.in[19]; const float* grw = p.in[20];
    bf16_t* YB = (bf16_t*)(p.ws + WS_YB);
    const int tid = threadIdx.x, wave = tid >> 6, lane = tid & 63;
    float* ssr = smem;
    float* ssa = smem + 512;
    for (int u = bid; u < 256; u += nb) {
        const int b = u >> 7, chunk = u & 127;
        float carry = 0.f;
        {
            const size_t cb = (size_t)(b * 128) * 512 + tid;
#pragma unroll 32
            for (int k = 0; k < chunk; ++k) carry = AEND[cb + (size_t)k * 512] * carry + HEND[cb + (size_t)k * 512];
        }
        const size_t tok0 = (size_t)b * SEQ + chunk * 64;
        float v[64];
        float h = carry;
        __syncthreads();
#pragma unroll
        for (int tt = 0; tt < 64; ++tt) {
            const size_t o = (tok0 + tt) * 512 + tid;
            h = AL[o] * h + UL[o];
            v[tt] = h * bf2f(GRG[o]);
            const float sq = wave_sum(v[tt] * v[tt]);
            const float av = OATT[o];
            const float sqa = wave_sum(av * av);
            if (lane == 0) { ssr[tt * 8 + wave] = sq; ssa[tt * 8 + wave] = sqa; }
        }
        __syncthreads();
        const float gr_w = grw[tid], ga_w = gaw[tid];
#pragma unroll
        for (int tt = 0; tt < 64; ++tt) {
            float s1 = 0.f, s2 = 0.f;
#pragma unroll
            for (int w = 0; w < 8; ++w) { s1 += ssr[tt * 8 + w]; s2 += ssa[tt * 8 + w]; }
            const float rs1 = 1.0f / sqrtf(s1 * (1.f / 512.f) + 1e-6f), rs2 = 1.0f / sqrtf(s2 * (1.f / 512.f) + 1e-6f);
            const size_t o = (tok0 + tt) * 512 + tid;
            const float ya = OATT[o] * rs2 * ga_w, yr = v[tt] * rs1 * gr_w;
            YB[(tok0 + tt) * 1024 + tid] = (bf16_t)(pk_bf16(ya, ya) & 0xffffu);
            YB[(tok0 + tt) * 1024 + 512 + tid] = (bf16_t)(pk_bf16(yr, yr) & 0xffffu);
        }
    }
}

__device__ __forceinline__ void phase8(const Params& p, int bid, int nb, float* smem) {
    const float* LOG = (const float*)(p.ws + WS_LOGITS); const float* brt = p.in[24];
    unsigned* cnt = (unsigned*)(p.ws + WS_HIST);
    int* EID = (int*)(p.ws + WS_EID); int* POS = (int*)(p.ws + WS_POS); float* WGT = (float*)(p.ws + WS_WGT);
    const int wave = threadIdx.x >> 6, lane = threadIdx.x & 63;
    float* s = smem + wave * 512; float* ssel = s + 256;
    int* lhist = (int*)(smem + 8 * 512);
    if (threadIdx.x < 256) lhist[threadIdx.x] = 0;
    __syncthreads();
    for (int tok = bid * NW + wave; tok < MTOK; tok += nb * NW) {
        __builtin_amdgcn_wave_barrier();
#pragma unroll
        for (int r = 0; r < 4; ++r) { const int e = r * 64 + lane; const float sv = sigm(LOG[(size_t)tok * 256 + e]); s[e] = sv; ssel[e] = sv + brt[e]; }
        __builtin_amdgcn_wave_barrier();
        float gsc = -INF;
        if (lane < 8) {
            float m1 = -INF, m2 = -INF;
            for (int i = 0; i < 32; ++i) { const float v = ssel[lane * 32 + i]; if (v > m1) { m2 = m1; m1 = v; } else if (v > m2) m2 = v; }
            gsc = m1 + m2;
        }
        int grank = 0;
#pragma unroll
        for (int g2 = 0; g2 < 8; ++g2) { const float v2 = __shfl(gsc, g2); grank += (v2 > gsc) || (v2 == gsc && g2 < lane); }
        const bool gok = (lane < 8) && (grank < 4);
        const unsigned long long gmask = __ballot(gok);
        float cv0, cv1, cv2, cv3;
        { const int e = lane;        cv0 = ((gmask >> (e >> 5)) & 1ull) ? ssel[e] : -INF; }
        { const int e = 64 + lane;   cv1 = ((gmask >> (e >> 5)) & 1ull) ? ssel[e] : -INF; }
        { const int e = 128 + lane;  cv2 = ((gmask >> (e >> 5)) & 1ull) ? ssel[e] : -INF; }
        { const int e = 192 + lane;  cv3 = ((gmask >> (e >> 5)) & 1ull) ? ssel[e] : -INF; }
        int my_e = 0; float my_s = 0.f;
#pragma unroll
        for (int k = 0; k < 8; ++k) {
            float bv = cv0; int bi = lane;
            if (cv1 > bv) { bv = cv1; bi = 64 + lane; }
            if (cv2 > bv) { bv = cv2; bi = 128 + lane; }
            if (cv3 > bv) { bv = cv3; bi = 192 + lane; }
#pragma unroll
            for (int o = 32; o; o >>= 1) { const float ov = __shfl_xor(bv, o); const int oi = __shfl_xor(bi, o); if (ov > bv || (ov == bv && oi < bi)) { bv = ov; bi = oi; } }
            if (bi == lane) cv0 = -INF;
            if (bi == 64 + lane) cv1 = -INF;
            if (bi == 128 + lane) cv2 = -INF;
            if (bi == 192 + lane) cv3 = -INF;
            if (lane == k) { my_e = bi; my_s = s[bi]; }
        }
        const float ssum = wave_sum(lane < 8 ? my_s : 0.f);
        if (lane < 8) {
            const int ps = atomicAdd(&lhist[my_e], 1);
            EID[tok * 8 + lane] = my_e; POS[tok * 8 + lane] = ps; WGT[tok * 8 + lane] = 2.5f * my_s / ssum;
        }
    }
    __syncthreads();
    if (threadIdx.x < 256) cnt[bid * 256 + threadIdx.x] = (unsigned)lhist[threadIdx.x];
}

__device__ __forceinline__ void expert_tables(const Params& p, int* off, int* tp, int shift = 6) {
    const unsigned* cnt = (const unsigned*)(p.ws + WS_CTL) + CW_CNT;
    __syncthreads();
    if (threadIdx.x < 256) off[threadIdx.x] = (int)cnt[threadIdx.x];
    __syncthreads();
    if (threadIdx.x == 0) {
        int o = 0, t = 0;
        for (int e = 0; e < 256; ++e) { const int c = off[e]; off[e] = o; tp[e] = t; o += c; t += (c + (1 << shift) - 1) >> shift; }
        off[256] = o; tp[256] = t; tp[257] = t + (MTOK >> shift);
    }
    __syncthreads();
}

__device__ __forceinline__ void phase9(const Params& p, int bid, int nb, float* smem) {
    int* off = (int*)smem; int* blkoff = off + 272; int* tot = off + 800;
    const unsigned* HIST = (const unsigned*)(p.ws + WS_HIST);
    unsigned* cnt = (unsigned*)(p.ws + WS_CTL) + CW_CNT;
    const int tid = threadIdx.x;
    __syncthreads();
    {
        const int e = tid & 255, hb = tid >> 8, b0 = hb * (nb >> 1), b1 = hb ? nb : (nb >> 1);
        int total = 0, pre = 0;
#pragma unroll 16
        for (int bb = b0; bb < b1; ++bb) { const int h = (int)HIST[bb * 256 + e]; total += h; pre += (bb < bid) ? h : 0; }
        if (hb) { tot[256 + e] = total; blkoff[256 + e] = pre; }
        __syncthreads();
        if (!hb) { total += tot[256 + e]; pre += blkoff[256 + e]; }
        __syncthreads();
        if (!hb) { tot[e] = total; blkoff[e] = pre; if (bid == 0) cnt[e] = (unsigned)total; }
    }
    __syncthreads();
    if (tid == 0) { int o = 0; for (int e = 0; e < 256; ++e) { off[e] = o; o += tot[e]; } }
    __syncthreads();
    const int* EID = (const int*)(p.ws + WS_EID); const int* POS = (const int*)(p.ws + WS_POS); const float* WGT = (const float*)(p.ws + WS_WGT);
    int* ST = (int*)(p.ws + WS_SLOTTOK); float* SW = (float*)(p.ws + WS_SLOTW); int* SOF = (int*)(p.ws + WS_SLOTOF);
    const int wave = tid >> 6, lane = tid & 63;
    for (int tok = bid * NW + wave; tok < MTOK; tok += nb * NW) {
        if (lane < 8) {
            const int idx = tok * 8 + lane; const int e = EID[idx];
            const int slot = off[e] + blkoff[e] + POS[idx];
            ST[slot] = tok; SW[slot] = WGT[idx]; SOF[idx] = slot;
        }
    }
}

__device__ __forceinline__ int find_expert(const int* tp, int rt) {
    int lo = 0, hi = 256;
    while (lo < hi) { const int mid = (lo + hi + 1) >> 1; if (tp[mid] <= rt) lo = mid; else hi = mid - 1; }
    return lo;
}

__device__ __forceinline__ void phase7_mfma(const Params& p, int bid, int nb, LAS unsigned char* lds) {
    const unsigned char* H2b = p.ws + WS_H2B; const float* wr = p.in[23];
    float* LOG = (float*)(p.ws + WS_LOGITS);
    const XcdDeal dl = xcd_deal(64 * 2, lds, nb);
    const bf16_t* wrb = (const bf16_t*)(p.ws + WS_WRB);
    gemm_stream<false, 1, 0, false, true>(lds, H2b, dl.n, 16, 256,
        [&](int ps, int r) { const int u = dl.lo + ps * dl.step; return (size_t)((u >> 1) * 256 + r) * 2048; },
        [&](int ps, int n4) -> const bf16_t* { const int u = dl.lo + ps * dl.step; return wrb + (u & 1) * 128 + n4 * 4; },
        [&](int) { return 256; },
        [&](int ps, int r, int n, f32x4 v) { const int u = dl.lo + ps * dl.step; *(f32x4*)(LOG + (size_t)((u >> 1) * 256 + r) * 256 + (u & 1) * 128 + n) = v; });
}

#define ETAB_OFF 24576
#define EDESC_OFF (ETAB_OFF + 1024)
__device__ __forceinline__ int expert_passes(const Params& p, int bid, int nb, const LAS unsigned char* lds, float* smem, int nct, int& npass) {
    int* off = (int*)(smem + ETAB_OFF); int* tp = off + 272; int* desc = (int*)(smem + EDESC_OFF);
    expert_tables(p, off, tp, 8);
    const unsigned* cnt = (const unsigned*)(p.ws + WS_CTL) + CW_CNT;
    const XcdDeal dl = xcd_deal(tp[257] * nct, lds, nb);
    npass = dl.n;
    for (int ps = threadIdx.x; ps < npass; ps += NT) {
        const int u = dl.lo + ps * dl.step;
        const int e = find_expert(tp, u / nct);
        const int nte = tp[e + 1] - tp[e], v = u - tp[e] * nct, ct = v / nte, rtl = v - ct * nte;
        const int rows_e = e < 256 ? (int)cnt[e] : MTOK;
        const int r0 = rtl * 256;
        desc[ps * 4 + 0] = (e < 256 ? off[e] : NK) + r0;
        desc[ps * 4 + 1] = (rows_e - r0) < 256 ? (rows_e - r0) : 256;
        desc[ps * 4 + 2] = e; desc[ps * 4 + 3] = ct;
    }
    __syncthreads();
    return dl.lo;
}

__device__ __forceinline__ void phase10_mfma(const Params& p, int bid, int nb, LAS unsigned char* lds, float* smem) {
    int npass; expert_passes(p, bid, nb, lds, smem, 4, npass);
    const LAS int* desc = (const LAS int*)(lds + EDESC_OFF * 4);
    const unsigned char* H2b = p.ws + WS_H2B; const int* ST = (const int*)(p.ws + WS_SLOTTOK);
    bf16_t* HIDB = (bf16_t*)(p.ws + WS_HIDB);
    const float* W1g = p.in[25]; const float* W3g = p.in[26]; const float* W1s = p.in[28]; const float* W3s = p.in[29];
    const float* SW = (const float*)(p.ws + WS_SLOTW);
    gemm_stream_ws(lds, H2b, npass, 16, 256,
        [&](int ps, int r) { const int slot0 = desc[ps * 4], mr = desc[ps * 4 + 1]; const int rr = r < mr ? r : mr - 1; const int slot = slot0 + rr;
                             const int tok = slot < NK ? ST[slot] : slot - NK; return (size_t)tok * 2048; },
        [&](int ps, int n4) -> const float* { const int e = desc[ps * 4 + 2], hc0 = desc[ps * 4 + 3] * 64; const int n = n4 * 4;
                             const int hc = hc0 + (n >> 6) * 32 + ((n >> 2) & 3) * 8 + ((n >> 4) & 1) * 4;
                             const float* W = ((n >> 5) & 1) ? (e < 256 ? W3g + (size_t)e * 262144 : W3s) : (e < 256 ? W1g + (size_t)e * 262144 : W1s); return W + hc; },
        [&](int ps) { return desc[ps * 4 + 1]; },
        [&](int ps, int rbase, int nbase, int mr, f32x4 (&acc)[8][4]) {
            const int slot0 = desc[ps * 4] + rbase, hc = desc[ps * 4 + 3] * 64 + (nbase >> 6) * 32 + ((nbase >> 2) & 3) * 8;
            float wv[8];
#pragma unroll
            for (int mi = 0; mi < 8; ++mi) { const int slot = slot0 + mi * 16; const float wl = SW[slot < NK ? slot : 0]; wv[mi] = slot < NK ? wl : 1.f; }
#pragma unroll
            for (int mi = 0; mi < 8; ++mi) {
                if (rbase + mi * 16 < mr) {
                    float h[8];
#pragma unroll
                    for (int ni = 0; ni < 2; ++ni) {
                        const f32x4 a = acc[mi][ni], bq = acc[mi][ni + 2];
#pragma unroll
                        for (int jj = 0; jj < 4; ++jj) h[ni * 4 + jj] = a[jj] * __builtin_amdgcn_rcpf(1.f + ex2(-a[jj] * LOG2E)) * bq[jj] * wv[mi];
                    }
                    u32x4 w; w[0] = pk_bf16(h[0], h[1]); w[1] = pk_bf16(h[2], h[3]); w[2] = pk_bf16(h[4], h[5]); w[3] = pk_bf16(h[6], h[7]);
                    *(u32x4*)(HIDB + (size_t)(slot0 + mi * 16) * 256 + hc) = w;
                }
            } });
}

__device__ __forceinline__ void phase11_mfma(const Params& p, int bid, int nb, LAS unsigned char* lds, float* smem) {
    int npass; expert_passes(p, bid, nb, lds, smem, 8, npass);
    const LAS int* desc = (const LAS int*)(lds + EDESC_OFF * 4);
    const unsigned char* HIDB = p.ws + WS_HIDB; const float* SW = (const float*)(p.ws + WS_SLOTW);
    bf16_t* SO = (bf16_t*)(p.ws + WS_SLOTOUT);
    const float* W2g = p.in[27]; const float* W2s = p.in[30];
    gemm_stream_ws(lds, HIDB, npass, 4, 1024,
        [&](int ps, int r) { const int slot0 = desc[ps * 4], mr = desc[ps * 4 + 1]; const int rr = r < mr ? r : mr - 1; return (size_t)(slot0 + rr) * 512; },
        [&](int ps, int n4) -> const float* { const int e = desc[ps * 4 + 2], n0 = desc[ps * 4 + 3] * 128; const int src4 = (n4 & ~7) + 2 * (n4 & 3) + ((n4 >> 2) & 1);
                                              return (e < 256 ? W2g + (size_t)e * 262144 : W2s) + n0 + src4 * 4; },
        [&](int ps) { return desc[ps * 4 + 1]; },
        [&](int ps, int rbase, int nbase, int mr, f32x4 (&acc)[8][4]) {
            const int slot0 = desc[ps * 4] + rbase, c0 = desc[ps * 4 + 3] * 128 + (nbase >> 6) * 64 + ((nbase >> 2) & 3) * 8;
#pragma unroll
            for (int mi = 0; mi < 8; ++mi) {
                if (rbase + mi * 16 < mr) {
                    bf16_t* op = SO + (size_t)(slot0 + mi * 16) * 1024 + c0;
#pragma unroll
                    for (int np = 0; np < 2; ++np) {
                        const f32x4 v0 = acc[mi][2 * np], v1 = acc[mi][2 * np + 1];
                        u32x4 o; o[0] = pk_bf16(v0[0], v0[1]); o[1] = pk_bf16(v0[2], v0[3]); o[2] = pk_bf16(v1[0], v1[1]); o[3] = pk_bf16(v1[2], v1[3]);
                        *(u32x4*)(op + np * 32) = o;
                    }
                }
            } });
}

__device__ __forceinline__ void phase12_mfma(const Params& p, int bid, int nb) {
    const float* X1 = (const float*)(p.ws + WS_X1); const bf16_t* SO = (const bf16_t*)(p.ws + WS_SLOTOUT); const int* SOF = (const int*)(p.ws + WS_SLOTOF);
    const float* mod = (const float*)(p.ws + WS_MOD); const float* fw = p.in[31];
    const int wave = threadIdx.x >> 6, lane = threadIdx.x & 63;
    for (int row = bid * NW + wave; row < MTOK; row += nb * NW) {
        const int b = row >> 13;
        const int myslot = lane < 8 ? SOF[row * 8 + lane] : NK + row;
        float acc[16];
#pragma unroll
        for (int i = 0; i < 16; ++i) acc[i] = 0.f;
        u32x4 w0[9], w1[9];
#pragma unroll
        for (int k = 0; k < 9; ++k) {
            const int slot = __builtin_amdgcn_readlane(myslot, k);
            const u32x4* rp = (const u32x4*)(SO + (size_t)slot * 1024 + lane * 16);
            w0[k] = rp[0]; w1[k] = rp[1];
        }
#pragma unroll
        for (int k = 0; k < 9; ++k) {
#pragma unroll
            for (int j = 0; j < 4; ++j) {
                acc[2 * j] += __uint_as_float(w0[k][j] << 16); acc[2 * j + 1] += __uint_as_float(w0[k][j] & 0xffff0000u);
                acc[8 + 2 * j] += __uint_as_float(w1[k][j] << 16); acc[8 + 2 * j + 1] += __uint_as_float(w1[k][j] & 0xffff0000u);
            }
        }
        float v[16]; float ss = 0.f;
#pragma unroll
        for (int i4 = 0; i4 < 4; ++i4) {
            const f32x4 xv = *(const f32x4*)(X1 + (size_t)row * 1024 + lane * 16 + i4 * 4);
            const f32x4 gv = *(const f32x4*)(mod + b * 6144 + 5120 + lane * 16 + i4 * 4);
#pragma unroll
            for (int j = 0; j < 4; ++j) { v[i4 * 4 + j] = xv[j] + gv[j] * acc[i4 * 4 + j]; ss += v[i4 * 4 + j] * v[i4 * 4 + j]; }
        }
        ss = wave_sum(ss);
        const float rstd = 1.0f / sqrtf(ss * (1.f / 1024.f) + 1e-6f);
#pragma unroll
        for (int i4 = 0; i4 < 4; ++i4) {
            const f32x4 wv = *(const f32x4*)(fw + lane * 16 + i4 * 4);
            f32x4 o;
#pragma unroll
            for (int j = 0; j < 4; ++j) o[j] = v[i4 * 4 + j] * rstd * wv[j];
            *(f32x4*)(p.out + (size_t)row * 1024 + lane * 16 + i4 * 4) = o;
        }
    }
}

__global__ void __launch_bounds__(NT, 2) k_fused(Params p) {
    extern __shared__ __attribute__((aligned(16))) unsigned char lds_raw[];
    LAS unsigned char* lds = (LAS unsigned char*)lds_raw;
    float* smem = (float*)lds_raw;
    if (threadIdx.x == 0) { *(LAS u32x4*)(lds + LDS_MISC) = (u32x4){0u, 0u, 0u, 0u}; }
    __syncthreads();
    XcdBarrier bar = xcd_barrier_post((unsigned*)(p.ws + WS_CTL), (volatile LAS unsigned*)(lds + LDS_MISC));
    if (threadIdx.x == 0) ((LAS int*)(lds + TOPO_OFF))[2] = (int)xb_add((unsigned*)(p.ws + WS_CTL) + CW_RANK + 64 * bar.x, 1u);
    const int bid = blockIdx.x, nb = gridDim.x;
#define PH(stmt) { stmt; xcd_barrier(bar); }
#define PHR(bit, stmt) { stmt; xcd_barrier(bar); if (REP & (bit)) { stmt; xcd_barrier(bar); } }
    PH(phase0(p, bid, nb, smem, lds))
    if (threadIdx.x == 0) {
        int pre = 0, mine = 0;
        for (unsigned j = 0; j < 16; ++j) { const int c = (int)xb_ld((unsigned*)(p.ws + WS_CTL) + XB_XCNT(j)); if (j < bar.x) pre += c; if (j == bar.x) mine = c; }
        ((LAS int*)(lds + TOPO_OFF))[0] = pre; ((LAS int*)(lds + TOPO_OFF))[1] = mine > 0 ? mine : 1;
    }
    __syncthreads();
    PHR(128, phase_modnorm(p, bid, nb, p.in[0], p.in[4], 0, 1024, (float*)(p.ws + WS_H1), (bf16_t*)(p.ws + WS_H1B)))
    PHR(1, phase2_e(p, bid, nb, lds))
    PH(phase3_mfma(p, bid, nb, lds))
    PH(phase3b_new(p, bid, nb, smem))
    PH(phase4_mfma(p.ws, bid, nb, lds))
    PH(phase4b_new(p, bid, nb, smem))
    PHR(512, phase5_e(p, bid, nb, lds))
    PH(phase_modnorm(p, bid, nb, (const float*)(p.ws + WS_X1), p.in[22], 3072, 4096, (float*)(p.ws + WS_H2), (bf16_t*)(p.ws + WS_H2B)))
    PHR(1024, phase7_mfma(p, bid, nb, lds))
    PH(phase8(p, bid, nb, smem))
    PH(phase9(p, bid, nb, smem))
    PHR(16, phase10_mfma(p, bid, nb, lds, smem))
    PHR(32, phase11_mfma(p, bid, nb, lds, smem))
    phase12_mfma(p, bid, nb);
    if (REP & 2048) { xcd_barrier(bar); phase12_mfma(p, bid, nb); }
    if (REP & 4096) { for (int i = 0; i < 20; ++i) xcd_barrier(bar); }
#undef PH
#undef PHR
}

extern "C" void kernel_launch(void* const* d_in, const int* in_sizes, int n_in, void* d_out, int out_size, void* d_ws, size_t ws_size, hipStream_t stream) {
    static int grid = 0;
    if (!grid) {
        int dev = 0, cus = 0;
        (void)hipGetDevice(&dev);
        (void)hipDeviceGetAttribute(&cus, hipDeviceAttributeMultiprocessorCount, dev);
        (void)hipFuncSetAttribute((const void*)k_fused, hipFuncAttributeMaxDynamicSharedMemorySize, LDS_BYTES);
        if (cus < 1) cus = 256;
        grid = cus;
    }
    Params p{};
    for (int i = 0; i < 32; ++i) p.in[i] = (const float*)d_in[i];
    p.out = (float*)d_out; p.ws = (unsigned char*)d_ws;
    (void)hipMemsetAsync((char*)d_ws + WS_CTL, 0, CTL_BYTES, stream);
    hipLaunchKernelGGL(k_fused, dim3(grid), dim3(NT), LDS_BYTES, stream, p);
}
```

```cpp
#include <hip/hip_runtime.h>
#include <stdint.h>
#include <type_traits>


#define MTOK 16384
#define SEQ 8192
#define SEQP 8195
#define DM 1024
#define NCOLS 2328
#define COL_KC 512
#define COL_KS 768
#define COL_VS 896
#define COL_KW 1024
#define COL_VW 1152
#define COL_G 1280
#define COL_XR 1304
#define COL_GR 1816
#define NCMP 511
#define NEXP 256
#define NK 131072

#define MiB (1048576ull)
#define WS_CTL 0ull
#define CTL_BYTES (1 * MiB)
#define CW_CNT 8192
#define CW_RANK 12288
#define WS_MOD (1 * MiB)
#define WS_LUT (1 * MiB + 65536)
#define WS_KC (2 * MiB)
#define WS_VC (3 * MiB)
#define WS_AEND (4 * MiB)
#define WS_HEND (5 * MiB)
#define WS_EID (6 * MiB)
#define WS_POS (7 * MiB)
#define WS_WGT (8 * MiB)
#define WS_SLOTTOK (9 * MiB)
#define WS_SLOTW (10 * MiB)
#define WS_CARRY (11 * MiB)
#define WS_SLOTOF (12 * MiB)
#define WS_HIST (13 * MiB)
#define WS_LOGITS (16 * MiB)
#define WS_H1 (32 * MiB)
#define WS_PROJ (96 * MiB)
#define WS_HL (256 * MiB)
#define WS_AP (288 * MiB)
#define WS_ACC (320 * MiB)
#define WS_HID (384 * MiB)
#define WS_Y (528 * MiB)
#define WS_H2 (592 * MiB)
#define WS_X1 (656 * MiB)
#define WS_H1B (720 * MiB)
#define WS_YB (752 * MiB)
#define WS_H2B (784 * MiB)
#define WS_HIDB (816 * MiB)
#define WS_QB (896 * MiB)
#define WS_KV6 (912 * MiB)
#define WS_GATE (936 * MiB)
#define WS_KCB (938 * MiB)
#define WS_VCB (939 * MiB)
#define WS_OATT (940 * MiB)
#define WS_BG (14 * MiB)
#define WS_GBIAS (15 * MiB)
#define WS_CBIAS (15 * MiB + 8192)
#define WS_XRB (972 * MiB)
#define WS_GRG (990 * MiB)
#define WS_CPART (1007 * MiB)
#define WS_ALRU (256 * MiB)
#define WS_ULRU (288 * MiB)
#define WS_WINB (1012 * MiB)
#define WS_WOUTB (1017 * MiB)
#define WS_WRB (1020 * MiB)
#define WS_WINT (1012 * MiB)
#define WS_WOUTT (1017 * MiB)
#define WS_WRT (1019 * MiB)
#define WS_SLOTOUT (32 * MiB)

#ifndef REP
#define REP 0
#endif
#ifndef USE_MFMA
#define USE_MFMA 31
#endif

struct Params {
    const float* in[32];
    float* out;
    unsigned char* ws;
};

#define NT 512
#define NW 8
#define LDS_BYTES 151552
#define LDS_MISC 131072
#define INF __builtin_huge_valf()
#define LOG2E 1.4426950408889634f

__device__ __forceinline__ float wave_sum(float v) {
#define WS_DPP(ctrl, rmask) __builtin_bit_cast(float, __builtin_amdgcn_update_dpp(0, __builtin_bit_cast(int, v), (ctrl), (rmask), 0xf, true))
    v += WS_DPP(0x111, 0xf);
    v += WS_DPP(0x112, 0xf);
    v += WS_DPP(0x114, 0xf);
    v += WS_DPP(0x118, 0xf);
    v += WS_DPP(0x142, 0xa);
    v += WS_DPP(0x143, 0xc);
#undef WS_DPP
    return __builtin_bit_cast(float, __builtin_amdgcn_readlane(__builtin_bit_cast(int, v), 63));
}
__device__ __forceinline__ float wave_max(float v) {
#pragma unroll
    for (int o = 32; o; o >>= 1) v = fmaxf(v, __shfl_xor(v, o));
    return v;
}
__device__ __forceinline__ float sigm(float x) { return __builtin_amdgcn_rcpf(1.f + __builtin_amdgcn_exp2f(-1.4426950408889634f * x)); }
__device__ __forceinline__ float tanh_fast(float x) { return 1.f - 2.f * __builtin_amdgcn_rcpf(1.f + __builtin_amdgcn_exp2f(2.8853900817779268f * x)); }
__device__ __forceinline__ float gelu_t(float x) { return 0.5f * x * (1.f + tanh_fast(0.7978845608028654f * (x + 0.044715f * x * x * x))); }
__device__ __forceinline__ float softplus_(float z) { return fmaxf(z, 0.f) + log1pf(expf(-fabsf(z))); }


#define XB_TMO      128
#define XB_XCNT(j)  (256  + 64 * (j))
#define XB_XSUB(j)  (1280 + 64 * (j))
#define XB_XGEN(j)  (2304 + 64 * (j))
#define XB_TOP      3328
#define XB_TOPGEN   3392
#define XCD_BAR_WORDS 3456
#define XB_SPIN_CAP (1u << 18)
#define LAS __attribute__((address_space(3)))

__device__ __forceinline__ unsigned xb_ld(unsigned* p)              { return __hip_atomic_load(p, __ATOMIC_RELAXED, __HIP_MEMORY_SCOPE_AGENT); }
__device__ __forceinline__ unsigned xb_add(unsigned* p, unsigned v) { return __hip_atomic_fetch_add(p, v, __ATOMIC_RELAXED, __HIP_MEMORY_SCOPE_AGENT); }
__device__ __forceinline__ unsigned xb_xcc_id() { return (unsigned)__builtin_amdgcn_s_getreg((3 << 11) | 20) & 0xFu; }
#define XB_SPIN(cond, bar) do { unsigned _sp = 0; while (cond) { __builtin_amdgcn_s_sleep(1); \
    if ((++_sp & 255u) == 0u) { if (xb_ld(&(bar)[XB_TMO])) break; if (_sp > XB_SPIN_CAP) { atomicAdd(&(bar)[XB_TMO], 1u); break; } } } } while (0)

struct XcdBarrier {
    unsigned* bar; unsigned x;
    volatile LAS unsigned* st;
};
__device__ __forceinline__ XcdBarrier xcd_barrier_post(unsigned* bar, volatile LAS unsigned* st) {
    XcdBarrier b; b.bar = bar; b.x = xb_xcc_id(); b.st = st;
    if (threadIdx.x == 0) (void)xb_add(&bar[XB_XCNT(b.x)], 1u);
    return b;
}
__device__ __forceinline__ void xcd_barrier_complete(unsigned* bar, unsigned x, unsigned& nloc, unsigned& nx) {
    const unsigned G = gridDim.x * gridDim.y * gridDim.z;
    unsigned sum, cnt, mine, sp = 0u;
    for (;;) {
        sum = 0u; cnt = 0u; mine = 0u;
#pragma unroll
        for (unsigned j = 0; j < 16; ++j) { const unsigned c = xb_ld(&bar[XB_XCNT(j)]); sum += c; cnt += (c > 0u) ? 1u : 0u; mine = (j == x) ? c : mine; }
        if (sum == G) break;
        __builtin_amdgcn_s_sleep(1);
        if ((++sp & 255u) == 0u) { if (xb_ld(&bar[XB_TMO])) break; if (sp > XB_SPIN_CAP) { atomicAdd(&bar[XB_TMO], 1u); break; } }
    }
    nloc = mine > 0u ? mine : 1u; nx = cnt > 0u ? cnt : 1u;
}
__device__ __forceinline__ void xcd_barrier(const XcdBarrier& b) {
    asm volatile("s_waitcnt vmcnt(0)" ::: "memory");
    __syncthreads();
    if (threadIdx.x == 0) {
        unsigned* bar = b.bar;
        __builtin_amdgcn_s_waitcnt(0);
        unsigned nloc = b.st[0], nx = b.st[1];
        if (nloc == 0u) { xcd_barrier_complete(bar, b.x, nloc, nx); b.st[0] = nloc; b.st[1] = nx; }
        const unsigned old = xb_add(&bar[XB_XSUB(b.x)], 1u);
        const unsigned gen = old / nloc;
        if (old + 1u == (gen + 1u) * nloc) {
            __builtin_amdgcn_fence(__ATOMIC_RELEASE, "agent");
            asm volatile("s_waitcnt vmcnt(0)" ::: "memory");
            const unsigned og = xb_add(&bar[XB_TOP], 1u);
            const unsigned tg = og / nx;
            if (og + 1u == (tg + 1u) * nx) xb_add(&bar[XB_TOPGEN], 1u);
            else XB_SPIN(xb_ld(&bar[XB_TOPGEN]) == tg, bar);
            __builtin_amdgcn_fence(__ATOMIC_ACQUIRE, "agent");
            xb_add(&bar[XB_XGEN(b.x)], 1u);
            asm volatile("s_waitcnt vmcnt(0)" ::: "memory");
        } else {
            XB_SPIN(xb_ld(&bar[XB_XGEN(b.x)]) == gen, bar);
            __builtin_amdgcn_fence(__ATOMIC_ACQUIRE, "agent");
            asm volatile("s_waitcnt vmcnt(0)" ::: "memory");
        }
    }
    __syncthreads();
}

typedef short bf16x8 __attribute__((ext_vector_type(8)));
typedef short s16x4 __attribute__((ext_vector_type(4)));
typedef short v4i16_t __attribute__((ext_vector_type(4)));
typedef float f32x4 __attribute__((ext_vector_type(4)));
typedef float f32x2 __attribute__((ext_vector_type(2)));
typedef __bf16 bf16x2_t __attribute__((ext_vector_type(2)));
typedef unsigned short bf16_t;
typedef unsigned u32x2 __attribute__((ext_vector_type(2)));
typedef unsigned u32x4 __attribute__((ext_vector_type(4)));
__device__ __forceinline__ unsigned pk_bf16(float lo, float hi) { return __builtin_bit_cast(unsigned, __builtin_convertvector((f32x2){lo, hi}, bf16x2_t)); }
__device__ __forceinline__ float bf2f(bf16_t v) { return __uint_as_float(((unsigned)v) << 16); }

__device__ __forceinline__ s16x4 tr_read(LAS unsigned char* pa) { s16x4 r; asm volatile("ds_read_b64_tr_b16 %0, %1" : "=v"(r) : "v"(pa) : "memory"); return r; }
#define TR_WAIT8(a0, a1, a2, a3, a4, a5, a6, a7) asm volatile("s_waitcnt lgkmcnt(0)" : "+v"(a0), "+v"(a1), "+v"(a2), "+v"(a3), "+v"(a4), "+v"(a5), "+v"(a6), "+v"(a7) :: "memory")

#define GEMM_LDS_A 0
#define GEMM_LDS_B 65536
template <bool PAIR, int DEPTH, int MODE = 0, bool TILE_EPI = false, bool BBF16 = false, class ARow, class BCol, class MRows, class Epi>
__device__ __forceinline__ void gemm_stream(LAS unsigned char* lds, const unsigned char* Abase, int npass, int nk, int ldb, ARow arow, BCol bcol, MRows mrowsf, Epi epi) {
    int tid_ = threadIdx.x; asm volatile("" : "+v"(tid_));
    const int tid = tid_, wid = __builtin_amdgcn_readfirstlane(tid >> 6), lane = tid & 63;
    const int wr = wid >> 1, wc = wid & 1, fr = lane & 15, fq = lane >> 4;
    if (npass <= 0) return;
    const int S = npass * nk;
    const int Ccol = ((wid & 1) * 32 + 8 * ((lane & 3) ^ ((lane >> 5) << 1))) * 2;
    const int Rbase = 16 * (wid >> 1) + (lane >> 2);
    unsigned asrc[4];
    const int n4 = tid & 31, kb = tid >> 5;
    typedef typename std::conditional<BBF16, const bf16_t*, const float*>::type bptr_t;
    bptr_t bp;
    const int fB = ((kb & 3) << 2) | ((kb >> 2) & 3);
    const int bwoff = 256 * kb + 16 * ((n4 >> 1) ^ fB) + 8 * (n4 & 1);
    const int aoff = wr * 8192 + ((fr * 64 + fq * 16) ^ ((fr >> 3) << 5));
    const int q = (lane >> 2) & 3, pp = lane & 3;
    const int b0 = (wc * 8 + (pp >> 1)) ^ ((q << 2) | (2 * (fq & 1)));
    const int browoff = 256 * (fq * 8 + q) + 8 * (pp & 1);
#define GS_BOFF(v) (browoff + 16 * (b0 ^ (v)))
    f32x4 acc[4][4];
#pragma unroll
    for (int i = 0; i < 4; ++i)
#pragma unroll
        for (int j = 0; j < 4; ++j) acc[i][j] = (f32x4){0.f, 0.f, 0.f, 0.f};
    float4 bregX[4], bregY[4];
    int aP = 0, aK = 0, bP = 0, bK = 0;
#define GS_SETA() do { _Pragma("unroll") for (int _i = 0; _i < 4; ++_i) asrc[_i] = (unsigned)(arow(aP, Rbase + 64 * _i) + Ccol); } while (0)
#define GS_ISSUE_A(buf) do { _Pragma("unroll") for (int _i = 0; _i < 4; ++_i) \
        __builtin_amdgcn_global_load_lds((const unsigned*)(Abase + (size_t)asrc[_i] + (size_t)aK * 128), (LAS unsigned*)(lds + GEMM_LDS_A + (buf) * 32768 + _i * 8192 + wid * 1024), 16, 0, 0); \
        if (++aK == nk) { aK = 0; ++aP; if (aP < npass) GS_SETA(); } } while (0)
#define GS_LOAD_B(breg) do { _Pragma("unroll") for (int _i = 0; _i < 4; ++_i) { \
            if constexpr (BBF16) { const u32x2 _t = *(const u32x2*)(bp + (size_t)(bK * 64 + kb + 16 * _i) * ldb); breg[_i].x = __uint_as_float(_t.x); breg[_i].y = __uint_as_float(_t.y); } \
            else breg[_i] = *(const float4*)(bp + (size_t)(bK * 64 + kb + 16 * _i) * ldb); } \
        if (++bK == nk) { bK = 0; ++bP; if (bP < npass) bp = bcol(bP, n4); } } while (0)
#define GS_WRITE_B(breg, buf) do { _Pragma("unroll") for (int _i = 0; _i < 4; ++_i) { u32x2 _w; \
            if constexpr (BBF16) { _w.x = __float_as_uint(breg[_i].x); _w.y = __float_as_uint(breg[_i].y); } \
            else { _w.x = pk_bf16(breg[_i].x, breg[_i].y); _w.y = pk_bf16(breg[_i].z, breg[_i].w); } \
        *(LAS u32x2*)(lds + GEMM_LDS_B + (buf) * 16384 + bwoff + 4096 * _i) = _w; } } while (0)
#define GS_COMPUTE(buf) do { _Pragma("unroll") for (int ks = 0; ks < 2; ++ks) { \
            bf16x8 af[4]; s16x4 tl0, tl1, tl2, tl3, th0, th1, th2, th3; \
            LAS unsigned char* bb_ = lds + GEMM_LDS_B + (buf) * 16384 + ks * 8192; \
            tl0 = tr_read(bb_ + GS_BOFF(0)); th0 = tr_read(bb_ + 1024 + GS_BOFF(1)); tl1 = tr_read(bb_ + GS_BOFF(2)); th1 = tr_read(bb_ + 1024 + GS_BOFF(3)); \
            tl2 = tr_read(bb_ + GS_BOFF(4)); th2 = tr_read(bb_ + 1024 + GS_BOFF(5)); tl3 = tr_read(bb_ + GS_BOFF(6)); th3 = tr_read(bb_ + 1024 + GS_BOFF(7)); \
            _Pragma("unroll") for (int mi = 0; mi < 4; ++mi) af[mi] = *(const LAS bf16x8*)(lds + GEMM_LDS_A + (buf) * 32768 + aoff + mi * 2048 + ks * 1024); \
            TR_WAIT8(tl0, th0, tl1, th1, tl2, th2, tl3, th3); \
            bf16x8 bfr[4]; \
            bfr[0] = (bf16x8){tl0[0], tl0[1], tl0[2], tl0[3], th0[0], th0[1], th0[2], th0[3]}; bfr[1] = (bf16x8){tl1[0], tl1[1], tl1[2], tl1[3], th1[0], th1[1], th1[2], th1[3]}; \
            bfr[2] = (bf16x8){tl2[0], tl2[1], tl2[2], tl2[3], th2[0], th2[1], th2[2], th2[3]}; bfr[3] = (bf16x8){tl3[0], tl3[1], tl3[2], tl3[3], th3[0], th3[1], th3[2], th3[3]}; \
            _Pragma("unroll") for (int mi = 0; mi < 4; ++mi) _Pragma("unroll") for (int ni = 0; ni < 4; ++ni) \
                acc[mi][ni] = __builtin_amdgcn_mfma_f32_16x16x32_bf16(bfr[ni], af[mi], acc[mi][ni], 0, 0, 0); } } while (0)
#define GS_STEP(CUR, NXT, BREG_LD, BREG_WR) do { \
        if (MODE != 2 && s + DEPTH < S) GS_LOAD_B(BREG_LD); \
        if (MODE != 3 && s + 1 < S) GS_ISSUE_A(NXT); \
        __builtin_amdgcn_sched_barrier(0); \
        if (MODE != 1 && active) GS_COMPUTE(CUR); \
        __builtin_amdgcn_sched_barrier(0); \
        if (s + 1 < S) GS_WRITE_B(BREG_WR, NXT); \
        const bool pass_end = (cK + 1 == nk); \
        if (++cK == nk) { \
            if constexpr (TILE_EPI) { if (active) epi(cP, wr * 64 + fr, wc * 64 + fq * 4, cm, acc); } else \
            if (active) { \
                _Pragma("unroll") for (int mi = 0; mi < 4; ++mi) { const int r = wr * 64 + mi * 16 + fr; \
                    if (r < cm) { \
                        if constexpr (PAIR) { _Pragma("unroll") for (int ni = 0; ni < 2; ++ni) { epi(cP, r, wc * 64 + ni * 16 + fq * 4, acc[mi][ni], acc[mi][ni + 2]); } } \
                        else { _Pragma("unroll") for (int ni = 0; ni < 4; ++ni) { epi(cP, r, wc * 64 + ni * 16 + fq * 4, acc[mi][ni]); } } } } } \
            _Pragma("unroll") for (int i = 0; i < 4; ++i) _Pragma("unroll") for (int j = 0; j < 4; ++j) acc[i][j] = (f32x4){0.f, 0.f, 0.f, 0.f}; \
            cK = 0; ++cP; if (cP < npass) { cm = mrowsf(cP); active = (wr * 64) < cm; } \
        } \
        asm volatile("s_waitcnt lgkmcnt(0)" ::: "memory"); \
        if (DEPTH >= 2 && (s + DEPTH < S) && !pass_end) asm volatile("s_waitcnt vmcnt(4)" ::: "memory"); else asm volatile("s_waitcnt vmcnt(0)" ::: "memory"); \
        asm volatile("" ::: "memory"); __builtin_amdgcn_s_barrier(); asm volatile("" ::: "memory"); ++s; } while (0)
    int cP = 0, cK = 0, cm = mrowsf(0);
    bool active = (wr * 64) < cm;
    GS_SETA(); bp = bcol(0, n4);
    GS_ISSUE_A(0); GS_LOAD_B(bregX);
    GS_WRITE_B(bregX, 0);
    if constexpr (DEPTH >= 2) { if (1 < S) GS_LOAD_B(bregY); }
    static_assert(DEPTH == 1 || DEPTH == 2, "B prefetch depth");
    asm volatile("s_waitcnt lgkmcnt(0)" ::: "memory");
    asm volatile("s_waitcnt vmcnt(%0)" :: "n"((DEPTH - 1) * 4) : "memory");
    __syncthreads();
    int s = 0;
    if constexpr (DEPTH == 1) {
        while (s < S) { GS_STEP(0, 1, bregX, bregX); if (s >= S) break; GS_STEP(1, 0, bregX, bregX); }
    } else if constexpr (DEPTH == 2) {
        while (s < S) { GS_STEP(0, 1, bregX, bregY); if (s >= S) break; GS_STEP(1, 0, bregY, bregX); }
    }
#undef GS_SETA
#undef GS_BOFF
#undef GS_ISSUE_A
#undef GS_LOAD_B
#undef GS_WRITE_B
#undef GS_COMPUTE
#undef GS_STEP
}


template <class ARow, class BCol, class MRows, class Epi>
__device__ __forceinline__ void gemm_stream_rs(LAS unsigned char* lds, const unsigned char* Abase, int npass, int nk, int ldb, ARow arow, BCol bcol, MRows mrowsf, Epi epi) {
    int tid_ = threadIdx.x; asm volatile("" : "+v"(tid_));
    const int tid = tid_, wid = __builtin_amdgcn_readfirstlane(tid >> 6), lane = tid & 63;
    const int wr = wid >> 1, wc = wid & 1, fr = lane & 15, fq = lane >> 4;
    if (npass <= 0) return;
    const int S = npass * nk;
    const int Ccol = ((wid & 1) * 32 + 8 * ((lane & 3) ^ ((lane >> 5) << 1))) * 2;
    const int Rbase = 16 * (wid >> 1) + (lane >> 2);
    unsigned asrc[4];
    const int n4 = tid & 31, kb = tid >> 5;
    const float* bp;
    const int fB = ((kb & 3) << 2) | ((kb >> 2) & 3);
    const int bwoff = 256 * kb + 16 * ((n4 >> 1) ^ fB) + 8 * (n4 & 1);
    const int awoff = wid * 1024 + lane * 16;
    const int aoff = wr * 8192 + ((fr * 64 + fq * 16) ^ ((fr >> 3) << 5));
    const int q = (lane >> 2) & 3, pp = lane & 3;
    const int b0 = (wc * 8 + (pp >> 1)) ^ ((q << 2) | (2 * (fq & 1)));
    const int browoff = 256 * (fq * 8 + q) + 8 * (pp & 1);
#define RS_BOFF(v) (browoff + 16 * (b0 ^ (v)))
    f32x4 acc[4][4];
#pragma unroll
    for (int i = 0; i < 4; ++i)
#pragma unroll
        for (int j = 0; j < 4; ++j) acc[i][j] = (f32x4){0.f, 0.f, 0.f, 0.f};
    f32x4 bX[4], bY[4]; u32x4 aX[4], aY[4];
    int aP = 0, aK = 0, bP = 0, bK = 0;
#define RS_SETA() do { _Pragma("unroll") for (int _i = 0; _i < 4; ++_i) asrc[_i] = (unsigned)(arow(aP, Rbase + 64 * _i) + Ccol); } while (0)
#define RS_LOAD(AR, BR) do { \
        _Pragma("unroll") for (int _i = 0; _i < 4; ++_i) AR[_i] = *(const u32x4*)(Abase + (size_t)asrc[_i] + (size_t)aK * 128); \
        _Pragma("unroll") for (int _i = 0; _i < 4; ++_i) BR[_i] = *(const f32x4*)(bp + (size_t)(bK * 64 + kb + 16 * _i) * ldb); \
        if (++aK == nk) { aK = 0; if (aP + 1 < npass) { ++aP; RS_SETA(); } } \
        if (++bK == nk) { bK = 0; if (bP + 1 < npass) { ++bP; bp = bcol(bP, n4); } } } while (0)
#define RS_WRITE(AR, BR, buf) do { \
        _Pragma("unroll") for (int _i = 0; _i < 4; ++_i) *(LAS u32x4*)(lds + GEMM_LDS_A + (buf) * 32768 + _i * 8192 + awoff) = AR[_i]; \
        _Pragma("unroll") for (int _i = 0; _i < 4; ++_i) { u32x2 _w; _w.x = pk_bf16(BR[_i][0], BR[_i][1]); _w.y = pk_bf16(BR[_i][2], BR[_i][3]); \
            *(LAS u32x2*)(lds + GEMM_LDS_B + (buf) * 16384 + bwoff + 4096 * _i) = _w; } } while (0)
#define RS_COMPUTE(buf) do { _Pragma("unroll") for (int ks = 0; ks < 2; ++ks) { \
            bf16x8 af[4]; s16x4 tl0, tl1, tl2, tl3, th0, th1, th2, th3; \
            LAS unsigned char* bb_ = lds + GEMM_LDS_B + (buf) * 16384 + ks * 8192; \
            tl0 = tr_read(bb_ + RS_BOFF(0)); th0 = tr_read(bb_ + 1024 + RS_BOFF(1)); tl1 = tr_read(bb_ + RS_BOFF(2)); th1 = tr_read(bb_ + 1024 + RS_BOFF(3)); \
            tl2 = tr_read(bb_ + RS_BOFF(4)); th2 = tr_read(bb_ + 1024 + RS_BOFF(5)); tl3 = tr_read(bb_ + RS_BOFF(6)); th3 = tr_read(bb_ + 1024 + RS_BOFF(7)); \
            _Pragma("unroll") for (int mi = 0; mi < 4; ++mi) af[mi] = *(const LAS bf16x8*)(lds + GEMM_LDS_A + (buf) * 32768 + aoff + mi * 2048 + ks * 1024); \
            TR_WAIT8(tl0, th0, tl1, th1, tl2, th2, tl3, th3); \
            bf16x8 bfr[4]; \
            bfr[0] = (bf16x8){tl0[0], tl0[1], tl0[2], tl0[3], th0[0], th0[1], th0[2], th0[3]}; bfr[1] = (bf16x8){tl1[0], tl1[1], tl1[2], tl1[3], th1[0], th1[1], th1[2], th1[3]}; \
            bfr[2] = (bf16x8){tl2[0], tl2[1], tl2[2], tl2[3], th2[0], th2[1], th2[2], th2[3]}; bfr[3] = (bf16x8){tl3[0], tl3[1], tl3[2], tl3[3], th3[0], th3[1], th3[2], th3[3]}; \
            _Pragma("unroll") for (int mi = 0; mi < 4; ++mi) _Pragma("unroll") for (int ni = 0; ni < 4; ++ni) \
                acc[mi][ni] = __builtin_amdgcn_mfma_f32_16x16x32_bf16(bfr[ni], af[mi], acc[mi][ni], 0, 0, 0); } } while (0)
#define RS_STEP(CUR, NXT, A_LD, B_LD, A_WR, B_WR) do { \
        RS_LOAD(A_LD, B_LD); \
        __builtin_amdgcn_sched_barrier(0); \
        if (active) RS_COMPUTE(CUR); \
        __builtin_amdgcn_sched_barrier(0); \
        RS_WRITE(A_WR, B_WR, NXT); \
        if (++cK == nk) { \
            if (active) epi(cP, wr * 64 + fr, wc * 64 + fq * 4, cm, acc); \
            _Pragma("unroll") for (int i = 0; i < 4; ++i) _Pragma("unroll") for (int j = 0; j < 4; ++j) acc[i][j] = (f32x4){0.f, 0.f, 0.f, 0.f}; \
            cK = 0; ++cP; if (cP < npass) { cm = mrowsf(cP); active = (wr * 64) < cm; } \
        } \
        asm volatile("s_waitcnt lgkmcnt(0)" ::: "memory"); \
        asm volatile("" ::: "memory"); __builtin_amdgcn_s_barrier(); asm volatile("" ::: "memory"); ++s; } while (0)
    int cP = 0, cK = 0, cm = mrowsf(0);
    bool active = (wr * 64) < cm;
    RS_SETA(); bp = bcol(0, n4);
    RS_LOAD(aX, bX); RS_WRITE(aX, bX, 0);
    RS_LOAD(aY, bY);
    asm volatile("s_waitcnt lgkmcnt(0)" ::: "memory");
    __syncthreads();
    int s = 0;
    while (s < S) { RS_STEP(0, 1, aX, bX, aY, bY); if (s >= S) break; RS_STEP(1, 0, aY, bY, aX, bX); }
#undef RS_BOFF
#undef RS_SETA
#undef RS_LOAD
#undef RS_WRITE
#undef RS_COMPUTE
#undef RS_STEP
}

namespace pg8 {
#define PG8_LAS __attribute__((address_space(3)))
typedef unsigned short bf16_t;
typedef short bf16x8 __attribute__((ext_vector_type(8)));
typedef float f32x4 __attribute__((ext_vector_type(4)));
typedef unsigned u32x4 __attribute__((ext_vector_type(4)));
constexpr int BM = 256, BK = 64, HALF = 128, HTB = HALF * BK * 2  , STAGE_BYTES = 8 * HTB, NXCD = 8, WGM = 8;

__host__ __device__ __forceinline__ int lds_byte(int r, int c) { const int st = (r >> 4) * 2 + (c >> 5), rr = r & 15, cc = c & 31, ob = rr * 64 + cc * 2; return st * 1024 + (ob ^ (((ob >> 9) & 1) << 5)); }
__host__ __device__ __forceinline__ void stage_rc(int b, int& R, int& C) { const int st = b / 1024, sb = b % 1024, swz = sb ^ (((sb >> 9) & 1) << 5); R = (st >> 1) * 16 + swz / 64; C = (st & 1) * 32 + (swz % 64) / 2; }
__host__ __device__ __forceinline__ int perm32(int rho) { const int n = rho >> 4, i = rho & 15; return 8 * (i >> 2) + 4 * n + (i & 3); }

struct Unit { int pm, pn; };
struct Gemm { const bf16_t* A; const bf16_t* Bt; int M, N, K; };

struct StaticOrder {
    int nM, nN, nwg, G, c;
    __host__ __device__ void init(int M, int N, int G_, int c_) { nM = M / BM; nN = N / BM; nwg = nM * nN; G = G_; c = c_; }
    __host__ __device__ bool next(int i, Unit& u) const {
        const long L = (long)i * G + c; if (L >= nwg) return false;
        int wgid = (int)L; { const int q = nwg / NXCD, r = nwg % NXCD, xcd = wgid % NXCD, off = wgid / NXCD; wgid = (xcd < r ? xcd * (q + 1) : r * (q + 1) + (xcd - r) * q) + off; }
        const int nig = WGM * nN, gid = wgid / nig, fm = gid * WGM, gsz = (nM - fm) < WGM ? (nM - fm) : WGM;
        u.pm = fm + ((wgid % nig) % gsz); u.pn = (wgid % nig) / gsz; return true;
    }
    __device__ __forceinline__ void a_ready(const Unit&) const {}
    __device__ __forceinline__ void done(const Unit&) const {}
};
template <class Epi, class Sched>
__device__ __forceinline__ void gemm_phase(PG8_LAS unsigned char* lds, const Gemm g, const Sched& S, const Epi& E) {
    int tid_l = threadIdx.x; asm volatile("" : "+v"(tid_l));
    const int tid = tid_l, wid = __builtin_amdgcn_readfirstlane(tid >> 6), lane = tid & 63, wr = wid >> 2, wc = wid & 3, fr = lane & 15, fq = lane >> 4;
    const int K = g.K, nt = K / BK;

    unsigned voffA[2], voffB[2];
#pragma unroll
    for (int i = 0; i < 2; ++i) { int R, C; stage_rc(tid * 16 + i * 8192, R, C); const int Rb = Epi::PERM ? ((R & ~31) + perm32(R & 31)) : R;
        voffA[i] = (unsigned)(R * K + C) * 2u; voffB[i] = (unsigned)(Rb * K + C) * 2u; }
    const size_t kstep = (size_t)(BK * 2);
    const size_t hstep = (size_t)HALF * K * 2;
    const size_t tstep = 2 * hstep;
    const unsigned ldsw = (unsigned)wid * 1024u;
    const int aoff = lds_byte(wr * 64 + fr, fq * 8), boff = lds_byte(wc * 32 + fr, fq * 8);
#define PG8_SA(b, h) (((b) * 2 + (h)) * HTB)
#define PG8_SB(b, h) ((4 + (b) * 2 + (h)) * HTB)
#define PG8_STAGE(bufoff, gbase, voff) do { _Pragma("unroll") for (int _i = 0; _i < 2; ++_i) \
        __builtin_amdgcn_global_load_lds((const unsigned*)((const char*)(gbase) + (voff)[_i]), (PG8_LAS unsigned*)(lds + (bufoff) + ldsw + _i * 8192), 16, 0, 0); } while (0)
#define PG8_LDA(dst, b, h) do { _Pragma("unroll") for (int m = 0; m < 4; ++m) _Pragma("unroll") for (int k = 0; k < 2; ++k) dst[m][k] = *(const PG8_LAS bf16x8*)(lds + PG8_SA(b, h) + aoff + m * 2048 + k * 1024); } while (0)
#define PG8_LDB(dst, b, h) do { _Pragma("unroll") for (int n = 0; n < 2; ++n) _Pragma("unroll") for (int k = 0; k < 2; ++k) dst[n][k] = *(const PG8_LAS bf16x8*)(lds + PG8_SB(b, h) + boff + n * 2048 + k * 1024); } while (0)
#define PG8_MMA(ai, bj, At, Bt) do { __builtin_amdgcn_s_setprio(1); _Pragma("unroll") for (int m = 0; m < 4; ++m) _Pragma("unroll") for (int n = 0; n < 2; ++n) _Pragma("unroll") for (int k = 0; k < 2; ++k) \
        acc[ai][bj][m][n] = __builtin_amdgcn_mfma_f32_16x16x32_bf16(Bt[n][k], At[m][k], acc[ai][bj][m][n], 0, 0, 0); __builtin_amdgcn_s_setprio(0); } while (0)
#define PG8_WAIT_V(n) asm volatile("s_waitcnt vmcnt(" #n ")" ::: "memory")
#define PG8_WAIT_L(n) asm volatile("s_waitcnt lgkmcnt(" #n ")" ::: "memory")
#define PG8_BAR __builtin_amdgcn_s_barrier()
#define PG8_SCHED __builtin_amdgcn_sched_barrier(0)
    Unit cur, nxt; int ui = 0;
    if (!S.next(0, cur)) return;
    f32x4 acc[2][2][4][2];
#pragma unroll
    for (int a = 0; a < 2; ++a)
#pragma unroll
        for (int b = 0; b < 2; ++b)
#pragma unroll
            for (int m = 0; m < 4; ++m)
#pragma unroll
                for (int n = 0; n < 2; ++n) acc[a][b][m][n] = (f32x4){0.f, 0.f, 0.f, 0.f};
    bf16x8 At[4][2], B0[2][2], B1[2][2];
    const char* cA = (const char*)g.A + (size_t)cur.pm * tstep; const char* cB = (const char*)g.Bt + (size_t)cur.pn * tstep;
    S.a_ready(cur);
    PG8_STAGE(PG8_SB(0, 0), cB, voffB); PG8_STAGE(PG8_SA(0, 0), cA, voffA); PG8_STAGE(PG8_SB(0, 1), cB + hstep, voffB); PG8_STAGE(PG8_SA(0, 1), cA + hstep, voffA);
    if (wr == 1) PG8_BAR;
    PG8_WAIT_V(4); PG8_BAR;
    PG8_STAGE(PG8_SB(1, 0), cB + kstep, voffB); PG8_STAGE(PG8_SA(1, 0), cA + kstep, voffA); PG8_STAGE(PG8_SB(1, 1), cB + hstep + kstep, voffB);
    PG8_WAIT_V(6); PG8_BAR;

    for (;;) {
        const bool has_next = S.next(ui + 1, nxt);
        const char* nA = has_next ? (const char*)g.A + (size_t)nxt.pm * tstep : cA; const char* nB = has_next ? (const char*)g.Bt + (size_t)nxt.pn * tstep : cB;
        for (int t = 0; t < nt; t += 2) {
            const bool last = (t == nt - 2);
            const char* a1 = cA + (size_t)(t + 1) * kstep;
            const char* a2 = last ? nA : cA + (size_t)(t + 2) * kstep; const char* b2 = last ? nB : cB + (size_t)(t + 2) * kstep;
            const char* a3 = a2 + kstep; const char* b3 = b2 + kstep;
            if (last && has_next) S.a_ready(nxt);
            PG8_LDB(B0, 0, 0); PG8_SCHED; PG8_LDA(At, 0, 0); PG8_STAGE(PG8_SA(1, 1), a1 + hstep, voffA);
            PG8_WAIT_L(8); PG8_BAR; PG8_WAIT_L(0); PG8_MMA(0, 0, At, B0); PG8_BAR; PG8_SCHED;
            PG8_LDB(B1, 0, 1); PG8_STAGE(PG8_SB(0, 0), b2, voffB);
            PG8_BAR; PG8_WAIT_L(0); PG8_MMA(0, 1, At, B1); PG8_BAR;
            PG8_LDA(At, 0, 1); PG8_STAGE(PG8_SA(0, 0), a2, voffA);
            PG8_BAR; PG8_WAIT_L(0); PG8_MMA(1, 0, At, B0); PG8_BAR; PG8_SCHED;
            PG8_STAGE(PG8_SB(0, 1), b2 + hstep, voffB);
            PG8_WAIT_V(6); PG8_BAR; PG8_MMA(1, 1, At, B1); PG8_BAR;
            PG8_LDB(B0, 1, 0); PG8_SCHED; PG8_LDA(At, 1, 0); PG8_STAGE(PG8_SA(0, 1), a2 + hstep, voffA);
            PG8_WAIT_L(8); PG8_BAR; PG8_WAIT_L(0); PG8_MMA(0, 0, At, B0); PG8_BAR; PG8_SCHED;
            PG8_LDB(B1, 1, 1); PG8_STAGE(PG8_SB(1, 0), b3, voffB);
            PG8_BAR; PG8_WAIT_L(0); PG8_MMA(0, 1, At, B1); PG8_BAR;
            PG8_LDA(At, 1, 1); PG8_STAGE(PG8_SA(1, 0), a3, voffA);
            PG8_BAR; PG8_WAIT_L(0); PG8_MMA(1, 0, At, B0); PG8_BAR; PG8_SCHED;
            PG8_STAGE(PG8_SB(1, 1), b3 + hstep, voffB);
            PG8_WAIT_V(6); PG8_BAR; PG8_MMA(1, 1, At, B1); PG8_BAR;
        }

        if constexpr (!Epi::AFTER_DRAIN) { E(acc, cur, wr, wc, fr, fq); S.done(cur); }

        if (!has_next) break;
#pragma unroll
        for (int a = 0; a < 2; ++a)
#pragma unroll
            for (int b = 0; b < 2; ++b)
#pragma unroll
                for (int m = 0; m < 4; ++m)
#pragma unroll
                    for (int n = 0; n < 2; ++n) acc[a][b][m][n] = (f32x4){0.f, 0.f, 0.f, 0.f};
        cur = nxt; cA = nA; cB = nB; ++ui;
    }
    PG8_WAIT_V(0);
    if (wr == 0) PG8_BAR;
    PG8_BAR;
    if constexpr (Epi::AFTER_DRAIN) { E.fused(acc, cur, wr, wc, fr, fq, lds, wid, lane); S.done(cur); }

#undef PG8_SA
#undef PG8_SB
#undef PG8_STAGE
#undef PG8_LDA
#undef PG8_LDB
#undef PG8_MMA
#undef PG8_WAIT_V
#undef PG8_WAIT_L
#undef PG8_BAR
#undef PG8_SCHED
}
}
template <class F> struct EpiWrap {
    static constexpr bool PERM = false, AFTER_DRAIN = false; F f;
    __device__ __forceinline__ void operator()(const f32x4 (&acc)[2][2][4][2], const pg8::Unit& u, int wr, int wc, int fr, int fq) const { f(acc, u, wr, wc, fr, fq); }
};
template <class F> __device__ __forceinline__ EpiWrap<F> make_epi(F f) { return EpiWrap<F>{f}; }
template <class F> struct EpiWrapP {
    static constexpr bool PERM = true, AFTER_DRAIN = false; F f;
    __device__ __forceinline__ void operator()(const f32x4 (&acc)[2][2][4][2], const pg8::Unit& u, int wr, int wc, int fr, int fq) const { f(acc, u, wr, wc, fr, fq); }
};
template <class F> __device__ __forceinline__ EpiWrapP<F> make_epi_p(F f) { return EpiWrapP<F>{f}; }

__device__ __forceinline__ void transpose_item(const float* W, int K, int N, int Npad, bf16_t* WT, LAS float* scr, int item, int lane) {
    const int nblk = Npad / 32, kb = item / nblk, nb_ = item % nblk, k0 = 64 * kb, n0 = 32 * nb_;
#pragma unroll 8
    for (int i = 0; i < 32; ++i) { const int kk = 2 * i + (lane >> 5), n = n0 + (lane & 31); scr[kk * 33 + (lane & 31)] = n < N ? W[(size_t)(k0 + kk) * N + n] : 0.f; }
    asm volatile("s_waitcnt lgkmcnt(0)" ::: "memory");
    const int c = lane & 7;
#pragma unroll
    for (int j = 0; j < 4; ++j) { const int n = (lane >> 3) + 8 * j; const LAS float* sp = scr + (8 * c) * 33 + n;
        u32x4 o; o[0] = pk_bf16(sp[0 * 33], sp[1 * 33]); o[1] = pk_bf16(sp[2 * 33], sp[3 * 33]); o[2] = pk_bf16(sp[4 * 33], sp[5 * 33]); o[3] = pk_bf16(sp[6 * 33], sp[7 * 33]);
        *(u32x4*)(WT + (size_t)(n0 + n) * K + k0 + 8 * c) = o; }
    asm volatile("s_waitcnt lgkmcnt(0)" ::: "memory");
}

template <class ARow, class BCol, class MRows, class Epi>
__device__ __forceinline__ void gemm_stream_ws(LAS unsigned char* lds, const unsigned char* Abase, int npass, int nk, int ldb, ARow arow, BCol bcol, MRows mrowsf, Epi epi) {
    int tid_ = threadIdx.x; asm volatile("" : "+v"(tid_));
    const int tid = tid_, wid = __builtin_amdgcn_readfirstlane(tid >> 6), lane = tid & 63;
    if (npass <= 0) return;
    const int S = npass * nk;
#define WS_BAR() do { asm volatile("s_waitcnt lgkmcnt(0)" ::: "memory"); __builtin_amdgcn_s_barrier(); asm volatile("" ::: "memory"); } while (0)
    if (wid < 4) {
        const int wr2 = wid >> 1, wc = wid & 1, fr = lane & 15, fq = lane >> 4;
        const int aoff = wr2 * 16384 + ((fr * 64 + fq * 16) ^ ((fr >> 3) << 5));
        const int q = (lane >> 2) & 3, pp = lane & 3;
        const int b0 = (wc * 8 + (pp >> 1)) ^ ((q << 2) | (2 * (fq & 1)));
        const int browoff = 256 * (fq * 8 + q) + 8 * (pp & 1);
#define WS_BOFF(v) (browoff + 16 * (b0 ^ (v)))
        f32x4 acc[8][4];
#pragma unroll
        for (int i = 0; i < 8; ++i)
#pragma unroll
            for (int j = 0; j < 4; ++j) acc[i][j] = (f32x4){0.f, 0.f, 0.f, 0.f};
        int cP = 0, cK = 0, cm = mrowsf(0);
        bool active = (wr2 * 128) < cm;
#define WS_COMPUTE(buf) do { _Pragma("unroll") for (int ks = 0; ks < 2; ++ks) { \
            bf16x8 af[8]; s16x4 tl0, tl1, tl2, tl3, th0, th1, th2, th3; \
            LAS unsigned char* bb_ = lds + GEMM_LDS_B + (buf) * 16384 + ks * 8192; \
            tl0 = tr_read(bb_ + WS_BOFF(0)); th0 = tr_read(bb_ + 1024 + WS_BOFF(1)); tl1 = tr_read(bb_ + WS_BOFF(2)); th1 = tr_read(bb_ + 1024 + WS_BOFF(3)); \
            tl2 = tr_read(bb_ + WS_BOFF(4)); th2 = tr_read(bb_ + 1024 + WS_BOFF(5)); tl3 = tr_read(bb_ + WS_BOFF(6)); th3 = tr_read(bb_ + 1024 + WS_BOFF(7)); \
            _Pragma("unroll") for (int mi = 0; mi < 8; ++mi) af[mi] = *(const LAS bf16x8*)(lds + GEMM_LDS_A + (buf) * 32768 + aoff + mi * 2048 + ks * 1024); \
            TR_WAIT8(tl0, th0, tl1, th1, tl2, th2, tl3, th3); \
            bf16x8 bfr[4]; \
            bfr[0] = (bf16x8){tl0[0], tl0[1], tl0[2], tl0[3], th0[0], th0[1], th0[2], th0[3]}; bfr[1] = (bf16x8){tl1[0], tl1[1], tl1[2], tl1[3], th1[0], th1[1], th1[2], th1[3]}; \
            bfr[2] = (bf16x8){tl2[0], tl2[1], tl2[2], tl2[3], th2[0], th2[1], th2[2], th2[3]}; bfr[3] = (bf16x8){tl3[0], tl3[1], tl3[2], tl3[3], th3[0], th3[1], th3[2], th3[3]}; \
            _Pragma("unroll") for (int mi = 0; mi < 8; ++mi) _Pragma("unroll") for (int ni = 0; ni < 4; ++ni) \
                acc[mi][ni] = __builtin_amdgcn_mfma_f32_16x16x32_bf16(bfr[ni], af[mi], acc[mi][ni], 0, 0, 0); } } while (0)
#define WS_CSTEP(CUR) do { \
            if (active) WS_COMPUTE(CUR); \
            if (++cK == nk) { \
                if (active) epi(cP, wr2 * 128 + fr, wc * 64 + fq * 4, cm, acc); \
                _Pragma("unroll") for (int i = 0; i < 8; ++i) _Pragma("unroll") for (int j = 0; j < 4; ++j) acc[i][j] = (f32x4){0.f, 0.f, 0.f, 0.f}; \
                cK = 0; ++cP; if (cP < npass) { cm = mrowsf(cP); active = (wr2 * 128) < cm; } \
            } \
            WS_BAR(); ++s; } while (0)
        WS_BAR();
        int s = 0;
        while (s < S) { WS_CSTEP(0); if (s >= S) break; WS_CSTEP(1); }
#undef WS_BOFF
#undef WS_COMPUTE
#undef WS_CSTEP
    } else {
        const int pt = tid - 256;
        const int Ccol = (((pt >> 6) & 1) * 32 + 8 * ((lane & 3) ^ ((lane >> 5) << 1))) * 2;
        const int Rbase = 16 * (pt >> 7) + (lane >> 2);
        unsigned asrc[8];
        const int n4 = pt & 31, kb8 = pt >> 5;
        const float* bp;
        int bwoff[2];
#pragma unroll
        for (int par = 0; par < 2; ++par) { const int row = kb8 + 8 * par; const int fB = ((row & 3) << 2) | ((row >> 2) & 3); bwoff[par] = 256 * row + 16 * ((n4 >> 1) ^ fB) + 8 * (n4 & 1); }
        const int awoff = pt * 16;
        f32x4 bX[8], bY[8]; u32x4 aX[8], aY[8];
        int aP = 0, aK = 0, bP = 0, bK = 0;
#define WS_SETA() do { _Pragma("unroll") for (int _i = 0; _i < 8; ++_i) asrc[_i] = (unsigned)(arow(aP, Rbase + 32 * _i) + Ccol); } while (0)
#define WS_LOAD(AR, BR) do { \
            _Pragma("unroll") for (int _i = 0; _i < 8; ++_i) AR[_i] = *(const u32x4*)(Abase + (size_t)asrc[_i] + (size_t)aK * 128); \
            _Pragma("unroll") for (int _i = 0; _i < 8; ++_i) BR[_i] = *(const f32x4*)(bp + (size_t)(bK * 64 + kb8 + 8 * _i) * ldb); \
            if (++aK == nk) { aK = 0; if (aP + 1 < npass) { ++aP; WS_SETA(); } } \
            if (++bK == nk) { bK = 0; if (bP + 1 < npass) { ++bP; bp = bcol(bP, n4); } } } while (0)
#define WS_WRITE(AR, BR, buf) do { \
            _Pragma("unroll") for (int _i = 0; _i < 8; ++_i) *(LAS u32x4*)(lds + GEMM_LDS_A + (buf) * 32768 + _i * 4096 + awoff) = AR[_i]; \
            _Pragma("unroll") for (int _i = 0; _i < 8; ++_i) { u32x2 _w; _w.x = pk_bf16(BR[_i][0], BR[_i][1]); _w.y = pk_bf16(BR[_i][2], BR[_i][3]); \
                *(LAS u32x2*)(lds + GEMM_LDS_B + (buf) * 16384 + bwoff[_i & 1] + 4096 * (_i >> 1)) = _w; } } while (0)
#define WS_PSTEP(NXT, A_LD, B_LD, A_WR, B_WR) do { WS_LOAD(A_LD, B_LD); WS_WRITE(A_WR, B_WR, NXT); WS_BAR(); ++s; } while (0)
        WS_SETA(); bp = bcol(0, n4);
        WS_LOAD(aX, bX); WS_WRITE(aX, bX, 0);
        WS_LOAD(aY, bY);
        WS_BAR();
        int s = 0;
        while (s < S) { WS_PSTEP(1, aX, bX, aY, bY); if (s >= S) break; WS_PSTEP(0, aY, bY, aX, bX); }
#undef WS_SETA
#undef WS_LOAD
#undef WS_WRITE
#undef WS_PSTEP
    }
#undef WS_BAR
}

struct XcdDeal { int lo, step, n; };
#define TOPO_OFF (LDS_MISC + 16)
__device__ __forceinline__ XcdDeal xcd_deal(int U, const LAS unsigned char* lds, int nb) {
    const LAS int* tp_ = (const LAS int*)(lds + TOPO_OFF);
    const int px = tp_[0], cx = tp_[1], rank = tp_[2];
    XcdDeal d;
    const int xlo = (int)((long)px * U / nb), xhi = (int)((long)(px + cx) * U / nb);
    d.lo = xlo + rank; d.step = cx; d.n = (xhi - xlo - rank + cx - 1) / cx; if (d.n < 0) d.n = 0;
    return d;
}

__device__ __forceinline__ void phase0(const Params& p, int bid, int nb, float* smem, LAS unsigned char* smem_las) {
    const float* c = p.in[1]; const float* w_ada = p.in[2]; const float* b_ada = p.in[3];
    float* mod = (float*)(p.ws + WS_MOD);
    const int tid = threadIdx.x;
    float* sc = smem;
    float* red = smem + 2048;
    for (int i = tid; i < 2048; i += NT) { const float cv = c[i]; sc[i] = cv / (1.f + expf(-cv)); }
    __syncthreads();
    const int jl = tid & 63, kg = tid >> 6;
    for (int u = bid; u < 96; u += nb) {
        const int j = u * 64 + jl;
        float a0 = 0.f, a1 = 0.f;
#pragma unroll 8
        for (int k = kg * 128; k < kg * 128 + 128; ++k) { const float w = w_ada[(size_t)k * 6144 + j]; a0 += sc[k] * w; a1 += sc[1024 + k] * w; }
        red[(kg * 2 + 0) * 64 + jl] = a0; red[(kg * 2 + 1) * 64 + jl] = a1;
        __syncthreads();
        if (tid < 128) {
            const int bb = tid >> 6; float sacc = 0.f;
#pragma unroll
            for (int g2 = 0; g2 < 8; ++g2) sacc += red[(g2 * 2 + bb) * 64 + jl];
            mod[bb * 6144 + j] = sacc + b_ada[j];
        }
        __syncthreads();
    }
    {
        const float* conv_w = p.in[12]; const float* conv_b = p.in[13]; const float* wa = p.in[14]; const float* ba = p.in[15]; const float* wx = p.in[16]; const float* bx = p.in[17];
        float* BG = (float*)(p.ws + WS_BG); float* GB = (float*)(p.ws + WS_GBIAS);
        for (int idx = bid * NT + tid; idx < 8 * 256 * 128; idx += nb * NT) {
            const int n = idx & 127, k = (idx >> 7) & 255, hb = idx >> 15;
            const int w = k >> 6, i = k & 63, j = (n >> 6) * 32 + ((n >> 4) & 1) * 16 + (n & 15);
            const float* W = ((n >> 5) & 1) ? wx : wa;
            BG[idx] = conv_w[w * 512 + hb * 64 + i] * W[(hb * 64 + i) * 64 + j];
        }
        for (int idx = bid * NT + tid; idx < 8 * 128; idx += nb * NT) {
            const int n = idx & 127, hb = idx >> 7, j = (n >> 6) * 32 + ((n >> 4) & 1) * 16 + (n & 15);
            const bool isx = (n >> 5) & 1; const float* W = isx ? wx : wa;
            float acc = isx ? bx[hb * 64 + j] : ba[hb * 64 + j];
            for (int i = 0; i < 64; ++i) acc += conv_b[hb * 64 + i] * W[(hb * 64 + i) * 64 + j];
            GB[idx] = acc;
        }
        float* CB = (float*)(p.ws + WS_CBIAS); const float* pos = p.in[6];
        for (int idx = bid * NW + (tid >> 6); idx < 128; idx += nb * NW) {
            const int kv = idx >> 6, j = idx & 63; const float* w1 = kv ? p.in[9] : p.in[7];
            float acc = 0.f;
#pragma unroll 8
            for (int k = (tid & 63); k < 2048; k += 64) acc += pos[k] * w1[(size_t)k * 64 + j];
            acc = wave_sum(acc);
            if ((tid & 63) == 0) CB[idx] = acc;
        }
        bf16_t* XRB = (bf16_t*)(p.ws + WS_XRB);
        for (int idx = bid * NT + tid; idx < 16 * 3 * 64; idx += nb * NT) { const int sq = idx / 192, rem = idx % 192; XRB[(size_t)sq * SEQP * 64 + rem] = 0; }
    }
    {
        const f32x4* sp = (const f32x4*)p.in[23]; u32x2* dp = (u32x2*)(p.ws + WS_WRB);
        for (int i = bid * NT + tid; i < 1024 * 256 / 4; i += nb * NT) { const f32x4 v = sp[i]; u32x2 w; w.x = pk_bf16(v[0], v[1]); w.y = pk_bf16(v[2], v[3]); dp[i] = w; }
    }
    {
        LAS float* scr = (LAS float*)((LAS unsigned char*)smem_las + 16384 + (tid >> 6) * 8704);
        const int gw = bid * NW + (tid >> 6), ngw = nb * NW, lane_ = tid & 63;
        const int I1 = 16 * 80, I2 = 16 * 32;
        for (int it = gw; it < I1 + I2; it += ngw) {
            if (it < I1) transpose_item(p.in[5], 1024, NCOLS, 2560, (bf16_t*)(p.ws + WS_WINT), scr, it, lane_);
            else transpose_item(p.in[21], 1024, 1024, 1024, (bf16_t*)(p.ws + WS_WOUTT), scr, it - I1, lane_);
        }
    }
    float* lut = (float*)(p.ws + WS_LUT); const float* rel = p.in[11];
    for (int idx = bid * NT + tid; idx < 8 * 1024; idx += nb * NT) {
        const int h = idx >> 10, d = idx & 1023;
        int bucket;
        if (d < 16) bucket = d;
        else { const int l = 16 + (int)(logf((float)d / 16.0f) / 4.1588830833596715f * 16.0f); bucket = l < 31 ? l : 31; }
        lut[idx] = rel[bucket * 8 + h];
    }
}

__device__ __forceinline__ void phase_modnorm(const Params& p, int bid, int nb, const float* src, const float* nw, int sh_off, int sc_off, float* dst, bf16_t* dstb) {
    const float* mod = (const float*)(p.ws + WS_MOD);
    const int wave = threadIdx.x >> 6, lane = threadIdx.x & 63;
    (void)dst;
    for (int row = bid * NW + wave; row < MTOK; row += nb * NW) {
        const int b = row >> 13;
        const float* xr = src + (size_t)row * 1024 + lane * 16;
        f32x4 v[4]; float ss = 0.f;
#pragma unroll
        for (int i = 0; i < 4; ++i) { v[i] = *(const f32x4*)(xr + 4 * i); ss += (v[i][0] * v[i][0] + v[i][1] * v[i][1]) + (v[i][2] * v[i][2] + v[i][3] * v[i][3]); }
        ss = wave_sum(ss);
        const float rstd = 1.0f / sqrtf(ss * (1.f / 1024.f) + 1e-6f);
        u32x4 o[2];
#pragma unroll
        for (int i = 0; i < 4; ++i) {
            const int ci = lane * 16 + 4 * i;
            const f32x4 sh = *(const f32x4*)(mod + b * 6144 + sh_off + ci), sc = *(const f32x4*)(mod + b * 6144 + sc_off + ci), w = *(const f32x4*)(nw + ci);
            f32x4 h;
#pragma unroll
            for (int j = 0; j < 4; ++j) h[j] = v[i][j] * rstd * w[j] * (1.f + sc[j]) + sh[j];
            o[i >> 1][(i & 1) * 2 + 0] = pk_bf16(h[0], h[1]); o[i >> 1][(i & 1) * 2 + 1] = pk_bf16(h[2], h[3]);
        }
        *(u32x4*)(dstb + (size_t)row * 1024 + lane * 16) = o[0];
        *(u32x4*)(dstb + (size_t)row * 1024 + lane * 16 + 8) = o[1];
    }
}

__device__ __forceinline__ void phase2_e(const Params& p, int bid, int nb, LAS unsigned char* lds) {
    bf16_t* QB = (bf16_t*)(p.ws + WS_QB); bf16_t* KV6 = (bf16_t*)(p.ws + WS_KV6); float* GATE = (float*)(p.ws + WS_GATE);
    bf16_t* XRB = (bf16_t*)(p.ws + WS_XRB); bf16_t* GRG = (bf16_t*)(p.ws + WS_GRG);
    pg8::Gemm g{(const pg8::bf16_t*)(p.ws + WS_H1B), (const pg8::bf16_t*)(p.ws + WS_WINT), MTOK, 2560, 1024};
    pg8::StaticOrder S; S.init(MTOK, 2560, nb, bid);
    auto E = make_epi_p([=](const f32x4 (&acc)[2][2][4][2], const pg8::Unit& u, int wr, int wc, int fr, int fq) {
#pragma unroll
        for (int ai = 0; ai < 2; ++ai)
#pragma unroll
            for (int mm = 0; mm < 4; ++mm) {
                const int m = u.pm * 256 + ai * 128 + wr * 64 + mm * 16 + fr;
#pragma unroll
                for (int bj = 0; bj < 2; ++bj) {
                    const int col = u.pn * 256 + bj * 128 + wc * 32 + fq * 8;
                    const f32x4 v0 = acc[ai][bj][mm][0], v1 = acc[ai][bj][mm][1];
                    if (col >= NCOLS) continue;
                    if (col < 512) {
                        const float sc = 0.125f * LOG2E; u32x4 w; w[0] = pk_bf16(v0[0] * sc, v0[1] * sc); w[1] = pk_bf16(v0[2] * sc, v0[3] * sc); w[2] = pk_bf16(v1[0] * sc, v1[1] * sc); w[3] = pk_bf16(v1[2] * sc, v1[3] * sc);
                        *(u32x4*)(QB + (size_t)m * 512 + col) = w;
                    } else if (col >= 1280 && col < 1304) {
                        f32x4 g0, g1;
#pragma unroll
                        for (int j = 0; j < 4; ++j) { g0[j] = sigm(v0[j]); g1[j] = sigm(v1[j]); }
                        *(f32x4*)(GATE + (size_t)m * 24 + (col - 1280)) = g0; *(f32x4*)(GATE + (size_t)m * 24 + (col - 1280) + 4) = g1;
                    } else if (col < 1280) {
                        const int c2 = col - 512, j6 = c2 >> 7, gg = (c2 >> 6) & 1, d = c2 & 63, bb = m >> 13, t = m & 8191;
                        u32x4 w; w[0] = pk_bf16(v0[0], v0[1]); w[1] = pk_bf16(v0[2], v0[3]); w[2] = pk_bf16(v1[0], v1[1]); w[3] = pk_bf16(v1[2], v1[3]);
                        *(u32x4*)(KV6 + (size_t)j6 * 2097152 + ((size_t)((bb * 2 + gg) * SEQ + t)) * 64 + d) = w;
                    } else if (col < 1816) {
                        const int c = col - 1304, hb = c >> 6, bb = m >> 13, t = m & 8191;
                        u32x4 w; w[0] = pk_bf16(v0[0], v0[1]); w[1] = pk_bf16(v0[2], v0[3]); w[2] = pk_bf16(v1[0], v1[1]); w[3] = pk_bf16(v1[2], v1[3]);
                        *(u32x4*)(XRB + ((size_t)(bb * 8 + hb) * SEQP + 3 + t) * 64 + (c & 63)) = w;
                    } else {
                        u32x4 w; w[0] = pk_bf16(gelu_t(v0[0]), gelu_t(v0[1])); w[1] = pk_bf16(gelu_t(v0[2]), gelu_t(v0[3])); w[2] = pk_bf16(gelu_t(v1[0]), gelu_t(v1[1])); w[3] = pk_bf16(gelu_t(v1[2]), gelu_t(v1[3]));
                        *(u32x4*)(GRG + (size_t)m * 512 + (col - 1816)) = w;
                    }
                }
            }
    });
    pg8::gemm_phase(lds, g, S, E);
}

__device__ __forceinline__ void phase5_e(const Params& p, int bid, int nb, LAS unsigned char* lds) {
    const float* x = p.in[0]; const float* mod = (const float*)(p.ws + WS_MOD); float* X1 = (float*)(p.ws + WS_X1);
    pg8::Gemm g{(const pg8::bf16_t*)(p.ws + WS_YB), (const pg8::bf16_t*)(p.ws + WS_WOUTT), MTOK, 1024, 1024};
    pg8::StaticOrder S; S.init(MTOK, 1024, nb, bid);
    auto E = make_epi([=](const f32x4 (&acc)[2][2][4][2], const pg8::Unit& u, int wr, int wc, int fr, int fq) {
        const int c0 = u.pn * 256 + wc * 32 + fq * 4;
        const int bb = (u.pm * 256) >> 13;
        f32x4 gv[2][2];
#pragma unroll
        for (int bj = 0; bj < 2; ++bj)
#pragma unroll
            for (int nn = 0; nn < 2; ++nn) gv[bj][nn] = *(const f32x4*)(mod + bb * 6144 + 2048 + c0 + bj * 128 + nn * 16);
#pragma unroll
        for (int ai = 0; ai < 2; ++ai)
#pragma unroll
            for (int mm = 0; mm < 4; ++mm) {
                const size_t o = (size_t)(u.pm * 256 + ai * 128 + wr * 64 + mm * 16 + fr) * 1024 + c0;
                f32x4 xv[2][2];
#pragma unroll
                for (int bj = 0; bj < 2; ++bj)
#pragma unroll
                    for (int nn = 0; nn < 2; ++nn) xv[bj][nn] = *(const f32x4*)(x + o + bj * 128 + nn * 16);
#pragma unroll
                for (int bj = 0; bj < 2; ++bj)
#pragma unroll
                    for (int nn = 0; nn < 2; ++nn) *(f32x4*)(X1 + o + bj * 128 + nn * 16) = xv[bj][nn] + gv[bj][nn] * acc[ai][bj][mm][nn];
            }
    });
    pg8::gemm_phase(lds, g, S, E);
}

#ifndef A4_PROBE_MASK
#define A4_PROBE_MASK 7
#endif
#define A4_KV 0
#define A4_SCORE 65536
#define A4_LUT 131200
#define LUTP 1156
#define A4_SELM 149760
__device__ __forceinline__ float ex2(float x) { return __builtin_amdgcn_exp2f(x); }

__device__ __forceinline__ float xmax_16_32(float v) {
    { auto r = __builtin_amdgcn_permlane16_swap(__float_as_uint(v), __float_as_uint(v), false, false); v = fmaxf(__uint_as_float(r[0]), __uint_as_float(r[1])); }
    { auto r = __builtin_amdgcn_permlane32_swap(__float_as_uint(v), __float_as_uint(v), false, false); v = fmaxf(__uint_as_float(r[0]), __uint_as_float(r[1])); }
    return v;
}
__device__ __forceinline__ float xsum_16_32(float v) {
    { auto r = __builtin_amdgcn_permlane16_swap(__float_as_uint(v), __float_as_uint(v), false, false); v = __uint_as_float(r[0]) + __uint_as_float(r[1]); }
    { auto r = __builtin_amdgcn_permlane32_swap(__float_as_uint(v), __float_as_uint(v), false, false); v = __uint_as_float(r[0]) + __uint_as_float(r[1]); }
    return v;
}


__device__ __forceinline__ void phase4_mfma(unsigned char* ws, int bid, int nb, LAS unsigned char* lds) {
    int tid_ = threadIdx.x; asm volatile("" : "+v"(tid_));
    const int tid = tid_, wid = __builtin_amdgcn_readfirstlane(tid >> 6), lane = tid & 63;
    const int col = lane & 15, tl = col >> 2, hd = col & 3, g4 = lane >> 4, fr = col;
    const bf16_t* QB = (const bf16_t*)(ws + WS_QB);
    const unsigned char* KV6 = ws + WS_KV6;
    const unsigned char* KCB = ws + WS_KCB; const unsigned char* VCB = ws + WS_VCB;
    const float* lutg = (const float*)(ws + WS_LUT);
    const float* GATE = (const float*)(ws + WS_GATE);
    float* OATT = (float*)(ws + WS_OATT);
    LAS float* lutl = (LAS float*)(lds + A4_LUT);
    LAS float* score = (LAS float*)(lds + A4_SCORE);
    LAS unsigned* selm = (LAS unsigned*)(lds + A4_SELM);
    const int koff0 = fr * 128 + 16 * ((g4) ^ (fr & 7)), koff1 = fr * 128 + 16 * ((4 + g4) ^ (fr & 7));
    const int q4 = (lane >> 2) & 3, pp = lane & 3, xk = (g4 & 1) * 4 + q4;
    int voff[4];
#pragma unroll
    for (int db = 0; db < 4; ++db) voff[db] = (g4 * 4 + q4) * 128 + 16 * ((db * 2 + (pp >> 1)) ^ xk) + 8 * (pp & 1);
    const int dr = tid >> 3, dsrc = dr * 128 + (((tid & 7) ^ (dr & 7)) * 16);

#define A4_ISSUE(kbase, vbase, stage) do { \
        __builtin_amdgcn_global_load_lds((const unsigned*)((kbase) + dsrc), (LAS unsigned*)(lds + A4_KV + (stage) * 16384 + wid * 1024), 16, 0, 0); \
        if (vbase) __builtin_amdgcn_global_load_lds((const unsigned*)((vbase) + dsrc), (LAS unsigned*)(lds + A4_KV + (stage) * 16384 + 8192 + wid * 1024), 16, 0, 0); } while (0)
#define A4_SYNC() do { asm volatile("s_waitcnt vmcnt(0)" ::: "memory"); __syncthreads(); } while (0)
#define A4_SYNC_RING(issued) do { asm volatile("s_waitcnt lgkmcnt(0)" ::: "memory"); if (issued) asm volatile("s_waitcnt vmcnt(2)" ::: "memory"); else asm volatile("s_waitcnt vmcnt(0)" ::: "memory"); \
        asm volatile("" ::: "memory"); __builtin_amdgcn_s_barrier(); asm volatile("" ::: "memory"); } while (0)

    for (int u2 = bid; u2 < 256; u2 += nb)
    for (int hf = 0; hf < 2; ++hf)
    for (int rep4 = 0; rep4 < ((REP & 64) ? 2 : 1); ++rep4) {
        const bool probe = rep4 > 0; const int amask = probe ? A4_PROBE_MASK : 7;
        const int bg = u2 >> 6, b = bg >> 1, g = bg & 1;
        const int T = hf ? 127 - (u2 & 63) : (u2 & 63);
        const int t0 = T * 64;
        const size_t seqbase = (size_t)(b * 2 + g) * SEQ;
        __syncthreads();
        for (int i = tid; i < 4 * 1152; i += NT) { const int hh = i / 1152, dd = i - hh * 1152; lutl[hh * LUTP + dd] = lutg[(g * 4 + hh) * 1024 + (dd < 1023 ? dd : 1023)] * LOG2E; }
        if (!probe) for (int i = tid; i < 8192; i += NT) score[i] = 0.f;
        int tq[2]; tq[0] = t0 + 8 * wid + tl; tq[1] = tq[0] + 4;
        bf16x8 qf[2][2];
#pragma unroll
        for (int ct = 0; ct < 2; ++ct) {
            const size_t m = (size_t)b * SEQ + tq[ct];
#pragma unroll
            for (int h2 = 0; h2 < 2; ++h2) qf[ct][h2] = *(const bf16x8*)(QB + m * 512 + (g * 4 + hd) * 64 + h2 * 32 + g4 * 8);
        }
#define A4_GATEV(ct, br) (GATE[((size_t)b * SEQ + tq[ct]) * 24 + (g * 4 + hd) * 3 + (br)])
        __syncthreads();

        float mrun[2], lrun[2];
        f32x4 O[2][4];
        bf16x8 kf[4][2];
        f32x4 sv[4];
#define A4_LOADK(stage) do { _Pragma("unroll") for (int kt = 0; kt < 4; ++kt) { \
            kf[kt][0] = *(const LAS bf16x8*)(lds + A4_KV + (stage) * 16384 + kt * 2048 + koff0); \
            kf[kt][1] = *(const LAS bf16x8*)(lds + A4_KV + (stage) * 16384 + kt * 2048 + koff1); } } while (0)
#define A4_SCORES(ct) do { _Pragma("unroll") for (int kt = 0; kt < 4; ++kt) { \
            sv[kt] = __builtin_amdgcn_mfma_f32_16x16x32_bf16(kf[kt][0], qf[ct][0], (f32x4){0.f, 0.f, 0.f, 0.f}, 0, 0, 0); \
            sv[kt] = __builtin_amdgcn_mfma_f32_16x16x32_bf16(kf[kt][1], qf[ct][1], sv[kt], 0, 0, 0); } } while (0)
#define A4_VREADS(stage, a, l0, h0, l1, h1, l2, h2, l3, h3) do { \
            LAS unsigned char* vb_ = lds + A4_KV + (stage) * 16384 + 8192 + (a) * 4096; \
            l0 = tr_read(vb_ + voff[0]); h0 = tr_read(vb_ + 2048 + voff[0]); l1 = tr_read(vb_ + voff[1]); h1 = tr_read(vb_ + 2048 + voff[1]); \
            l2 = tr_read(vb_ + voff[2]); h2 = tr_read(vb_ + 2048 + voff[2]); l3 = tr_read(vb_ + voff[3]); h3 = tr_read(vb_ + 2048 + voff[3]); } while (0)
#define A4_PVMMA(ct, a, l0, h0, l1, h1, l2, h2, l3, h3) do { \
            u32x4 pw; pw[0] = pk_bf16(sv[2 * (a)][0], sv[2 * (a)][1]); pw[1] = pk_bf16(sv[2 * (a)][2], sv[2 * (a)][3]); \
            pw[2] = pk_bf16(sv[2 * (a) + 1][0], sv[2 * (a) + 1][1]); pw[3] = pk_bf16(sv[2 * (a) + 1][2], sv[2 * (a) + 1][3]); \
            const bf16x8 pf = __builtin_bit_cast(bf16x8, pw); \
            O[ct][0] = __builtin_amdgcn_mfma_f32_16x16x32_bf16((bf16x8){l0[0], l0[1], l0[2], l0[3], h0[0], h0[1], h0[2], h0[3]}, pf, O[ct][0], 0, 0, 0); \
            O[ct][1] = __builtin_amdgcn_mfma_f32_16x16x32_bf16((bf16x8){l1[0], l1[1], l1[2], l1[3], h1[0], h1[1], h1[2], h1[3]}, pf, O[ct][1], 0, 0, 0); \
            O[ct][2] = __builtin_amdgcn_mfma_f32_16x16x32_bf16((bf16x8){l2[0], l2[1], l2[2], l2[3], h2[0], h2[1], h2[2], h2[3]}, pf, O[ct][2], 0, 0, 0); \
            O[ct][3] = __builtin_amdgcn_mfma_f32_16x16x32_bf16((bf16x8){l3[0], l3[1], l3[2], l3[3], h3[0], h3[1], h3[2], h3[3]}, pf, O[ct][3], 0, 0, 0); } while (0)
#define A4_ONLINE_PV(ct, stage) do { \
            s16x4 va0, va1, va2, va3, va4, va5, va6, va7; \
            A4_VREADS(stage, 0, va0, va1, va2, va3, va4, va5, va6, va7); \
            float mx = fmaxf(fmaxf(sv[0][0], sv[0][1]), fmaxf(sv[0][2], sv[0][3])); \
            _Pragma("unroll") for (int kt = 1; kt < 4; ++kt) _Pragma("unroll") for (int j = 0; j < 4; ++j) mx = fmaxf(mx, sv[kt][j]); \
            mx = xmax_16_32(mx); \
            const float mnew = fmaxf(mrun[ct], mx); const float muse = (mnew == -INF) ? 0.f : mnew; \
            const float scl = ex2(mrun[ct] - muse); mrun[ct] = mnew; \
            const float nmu = -muse; \
            _Pragma("unroll") for (int kt = 0; kt < 4; ++kt) { sv[kt] += nmu; _Pragma("unroll") for (int j = 0; j < 4; ++j) sv[kt][j] = ex2(sv[kt][j]); } \
            const f32x4 ls4 = (sv[0] + sv[1]) + (sv[2] + sv[3]); const float ls = (ls4[0] + ls4[1]) + (ls4[2] + ls4[3]); \
            lrun[ct] = lrun[ct] * scl + ls; \
            if (__builtin_amdgcn_ballot_w64(scl != 1.f) != 0ull) { _Pragma("unroll") for (int db = 0; db < 4; ++db) O[ct][db] *= scl; } \
            TR_WAIT8(va0, va1, va2, va3, va4, va5, va6, va7); \
            s16x4 vb0, vb1, vb2, vb3, vb4, vb5, vb6, vb7; \
            A4_VREADS(stage, 1, vb0, vb1, vb2, vb3, vb4, vb5, vb6, vb7); \
            A4_PVMMA(ct, 0, va0, va1, va2, va3, va4, va5, va6, va7); \
            TR_WAIT8(vb0, vb1, vb2, vb3, vb4, vb5, vb6, vb7); \
            A4_PVMMA(ct, 1, vb0, vb1, vb2, vb3, vb4, vb5, vb6, vb7); } while (0)
#define A4_PV(ct, stage) do { \
            s16x4 va0, va1, va2, va3, va4, va5, va6, va7; \
            A4_VREADS(stage, 0, va0, va1, va2, va3, va4, va5, va6, va7); \
            TR_WAIT8(va0, va1, va2, va3, va4, va5, va6, va7); \
            A4_PVMMA(ct, 0, va0, va1, va2, va3, va4, va5, va6, va7); \
            A4_VREADS(stage, 1, va0, va1, va2, va3, va4, va5, va6, va7); \
            TR_WAIT8(va0, va1, va2, va3, va4, va5, va6, va7); \
            A4_PVMMA(ct, 1, va0, va1, va2, va3, va4, va5, va6, va7); } while (0)
#define A4_RESET() do { _Pragma("unroll") for (int ct = 0; ct < 2; ++ct) { mrun[ct] = -INF; lrun[ct] = 0.f; \
            _Pragma("unroll") for (int db = 0; db < 4; ++db) O[ct][db] = (f32x4){0.f, 0.f, 0.f, 0.f}; } } while (0)
#define A4_FINISH(br, first) do { _Pragma("unroll") for (int ct = 0; ct < 2; ++ct) { \
            float lt = lrun[ct]; lt = xsum_16_32(lt); \
            const float wv = A4_GATEV(ct, br) / fmaxf(lt, 1e-30f); \
            float* op = OATT + ((size_t)b * SEQ + tq[ct]) * 512 + (g * 4 + hd) * 64 + g4 * 4; \
            _Pragma("unroll") for (int db = 0; db < 4; ++db) { f32x4 r = O[ct][db] * wv; if (!(first)) r += *(const f32x4*)(op + db * 16); *(f32x4*)(op + db * 16) = r; } } } while (0)

        if (amask & 1) {
            const unsigned char* KW = KV6 + (size_t)4 * 4194304 + seqbase * 128; const unsigned char* VW = KV6 + (size_t)5 * 4194304 + seqbase * 128;
            A4_RESET();
            const int s0 = T >= 8 ? 0 : 8 - T;
            { const int jb = T - 8 + s0; A4_ISSUE(KW + (size_t)jb * 8192, VW + (size_t)jb * 8192, 0);
              if (s0 < 8) { A4_ISSUE(KW + (size_t)(jb + 1) * 8192, VW + (size_t)(jb + 1) * 8192, 1); asm volatile("s_waitcnt vmcnt(2)" ::: "memory"); } else asm volatile("s_waitcnt vmcnt(0)" ::: "memory");
              __syncthreads(); }
            int stage = 0;
            for (int s = s0; s <= 8; ++s) {
                const int jb = T - 8 + s;
                const bool iss = (s + 2 <= 8);
                if (iss) { const int st2 = stage >= 1 ? stage - 1 : 2; const unsigned char* kn = KW + (size_t)(jb + 2) * 8192; const unsigned char* vn = VW + (size_t)(jb + 2) * 8192; A4_ISSUE(kn, vn, st2); }
#pragma unroll
                for (int ct = 0; ct < 2; ++ct) {
                    A4_LOADK(stage);
                    A4_SCORES(ct);
                    __builtin_amdgcn_sched_barrier(0);
                    const int t = tq[ct];
                    {
                        const int base = t - jb * 64 - g4 * 4;
                        const LAS float* lp = lutl + hd * LUTP + base - 51;
                        const bool edge = (s == 0) || (s == 8);
#pragma unroll
                        for (int kt = 0; kt < 4; ++kt) {
                            f32x4 bs;
#pragma unroll
                            for (int j = 0; j < 4; ++j) bs[j] = lp[51 - kt * 16 - j];
                            asm volatile("" : "+v"(bs));
                            sv[kt] += bs;
                        }
                        if (edge) {
#pragma unroll
                            for (int kt = 0; kt < 4; ++kt)
#pragma unroll
                                for (int j = 0; j < 4; ++j) { const int dist = base - kt * 16 - j; sv[kt][j] = ((dist >= 0) && (dist < 512)) ? sv[kt][j] : -INF; }
                        }
                    }
                    A4_ONLINE_PV(ct, stage);
                    __builtin_amdgcn_sched_barrier(0);
                }
                A4_SYNC_RING(iss);
                stage = stage == 2 ? 0 : stage + 1;
            }
            if (!probe) A4_FINISH(2, true);
        }
        if (amask & 2) {
            const unsigned char* KC = KCB + (size_t)(b * 2 + g) * 512 * 128; const unsigned char* VC = VCB + (size_t)(b * 2 + g) * 512 * 128;
            int ncmp = 4 * T + 3; if (ncmp > NCMP) ncmp = NCMP;
            const int nblk = (ncmp + 63) >> 6;
            A4_RESET();
            A4_ISSUE(KC, (const unsigned char*)nullptr, 0);
            A4_SYNC();
            for (int s = 0; s < nblk; ++s) {
                const int stage = s & 1;
                if (s + 1 < nblk) A4_ISSUE(KC + (size_t)(s + 1) * 8192, (const unsigned char*)nullptr, stage ^ 1);
#pragma unroll
                for (int ct = 0; ct < 2; ++ct) {
                    A4_LOADK(stage);
                    A4_SCORES(ct);
                    __builtin_amdgcn_sched_barrier(0);
                    const int t = tq[ct];
                    float mx = -INF;
#pragma unroll
                    for (int kt = 0; kt < 4; ++kt) {
                        f32x4 bs;
#pragma unroll
                        for (int j = 0; j < 4; ++j) { int dist = t - (16 * (s * 64 + kt * 16 + g4 * 4 + j) + 31); dist = dist < 1023 ? dist : 1023; bs[j] = lutl[hd * LUTP + (dist & 1023)]; }
                        asm volatile("" : "+v"(bs));
#pragma unroll
                        for (int j = 0; j < 4; ++j) {
                            const int n = s * 64 + kt * 16 + g4 * 4 + j; const int dist = t - (16 * n + 31);
                            const bool ok = (dist >= 0) && (n < NCMP);
                            sv[kt][j] = ok ? sv[kt][j] + bs[j] : -INF; mx = fmaxf(mx, sv[kt][j]);
                        }
                    }
                    mx = xmax_16_32(mx);
                    const float mnew = fmaxf(mrun[ct], mx); const float muse = (mnew == -INF) ? 0.f : mnew;
                    const float scl = ex2(mrun[ct] - muse); mrun[ct] = mnew;
                    float ls = 0.f;
#pragma unroll
                    for (int kt = 0; kt < 4; ++kt)
#pragma unroll
                        for (int j = 0; j < 4; ++j) ls += ex2(sv[kt][j] - muse);
                    lrun[ct] = lrun[ct] * scl + ls;
                    __builtin_amdgcn_sched_barrier(0);
                }
                A4_SYNC();
            }
            float mfin[2], linv[2];
#pragma unroll
            for (int ct = 0; ct < 2; ++ct) {
                float lt = lrun[ct]; lt = xsum_16_32(lt);
                linv[ct] = 1.f / fmaxf(lt, 1e-30f); mfin[ct] = (mrun[ct] == -INF) ? 0.f : mrun[ct];
            }
            A4_ISSUE(KC, VC, 0);
            A4_SYNC();
            for (int s = 0; s < nblk; ++s) {
                const int stage = s & 1;
                if (s + 1 < nblk) { const unsigned char* kn = KC + (size_t)(s + 1) * 8192; const unsigned char* vn = VC + (size_t)(s + 1) * 8192; A4_ISSUE(kn, vn, stage ^ 1); }
#pragma unroll
                for (int ct = 0; ct < 2; ++ct) {
                    A4_LOADK(stage);
                    A4_SCORES(ct);
                    __builtin_amdgcn_sched_barrier(0);
                    const int t = tq[ct];
#pragma unroll
                    for (int kt = 0; kt < 4; ++kt) {
                        f32x4 bs;
#pragma unroll
                        for (int j = 0; j < 4; ++j) { int dist = t - (16 * (s * 64 + kt * 16 + g4 * 4 + j) + 31); dist = dist < 1023 ? dist : 1023; bs[j] = lutl[hd * LUTP + (dist & 1023)]; }
                        asm volatile("" : "+v"(bs));
#pragma unroll
                        for (int j = 0; j < 4; ++j) {
                            const int n = s * 64 + kt * 16 + g4 * 4 + j; const int dist = t - (16 * n + 31);
                            const bool ok = (dist >= 0) && (n < NCMP);
                            sv[kt][j] = ok ? ex2(sv[kt][j] + bs[j] - mfin[ct]) * linv[ct] : 0.f;
                        }
                        float s4 = (sv[kt][0] + sv[kt][1]) + (sv[kt][2] + sv[kt][3]); float s3 = sv[kt][3];
                        s4 += __shfl_xor(s4, 1); s4 += __shfl_xor(s4, 2); s3 += __shfl_xor(s3, 1); s3 += __shfl_xor(s3, 2);
                        const int a = s * 16 + kt * 4 + g4;
                        if (hd == 0 && !probe) {
                            LAS float* sp = score + (8 * wid + 4 * ct + tl) * 128 + a;
                            atomicAdd((float*)sp, s4);
                            if (a + 1 < 128) atomicAdd((float*)(sp + 1), s3);
                        }
                    }
                    A4_PV(ct, stage);
                    __builtin_amdgcn_sched_barrier(0);
                }
                A4_SYNC();
            }
            if (!probe)
#pragma unroll
            for (int ct = 0; ct < 2; ++ct) {
                float* op = OATT + ((size_t)b * SEQ + tq[ct]) * 512 + (g * 4 + hd) * 64 + g4 * 4;
#pragma unroll
                for (int db = 0; db < 4; ++db) { const float gcv = A4_GATEV(ct, 0); f32x4 r = O[ct][db] * gcv; r += *(const f32x4*)(op + db * 16); *(f32x4*)(op + db * 16) = r; }
            }
        }
        __syncthreads();
        if (!probe)
        for (int tt = 0; tt < 8; ++tt) {
            const int ti = 8 * wid + tt;
            const int j0 = lane, j1 = lane + 64;
            bool sel0, sel1;
            if (T <= 15) { sel0 = j0 <= T; sel1 = false; }
            else {
                const bool c0 = (j0 >= 1) && (j0 <= T - 2), c1 = (j1 <= T - 2);
                const float s0 = c0 ? score[ti * 128 + j0] : -INF, s1 = c1 ? score[ti * 128 + j1] : -INF;
                int r0 = 0, r1 = 0;
                for (int j2 = 1; j2 <= T - 2; ++j2) { const float v = score[ti * 128 + j2]; r0 += (v > s0) || (v == s0 && j2 < j0); r1 += (v > s1) || (v == s1 && j2 < j1); }
                sel0 = (c0 && r0 < 13) || (j0 == 0) || (j0 == T) || (j0 == T - 1);
                sel1 = (c1 && r1 < 13) || (j1 == T) || (j1 == T - 1);
            }
            const unsigned long long b0 = __ballot(sel0), b1 = __ballot(sel1);
            if (lane == 0) { selm[ti * 4 + 0] = (unsigned)b0; selm[ti * 4 + 1] = (unsigned)(b0 >> 32); selm[ti * 4 + 2] = (unsigned)b1; selm[ti * 4 + 3] = (unsigned)(b1 >> 32); }
        }
        __builtin_amdgcn_wave_barrier();
        asm volatile("s_waitcnt lgkmcnt(0)" ::: "memory");
        if (amask & 4) {
            const unsigned char* KS = KV6 + (size_t)2 * 4194304 + seqbase * 128; const unsigned char* VS = KV6 + (size_t)3 * 4194304 + seqbase * 128;
            unsigned un[2][4];
#pragma unroll
            for (int ct = 0; ct < 2; ++ct)
#pragma unroll
                for (int w = 0; w < 4; ++w) {
                    unsigned uu = selm[(8 * wid + 4 * ct + 0) * 4 + w] | selm[(8 * wid + 4 * ct + 1) * 4 + w] | selm[(8 * wid + 4 * ct + 2) * 4 + w] | selm[(8 * wid + 4 * ct + 3) * 4 + w];
                    un[ct][w] = __builtin_amdgcn_readfirstlane(uu);
                }
            A4_RESET();
            const float cbfar = lutl[hd * LUTP + 1023];
            __syncthreads();
#pragma unroll
            for (int bq = 0; bq < 4; ++bq) if (bq <= T) { const unsigned char* kn = KS + (size_t)bq * 8192; const unsigned char* vn = VS + (size_t)bq * 8192; A4_ISSUE(kn, vn, bq); }
            A4_SYNC();
#pragma unroll
            for (int w = 0; w < 4; ++w) {
                const unsigned selw0 = selm[(8 * wid + tl) * 4 + w], selw1 = selm[(8 * wid + 4 + tl) * 4 + w];
                for (int gg = 0; gg < 8; ++gg) {
                    const int j0 = w * 32 + gg * 4;
                    if (j0 > T) break;
#pragma unroll
                    for (int bq = 0; bq < 4; ++bq) { const int jn = j0 + 4 + bq; if (jn <= T) { const unsigned char* kn = KS + (size_t)jn * 8192; const unsigned char* vn = VS + (size_t)jn * 8192; A4_ISSUE(kn, vn, (jn & 7)); } }
                    for (int bq = 0; bq < 4; ++bq) {
                        const int j = j0 + bq;
                        if (j > T) break;
                        const int jb = gg * 4 + bq, stage = j & 7;
                        const bool need0 = (un[0][w] >> jb) & 1u, need1 = (un[1][w] >> jb) & 1u;
                        if (need0 || need1) {
#pragma unroll
                            for (int ct = 0; ct < 2; ++ct) {
                                if (ct == 0 ? need0 : need1) {
                                    A4_LOADK(stage);
                                    A4_SCORES(ct);
                                    __builtin_amdgcn_sched_barrier(0);
                                    const int t = tq[ct];
                                    const bool csel = ((ct == 0 ? selw0 : selw1) >> jb) & 1u;
                                    if (j * 64 + 63 + 1023 <= t0) {
                                        const float cb = csel ? cbfar : -INF;
#pragma unroll
                                        for (int kt = 0; kt < 4; ++kt)
#pragma unroll
                                            for (int jj = 0; jj < 4; ++jj) sv[kt][jj] += cb;
                                    } else {
                                        const int base = t - j * 64 - g4 * 4;
                                        const LAS float* lp = lutl + hd * LUTP + base - 51;
                                        const float msk = csel ? 0.f : -INF;
#pragma unroll
                                        for (int kt = 0; kt < 4; ++kt) {
                                            f32x4 bs;
#pragma unroll
                                            for (int jj = 0; jj < 4; ++jj) bs[jj] = lp[51 - kt * 16 - jj];
                                            asm volatile("" : "+v"(bs));
                                            sv[kt] += bs + msk;
                                        }
                                        if (j == T) {
#pragma unroll
                                            for (int kt = 0; kt < 4; ++kt)
#pragma unroll
                                                for (int jj = 0; jj < 4; ++jj) { const int dist = base - kt * 16 - jj; sv[kt][jj] = (dist >= 0) ? sv[kt][jj] : -INF; }
                                        }
                                    }
                                    A4_ONLINE_PV(ct, stage);
                                    __builtin_amdgcn_sched_barrier(0);
                                }
                            }
                        }
                    }
                    A4_SYNC();
                }
            }
            if (!probe) A4_FINISH(1, false);
        }
    }
#undef A4_ISSUE
#undef A4_SYNC
#undef A4_SYNC_RING
#undef A4_LOADK
#undef A4_SCORES
#undef A4_ONLINE_PV
#undef A4_PV
#undef A4_VREADS
#undef A4_PVMMA
#undef A4_RESET
#undef A4_FINISH
#undef A4_GATEV
}

__device__ __forceinline__ void phase3_mfma(const Params& p, int bid, int nb, LAS unsigned char* lds) {
    {
        const unsigned char* XRBb = p.ws + WS_XRB; const bf16_t* XRB = (const bf16_t*)(p.ws + WS_XRB);
        const float* BG = (const float*)(p.ws + WS_BG); const float* GB = (const float*)(p.ws + WS_GBIAS);
        const float* conv_w = p.in[12]; const float* conv_b = p.in[13]; const float* lam = p.in[18];
        float* AL = (float*)(p.ws + WS_ALRU); float* UL = (float*)(p.ws + WS_ULRU);
        const XcdDeal dl = xcd_deal(512, lds, nb);
        gemm_stream<true, 1, 0, true>(lds, XRBb, dl.n, 4, 128,
            [&](int ps, int r) { const int u = dl.lo + ps * dl.step; return ((size_t)(u >> 5) * SEQP + (u & 31) * 256 + r) * 128; },
            [&](int ps, int n4) -> const float* { const int u = dl.lo + ps * dl.step; return BG + ((u >> 5) & 7) * 32768 + n4 * 4; },
            [&](int) { return 256; },
            [&](int ps, int rbase, int nbase, int, f32x4 (&acc)[4][4]) {
                const int u = dl.lo + ps * dl.step, sq = u >> 5, hb = sq & 7, bb = sq >> 3, t0 = (u & 31) * 256 + rbase;
#pragma unroll
                for (int ni = 0; ni < 2; ++ni) {
                    const int n = nbase + ni * 16;
                    const int j = (n >> 6) * 32 + ((n >> 4) & 1) * 16 + (n & 15), c = hb * 64 + j;
                    f32x4 cw[4];
#pragma unroll
                    for (int w = 0; w < 4; ++w) cw[w] = *(const f32x4*)(conv_w + w * 512 + c);
                    const f32x4 cbv = *(const f32x4*)(conv_b + c), ga = *(const f32x4*)(GB + hb * 128 + n), gx = *(const f32x4*)(GB + hb * 128 + n + 32), lm = *(const f32x4*)(lam + c);
                    f32x4 spl;
#pragma unroll
                    for (int jj = 0; jj < 4; ++jj) spl[jj] = -8.0f * softplus_(-lm[jj]);
#pragma unroll
                    for (int mi = 0; mi < 4; ++mi) {
                        u32x2 xw[4];
#pragma unroll
                        for (int w = 0; w < 4; ++w) xw[w] = *(const u32x2*)(XRB + ((size_t)sq * SEQP + t0 + mi * 16 + w) * 64 + j);
                        f32x4 xc = cbv;
#pragma unroll
                        for (int w = 0; w < 4; ++w) {
                            xc[0] += cw[w][0] * __uint_as_float(xw[w].x << 16); xc[1] += cw[w][1] * __uint_as_float(xw[w].x & 0xffff0000u);
                            xc[2] += cw[w][2] * __uint_as_float(xw[w].y << 16); xc[3] += cw[w][3] * __uint_as_float(xw[w].y & 0xffff0000u);
                        }
                        f32x4 av, uv;
#pragma unroll
                        for (int jj = 0; jj < 4; ++jj) {
                            const float r_ = sigm(acc[mi][ni][jj] + ga[jj]), ig = sigm(acc[mi][ni + 2][jj] + gx[jj]);
                            const float la = r_ * spl[jj];
                            const float a1 = __builtin_amdgcn_exp2f(la * 1.4426950408889634f);
                            av[jj] = a1; uv[jj] = __builtin_amdgcn_sqrtf(fmaxf(1.f - a1 * a1, 0.f)) * (ig * xc[jj]);
                        }
                        const size_t o = ((size_t)bb * SEQ + t0 + mi * 16) * 512 + c;
                        *(f32x4*)(AL + o) = av; *(f32x4*)(UL + o) = uv;
                        __builtin_amdgcn_sched_barrier(0);
                    }
                } });
    }
    {
        const unsigned char* KV6 = p.ws + WS_KV6; float* CP = (float*)(p.ws + WS_CPART);
        const float* W1k = p.in[7]; const float* W1v = p.in[9];
        const XcdDeal dl = xcd_deal(64, lds, nb);
        gemm_stream<false, 1>(lds, KV6, dl.n, 8, 64,
            [&](int ps, int r) { const int u = dl.lo + ps * dl.step, ks = u >> 4, kv = (u >> 3) & 1, R = (u & 7) * 256 + r;
                                 return (size_t)kv * 4194304 + ((size_t)(R >> 9) * SEQ + 16 * (R & 511)) * 128 + (size_t)ks * 1024; },
            [&](int ps, int n4) -> const float* { const int u = dl.lo + ps * dl.step, ks = u >> 4, kv = (u >> 3) & 1; return (kv ? W1v : W1k) + (size_t)ks * 512 * 64 + ((n4 * 4) & 63); },
            [&](int) { return 256; },
            [&](int ps, int r, int n, f32x4 v) { if (n < 64) { const int u = dl.lo + ps * dl.step; *(f32x4*)(CP + ((size_t)(u >> 3) * 2048 + (u & 7) * 256 + r) * 64 + n) = v; } });
    }
}

__device__ __forceinline__ void phase3b_new(const Params& p, int bid, int nb, float* smem) {
    const int tid = threadIdx.x;
    {
        const float* AL = (const float*)(p.ws + WS_ALRU); const float* UL = (const float*)(p.ws + WS_ULRU);
        float* AEND = (float*)(p.ws + WS_AEND); float* HEND = (float*)(p.ws + WS_HEND);
        const int cg = tid & 127, sg = tid >> 7;
        f32x4* summA = (f32x4*)smem; f32x4* summH = summA + 512;
        for (int u = bid; u < 256; u += nb) {
            const size_t base = ((size_t)(u >> 7) * SEQ + (u & 127) * 64 + sg * 16) * 512 + 4 * cg;
            f32x4 av[16], uv[16];
#pragma unroll
            for (int tt = 0; tt < 16; ++tt) { av[tt] = *(const f32x4*)(AL + base + (size_t)tt * 512); uv[tt] = *(const f32x4*)(UL + base + (size_t)tt * 512); }
            f32x4 A = (f32x4){1.f, 1.f, 1.f, 1.f}, H = (f32x4){0.f, 0.f, 0.f, 0.f};
#pragma unroll
            for (int tt = 0; tt < 16; ++tt) { H = av[tt] * H + uv[tt]; A = A * av[tt]; }
            __syncthreads();
            summA[sg * 128 + cg] = A; summH[sg * 128 + cg] = H;
            __syncthreads();
            if (sg == 0) {
#pragma unroll
                for (int j = 1; j < 4; ++j) { const f32x4 a2 = summA[j * 128 + cg], h2 = summH[j * 128 + cg]; H = a2 * H + h2; A = A * a2; }
                *(f32x4*)(AEND + (size_t)u * 512 + 4 * cg) = A; *(f32x4*)(HEND + (size_t)u * 512 + 4 * cg) = H;
            }
        }
        __syncthreads();
    }
    {
        const float* CP = (const float*)(p.ws + WS_CPART); const float* CB = (const float*)(p.ws + WS_CBIAS);
        float* hid = smem;
        for (int u = bid; u < 64; u += nb) {
            const int kv = u >> 5, R0 = (u & 31) * 64;
            const float* w2 = kv ? p.in[10] : p.in[8];
            bf16_t* ob = (bf16_t*)(p.ws + (kv ? WS_VCB : WS_KCB));
            __syncthreads();
            for (int i = tid; i < 64 * 64; i += NT) {
                const int r = i >> 6, c = i & 63; const size_t o = ((size_t)kv * 2048 + R0 + r) * 64 + c;
                const float v = ((CP[o] + CP[o + 262144]) + (CP[o + 524288] + CP[o + 786432])) + CB[kv * 64 + c];
                hid[r * 65 + c] = gelu_t(v);
            }
            __syncthreads();
            for (int i = tid; i < 64 * 64; i += NT) {
                const int r = i >> 6, j = i & 63; float acc = 0.f;
#pragma unroll 8
                for (int k = 0; k < 64; ++k) acc += hid[r * 65 + k] * w2[k * 64 + j];
                const int R = R0 + r;
                if ((R & 511) == 511) acc = 0.f;
                ob[(size_t)R * 64 + j] = (bf16_t)(pk_bf16(acc, acc) & 0xffffu);
            }
        }
    }
}

__device__ __forceinline__ void phase4b_new(const Params& p, int bid, int nb, float* smem) {
    const float* AL = (const float*)(p.ws + WS_ALRU); const float* UL = (const float*)(p.ws + WS_ULRU);
    const float* AEND = (const float*)(p.ws + WS_AEND); const float* HEND = (const float*)(p.ws + WS_HEND);
    const bf16_t* GRG = (const bf16_t*)(p.ws + WS_GRG); const float* OATT = (const float*)(p.ws + WS_OATT);
    const float* gaw = p.in[19]; const float* grw = p.in[20];
    bf16_t* YB = (bf16_t*)(p.ws + WS_YB);
    const int tid = threadIdx.x, lane = tid & 63;
    const int cg = tid & 127, sg = tid >> 7, wsub = (tid >> 6) & 1;
    f32x4* summA = (f32x4*)smem;
    f32x4* summH = summA + 512;
    float* ssr = smem + 4096;
    float* ssa = ssr + 128;
    const f32x4 gr_w = *(const f32x4*)(grw + 4 * cg), ga_w = *(const f32x4*)(gaw + 4 * cg);
    for (int u = bid; u < 256; u += nb) {
        const int b = u >> 7, chunk = u & 127;
        f32x4 carry = (f32x4){0.f, 0.f, 0.f, 0.f};
        {
            const size_t cb = (size_t)(b * 128) * 512 + 4 * cg;
#pragma unroll 16
            for (int k = 0; k < chunk; ++k) carry = *(const f32x4*)(AEND + cb + (size_t)k * 512) * carry + *(const f32x4*)(HEND + cb + (size_t)k * 512);
        }
        const size_t tok0 = (size_t)b * SEQ + chunk * 64 + sg * 16;
        f32x4 av[16], uv[16];
#pragma unroll
        for (int tt = 0; tt < 16; ++tt) { const size_t o = (tok0 + tt) * 512 + 4 * cg; av[tt] = *(const f32x4*)(AL + o); uv[tt] = *(const f32x4*)(UL + o); }
        f32x4 A = (f32x4){1.f, 1.f, 1.f, 1.f}, H = (f32x4){0.f, 0.f, 0.f, 0.f};
#pragma unroll
        for (int tt = 0; tt < 16; ++tt) { H = av[tt] * H + uv[tt]; A = A * av[tt]; }
        __syncthreads();
        summA[sg * 128 + cg] = A; summH[sg * 128 + cg] = H;
        __syncthreads();
#pragma unroll
        for (int j = 0; j < 3; ++j) if (j < sg) carry = summA[j * 128 + cg] * carry + summH[j * 128 + cg];
        f32x4 h = carry;
#pragma unroll
        for (int tt = 0; tt < 16; ++tt) {
            const size_t o = (tok0 + tt) * 512 + 4 * cg;
            h = av[tt] * h + uv[tt];
            const u32x2 gw = *(const u32x2*)(GRG + o);
            f32x4 v; v[0] = h[0] * __uint_as_float(gw.x << 16); v[1] = h[1] * __uint_as_float(gw.x & 0xffff0000u); v[2] = h[2] * __uint_as_float(gw.y << 16); v[3] = h[3] * __uint_as_float(gw.y & 0xffff0000u);
            uv[tt] = v;
            const float sq = wave_sum((v[0] * v[0] + v[1] * v[1]) + (v[2] * v[2] + v[3] * v[3]));
            const f32x4 oa = *(const f32x4*)(OATT + o);
            av[tt] = oa;
            const float sqa = wave_sum((oa[0] * oa[0] + oa[1] * oa[1]) + (oa[2] * oa[2] + oa[3] * oa[3]));
            if (lane == 0) { ssr[(sg * 16 + tt) * 2 + wsub] = sq; ssa[(sg * 16 + tt) * 2 + wsub] = sqa; }
        }
        __syncthreads();
#pragma unroll
        for (int tt = 0; tt < 16; ++tt) {
            const int ti = sg * 16 + tt;
            const float s1 = ssr[ti * 2] + ssr[ti * 2 + 1], s2 = ssa[ti * 2] + ssa[ti * 2 + 1];
            const float rs1 = __builtin_amdgcn_rsqf(s1 * (1.f / 512.f) + 1e-6f), rs2 = __builtin_amdgcn_rsqf(s2 * (1.f / 512.f) + 1e-6f);
            const f32x4 ya = av[tt] * rs2 * ga_w, yr = uv[tt] * rs1 * gr_w;
            u32x2 wa, wr_; wa.x = pk_bf16(ya[0], ya[1]); wa.y = pk_bf16(ya[2], ya[3]); wr_.x = pk_bf16(yr[0], yr[1]); wr_.y = pk_bf16(yr[2], yr[3]);
            *(u32x2*)(YB + (tok0 + tt) * 1024 + 4 * cg) = wa;
            *(u32x2*)(YB + (tok0 + tt) * 1024 + 512 + 4 * cg) = wr_;
        }
    }
}

__device__ __forceinline__ void phase8(const Params& p, int bid, int nb, float* smem) {
    const float* LOG = (const float*)(p.ws + WS_LOGITS); const float* brt = p.in[24];
    unsigned* cnt = (unsigned*)(p.ws + WS_HIST);
    int* EID = (int*)(p.ws + WS_EID); int* POS = (int*)(p.ws + WS_POS); float* WGT = (float*)(p.ws + WS_WGT);
    const int wave = threadIdx.x >> 6, lane = threadIdx.x & 63;
    float* s = smem + wave * 512; float* ssel = s + 256;
    int* lhist = (int*)(smem + 8 * 512);
    if (threadIdx.x < 256) lhist[threadIdx.x] = 0;
    __syncthreads();
    for (int tok = bid * NW + wave; tok < MTOK; tok += nb * NW) {
        __builtin_amdgcn_wave_barrier();
#pragma unroll
        for (int r = 0; r < 4; ++r) { const int e = r * 64 + lane; const float sv = sigm(LOG[(size_t)tok * 256 + e]); s[e] = sv; ssel[e] = sv + brt[e]; }
        __builtin_amdgcn_wave_barrier();
        float gsc = -INF;
        if (lane < 8) {
            float m1 = -INF, m2 = -INF;
            for (int i = 0; i < 32; ++i) { const float v = ssel[lane * 32 + i]; if (v > m1) { m2 = m1; m1 = v; } else if (v > m2) m2 = v; }
            gsc = m1 + m2;
        }
        int grank = 0;
#pragma unroll
        for (int g2 = 0; g2 < 8; ++g2) { const float v2 = __shfl(gsc, g2); grank += (v2 > gsc) || (v2 == gsc && g2 < lane); }
        const bool gok = (lane < 8) && (grank < 4);
        const unsigned long long gmask = __ballot(gok);
        float cv0, cv1, cv2, cv3;
        { const int e = lane;        cv0 = ((gmask >> (e >> 5)) & 1ull) ? ssel[e] : -INF; }
        { const int e = 64 + lane;   cv1 = ((gmask >> (e >> 5)) & 1ull) ? ssel[e] : -INF; }
        { const int e = 128 + lane;  cv2 = ((gmask >> (e >> 5)) & 1ull) ? ssel[e] : -INF; }
        { const int e = 192 + lane;  cv3 = ((gmask >> (e >> 5)) & 1ull) ? ssel[e] : -INF; }
        int my_e = 0; float my_s = 0.f;
#pragma unroll
        for (int k = 0; k < 8; ++k) {
            float bv = cv0; int bi = lane;
            if (cv1 > bv) { bv = cv1; bi = 64 + lane; }
            if (cv2 > bv) { bv = cv2; bi = 128 + lane; }
            if (cv3 > bv) { bv = cv3; bi = 192 + lane; }
#pragma unroll
            for (int o = 32; o; o >>= 1) { const float ov = __shfl_xor(bv, o); const int oi = __shfl_xor(bi, o); if (ov > bv || (ov == bv && oi < bi)) { bv = ov; bi = oi; } }
            if (bi == lane) cv0 = -INF;
            if (bi == 64 + lane) cv1 = -INF;
            if (bi == 128 + lane) cv2 = -INF;
            if (bi == 192 + lane) cv3 = -INF;
            if (lane == k) { my_e = bi; my_s = s[bi]; }
        }
        const float ssum = wave_sum(lane < 8 ? my_s : 0.f);
        if (lane < 8) {
            const int ps = atomicAdd(&lhist[my_e], 1);
            EID[tok * 8 + lane] = my_e; POS[tok * 8 + lane] = ps; WGT[tok * 8 + lane] = 2.5f * my_s / ssum;
        }
    }
    __syncthreads();
    if (threadIdx.x < 256) cnt[bid * 256 + threadIdx.x] = (unsigned)lhist[threadIdx.x];
}

__device__ __forceinline__ void expert_tables(const Params& p, int* off, int* tp, int shift = 6) {
    const unsigned* cnt = (const unsigned*)(p.ws + WS_CTL) + CW_CNT;
    __syncthreads();
    if (threadIdx.x < 256) off[threadIdx.x] = (int)cnt[threadIdx.x];
    __syncthreads();
    if (threadIdx.x == 0) {
        int o = 0, t = 0;
        for (int e = 0; e < 256; ++e) { const int c = off[e]; off[e] = o; tp[e] = t; o += c; t += (c + (1 << shift) - 1) >> shift; }
        off[256] = o; tp[256] = t; tp[257] = t + (MTOK >> shift);
    }
    __syncthreads();
}

__device__ __forceinline__ void phase9(const Params& p, int bid, int nb, float* smem) {
    int* off = (int*)smem; int* blkoff = off + 272; int* tot = off + 800;
    const unsigned* HIST = (const unsigned*)(p.ws + WS_HIST);
    unsigned* cnt = (unsigned*)(p.ws + WS_CTL) + CW_CNT;
    const int tid = threadIdx.x;
    __syncthreads();
    {
        const int e = tid & 255, hb = tid >> 8, b0 = hb * (nb >> 1), b1 = hb ? nb : (nb >> 1);
        int total = 0, pre = 0;
#pragma unroll 16
        for (int bb = b0; bb < b1; ++bb) { const int h = (int)HIST[bb * 256 + e]; total += h; pre += (bb < bid) ? h : 0; }
        if (hb) { tot[256 + e] = total; blkoff[256 + e] = pre; }
        __syncthreads();
        if (!hb) { total += tot[256 + e]; pre += blkoff[256 + e]; }
        __syncthreads();
        if (!hb) { tot[e] = total; blkoff[e] = pre; if (bid == 0) cnt[e] = (unsigned)total; }
    }
    __syncthreads();
    if (tid == 0) { int o = 0; for (int e = 0; e < 256; ++e) { off[e] = o; o += tot[e]; } }
    __syncthreads();
    const int* EID = (const int*)(p.ws + WS_EID); const int* POS = (const int*)(p.ws + WS_POS); const float* WGT = (const float*)(p.ws + WS_WGT);
    int* ST = (int*)(p.ws + WS_SLOTTOK); float* SW = (float*)(p.ws + WS_SLOTW); int* SOF = (int*)(p.ws + WS_SLOTOF);
    const int wave = tid >> 6, lane = tid & 63;
    for (int tok = bid * NW + wave; tok < MTOK; tok += nb * NW) {
        if (lane < 8) {
            const int idx = tok * 8 + lane; const int e = EID[idx];
            const int slot = off[e] + blkoff[e] + POS[idx];
            ST[slot] = tok; SW[slot] = WGT[idx]; SOF[idx] = slot;
        }
    }
}

__device__ __forceinline__ int find_expert(const int* tp, int rt) {
    int lo = 0, hi = 256;
    while (lo < hi) { const int mid = (lo + hi + 1) >> 1; if (tp[mid] <= rt) lo = mid; else hi = mid - 1; }
    return lo;
}

__device__ __forceinline__ void phase7_mfma(const Params& p, int bid, int nb, LAS unsigned char* lds) {
    const unsigned char* H2b = p.ws + WS_H2B; const float* wr = p.in[23];
    float* LOG = (float*)(p.ws + WS_LOGITS);
    const XcdDeal dl = xcd_deal(64 * 2, lds, nb);
    const bf16_t* wrb = (const bf16_t*)(p.ws + WS_WRB);
    gemm_stream<false, 1, 0, false, true>(lds, H2b, dl.n, 16, 256,
        [&](int ps, int r) { const int u = dl.lo + ps * dl.step; return (size_t)((u >> 1) * 256 + r) * 2048; },
        [&](int ps, int n4) -> const bf16_t* { const int u = dl.lo + ps * dl.step; return wrb + (u & 1) * 128 + n4 * 4; },
        [&](int) { return 256; },
        [&](int ps, int r, int n, f32x4 v) { const int u = dl.lo + ps * dl.step; *(f32x4*)(LOG + (size_t)((u >> 1) * 256 + r) * 256 + (u & 1) * 128 + n) = v; });
}

#define ETAB_OFF 24576
#define EDESC_OFF (ETAB_OFF + 1024)
__device__ __forceinline__ int expert_passes(const Params& p, int bid, int nb, const LAS unsigned char* lds, float* smem, int nct, int& npass) {
    int* off = (int*)(smem + ETAB_OFF); int* tp = off + 272; int* desc = (int*)(smem + EDESC_OFF);
    expert_tables(p, off, tp, 8);
    const unsigned* cnt = (const unsigned*)(p.ws + WS_CTL) + CW_CNT;
    const XcdDeal dl = xcd_deal(tp[257] * nct, lds, nb);
    npass = dl.n;
    for (int ps = threadIdx.x; ps < npass; ps += NT) {
        const int u = dl.lo + ps * dl.step;
        const int e = find_expert(tp, u / nct);
        const int nte = tp[e + 1] - tp[e], v = u - tp[e] * nct, ct = v / nte, rtl = v - ct * nte;
        const int rows_e = e < 256 ? (int)cnt[e] : MTOK;
        const int r0 = rtl * 256;
        desc[ps * 4 + 0] = (e < 256 ? off[e] : NK) + r0;
        desc[ps * 4 + 1] = (rows_e - r0) < 256 ? (rows_e - r0) : 256;
        desc[ps * 4 + 2] = e; desc[ps * 4 + 3] = ct;
    }
    __syncthreads();
    return dl.lo;
}

__device__ __forceinline__ void phase10_mfma(const Params& p, int bid, int nb, LAS unsigned char* lds, float* smem) {
    int npass; expert_passes(p, bid, nb, lds, smem, 4, npass);
    const LAS int* desc = (const LAS int*)(lds + EDESC_OFF * 4);
    const unsigned char* H2b = p.ws + WS_H2B; const int* ST = (const int*)(p.ws + WS_SLOTTOK);
    bf16_t* HIDB = (bf16_t*)(p.ws + WS_HIDB);
    const float* W1g = p.in[25]; const float* W3g = p.in[26]; const float* W1s = p.in[28]; const float* W3s = p.in[29];
    const float* SW = (const float*)(p.ws + WS_SLOTW);
    gemm_stream_ws(lds, H2b, npass, 16, 256,
        [&](int ps, int r) { const int slot0 = desc[ps * 4], mr = desc[ps * 4 + 1]; const int rr = r < mr ? r : mr - 1; const int slot = slot0 + rr;
                             const int tok = slot < NK ? ST[slot] : slot - NK; return (size_t)tok * 2048; },
        [&](int ps, int n4) -> const float* { const int e = desc[ps * 4 + 2], hc0 = desc[ps * 4 + 3] * 64; const int n = n4 * 4;
                             const int hc = hc0 + (n >> 6) * 32 + ((n >> 2) & 3) * 8 + ((n >> 4) & 1) * 4;
                             const float* W = ((n >> 5) & 1) ? (e < 256 ? W3g + (size_t)e * 262144 : W3s) : (e < 256 ? W1g + (size_t)e * 262144 : W1s); return W + hc; },
        [&](int ps) { return desc[ps * 4 + 1]; },
        [&](int ps, int rbase, int nbase, int mr, f32x4 (&acc)[8][4]) {
            const int slot0 = desc[ps * 4] + rbase, hc = desc[ps * 4 + 3] * 64 + (nbase >> 6) * 32 + ((nbase >> 2) & 3) * 8;
            float wv[8];
#pragma unroll
            for (int mi = 0; mi < 8; ++mi) { const int slot = slot0 + mi * 16; const float wl = SW[slot < NK ? slot : 0]; wv[mi] = slot < NK ? wl : 1.f; }
#pragma unroll
            for (int mi = 0; mi < 8; ++mi) {
                if (rbase + mi * 16 < mr) {
                    float h[8];
#pragma unroll
                    for (int ni = 0; ni < 2; ++ni) {
                        const f32x4 a = acc[mi][ni], bq = acc[mi][ni + 2];
#pragma unroll
                        for (int jj = 0; jj < 4; ++jj) h[ni * 4 + jj] = a[jj] * __builtin_amdgcn_rcpf(1.f + ex2(-a[jj] * LOG2E)) * bq[jj] * wv[mi];
                    }
                    u32x4 w; w[0] = pk_bf16(h[0], h[1]); w[1] = pk_bf16(h[2], h[3]); w[2] = pk_bf16(h[4], h[5]); w[3] = pk_bf16(h[6], h[7]);
                    *(u32x4*)(HIDB + (size_t)(slot0 + mi * 16) * 256 + hc) = w;
                }
            } });
}

__device__ __forceinline__ void phase11_mfma(const Params& p, int bid, int nb, LAS unsigned char* lds, float* smem) {
    int npass; expert_passes(p, bid, nb, lds, smem, 8, npass);
    const LAS int* desc = (const LAS int*)(lds + EDESC_OFF * 4);
    const unsigned char* HIDB = p.ws + WS_HIDB; const float* SW = (const float*)(p.ws + WS_SLOTW);
    bf16_t* SO = (bf16_t*)(p.ws + WS_SLOTOUT);
    const float* W2g = p.in[27]; const float* W2s = p.in[30];
    gemm_stream_ws(lds, HIDB, npass, 4, 1024,
        [&](int ps, int r) { const int slot0 = desc[ps * 4], mr = desc[ps * 4 + 1]; const int rr = r < mr ? r : mr - 1; return (size_t)(slot0 + rr) * 512; },
        [&](int ps, int n4) -> const float* { const int e = desc[ps * 4 + 2], n0 = desc[ps * 4 + 3] * 128; const int src4 = (n4 & ~7) + 2 * (n4 & 3) + ((n4 >> 2) & 1);
                                              return (e < 256 ? W2g + (size_t)e * 262144 : W2s) + n0 + src4 * 4; },
        [&](int ps) { return desc[ps * 4 + 1]; },
        [&](int ps, int rbase, int nbase, int mr, f32x4 (&acc)[8][4]) {
            const int slot0 = desc[ps * 4] + rbase, c0 = desc[ps * 4 + 3] * 128 + (nbase >> 6) * 64 + ((nbase >> 2) & 3) * 8;
#pragma unroll
            for (int mi = 0; mi < 8; ++mi) {
                if (rbase + mi * 16 < mr) {
                    bf16_t* op = SO + (size_t)(slot0 + mi * 16) * 1024 + c0;
#pragma unroll
                    for (int np = 0; np < 2; ++np) {
                        const f32x4 v0 = acc[mi][2 * np], v1 = acc[mi][2 * np + 1];
                        u32x4 o; o[0] = pk_bf16(v0[0], v0[1]); o[1] = pk_bf16(v0[2], v0[3]); o[2] = pk_bf16(v1[0], v1[1]); o[3] = pk_bf16(v1[2], v1[3]);
                        *(u32x4*)(op + np * 32) = o;
                    }
                }
            } });
}

__device__ __forceinline__ void phase12_mfma(const Params& p, int bid, int nb) {
    const float* X1 = (const float*)(p.ws + WS_X1); const bf16_t* SO = (const bf16_t*)(p.ws + WS_SLOTOUT); const int* SOF = (const int*)(p.ws + WS_SLOTOF);
    const float* mod = (const float*)(p.ws + WS_MOD); const float* fw = p.in[31];
    const int wave = threadIdx.x >> 6, lane = threadIdx.x & 63;
    for (int row = bid * NW + wave; row < MTOK; row += nb * NW) {
        const int b = row >> 13;
        const int myslot = lane < 8 ? SOF[row * 8 + lane] : NK + row;
        float acc[16];
#pragma unroll
        for (int i = 0; i < 16; ++i) acc[i] = 0.f;
        u32x4 w0[9], w1[9];
#pragma unroll
        for (int k = 0; k < 9; ++k) {
            const int slot = __builtin_amdgcn_readlane(myslot, k);
            const u32x4* rp = (const u32x4*)(SO + (size_t)slot * 1024 + lane * 16);
            w0[k] = rp[0]; w1[k] = rp[1];
        }
#pragma unroll
        for (int k = 0; k < 9; ++k) {
#pragma unroll
            for (int j = 0; j < 4; ++j) {
                acc[2 * j] += __uint_as_float(w0[k][j] << 16); acc[2 * j + 1] += __uint_as_float(w0[k][j] & 0xffff0000u);
                acc[8 + 2 * j] += __uint_as_float(w1[k][j] << 16); acc[8 + 2 * j + 1] += __uint_as_float(w1[k][j] & 0xffff0000u);
            }
        }
        float v[16]; float ss = 0.f;
#pragma unroll
        for (int i4 = 0; i4 < 4; ++i4) {
            const f32x4 xv = *(const f32x4*)(X1 + (size_t)row * 1024 + lane * 16 + i4 * 4);
            const f32x4 gv = *(const f32x4*)(mod + b * 6144 + 5120 + lane * 16 + i4 * 4);
#pragma unroll
            for (int j = 0; j < 4; ++j) { v[i4 * 4 + j] = xv[j] + gv[j] * acc[i4 * 4 + j]; ss += v[i4 * 4 + j] * v[i4 * 4 + j]; }
        }
        ss = wave_sum(ss);
        const float rstd = 1.0f / sqrtf(ss * (1.f / 1024.f) + 1e-6f);
#pragma unroll
        for (int i4 = 0; i4 < 4; ++i4) {
            const f32x4 wv = *(const f32x4*)(fw + lane * 16 + i4 * 4);
            f32x4 o;
#pragma unroll
            for (int j = 0; j < 4; ++j) o[j] = v[i4 * 4 + j] * rstd * wv[j];
            *(f32x4*)(p.out + (size_t)row * 1024 + lane * 16 + i4 * 4) = o;
        }
    }
}

__global__ void __launch_bounds__(NT, 2) k_fused(Params p) {
    extern __shared__ __attribute__((aligned(16))) unsigned char lds_raw[];
    LAS unsigned char* lds = (LAS unsigned char*)lds_raw;
    float* smem = (float*)lds_raw;
    if (threadIdx.x == 0) { *(LAS u32x4*)(lds + LDS_MISC) = (u32x4){0u, 0u, 0u, 0u}; }
    __syncthreads();
    XcdBarrier bar = xcd_barrier_post((unsigned*)(p.ws + WS_CTL), (volatile LAS unsigned*)(lds + LDS_MISC));
    if (threadIdx.x == 0) ((LAS int*)(lds + TOPO_OFF))[2] = (int)xb_add((unsigned*)(p.ws + WS_CTL) + CW_RANK + 64 * bar.x, 1u);
    const int bid = blockIdx.x, nb = gridDim.x;
#define PH(stmt) { stmt; xcd_barrier(bar); }
#define PHR(bit, stmt) { stmt; xcd_barrier(bar); if (REP & (bit)) { stmt; xcd_barrier(bar); } }
    PH(phase0(p, bid, nb, smem, lds))
    if (threadIdx.x == 0) {
        int pre = 0, mine = 0;
        for (unsigned j = 0; j < 16; ++j) { const int c = (int)xb_ld((unsigned*)(p.ws + WS_CTL) + XB_XCNT(j)); if (j < bar.x) pre += c; if (j == bar.x) mine = c; }
        ((LAS int*)(lds + TOPO_OFF))[0] = pre; ((LAS int*)(lds + TOPO_OFF))[1] = mine > 0 ? mine : 1;
    }
    __syncthreads();
    PHR(128, phase_modnorm(p, bid, nb, p.in[0], p.in[4], 0, 1024, (float*)(p.ws + WS_H1), (bf16_t*)(p.ws + WS_H1B)))
    PHR(1, phase2_e(p, bid, nb, lds))
    PH(phase3_mfma(p, bid, nb, lds))
    PH(phase3b_new(p, bid, nb, smem))
    PH(phase4_mfma(p.ws, bid, nb, lds))
    PH(phase4b_new(p, bid, nb, smem))
    PHR(512, phase5_e(p, bid, nb, lds))
    PH(phase_modnorm(p, bid, nb, (const float*)(p.ws + WS_X1), p.in[22], 3072, 4096, (float*)(p.ws + WS_H2), (bf16_t*)(p.ws + WS_H2B)))
    PHR(1024, phase7_mfma(p, bid, nb, lds))
    PH(phase8(p, bid, nb, smem))
    PH(phase9(p, bid, nb, smem))
    PHR(16, phase10_mfma(p, bid, nb, lds, smem))
    PHR(32, phase11_mfma(p, bid, nb, lds, smem))
    phase12_mfma(p, bid, nb);
    if (REP & 2048) { xcd_barrier(bar); phase12_mfma(p, bid, nb); }
    if (REP & 4096) { for (int i = 0; i < 20; ++i) xcd_barrier(bar); }
#undef PH
#undef PHR
}

extern "C" void kernel_launch(void* const* d_in, const int* in_sizes, int n_in, void* d_out, int out_size, void* d_ws, size_t ws_size, hipStream_t stream) {
    static int grid = 0;
    if (!grid) {
        int dev = 0, cus = 0;
        (void)hipGetDevice(&dev);
        (void)hipDeviceGetAttribute(&cus, hipDeviceAttributeMultiprocessorCount, dev);
        (void)hipFuncSetAttribute((const void*)k_fused, hipFuncAttributeMaxDynamicSharedMemorySize, LDS_BYTES);
        if (cus < 1) cus = 256;
        grid = cus;
    }
    Params p{};
    for (int i = 0; i < 32; ++i) p.in[i] = (const float*)d_in[i];
    p.out = (float*)d_out; p.ws = (unsigned char*)d_ws;
    (void)hipMemsetAsync((char*)d_ws + WS_CTL, 0, CTL_BYTES, stream);
    hipLaunchKernelGGL(k_fused, dim3(grid), dim3(NT), LDS_BYTES, stream, p);
}
```

```cpp
#include <hip/hip_runtime.h>
#include <stdint.h>
#include <type_traits>


#define MTOK 16384
#define SEQ 8192
#define SEQP 8195
#define DM 1024
#define NCOLS 2328
#define COL_KC 512
#define COL_KS 768
#define COL_VS 896
#define COL_KW 1024
#define COL_VW 1152
#define COL_G 1280
#define COL_XR 1304
#define COL_GR 1816
#define NCMP 511
#define NEXP 256
#define NK 131072

#define MiB (1048576ull)
#define WS_CTL 0ull
#define CTL_BYTES (1 * MiB)
#define CW_CNT 8192
#define CW_RANK 12288
#define WS_MOD (1 * MiB)
#define WS_LUT (1 * MiB + 65536)
#define WS_KC (2 * MiB)
#define WS_VC (3 * MiB)
#define WS_AEND (4 * MiB)
#define WS_HEND (5 * MiB)
#define WS_EID (6 * MiB)
#define WS_POS (7 * MiB)
#define WS_WGT (8 * MiB)
#define WS_SLOTTOK (9 * MiB)
#define WS_SLOTW (10 * MiB)
#define WS_CARRY (11 * MiB)
#define WS_SLOTOF (12 * MiB)
#define WS_HIST (13 * MiB)
#define WS_LOGITS (16 * MiB)
#define WS_H1 (32 * MiB)
#define WS_PROJ (96 * MiB)
#define WS_HL (256 * MiB)
#define WS_AP (288 * MiB)
#define WS_ACC (320 * MiB)
#define WS_HID (384 * MiB)
#define WS_Y (528 * MiB)
#define WS_H2 (592 * MiB)
#define WS_X1 (656 * MiB)
#define WS_H1B (720 * MiB)
#define WS_YB (752 * MiB)
#define WS_H2B (784 * MiB)
#define WS_HIDB (816 * MiB)
#define WS_QB (896 * MiB)
#define WS_KV6 (912 * MiB)
#define WS_GATE (936 * MiB)
#define WS_KCB (938 * MiB)
#define WS_VCB (939 * MiB)
#define WS_OATT (940 * MiB)
#define WS_BG (14 * MiB)
#define WS_GBIAS (15 * MiB)
#define WS_CBIAS (15 * MiB + 8192)
#define WS_XRB (972 * MiB)
#define WS_GRG (990 * MiB)
#define WS_CPART (1007 * MiB)
#define WS_ALRU (256 * MiB)
#define WS_ULRU (288 * MiB)
#define WS_WINB (1012 * MiB)
#define WS_WOUTB (1017 * MiB)
#define WS_WRB (1020 * MiB)
#define WS_WINT (1012 * MiB)
#define WS_WOUTT (1017 * MiB)
#define WS_WRT (1019 * MiB)
#define WS_SLOTOUT (32 * MiB)

#ifndef REP
#define REP 0
#endif
#ifndef USE_MFMA
#define USE_MFMA 31
#endif

struct Params {
    const float* in[32];
    float* out;
    unsigned char* ws;
};

#define NT 512
#define NW 8
#define LDS_BYTES 151552
#define LDS_MISC 131072
#define INF __builtin_huge_valf()
#define LOG2E 1.4426950408889634f

__device__ __forceinline__ float wave_sum(float v) {
#define WS_DPP(ctrl, rmask) __builtin_bit_cast(float, __builtin_amdgcn_update_dpp(0, __builtin_bit_cast(int, v), (ctrl), (rmask), 0xf, true))
    v += WS_DPP(0x111, 0xf);
    v += WS_DPP(0x112, 0xf);
    v += WS_DPP(0x114, 0xf);
    v += WS_DPP(0x118, 0xf);
    v += WS_DPP(0x142, 0xa);
    v += WS_DPP(0x143, 0xc);
#undef WS_DPP
    return __builtin_bit_cast(float, __builtin_amdgcn_readlane(__builtin_bit_cast(int, v), 63));
}
__device__ __forceinline__ float wave_max(float v) {
#pragma unroll
    for (int o = 32; o; o >>= 1) v = fmaxf(v, __shfl_xor(v, o));
    return v;
}
__device__ __forceinline__ float wave_max_f(float v) {
#define WM_DPP(ctrl, rmask) __builtin_bit_cast(float, __builtin_amdgcn_update_dpp(__builtin_bit_cast(int, -INF), __builtin_bit_cast(int, v), (ctrl), (rmask), 0xf, false))
    v = fmaxf(v, WM_DPP(0x111, 0xf)); v = fmaxf(v, WM_DPP(0x112, 0xf)); v = fmaxf(v, WM_DPP(0x114, 0xf)); v = fmaxf(v, WM_DPP(0x118, 0xf));
    v = fmaxf(v, WM_DPP(0x142, 0xa)); v = fmaxf(v, WM_DPP(0x143, 0xc));
#undef WM_DPP
    return __builtin_bit_cast(float, __builtin_amdgcn_readlane(__builtin_bit_cast(int, v), 63));
}
__device__ __forceinline__ int wave_min_i(int v) {
#define WM_DPP(ctrl, rmask) __builtin_amdgcn_update_dpp(0x7fffffff, v, (ctrl), (rmask), 0xf, false)
    v = min(v, WM_DPP(0x111, 0xf)); v = min(v, WM_DPP(0x112, 0xf)); v = min(v, WM_DPP(0x114, 0xf)); v = min(v, WM_DPP(0x118, 0xf));
    v = min(v, WM_DPP(0x142, 0xa)); v = min(v, WM_DPP(0x143, 0xc));
#undef WM_DPP
    return __builtin_amdgcn_readlane(v, 63);
}
__device__ __forceinline__ float half_top2_sum(float v) {
    float m1 = v, m2 = -INF;
#define T2_STEP(ctrl, rmask) { const float p1 = __builtin_bit_cast(float, __builtin_amdgcn_update_dpp(__builtin_bit_cast(int, -INF), __builtin_bit_cast(int, m1), (ctrl), (rmask), 0xf, false)); \
                               const float p2 = __builtin_bit_cast(float, __builtin_amdgcn_update_dpp(__builtin_bit_cast(int, -INF), __builtin_bit_cast(int, m2), (ctrl), (rmask), 0xf, false)); \
                               const float n2 = fmaxf(fminf(m1, p1), fmaxf(m2, p2)); m1 = fmaxf(m1, p1); m2 = n2; }
    T2_STEP(0x111, 0xf) T2_STEP(0x112, 0xf) T2_STEP(0x114, 0xf) T2_STEP(0x118, 0xf) T2_STEP(0x142, 0xa)
#undef T2_STEP
    return m1 + m2;
}
__device__ __forceinline__ float sigm(float x) { return __builtin_amdgcn_rcpf(1.f + __builtin_amdgcn_exp2f(-1.4426950408889634f * x)); }
__device__ __forceinline__ float tanh_fast(float x) { return 1.f - 2.f * __builtin_amdgcn_rcpf(1.f + __builtin_amdgcn_exp2f(2.8853900817779268f * x)); }
__device__ __forceinline__ float gelu_t(float x) { return 0.5f * x * (1.f + tanh_fast(0.7978845608028654f * (x + 0.044715f * x * x * x))); }
__device__ __forceinline__ float softplus_(float z) { return fmaxf(z, 0.f) + log1pf(expf(-fabsf(z))); }


#define XB_TMO      128
#define XB_XCNT(j)  (256  + 64 * (j))
#define XB_XSUB(j)  (1280 + 64 * (j))
#define XB_XGEN(j)  (2304 + 64 * (j))
#define XB_TOP      3328
#define XB_TOPGEN   3392
#define XCD_BAR_WORDS 3456
#define XB_SPIN_CAP (1u << 18)
#define LAS __attribute__((address_space(3)))

__device__ __forceinline__ unsigned xb_ld(unsigned* p)              { return __hip_atomic_load(p, __ATOMIC_RELAXED, __HIP_MEMORY_SCOPE_AGENT); }
__device__ __forceinline__ unsigned xb_add(unsigned* p, unsigned v) { return __hip_atomic_fetch_add(p, v, __ATOMIC_RELAXED, __HIP_MEMORY_SCOPE_AGENT); }
__device__ __forceinline__ unsigned xb_xcc_id() { return (unsigned)__builtin_amdgcn_s_getreg((3 << 11) | 20) & 0xFu; }
#define XB_SPIN(cond, bar) do { unsigned _sp = 0; while (cond) { __builtin_amdgcn_s_sleep(1); \
    if ((++_sp & 255u) == 0u) { if (xb_ld(&(bar)[XB_TMO])) break; if (_sp > XB_SPIN_CAP) { atomicAdd(&(bar)[XB_TMO], 1u); break; } } } } while (0)

struct XcdBarrier {
    unsigned* bar; unsigned x;
    volatile LAS unsigned* st;
};
__device__ __forceinline__ XcdBarrier xcd_barrier_post(unsigned* bar, volatile LAS unsigned* st) {
    XcdBarrier b; b.bar = bar; b.x = xb_xcc_id(); b.st = st;
    if (threadIdx.x == 0) (void)xb_add(&bar[XB_XCNT(b.x)], 1u);
    return b;
}
__device__ __forceinline__ void xcd_barrier_complete(unsigned* bar, unsigned x, unsigned& nloc, unsigned& nx) {
    const unsigned G = gridDim.x * gridDim.y * gridDim.z;
    unsigned sum, cnt, mine, sp = 0u;
    for (;;) {
        sum = 0u; cnt = 0u; mine = 0u;
#pragma unroll
        for (unsigned j = 0; j < 16; ++j) { const unsigned c = xb_ld(&bar[XB_XCNT(j)]); sum += c; cnt += (c > 0u) ? 1u : 0u; mine = (j == x) ? c : mine; }
        if (sum == G) break;
        __builtin_amdgcn_s_sleep(1);
        if ((++sp & 255u) == 0u) { if (xb_ld(&bar[XB_TMO])) break; if (sp > XB_SPIN_CAP) { atomicAdd(&bar[XB_TMO], 1u); break; } }
    }
    nloc = mine > 0u ? mine : 1u; nx = cnt > 0u ? cnt : 1u;
}
__device__ __forceinline__ void xcd_barrier(const XcdBarrier& b) {
    asm volatile("s_waitcnt vmcnt(0)" ::: "memory");
    __syncthreads();
    if (threadIdx.x == 0) {
        unsigned* bar = b.bar;
        __builtin_amdgcn_s_waitcnt(0);
        unsigned nloc = b.st[0], nx = b.st[1];
        if (nloc == 0u) { xcd_barrier_complete(bar, b.x, nloc, nx); b.st[0] = nloc; b.st[1] = nx; }
        const unsigned old = xb_add(&bar[XB_XSUB(b.x)], 1u);
        const unsigned gen = old / nloc;
        if (old + 1u == (gen + 1u) * nloc) {
            __builtin_amdgcn_fence(__ATOMIC_RELEASE, "agent");
            asm volatile("s_waitcnt vmcnt(0)" ::: "memory");
            const unsigned og = xb_add(&bar[XB_TOP], 1u);
            const unsigned tg = og / nx;
            if (og + 1u == (tg + 1u) * nx) xb_add(&bar[XB_TOPGEN], 1u);
            else XB_SPIN(xb_ld(&bar[XB_TOPGEN]) == tg, bar);
            __builtin_amdgcn_fence(__ATOMIC_ACQUIRE, "agent");
            xb_add(&bar[XB_XGEN(b.x)], 1u);
            asm volatile("s_waitcnt vmcnt(0)" ::: "memory");
        } else {
            XB_SPIN(xb_ld(&bar[XB_XGEN(b.x)]) == gen, bar);
            __builtin_amdgcn_fence(__ATOMIC_ACQUIRE, "agent");
            asm volatile("s_waitcnt vmcnt(0)" ::: "memory");
        }
    }
    __syncthreads();
}

typedef short bf16x8 __attribute__((ext_vector_type(8)));
typedef short s16x4 __attribute__((ext_vector_type(4)));
typedef short v4i16_t __attribute__((ext_vector_type(4)));
typedef float f32x4 __attribute__((ext_vector_type(4)));
typedef float f32x2 __attribute__((ext_vector_type(2)));
typedef __bf16 bf16x2_t __attribute__((ext_vector_type(2)));
typedef unsigned short bf16_t;
typedef unsigned u32x2 __attribute__((ext_vector_type(2)));
typedef unsigned u32x4 __attribute__((ext_vector_type(4)));
__device__ __forceinline__ unsigned pk_bf16(float lo, float hi) { return __builtin_bit_cast(unsigned, __builtin_convertvector((f32x2){lo, hi}, bf16x2_t)); }
__device__ __forceinline__ float bf2f(bf16_t v) { return __uint_as_float(((unsigned)v) << 16); }

__device__ __forceinline__ s16x4 tr_read(LAS unsigned char* pa) { s16x4 r; asm volatile("ds_read_b64_tr_b16 %0, %1" : "=v"(r) : "v"(pa) : "memory"); return r; }
#define TR_WAIT8(a0, a1, a2, a3, a4, a5, a6, a7) asm volatile("s_waitcnt lgkmcnt(0)" : "+v"(a0), "+v"(a1), "+v"(a2), "+v"(a3), "+v"(a4), "+v"(a5), "+v"(a6), "+v"(a7) :: "memory")

#define GEMM_LDS_A 0
#define GEMM_LDS_B 65536
template <bool PAIR, int DEPTH, int MODE = 0, bool TILE_EPI = false, bool BBF16 = false, class ARow, class BCol, class MRows, class Epi>
__device__ __forceinline__ void gemm_stream(LAS unsigned char* lds, const unsigned char* Abase, int npass, int nk, int ldb, ARow arow, BCol bcol, MRows mrowsf, Epi epi) {
    int tid_ = threadIdx.x; asm volatile("" : "+v"(tid_));
    const int tid = tid_, wid = __builtin_amdgcn_readfirstlane(tid >> 6), lane = tid & 63;
    const int wr = wid >> 1, wc = wid & 1, fr = lane & 15, fq = lane >> 4;
    if (npass <= 0) return;
    const int S = npass * nk;
    const int Ccol = ((wid & 1) * 32 + 8 * ((lane & 3) ^ ((lane >> 5) << 1))) * 2;
    const int Rbase = 16 * (wid >> 1) + (lane >> 2);
    unsigned asrc[4];
    const int n4 = tid & 31, kb = tid >> 5;
    typedef typename std::conditional<BBF16, const bf16_t*, const float*>::type bptr_t;
    bptr_t bp;
    const int fB = ((kb & 3) << 2) | ((kb >> 2) & 3);
    const int bwoff = 256 * kb + 16 * ((n4 >> 1) ^ fB) + 8 * (n4 & 1);
    const int aoff = wr * 8192 + ((fr * 64 + fq * 16) ^ ((fr >> 3) << 5));
    const int q = (lane >> 2) & 3, pp = lane & 3;
    const int b0 = (wc * 8 + (pp >> 1)) ^ ((q << 2) | (2 * (fq & 1)));
    const int browoff = 256 * (fq * 8 + q) + 8 * (pp & 1);
#define GS_BOFF(v) (browoff + 16 * (b0 ^ (v)))
    f32x4 acc[4][4];
#pragma unroll
    for (int i = 0; i < 4; ++i)
#pragma unroll
        for (int j = 0; j < 4; ++j) acc[i][j] = (f32x4){0.f, 0.f, 0.f, 0.f};
    float4 bregX[4], bregY[4];
    int aP = 0, aK = 0, bP = 0, bK = 0;
#define GS_SETA() do { _Pragma("unroll") for (int _i = 0; _i < 4; ++_i) asrc[_i] = (unsigned)(arow(aP, Rbase + 64 * _i) + Ccol); } while (0)
#define GS_ISSUE_A(buf) do { _Pragma("unroll") for (int _i = 0; _i < 4; ++_i) \
        __builtin_amdgcn_global_load_lds((const unsigned*)(Abase + (size_t)asrc[_i] + (size_t)aK * 128), (LAS unsigned*)(lds + GEMM_LDS_A + (buf) * 32768 + _i * 8192 + wid * 1024), 16, 0, 0); \
        if (++aK == nk) { aK = 0; ++aP; if (aP < npass) GS_SETA(); } } while (0)
#define GS_LOAD_B(breg) do { _Pragma("unroll") for (int _i = 0; _i < 4; ++_i) { \
            if constexpr (BBF16) { const u32x2 _t = *(const u32x2*)(bp + (size_t)(bK * 64 + kb + 16 * _i) * ldb); breg[_i].x = __uint_as_float(_t.x); breg[_i].y = __uint_as_float(_t.y); } \
            else breg[_i] = *(const float4*)(bp + (size_t)(bK * 64 + kb + 16 * _i) * ldb); } \
        if (++bK == nk) { bK = 0; ++bP; if (bP < npass) bp = bcol(bP, n4); } } while (0)
#define GS_WRITE_B(breg, buf) do { _Pragma("unroll") for (int _i = 0; _i < 4; ++_i) { u32x2 _w; \
            if constexpr (BBF16) { _w.x = __float_as_uint(breg[_i].x); _w.y = __float_as_uint(breg[_i].y); } \
            else { _w.x = pk_bf16(breg[_i].x, breg[_i].y); _w.y = pk_bf16(breg[_i].z, breg[_i].w); } \
        *(LAS u32x2*)(lds + GEMM_LDS_B + (buf) * 16384 + bwoff + 4096 * _i) = _w; } } while (0)
#define GS_COMPUTE(buf) do { _Pragma("unroll") for (int ks = 0; ks < 2; ++ks) { \
            bf16x8 af[4]; s16x4 tl0, tl1, tl2, tl3, th0, th1, th2, th3; \
            LAS unsigned char* bb_ = lds + GEMM_LDS_B + (buf) * 16384 + ks * 8192; \
            tl0 = tr_read(bb_ + GS_BOFF(0)); th0 = tr_read(bb_ + 1024 + GS_BOFF(1)); tl1 = tr_read(bb_ + GS_BOFF(2)); th1 = tr_read(bb_ + 1024 + GS_BOFF(3)); \
            tl2 = tr_read(bb_ + GS_BOFF(4)); th2 = tr_read(bb_ + 1024 + GS_BOFF(5)); tl3 = tr_read(bb_ + GS_BOFF(6)); th3 = tr_read(bb_ + 1024 + GS_BOFF(7)); \
            _Pragma("unroll") for (int mi = 0; mi < 4; ++mi) af[mi] = *(const LAS bf16x8*)(lds + GEMM_LDS_A + (buf) * 32768 + aoff + mi * 2048 + ks * 1024); \
            TR_WAIT8(tl0, th0, tl1, th1, tl2, th2, tl3, th3); \
            bf16x8 bfr[4]; \
            bfr[0] = (bf16x8){tl0[0], tl0[1], tl0[2], tl0[3], th0[0], th0[1], th0[2], th0[3]}; bfr[1] = (bf16x8){tl1[0], tl1[1], tl1[2], tl1[3], th1[0], th1[1], th1[2], th1[3]}; \
            bfr[2] = (bf16x8){tl2[0], tl2[1], tl2[2], tl2[3], th2[0], th2[1], th2[2], th2[3]}; bfr[3] = (bf16x8){tl3[0], tl3[1], tl3[2], tl3[3], th3[0], th3[1], th3[2], th3[3]}; \
            _Pragma("unroll") for (int mi = 0; mi < 4; ++mi) _Pragma("unroll") for (int ni = 0; ni < 4; ++ni) \
                acc[mi][ni] = __builtin_amdgcn_mfma_f32_16x16x32_bf16(bfr[ni], af[mi], acc[mi][ni], 0, 0, 0); } } while (0)
#define GS_STEP(CUR, NXT, BREG_LD, BREG_WR) do { \
        if (MODE != 2 && s + DEPTH < S) GS_LOAD_B(BREG_LD); \
        if (MODE != 3 && s + 1 < S) GS_ISSUE_A(NXT); \
        __builtin_amdgcn_sched_barrier(0); \
        if (MODE != 1 && active) GS_COMPUTE(CUR); \
        __builtin_amdgcn_sched_barrier(0); \
        if (s + 1 < S) GS_WRITE_B(BREG_WR, NXT); \
        const bool pass_end = (cK + 1 == nk); \
        if (++cK == nk) { \
            if constexpr (TILE_EPI) { if (active) epi(cP, wr * 64 + fr, wc * 64 + fq * 4, cm, acc); } else \
            if (active) { \
                _Pragma("unroll") for (int mi = 0; mi < 4; ++mi) { const int r = wr * 64 + mi * 16 + fr; \
                    if (r < cm) { \
                        if constexpr (PAIR) { _Pragma("unroll") for (int ni = 0; ni < 2; ++ni) { epi(cP, r, wc * 64 + ni * 16 + fq * 4, acc[mi][ni], acc[mi][ni + 2]); } } \
                        else { _Pragma("unroll") for (int ni = 0; ni < 4; ++ni) { epi(cP, r, wc * 64 + ni * 16 + fq * 4, acc[mi][ni]); } } } } } \
            _Pragma("unroll") for (int i = 0; i < 4; ++i) _Pragma("unroll") for (int j = 0; j < 4; ++j) acc[i][j] = (f32x4){0.f, 0.f, 0.f, 0.f}; \
            cK = 0; ++cP; if (cP < npass) { cm = mrowsf(cP); active = (wr * 64) < cm; } \
        } \
        asm volatile("s_waitcnt lgkmcnt(0)" ::: "memory"); \
        if (DEPTH >= 2 && (s + DEPTH < S) && !pass_end) asm volatile("s_waitcnt vmcnt(4)" ::: "memory"); else asm volatile("s_waitcnt vmcnt(0)" ::: "memory"); \
        asm volatile("" ::: "memory"); __builtin_amdgcn_s_barrier(); asm volatile("" ::: "memory"); ++s; } while (0)
    int cP = 0, cK = 0, cm = mrowsf(0);
    bool active = (wr * 64) < cm;
    GS_SETA(); bp = bcol(0, n4);
    GS_ISSUE_A(0); GS_LOAD_B(bregX);
    GS_WRITE_B(bregX, 0);
    if constexpr (DEPTH >= 2) { if (1 < S) GS_LOAD_B(bregY); }
    static_assert(DEPTH == 1 || DEPTH == 2, "B prefetch depth");
    asm volatile("s_waitcnt lgkmcnt(0)" ::: "memory");
    asm volatile("s_waitcnt vmcnt(%0)" :: "n"((DEPTH - 1) * 4) : "memory");
    __syncthreads();
    int s = 0;
    if constexpr (DEPTH == 1) {
        while (s < S) { GS_STEP(0, 1, bregX, bregX); if (s >= S) break; GS_STEP(1, 0, bregX, bregX); }
    } else if constexpr (DEPTH == 2) {
        while (s < S) { GS_STEP(0, 1, bregX, bregY); if (s >= S) break; GS_STEP(1, 0, bregY, bregX); }
    }
#undef GS_SETA
#undef GS_BOFF
#undef GS_ISSUE_A
#undef GS_LOAD_B
#undef GS_WRITE_B
#undef GS_COMPUTE
#undef GS_STEP
}


template <class ARow, class BCol, class MRows, class Epi>
__device__ __forceinline__ void gemm_stream_rs(LAS unsigned char* lds, const unsigned char* Abase, int npass, int nk, int ldb, ARow arow, BCol bcol, MRows mrowsf, Epi epi) {
    int tid_ = threadIdx.x; asm volatile("" : "+v"(tid_));
    const int tid = tid_, wid = __builtin_amdgcn_readfirstlane(tid >> 6), lane = tid & 63;
    const int wr = wid >> 1, wc = wid & 1, fr = lane & 15, fq = lane >> 4;
    if (npass <= 0) return;
    const int S = npass * nk;
    const int Ccol = ((wid & 1) * 32 + 8 * ((lane & 3) ^ ((lane >> 5) << 1))) * 2;
    const int Rbase = 16 * (wid >> 1) + (lane >> 2);
    unsigned asrc[4];
    const int n4 = tid & 31, kb = tid >> 5;
    const float* bp;
    const int fB = ((kb & 3) << 2) | ((kb >> 2) & 3);
    const int bwoff = 256 * kb + 16 * ((n4 >> 1) ^ fB) + 8 * (n4 & 1);
    const int awoff = wid * 1024 + lane * 16;
    const int aoff = wr * 8192 + ((fr * 64 + fq * 16) ^ ((fr >> 3) << 5));
    const int q = (lane >> 2) & 3, pp = lane & 3;
    const int b0 = (wc * 8 + (pp >> 1)) ^ ((q << 2) | (2 * (fq & 1)));
    const int browoff = 256 * (fq * 8 + q) + 8 * (pp & 1);
#define RS_BOFF(v) (browoff + 16 * (b0 ^ (v)))
    f32x4 acc[4][4];
#pragma unroll
    for (int i = 0; i < 4; ++i)
#pragma unroll
        for (int j = 0; j < 4; ++j) acc[i][j] = (f32x4){0.f, 0.f, 0.f, 0.f};
    f32x4 bX[4], bY[4]; u32x4 aX[4], aY[4];
    int aP = 0, aK = 0, bP = 0, bK = 0;
#define RS_SETA() do { _Pragma("unroll") for (int _i = 0; _i < 4; ++_i) asrc[_i] = (unsigned)(arow(aP, Rbase + 64 * _i) + Ccol); } while (0)
#define RS_LOAD(AR, BR) do { \
        _Pragma("unroll") for (int _i = 0; _i < 4; ++_i) AR[_i] = *(const u32x4*)(Abase + (size_t)asrc[_i] + (size_t)aK * 128); \
        _Pragma("unroll") for (int _i = 0; _i < 4; ++_i) BR[_i] = *(const f32x4*)(bp + (size_t)(bK * 64 + kb + 16 * _i) * ldb); \
        if (++aK == nk) { aK = 0; if (aP + 1 < npass) { ++aP; RS_SETA(); } } \
        if (++bK == nk) { bK = 0; if (bP + 1 < npass) { ++bP; bp = bcol(bP, n4); } } } while (0)
#define RS_WRITE(AR, BR, buf) do { \
        _Pragma("unroll") for (int _i = 0; _i < 4; ++_i) *(LAS u32x4*)(lds + GEMM_LDS_A + (buf) * 32768 + _i * 8192 + awoff) = AR[_i]; \
        _Pragma("unroll") for (int _i = 0; _i < 4; ++_i) { u32x2 _w; _w.x = pk_bf16(BR[_i][0], BR[_i][1]); _w.y = pk_bf16(BR[_i][2], BR[_i][3]); \
            *(LAS u32x2*)(lds + GEMM_LDS_B + (buf) * 16384 + bwoff + 4096 * _i) = _w; } } while (0)
#define RS_COMPUTE(buf) do { _Pragma("unroll") for (int ks = 0; ks < 2; ++ks) { \
            bf16x8 af[4]; s16x4 tl0, tl1, tl2, tl3, th0, th1, th2, th3; \
            LAS unsigned char* bb_ = lds + GEMM_LDS_B + (buf) * 16384 + ks * 8192; \
            tl0 = tr_read(bb_ + RS_BOFF(0)); th0 = tr_read(bb_ + 1024 + RS_BOFF(1)); tl1 = tr_read(bb_ + RS_BOFF(2)); th1 = tr_read(bb_ + 1024 + RS_BOFF(3)); \
            tl2 = tr_read(bb_ + RS_BOFF(4)); th2 = tr_read(bb_ + 1024 + RS_BOFF(5)); tl3 = tr_read(bb_ + RS_BOFF(6)); th3 = tr_read(bb_ + 1024 + RS_BOFF(7)); \
            _Pragma("unroll") for (int mi = 0; mi < 4; ++mi) af[mi] = *(const LAS bf16x8*)(lds + GEMM_LDS_A + (buf) * 32768 + aoff + mi * 2048 + ks * 1024); \
            TR_WAIT8(tl0, th0, tl1, th1, tl2, th2, tl3, th3); \
            bf16x8 bfr[4]; \
            bfr[0] = (bf16x8){tl0[0], tl0[1], tl0[2], tl0[3], th0[0], th0[1], th0[2], th0[3]}; bfr[1] = (bf16x8){tl1[0], tl1[1], tl1[2], tl1[3], th1[0], th1[1], th1[2], th1[3]}; \
            bfr[2] = (bf16x8){tl2[0], tl2[1], tl2[2], tl2[3], th2[0], th2[1], th2[2], th2[3]}; bfr[3] = (bf16x8){tl3[0], tl3[1], tl3[2], tl3[3], th3[0], th3[1], th3[2], th3[3]}; \
            _Pragma("unroll") for (int mi = 0; mi < 4; ++mi) _Pragma("unroll") for (int ni = 0; ni < 4; ++ni) \
                acc[mi][ni] = __builtin_amdgcn_mfma_f32_16x16x32_bf16(bfr[ni], af[mi], acc[mi][ni], 0, 0, 0); } } while (0)
#define RS_STEP(CUR, NXT, A_LD, B_LD, A_WR, B_WR) do { \
        RS_LOAD(A_LD, B_LD); \
        __builtin_amdgcn_sched_barrier(0); \
        if (active) RS_COMPUTE(CUR); \
        __builtin_amdgcn_sched_barrier(0); \
        RS_WRITE(A_WR, B_WR, NXT); \
        if (++cK == nk) { \
            if (active) epi(cP, wr * 64 + fr, wc * 64 + fq * 4, cm, acc); \
            _Pragma("unroll") for (int i = 0; i < 4; ++i) _Pragma("unroll") for (int j = 0; j < 4; ++j) acc[i][j] = (f32x4){0.f, 0.f, 0.f, 0.f}; \
            cK = 0; ++cP; if (cP < npass) { cm = mrowsf(cP); active = (wr * 64) < cm; } \
        } \
        asm volatile("s_waitcnt lgkmcnt(0)" ::: "memory"); \
        asm volatile("" ::: "memory"); __builtin_amdgcn_s_barrier(); asm volatile("" ::: "memory"); ++s; } while (0)
    int cP = 0, cK = 0, cm = mrowsf(0);
    bool active = (wr * 64) < cm;
    RS_SETA(); bp = bcol(0, n4);
    RS_LOAD(aX, bX); RS_WRITE(aX, bX, 0);
    RS_LOAD(aY, bY);
    asm volatile("s_waitcnt lgkmcnt(0)" ::: "memory");
    __syncthreads();
    int s = 0;
    while (s < S) { RS_STEP(0, 1, aX, bX, aY, bY); if (s >= S) break; RS_STEP(1, 0, aY, bY, aX, bX); }
#undef RS_BOFF
#undef RS_SETA
#undef RS_LOAD
#undef RS_WRITE
#undef RS_COMPUTE
#undef RS_STEP
}

namespace pg8 {
#define PG8_LAS __attribute__((address_space(3)))
typedef unsigned short bf16_t;
typedef short bf16x8 __attribute__((ext_vector_type(8)));
typedef float f32x4 __attribute__((ext_vector_type(4)));
typedef unsigned u32x4 __attribute__((ext_vector_type(4)));
constexpr int BM = 256, BK = 64, HALF = 128, HTB = HALF * BK * 2  , STAGE_BYTES = 8 * HTB, NXCD = 8, WGM = 8;

__host__ __device__ __forceinline__ int lds_byte(int r, int c) { const int st = (r >> 4) * 2 + (c >> 5), rr = r & 15, cc = c & 31, ob = rr * 64 + cc * 2; return st * 1024 + (ob ^ (((ob >> 9) & 1) << 5)); }
__host__ __device__ __forceinline__ void stage_rc(int b, int& R, int& C) { const int st = b / 1024, sb = b % 1024, swz = sb ^ (((sb >> 9) & 1) << 5); R = (st >> 1) * 16 + swz / 64; C = (st & 1) * 32 + (swz % 64) / 2; }
__host__ __device__ __forceinline__ int perm32(int rho) { const int n = rho >> 4, i = rho & 15; return 8 * (i >> 2) + 4 * n + (i & 3); }

struct Unit { int pm, pn; };
struct Gemm { const bf16_t* A; const bf16_t* Bt; int M, N, K; };

struct StaticOrder {
    int nM, nN, nwg, G, c;
    __host__ __device__ void init(int M, int N, int G_, int c_) { nM = M / BM; nN = N / BM; nwg = nM * nN; G = G_; c = c_; }
    __host__ __device__ bool next(int i, Unit& u) const {
        const long L = (long)i * G + c; if (L >= nwg) return false;
        int wgid = (int)L; { const int q = nwg / NXCD, r = nwg % NXCD, xcd = wgid % NXCD, off = wgid / NXCD; wgid = (xcd < r ? xcd * (q + 1) : r * (q + 1) + (xcd - r) * q) + off; }
        const int nig = WGM * nN, gid = wgid / nig, fm = gid * WGM, gsz = (nM - fm) < WGM ? (nM - fm) : WGM;
        u.pm = fm + ((wgid % nig) % gsz); u.pn = (wgid % nig) / gsz; return true;
    }
    __device__ __forceinline__ void a_ready(const Unit&) const {}
    __device__ __forceinline__ void done(const Unit&) const {}
};
template <class Epi, class Sched>
__device__ __forceinline__ void gemm_phase(PG8_LAS unsigned char* lds, const Gemm g, const Sched& S, const Epi& E) {
    int tid_l = threadIdx.x; asm volatile("" : "+v"(tid_l));
    const int tid = tid_l, wid = __builtin_amdgcn_readfirstlane(tid >> 6), lane = tid & 63, wr = wid >> 2, wc = wid & 3, fr = lane & 15, fq = lane >> 4;
    const int K = g.K, nt = K / BK;

    unsigned voffA[2], voffB[2];
#pragma unroll
    for (int i = 0; i < 2; ++i) { int R, C; stage_rc(tid * 16 + i * 8192, R, C); const int Rb = Epi::PERM ? ((R & ~31) + perm32(R & 31)) : R;
        voffA[i] = (unsigned)(R * K + C) * 2u; voffB[i] = (unsigned)(Rb * K + C) * 2u; }
    const size_t kstep = (size_t)(BK * 2);
    const size_t hstep = (size_t)HALF * K * 2;
    const size_t tstep = 2 * hstep;
    const unsigned ldsw = (unsigned)wid * 1024u;
    const int aoff = lds_byte(wr * 64 + fr, fq * 8), boff = lds_byte(wc * 32 + fr, fq * 8);
#define PG8_SA(b, h) (((b) * 2 + (h)) * HTB)
#define PG8_SB(b, h) ((4 + (b) * 2 + (h)) * HTB)
#define PG8_STAGE(bufoff, gbase, voff) do { _Pragma("unroll") for (int _i = 0; _i < 2; ++_i) \
        __builtin_amdgcn_global_load_lds((const unsigned*)((const char*)(gbase) + (voff)[_i]), (PG8_LAS unsigned*)(lds + (bufoff) + ldsw + _i * 8192), 16, 0, 0); } while (0)
#define PG8_LDA(dst, b, h) do { _Pragma("unroll") for (int m = 0; m < 4; ++m) _Pragma("unroll") for (int k = 0; k < 2; ++k) dst[m][k] = *(const PG8_LAS bf16x8*)(lds + PG8_SA(b, h) + aoff + m * 2048 + k * 1024); } while (0)
#define PG8_LDB(dst, b, h) do { _Pragma("unroll") for (int n = 0; n < 2; ++n) _Pragma("unroll") for (int k = 0; k < 2; ++k) dst[n][k] = *(const PG8_LAS bf16x8*)(lds + PG8_SB(b, h) + boff + n * 2048 + k * 1024); } while (0)
#define PG8_MMA(ai, bj, At, Bt) do { __builtin_amdgcn_s_setprio(1); _Pragma("unroll") for (int m = 0; m < 4; ++m) _Pragma("unroll") for (int n = 0; n < 2; ++n) _Pragma("unroll") for (int k = 0; k < 2; ++k) \
        acc[ai][bj][m][n] = __builtin_amdgcn_mfma_f32_16x16x32_bf16(Bt[n][k], At[m][k], acc[ai][bj][m][n], 0, 0, 0); __builtin_amdgcn_s_setprio(0); } while (0)
#define PG8_WAIT_V(n) asm volatile("s_waitcnt vmcnt(" #n ")" ::: "memory")
#define PG8_WAIT_L(n) asm volatile("s_waitcnt lgkmcnt(" #n ")" ::: "memory")
#define PG8_BAR __builtin_amdgcn_s_barrier()
#define PG8_SCHED __builtin_amdgcn_sched_barrier(0)
    Unit cur, nxt; int ui = 0;
    if (!S.next(0, cur)) return;
    f32x4 acc[2][2][4][2];
#pragma unroll
    for (int a = 0; a < 2; ++a)
#pragma unroll
        for (int b = 0; b < 2; ++b)
#pragma unroll
            for (int m = 0; m < 4; ++m)
#pragma unroll
                for (int n = 0; n < 2; ++n) acc[a][b][m][n] = (f32x4){0.f, 0.f, 0.f, 0.f};
    bf16x8 At[4][2], B0[2][2], B1[2][2];
    const char* cA = (const char*)g.A + (size_t)cur.pm * tstep; const char* cB = (const char*)g.Bt + (size_t)cur.pn * tstep;
    S.a_ready(cur);
    PG8_STAGE(PG8_SB(0, 0), cB, voffB); PG8_STAGE(PG8_SA(0, 0), cA, voffA); PG8_STAGE(PG8_SB(0, 1), cB + hstep, voffB); PG8_STAGE(PG8_SA(0, 1), cA + hstep, voffA);
    if (wr == 1) PG8_BAR;
    PG8_WAIT_V(4); PG8_BAR;
    PG8_STAGE(PG8_SB(1, 0), cB + kstep, voffB); PG8_STAGE(PG8_SA(1, 0), cA + kstep, voffA); PG8_STAGE(PG8_SB(1, 1), cB + hstep + kstep, voffB);
    PG8_WAIT_V(6); PG8_BAR;

    for (;;) {
        const bool has_next = S.next(ui + 1, nxt);
        const char* nA = has_next ? (const char*)g.A + (size_t)nxt.pm * tstep : cA; const char* nB = has_next ? (const char*)g.Bt + (size_t)nxt.pn * tstep : cB;
        for (int t = 0; t < nt; t += 2) {
            const bool last = (t == nt - 2);
            const char* a1 = cA + (size_t)(t + 1) * kstep;
            const char* a2 = last ? nA : cA + (size_t)(t + 2) * kstep; const char* b2 = last ? nB : cB + (size_t)(t + 2) * kstep;
            const char* a3 = a2 + kstep; const char* b3 = b2 + kstep;
            if (last && has_next) S.a_ready(nxt);
            PG8_LDB(B0, 0, 0); PG8_SCHED; PG8_LDA(At, 0, 0); PG8_STAGE(PG8_SA(1, 1), a1 + hstep, voffA);
            PG8_WAIT_L(8); PG8_BAR; PG8_WAIT_L(0); PG8_MMA(0, 0, At, B0); PG8_BAR; PG8_SCHED;
            PG8_LDB(B1, 0, 1); PG8_STAGE(PG8_SB(0, 0), b2, voffB);
            PG8_BAR; PG8_WAIT_L(0); PG8_MMA(0, 1, At, B1); PG8_BAR;
            PG8_LDA(At, 0, 1); PG8_STAGE(PG8_SA(0, 0), a2, voffA);
            PG8_BAR; PG8_WAIT_L(0); PG8_MMA(1, 0, At, B0); PG8_BAR; PG8_SCHED;
            PG8_STAGE(PG8_SB(0, 1), b2 + hstep, voffB);
            PG8_WAIT_V(6); PG8_BAR; PG8_MMA(1, 1, At, B1); PG8_BAR;
            PG8_LDB(B0, 1, 0); PG8_SCHED; PG8_LDA(At, 1, 0); PG8_STAGE(PG8_SA(0, 1), a2 + hstep, voffA);
            PG8_WAIT_L(8); PG8_BAR; PG8_WAIT_L(0); PG8_MMA(0, 0, At, B0); PG8_BAR; PG8_SCHED;
            PG8_LDB(B1, 1, 1); PG8_STAGE(PG8_SB(1, 0), b3, voffB);
            PG8_BAR; PG8_WAIT_L(0); PG8_MMA(0, 1, At, B1); PG8_BAR;
            PG8_LDA(At, 1, 1); PG8_STAGE(PG8_SA(1, 0), a3, voffA);
            PG8_BAR; PG8_WAIT_L(0); PG8_MMA(1, 0, At, B0); PG8_BAR; PG8_SCHED;
            PG8_STAGE(PG8_SB(1, 1), b3 + hstep, voffB);
            PG8_WAIT_V(6); PG8_BAR; PG8_MMA(1, 1, At, B1); PG8_BAR;
        }

        if constexpr (!Epi::AFTER_DRAIN) { E(acc, cur, wr, wc, fr, fq); S.done(cur); }

        if (!has_next) break;
#pragma unroll
        for (int a = 0; a < 2; ++a)
#pragma unroll
            for (int b = 0; b < 2; ++b)
#pragma unroll
                for (int m = 0; m < 4; ++m)
#pragma unroll
                    for (int n = 0; n < 2; ++n) acc[a][b][m][n] = (f32x4){0.f, 0.f, 0.f, 0.f};
        cur = nxt; cA = nA; cB = nB; ++ui;
    }
    PG8_WAIT_V(0);
    if (wr == 0) PG8_BAR;
    PG8_BAR;
    if constexpr (Epi::AFTER_DRAIN) { E.fused(acc, cur, wr, wc, fr, fq, lds, wid, lane); S.done(cur); }

#undef PG8_SA
#undef PG8_SB
#undef PG8_STAGE
#undef PG8_LDA
#undef PG8_LDB
#undef PG8_MMA
#undef PG8_WAIT_V
#undef PG8_WAIT_L
#undef PG8_BAR
#undef PG8_SCHED
}
}
template <class F> struct EpiWrap {
    static constexpr bool PERM = false, AFTER_DRAIN = false; F f;
    __device__ __forceinline__ void operator()(const f32x4 (&acc)[2][2][4][2], const pg8::Unit& u, int wr, int wc, int fr, int fq) const { f(acc, u, wr, wc, fr, fq); }
};
template <class F> __device__ __forceinline__ EpiWrap<F> make_epi(F f) { return EpiWrap<F>{f}; }
template <class F> struct EpiWrapP {
    static constexpr bool PERM = true, AFTER_DRAIN = false; F f;
    __device__ __forceinline__ void operator()(const f32x4 (&acc)[2][2][4][2], const pg8::Unit& u, int wr, int wc, int fr, int fq) const { f(acc, u, wr, wc, fr, fq); }
};
template <class F> __device__ __forceinline__ EpiWrapP<F> make_epi_p(F f) { return EpiWrapP<F>{f}; }

__device__ __forceinline__ void transpose_item(const float* W, int K, int N, int Npad, bf16_t* WT, LAS float* scr, int item, int lane) {
    const int nblk = Npad / 32, kb = item / nblk, nb_ = item % nblk, k0 = 64 * kb, n0 = 32 * nb_;
#pragma unroll 8
    for (int i = 0; i < 32; ++i) { const int kk = 2 * i + (lane >> 5), n = n0 + (lane & 31); scr[kk * 33 + (lane & 31)] = n < N ? W[(size_t)(k0 + kk) * N + n] : 0.f; }
    asm volatile("s_waitcnt lgkmcnt(0)" ::: "memory");
    const int c = lane & 7;
#pragma unroll
    for (int j = 0; j < 4; ++j) { const int n = (lane >> 3) + 8 * j; const LAS float* sp = scr + (8 * c) * 33 + n;
        u32x4 o; o[0] = pk_bf16(sp[0 * 33], sp[1 * 33]); o[1] = pk_bf16(sp[2 * 33], sp[3 * 33]); o[2] = pk_bf16(sp[4 * 33], sp[5 * 33]); o[3] = pk_bf16(sp[6 * 33], sp[7 * 33]);
        *(u32x4*)(WT + (size_t)(n0 + n) * K + k0 + 8 * c) = o; }
    asm volatile("s_waitcnt lgkmcnt(0)" ::: "memory");
}

template <class ARow, class BCol, class MRows, class Epi>
__device__ __forceinline__ void gemm_stream_ws(LAS unsigned char* lds, const unsigned char* Abase, int npass, int nk, int ldb, ARow arow, BCol bcol, MRows mrowsf, Epi epi) {
    int tid_ = threadIdx.x; asm volatile("" : "+v"(tid_));
    const int tid = tid_, wid = __builtin_amdgcn_readfirstlane(tid >> 6), lane = tid & 63;
    if (npass <= 0) return;
    const int S = npass * nk;
#define WS_BAR() do { asm volatile("s_waitcnt lgkmcnt(0)" ::: "memory"); __builtin_amdgcn_s_barrier(); asm volatile("" ::: "memory"); } while (0)
    if (wid < 4) {
        const int wr2 = wid >> 1, wc = wid & 1, fr = lane & 15, fq = lane >> 4;
        const int aoff = wr2 * 16384 + ((fr * 64 + fq * 16) ^ ((fr >> 3) << 5));
        const int q = (lane >> 2) & 3, pp = lane & 3;
        const int b0 = (wc * 8 + (pp >> 1)) ^ ((q << 2) | (2 * (fq & 1)));
        const int browoff = 256 * (fq * 8 + q) + 8 * (pp & 1);
#define WS_BOFF(v) (browoff + 16 * (b0 ^ (v)))
        f32x4 acc[8][4];
#pragma unroll
        for (int i = 0; i < 8; ++i)
#pragma unroll
            for (int j = 0; j < 4; ++j) acc[i][j] = (f32x4){0.f, 0.f, 0.f, 0.f};
        int cP = 0, cK = 0, cm = mrowsf(0);
        bool active = (wr2 * 128) < cm;
#define WS_COMPUTE(buf) do { _Pragma("unroll") for (int ks = 0; ks < 2; ++ks) { \
            bf16x8 af[8]; s16x4 tl0, tl1, tl2, tl3, th0, th1, th2, th3; \
            LAS unsigned char* bb_ = lds + GEMM_LDS_B + (buf) * 16384 + ks * 8192; \
            tl0 = tr_read(bb_ + WS_BOFF(0)); th0 = tr_read(bb_ + 1024 + WS_BOFF(1)); tl1 = tr_read(bb_ + WS_BOFF(2)); th1 = tr_read(bb_ + 1024 + WS_BOFF(3)); \
            tl2 = tr_read(bb_ + WS_BOFF(4)); th2 = tr_read(bb_ + 1024 + WS_BOFF(5)); tl3 = tr_read(bb_ + WS_BOFF(6)); th3 = tr_read(bb_ + 1024 + WS_BOFF(7)); \
            _Pragma("unroll") for (int mi = 0; mi < 8; ++mi) af[mi] = *(const LAS bf16x8*)(lds + GEMM_LDS_A + (buf) * 32768 + aoff + mi * 2048 + ks * 1024); \
            TR_WAIT8(tl0, th0, tl1, th1, tl2, th2, tl3, th3); \
            bf16x8 bfr[4]; \
            bfr[0] = (bf16x8){tl0[0], tl0[1], tl0[2], tl0[3], th0[0], th0[1], th0[2], th0[3]}; bfr[1] = (bf16x8){tl1[0], tl1[1], tl1[2], tl1[3], th1[0], th1[1], th1[2], th1[3]}; \
            bfr[2] = (bf16x8){tl2[0], tl2[1], tl2[2], tl2[3], th2[0], th2[1], th2[2], th2[3]}; bfr[3] = (bf16x8){tl3[0], tl3[1], tl3[2], tl3[3], th3[0], th3[1], th3[2], th3[3]}; \
            _Pragma("unroll") for (int mi = 0; mi < 8; ++mi) _Pragma("unroll") for (int ni = 0; ni < 4; ++ni) \
                acc[mi][ni] = __builtin_amdgcn_mfma_f32_16x16x32_bf16(bfr[ni], af[mi], acc[mi][ni], 0, 0, 0); } } while (0)
#define WS_CSTEP(CUR) do { \
            if (active) WS_COMPUTE(CUR); \
            if (++cK == nk) { \
                if (active) epi(cP, wr2 * 128 + fr, wc * 64 + fq * 4, cm, acc); \
                _Pragma("unroll") for (int i = 0; i < 8; ++i) _Pragma("unroll") for (int j = 0; j < 4; ++j) acc[i][j] = (f32x4){0.f, 0.f, 0.f, 0.f}; \
                cK = 0; ++cP; if (cP < npass) { cm = mrowsf(cP); active = (wr2 * 128) < cm; } \
            } \
            WS_BAR(); ++s; } while (0)
        WS_BAR();
        int s = 0;
        while (s < S) { WS_CSTEP(0); if (s >= S) break; WS_CSTEP(1); }
#undef WS_BOFF
#undef WS_COMPUTE
#undef WS_CSTEP
    } else {
        const int pt = tid - 256;
        const int Ccol = (((pt >> 6) & 1) * 32 + 8 * ((lane & 3) ^ ((lane >> 5) << 1))) * 2;
        const int Rbase = 16 * (pt >> 7) + (lane >> 2);
        unsigned asrc[8];
        const int n4 = pt & 31, kb8 = pt >> 5;
        const float* bp;
        int bwoff[2];
#pragma unroll
        for (int par = 0; par < 2; ++par) { const int row = kb8 + 8 * par; const int fB = ((row & 3) << 2) | ((row >> 2) & 3); bwoff[par] = 256 * row + 16 * ((n4 >> 1) ^ fB) + 8 * (n4 & 1); }
        const int awoff = pt * 16;
        f32x4 bX[8], bY[8]; u32x4 aX[8], aY[8];
        int aP = 0, aK = 0, bP = 0, bK = 0;
#define WS_SETA() do { _Pragma("unroll") for (int _i = 0; _i < 8; ++_i) asrc[_i] = (unsigned)(arow(aP, Rbase + 32 * _i) + Ccol); } while (0)
#define WS_LOAD(AR, BR) do { \
            _Pragma("unroll") for (int _i = 0; _i < 8; ++_i) AR[_i] = *(const u32x4*)(Abase + (size_t)asrc[_i] + (size_t)aK * 128); \
            _Pragma("unroll") for (int _i = 0; _i < 8; ++_i) BR[_i] = *(const f32x4*)(bp + (size_t)(bK * 64 + kb8 + 8 * _i) * ldb); \
            if (++aK == nk) { aK = 0; if (aP + 1 < npass) { ++aP; WS_SETA(); } } \
            if (++bK == nk) { bK = 0; if (bP + 1 < npass) { ++bP; bp = bcol(bP, n4); } } } while (0)
#define WS_WRITE(AR, BR, buf) do { \
            _Pragma("unroll") for (int _i = 0; _i < 8; ++_i) *(LAS u32x4*)(lds + GEMM_LDS_A + (buf) * 32768 + _i * 4096 + awoff) = AR[_i]; \
            _Pragma("unroll") for (int _i = 0; _i < 8; ++_i) { u32x2 _w; _w.x = pk_bf16(BR[_i][0], BR[_i][1]); _w.y = pk_bf16(BR[_i][2], BR[_i][3]); \
                *(LAS u32x2*)(lds + GEMM_LDS_B + (buf) * 16384 + bwoff[_i & 1] + 4096 * (_i >> 1)) = _w; } } while (0)
#define WS_PSTEP(NXT, A_LD, B_LD, A_WR, B_WR) do { WS_LOAD(A_LD, B_LD); WS_WRITE(A_WR, B_WR, NXT); WS_BAR(); ++s; } while (0)
        WS_SETA(); bp = bcol(0, n4);
        WS_LOAD(aX, bX); WS_WRITE(aX, bX, 0);
        WS_LOAD(aY, bY);
        WS_BAR();
        int s = 0;
        while (s < S) { WS_PSTEP(1, aX, bX, aY, bY); if (s >= S) break; WS_PSTEP(0, aY, bY, aX, bX); }
#undef WS_SETA
#undef WS_LOAD
#undef WS_WRITE
#undef WS_PSTEP
    }
#undef WS_BAR
}

struct XcdDeal { int lo, step, n; };
#define TOPO_OFF (LDS_MISC + 16)
__device__ __forceinline__ XcdDeal xcd_deal(int U, const LAS unsigned char* lds, int nb) {
    const LAS int* tp_ = (const LAS int*)(lds + TOPO_OFF);
    const int px = tp_[0], cx = tp_[1], rank = tp_[2];
    XcdDeal d;
    const int xlo = (int)((long)px * U / nb), xhi = (int)((long)(px + cx) * U / nb);
    d.lo = xlo + rank; d.step = cx; d.n = (xhi - xlo - rank + cx - 1) / cx; if (d.n < 0) d.n = 0;
    return d;
}

__device__ __forceinline__ void phase0(const Params& p, int bid, int nb, float* smem, LAS unsigned char* smem_las) {
    const float* c = p.in[1]; const float* w_ada = p.in[2]; const float* b_ada = p.in[3];
    float* mod = (float*)(p.ws + WS_MOD);
    const int tid = threadIdx.x;
    float* sc = smem;
    float* red = smem + 2048;
    for (int i = tid; i < 2048; i += NT) { const float cv = c[i]; sc[i] = cv / (1.f + expf(-cv)); }
    __syncthreads();
    {
        const int cq = tid & 7, kg = tid >> 3;
        for (int u = bid; u < 192; u += nb) {
            const float* wp = w_ada + (size_t)(kg * 16) * 6144 + u * 32 + cq * 4;
            f32x4 wv[16];
#pragma unroll
            for (int i = 0; i < 16; ++i) wv[i] = *(const f32x4*)(wp + (size_t)i * 6144);
            f32x4 a0 = (f32x4){0.f, 0.f, 0.f, 0.f}, a1 = (f32x4){0.f, 0.f, 0.f, 0.f};
#pragma unroll
            for (int i = 0; i < 16; ++i) { a0 += sc[kg * 16 + i] * wv[i]; a1 += sc[1024 + kg * 16 + i] * wv[i]; }
            *(f32x4*)(red + (kg * 2 + 0) * 32 + cq * 4) = a0; *(f32x4*)(red + (kg * 2 + 1) * 32 + cq * 4) = a1;
            __syncthreads();
            if (tid < 64) {
                const int bb = tid >> 5, col = tid & 31; float sacc = 0.f;
#pragma unroll 16
                for (int g2 = 0; g2 < 64; ++g2) sacc += red[(g2 * 2 + bb) * 32 + col];
                mod[bb * 6144 + u * 32 + col] = sacc + b_ada[u * 32 + col];
            }
            __syncthreads();
        }
    }
    {
        const float* conv_w = p.in[12]; const float* conv_b = p.in[13]; const float* wa = p.in[14]; const float* ba = p.in[15]; const float* wx = p.in[16]; const float* bx = p.in[17];
        float* BG = (float*)(p.ws + WS_BG); float* GB = (float*)(p.ws + WS_GBIAS);
        for (int idx = bid * NT + tid; idx < 8 * 256 * 128; idx += nb * NT) {
            const int n = idx & 127, k = (idx >> 7) & 255, hb = idx >> 15;
            const int w = k >> 6, i = k & 63, j = (n >> 6) * 32 + ((n >> 4) & 1) * 16 + (n & 15);
            const float* W = ((n >> 5) & 1) ? wx : wa;
            BG[idx] = conv_w[w * 512 + hb * 64 + i] * W[(hb * 64 + i) * 64 + j];
        }
        for (int idx = bid * NT + tid; idx < 8 * 128; idx += nb * NT) {
            const int n = idx & 127, hb = idx >> 7, j = (n >> 6) * 32 + ((n >> 4) & 1) * 16 + (n & 15);
            const bool isx = (n >> 5) & 1; const float* W = isx ? wx : wa;
            float acc = isx ? bx[hb * 64 + j] : ba[hb * 64 + j];
            for (int i = 0; i < 64; ++i) acc += conv_b[hb * 64 + i] * W[(hb * 64 + i) * 64 + j];
            GB[idx] = acc;
        }
        float* CB = (float*)(p.ws + WS_CBIAS); const float* pos = p.in[6];
        for (int idx = bid * NW + (tid >> 6); idx < 128; idx += nb * NW) {
            const int kv = idx >> 6, j = idx & 63; const float* w1 = kv ? p.in[9] : p.in[7];
            float acc = 0.f;
#pragma unroll 8
            for (int k = (tid & 63); k < 2048; k += 64) acc += pos[k] * w1[(size_t)k * 64 + j];
            acc = wave_sum(acc);
            if ((tid & 63) == 0) CB[idx] = acc;
        }
        bf16_t* XRB = (bf16_t*)(p.ws + WS_XRB);
        for (int idx = bid * NT + tid; idx < 16 * 3 * 64; idx += nb * NT) { const int sq = idx / 192, rem = idx % 192; XRB[(size_t)sq * SEQP * 64 + rem] = 0; }
    }
    {
        const f32x4* sp = (const f32x4*)p.in[23]; u32x2* dp = (u32x2*)(p.ws + WS_WRB);
        for (int i = bid * NT + tid; i < 1024 * 256 / 4; i += nb * NT) { const f32x4 v = sp[i]; u32x2 w; w.x = pk_bf16(v[0], v[1]); w.y = pk_bf16(v[2], v[3]); dp[i] = w; }
    }
    {
        LAS float* scr = (LAS float*)((LAS unsigned char*)smem_las + 16384 + (tid >> 6) * 8704);
        const int gw = bid * NW + (tid >> 6), ngw = nb * NW, lane_ = tid & 63;
        const int I1 = 16 * 80, I2 = 16 * 32;
        for (int it = gw; it < I1 + I2; it += ngw) {
            if (it < I1) transpose_item(p.in[5], 1024, NCOLS, 2560, (bf16_t*)(p.ws + WS_WINT), scr, it, lane_);
            else transpose_item(p.in[21], 1024, 1024, 1024, (bf16_t*)(p.ws + WS_WOUTT), scr, it - I1, lane_);
        }
    }
    float* lut = (float*)(p.ws + WS_LUT); const float* rel = p.in[11];
    for (int idx = bid * NT + tid; idx < 8 * 1024; idx += nb * NT) {
        const int h = idx >> 10, d = idx & 1023;
        int bucket;
        if (d < 16) bucket = d;
        else { const int l = 16 + (int)(logf((float)d / 16.0f) / 4.1588830833596715f * 16.0f); bucket = l < 31 ? l : 31; }
        lut[idx] = rel[bucket * 8 + h];
    }
}

__device__ __forceinline__ void phase_modnorm(const Params& p, int bid, int nb, const float* src, const float* nw, int sh_off, int sc_off, float* dst, bf16_t* dstb) {
    const float* mod = (const float*)(p.ws + WS_MOD);
    const int wave = threadIdx.x >> 6, lane = threadIdx.x & 63;
    (void)dst;
    for (int row = bid * NW + wave; row < MTOK; row += nb * NW) {
        const int b = row >> 13;
        const float* xr = src + (size_t)row * 1024 + lane * 16;
        f32x4 v[4]; float ss = 0.f;
#pragma unroll
        for (int i = 0; i < 4; ++i) { v[i] = *(const f32x4*)(xr + 4 * i); ss += (v[i][0] * v[i][0] + v[i][1] * v[i][1]) + (v[i][2] * v[i][2] + v[i][3] * v[i][3]); }
        ss = wave_sum(ss);
        const float rstd = 1.0f / sqrtf(ss * (1.f / 1024.f) + 1e-6f);
        u32x4 o[2];
#pragma unroll
        for (int i = 0; i < 4; ++i) {
            const int ci = lane * 16 + 4 * i;
            const f32x4 sh = *(const f32x4*)(mod + b * 6144 + sh_off + ci), sc = *(const f32x4*)(mod + b * 6144 + sc_off + ci), w = *(const f32x4*)(nw + ci);
            f32x4 h;
#pragma unroll
            for (int j = 0; j < 4; ++j) h[j] = v[i][j] * rstd * w[j] * (1.f + sc[j]) + sh[j];
            o[i >> 1][(i & 1) * 2 + 0] = pk_bf16(h[0], h[1]); o[i >> 1][(i & 1) * 2 + 1] = pk_bf16(h[2], h[3]);
        }
        *(u32x4*)(dstb + (size_t)row * 1024 + lane * 16) = o[0];
        *(u32x4*)(dstb + (size_t)row * 1024 + lane * 16 + 8) = o[1];
    }
}

__device__ __forceinline__ void phase2_e(const Params& p, int bid, int nb, LAS unsigned char* lds) {
    bf16_t* QB = (bf16_t*)(p.ws + WS_QB); bf16_t* KV6 = (bf16_t*)(p.ws + WS_KV6); float* GATE = (float*)(p.ws + WS_GATE);
    bf16_t* XRB = (bf16_t*)(p.ws + WS_XRB); bf16_t* GRG = (bf16_t*)(p.ws + WS_GRG);
    pg8::Gemm g{(const pg8::bf16_t*)(p.ws + WS_H1B), (const pg8::bf16_t*)(p.ws + WS_WINT), MTOK, 2560, 1024};
    pg8::StaticOrder S; S.init(MTOK, 2560, nb, bid);
    auto E = make_epi_p([=](const f32x4 (&acc)[2][2][4][2], const pg8::Unit& u, int wr, int wc, int fr, int fq) {
#pragma unroll
        for (int ai = 0; ai < 2; ++ai)
#pragma unroll
            for (int mm = 0; mm < 4; ++mm) {
                const int m = u.pm * 256 + ai * 128 + wr * 64 + mm * 16 + fr;
#pragma unroll
                for (int bj = 0; bj < 2; ++bj) {
                    const int col = u.pn * 256 + bj * 128 + wc * 32 + fq * 8;
                    const f32x4 v0 = acc[ai][bj][mm][0], v1 = acc[ai][bj][mm][1];
                    if (col >= NCOLS) continue;
                    if (col < 512) {
                        const float sc = 0.125f * LOG2E; u32x4 w; w[0] = pk_bf16(v0[0] * sc, v0[1] * sc); w[1] = pk_bf16(v0[2] * sc, v0[3] * sc); w[2] = pk_bf16(v1[0] * sc, v1[1] * sc); w[3] = pk_bf16(v1[2] * sc, v1[3] * sc);
                        *(u32x4*)(QB + (size_t)m * 512 + col) = w;
                    } else if (col >= 1280 && col < 1304) {
                        f32x4 g0, g1;
#pragma unroll
                        for (int j = 0; j < 4; ++j) { g0[j] = sigm(v0[j]); g1[j] = sigm(v1[j]); }
                        *(f32x4*)(GATE + (size_t)m * 24 + (col - 1280)) = g0; *(f32x4*)(GATE + (size_t)m * 24 + (col - 1280) + 4) = g1;
                    } else if (col < 1280) {
                        const int c2 = col - 512, j6 = c2 >> 7, gg = (c2 >> 6) & 1, d = c2 & 63, bb = m >> 13, t = m & 8191;
                        u32x4 w; w[0] = pk_bf16(v0[0], v0[1]); w[1] = pk_bf16(v0[2], v0[3]); w[2] = pk_bf16(v1[0], v1[1]); w[3] = pk_bf16(v1[2], v1[3]);
                        *(u32x4*)(KV6 + (size_t)j6 * 2097152 + ((size_t)((bb * 2 + gg) * SEQ + t)) * 64 + d) = w;
                    } else if (col < 1816) {
                        const int c = col - 1304, hb = c >> 6, bb = m >> 13, t = m & 8191;
                        u32x4 w; w[0] = pk_bf16(v0[0], v0[1]); w[1] = pk_bf16(v0[2], v0[3]); w[2] = pk_bf16(v1[0], v1[1]); w[3] = pk_bf16(v1[2], v1[3]);
                        *(u32x4*)(XRB + ((size_t)(bb * 8 + hb) * SEQP + 3 + t) * 64 + (c & 63)) = w;
                    } else {
                        u32x4 w; w[0] = pk_bf16(gelu_t(v0[0]), gelu_t(v0[1])); w[1] = pk_bf16(gelu_t(v0[2]), gelu_t(v0[3])); w[2] = pk_bf16(gelu_t(v1[0]), gelu_t(v1[1])); w[3] = pk_bf16(gelu_t(v1[2]), gelu_t(v1[3]));
                        *(u32x4*)(GRG + (size_t)m * 512 + (col - 1816)) = w;
                    }
                }
            }
    });
    pg8::gemm_phase(lds, g, S, E);
}

__device__ __forceinline__ void phase5_e(const Params& p, int bid, int nb, LAS unsigned char* lds) {
    const float* x = p.in[0]; const float* mod = (const float*)(p.ws + WS_MOD); float* X1 = (float*)(p.ws + WS_X1);
    pg8::Gemm g{(const pg8::bf16_t*)(p.ws + WS_YB), (const pg8::bf16_t*)(p.ws + WS_WOUTT), MTOK, 1024, 1024};
    pg8::StaticOrder S; S.init(MTOK, 1024, nb, bid);
    auto E = make_epi([=](const f32x4 (&acc)[2][2][4][2], const pg8::Unit& u, int wr, int wc, int fr, int fq) {
        const int c0 = u.pn * 256 + wc * 32 + fq * 4;
        const int bb = (u.pm * 256) >> 13;
        f32x4 gv[2][2];
#pragma unroll
        for (int bj = 0; bj < 2; ++bj)
#pragma unroll
            for (int nn = 0; nn < 2; ++nn) gv[bj][nn] = *(const f32x4*)(mod + bb * 6144 + 2048 + c0 + bj * 128 + nn * 16);
#pragma unroll
        for (int ai = 0; ai < 2; ++ai)
#pragma unroll
            for (int mm = 0; mm < 4; ++mm) {
                const size_t o = (size_t)(u.pm * 256 + ai * 128 + wr * 64 + mm * 16 + fr) * 1024 + c0;
                f32x4 xv[2][2];
#pragma unroll
                for (int bj = 0; bj < 2; ++bj)
#pragma unroll
                    for (int nn = 0; nn < 2; ++nn) xv[bj][nn] = *(const f32x4*)(x + o + bj * 128 + nn * 16);
#pragma unroll
                for (int bj = 0; bj < 2; ++bj)
#pragma unroll
                    for (int nn = 0; nn < 2; ++nn) *(f32x4*)(X1 + o + bj * 128 + nn * 16) = xv[bj][nn] + gv[bj][nn] * acc[ai][bj][mm][nn];
            }
    });
    pg8::gemm_phase(lds, g, S, E);
}

#ifndef A4_PROBE_MASK
#define A4_PROBE_MASK 7
#endif
#define A4_KV 0
#define A4_SCORE 65536
#define A4_LUT 131200
#define LUTP 1156
#define A4_SELM 149760
__device__ __forceinline__ float ex2(float x) { return __builtin_amdgcn_exp2f(x); }

__device__ __forceinline__ float xmax_16_32(float v) {
    { auto r = __builtin_amdgcn_permlane16_swap(__float_as_uint(v), __float_as_uint(v), false, false); v = fmaxf(__uint_as_float(r[0]), __uint_as_float(r[1])); }
    { auto r = __builtin_amdgcn_permlane32_swap(__float_as_uint(v), __float_as_uint(v), false, false); v = fmaxf(__uint_as_float(r[0]), __uint_as_float(r[1])); }
    return v;
}
__device__ __forceinline__ float xsum_16_32(float v) {
    { auto r = __builtin_amdgcn_permlane16_swap(__float_as_uint(v), __float_as_uint(v), false, false); v = __uint_as_float(r[0]) + __uint_as_float(r[1]); }
    { auto r = __builtin_amdgcn_permlane32_swap(__float_as_uint(v), __float_as_uint(v), false, false); v = __uint_as_float(r[0]) + __uint_as_float(r[1]); }
    return v;
}


__device__ __forceinline__ void phase4_mfma(unsigned char* ws, int bid, int nb, LAS unsigned char* lds) {
    int tid_ = threadIdx.x; asm volatile("" : "+v"(tid_));
    const int tid = tid_, wid = __builtin_amdgcn_readfirstlane(tid >> 6), lane = tid & 63;
    const int col = lane & 15, tl = col >> 2, hd = col & 3, g4 = lane >> 4, fr = col;
    const bf16_t* QB = (const bf16_t*)(ws + WS_QB);
    const unsigned char* KV6 = ws + WS_KV6;
    const unsigned char* KCB = ws + WS_KCB; const unsigned char* VCB = ws + WS_VCB;
    const float* lutg = (const float*)(ws + WS_LUT);
    const float* GATE = (const float*)(ws + WS_GATE);
    float* OATT = (float*)(ws + WS_OATT);
    LAS float* lutl = (LAS float*)(lds + A4_LUT);
    LAS float* score = (LAS float*)(lds + A4_SCORE);
    LAS unsigned* selm = (LAS unsigned*)(lds + A4_SELM);
    const int koff0 = fr * 128 + 16 * ((g4) ^ (fr & 7)), koff1 = fr * 128 + 16 * ((4 + g4) ^ (fr & 7));
    const int q4 = (lane >> 2) & 3, pp = lane & 3, xk = (g4 & 1) * 4 + q4;
    int voff[4];
#pragma unroll
    for (int db = 0; db < 4; ++db) voff[db] = (g4 * 4 + q4) * 128 + 16 * ((db * 2 + (pp >> 1)) ^ xk) + 8 * (pp & 1);
    const int dr = tid >> 3, dsrc = dr * 128 + (((tid & 7) ^ (dr & 7)) * 16);

#define A4_ISSUE(kbase, vbase, stage) do { \
        __builtin_amdgcn_global_load_lds((const unsigned*)((kbase) + dsrc), (LAS unsigned*)(lds + A4_KV + (stage) * 16384 + wid * 1024), 16, 0, 0); \
        if (vbase) __builtin_amdgcn_global_load_lds((const unsigned*)((vbase) + dsrc), (LAS unsigned*)(lds + A4_KV + (stage) * 16384 + 8192 + wid * 1024), 16, 0, 0); } while (0)
#define A4_SYNC() do { asm volatile("s_waitcnt vmcnt(0)" ::: "memory"); __syncthreads(); } while (0)
#define A4_SYNC_RING(issued) do { asm volatile("s_waitcnt lgkmcnt(0)" ::: "memory"); if (issued) asm volatile("s_waitcnt vmcnt(2)" ::: "memory"); else asm volatile("s_waitcnt vmcnt(0)" ::: "memory"); \
        asm volatile("" ::: "memory"); __builtin_amdgcn_s_barrier(); asm volatile("" ::: "memory"); } while (0)

    for (int u2 = bid; u2 < 256; u2 += nb)
    for (int hf = 0; hf < 2; ++hf)
    for (int rep4 = 0; rep4 < ((REP & 64) ? 2 : 1); ++rep4) {
        const bool probe = rep4 > 0; const int amask = probe ? A4_PROBE_MASK : 7;
        const int bg = u2 >> 6, b = bg >> 1, g = bg & 1;
        const int T = hf ? 127 - (u2 & 63) : (u2 & 63);
        const int t0 = T * 64;
        const size_t seqbase = (size_t)(b * 2 + g) * SEQ;
        __syncthreads();
        for (int i = tid; i < 4 * 1152; i += NT) { const int hh = i / 1152, dd = i - hh * 1152; lutl[hh * LUTP + dd] = lutg[(g * 4 + hh) * 1024 + (dd < 1023 ? dd : 1023)] * LOG2E; }
        if (!probe) for (int i = tid; i < 8192; i += NT) score[i] = 0.f;
        int tq[2]; tq[0] = t0 + 8 * wid + tl; tq[1] = tq[0] + 4;
        bf16x8 qf[2][2];
#pragma unroll
        for (int ct = 0; ct < 2; ++ct) {
            const size_t m = (size_t)b * SEQ + tq[ct];
#pragma unroll
            for (int h2 = 0; h2 < 2; ++h2) qf[ct][h2] = *(const bf16x8*)(QB + m * 512 + (g * 4 + hd) * 64 + h2 * 32 + g4 * 8);
        }
#define A4_GATEV(ct, br) (GATE[((size_t)b * SEQ + tq[ct]) * 24 + (g * 4 + hd) * 3 + (br)])
        __syncthreads();

        float mrun[2], lrun[2];
        f32x4 O[2][4];
        bf16x8 kf[4][2];
        f32x4 sv[4];
#define A4_LOADK(stage) do { _Pragma("unroll") for (int kt = 0; kt < 4; ++kt) { \
            kf[kt][0] = *(const LAS bf16x8*)(lds + A4_KV + (stage) * 16384 + kt * 2048 + koff0); \
            kf[kt][1] = *(const LAS bf16x8*)(lds + A4_KV + (stage) * 16384 + kt * 2048 + koff1); } } while (0)
#define A4_SCORES(ct) do { _Pragma("unroll") for (int kt = 0; kt < 4; ++kt) { \
            sv[kt] = __builtin_amdgcn_mfma_f32_16x16x32_bf16(kf[kt][0], qf[ct][0], (f32x4){0.f, 0.f, 0.f, 0.f}, 0, 0, 0); \
            sv[kt] = __builtin_amdgcn_mfma_f32_16x16x32_bf16(kf[kt][1], qf[ct][1], sv[kt], 0, 0, 0); } } while (0)
#define A4_VREADS(stage, a, l0, h0, l1, h1, l2, h2, l3, h3) do { \
            LAS unsigned char* vb_ = lds + A4_KV + (stage) * 16384 + 8192 + (a) * 4096; \
            l0 = tr_read(vb_ + voff[0]); h0 = tr_read(vb_ + 2048 + voff[0]); l1 = tr_read(vb_ + voff[1]); h1 = tr_read(vb_ + 2048 + voff[1]); \
            l2 = tr_read(vb_ + voff[2]); h2 = tr_read(vb_ + 2048 + voff[2]); l3 = tr_read(vb_ + voff[3]); h3 = tr_read(vb_ + 2048 + voff[3]); } while (0)
#define A4_PVMMA(ct, a, l0, h0, l1, h1, l2, h2, l3, h3) do { \
            u32x4 pw; pw[0] = pk_bf16(sv[2 * (a)][0], sv[2 * (a)][1]); pw[1] = pk_bf16(sv[2 * (a)][2], sv[2 * (a)][3]); \
            pw[2] = pk_bf16(sv[2 * (a) + 1][0], sv[2 * (a) + 1][1]); pw[3] = pk_bf16(sv[2 * (a) + 1][2], sv[2 * (a) + 1][3]); \
            const bf16x8 pf = __builtin_bit_cast(bf16x8, pw); \
            O[ct][0] = __builtin_amdgcn_mfma_f32_16x16x32_bf16((bf16x8){l0[0], l0[1], l0[2], l0[3], h0[0], h0[1], h0[2], h0[3]}, pf, O[ct][0], 0, 0, 0); \
            O[ct][1] = __builtin_amdgcn_mfma_f32_16x16x32_bf16((bf16x8){l1[0], l1[1], l1[2], l1[3], h1[0], h1[1], h1[2], h1[3]}, pf, O[ct][1], 0, 0, 0); \
            O[ct][2] = __builtin_amdgcn_mfma_f32_16x16x32_bf16((bf16x8){l2[0], l2[1], l2[2], l2[3], h2[0], h2[1], h2[2], h2[3]}, pf, O[ct][2], 0, 0, 0); \
            O[ct][3] = __builtin_amdgcn_mfma_f32_16x16x32_bf16((bf16x8){l3[0], l3[1], l3[2], l3[3], h3[0], h3[1], h3[2], h3[3]}, pf, O[ct][3], 0, 0, 0); } while (0)
#define A4_ONLINE_PV(ct, stage) do { \
            s16x4 va0, va1, va2, va3, va4, va5, va6, va7; \
            A4_VREADS(stage, 0, va0, va1, va2, va3, va4, va5, va6, va7); \
            float mx = fmaxf(fmaxf(sv[0][0], sv[0][1]), fmaxf(sv[0][2], sv[0][3])); \
            _Pragma("unroll") for (int kt = 1; kt < 4; ++kt) _Pragma("unroll") for (int j = 0; j < 4; ++j) mx = fmaxf(mx, sv[kt][j]); \
            mx = xmax_16_32(mx); \
            const float mnew = fmaxf(mrun[ct], mx); const float muse = (mnew == -INF) ? 0.f : mnew; \
            const float scl = ex2(mrun[ct] - muse); mrun[ct] = mnew; \
            const float nmu = -muse; \
            _Pragma("unroll") for (int kt = 0; kt < 4; ++kt) { sv[kt] += nmu; _Pragma("unroll") for (int j = 0; j < 4; ++j) sv[kt][j] = ex2(sv[kt][j]); } \
            const f32x4 ls4 = (sv[0] + sv[1]) + (sv[2] + sv[3]); const float ls = (ls4[0] + ls4[1]) + (ls4[2] + ls4[3]); \
            lrun[ct] = lrun[ct] * scl + ls; \
            if (__builtin_amdgcn_ballot_w64(scl != 1.f) != 0ull) { _Pragma("unroll") for (int db = 0; db < 4; ++db) O[ct][db] *= scl; } \
            TR_WAIT8(va0, va1, va2, va3, va4, va5, va6, va7); \
            s16x4 vb0, vb1, vb2, vb3, vb4, vb5, vb6, vb7; \
            A4_VREADS(stage, 1, vb0, vb1, vb2, vb3, vb4, vb5, vb6, vb7); \
            A4_PVMMA(ct, 0, va0, va1, va2, va3, va4, va5, va6, va7); \
            TR_WAIT8(vb0, vb1, vb2, vb3, vb4, vb5, vb6, vb7); \
            A4_PVMMA(ct, 1, vb0, vb1, vb2, vb3, vb4, vb5, vb6, vb7); } while (0)
#define A4_PV(ct, stage) do { \
            s16x4 va0, va1, va2, va3, va4, va5, va6, va7; \
            A4_VREADS(stage, 0, va0, va1, va2, va3, va4, va5, va6, va7); \
            TR_WAIT8(va0, va1, va2, va3, va4, va5, va6, va7); \
            A4_PVMMA(ct, 0, va0, va1, va2, va3, va4, va5, va6, va7); \
            A4_VREADS(stage, 1, va0, va1, va2, va3, va4, va5, va6, va7); \
            TR_WAIT8(va0, va1, va2, va3, va4, va5, va6, va7); \
            A4_PVMMA(ct, 1, va0, va1, va2, va3, va4, va5, va6, va7); } while (0)
#define A4_RESET() do { _Pragma("unroll") for (int ct = 0; ct < 2; ++ct) { mrun[ct] = -INF; lrun[ct] = 0.f; \
            _Pragma("unroll") for (int db = 0; db < 4; ++db) O[ct][db] = (f32x4){0.f, 0.f, 0.f, 0.f}; } } while (0)
#define A4_FINISH(br, first) do { _Pragma("unroll") for (int ct = 0; ct < 2; ++ct) { \
            float lt = lrun[ct]; lt = xsum_16_32(lt); \
            const float wv = A4_GATEV(ct, br) / fmaxf(lt, 1e-30f); \
            float* op = OATT + ((size_t)b * SEQ + tq[ct]) * 512 + (g * 4 + hd) * 64 + g4 * 4; \
            _Pragma("unroll") for (int db = 0; db < 4; ++db) { f32x4 r = O[ct][db] * wv; if (!(first)) r += *(const f32x4*)(op + db * 16); *(f32x4*)(op + db * 16) = r; } } } while (0)

        if (amask & 1) {
            const unsigned char* KW = KV6 + (size_t)4 * 4194304 + seqbase * 128; const unsigned char* VW = KV6 + (size_t)5 * 4194304 + seqbase * 128;
            A4_RESET();
            const int s0 = T >= 8 ? 0 : 8 - T;
            { const int jb = T - 8 + s0; A4_ISSUE(KW + (size_t)jb * 8192, VW + (size_t)jb * 8192, 0);
              if (s0 < 8) { A4_ISSUE(KW + (size_t)(jb + 1) * 8192, VW + (size_t)(jb + 1) * 8192, 1); asm volatile("s_waitcnt vmcnt(2)" ::: "memory"); } else asm volatile("s_waitcnt vmcnt(0)" ::: "memory");
              __syncthreads(); }
            int stage = 0;
            for (int s = s0; s <= 8; ++s) {
                const int jb = T - 8 + s;
                const bool iss = (s + 2 <= 8);
                if (iss) { const int st2 = stage >= 1 ? stage - 1 : 2; const unsigned char* kn = KW + (size_t)(jb + 2) * 8192; const unsigned char* vn = VW + (size_t)(jb + 2) * 8192; A4_ISSUE(kn, vn, st2); }
#pragma unroll
                for (int ct = 0; ct < 2; ++ct) {
                    A4_LOADK(stage);
                    A4_SCORES(ct);
                    __builtin_amdgcn_sched_barrier(0);
                    const int t = tq[ct];
                    {
                        const int base = t - jb * 64 - g4 * 4;
                        const LAS float* lp = lutl + hd * LUTP + base - 51;
                        const bool edge = (s == 0) || (s == 8);
#pragma unroll
                        for (int kt = 0; kt < 4; ++kt) {
                            f32x4 bs;
#pragma unroll
                            for (int j = 0; j < 4; ++j) bs[j] = lp[51 - kt * 16 - j];
                            asm volatile("" : "+v"(bs));
                            sv[kt] += bs;
                        }
                        if (edge) {
#pragma unroll
                            for (int kt = 0; kt < 4; ++kt)
#pragma unroll
                                for (int j = 0; j < 4; ++j) { const int dist = base - kt * 16 - j; sv[kt][j] = ((dist >= 0) && (dist < 512)) ? sv[kt][j] : -INF; }
                        }
                    }
                    A4_ONLINE_PV(ct, stage);
                    __builtin_amdgcn_sched_barrier(0);
                }
                A4_SYNC_RING(iss);
                stage = stage == 2 ? 0 : stage + 1;
            }
            if (!probe) A4_FINISH(2, true);
        }
        if (amask & 2) {
            const unsigned char* KC = KCB + (size_t)(b * 2 + g) * 512 * 128; const unsigned char* VC = VCB + (size_t)(b * 2 + g) * 512 * 128;
            int ncmp = 4 * T + 3; if (ncmp > NCMP) ncmp = NCMP;
            const int nblk = (ncmp + 63) >> 6;
            A4_RESET();
            A4_ISSUE(KC, (const unsigned char*)nullptr, 0);
            A4_SYNC();
            for (int s = 0; s < nblk; ++s) {
                const int stage = s & 1;
                if (s + 1 < nblk) A4_ISSUE(KC + (size_t)(s + 1) * 8192, (const unsigned char*)nullptr, stage ^ 1);
#pragma unroll
                for (int ct = 0; ct < 2; ++ct) {
                    A4_LOADK(stage);
                    A4_SCORES(ct);
                    __builtin_amdgcn_sched_barrier(0);
                    const int t = tq[ct];
                    float mx = -INF;
#pragma unroll
                    for (int kt = 0; kt < 4; ++kt) {
                        f32x4 bs;
#pragma unroll
                        for (int j = 0; j < 4; ++j) { int dist = t - (16 * (s * 64 + kt * 16 + g4 * 4 + j) + 31); dist = dist < 1023 ? dist : 1023; bs[j] = lutl[hd * LUTP + (dist & 1023)]; }
                        asm volatile("" : "+v"(bs));
#pragma unroll
                        for (int j = 0; j < 4; ++j) {
                            const int n = s * 64 + kt * 16 + g4 * 4 + j; const int dist = t - (16 * n + 31);
                            const bool ok = (dist >= 0) && (n < NCMP);
                            sv[kt][j] = ok ? sv[kt][j] + bs[j] : -INF; mx = fmaxf(mx, sv[kt][j]);
                        }
                    }
                    mx = xmax_16_32(mx);
                    const float mnew = fmaxf(mrun[ct], mx); const float muse = (mnew == -INF) ? 0.f : mnew;
                    const float scl = ex2(mrun[ct] - muse); mrun[ct] = mnew;
                    float ls = 0.f;
#pragma unroll
                    for (int kt = 0; kt < 4; ++kt)
#pragma unroll
                        for (int j = 0; j < 4; ++j) ls += ex2(sv[kt][j] - muse);
                    lrun[ct] = lrun[ct] * scl + ls;
                    __builtin_amdgcn_sched_barrier(0);
                }
                A4_SYNC();
            }
            float mfin[2], linv[2];
#pragma unroll
            for (int ct = 0; ct < 2; ++ct) {
                float lt = lrun[ct]; lt = xsum_16_32(lt);
                linv[ct] = 1.f / fmaxf(lt, 1e-30f); mfin[ct] = (mrun[ct] == -INF) ? 0.f : mrun[ct];
            }
            A4_ISSUE(KC, VC, 0);
            A4_SYNC();
            for (int s = 0; s < nblk; ++s) {
                const int stage = s & 1;
                if (s + 1 < nblk) { const unsigned char* kn = KC + (size_t)(s + 1) * 8192; const unsigned char* vn = VC + (size_t)(s + 1) * 8192; A4_ISSUE(kn, vn, stage ^ 1); }
#pragma unroll
                for (int ct = 0; ct < 2; ++ct) {
                    A4_LOADK(stage);
                    A4_SCORES(ct);
                    __builtin_amdgcn_sched_barrier(0);
                    const int t = tq[ct];
#pragma unroll
                    for (int kt = 0; kt < 4; ++kt) {
                        f32x4 bs;
#pragma unroll
                        for (int j = 0; j < 4; ++j) { int dist = t - (16 * (s * 64 + kt * 16 + g4 * 4 + j) + 31); dist = dist < 1023 ? dist : 1023; bs[j] = lutl[hd * LUTP + (dist & 1023)]; }
                        asm volatile("" : "+v"(bs));
#pragma unroll
                        for (int j = 0; j < 4; ++j) {
                            const int n = s * 64 + kt * 16 + g4 * 4 + j; const int dist = t - (16 * n + 31);
                            const bool ok = (dist >= 0) && (n < NCMP);
                            sv[kt][j] = ok ? ex2(sv[kt][j] + bs[j] - mfin[ct]) * linv[ct] : 0.f;
                        }
                        float s4 = (sv[kt][0] + sv[kt][1]) + (sv[kt][2] + sv[kt][3]); float s3 = sv[kt][3];
                        s4 += __shfl_xor(s4, 1); s4 += __shfl_xor(s4, 2); s3 += __shfl_xor(s3, 1); s3 += __shfl_xor(s3, 2);
                        const int a = s * 16 + kt * 4 + g4;
                        if (hd == 0 && !probe) {
                            LAS float* sp = score + (8 * wid + 4 * ct + tl) * 128 + a;
                            atomicAdd((float*)sp, s4);
                            if (a + 1 < 128) atomicAdd((float*)(sp + 1), s3);
                        }
                    }
                    A4_PV(ct, stage);
                    __builtin_amdgcn_sched_barrier(0);
                }
                A4_SYNC();
            }
            if (!probe)
#pragma unroll
            for (int ct = 0; ct < 2; ++ct) {
                float* op = OATT + ((size_t)b * SEQ + tq[ct]) * 512 + (g * 4 + hd) * 64 + g4 * 4;
#pragma unroll
                for (int db = 0; db < 4; ++db) { const float gcv = A4_GATEV(ct, 0); f32x4 r = O[ct][db] * gcv; r += *(const f32x4*)(op + db * 16); *(f32x4*)(op + db * 16) = r; }
            }
        }
        __syncthreads();
        if (!probe)
        for (int tt = 0; tt < 8; ++tt) {
            const int ti = 8 * wid + tt;
            const int j0 = lane, j1 = lane + 64;
            bool sel0, sel1;
            if (T <= 15) { sel0 = j0 <= T; sel1 = false; }
            else {
                const bool c0 = (j0 >= 1) && (j0 <= T - 2), c1 = (j1 <= T - 2);
                const float s0 = c0 ? score[ti * 128 + j0] : -INF, s1 = c1 ? score[ti * 128 + j1] : -INF;
                int r0 = 0, r1 = 0;
                for (int j2 = 1; j2 <= T - 2; ++j2) { const float v = score[ti * 128 + j2]; r0 += (v > s0) || (v == s0 && j2 < j0); r1 += (v > s1) || (v == s1 && j2 < j1); }
                sel0 = (c0 && r0 < 13) || (j0 == 0) || (j0 == T) || (j0 == T - 1);
                sel1 = (c1 && r1 < 13) || (j1 == T) || (j1 == T - 1);
            }
            const unsigned long long b0 = __ballot(sel0), b1 = __ballot(sel1);
            if (lane == 0) { selm[ti * 4 + 0] = (unsigned)b0; selm[ti * 4 + 1] = (unsigned)(b0 >> 32); selm[ti * 4 + 2] = (unsigned)b1; selm[ti * 4 + 3] = (unsigned)(b1 >> 32); }
        }
        __builtin_amdgcn_wave_barrier();
        asm volatile("s_waitcnt lgkmcnt(0)" ::: "memory");
        if (amask & 4) {
            const unsigned char* KS = KV6 + (size_t)2 * 4194304 + seqbase * 128; const unsigned char* VS = KV6 + (size_t)3 * 4194304 + seqbase * 128;
            unsigned un[2][4];
#pragma unroll
            for (int ct = 0; ct < 2; ++ct)
#pragma unroll
                for (int w = 0; w < 4; ++w) {
                    unsigned uu = selm[(8 * wid + 4 * ct + 0) * 4 + w] | selm[(8 * wid + 4 * ct + 1) * 4 + w] | selm[(8 * wid + 4 * ct + 2) * 4 + w] | selm[(8 * wid + 4 * ct + 3) * 4 + w];
                    un[ct][w] = __builtin_amdgcn_readfirstlane(uu);
                }
            A4_RESET();
            const float cbfar = lutl[hd * LUTP + 1023];
            __syncthreads();
#pragma unroll
            for (int bq = 0; bq < 4; ++bq) if (bq <= T) { const unsigned char* kn = KS + (size_t)bq * 8192; const unsigned char* vn = VS + (size_t)bq * 8192; A4_ISSUE(kn, vn, bq); }
            A4_SYNC();
#pragma unroll
            for (int w = 0; w < 4; ++w) {
                const unsigned selw0 = selm[(8 * wid + tl) * 4 + w], selw1 = selm[(8 * wid + 4 + tl) * 4 + w];
                for (int gg = 0; gg < 8; ++gg) {
                    const int j0 = w * 32 + gg * 4;
                    if (j0 > T) break;
#pragma unroll
                    for (int bq = 0; bq < 4; ++bq) { const int jn = j0 + 4 + bq; if (jn <= T) { const unsigned char* kn = KS + (size_t)jn * 8192; const unsigned char* vn = VS + (size_t)jn * 8192; A4_ISSUE(kn, vn, (jn & 7)); } }
                    for (int bq = 0; bq < 4; ++bq) {
                        const int j = j0 + bq;
                        if (j > T) break;
                        const int jb = gg * 4 + bq, stage = j & 7;
                        const bool need0 = (un[0][w] >> jb) & 1u, need1 = (un[1][w] >> jb) & 1u;
                        if (need0 || need1) {
#pragma unroll
                            for (int ct = 0; ct < 2; ++ct) {
                                if (ct == 0 ? need0 : need1) {
                                    A4_LOADK(stage);
                                    A4_SCORES(ct);
                                    __builtin_amdgcn_sched_barrier(0);
                                    const int t = tq[ct];
                                    const bool csel = ((ct == 0 ? selw0 : selw1) >> jb) & 1u;
                                    if (j * 64 + 63 + 1023 <= t0) {
                                        const float cb = csel ? cbfar : -INF;
#pragma unroll
                                        for (int kt = 0; kt < 4; ++kt)
#pragma unroll
                                            for (int jj = 0; jj < 4; ++jj) sv[kt][jj] += cb;
                                    } else {
                                        const int base = t - j * 64 - g4 * 4;
                                        const LAS float* lp = lutl + hd * LUTP + base - 51;
                                        const float msk = csel ? 0.f : -INF;
#pragma unroll
                                        for (int kt = 0; kt < 4; ++kt) {
                                            f32x4 bs;
#pragma unroll
                                            for (int jj = 0; jj < 4; ++jj) bs[jj] = lp[51 - kt * 16 - jj];
                                            asm volatile("" : "+v"(bs));
                                            sv[kt] += bs + msk;
                                        }
                                        if (j == T) {
#pragma unroll
                                            for (int kt = 0; kt < 4; ++kt)
#pragma unroll
                                                for (int jj = 0; jj < 4; ++jj) { const int dist = base - kt * 16 - jj; sv[kt][jj] = (dist >= 0) ? sv[kt][jj] : -INF; }
                                        }
                                    }
                                    A4_ONLINE_PV(ct, stage);
                                    __builtin_amdgcn_sched_barrier(0);
                                }
                            }
                        }
                    }
                    A4_SYNC();
                }
            }
            if (!probe) A4_FINISH(1, false);
        }
    }
#undef A4_ISSUE
#undef A4_SYNC
#undef A4_SYNC_RING
#undef A4_LOADK
#undef A4_SCORES
#undef A4_ONLINE_PV
#undef A4_PV
#undef A4_VREADS
#undef A4_PVMMA
#undef A4_RESET
#undef A4_FINISH
#undef A4_GATEV
}

__device__ __forceinline__ void phase3_mfma(const Params& p, int bid, int nb, LAS unsigned char* lds) {
    {
        const unsigned char* XRBb = p.ws + WS_XRB; const bf16_t* XRB = (const bf16_t*)(p.ws + WS_XRB);
        const float* BG = (const float*)(p.ws + WS_BG); const float* GB = (const float*)(p.ws + WS_GBIAS);
        const float* conv_w = p.in[12]; const float* conv_b = p.in[13]; const float* lam = p.in[18];
        float* AL = (float*)(p.ws + WS_ALRU); float* UL = (float*)(p.ws + WS_ULRU);
        const XcdDeal dl = xcd_deal(512, lds, nb);
        gemm_stream<true, 1, 0, true>(lds, XRBb, dl.n, 4, 128,
            [&](int ps, int r) { const int u = dl.lo + ps * dl.step; return ((size_t)(u >> 5) * SEQP + (u & 31) * 256 + r) * 128; },
            [&](int ps, int n4) -> const float* { const int u = dl.lo + ps * dl.step; return BG + ((u >> 5) & 7) * 32768 + n4 * 4; },
            [&](int) { return 256; },
            [&](int ps, int rbase, int nbase, int, f32x4 (&acc)[4][4]) {
                const int u = dl.lo + ps * dl.step, sq = u >> 5, hb = sq & 7, bb = sq >> 3, t0 = (u & 31) * 256 + rbase;
#pragma unroll
                for (int ni = 0; ni < 2; ++ni) {
                    const int n = nbase + ni * 16;
                    const int j = (n >> 6) * 32 + ((n >> 4) & 1) * 16 + (n & 15), c = hb * 64 + j;
                    f32x4 cw[4];
#pragma unroll
                    for (int w = 0; w < 4; ++w) cw[w] = *(const f32x4*)(conv_w + w * 512 + c);
                    const f32x4 cbv = *(const f32x4*)(conv_b + c), ga = *(const f32x4*)(GB + hb * 128 + n), gx = *(const f32x4*)(GB + hb * 128 + n + 32), lm = *(const f32x4*)(lam + c);
                    f32x4 spl;
#pragma unroll
                    for (int jj = 0; jj < 4; ++jj) spl[jj] = -8.0f * softplus_(-lm[jj]);
#pragma unroll
                    for (int mi = 0; mi < 4; ++mi) {
                        u32x2 xw[4];
#pragma unroll
                        for (int w = 0; w < 4; ++w) xw[w] = *(const u32x2*)(XRB + ((size_t)sq * SEQP + t0 + mi * 16 + w) * 64 + j);
                        f32x4 xc = cbv;
#pragma unroll
                        for (int w = 0; w < 4; ++w) {
                            xc[0] += cw[w][0] * __uint_as_float(xw[w].x << 16); xc[1] += cw[w][1] * __uint_as_float(xw[w].x & 0xffff0000u);
                            xc[2] += cw[w][2] * __uint_as_float(xw[w].y << 16); xc[3] += cw[w][3] * __uint_as_float(xw[w].y & 0xffff0000u);
                        }
                        f32x4 av, uv;
#pragma unroll
                        for (int jj = 0; jj < 4; ++jj) {
                            const float r_ = sigm(acc[mi][ni][jj] + ga[jj]), ig = sigm(acc[mi][ni + 2][jj] + gx[jj]);
                            const float la = r_ * spl[jj];
                            const float a1 = __builtin_amdgcn_exp2f(la * 1.4426950408889634f);
                            av[jj] = a1; uv[jj] = __builtin_amdgcn_sqrtf(fmaxf(1.f - a1 * a1, 0.f)) * (ig * xc[jj]);
                        }
                        const size_t o = ((size_t)bb * SEQ + t0 + mi * 16) * 512 + c;
                        *(f32x4*)(AL + o) = av; *(f32x4*)(UL + o) = uv;
                        __builtin_amdgcn_sched_barrier(0);
                    }
                } });
    }
    {
        const unsigned char* KV6 = p.ws + WS_KV6; float* CP = (float*)(p.ws + WS_CPART);
        const float* W1k = p.in[7]; const float* W1v = p.in[9];
        const XcdDeal dl = xcd_deal(64, lds, nb);
        gemm_stream<false, 1>(lds, KV6, dl.n, 8, 64,
            [&](int ps, int r) { const int u = dl.lo + ps * dl.step, ks = u >> 4, kv = (u >> 3) & 1, R = (u & 7) * 256 + r;
                                 return (size_t)kv * 4194304 + ((size_t)(R >> 9) * SEQ + 16 * (R & 511)) * 128 + (size_t)ks * 1024; },
            [&](int ps, int n4) -> const float* { const int u = dl.lo + ps * dl.step, ks = u >> 4, kv = (u >> 3) & 1; return (kv ? W1v : W1k) + (size_t)ks * 512 * 64 + ((n4 * 4) & 63); },
            [&](int) { return 256; },
            [&](int ps, int r, int n, f32x4 v) { if (n < 64) { const int u = dl.lo + ps * dl.step; *(f32x4*)(CP + ((size_t)(u >> 3) * 2048 + (u & 7) * 256 + r) * 64 + n) = v; } });
    }
}

__device__ __forceinline__ void phase3b_new(const Params& p, int bid, int nb, float* smem) {
    const int tid = threadIdx.x;
    {
        const float* AL = (const float*)(p.ws + WS_ALRU); const float* UL = (const float*)(p.ws + WS_ULRU);
        float* AEND = (float*)(p.ws + WS_AEND); float* HEND = (float*)(p.ws + WS_HEND);
        const int cg = tid & 127, sg = tid >> 7;
        f32x4* summA = (f32x4*)smem; f32x4* summH = summA + 512;
        for (int u = bid; u < 256; u += nb) {
            const size_t base = ((size_t)(u >> 7) * SEQ + (u & 127) * 64 + sg * 16) * 512 + 4 * cg;
            f32x4 av[16], uv[16];
#pragma unroll
            for (int tt = 0; tt < 16; ++tt) { av[tt] = *(const f32x4*)(AL + base + (size_t)tt * 512); uv[tt] = *(const f32x4*)(UL + base + (size_t)tt * 512); }
            f32x4 A = (f32x4){1.f, 1.f, 1.f, 1.f}, H = (f32x4){0.f, 0.f, 0.f, 0.f};
#pragma unroll
            for (int tt = 0; tt < 16; ++tt) { H = av[tt] * H + uv[tt]; A = A * av[tt]; }
            __syncthreads();
            summA[sg * 128 + cg] = A; summH[sg * 128 + cg] = H;
            __syncthreads();
            if (sg == 0) {
#pragma unroll
                for (int j = 1; j < 4; ++j) { const f32x4 a2 = summA[j * 128 + cg], h2 = summH[j * 128 + cg]; H = a2 * H + h2; A = A * a2; }
                *(f32x4*)(AEND + (size_t)u * 512 + 4 * cg) = A; *(f32x4*)(HEND + (size_t)u * 512 + 4 * cg) = H;
            }
        }
        __syncthreads();
    }
    {
        const float* CP = (const float*)(p.ws + WS_CPART); const float* CB = (const float*)(p.ws + WS_CBIAS);
        float* hid = smem;
        for (int u = bid; u < 64; u += nb) {
            const int kv = u >> 5, R0 = (u & 31) * 64;
            const float* w2 = kv ? p.in[10] : p.in[8];
            bf16_t* ob = (bf16_t*)(p.ws + (kv ? WS_VCB : WS_KCB));
            __syncthreads();
            for (int i = tid; i < 64 * 64; i += NT) {
                const int r = i >> 6, c = i & 63; const size_t o = ((size_t)kv * 2048 + R0 + r) * 64 + c;
                const float v = ((CP[o] + CP[o + 262144]) + (CP[o + 524288] + CP[o + 786432])) + CB[kv * 64 + c];
                hid[r * 65 + c] = gelu_t(v);
            }
            __syncthreads();
            for (int i = tid; i < 64 * 64; i += NT) {
                const int r = i >> 6, j = i & 63; float acc = 0.f;
#pragma unroll 8
                for (int k = 0; k < 64; ++k) acc += hid[r * 65 + k] * w2[k * 64 + j];
                const int R = R0 + r;
                if ((R & 511) == 511) acc = 0.f;
                ob[(size_t)R * 64 + j] = (bf16_t)(pk_bf16(acc, acc) & 0xffffu);
            }
        }
    }
}

__device__ __forceinline__ void phase4b_new(const Params& p, int bid, int nb, float* smem) {
    const float* AL = (const float*)(p.ws + WS_ALRU); const float* UL = (const float*)(p.ws + WS_ULRU);
    const float* AEND = (const float*)(p.ws + WS_AEND); const float* HEND = (const float*)(p.ws + WS_HEND);
    const bf16_t* GRG = (const bf16_t*)(p.ws + WS_GRG); const float* OATT = (const float*)(p.ws + WS_OATT);
    const float* gaw = p.in[19]; const float* grw = p.in[20];
    bf16_t* YB = (bf16_t*)(p.ws + WS_YB);
    const int tid = threadIdx.x, lane = tid & 63;
    const int cg = tid & 127, sg = tid >> 7, wsub = (tid >> 6) & 1;
    f32x4* summA = (f32x4*)smem;
    f32x4* summH = summA + 512;
    float* ssr = smem + 4096;
    float* ssa = ssr + 128;
    const f32x4 gr_w = *(const f32x4*)(grw + 4 * cg), ga_w = *(const f32x4*)(gaw + 4 * cg);
    for (int u = bid; u < 256; u += nb) {
        const int b = u >> 7, chunk = u & 127;
        f32x4 carry = (f32x4){0.f, 0.f, 0.f, 0.f};
        {
            const size_t cb = (size_t)(b * 128) * 512 + 4 * cg;
#pragma unroll 16
            for (int k = 0; k < chunk; ++k) carry = *(const f32x4*)(AEND + cb + (size_t)k * 512) * carry + *(const f32x4*)(HEND + cb + (size_t)k * 512);
        }
        const size_t tok0 = (size_t)b * SEQ + chunk * 64 + sg * 16;
        f32x4 av[16], uv[16];
#pragma unroll
        for (int tt = 0; tt < 16; ++tt) { const size_t o = (tok0 + tt) * 512 + 4 * cg; av[tt] = *(const f32x4*)(AL + o); uv[tt] = *(const f32x4*)(UL + o); }
        f32x4 A = (f32x4){1.f, 1.f, 1.f, 1.f}, H = (f32x4){0.f, 0.f, 0.f, 0.f};
#pragma unroll
        for (int tt = 0; tt < 16; ++tt) { H = av[tt] * H + uv[tt]; A = A * av[tt]; }
        __syncthreads();
        summA[sg * 128 + cg] = A; summH[sg * 128 + cg] = H;
        __syncthreads();
#pragma unroll
        for (int j = 0; j < 3; ++j) if (j < sg) carry = summA[j * 128 + cg] * carry + summH[j * 128 + cg];
        f32x4 h = carry;
#pragma unroll
        for (int tt = 0; tt < 16; ++tt) {
            const size_t o = (tok0 + tt) * 512 + 4 * cg;
            h = av[tt] * h + uv[tt];
            const u32x2 gw = *(const u32x2*)(GRG + o);
            f32x4 v; v[0] = h[0] * __uint_as_float(gw.x << 16); v[1] = h[1] * __uint_as_float(gw.x & 0xffff0000u); v[2] = h[2] * __uint_as_float(gw.y << 16); v[3] = h[3] * __uint_as_float(gw.y & 0xffff0000u);
            uv[tt] = v;
            const float sq = wave_sum((v[0] * v[0] + v[1] * v[1]) + (v[2] * v[2] + v[3] * v[3]));
            const f32x4 oa = *(const f32x4*)(OATT + o);
            av[tt] = oa;
            const float sqa = wave_sum((oa[0] * oa[0] + oa[1] * oa[1]) + (oa[2] * oa[2] + oa[3] * oa[3]));
            if (lane == 0) { ssr[(sg * 16 + tt) * 2 + wsub] = sq; ssa[(sg * 16 + tt) * 2 + wsub] = sqa; }
        }
        __syncthreads();
#pragma unroll
        for (int tt = 0; tt < 16; ++tt) {
            const int ti = sg * 16 + tt;
            const float s1 = ssr[ti * 2] + ssr[ti * 2 + 1], s2 = ssa[ti * 2] + ssa[ti * 2 + 1];
            const float rs1 = __builtin_amdgcn_rsqf(s1 * (1.f / 512.f) + 1e-6f), rs2 = __builtin_amdgcn_rsqf(s2 * (1.f / 512.f) + 1e-6f);
            const f32x4 ya = av[tt] * rs2 * ga_w, yr = uv[tt] * rs1 * gr_w;
            u32x2 wa, wr_; wa.x = pk_bf16(ya[0], ya[1]); wa.y = pk_bf16(ya[2], ya[3]); wr_.x = pk_bf16(yr[0], yr[1]); wr_.y = pk_bf16(yr[2], yr[3]);
            *(u32x2*)(YB + (tok0 + tt) * 1024 + 4 * cg) = wa;
            *(u32x2*)(YB + (tok0 + tt) * 1024 + 512 + 4 * cg) = wr_;
        }
    }
}

__device__ __forceinline__ void phase8(const Params& p, int bid, int nb, float* smem) {
    const float* LOG = (const float*)(p.ws + WS_LOGITS); const float* brt = p.in[24];
    unsigned* cnt = (unsigned*)(p.ws + WS_HIST);
    int* EID = (int*)(p.ws + WS_EID); int* POS = (int*)(p.ws + WS_POS); float* WGT = (float*)(p.ws + WS_WGT);
    int tid_ = threadIdx.x; asm volatile("" : "+v"(tid_));
    const int wave = tid_ >> 6, lane = tid_ & 63;
    int* lhist = (int*)smem;
    if (tid_ < 256) lhist[tid_] = 0;
    __syncthreads();
    float bias[4];
#pragma unroll
    for (int r = 0; r < 4; ++r) bias[r] = brt[r * 64 + lane];
    for (int tok0 = bid * NW + wave; tok0 < MTOK; tok0 += 8 * nb * NW) {
        float lg[8][4];
#pragma unroll
        for (int k = 0; k < 8; ++k) { const int tok = tok0 + k * nb * NW; const int tc = tok < MTOK ? tok : tok0;
#pragma unroll
            for (int r = 0; r < 4; ++r) lg[k][r] = LOG[(size_t)tc * 256 + r * 64 + lane]; }
#pragma unroll
        for (int k = 0; k < 8; ++k) {
            const int tok = tok0 + k * nb * NW;
            if (tok < MTOK) {
                float sv[4], cv[4], gs[4];
#pragma unroll
                for (int r = 0; r < 4; ++r) { sv[r] = sigm(lg[k][r]); cv[r] = sv[r] + bias[r]; gs[r] = half_top2_sum(cv[r]); }
                float gsc = -INF;
#pragma unroll
                for (int r = 0; r < 4; ++r) {
                    const float ga = __builtin_bit_cast(float, __builtin_amdgcn_readlane(__builtin_bit_cast(int, gs[r]), 31));
                    const float gb = __builtin_bit_cast(float, __builtin_amdgcn_readlane(__builtin_bit_cast(int, gs[r]), 63));
                    gsc = lane == 2 * r ? ga : gsc; gsc = lane == 2 * r + 1 ? gb : gsc;
                }
                int grank = 0;
#pragma unroll
                for (int g2 = 0; g2 < 8; ++g2) { const float v2 = __builtin_bit_cast(float, __builtin_amdgcn_readlane(__builtin_bit_cast(int, gsc), g2)); grank += ((v2 > gsc) || (v2 == gsc && g2 < lane)) ? 1 : 0; }
                const unsigned long long gmask = __ballot((lane < 8) && (grank < 4));
#pragma unroll
                for (int r = 0; r < 4; ++r) cv[r] = ((gmask >> (2 * r + (lane >> 5))) & 1ull) ? cv[r] : -INF;
                int my_e = 0; float my_s = 0.f;
#pragma unroll
                for (int kk = 0; kk < 8; ++kk) {
                    float bv = cv[0]; int bi = lane;
                    if (cv[1] > bv) { bv = cv[1]; bi = 64 + lane; }
                    if (cv[2] > bv) { bv = cv[2]; bi = 128 + lane; }
                    if (cv[3] > bv) { bv = cv[3]; bi = 192 + lane; }
                    const float mx = wave_max_f(bv);
                    const int sel = wave_min_i(bv == mx ? bi : 0x7fffffff);
                    const int sr = sel >> 6;
                    const float mine = sr == 0 ? sv[0] : sr == 1 ? sv[1] : sr == 2 ? sv[2] : sv[3];
                    const float ssel = __builtin_bit_cast(float, __builtin_amdgcn_readlane(__builtin_bit_cast(int, mine), sel & 63));
                    if (lane == (sel & 63)) { cv[0] = sr == 0 ? -INF : cv[0]; cv[1] = sr == 1 ? -INF : cv[1]; cv[2] = sr == 2 ? -INF : cv[2]; cv[3] = sr == 3 ? -INF : cv[3]; }
                    if (lane == kk) { my_e = sel; my_s = ssel; }
                }
                const float ssum = wave_sum(lane < 8 ? my_s : 0.f);
                if (lane < 8) {
                    const int ps = atomicAdd(&lhist[my_e], 1);
                    EID[tok * 8 + lane] = my_e; POS[tok * 8 + lane] = ps; WGT[tok * 8 + lane] = 2.5f * my_s / ssum;
                }
            }
        }
    }
    __syncthreads();
    if (tid_ < 256) cnt[bid * 256 + tid_] = (unsigned)lhist[tid_];
}

__device__ __forceinline__ void expert_tables(const Params& p, int* off, int* tp, int shift = 6) {
    const unsigned* cnt = (const unsigned*)(p.ws + WS_CTL) + CW_CNT;
    __syncthreads();
    if (threadIdx.x < 64) {
        const int l = threadIdx.x; const int rnd = (1 << shift) - 1;
        const u32x4 c4 = *(const u32x4*)(cnt + 4 * l);
        const int c0 = (int)c4[0], c1 = (int)c4[1], c2 = (int)c4[2], c3 = (int)c4[3];
        const int t0 = (c0 + rnd) >> shift, t1 = (c1 + rnd) >> shift, t2 = (c2 + rnd) >> shift, t3 = (c3 + rnd) >> shift;
        const int so = c0 + c1 + c2 + c3, st = t0 + t1 + t2 + t3;
        int io = so, it = st;
#pragma unroll
        for (int d = 1; d < 64; d <<= 1) { const int uo = __shfl_up(io, d), ut = __shfl_up(it, d); if (l >= d) { io += uo; it += ut; } }
        const int eo = io - so, et = it - st;
        off[4 * l] = eo; off[4 * l + 1] = eo + c0; off[4 * l + 2] = eo + c0 + c1; off[4 * l + 3] = eo + c0 + c1 + c2;
        tp[4 * l] = et; tp[4 * l + 1] = et + t0; tp[4 * l + 2] = et + t0 + t1; tp[4 * l + 3] = et + t0 + t1 + t2;
        if (l == 63) { off[256] = io; tp[256] = it; tp[257] = it + (MTOK >> shift); }
    }
    __syncthreads();
}

__device__ __forceinline__ void phase9(const Params& p, int bid, int nb, float* smem) {
    int* off = (int*)smem; int* blkoff = off + 272; int* tot = off + 528; int* ptot = off + 1024; int* ppre = off + 3072;
    const unsigned* HIST = (const unsigned*)(p.ws + WS_HIST);
    unsigned* cnt = (unsigned*)(p.ws + WS_CTL) + CW_CNT;
    int tid_ = threadIdx.x; asm volatile("" : "+v"(tid_));
    const int tid = tid_;
    __syncthreads();
    {
        const int e4 = tid & 63, bg = tid >> 6, gsz = (nb + 7) >> 3, b0 = bg * gsz, b1 = (b0 + gsz) < nb ? (b0 + gsz) : nb;
        int t0 = 0, t1 = 0, t2 = 0, t3 = 0, q0 = 0, q1 = 0, q2 = 0, q3 = 0;
#pragma unroll 16
        for (int bb = b0; bb < b1; ++bb) {
            const u32x4 h = *(const u32x4*)(HIST + (size_t)bb * 256 + 4 * e4); const bool pre = bb < bid;
            t0 += (int)h[0]; t1 += (int)h[1]; t2 += (int)h[2]; t3 += (int)h[3];
            q0 += pre ? (int)h[0] : 0; q1 += pre ? (int)h[1] : 0; q2 += pre ? (int)h[2] : 0; q3 += pre ? (int)h[3] : 0;
        }
        int* pt = ptot + bg * 256 + 4 * e4; int* pq = ppre + bg * 256 + 4 * e4;
        pt[0] = t0; pt[1] = t1; pt[2] = t2; pt[3] = t3; pq[0] = q0; pq[1] = q1; pq[2] = q2; pq[3] = q3;
        __syncthreads();
        if (tid < 256) {
            int total = 0, pre = 0;
#pragma unroll
            for (int g = 0; g < 8; ++g) { total += ptot[g * 256 + tid]; pre += ppre[g * 256 + tid]; }
            tot[tid] = total; blkoff[tid] = pre; if (bid == 0) cnt[tid] = (unsigned)total;
        }
    }
    __syncthreads();
    if (tid < 64) {
        const int c0 = tot[4 * tid], c1 = tot[4 * tid + 1], c2 = tot[4 * tid + 2], c3 = tot[4 * tid + 3];
        const int so = c0 + c1 + c2 + c3; int io = so;
#pragma unroll
        for (int d = 1; d < 64; d <<= 1) { const int uo = __shfl_up(io, d); if (tid >= d) io += uo; }
        const int eo = io - so;
        off[4 * tid] = eo; off[4 * tid + 1] = eo + c0; off[4 * tid + 2] = eo + c0 + c1; off[4 * tid + 3] = eo + c0 + c1 + c2;
    }
    __syncthreads();
    const int* EID = (const int*)(p.ws + WS_EID); const int* POS = (const int*)(p.ws + WS_POS); const float* WGT = (const float*)(p.ws + WS_WGT);
    int* ST = (int*)(p.ws + WS_SLOTTOK); float* SW = (float*)(p.ws + WS_SLOTW); int* SOF = (int*)(p.ws + WS_SLOTOF);
    const int wave = tid >> 6, lane = tid & 63;
    for (int tok0 = bid * NW + wave; tok0 < MTOK; tok0 += 8 * nb * NW) {
        const int tok = tok0 + (lane >> 3) * nb * NW;
        if (tok < MTOK) {
            const int idx = tok * 8 + (lane & 7); const int e = EID[idx];
            const int slot = off[e] + blkoff[e] + POS[idx];
            ST[slot] = tok; SW[slot] = WGT[idx]; SOF[idx] = slot;
        }
    }
}

__device__ __forceinline__ int find_expert(const int* tp, int rt) {
    int lo = 0, hi = 256;
    while (lo < hi) { const int mid = (lo + hi + 1) >> 1; if (tp[mid] <= rt) lo = mid; else hi = mid - 1; }
    return lo;
}

__device__ __forceinline__ void phase7_mfma(const Params& p, int bid, int nb, LAS unsigned char* lds) {
    const unsigned char* H2b = p.ws + WS_H2B; const float* wr = p.in[23];
    float* LOG = (float*)(p.ws + WS_LOGITS);
    const XcdDeal dl = xcd_deal(64 * 2, lds, nb);
    const bf16_t* wrb = (const bf16_t*)(p.ws + WS_WRB);
    gemm_stream<false, 1, 0, false, true>(lds, H2b, dl.n, 16, 256,
        [&](int ps, int r) { const int u = dl.lo + ps * dl.step; return (size_t)((u >> 1) * 256 + r) * 2048; },
        [&](int ps, int n4) -> const bf16_t* { const int u = dl.lo + ps * dl.step; return wrb + (u & 1) * 128 + n4 * 4; },
        [&](int) { return 256; },
        [&](int ps, int r, int n, f32x4 v) { const int u = dl.lo + ps * dl.step; *(f32x4*)(LOG + (size_t)((u >> 1) * 256 + r) * 256 + (u & 1) * 128 + n) = v; });
}

#define ETAB_OFF 24576
#define EDESC_OFF (ETAB_OFF + 1024)
__device__ __forceinline__ int expert_passes(const Params& p, int bid, int nb, const LAS unsigned char* lds, float* smem, int nct, int& npass) {
    int* off = (int*)(smem + ETAB_OFF); int* tp = off + 272; int* desc = (int*)(smem + EDESC_OFF);
    expert_tables(p, off, tp, 8);
    const unsigned* cnt = (const unsigned*)(p.ws + WS_CTL) + CW_CNT;
    const XcdDeal dl = xcd_deal(tp[257] * nct, lds, nb);
    npass = dl.n;
    for (int ps = threadIdx.x; ps < npass; ps += NT) {
        const int u = dl.lo + ps * dl.step;
        const int e = find_expert(tp, u / nct);
        const int nte = tp[e + 1] - tp[e], v = u - tp[e] * nct, ct = v / nte, rtl = v - ct * nte;
        const int rows_e = e < 256 ? (int)cnt[e] : MTOK;
        const int r0 = rtl * 256;
        desc[ps * 4 + 0] = (e < 256 ? off[e] : NK) + r0;
        desc[ps * 4 + 1] = (rows_e - r0) < 256 ? (rows_e - r0) : 256;
        desc[ps * 4 + 2] = e; desc[ps * 4 + 3] = ct;
    }
    __syncthreads();
    return dl.lo;
}

__device__ __forceinline__ void phase10_mfma(const Params& p, int bid, int nb, LAS unsigned char* lds, float* smem) {
    int npass; expert_passes(p, bid, nb, lds, smem, 4, npass);
    const LAS int* desc = (const LAS int*)(lds + EDESC_OFF * 4);
    const unsigned char* H2b = p.ws + WS_H2B; const int* ST = (const int*)(p.ws + WS_SLOTTOK);
    bf16_t* HIDB = (bf16_t*)(p.ws + WS_HIDB);
    const float* W1g = p.in[25]; const float* W3g = p.in[26]; const float* W1s = p.in[28]; const float* W3s = p.in[29];
    const float* SW = (const float*)(p.ws + WS_SLOTW);
    gemm_stream_ws(lds, H2b, npass, 16, 256,
        [&](int ps, int r) { const int slot0 = desc[ps * 4], mr = desc[ps * 4 + 1]; const int rr = r < mr ? r : mr - 1; const int slot = slot0 + rr;
                             const int tok = slot < NK ? ST[slot] : slot - NK; return (size_t)tok * 2048; },
        [&](int ps, int n4) -> const float* { const int e = desc[ps * 4 + 2], hc0 = desc[ps * 4 + 3] * 64; const int n = n4 * 4;
                             const int hc = hc0 + (n >> 6) * 32 + ((n >> 2) & 3) * 8 + ((n >> 4) & 1) * 4;
                             const float* W = ((n >> 5) & 1) ? (e < 256 ? W3g + (size_t)e * 262144 : W3s) : (e < 256 ? W1g + (size_t)e * 262144 : W1s); return W + hc; },
        [&](int ps) { return desc[ps * 4 + 1]; },
        [&](int ps, int rbase, int nbase, int mr, f32x4 (&acc)[8][4]) {
            const int slot0 = desc[ps * 4] + rbase, hc = desc[ps * 4 + 3] * 64 + (nbase >> 6) * 32 + ((nbase >> 2) & 3) * 8;
            float wv[8];
#pragma unroll
            for (int mi = 0; mi < 8; ++mi) { const int slot = slot0 + mi * 16; const float wl = SW[slot < NK ? slot : 0]; wv[mi] = slot < NK ? wl : 1.f; }
#pragma unroll
            for (int mi = 0; mi < 8; ++mi) {
                if (rbase + mi * 16 < mr) {
                    float h[8];
#pragma unroll
                    for (int ni = 0; ni < 2; ++ni) {
                        const f32x4 a = acc[mi][ni], bq = acc[mi][ni + 2];
#pragma unroll
                        for (int jj = 0; jj < 4; ++jj) h[ni * 4 + jj] = a[jj] * __builtin_amdgcn_rcpf(1.f + ex2(-a[jj] * LOG2E)) * bq[jj] * wv[mi];
                    }
                    u32x4 w; w[0] = pk_bf16(h[0], h[1]); w[1] = pk_bf16(h[2], h[3]); w[2] = pk_bf16(h[4], h[5]); w[3] = pk_bf16(h[6], h[7]);
                    *(u32x4*)(HIDB + (size_t)(slot0 + mi * 16) * 256 + hc) = w;
                }
            } });
}

__device__ __forceinline__ void phase11_mfma(const Params& p, int bid, int nb, LAS unsigned char* lds, float* smem) {
    int npass; expert_passes(p, bid, nb, lds, smem, 8, npass);
    const LAS int* desc = (const LAS int*)(lds + EDESC_OFF * 4);
    const unsigned char* HIDB = p.ws + WS_HIDB; const float* SW = (const float*)(p.ws + WS_SLOTW);
    bf16_t* SO = (bf16_t*)(p.ws + WS_SLOTOUT);
    const float* W2g = p.in[27]; const float* W2s = p.in[30];
    gemm_stream_ws(lds, HIDB, npass, 4, 1024,
        [&](int ps, int r) { const int slot0 = desc[ps * 4], mr = desc[ps * 4 + 1]; const int rr = r < mr ? r : mr - 1; return (size_t)(slot0 + rr) * 512; },
        [&](int ps, int n4) -> const float* { const int e = desc[ps * 4 + 2], n0 = desc[ps * 4 + 3] * 128; const int src4 = (n4 & ~7) + 2 * (n4 & 3) + ((n4 >> 2) & 1);
                                              return (e < 256 ? W2g + (size_t)e * 262144 : W2s) + n0 + src4 * 4; },
        [&](int ps) { return desc[ps * 4 + 1]; },
        [&](int ps, int rbase, int nbase, int mr, f32x4 (&acc)[8][4]) {
            const int slot0 = desc[ps * 4] + rbase, c0 = desc[ps * 4 + 3] * 128 + (nbase >> 6) * 64 + ((nbase >> 2) & 3) * 8;
#pragma unroll
            for (int mi = 0; mi < 8; ++mi) {
                if (rbase + mi * 16 < mr) {
                    bf16_t* op = SO + (size_t)(slot0 + mi * 16) * 1024 + c0;
#pragma unroll
                    for (int np = 0; np < 2; ++np) {
                        const f32x4 v0 = acc[mi][2 * np], v1 = acc[mi][2 * np + 1];
                        u32x4 o; o[0] = pk_bf16(v0[0], v0[1]); o[1] = pk_bf16(v0[2], v0[3]); o[2] = pk_bf16(v1[0], v1[1]); o[3] = pk_bf16(v1[2], v1[3]);
                        *(u32x4*)(op + np * 32) = o;
                    }
                }
            } });
}

__device__ __forceinline__ void phase12_mfma(const Params& p, int bid, int nb) {
    const float* X1 = (const float*)(p.ws + WS_X1); const bf16_t* SO = (const bf16_t*)(p.ws + WS_SLOTOUT); const int* SOF = (const int*)(p.ws + WS_SLOTOF);
    const float* mod = (const float*)(p.ws + WS_MOD); const float* fw = p.in[31];
    const int wave = threadIdx.x >> 6, lane = threadIdx.x & 63;
    for (int row = bid * NW + wave; row < MTOK; row += nb * NW) {
        const int b = row >> 13;
        const int myslot = lane < 8 ? SOF[row * 8 + lane] : NK + row;
        float acc[16];
#pragma unroll
        for (int i = 0; i < 16; ++i) acc[i] = 0.f;
        u32x4 w0[9], w1[9];
#pragma unroll
        for (int k = 0; k < 9; ++k) {
            const int slot = __builtin_amdgcn_readlane(myslot, k);
            const u32x4* rp = (const u32x4*)(SO + (size_t)slot * 1024 + lane * 16);
            w0[k] = rp[0]; w1[k] = rp[1];
        }
#pragma unroll
        for (int k = 0; k < 9; ++k) {
#pragma unroll
            for (int j = 0; j < 4; ++j) {
                acc[2 * j] += __uint_as_float(w0[k][j] << 16); acc[2 * j + 1] += __uint_as_float(w0[k][j] & 0xffff0000u);
                acc[8 + 2 * j] += __uint_as_float(w1[k][j] << 16); acc[8 + 2 * j + 1] += __uint_as_float(w1[k][j] & 0xffff0000u);
            }
        }
        float v[16]; float ss = 0.f;
#pragma unroll
        for (int i4 = 0; i4 < 4; ++i4) {
            const f32x4 xv = *(const f32x4*)(X1 + (size_t)row * 1024 + lane * 16 + i4 * 4);
            const f32x4 gv = *(const f32x4*)(mod + b * 6144 + 5120 + lane * 16 + i4 * 4);
#pragma unroll
            for (int j = 0; j < 4; ++j) { v[i4 * 4 + j] = xv[j] + gv[j] * acc[i4 * 4 + j]; ss += v[i4 * 4 + j] * v[i4 * 4 + j]; }
        }
        ss = wave_sum(ss);
        const float rstd = 1.0f / sqrtf(ss * (1.f / 1024.f) + 1e-6f);
#pragma unroll
        for (int i4 = 0; i4 < 4; ++i4) {
            const f32x4 wv = *(const f32x4*)(fw + lane * 16 + i4 * 4);
            f32x4 o;
#pragma unroll
            for (int j = 0; j < 4; ++j) o[j] = v[i4 * 4 + j] * rstd * wv[j];
            *(f32x4*)(p.out + (size_t)row * 1024 + lane * 16 + i4 * 4) = o;
        }
    }
}

__global__ void __launch_bounds__(NT, 2) k_fused(Params p) {
    extern __shared__ __attribute__((aligned(16))) unsigned char lds_raw[];
    LAS unsigned char* lds = (LAS unsigned char*)lds_raw;
    float* smem = (float*)lds_raw;
    if (threadIdx.x == 0) { *(LAS u32x4*)(lds + LDS_MISC) = (u32x4){0u, 0u, 0u, 0u}; }
    __syncthreads();
    XcdBarrier bar = xcd_barrier_post((unsigned*)(p.ws + WS_CTL), (volatile LAS unsigned*)(lds + LDS_MISC));
    if (threadIdx.x == 0) ((LAS int*)(lds + TOPO_OFF))[2] = (int)xb_add((unsigned*)(p.ws + WS_CTL) + CW_RANK + 64 * bar.x, 1u);
    const int bid = blockIdx.x, nb = gridDim.x;
#define PH(stmt) { stmt; xcd_barrier(bar); }
#define PHR(bit, stmt) { stmt; xcd_barrier(bar); if (REP & (bit)) { stmt; xcd_barrier(bar); } }
    PH(phase0(p, bid, nb, smem, lds))
    if (threadIdx.x == 0) {
        int pre = 0, mine = 0;
        for (unsigned j = 0; j < 16; ++j) { const int c = (int)xb_ld((unsigned*)(p.ws + WS_CTL) + XB_XCNT(j)); if (j < bar.x) pre += c; if (j == bar.x) mine = c; }
        ((LAS int*)(lds + TOPO_OFF))[0] = pre; ((LAS int*)(lds + TOPO_OFF))[1] = mine > 0 ? mine : 1;
    }
    __syncthreads();
    PHR(128, phase_modnorm(p, bid, nb, p.in[0], p.in[4], 0, 1024, (float*)(p.ws + WS_H1), (bf16_t*)(p.ws + WS_H1B)))
    PHR(1, phase2_e(p, bid, nb, lds))
    PH(phase3_mfma(p, bid, nb, lds))
    PH(phase3b_new(p, bid, nb, smem))
    PH(phase4_mfma(p.ws, bid, nb, lds))
    PH(phase4b_new(p, bid, nb, smem))
    PHR(512, phase5_e(p, bid, nb, lds))
    PH(phase_modnorm(p, bid, nb, (const float*)(p.ws + WS_X1), p.in[22], 3072, 4096, (float*)(p.ws + WS_H2), (bf16_t*)(p.ws + WS_H2B)))
    PHR(1024, phase7_mfma(p, bid, nb, lds))
    PH(phase8(p, bid, nb, smem))
    PH(phase9(p, bid, nb, smem))
    PHR(16, phase10_mfma(p, bid, nb, lds, smem))
    PHR(32, phase11_mfma(p, bid, nb, lds, smem))
    phase12_mfma(p, bid, nb);
    if (REP & 2048) { xcd_barrier(bar); phase12_mfma(p, bid, nb); }
    if (REP & 4096) { for (int i = 0; i < 20; ++i) xcd_barrier(bar); }
#undef PH
#undef PHR
}

extern "C" void kernel_launch(void* const* d_in, const int* in_sizes, int n_in, void* d_out, int out_size, void* d_ws, size_t ws_size, hipStream_t stream) {
    static int grid = 0;
    if (!grid) {
        int dev = 0, cus = 0;
        (void)hipGetDevice(&dev);
        (void)hipDeviceGetAttribute(&cus, hipDeviceAttributeMultiprocessorCount, dev);
        (void)hipFuncSetAttribute((const void*)k_fused, hipFuncAttributeMaxDynamicSharedMemorySize, LDS_BYTES);
        if (cus < 1) cus = 256;
        grid = cus;
    }
    Params p{};
    for (int i = 0; i < 32; ++i) p.in[i] = (const float*)d_in[i];
    p.out = (float*)d_out; p.ws = (unsigned char*)d_ws;
    (void)hipMemsetAsync((char*)d_ws + WS_CTL, 0, CTL_BYTES, stream);
    hipLaunchKernelGGL(k_fused, dim3(grid), dim3(NT), LDS_BYTES, stream, p);
}
```

```cpp
#include <hip/hip_runtime.h>
#include <stdint.h>
#include <type_traits>


#define MTOK 16384
#define SEQ 8192
#define SEQP 8195
#define DM 1024
#define NCOLS 2328
#define COL_KC 512
#define COL_KS 768
#define COL_VS 896
#define COL_KW 1024
#define COL_VW 1152
#define COL_G 1280
#define COL_XR 1304
#define COL_GR 1816
#define NCMP 511
#define NEXP 256
#define NK 131072

#define MiB (1048576ull)
#define WS_CTL 0ull
#define CTL_BYTES (1 * MiB)
#define CW_CNT 8192
#define CW_RANK 12288
#define WS_MOD (1 * MiB)
#define WS_LUT (1 * MiB + 65536)
#define WS_KC (2 * MiB)
#define WS_VC (3 * MiB)
#define WS_AEND (4 * MiB)
#define WS_HEND (5 * MiB)
#define WS_EID (6 * MiB)
#define WS_POS (7 * MiB)
#define WS_WGT (8 * MiB)
#define WS_SLOTTOK (9 * MiB)
#define WS_SLOTW (10 * MiB)
#define WS_CARRY (11 * MiB)
#define WS_SLOTOF (12 * MiB)
#define WS_HIST (13 * MiB)
#define WS_LOGITS (16 * MiB)
#define WS_H1 (32 * MiB)
#define WS_PROJ (96 * MiB)
#define WS_HL (256 * MiB)
#define WS_AP (288 * MiB)
#define WS_ACC (320 * MiB)
#define WS_HID (384 * MiB)
#define WS_Y (528 * MiB)
#define WS_H2 (592 * MiB)
#define WS_X1 (656 * MiB)
#define WS_H1B (720 * MiB)
#define WS_YB (752 * MiB)
#define WS_H2B (784 * MiB)
#define WS_HIDB (816 * MiB)
#define WS_QB (896 * MiB)
#define WS_KV6 (912 * MiB)
#define WS_GATE (936 * MiB)
#define WS_KCB (938 * MiB)
#define WS_VCB (939 * MiB)
#define WS_OATT (940 * MiB)
#define WS_BG (14 * MiB)
#define WS_GBIAS (15 * MiB)
#define WS_CBIAS (15 * MiB + 8192)
#define WS_XRB (972 * MiB)
#define WS_GRG (990 * MiB)
#define WS_CPART (1007 * MiB)
#define WS_ALRU (256 * MiB)
#define WS_ULRU (288 * MiB)
#define WS_WINB (1012 * MiB)
#define WS_WOUTB (1017 * MiB)
#define WS_WRB (1020 * MiB)
#define WS_WINT (1012 * MiB)
#define WS_WOUTT (1017 * MiB)
#define WS_WRT (1019 * MiB)
#define WS_SLOTOUT (32 * MiB)

#ifndef REP
#define REP 0
#endif
#ifndef USE_MFMA
#define USE_MFMA 31
#endif

struct Params {
    const float* in[32];
    float* out;
    unsigned char* ws;
};

#define NT 512
#define NW 8
#define LDS_BYTES 151552
#define LDS_MISC 131072
#define INF __builtin_huge_valf()
#define LOG2E 1.4426950408889634f

__device__ __forceinline__ float wave_sum(float v) {
#define WS_DPP(ctrl, rmask) __builtin_bit_cast(float, __builtin_amdgcn_update_dpp(0, __builtin_bit_cast(int, v), (ctrl), (rmask), 0xf, true))
    v += WS_DPP(0x111, 0xf);
    v += WS_DPP(0x112, 0xf);
    v += WS_DPP(0x114, 0xf);
    v += WS_DPP(0x118, 0xf);
    v += WS_DPP(0x142, 0xa);
    v += WS_DPP(0x143, 0xc);
#undef WS_DPP
    return __builtin_bit_cast(float, __builtin_amdgcn_readlane(__builtin_bit_cast(int, v), 63));
}
__device__ __forceinline__ float wave_max(float v) {
#pragma unroll
    for (int o = 32; o; o >>= 1) v = fmaxf(v, __shfl_xor(v, o));
    return v;
}
__device__ __forceinline__ float wave_max_f(float v) {
#define WM_DPP(ctrl, rmask) __builtin_bit_cast(float, __builtin_amdgcn_update_dpp(__builtin_bit_cast(int, -INF), __builtin_bit_cast(int, v), (ctrl), (rmask), 0xf, false))
    v = fmaxf(v, WM_DPP(0x111, 0xf)); v = fmaxf(v, WM_DPP(0x112, 0xf)); v = fmaxf(v, WM_DPP(0x114, 0xf)); v = fmaxf(v, WM_DPP(0x118, 0xf));
    v = fmaxf(v, WM_DPP(0x142, 0xa)); v = fmaxf(v, WM_DPP(0x143, 0xc));
#undef WM_DPP
    return __builtin_bit_cast(float, __builtin_amdgcn_readlane(__builtin_bit_cast(int, v), 63));
}
__device__ __forceinline__ int wave_min_i(int v) {
#define WM_DPP(ctrl, rmask) __builtin_amdgcn_update_dpp(0x7fffffff, v, (ctrl), (rmask), 0xf, false)
    v = min(v, WM_DPP(0x111, 0xf)); v = min(v, WM_DPP(0x112, 0xf)); v = min(v, WM_DPP(0x114, 0xf)); v = min(v, WM_DPP(0x118, 0xf));
    v = min(v, WM_DPP(0x142, 0xa)); v = min(v, WM_DPP(0x143, 0xc));
#undef WM_DPP
    return __builtin_amdgcn_readlane(v, 63);
}
__device__ __forceinline__ float half_top2_sum(float v) {
    float m1 = v, m2 = -INF;
#define T2_STEP(ctrl, rmask) { const float p1 = __builtin_bit_cast(float, __builtin_amdgcn_update_dpp(__builtin_bit_cast(int, -INF), __builtin_bit_cast(int, m1), (ctrl), (rmask), 0xf, false)); \
                               const float p2 = __builtin_bit_cast(float, __builtin_amdgcn_update_dpp(__builtin_bit_cast(int, -INF), __builtin_bit_cast(int, m2), (ctrl), (rmask), 0xf, false)); \
                               const float n2 = fmaxf(fminf(m1, p1), fmaxf(m2, p2)); m1 = fmaxf(m1, p1); m2 = n2; }
    T2_STEP(0x111, 0xf) T2_STEP(0x112, 0xf) T2_STEP(0x114, 0xf) T2_STEP(0x118, 0xf) T2_STEP(0x142, 0xa)
#undef T2_STEP
    return m1 + m2;
}
__device__ __forceinline__ float sigm(float x) { return __builtin_amdgcn_rcpf(1.f + __builtin_amdgcn_exp2f(-1.4426950408889634f * x)); }
__device__ __forceinline__ float tanh_fast(float x) { return 1.f - 2.f * __builtin_amdgcn_rcpf(1.f + __builtin_amdgcn_exp2f(2.8853900817779268f * x)); }
__device__ __forceinline__ float gelu_t(float x) { return 0.5f * x * (1.f + tanh_fast(0.7978845608028654f * (x + 0.044715f * x * x * x))); }
__device__ __forceinline__ float softplus_(float z) { return fmaxf(z, 0.f) + log1pf(expf(-fabsf(z))); }


#define XB_TMO      128
#define XB_XCNT(j)  (256  + 64 * (j))
#define XB_XSUB(j)  (1280 + 64 * (j))
#define XB_XGEN(j)  (2304 + 64 * (j))
#define XB_TOP      3328
#define XB_TOPGEN   3392
#define XCD_BAR_WORDS 3456
#define XB_SPIN_CAP (1u << 18)
#define LAS __attribute__((address_space(3)))

__device__ __forceinline__ unsigned xb_ld(unsigned* p)              { return __hip_atomic_load(p, __ATOMIC_RELAXED, __HIP_MEMORY_SCOPE_AGENT); }
__device__ __forceinline__ unsigned xb_add(unsigned* p, unsigned v) { return __hip_atomic_fetch_add(p, v, __ATOMIC_RELAXED, __HIP_MEMORY_SCOPE_AGENT); }
__device__ __forceinline__ unsigned xb_xcc_id() { return (unsigned)__builtin_amdgcn_s_getreg((3 << 11) | 20) & 0xFu; }
#define XB_SPIN(cond, bar) do { unsigned _sp = 0; while (cond) { __builtin_amdgcn_s_sleep(1); \
    if ((++_sp & 255u) == 0u) { if (xb_ld(&(bar)[XB_TMO])) break; if (_sp > XB_SPIN_CAP) { atomicAdd(&(bar)[XB_TMO], 1u); break; } } } } while (0)

struct XcdBarrier {
    unsigned* bar; unsigned x;
    volatile LAS unsigned* st;
};
__device__ __forceinline__ XcdBarrier xcd_barrier_post(unsigned* bar, volatile LAS unsigned* st) {
    XcdBarrier b; b.bar = bar; b.x = xb_xcc_id(); b.st = st;
    if (threadIdx.x == 0) (void)xb_add(&bar[XB_XCNT(b.x)], 1u);
    return b;
}
__device__ __forceinline__ void xcd_barrier_complete(unsigned* bar, unsigned x, unsigned& nloc, unsigned& nx) {
    const unsigned G = gridDim.x * gridDim.y * gridDim.z;
    unsigned sum, cnt, mine, sp = 0u;
    for (;;) {
        sum = 0u; cnt = 0u; mine = 0u;
#pragma unroll
        for (unsigned j = 0; j < 16; ++j) { const unsigned c = xb_ld(&bar[XB_XCNT(j)]); sum += c; cnt += (c > 0u) ? 1u : 0u; mine = (j == x) ? c : mine; }
        if (sum == G) break;
        __builtin_amdgcn_s_sleep(1);
        if ((++sp & 255u) == 0u) { if (xb_ld(&bar[XB_TMO])) break; if (sp > XB_SPIN_CAP) { atomicAdd(&bar[XB_TMO], 1u); break; } }
    }
    nloc = mine > 0u ? mine : 1u; nx = cnt > 0u ? cnt : 1u;
}
__device__ __forceinline__ void xcd_barrier(const XcdBarrier& b) {
    asm volatile("s_waitcnt vmcnt(0)" ::: "memory");
    __syncthreads();
    if (threadIdx.x == 0) {
        unsigned* bar = b.bar;
        __builtin_amdgcn_s_waitcnt(0);
        unsigned nloc = b.st[0], nx = b.st[1];
        if (nloc == 0u) { xcd_barrier_complete(bar, b.x, nloc, nx); b.st[0] = nloc; b.st[1] = nx; }
        const unsigned old = xb_add(&bar[XB_XSUB(b.x)], 1u);
        const unsigned gen = old / nloc;
        if (old + 1u == (gen + 1u) * nloc) {
            __builtin_amdgcn_fence(__ATOMIC_RELEASE, "agent");
            asm volatile("s_waitcnt vmcnt(0)" ::: "memory");
            const unsigned og = xb_add(&bar[XB_TOP], 1u);
            const unsigned tg = og / nx;
            if (og + 1u == (tg + 1u) * nx) xb_add(&bar[XB_TOPGEN], 1u);
            else XB_SPIN(xb_ld(&bar[XB_TOPGEN]) == tg, bar);
            __builtin_amdgcn_fence(__ATOMIC_ACQUIRE, "agent");
            xb_add(&bar[XB_XGEN(b.x)], 1u);
            asm volatile("s_waitcnt vmcnt(0)" ::: "memory");
        } else {
            XB_SPIN(xb_ld(&bar[XB_XGEN(b.x)]) == gen, bar);
            __builtin_amdgcn_fence(__ATOMIC_ACQUIRE, "agent");
            asm volatile("s_waitcnt vmcnt(0)" ::: "memory");
        }
    }
    __syncthreads();
}

typedef short bf16x8 __attribute__((ext_vector_type(8)));
typedef short s16x4 __attribute__((ext_vector_type(4)));
typedef short v4i16_t __attribute__((ext_vector_type(4)));
typedef float f32x4 __attribute__((ext_vector_type(4)));
typedef float f32x2 __attribute__((ext_vector_type(2)));
typedef __bf16 bf16x2_t __attribute__((ext_vector_type(2)));
typedef unsigned short bf16_t;
typedef unsigned u32x2 __attribute__((ext_vector_type(2)));
typedef unsigned u32x4 __attribute__((ext_vector_type(4)));
__device__ __forceinline__ unsigned pk_bf16(float lo, float hi) { return __builtin_bit_cast(unsigned, __builtin_convertvector((f32x2){lo, hi}, bf16x2_t)); }
__device__ __forceinline__ float bf2f(bf16_t v) { return __uint_as_float(((unsigned)v) << 16); }

__device__ __forceinline__ s16x4 tr_read(LAS unsigned char* pa) { s16x4 r; asm volatile("ds_read_b64_tr_b16 %0, %1" : "=v"(r) : "v"(pa) : "memory"); return r; }
#define TR_WAIT8(a0, a1, a2, a3, a4, a5, a6, a7) asm volatile("s_waitcnt lgkmcnt(0)" : "+v"(a0), "+v"(a1), "+v"(a2), "+v"(a3), "+v"(a4), "+v"(a5), "+v"(a6), "+v"(a7) :: "memory")

#define GEMM_LDS_A 0
#define GEMM_LDS_B 65536
template <bool PAIR, int DEPTH, int MODE = 0, bool TILE_EPI = false, bool BBF16 = false, class ARow, class BCol, class MRows, class Epi>
__device__ __forceinline__ void gemm_stream(LAS unsigned char* lds, const unsigned char* Abase, int npass, int nk, int ldb, ARow arow, BCol bcol, MRows mrowsf, Epi epi) {
    int tid_ = threadIdx.x; asm volatile("" : "+v"(tid_));
    const int tid = tid_, wid = __builtin_amdgcn_readfirstlane(tid >> 6), lane = tid & 63;
    const int wr = wid >> 1, wc = wid & 1, fr = lane & 15, fq = lane >> 4;
    if (npass <= 0) return;
    const int S = npass * nk;
    const int Ccol = ((wid & 1) * 32 + 8 * ((lane & 3) ^ ((lane >> 5) << 1))) * 2;
    const int Rbase = 16 * (wid >> 1) + (lane >> 2);
    unsigned asrc[4];
    const int n4 = tid & 31, kb = tid >> 5;
    typedef typename std::conditional<BBF16, const bf16_t*, const float*>::type bptr_t;
    bptr_t bp;
    const int fB = ((kb & 3) << 2) | ((kb >> 2) & 3);
    const int bwoff = 256 * kb + 16 * ((n4 >> 1) ^ fB) + 8 * (n4 & 1);
    const int aoff = wr * 8192 + ((fr * 64 + fq * 16) ^ ((fr >> 3) << 5));
    const int q = (lane >> 2) & 3, pp = lane & 3;
    const int b0 = (wc * 8 + (pp >> 1)) ^ ((q << 2) | (2 * (fq & 1)));
    const int browoff = 256 * (fq * 8 + q) + 8 * (pp & 1);
#define GS_BOFF(v) (browoff + 16 * (b0 ^ (v)))
    f32x4 acc[4][4];
#pragma unroll
    for (int i = 0; i < 4; ++i)
#pragma unroll
        for (int j = 0; j < 4; ++j) acc[i][j] = (f32x4){0.f, 0.f, 0.f, 0.f};
    float4 bregX[4], bregY[4];
    int aP = 0, aK = 0, bP = 0, bK = 0;
#define GS_SETA() do { _Pragma("unroll") for (int _i = 0; _i < 4; ++_i) asrc[_i] = (unsigned)(arow(aP, Rbase + 64 * _i) + Ccol); } while (0)
#define GS_ISSUE_A(buf) do { _Pragma("unroll") for (int _i = 0; _i < 4; ++_i) \
        __builtin_amdgcn_global_load_lds((const unsigned*)(Abase + (size_t)asrc[_i] + (size_t)aK * 128), (LAS unsigned*)(lds + GEMM_LDS_A + (buf) * 32768 + _i * 8192 + wid * 1024), 16, 0, 0); \
        if (++aK == nk) { aK = 0; ++aP; if (aP < npass) GS_SETA(); } } while (0)
#define GS_LOAD_B(breg) do { _Pragma("unroll") for (int _i = 0; _i < 4; ++_i) { \
            if constexpr (BBF16) { const u32x2 _t = *(const u32x2*)(bp + (size_t)(bK * 64 + kb + 16 * _i) * ldb); breg[_i].x = __uint_as_float(_t.x); breg[_i].y = __uint_as_float(_t.y); } \
            else breg[_i] = *(const float4*)(bp + (size_t)(bK * 64 + kb + 16 * _i) * ldb); } \
        if (++bK == nk) { bK = 0; ++bP; if (bP < npass) bp = bcol(bP, n4); } } while (0)
#define GS_WRITE_B(breg, buf) do { _Pragma("unroll") for (int _i = 0; _i < 4; ++_i) { u32x2 _w; \
            if constexpr (BBF16) { _w.x = __float_as_uint(breg[_i].x); _w.y = __float_as_uint(breg[_i].y); } \
            else { _w.x = pk_bf16(breg[_i].x, breg[_i].y); _w.y = pk_bf16(breg[_i].z, breg[_i].w); } \
        *(LAS u32x2*)(lds + GEMM_LDS_B + (buf) * 16384 + bwoff + 4096 * _i) = _w; } } while (0)
#define GS_COMPUTE(buf) do { _Pragma("unroll") for (int ks = 0; ks < 2; ++ks) { \
            bf16x8 af[4]; s16x4 tl0, tl1, tl2, tl3, th0, th1, th2, th3; \
            LAS unsigned char* bb_ = lds + GEMM_LDS_B + (buf) * 16384 + ks * 8192; \
            tl0 = tr_read(bb_ + GS_BOFF(0)); th0 = tr_read(bb_ + 1024 + GS_BOFF(1)); tl1 = tr_read(bb_ + GS_BOFF(2)); th1 = tr_read(bb_ + 1024 + GS_BOFF(3)); \
            tl2 = tr_read(bb_ + GS_BOFF(4)); th2 = tr_read(bb_ + 1024 + GS_BOFF(5)); tl3 = tr_read(bb_ + GS_BOFF(6)); th3 = tr_read(bb_ + 1024 + GS_BOFF(7)); \
            _Pragma("unroll") for (int mi = 0; mi < 4; ++mi) af[mi] = *(const LAS bf16x8*)(lds + GEMM_LDS_A + (buf) * 32768 + aoff + mi * 2048 + ks * 1024); \
            TR_WAIT8(tl0, th0, tl1, th1, tl2, th2, tl3, th3); \
            bf16x8 bfr[4]; \
            bfr[0] = (bf16x8){tl0[0], tl0[1], tl0[2], tl0[3], th0[0], th0[1], th0[2], th0[3]}; bfr[1] = (bf16x8){tl1[0], tl1[1], tl1[2], tl1[3], th1[0], th1[1], th1[2], th1[3]}; \
            bfr[2] = (bf16x8){tl2[0], tl2[1], tl2[2], tl2[3], th2[0], th2[1], th2[2], th2[3]}; bfr[3] = (bf16x8){tl3[0], tl3[1], tl3[2], tl3[3], th3[0], th3[1], th3[2], th3[3]}; \
            _Pragma("unroll") for (int mi = 0; mi < 4; ++mi) _Pragma("unroll") for (int ni = 0; ni < 4; ++ni) \
                acc[mi][ni] = __builtin_amdgcn_mfma_f32_16x16x32_bf16(bfr[ni], af[mi], acc[mi][ni], 0, 0, 0); } } while (0)
#define GS_STEP(CUR, NXT, BREG_LD, BREG_WR) do { \
        if (MODE != 2 && s + DEPTH < S) GS_LOAD_B(BREG_LD); \
        if (MODE != 3 && s + 1 < S) GS_ISSUE_A(NXT); \
        __builtin_amdgcn_sched_barrier(0); \
        if (MODE != 1 && active) GS_COMPUTE(CUR); \
        __builtin_amdgcn_sched_barrier(0); \
        if (s + 1 < S) GS_WRITE_B(BREG_WR, NXT); \
        const bool pass_end = (cK + 1 == nk); \
        if (++cK == nk) { \
            if constexpr (TILE_EPI) { if (active) epi(cP, wr * 64 + fr, wc * 64 + fq * 4, cm, acc); } else \
            if (active) { \
                _Pragma("unroll") for (int mi = 0; mi < 4; ++mi) { const int r = wr * 64 + mi * 16 + fr; \
                    if (r < cm) { \
                        if constexpr (PAIR) { _Pragma("unroll") for (int ni = 0; ni < 2; ++ni) { epi(cP, r, wc * 64 + ni * 16 + fq * 4, acc[mi][ni], acc[mi][ni + 2]); } } \
                        else { _Pragma("unroll") for (int ni = 0; ni < 4; ++ni) { epi(cP, r, wc * 64 + ni * 16 + fq * 4, acc[mi][ni]); } } } } } \
            _Pragma("unroll") for (int i = 0; i < 4; ++i) _Pragma("unroll") for (int j = 0; j < 4; ++j) acc[i][j] = (f32x4){0.f, 0.f, 0.f, 0.f}; \
            cK = 0; ++cP; if (cP < npass) { cm = mrowsf(cP); active = (wr * 64) < cm; } \
        } \
        asm volatile("s_waitcnt lgkmcnt(0)" ::: "memory"); \
        if (DEPTH >= 2 && (s + DEPTH < S) && !pass_end) asm volatile("s_waitcnt vmcnt(4)" ::: "memory"); else asm volatile("s_waitcnt vmcnt(0)" ::: "memory"); \
        asm volatile("" ::: "memory"); __builtin_amdgcn_s_barrier(); asm volatile("" ::: "memory"); ++s; } while (0)
    int cP = 0, cK = 0, cm = mrowsf(0);
    bool active = (wr * 64) < cm;
    GS_SETA(); bp = bcol(0, n4);
    GS_ISSUE_A(0); GS_LOAD_B(bregX);
    GS_WRITE_B(bregX, 0);
    if constexpr (DEPTH >= 2) { if (1 < S) GS_LOAD_B(bregY); }
    static_assert(DEPTH == 1 || DEPTH == 2, "B prefetch depth");
    asm volatile("s_waitcnt lgkmcnt(0)" ::: "memory");
    asm volatile("s_waitcnt vmcnt(%0)" :: "n"((DEPTH - 1) * 4) : "memory");
    __syncthreads();
    int s = 0;
    if constexpr (DEPTH == 1) {
        while (s < S) { GS_STEP(0, 1, bregX, bregX); if (s >= S) break; GS_STEP(1, 0, bregX, bregX); }
    } else if constexpr (DEPTH == 2) {
        while (s < S) { GS_STEP(0, 1, bregX, bregY); if (s >= S) break; GS_STEP(1, 0, bregY, bregX); }
    }
#undef GS_SETA
#undef GS_BOFF
#undef GS_ISSUE_A
#undef GS_LOAD_B
#undef GS_WRITE_B
#undef GS_COMPUTE
#undef GS_STEP
}


template <class ARow, class BCol, class MRows, class Epi>
__device__ __forceinline__ void gemm_stream_rs(LAS unsigned char* lds, const unsigned char* Abase, int npass, int nk, int ldb, ARow arow, BCol bcol, MRows mrowsf, Epi epi) {
    int tid_ = threadIdx.x; asm volatile("" : "+v"(tid_));
    const int tid = tid_, wid = __builtin_amdgcn_readfirstlane(tid >> 6), lane = tid & 63;
    const int wr = wid >> 1, wc = wid & 1, fr = lane & 15, fq = lane >> 4;
    if (npass <= 0) return;
    const int S = npass * nk;
    const int Ccol = ((wid & 1) * 32 + 8 * ((lane & 3) ^ ((lane >> 5) << 1))) * 2;
    const int Rbase = 16 * (wid >> 1) + (lane >> 2);
    unsigned asrc[4];
    const int n4 = tid & 31, kb = tid >> 5;
    const float* bp;
    const int fB = ((kb & 3) << 2) | ((kb >> 2) & 3);
    const int bwoff = 256 * kb + 16 * ((n4 >> 1) ^ fB) + 8 * (n4 & 1);
    const int awoff = wid * 1024 + lane * 16;
    const int aoff = wr * 8192 + ((fr * 64 + fq * 16) ^ ((fr >> 3) << 5));
    const int q = (lane >> 2) & 3, pp = lane & 3;
    const int b0 = (wc * 8 + (pp >> 1)) ^ ((q << 2) | (2 * (fq & 1)));
    const int browoff = 256 * (fq * 8 + q) + 8 * (pp & 1);
#define RS_BOFF(v) (browoff + 16 * (b0 ^ (v)))
    f32x4 acc[4][4];
#pragma unroll
    for (int i = 0; i < 4; ++i)
#pragma unroll
        for (int j = 0; j < 4; ++j) acc[i][j] = (f32x4){0.f, 0.f, 0.f, 0.f};
    f32x4 bX[4], bY[4]; u32x4 aX[4], aY[4];
    int aP = 0, aK = 0, bP = 0, bK = 0;
#define RS_SETA() do { _Pragma("unroll") for (int _i = 0; _i < 4; ++_i) asrc[_i] = (unsigned)(arow(aP, Rbase + 64 * _i) + Ccol); } while (0)
#define RS_LOAD(AR, BR) do { \
        _Pragma("unroll") for (int _i = 0; _i < 4; ++_i) AR[_i] = *(const u32x4*)(Abase + (size_t)asrc[_i] + (size_t)aK * 128); \
        _Pragma("unroll") for (int _i = 0; _i < 4; ++_i) BR[_i] = *(const f32x4*)(bp + (size_t)(bK * 64 + kb + 16 * _i) * ldb); \
        if (++aK == nk) { aK = 0; if (aP + 1 < npass) { ++aP; RS_SETA(); } } \
        if (++bK == nk) { bK = 0; if (bP + 1 < npass) { ++bP; bp = bcol(bP, n4); } } } while (0)
#define RS_WRITE(AR, BR, buf) do { \
        _Pragma("unroll") for (int _i = 0; _i < 4; ++_i) *(LAS u32x4*)(lds + GEMM_LDS_A + (buf) * 32768 + _i * 8192 + awoff) = AR[_i]; \
        _Pragma("unroll") for (int _i = 0; _i < 4; ++_i) { u32x2 _w; _w.x = pk_bf16(BR[_i][0], BR[_i][1]); _w.y = pk_bf16(BR[_i][2], BR[_i][3]); \
            *(LAS u32x2*)(lds + GEMM_LDS_B + (buf) * 16384 + bwoff + 4096 * _i) = _w; } } while (0)
#define RS_COMPUTE(buf) do { _Pragma("unroll") for (int ks = 0; ks < 2; ++ks) { \
            bf16x8 af[4]; s16x4 tl0, tl1, tl2, tl3, th0, th1, th2, th3; \
            LAS unsigned char* bb_ = lds + GEMM_LDS_B + (buf) * 16384 + ks * 8192; \
            tl0 = tr_read(bb_ + RS_BOFF(0)); th0 = tr_read(bb_ + 1024 + RS_BOFF(1)); tl1 = tr_read(bb_ + RS_BOFF(2)); th1 = tr_read(bb_ + 1024 + RS_BOFF(3)); \
            tl2 = tr_read(bb_ + RS_BOFF(4)); th2 = tr_read(bb_ + 1024 + RS_BOFF(5)); tl3 = tr_read(bb_ + RS_BOFF(6)); th3 = tr_read(bb_ + 1024 + RS_BOFF(7)); \
            _Pragma("unroll") for (int mi = 0; mi < 4; ++mi) af[mi] = *(const LAS bf16x8*)(lds + GEMM_LDS_A + (buf) * 32768 + aoff + mi * 2048 + ks * 1024); \
            TR_WAIT8(tl0, th0, tl1, th1, tl2, th2, tl3, th3); \
            bf16x8 bfr[4]; \
            bfr[0] = (bf16x8){tl0[0], tl0[1], tl0[2], tl0[3], th0[0], th0[1], th0[2], th0[3]}; bfr[1] = (bf16x8){tl1[0], tl1[1], tl1[2], tl1[3], th1[0], th1[1], th1[2], th1[3]}; \
            bfr[2] = (bf16x8){tl2[0], tl2[1], tl2[2], tl2[3], th2[0], th2[1], th2[2], th2[3]}; bfr[3] = (bf16x8){tl3[0], tl3[1], tl3[2], tl3[3], th3[0], th3[1], th3[2], th3[3]}; \
            _Pragma("unroll") for (int mi = 0; mi < 4; ++mi) _Pragma("unroll") for (int ni = 0; ni < 4; ++ni) \
                acc[mi][ni] = __builtin_amdgcn_mfma_f32_16x16x32_bf16(bfr[ni], af[mi], acc[mi][ni], 0, 0, 0); } } while (0)
#define RS_STEP(CUR, NXT, A_LD, B_LD, A_WR, B_WR) do { \
        RS_LOAD(A_LD, B_LD); \
        __builtin_amdgcn_sched_barrier(0); \
        if (active) RS_COMPUTE(CUR); \
        __builtin_amdgcn_sched_barrier(0); \
        RS_WRITE(A_WR, B_WR, NXT); \
        if (++cK == nk) { \
            if (active) epi(cP, wr * 64 + fr, wc * 64 + fq * 4, cm, acc); \
            _Pragma("unroll") for (int i = 0; i < 4; ++i) _Pragma("unroll") for (int j = 0; j < 4; ++j) acc[i][j] = (f32x4){0.f, 0.f, 0.f, 0.f}; \
            cK = 0; ++cP; if (cP < npass) { cm = mrowsf(cP); active = (wr * 64) < cm; } \
        } \
        asm volatile("s_waitcnt lgkmcnt(0)" ::: "memory"); \
        asm volatile("" ::: "memory"); __builtin_amdgcn_s_barrier(); asm volatile("" ::: "memory"); ++s; } while (0)
    int cP = 0, cK = 0, cm = mrowsf(0);
    bool active = (wr * 64) < cm;
    RS_SETA(); bp = bcol(0, n4);
    RS_LOAD(aX, bX); RS_WRITE(aX, bX, 0);
    RS_LOAD(aY, bY);
    asm volatile("s_waitcnt lgkmcnt(0)" ::: "memory");
    __syncthreads();
    int s = 0;
    while (s < S) { RS_STEP(0, 1, aX, bX, aY, bY); if (s >= S) break; RS_STEP(1, 0, aY, bY, aX, bX); }
#undef RS_BOFF
#undef RS_SETA
#undef RS_LOAD
#undef RS_WRITE
#undef RS_COMPUTE
#undef RS_STEP
}

namespace pg8 {
#define PG8_LAS __attribute__((address_space(3)))
typedef unsigned short bf16_t;
typedef short bf16x8 __attribute__((ext_vector_type(8)));
typedef float f32x4 __attribute__((ext_vector_type(4)));
typedef unsigned u32x4 __attribute__((ext_vector_type(4)));
constexpr int BM = 256, BK = 64, HALF = 128, HTB = HALF * BK * 2  , STAGE_BYTES = 8 * HTB, NXCD = 8, WGM = 8;

__host__ __device__ __forceinline__ int lds_byte(int r, int c) { const int st = (r >> 4) * 2 + (c >> 5), rr = r & 15, cc = c & 31, ob = rr * 64 + cc * 2; return st * 1024 + (ob ^ (((ob >> 9) & 1) << 5)); }
__host__ __device__ __forceinline__ void stage_rc(int b, int& R, int& C) { const int st = b / 1024, sb = b % 1024, swz = sb ^ (((sb >> 9) & 1) << 5); R = (st >> 1) * 16 + swz / 64; C = (st & 1) * 32 + (swz % 64) / 2; }
__host__ __device__ __forceinline__ int perm32(int rho) { const int n = rho >> 4, i = rho & 15; return 8 * (i >> 2) + 4 * n + (i & 3); }

struct Unit { int pm, pn; };
struct Gemm { const bf16_t* A; const bf16_t* Bt; int M, N, K; };

struct StaticOrder {
    int nM, nN, nwg, G, c;
    __host__ __device__ void init(int M, int N, int G_, int c_) { nM = M / BM; nN = N / BM; nwg = nM * nN; G = G_; c = c_; }
    __host__ __device__ bool next(int i, Unit& u) const {
        const long L = (long)i * G + c; if (L >= nwg) return false;
        int wgid = (int)L; { const int q = nwg / NXCD, r = nwg % NXCD, xcd = wgid % NXCD, off = wgid / NXCD; wgid = (xcd < r ? xcd * (q + 1) : r * (q + 1) + (xcd - r) * q) + off; }
        const int nig = WGM * nN, gid = wgid / nig, fm = gid * WGM, gsz = (nM - fm) < WGM ? (nM - fm) : WGM;
        u.pm = fm + ((wgid % nig) % gsz); u.pn = (wgid % nig) / gsz; return true;
    }
    __device__ __forceinline__ void a_ready(const Unit&) const {}
    __device__ __forceinline__ void done(const Unit&) const {}
};
template <class Epi, class Sched>
__device__ __forceinline__ void gemm_phase(PG8_LAS unsigned char* lds, const Gemm g, const Sched& S, const Epi& E) {
    int tid_l = threadIdx.x; asm volatile("" : "+v"(tid_l));
    const int tid = tid_l, wid = __builtin_amdgcn_readfirstlane(tid >> 6), lane = tid & 63, wr = wid >> 2, wc = wid & 3, fr = lane & 15, fq = lane >> 4;
    const int K = g.K, nt = K / BK;

    unsigned voffA[2], voffB[2];
#pragma unroll
    for (int i = 0; i < 2; ++i) { int R, C; stage_rc(tid * 16 + i * 8192, R, C); const int Rb = Epi::PERM ? ((R & ~31) + perm32(R & 31)) : R;
        voffA[i] = (unsigned)(R * K + C) * 2u; voffB[i] = (unsigned)(Rb * K + C) * 2u; }
    const size_t kstep = (size_t)(BK * 2);
    const size_t hstep = (size_t)HALF * K * 2;
    const size_t tstep = 2 * hstep;
    const unsigned ldsw = (unsigned)wid * 1024u;
    const int aoff = lds_byte(wr * 64 + fr, fq * 8), boff = lds_byte(wc * 32 + fr, fq * 8);
#define PG8_SA(b, h) (((b) * 2 + (h)) * HTB)
#define PG8_SB(b, h) ((4 + (b) * 2 + (h)) * HTB)
#define PG8_STAGE(bufoff, gbase, voff) do { _Pragma("unroll") for (int _i = 0; _i < 2; ++_i) \
        __builtin_amdgcn_global_load_lds((const unsigned*)((const char*)(gbase) + (voff)[_i]), (PG8_LAS unsigned*)(lds + (bufoff) + ldsw + _i * 8192), 16, 0, 0); } while (0)
#define PG8_LDA(dst, b, h) do { _Pragma("unroll") for (int m = 0; m < 4; ++m) _Pragma("unroll") for (int k = 0; k < 2; ++k) dst[m][k] = *(const PG8_LAS bf16x8*)(lds + PG8_SA(b, h) + aoff + m * 2048 + k * 1024); } while (0)
#define PG8_LDB(dst, b, h) do { _Pragma("unroll") for (int n = 0; n < 2; ++n) _Pragma("unroll") for (int k = 0; k < 2; ++k) dst[n][k] = *(const PG8_LAS bf16x8*)(lds + PG8_SB(b, h) + boff + n * 2048 + k * 1024); } while (0)
#define PG8_MMA(ai, bj, At, Bt) do { __builtin_amdgcn_s_setprio(1); _Pragma("unroll") for (int m = 0; m < 4; ++m) _Pragma("unroll") for (int n = 0; n < 2; ++n) _Pragma("unroll") for (int k = 0; k < 2; ++k) \
        acc[ai][bj][m][n] = __builtin_amdgcn_mfma_f32_16x16x32_bf16(Bt[n][k], At[m][k], acc[ai][bj][m][n], 0, 0, 0); __builtin_amdgcn_s_setprio(0); } while (0)
#define PG8_WAIT_V(n) asm volatile("s_waitcnt vmcnt(" #n ")" ::: "memory")
#define PG8_WAIT_L(n) asm volatile("s_waitcnt lgkmcnt(" #n ")" ::: "memory")
#define PG8_BAR __builtin_amdgcn_s_barrier()
#define PG8_SCHED __builtin_amdgcn_sched_barrier(0)
    Unit cur, nxt; int ui = 0;
    if (!S.next(0, cur)) return;
    f32x4 acc[2][2][4][2];
#pragma unroll
    for (int a = 0; a < 2; ++a)
#pragma unroll
        for (int b = 0; b < 2; ++b)
#pragma unroll
            for (int m = 0; m < 4; ++m)
#pragma unroll
                for (int n = 0; n < 2; ++n) acc[a][b][m][n] = (f32x4){0.f, 0.f, 0.f, 0.f};
    bf16x8 At[4][2], B0[2][2], B1[2][2];
    const char* cA = (const char*)g.A + (size_t)cur.pm * tstep; const char* cB = (const char*)g.Bt + (size_t)cur.pn * tstep;
    S.a_ready(cur);
    PG8_STAGE(PG8_SB(0, 0), cB, voffB); PG8_STAGE(PG8_SA(0, 0), cA, voffA); PG8_STAGE(PG8_SB(0, 1), cB + hstep, voffB); PG8_STAGE(PG8_SA(0, 1), cA + hstep, voffA);
    if (wr == 1) PG8_BAR;
    PG8_WAIT_V(4); PG8_BAR;
    PG8_STAGE(PG8_SB(1, 0), cB + kstep, voffB); PG8_STAGE(PG8_SA(1, 0), cA + kstep, voffA); PG8_STAGE(PG8_SB(1, 1), cB + hstep + kstep, voffB);
    PG8_WAIT_V(6); PG8_BAR;

    for (;;) {
        const bool has_next = S.next(ui + 1, nxt);
        const char* nA = has_next ? (const char*)g.A + (size_t)nxt.pm * tstep : cA; const char* nB = has_next ? (const char*)g.Bt + (size_t)nxt.pn * tstep : cB;
        for (int t = 0; t < nt; t += 2) {
            const bool last = (t == nt - 2);
            const char* a1 = cA + (size_t)(t + 1) * kstep;
            const char* a2 = last ? nA : cA + (size_t)(t + 2) * kstep; const char* b2 = last ? nB : cB + (size_t)(t + 2) * kstep;
            const char* a3 = a2 + kstep; const char* b3 = b2 + kstep;
            if (last && has_next) S.a_ready(nxt);
            PG8_LDB(B0, 0, 0); PG8_SCHED; PG8_LDA(At, 0, 0); PG8_STAGE(PG8_SA(1, 1), a1 + hstep, voffA);
            PG8_WAIT_L(8); PG8_BAR; PG8_WAIT_L(0); PG8_MMA(0, 0, At, B0); PG8_BAR; PG8_SCHED;
            PG8_LDB(B1, 0, 1); PG8_STAGE(PG8_SB(0, 0), b2, voffB);
            PG8_BAR; PG8_WAIT_L(0); PG8_MMA(0, 1, At, B1); PG8_BAR;
            PG8_LDA(At, 0, 1); PG8_STAGE(PG8_SA(0, 0), a2, voffA);
            PG8_BAR; PG8_WAIT_L(0); PG8_MMA(1, 0, At, B0); PG8_BAR; PG8_SCHED;
            PG8_STAGE(PG8_SB(0, 1), b2 + hstep, voffB);
            PG8_WAIT_V(6); PG8_BAR; PG8_MMA(1, 1, At, B1); PG8_BAR;
            PG8_LDB(B0, 1, 0); PG8_SCHED; PG8_LDA(At, 1, 0); PG8_STAGE(PG8_SA(0, 1), a2 + hstep, voffA);
            PG8_WAIT_L(8); PG8_BAR; PG8_WAIT_L(0); PG8_MMA(0, 0, At, B0); PG8_BAR; PG8_SCHED;
            PG8_LDB(B1, 1, 1); PG8_STAGE(PG8_SB(1, 0), b3, voffB);
            PG8_BAR; PG8_WAIT_L(0); PG8_MMA(0, 1, At, B1); PG8_BAR;
            PG8_LDA(At, 1, 1); PG8_STAGE(PG8_SA(1, 0), a3, voffA);
            PG8_BAR; PG8_WAIT_L(0); PG8_MMA(1, 0, At, B0); PG8_BAR; PG8_SCHED;
            PG8_STAGE(PG8_SB(1, 1), b3 + hstep, voffB);
            PG8_WAIT_V(6); PG8_BAR; PG8_MMA(1, 1, At, B1); PG8_BAR;
        }

        if constexpr (!Epi::AFTER_DRAIN) { E(acc, cur, wr, wc, fr, fq); S.done(cur); }

        if (!has_next) break;
#pragma unroll
        for (int a = 0; a < 2; ++a)
#pragma unroll
            for (int b = 0; b < 2; ++b)
#pragma unroll
                for (int m = 0; m < 4; ++m)
#pragma unroll
                    for (int n = 0; n < 2; ++n) acc[a][b][m][n] = (f32x4){0.f, 0.f, 0.f, 0.f};
        cur = nxt; cA = nA; cB = nB; ++ui;
    }
    PG8_WAIT_V(0);
    if (wr == 0) PG8_BAR;
    PG8_BAR;
    if constexpr (Epi::AFTER_DRAIN) { E.fused(acc, cur, wr, wc, fr, fq, lds, wid, lane); S.done(cur); }

#undef PG8_SA
#undef PG8_SB
#undef PG8_STAGE
#undef PG8_LDA
#undef PG8_LDB
#undef PG8_MMA
#undef PG8_WAIT_V
#undef PG8_WAIT_L
#undef PG8_BAR
#undef PG8_SCHED
}
}
template <class F> struct EpiWrap {
    static constexpr bool PERM = false, AFTER_DRAIN = false; F f;
    __device__ __forceinline__ void operator()(const f32x4 (&acc)[2][2][4][2], const pg8::Unit& u, int wr, int wc, int fr, int fq) const { f(acc, u, wr, wc, fr, fq); }
};
template <class F> __device__ __forceinline__ EpiWrap<F> make_epi(F f) { return EpiWrap<F>{f}; }
template <class F> struct EpiWrapP {
    static constexpr bool PERM = true, AFTER_DRAIN = false; F f;
    __device__ __forceinline__ void operator()(const f32x4 (&acc)[2][2][4][2], const pg8::Unit& u, int wr, int wc, int fr, int fq) const { f(acc, u, wr, wc, fr, fq); }
};
template <class F> __device__ __forceinline__ EpiWrapP<F> make_epi_p(F f) { return EpiWrapP<F>{f}; }

__device__ __forceinline__ void transpose_item(const float* W, int K, int N, int Npad, bf16_t* WT, LAS float* scr, int item, int lane) {
    const int nblk = Npad / 32, kb = item / nblk, nb_ = item % nblk, k0 = 64 * kb, n0 = 32 * nb_;
#pragma unroll 8
    for (int i = 0; i < 32; ++i) { const int kk = 2 * i + (lane >> 5), n = n0 + (lane & 31); scr[kk * 33 + (lane & 31)] = n < N ? W[(size_t)(k0 + kk) * N + n] : 0.f; }
    asm volatile("s_waitcnt lgkmcnt(0)" ::: "memory");
    const int c = lane & 7;
#pragma unroll
    for (int j = 0; j < 4; ++j) { const int n = (lane >> 3) + 8 * j; const LAS float* sp = scr + (8 * c) * 33 + n;
        u32x4 o; o[0] = pk_bf16(sp[0 * 33], sp[1 * 33]); o[1] = pk_bf16(sp[2 * 33], sp[3 * 33]); o[2] = pk_bf16(sp[4 * 33], sp[5 * 33]); o[3] = pk_bf16(sp[6 * 33], sp[7 * 33]);
        *(u32x4*)(WT + (size_t)(n0 + n) * K + k0 + 8 * c) = o; }
    asm volatile("s_waitcnt lgkmcnt(0)" ::: "memory");
}

template <class ARow, class BCol, class MRows, class Epi>
__device__ __forceinline__ void gemm_stream_ws(LAS unsigned char* lds, const unsigned char* Abase, int npass, int nk, int ldb, ARow arow, BCol bcol, MRows mrowsf, Epi epi) {
    int tid_ = threadIdx.x; asm volatile("" : "+v"(tid_));
    const int tid = tid_, wid = __builtin_amdgcn_readfirstlane(tid >> 6), lane = tid & 63;
    if (npass <= 0) return;
    const int S = npass * nk;
#define WS_BAR() do { asm volatile("s_waitcnt lgkmcnt(0)" ::: "memory"); __builtin_amdgcn_s_barrier(); asm volatile("" ::: "memory"); } while (0)
    if (wid < 4) {
        const int wr2 = wid >> 1, wc = wid & 1, fr = lane & 15, fq = lane >> 4;
        const int aoff = wr2 * 16384 + ((fr * 64 + fq * 16) ^ ((fr >> 3) << 5));
        const int q = (lane >> 2) & 3, pp = lane & 3;
        const int b0 = (wc * 8 + (pp >> 1)) ^ ((q << 2) | (2 * (fq & 1)));
        const int browoff = 256 * (fq * 8 + q) + 8 * (pp & 1);
#define WS_BOFF(v) (browoff + 16 * (b0 ^ (v)))
        f32x4 acc[8][4];
#pragma unroll
        for (int i = 0; i < 8; ++i)
#pragma unroll
            for (int j = 0; j < 4; ++j) acc[i][j] = (f32x4){0.f, 0.f, 0.f, 0.f};
        int cP = 0, cK = 0, cm = mrowsf(0);
        bool active = (wr2 * 128) < cm;
#define WS_COMPUTE(buf) do { _Pragma("unroll") for (int ks = 0; ks < 2; ++ks) { \
            bf16x8 af[8]; s16x4 tl0, tl1, tl2, tl3, th0, th1, th2, th3; \
            LAS unsigned char* bb_ = lds + GEMM_LDS_B + (buf) * 16384 + ks * 8192; \
            tl0 = tr_read(bb_ + WS_BOFF(0)); th0 = tr_read(bb_ + 1024 + WS_BOFF(1)); tl1 = tr_read(bb_ + WS_BOFF(2)); th1 = tr_read(bb_ + 1024 + WS_BOFF(3)); \
            tl2 = tr_read(bb_ + WS_BOFF(4)); th2 = tr_read(bb_ + 1024 + WS_BOFF(5)); tl3 = tr_read(bb_ + WS_BOFF(6)); th3 = tr_read(bb_ + 1024 + WS_BOFF(7)); \
            _Pragma("unroll") for (int mi = 0; mi < 8; ++mi) af[mi] = *(const LAS bf16x8*)(lds + GEMM_LDS_A + (buf) * 32768 + aoff + mi * 2048 + ks * 1024); \
            TR_WAIT8(tl0, th0, tl1, th1, tl2, th2, tl3, th3); \
            bf16x8 bfr[4]; \
            bfr[0] = (bf16x8){tl0[0], tl0[1], tl0[2], tl0[3], th0[0], th0[1], th0[2], th0[3]}; bfr[1] = (bf16x8){tl1[0], tl1[1], tl1[2], tl1[3], th1[0], th1[1], th1[2], th1[3]}; \
            bfr[2] = (bf16x8){tl2[0], tl2[1], tl2[2], tl2[3], th2[0], th2[1], th2[2], th2[3]}; bfr[3] = (bf16x8){tl3[0], tl3[1], tl3[2], tl3[3], th3[0], th3[1], th3[2], th3[3]}; \
            _Pragma("unroll") for (int mi = 0; mi < 8; ++mi) _Pragma("unroll") for (int ni = 0; ni < 4; ++ni) \
                acc[mi][ni] = __builtin_amdgcn_mfma_f32_16x16x32_bf16(bfr[ni], af[mi], acc[mi][ni], 0, 0, 0); } } while (0)
#define WS_CSTEP(CUR) do { \
            if (active) WS_COMPUTE(CUR); \
            if (++cK == nk) { \
                if (active) epi(cP, wr2 * 128 + fr, wc * 64 + fq * 4, cm, acc); \
                _Pragma("unroll") for (int i = 0; i < 8; ++i) _Pragma("unroll") for (int j = 0; j < 4; ++j) acc[i][j] = (f32x4){0.f, 0.f, 0.f, 0.f}; \
                cK = 0; ++cP; if (cP < npass) { cm = mrowsf(cP); active = (wr2 * 128) < cm; } \
            } \
            WS_BAR(); ++s; } while (0)
        WS_BAR();
        int s = 0;
        while (s < S) { WS_CSTEP(0); if (s >= S) break; WS_CSTEP(1); }
#undef WS_BOFF
#undef WS_COMPUTE
#undef WS_CSTEP
    } else {
        const int pt = tid - 256;
        const int Ccol = (((pt >> 6) & 1) * 32 + 8 * ((lane & 3) ^ ((lane >> 5) << 1))) * 2;
        const int Rbase = 16 * (pt >> 7) + (lane >> 2);
        unsigned asrc[8];
        const int n4 = pt & 31, kb8 = pt >> 5;
        const float* bp;
        int bwoff[2];
#pragma unroll
        for (int par = 0; par < 2; ++par) { const int row = kb8 + 8 * par; const int fB = ((row & 3) << 2) | ((row >> 2) & 3); bwoff[par] = 256 * row + 16 * ((n4 >> 1) ^ fB) + 8 * (n4 & 1); }
        const int awoff = pt * 16;
        f32x4 bX[8], bY[8]; u32x4 aX[8], aY[8];
        int aP = 0, aK = 0, bP = 0, bK = 0;
#define WS_SETA() do { _Pragma("unroll") for (int _i = 0; _i < 8; ++_i) asrc[_i] = (unsigned)(arow(aP, Rbase + 32 * _i) + Ccol); } while (0)
#define WS_LOAD(AR, BR) do { \
            _Pragma("unroll") for (int _i = 0; _i < 8; ++_i) AR[_i] = *(const u32x4*)(Abase + (size_t)asrc[_i] + (size_t)aK * 128); \
            _Pragma("unroll") for (int _i = 0; _i < 8; ++_i) BR[_i] = *(const f32x4*)(bp + (size_t)(bK * 64 + kb8 + 8 * _i) * ldb); \
            if (++aK == nk) { aK = 0; if (aP + 1 < npass) { ++aP; WS_SETA(); } } \
            if (++bK == nk) { bK = 0; if (bP + 1 < npass) { ++bP; bp = bcol(bP, n4); } } } while (0)
#define WS_WRITE(AR, BR, buf) do { \
            _Pragma("unroll") for (int _i = 0; _i < 8; ++_i) *(LAS u32x4*)(lds + GEMM_LDS_A + (buf) * 32768 + _i * 4096 + awoff) = AR[_i]; \
            _Pragma("unroll") for (int _i = 0; _i < 8; ++_i) { u32x2 _w; _w.x = pk_bf16(BR[_i][0], BR[_i][1]); _w.y = pk_bf16(BR[_i][2], BR[_i][3]); \
                *(LAS u32x2*)(lds + GEMM_LDS_B + (buf) * 16384 + bwoff[_i & 1] + 4096 * (_i >> 1)) = _w; } } while (0)
#define WS_PSTEP(NXT, A_LD, B_LD, A_WR, B_WR) do { WS_LOAD(A_LD, B_LD); WS_WRITE(A_WR, B_WR, NXT); WS_BAR(); ++s; } while (0)
        WS_SETA(); bp = bcol(0, n4);
        WS_LOAD(aX, bX); WS_WRITE(aX, bX, 0);
        WS_LOAD(aY, bY);
        WS_BAR();
        int s = 0;
        while (s < S) { WS_PSTEP(1, aX, bX, aY, bY); if (s >= S) break; WS_PSTEP(0, aY, bY, aX, bX); }
#undef WS_SETA
#undef WS_LOAD
#undef WS_WRITE
#undef WS_PSTEP
    }
#undef WS_BAR
}

struct XcdDeal { int lo, step, n; };
#define TOPO_OFF (LDS_MISC + 16)
__device__ __forceinline__ XcdDeal xcd_deal(int U, const LAS unsigned char* lds, int nb) {
    const LAS int* tp_ = (const LAS int*)(lds + TOPO_OFF);
    const int px = tp_[0], cx = tp_[1], rank = tp_[2];
    XcdDeal d;
    const int xlo = (int)((long)px * U / nb), xhi = (int)((long)(px + cx) * U / nb);
    d.lo = xlo + rank; d.step = cx; d.n = (xhi - xlo - rank + cx - 1) / cx; if (d.n < 0) d.n = 0;
    return d;
}

__device__ __forceinline__ void phase0(const Params& p, int bid, int nb, float* smem, LAS unsigned char* smem_las) {
    const float* c = p.in[1]; const float* w_ada = p.in[2]; const float* b_ada = p.in[3];
    float* mod = (float*)(p.ws + WS_MOD);
    const int tid = threadIdx.x;
    float* sc = smem;
    float* red = smem + 2048;
    for (int i = tid; i < 2048; i += NT) { const float cv = c[i]; sc[i] = cv / (1.f + expf(-cv)); }
    __syncthreads();
    {
        const int cq = tid & 7, kg = tid >> 3;
        for (int u = bid; u < 192; u += nb) {
            const float* wp = w_ada + (size_t)(kg * 16) * 6144 + u * 32 + cq * 4;
            f32x4 wv[16];
#pragma unroll
            for (int i = 0; i < 16; ++i) wv[i] = *(const f32x4*)(wp + (size_t)i * 6144);
            f32x4 a0 = (f32x4){0.f, 0.f, 0.f, 0.f}, a1 = (f32x4){0.f, 0.f, 0.f, 0.f};
#pragma unroll
            for (int i = 0; i < 16; ++i) { a0 += sc[kg * 16 + i] * wv[i]; a1 += sc[1024 + kg * 16 + i] * wv[i]; }
            *(f32x4*)(red + (kg * 2 + 0) * 32 + cq * 4) = a0; *(f32x4*)(red + (kg * 2 + 1) * 32 + cq * 4) = a1;
            __syncthreads();
            if (tid < 64) {
                const int bb = tid >> 5, col = tid & 31; float sacc = 0.f;
#pragma unroll 16
                for (int g2 = 0; g2 < 64; ++g2) sacc += red[(g2 * 2 + bb) * 32 + col];
                mod[bb * 6144 + u * 32 + col] = sacc + b_ada[u * 32 + col];
            }
            __syncthreads();
        }
    }
    {
        const float* conv_w = p.in[12]; const float* conv_b = p.in[13]; const float* wa = p.in[14]; const float* ba = p.in[15]; const float* wx = p.in[16]; const float* bx = p.in[17];
        float* BG = (float*)(p.ws + WS_BG); float* GB = (float*)(p.ws + WS_GBIAS);
        for (int idx = bid * NT + tid; idx < 8 * 256 * 128; idx += nb * NT) {
            const int n = idx & 127, k = (idx >> 7) & 255, hb = idx >> 15;
            const int w = k >> 6, i = k & 63, j = (n >> 6) * 32 + ((n >> 4) & 1) * 16 + (n & 15);
            const float* W = ((n >> 5) & 1) ? wx : wa;
            BG[idx] = conv_w[w * 512 + hb * 64 + i] * W[(hb * 64 + i) * 64 + j];
        }
        for (int idx = bid * NT + tid; idx < 8 * 128; idx += nb * NT) {
            const int n = idx & 127, hb = idx >> 7, j = (n >> 6) * 32 + ((n >> 4) & 1) * 16 + (n & 15);
            const bool isx = (n >> 5) & 1; const float* W = isx ? wx : wa;
            float acc = isx ? bx[hb * 64 + j] : ba[hb * 64 + j];
            for (int i = 0; i < 64; ++i) acc += conv_b[hb * 64 + i] * W[(hb * 64 + i) * 64 + j];
            GB[idx] = acc;
        }
        float* CB = (float*)(p.ws + WS_CBIAS); const float* pos = p.in[6];
        for (int idx = bid * NW + (tid >> 6); idx < 128; idx += nb * NW) {
            const int kv = idx >> 6, j = idx & 63; const float* w1 = kv ? p.in[9] : p.in[7];
            float acc = 0.f;
#pragma unroll 8
            for (int k = (tid & 63); k < 2048; k += 64) acc += pos[k] * w1[(size_t)k * 64 + j];
            acc = wave_sum(acc);
            if ((tid & 63) == 0) CB[idx] = acc;
        }
        bf16_t* XRB = (bf16_t*)(p.ws + WS_XRB);
        for (int idx = bid * NT + tid; idx < 16 * 3 * 64; idx += nb * NT) { const int sq = idx / 192, rem = idx % 192; XRB[(size_t)sq * SEQP * 64 + rem] = 0; }
    }
    {
        const f32x4* sp = (const f32x4*)p.in[23]; u32x2* dp = (u32x2*)(p.ws + WS_WRB);
        for (int i = bid * NT + tid; i < 1024 * 256 / 4; i += nb * NT) { const f32x4 v = sp[i]; u32x2 w; w.x = pk_bf16(v[0], v[1]); w.y = pk_bf16(v[2], v[3]); dp[i] = w; }
    }
    {
        LAS float* scr = (LAS float*)((LAS unsigned char*)smem_las + 16384 + (tid >> 6) * 8704);
        const int gw = bid * NW + (tid >> 6), ngw = nb * NW, lane_ = tid & 63;
        const int I1 = 16 * 80, I2 = 16 * 32;
        for (int it = gw; it < I1 + I2; it += ngw) {
            if (it < I1) transpose_item(p.in[5], 1024, NCOLS, 2560, (bf16_t*)(p.ws + WS_WINT), scr, it, lane_);
            else transpose_item(p.in[21], 1024, 1024, 1024, (bf16_t*)(p.ws + WS_WOUTT), scr, it - I1, lane_);
        }
    }
    float* lut = (float*)(p.ws + WS_LUT); const float* rel = p.in[11];
    for (int idx = bid * NT + tid; idx < 8 * 1024; idx += nb * NT) {
        const int h = idx >> 10, d = idx & 1023;
        int bucket;
        if (d < 16) bucket = d;
        else { const int l = 16 + (int)(logf((float)d / 16.0f) / 4.1588830833596715f * 16.0f); bucket = l < 31 ? l : 31; }
        lut[idx] = rel[bucket * 8 + h];
    }
}

template <bool SRC_BF16>
__device__ __forceinline__ void phase_modnorm(const Params& p, int bid, int nb, const void* src_, const float* nw, int sh_off, int sc_off, bf16_t* dstb) {
    const float* mod = (const float*)(p.ws + WS_MOD);
    int tid_ = threadIdx.x; asm volatile("" : "+v"(tid_));
    const int wave = tid_ >> 6, lane = tid_ & 63;
    const int RS = nb * NW;
    f32x4 w4[4];
#pragma unroll
    for (int i = 0; i < 4; ++i) w4[i] = *(const f32x4*)(nw + lane * 16 + 4 * i);
    for (int row0 = bid * NW + wave; row0 < MTOK; row0 += 4 * RS) {
        f32x4 v[4][4];
#pragma unroll
        for (int k = 0; k < 4; ++k) {
            const int row = row0 + k * RS; const int rc = row < MTOK ? row : row0;
            if constexpr (SRC_BF16) {
                const u32x4* xr = (const u32x4*)((const bf16_t*)src_ + (size_t)rc * 1024 + lane * 16);
                const u32x4 r0 = xr[0], r1 = xr[1];
#pragma unroll
                for (int j = 0; j < 4; ++j) { v[k][j >> 1][(j & 1) * 2] = __uint_as_float(r0[j] << 16); v[k][j >> 1][(j & 1) * 2 + 1] = __uint_as_float(r0[j] & 0xffff0000u);
                                              v[k][2 + (j >> 1)][(j & 1) * 2] = __uint_as_float(r1[j] << 16); v[k][2 + (j >> 1)][(j & 1) * 2 + 1] = __uint_as_float(r1[j] & 0xffff0000u); }
            } else {
                const float* xr = (const float*)src_ + (size_t)rc * 1024 + lane * 16;
#pragma unroll
                for (int i = 0; i < 4; ++i) v[k][i] = *(const f32x4*)(xr + 4 * i);
            }
        }
#pragma unroll
        for (int k = 0; k < 4; ++k) {
            const int row = row0 + k * RS;
            if (row < MTOK) {
                const int b = row >> 13;
                float ss = 0.f;
#pragma unroll
                for (int i = 0; i < 4; ++i) ss += (v[k][i][0] * v[k][i][0] + v[k][i][1] * v[k][i][1]) + (v[k][i][2] * v[k][i][2] + v[k][i][3] * v[k][i][3]);
                ss = wave_sum(ss);
                const float rstd = __builtin_amdgcn_rsqf(ss * (1.f / 1024.f) + 1e-6f);
                u32x4 o[2];
#pragma unroll
                for (int i = 0; i < 4; ++i) {
                    const int ci = lane * 16 + 4 * i;
                    const f32x4 sh = *(const f32x4*)(mod + b * 6144 + sh_off + ci), sc = *(const f32x4*)(mod + b * 6144 + sc_off + ci);
                    f32x4 h;
#pragma unroll
                    for (int j = 0; j < 4; ++j) h[j] = v[k][i][j] * rstd * w4[i][j] * (1.f + sc[j]) + sh[j];
                    o[i >> 1][(i & 1) * 2 + 0] = pk_bf16(h[0], h[1]); o[i >> 1][(i & 1) * 2 + 1] = pk_bf16(h[2], h[3]);
                }
                *(u32x4*)(dstb + (size_t)row * 1024 + lane * 16) = o[0];
                *(u32x4*)(dstb + (size_t)row * 1024 + lane * 16 + 8) = o[1];
            }
        }
    }
}

__device__ __forceinline__ void phase2_e(const Params& p, int bid, int nb, LAS unsigned char* lds) {
    bf16_t* QB = (bf16_t*)(p.ws + WS_QB); bf16_t* KV6 = (bf16_t*)(p.ws + WS_KV6); float* GATE = (float*)(p.ws + WS_GATE);
    bf16_t* XRB = (bf16_t*)(p.ws + WS_XRB); bf16_t* GRG = (bf16_t*)(p.ws + WS_GRG);
    pg8::Gemm g{(const pg8::bf16_t*)(p.ws + WS_H1B), (const pg8::bf16_t*)(p.ws + WS_WINT), MTOK, 2560, 1024};
    pg8::StaticOrder S; S.init(MTOK, 2560, nb, bid);
    auto E = make_epi_p([=](const f32x4 (&acc)[2][2][4][2], const pg8::Unit& u, int wr, int wc, int fr, int fq) {
#pragma unroll
        for (int ai = 0; ai < 2; ++ai)
#pragma unroll
            for (int mm = 0; mm < 4; ++mm) {
                const int m = u.pm * 256 + ai * 128 + wr * 64 + mm * 16 + fr;
#pragma unroll
                for (int bj = 0; bj < 2; ++bj) {
                    const int col = u.pn * 256 + bj * 128 + wc * 32 + fq * 8;
                    const f32x4 v0 = acc[ai][bj][mm][0], v1 = acc[ai][bj][mm][1];
                    if (col >= NCOLS) continue;
                    if (col < 512) {
                        const float sc = 0.125f * LOG2E; u32x4 w; w[0] = pk_bf16(v0[0] * sc, v0[1] * sc); w[1] = pk_bf16(v0[2] * sc, v0[3] * sc); w[2] = pk_bf16(v1[0] * sc, v1[1] * sc); w[3] = pk_bf16(v1[2] * sc, v1[3] * sc);
                        *(u32x4*)(QB + (size_t)m * 512 + col) = w;
                    } else if (col >= 1280 && col < 1304) {
                        f32x4 g0, g1;
#pragma unroll
                        for (int j = 0; j < 4; ++j) { g0[j] = sigm(v0[j]); g1[j] = sigm(v1[j]); }
                        *(f32x4*)(GATE + (size_t)m * 24 + (col - 1280)) = g0; *(f32x4*)(GATE + (size_t)m * 24 + (col - 1280) + 4) = g1;
                    } else if (col < 1280) {
                        const int c2 = col - 512, j6 = c2 >> 7, gg = (c2 >> 6) & 1, d = c2 & 63, bb = m >> 13, t = m & 8191;
                        u32x4 w; w[0] = pk_bf16(v0[0], v0[1]); w[1] = pk_bf16(v0[2], v0[3]); w[2] = pk_bf16(v1[0], v1[1]); w[3] = pk_bf16(v1[2], v1[3]);
                        *(u32x4*)(KV6 + (size_t)j6 * 2097152 + ((size_t)((bb * 2 + gg) * SEQ + t)) * 64 + d) = w;
                    } else if (col < 1816) {
                        const int c = col - 1304, hb = c >> 6, bb = m >> 13, t = m & 8191;
                        u32x4 w; w[0] = pk_bf16(v0[0], v0[1]); w[1] = pk_bf16(v0[2], v0[3]); w[2] = pk_bf16(v1[0], v1[1]); w[3] = pk_bf16(v1[2], v1[3]);
                        *(u32x4*)(XRB + ((size_t)(bb * 8 + hb) * SEQP + 3 + t) * 64 + (c & 63)) = w;
                    } else {
                        u32x4 w; w[0] = pk_bf16(gelu_t(v0[0]), gelu_t(v0[1])); w[1] = pk_bf16(gelu_t(v0[2]), gelu_t(v0[3])); w[2] = pk_bf16(gelu_t(v1[0]), gelu_t(v1[1])); w[3] = pk_bf16(gelu_t(v1[2]), gelu_t(v1[3]));
                        *(u32x4*)(GRG + (size_t)m * 512 + (col - 1816)) = w;
                    }
                }
            }
    });
    pg8::gemm_phase(lds, g, S, E);
}

__device__ __forceinline__ void phase5_e(const Params& p, int bid, int nb, LAS unsigned char* lds) {
    const float* x = p.in[0]; const float* mod = (const float*)(p.ws + WS_MOD); bf16_t* X1 = (bf16_t*)(p.ws + WS_X1);
    pg8::Gemm g{(const pg8::bf16_t*)(p.ws + WS_YB), (const pg8::bf16_t*)(p.ws + WS_WOUTT), MTOK, 1024, 1024};
    pg8::StaticOrder S; S.init(MTOK, 1024, nb, bid);
    auto E = make_epi_p([=](const f32x4 (&acc)[2][2][4][2], const pg8::Unit& u, int wr, int wc, int fr, int fq) {
        const int c0 = u.pn * 256 + wc * 32 + fq * 8;
        const int bb = (u.pm * 256) >> 13;
        f32x4 gv[2][2];
#pragma unroll
        for (int bj = 0; bj < 2; ++bj)
#pragma unroll
            for (int nn = 0; nn < 2; ++nn) gv[bj][nn] = *(const f32x4*)(mod + bb * 6144 + 2048 + c0 + bj * 128 + nn * 4);
#pragma unroll
        for (int ai = 0; ai < 2; ++ai)
#pragma unroll
            for (int mm = 0; mm < 4; ++mm) {
                const size_t o = (size_t)(u.pm * 256 + ai * 128 + wr * 64 + mm * 16 + fr) * 1024 + c0;
                f32x4 xv[2][2];
#pragma unroll
                for (int bj = 0; bj < 2; ++bj)
#pragma unroll
                    for (int nn = 0; nn < 2; ++nn) xv[bj][nn] = *(const f32x4*)(x + o + bj * 128 + nn * 4);
#pragma unroll
                for (int bj = 0; bj < 2; ++bj) {
                    const f32x4 r0 = xv[bj][0] + gv[bj][0] * acc[ai][bj][mm][0], r1 = xv[bj][1] + gv[bj][1] * acc[ai][bj][mm][1];
                    u32x4 w; w[0] = pk_bf16(r0[0], r0[1]); w[1] = pk_bf16(r0[2], r0[3]); w[2] = pk_bf16(r1[0], r1[1]); w[3] = pk_bf16(r1[2], r1[3]);
                    *(u32x4*)(X1 + o + bj * 128) = w;
                }
            }
    });
    pg8::gemm_phase(lds, g, S, E);
}

#ifndef A4_PROBE_MASK
#define A4_PROBE_MASK 7
#endif
#define A4_KV 0
#define A4_SCORE 65536
#define A4_LUT 131200
#define LUTP 1156
#define A4_SELM 149760
__device__ __forceinline__ float ex2(float x) { return __builtin_amdgcn_exp2f(x); }

__device__ __forceinline__ float xmax_16_32(float v) {
    { auto r = __builtin_amdgcn_permlane16_swap(__float_as_uint(v), __float_as_uint(v), false, false); v = fmaxf(__uint_as_float(r[0]), __uint_as_float(r[1])); }
    { auto r = __builtin_amdgcn_permlane32_swap(__float_as_uint(v), __float_as_uint(v), false, false); v = fmaxf(__uint_as_float(r[0]), __uint_as_float(r[1])); }
    return v;
}
__device__ __forceinline__ float xsum_16_32(float v) {
    { auto r = __builtin_amdgcn_permlane16_swap(__float_as_uint(v), __float_as_uint(v), false, false); v = __uint_as_float(r[0]) + __uint_as_float(r[1]); }
    { auto r = __builtin_amdgcn_permlane32_swap(__float_as_uint(v), __float_as_uint(v), false, false); v = __uint_as_float(r[0]) + __uint_as_float(r[1]); }
    return v;
}


__device__ __forceinline__ void phase4_mfma(unsigned char* ws, int bid, int nb, LAS unsigned char* lds) {
    int tid_ = threadIdx.x; asm volatile("" : "+v"(tid_));
    const int tid = tid_, wid = __builtin_amdgcn_readfirstlane(tid >> 6), lane = tid & 63;
    const int col = lane & 15, tl = col >> 2, hd = col & 3, g4 = lane >> 4, fr = col;
    const bf16_t* QB = (const bf16_t*)(ws + WS_QB);
    const unsigned char* KV6 = ws + WS_KV6;
    const unsigned char* KCB = ws + WS_KCB; const unsigned char* VCB = ws + WS_VCB;
    const float* lutg = (const float*)(ws + WS_LUT);
    const float* GATE = (const float*)(ws + WS_GATE);
    float* OATT = (float*)(ws + WS_OATT);
    LAS float* lutl = (LAS float*)(lds + A4_LUT);
    LAS float* score = (LAS float*)(lds + A4_SCORE);
    LAS unsigned* selm = (LAS unsigned*)(lds + A4_SELM);
    const int koff0 = fr * 128 + 16 * ((g4) ^ (fr & 7)), koff1 = fr * 128 + 16 * ((4 + g4) ^ (fr & 7));
    const int q4 = (lane >> 2) & 3, pp = lane & 3, xk = (g4 & 1) * 4 + q4;
    int voff[4];
#pragma unroll
    for (int db = 0; db < 4; ++db) voff[db] = (g4 * 4 + q4) * 128 + 16 * ((db * 2 + (pp >> 1)) ^ xk) + 8 * (pp & 1);
    const int dr = tid >> 3, dsrc = dr * 128 + (((tid & 7) ^ (dr & 7)) * 16);

#define A4_ISSUE(kbase, vbase, stage) do { \
        __builtin_amdgcn_global_load_lds((const unsigned*)((kbase) + dsrc), (LAS unsigned*)(lds + A4_KV + (stage) * 16384 + wid * 1024), 16, 0, 0); \
        if (vbase) __builtin_amdgcn_global_load_lds((const unsigned*)((vbase) + dsrc), (LAS unsigned*)(lds + A4_KV + (stage) * 16384 + 8192 + wid * 1024), 16, 0, 0); } while (0)
#define A4_SYNC() do { asm volatile("s_waitcnt vmcnt(0)" ::: "memory"); __syncthreads(); } while (0)
#define A4_SYNC_RING(issued) do { asm volatile("s_waitcnt lgkmcnt(0)" ::: "memory"); if (issued) asm volatile("s_waitcnt vmcnt(2)" ::: "memory"); else asm volatile("s_waitcnt vmcnt(0)" ::: "memory"); \
        asm volatile("" ::: "memory"); __builtin_amdgcn_s_barrier(); asm volatile("" ::: "memory"); } while (0)

    for (int u2 = bid; u2 < 256; u2 += nb)
    for (int hf = 0; hf < 2; ++hf)
    for (int rep4 = 0; rep4 < ((REP & 64) ? 2 : 1); ++rep4) {
        const bool probe = rep4 > 0; const int amask = probe ? A4_PROBE_MASK : 7;
        const int bg = u2 >> 6, b = bg >> 1, g = bg & 1;
        const int T = hf ? 127 - (u2 & 63) : (u2 & 63);
        const int t0 = T * 64;
        const size_t seqbase = (size_t)(b * 2 + g) * SEQ;
        __syncthreads();
        for (int i = tid; i < 4 * 1152; i += NT) { const int hh = i / 1152, dd = i - hh * 1152; lutl[hh * LUTP + dd] = lutg[(g * 4 + hh) * 1024 + (dd < 1023 ? dd : 1023)] * LOG2E; }
        if (!probe) for (int i = tid; i < 8192; i += NT) score[i] = 0.f;
        int tq[2]; tq[0] = t0 + 8 * wid + tl; tq[1] = tq[0] + 4;
        bf16x8 qf[2][2];
#pragma unroll
        for (int ct = 0; ct < 2; ++ct) {
            const size_t m = (size_t)b * SEQ + tq[ct];
#pragma unroll
            for (int h2 = 0; h2 < 2; ++h2) qf[ct][h2] = *(const bf16x8*)(QB + m * 512 + (g * 4 + hd) * 64 + h2 * 32 + g4 * 8);
        }
#define A4_GATEV(ct, br) (GATE[((size_t)b * SEQ + tq[ct]) * 24 + (g * 4 + hd) * 3 + (br)])
        __syncthreads();

        float mrun[2], lrun[2];
        f32x4 O[2][4];
        bf16x8 kf[4][2];
        f32x4 sv[4];
#define A4_LOADK(stage) do { _Pragma("unroll") for (int kt = 0; kt < 4; ++kt) { \
            kf[kt][0] = *(const LAS bf16x8*)(lds + A4_KV + (stage) * 16384 + kt * 2048 + koff0); \
            kf[kt][1] = *(const LAS bf16x8*)(lds + A4_KV + (stage) * 16384 + kt * 2048 + koff1); } } while (0)
#define A4_SCORES(ct) do { _Pragma("unroll") for (int kt = 0; kt < 4; ++kt) { \
            sv[kt] = __builtin_amdgcn_mfma_f32_16x16x32_bf16(kf[kt][0], qf[ct][0], (f32x4){0.f, 0.f, 0.f, 0.f}, 0, 0, 0); \
            sv[kt] = __builtin_amdgcn_mfma_f32_16x16x32_bf16(kf[kt][1], qf[ct][1], sv[kt], 0, 0, 0); } } while (0)
#define A4_VREADS(stage, a, l0, h0, l1, h1, l2, h2, l3, h3) do { \
            LAS unsigned char* vb_ = lds + A4_KV + (stage) * 16384 + 8192 + (a) * 4096; \
            l0 = tr_read(vb_ + voff[0]); h0 = tr_read(vb_ + 2048 + voff[0]); l1 = tr_read(vb_ + voff[1]); h1 = tr_read(vb_ + 2048 + voff[1]); \
            l2 = tr_read(vb_ + voff[2]); h2 = tr_read(vb_ + 2048 + voff[2]); l3 = tr_read(vb_ + voff[3]); h3 = tr_read(vb_ + 2048 + voff[3]); } while (0)
#define A4_PVMMA(ct, a, l0, h0, l1, h1, l2, h2, l3, h3) do { \
            u32x4 pw; pw[0] = pk_bf16(sv[2 * (a)][0], sv[2 * (a)][1]); pw[1] = pk_bf16(sv[2 * (a)][2], sv[2 * (a)][3]); \
            pw[2] = pk_bf16(sv[2 * (a) + 1][0], sv[2 * (a) + 1][1]); pw[3] = pk_bf16(sv[2 * (a) + 1][2], sv[2 * (a) + 1][3]); \
            const bf16x8 pf = __builtin_bit_cast(bf16x8, pw); \
            O[ct][0] = __builtin_amdgcn_mfma_f32_16x16x32_bf16((bf16x8){l0[0], l0[1], l0[2], l0[3], h0[0], h0[1], h0[2], h0[3]}, pf, O[ct][0], 0, 0, 0); \
            O[ct][1] = __builtin_amdgcn_mfma_f32_16x16x32_bf16((bf16x8){l1[0], l1[1], l1[2], l1[3], h1[0], h1[1], h1[2], h1[3]}, pf, O[ct][1], 0, 0, 0); \
            O[ct][2] = __builtin_amdgcn_mfma_f32_16x16x32_bf16((bf16x8){l2[0], l2[1], l2[2], l2[3], h2[0], h2[1], h2[2], h2[3]}, pf, O[ct][2], 0, 0, 0); \
            O[ct][3] = __builtin_amdgcn_mfma_f32_16x16x32_bf16((bf16x8){l3[0], l3[1], l3[2], l3[3], h3[0], h3[1], h3[2], h3[3]}, pf, O[ct][3], 0, 0, 0); } while (0)
#define A4_ONLINE_PV(ct, stage) do { \
            s16x4 va0, va1, va2, va3, va4, va5, va6, va7; \
            A4_VREADS(stage, 0, va0, va1, va2, va3, va4, va5, va6, va7); \
            float mx = fmaxf(fmaxf(sv[0][0], sv[0][1]), fmaxf(sv[0][2], sv[0][3])); \
            _Pragma("unroll") for (int kt = 1; kt < 4; ++kt) _Pragma("unroll") for (int j = 0; j < 4; ++j) mx = fmaxf(mx, sv[kt][j]); \
            mx = xmax_16_32(mx); \
            const float mnew = fmaxf(mrun[ct], mx); const float muse = (mnew == -INF) ? 0.f : mnew; \
            const float scl = ex2(mrun[ct] - muse); mrun[ct] = mnew; \
            const float nmu = -muse; \
            _Pragma("unroll") for (int kt = 0; kt < 4; ++kt) { sv[kt] += nmu; _Pragma("unroll") for (int j = 0; j < 4; ++j) sv[kt][j] = ex2(sv[kt][j]); } \
            const f32x4 ls4 = (sv[0] + sv[1]) + (sv[2] + sv[3]); const float ls = (ls4[0] + ls4[1]) + (ls4[2] + ls4[3]); \
            lrun[ct] = lrun[ct] * scl + ls; \
            if (__builtin_amdgcn_ballot_w64(scl != 1.f) != 0ull) { _Pragma("unroll") for (int db = 0; db < 4; ++db) O[ct][db] *= scl; } \
            TR_WAIT8(va0, va1, va2, va3, va4, va5, va6, va7); \
            s16x4 vb0, vb1, vb2, vb3, vb4, vb5, vb6, vb7; \
            A4_VREADS(stage, 1, vb0, vb1, vb2, vb3, vb4, vb5, vb6, vb7); \
            A4_PVMMA(ct, 0, va0, va1, va2, va3, va4, va5, va6, va7); \
            TR_WAIT8(vb0, vb1, vb2, vb3, vb4, vb5, vb6, vb7); \
            A4_PVMMA(ct, 1, vb0, vb1, vb2, vb3, vb4, vb5, vb6, vb7); } while (0)
#define A4_PV(ct, stage) do { \
            s16x4 va0, va1, va2, va3, va4, va5, va6, va7; \
            A4_VREADS(stage, 0, va0, va1, va2, va3, va4, va5, va6, va7); \
            TR_WAIT8(va0, va1, va2, va3, va4, va5, va6, va7); \
            A4_PVMMA(ct, 0, va0, va1, va2, va3, va4, va5, va6, va7); \
            A4_VREADS(stage, 1, va0, va1, va2, va3, va4, va5, va6, va7); \
            TR_WAIT8(va0, va1, va2, va3, va4, va5, va6, va7); \
            A4_PVMMA(ct, 1, va0, va1, va2, va3, va4, va5, va6, va7); } while (0)
#define A4_RESET() do { _Pragma("unroll") for (int ct = 0; ct < 2; ++ct) { mrun[ct] = -INF; lrun[ct] = 0.f; \
            _Pragma("unroll") for (int db = 0; db < 4; ++db) O[ct][db] = (f32x4){0.f, 0.f, 0.f, 0.f}; } } while (0)
#define A4_FINISH(br, first) do { _Pragma("unroll") for (int ct = 0; ct < 2; ++ct) { \
            float lt = lrun[ct]; lt = xsum_16_32(lt); \
            const float wv = A4_GATEV(ct, br) / fmaxf(lt, 1e-30f); \
            float* op = OATT + ((size_t)b * SEQ + tq[ct]) * 512 + (g * 4 + hd) * 64 + g4 * 4; \
            _Pragma("unroll") for (int db = 0; db < 4; ++db) { f32x4 r = O[ct][db] * wv; if (!(first)) r += *(const f32x4*)(op + db * 16); *(f32x4*)(op + db * 16) = r; } } } while (0)

        if (amask & 1) {
            const unsigned char* KW = KV6 + (size_t)4 * 4194304 + seqbase * 128; const unsigned char* VW = KV6 + (size_t)5 * 4194304 + seqbase * 128;
            A4_RESET();
            const int s0 = T >= 8 ? 0 : 8 - T;
            { const int jb = T - 8 + s0; A4_ISSUE(KW + (size_t)jb * 8192, VW + (size_t)jb * 8192, 0);
              if (s0 < 8) { A4_ISSUE(KW + (size_t)(jb + 1) * 8192, VW + (size_t)(jb + 1) * 8192, 1); asm volatile("s_waitcnt vmcnt(2)" ::: "memory"); } else asm volatile("s_waitcnt vmcnt(0)" ::: "memory");
              __syncthreads(); }
            int stage = 0;
            for (int s = s0; s <= 8; ++s) {
                const int jb = T - 8 + s;
                const bool iss = (s + 2 <= 8);
                if (iss) { const int st2 = stage >= 1 ? stage - 1 : 2; const unsigned char* kn = KW + (size_t)(jb + 2) * 8192; const unsigned char* vn = VW + (size_t)(jb + 2) * 8192; A4_ISSUE(kn, vn, st2); }
#pragma unroll
                for (int ct = 0; ct < 2; ++ct) {
                    A4_LOADK(stage);
                    A4_SCORES(ct);
                    __builtin_amdgcn_sched_barrier(0);
                    const int t = tq[ct];
                    {
                        const int base = t - jb * 64 - g4 * 4;
                        const LAS float* lp = lutl + hd * LUTP + base - 51;
                        const bool edge = (s == 0) || (s == 8);
#pragma unroll
                        for (int kt = 0; kt < 4; ++kt) {
                            f32x4 bs;
#pragma unroll
                            for (int j = 0; j < 4; ++j) bs[j] = lp[51 - kt * 16 - j];
                            asm volatile("" : "+v"(bs));
                            sv[kt] += bs;
                        }
                        if (edge) {
#pragma unroll
                            for (int kt = 0; kt < 4; ++kt)
#pragma unroll
                                for (int j = 0; j < 4; ++j) { const int dist = base - kt * 16 - j; sv[kt][j] = ((dist >= 0) && (dist < 512)) ? sv[kt][j] : -INF; }
                        }
                    }
                    A4_ONLINE_PV(ct, stage);
                    __builtin_amdgcn_sched_barrier(0);
                }
                A4_SYNC_RING(iss);
                stage = stage == 2 ? 0 : stage + 1;
            }
            if (!probe) A4_FINISH(2, true);
        }
        if (amask & 2) {
            const unsigned char* KC = KCB + (size_t)(b * 2 + g) * 512 * 128; const unsigned char* VC = VCB + (size_t)(b * 2 + g) * 512 * 128;
            int ncmp = 4 * T + 3; if (ncmp > NCMP) ncmp = NCMP;
            const int nblk = (ncmp + 63) >> 6;
            A4_RESET();
            A4_ISSUE(KC, (const unsigned char*)nullptr, 0);
            A4_SYNC();
            for (int s = 0; s < nblk; ++s) {
                const int stage = s & 1;
                if (s + 1 < nblk) A4_ISSUE(KC + (size_t)(s + 1) * 8192, (const unsigned char*)nullptr, stage ^ 1);
#pragma unroll
                for (int ct = 0; ct < 2; ++ct) {
                    A4_LOADK(stage);
                    A4_SCORES(ct);
                    __builtin_amdgcn_sched_barrier(0);
                    const int t = tq[ct];
                    float mx = -INF;
#pragma unroll
                    for (int kt = 0; kt < 4; ++kt) {
                        f32x4 bs;
#pragma unroll
                        for (int j = 0; j < 4; ++j) { int dist = t - (16 * (s * 64 + kt * 16 + g4 * 4 + j) + 31); dist = dist < 1023 ? dist : 1023; bs[j] = lutl[hd * LUTP + (dist & 1023)]; }
                        asm volatile("" : "+v"(bs));
#pragma unroll
                        for (int j = 0; j < 4; ++j) {
                            const int n = s * 64 + kt * 16 + g4 * 4 + j; const int dist = t - (16 * n + 31);
                            const bool ok = (dist >= 0) && (n < NCMP);
                            sv[kt][j] = ok ? sv[kt][j] + bs[j] : -INF; mx = fmaxf(mx, sv[kt][j]);
                        }
                    }
                    mx = xmax_16_32(mx);
                    const float mnew = fmaxf(mrun[ct], mx); const float muse = (mnew == -INF) ? 0.f : mnew;
                    const float scl = ex2(mrun[ct] - muse); mrun[ct] = mnew;
                    float ls = 0.f;
#pragma unroll
                    for (int kt = 0; kt < 4; ++kt)
#pragma unroll
                        for (int j = 0; j < 4; ++j) ls += ex2(sv[kt][j] - muse);
                    lrun[ct] = lrun[ct] * scl + ls;
                    __builtin_amdgcn_sched_barrier(0);
                }
                A4_SYNC();
            }
            float mfin[2], linv[2];
#pragma unroll
            for (int ct = 0; ct < 2; ++ct) {
                float lt = lrun[ct]; lt = xsum_16_32(lt);
                linv[ct] = 1.f / fmaxf(lt, 1e-30f); mfin[ct] = (mrun[ct] == -INF) ? 0.f : mrun[ct];
            }
            A4_ISSUE(KC, VC, 0);
            A4_SYNC();
            for (int s = 0; s < nblk; ++s) {
                const int stage = s & 1;
                if (s + 1 < nblk) { const unsigned char* kn = KC + (size_t)(s + 1) * 8192; const unsigned char* vn = VC + (size_t)(s + 1) * 8192; A4_ISSUE(kn, vn, stage ^ 1); }
#pragma unroll
                for (int ct = 0; ct < 2; ++ct) {
                    A4_LOADK(stage);
                    A4_SCORES(ct);
                    __builtin_amdgcn_sched_barrier(0);
                    const int t = tq[ct];
#pragma unroll
                    for (int kt = 0; kt < 4; ++kt) {
                        f32x4 bs;
#pragma unroll
                        for (int j = 0; j < 4; ++j) { int dist = t - (16 * (s * 64 + kt * 16 + g4 * 4 + j) + 31); dist = dist < 1023 ? dist : 1023; bs[j] = lutl[hd * LUTP + (dist & 1023)]; }
                        asm volatile("" : "+v"(bs));
#pragma unroll
                        for (int j = 0; j < 4; ++j) {
                            const int n = s * 64 + kt * 16 + g4 * 4 + j; const int dist = t - (16 * n + 31);
                            const bool ok = (dist >= 0) && (n < NCMP);
                            sv[kt][j] = ok ? ex2(sv[kt][j] + bs[j] - mfin[ct]) * linv[ct] : 0.f;
                        }
                        float s4 = (sv[kt][0] + sv[kt][1]) + (sv[kt][2] + sv[kt][3]); float s3 = sv[kt][3];
                        s4 += __shfl_xor(s4, 1); s4 += __shfl_xor(s4, 2); s3 += __shfl_xor(s3, 1); s3 += __shfl_xor(s3, 2);
                        const int a = s * 16 + kt * 4 + g4;
                        if (hd == 0 && !probe) {
                            LAS float* sp = score + (8 * wid + 4 * ct + tl) * 128 + a;
                            atomicAdd((float*)sp, s4);
                            if (a + 1 < 128) atomicAdd((float*)(sp + 1), s3);
                        }
                    }
                    A4_PV(ct, stage);
                    __builtin_amdgcn_sched_barrier(0);
                }
                A4_SYNC();
            }
            if (!probe)
#pragma unroll
            for (int ct = 0; ct < 2; ++ct) {
                float* op = OATT + ((size_t)b * SEQ + tq[ct]) * 512 + (g * 4 + hd) * 64 + g4 * 4;
#pragma unroll
                for (int db = 0; db < 4; ++db) { const float gcv = A4_GATEV(ct, 0); f32x4 r = O[ct][db] * gcv; r += *(const f32x4*)(op + db * 16); *(f32x4*)(op + db * 16) = r; }
            }
        }
        __syncthreads();
        if (!probe)
        for (int tt = 0; tt < 8; ++tt) {
            const int ti = 8 * wid + tt;
            const int j0 = lane, j1 = lane + 64;
            bool sel0, sel1;
            if (T <= 15) { sel0 = j0 <= T; sel1 = false; }
            else {
                const bool c0 = (j0 >= 1) && (j0 <= T - 2), c1 = (j1 <= T - 2);
                const float s0 = c0 ? score[ti * 128 + j0] : -INF, s1 = c1 ? score[ti * 128 + j1] : -INF;
                int r0 = 0, r1 = 0;
                for (int j2 = 1; j2 <= T - 2; ++j2) { const float v = score[ti * 128 + j2]; r0 += (v > s0) || (v == s0 && j2 < j0); r1 += (v > s1) || (v == s1 && j2 < j1); }
                sel0 = (c0 && r0 < 13) || (j0 == 0) || (j0 == T) || (j0 == T - 1);
                sel1 = (c1 && r1 < 13) || (j1 == T) || (j1 == T - 1);
            }
            const unsigned long long b0 = __ballot(sel0), b1 = __ballot(sel1);
            if (lane == 0) { selm[ti * 4 + 0] = (unsigned)b0; selm[ti * 4 + 1] = (unsigned)(b0 >> 32); selm[ti * 4 + 2] = (unsigned)b1; selm[ti * 4 + 3] = (unsigned)(b1 >> 32); }
        }
        __builtin_amdgcn_wave_barrier();
        asm volatile("s_waitcnt lgkmcnt(0)" ::: "memory");
        if (amask & 4) {
            const unsigned char* KS = KV6 + (size_t)2 * 4194304 + seqbase * 128; const unsigned char* VS = KV6 + (size_t)3 * 4194304 + seqbase * 128;
            unsigned un[2][4];
#pragma unroll
            for (int ct = 0; ct < 2; ++ct)
#pragma unroll
                for (int w = 0; w < 4; ++w) {
                    unsigned uu = selm[(8 * wid + 4 * ct + 0) * 4 + w] | selm[(8 * wid + 4 * ct + 1) * 4 + w] | selm[(8 * wid + 4 * ct + 2) * 4 + w] | selm[(8 * wid + 4 * ct + 3) * 4 + w];
                    un[ct][w] = __builtin_amdgcn_readfirstlane(uu);
                }
            A4_RESET();
            const float cbfar = lutl[hd * LUTP + 1023];
            __syncthreads();
#pragma unroll
            for (int bq = 0; bq < 4; ++bq) if (bq <= T) { const unsigned char* kn = KS + (size_t)bq * 8192; const unsigned char* vn = VS + (size_t)bq * 8192; A4_ISSUE(kn, vn, bq); }
            A4_SYNC();
#pragma unroll
            for (int w = 0; w < 4; ++w) {
                const unsigned selw0 = selm[(8 * wid + tl) * 4 + w], selw1 = selm[(8 * wid + 4 + tl) * 4 + w];
                for (int gg = 0; gg < 8; ++gg) {
                    const int j0 = w * 32 + gg * 4;
                    if (j0 > T) break;
#pragma unroll
                    for (int bq = 0; bq < 4; ++bq) { const int jn = j0 + 4 + bq; if (jn <= T) { const unsigned char* kn = KS + (size_t)jn * 8192; const unsigned char* vn = VS + (size_t)jn * 8192; A4_ISSUE(kn, vn, (jn & 7)); } }
                    for (int bq = 0; bq < 4; ++bq) {
                        const int j = j0 + bq;
                        if (j > T) break;
                        const int jb = gg * 4 + bq, stage = j & 7;
                        const bool need0 = (un[0][w] >> jb) & 1u, need1 = (un[1][w] >> jb) & 1u;
                        if (need0 || need1) {
#pragma unroll
                            for (int ct = 0; ct < 2; ++ct) {
                                if (ct == 0 ? need0 : need1) {
                                    A4_LOADK(stage);
                                    A4_SCORES(ct);
                                    __builtin_amdgcn_sched_barrier(0);
                                    const int t = tq[ct];
                                    const bool csel = ((ct == 0 ? selw0 : selw1) >> jb) & 1u;
                                    if (j * 64 + 63 + 1023 <= t0) {
                                        const float cb = csel ? cbfar : -INF;
#pragma unroll
                                        for (int kt = 0; kt < 4; ++kt)
#pragma unroll
                                            for (int jj = 0; jj < 4; ++jj) sv[kt][jj] += cb;
                                    } else {
                                        const int base = t - j * 64 - g4 * 4;
                                        const LAS float* lp = lutl + hd * LUTP + base - 51;
                                        const float msk = csel ? 0.f : -INF;
#pragma unroll
                                        for (int kt = 0; kt < 4; ++kt) {
                                            f32x4 bs;
#pragma unroll
                                            for (int jj = 0; jj < 4; ++jj) bs[jj] = lp[51 - kt * 16 - jj];
                                            asm volatile("" : "+v"(bs));
                                            sv[kt] += bs + msk;
                                        }
                                        if (j == T) {
#pragma unroll
                                            for (int kt = 0; kt < 4; ++kt)
#pragma unroll
                                                for (int jj = 0; jj < 4; ++jj) { const int dist = base - kt * 16 - jj; sv[kt][jj] = (dist >= 0) ? sv[kt][jj] : -INF; }
                                        }
                                    }
                                    A4_ONLINE_PV(ct, stage);
                                    __builtin_amdgcn_sched_barrier(0);
                                }
                            }
                        }
                    }
                    A4_SYNC();
                }
            }
            if (!probe) A4_FINISH(1, false);
        }
    }
#undef A4_ISSUE
#undef A4_SYNC
#undef A4_SYNC_RING
#undef A4_LOADK
#undef A4_SCORES
#undef A4_ONLINE_PV
#undef A4_PV
#undef A4_VREADS
#undef A4_PVMMA
#undef A4_RESET
#undef A4_FINISH
#undef A4_GATEV
}

__device__ __forceinline__ void phase3_mfma(const Params& p, int bid, int nb, LAS unsigned char* lds) {
    {
        const unsigned char* XRBb = p.ws + WS_XRB; const bf16_t* XRB = (const bf16_t*)(p.ws + WS_XRB);
        const float* BG = (const float*)(p.ws + WS_BG); const float* GB = (const float*)(p.ws + WS_GBIAS);
        const float* conv_w = p.in[12]; const float* conv_b = p.in[13]; const float* lam = p.in[18];
        float* AL = (float*)(p.ws + WS_ALRU); float* UL = (float*)(p.ws + WS_ULRU);
        const XcdDeal dl = xcd_deal(512, lds, nb);
        gemm_stream<true, 1, 0, true>(lds, XRBb, dl.n, 4, 128,
            [&](int ps, int r) { const int u = dl.lo + ps * dl.step; return ((size_t)(u >> 5) * SEQP + (u & 31) * 256 + r) * 128; },
            [&](int ps, int n4) -> const float* { const int u = dl.lo + ps * dl.step; return BG + ((u >> 5) & 7) * 32768 + n4 * 4; },
            [&](int) { return 256; },
            [&](int ps, int rbase, int nbase, int, f32x4 (&acc)[4][4]) {
                const int u = dl.lo + ps * dl.step, sq = u >> 5, hb = sq & 7, bb = sq >> 3, t0 = (u & 31) * 256 + rbase;
#pragma unroll
                for (int ni = 0; ni < 2; ++ni) {
                    const int n = nbase + ni * 16;
                    const int j = (n >> 6) * 32 + ((n >> 4) & 1) * 16 + (n & 15), c = hb * 64 + j;
                    f32x4 cw[4];
#pragma unroll
                    for (int w = 0; w < 4; ++w) cw[w] = *(const f32x4*)(conv_w + w * 512 + c);
                    const f32x4 cbv = *(const f32x4*)(conv_b + c), ga = *(const f32x4*)(GB + hb * 128 + n), gx = *(const f32x4*)(GB + hb * 128 + n + 32), lm = *(const f32x4*)(lam + c);
                    f32x4 spl;
#pragma unroll
                    for (int jj = 0; jj < 4; ++jj) spl[jj] = -8.0f * softplus_(-lm[jj]);
#pragma unroll
                    for (int mi = 0; mi < 4; ++mi) {
                        u32x2 xw[4];
#pragma unroll
                        for (int w = 0; w < 4; ++w) xw[w] = *(const u32x2*)(XRB + ((size_t)sq * SEQP + t0 + mi * 16 + w) * 64 + j);
                        f32x4 xc = cbv;
#pragma unroll
                        for (int w = 0; w < 4; ++w) {
                            xc[0] += cw[w][0] * __uint_as_float(xw[w].x << 16); xc[1] += cw[w][1] * __uint_as_float(xw[w].x & 0xffff0000u);
                            xc[2] += cw[w][2] * __uint_as_float(xw[w].y << 16); xc[3] += cw[w][3] * __uint_as_float(xw[w].y & 0xffff0000u);
                        }
                        f32x4 av, uv;
#pragma unroll
                        for (int jj = 0; jj < 4; ++jj) {
                            const float r_ = sigm(acc[mi][ni][jj] + ga[jj]), ig = sigm(acc[mi][ni + 2][jj] + gx[jj]);
                            const float la = r_ * spl[jj];
                            const float a1 = __builtin_amdgcn_exp2f(la * 1.4426950408889634f);
                            av[jj] = a1; uv[jj] = __builtin_amdgcn_sqrtf(fmaxf(1.f - a1 * a1, 0.f)) * (ig * xc[jj]);
                        }
                        const size_t o = ((size_t)bb * SEQ + t0 + mi * 16) * 512 + c;
                        *(f32x4*)(AL + o) = av; *(f32x4*)(UL + o) = uv;
                        __builtin_amdgcn_sched_barrier(0);
                    }
                } });
    }
    {
        const unsigned char* KV6 = p.ws + WS_KV6; float* CP = (float*)(p.ws + WS_CPART);
        const float* W1k = p.in[7]; const float* W1v = p.in[9];
        const XcdDeal dl = xcd_deal(64, lds, nb);
        gemm_stream<false, 1>(lds, KV6, dl.n, 8, 64,
            [&](int ps, int r) { const int u = dl.lo + ps * dl.step, ks = u >> 4, kv = (u >> 3) & 1, R = (u & 7) * 256 + r;
                                 return (size_t)kv * 4194304 + ((size_t)(R >> 9) * SEQ + 16 * (R & 511)) * 128 + (size_t)ks * 1024; },
            [&](int ps, int n4) -> const float* { const int u = dl.lo + ps * dl.step, ks = u >> 4, kv = (u >> 3) & 1; return (kv ? W1v : W1k) + (size_t)ks * 512 * 64 + ((n4 * 4) & 63); },
            [&](int) { return 256; },
            [&](int ps, int r, int n, f32x4 v) { if (n < 64) { const int u = dl.lo + ps * dl.step; *(f32x4*)(CP + ((size_t)(u >> 3) * 2048 + (u & 7) * 256 + r) * 64 + n) = v; } });
    }
}

__device__ __forceinline__ void phase3b_new(const Params& p, int bid, int nb, float* smem) {
    const int tid = threadIdx.x;
    {
        const float* AL = (const float*)(p.ws + WS_ALRU); const float* UL = (const float*)(p.ws + WS_ULRU);
        float* AEND = (float*)(p.ws + WS_AEND); float* HEND = (float*)(p.ws + WS_HEND);
        const int cg = tid & 127, sg = tid >> 7;
        f32x4* summA = (f32x4*)smem; f32x4* summH = summA + 512;
        for (int u = bid; u < 256; u += nb) {
            const size_t base = ((size_t)(u >> 7) * SEQ + (u & 127) * 64 + sg * 16) * 512 + 4 * cg;
            f32x4 av[16], uv[16];
#pragma unroll
            for (int tt = 0; tt < 16; ++tt) { av[tt] = *(const f32x4*)(AL + base + (size_t)tt * 512); uv[tt] = *(const f32x4*)(UL + base + (size_t)tt * 512); }
            f32x4 A = (f32x4){1.f, 1.f, 1.f, 1.f}, H = (f32x4){0.f, 0.f, 0.f, 0.f};
#pragma unroll
            for (int tt = 0; tt < 16; ++tt) { H = av[tt] * H + uv[tt]; A = A * av[tt]; }
            __syncthreads();
            summA[sg * 128 + cg] = A; summH[sg * 128 + cg] = H;
            __syncthreads();
            if (sg == 0) {
#pragma unroll
                for (int j = 1; j < 4; ++j) { const f32x4 a2 = summA[j * 128 + cg], h2 = summH[j * 128 + cg]; H = a2 * H + h2; A = A * a2; }
                *(f32x4*)(AEND + (size_t)u * 512 + 4 * cg) = A; *(f32x4*)(HEND + (size_t)u * 512 + 4 * cg) = H;
            }
        }
        __syncthreads();
    }
    {
        const float* CP = (const float*)(p.ws + WS_CPART); const float* CB = (const float*)(p.ws + WS_CBIAS);
        float* hid = smem;
        for (int u = bid; u < 64; u += nb) {
            const int kv = u >> 5, R0 = (u & 31) * 64;
            const float* w2 = kv ? p.in[10] : p.in[8];
            bf16_t* ob = (bf16_t*)(p.ws + (kv ? WS_VCB : WS_KCB));
            __syncthreads();
            for (int i = tid; i < 64 * 64; i += NT) {
                const int r = i >> 6, c = i & 63; const size_t o = ((size_t)kv * 2048 + R0 + r) * 64 + c;
                const float v = ((CP[o] + CP[o + 262144]) + (CP[o + 524288] + CP[o + 786432])) + CB[kv * 64 + c];
                hid[r * 65 + c] = gelu_t(v);
            }
            __syncthreads();
            for (int i = tid; i < 64 * 64; i += NT) {
                const int r = i >> 6, j = i & 63; float acc = 0.f;
#pragma unroll 8
                for (int k = 0; k < 64; ++k) acc += hid[r * 65 + k] * w2[k * 64 + j];
                const int R = R0 + r;
                if ((R & 511) == 511) acc = 0.f;
                ob[(size_t)R * 64 + j] = (bf16_t)(pk_bf16(acc, acc) & 0xffffu);
            }
        }
    }
}

__device__ __forceinline__ void phase4b_new(const Params& p, int bid, int nb, float* smem) {
    const float* AL = (const float*)(p.ws + WS_ALRU); const float* UL = (const float*)(p.ws + WS_ULRU);
    const float* AEND = (const float*)(p.ws + WS_AEND); const float* HEND = (const float*)(p.ws + WS_HEND);
    const bf16_t* GRG = (const bf16_t*)(p.ws + WS_GRG); const float* OATT = (const float*)(p.ws + WS_OATT);
    const float* gaw = p.in[19]; const float* grw = p.in[20];
    bf16_t* YB = (bf16_t*)(p.ws + WS_YB);
    const int tid = threadIdx.x, lane = tid & 63;
    const int cg = tid & 127, sg = tid >> 7, wsub = (tid >> 6) & 1;
    f32x4* summA = (f32x4*)smem;
    f32x4* summH = summA + 512;
    float* ssr = smem + 4096;
    float* ssa = ssr + 128;
    const f32x4 gr_w = *(const f32x4*)(grw + 4 * cg), ga_w = *(const f32x4*)(gaw + 4 * cg);
    for (int u = bid; u < 256; u += nb) {
        const int b = u >> 7, chunk = u & 127;
        f32x4 carry = (f32x4){0.f, 0.f, 0.f, 0.f};
        {
            const size_t cb = (size_t)(b * 128) * 512 + 4 * cg;
#pragma unroll 16
            for (int k = 0; k < chunk; ++k) carry = *(const f32x4*)(AEND + cb + (size_t)k * 512) * carry + *(const f32x4*)(HEND + cb + (size_t)k * 512);
        }
        const size_t tok0 = (size_t)b * SEQ + chunk * 64 + sg * 16;
        f32x4 av[16], uv[16];
#pragma unroll
        for (int tt = 0; tt < 16; ++tt) { const size_t o = (tok0 + tt) * 512 + 4 * cg; av[tt] = *(const f32x4*)(AL + o); uv[tt] = *(const f32x4*)(UL + o); }
        f32x4 A = (f32x4){1.f, 1.f, 1.f, 1.f}, H = (f32x4){0.f, 0.f, 0.f, 0.f};
#pragma unroll
        for (int tt = 0; tt < 16; ++tt) { H = av[tt] * H + uv[tt]; A = A * av[tt]; }
        __syncthreads();
        summA[sg * 128 + cg] = A; summH[sg * 128 + cg] = H;
        __syncthreads();
#pragma unroll
        for (int j = 0; j < 3; ++j) if (j < sg) carry = summA[j * 128 + cg] * carry + summH[j * 128 + cg];
        f32x4 h = carry;
#pragma unroll
        for (int tt = 0; tt < 16; ++tt) {
            const size_t o = (tok0 + tt) * 512 + 4 * cg;
            h = av[tt] * h + uv[tt];
            const u32x2 gw = *(const u32x2*)(GRG + o);
            f32x4 v; v[0] = h[0] * __uint_as_float(gw.x << 16); v[1] = h[1] * __uint_as_float(gw.x & 0xffff0000u); v[2] = h[2] * __uint_as_float(gw.y << 16); v[3] = h[3] * __uint_as_float(gw.y & 0xffff0000u);
            uv[tt] = v;
            const float sq = wave_sum((v[0] * v[0] + v[1] * v[1]) + (v[2] * v[2] + v[3] * v[3]));
            const f32x4 oa = *(const f32x4*)(OATT + o);
            av[tt] = oa;
            const float sqa = wave_sum((oa[0] * oa[0] + oa[1] * oa[1]) + (oa[2] * oa[2] + oa[3] * oa[3]));
            if (lane == 0) { ssr[(sg * 16 + tt) * 2 + wsub] = sq; ssa[(sg * 16 + tt) * 2 + wsub] = sqa; }
        }
        __syncthreads();
#pragma unroll
        for (int tt = 0; tt < 16; ++tt) {
            const int ti = sg * 16 + tt;
            const float s1 = ssr[ti * 2] + ssr[ti * 2 + 1], s2 = ssa[ti * 2] + ssa[ti * 2 + 1];
            const float rs1 = __builtin_amdgcn_rsqf(s1 * (1.f / 512.f) + 1e-6f), rs2 = __builtin_amdgcn_rsqf(s2 * (1.f / 512.f) + 1e-6f);
            const f32x4 ya = av[tt] * rs2 * ga_w, yr = uv[tt] * rs1 * gr_w;
            u32x2 wa, wr_; wa.x = pk_bf16(ya[0], ya[1]); wa.y = pk_bf16(ya[2], ya[3]); wr_.x = pk_bf16(yr[0], yr[1]); wr_.y = pk_bf16(yr[2], yr[3]);
            *(u32x2*)(YB + (tok0 + tt) * 1024 + 4 * cg) = wa;
            *(u32x2*)(YB + (tok0 + tt) * 1024 + 512 + 4 * cg) = wr_;
        }
    }
}

__device__ __forceinline__ void phase8(const Params& p, int bid, int nb, float* smem) {
    const float* LOG = (const float*)(p.ws + WS_LOGITS); const float* brt = p.in[24];
    unsigned* cnt = (unsigned*)(p.ws + WS_HIST);
    int* EID = (int*)(p.ws + WS_EID); int* POS = (int*)(p.ws + WS_POS); float* WGT = (float*)(p.ws + WS_WGT);
    int tid_ = threadIdx.x; asm volatile("" : "+v"(tid_));
    const int wave = tid_ >> 6, lane = tid_ & 63;
    int* lhist = (int*)smem;
    if (tid_ < 256) lhist[tid_] = 0;
    __syncthreads();
    float bias[4];
#pragma unroll
    for (int r = 0; r < 4; ++r) bias[r] = brt[r * 64 + lane];
    for (int tok0 = bid * NW + wave; tok0 < MTOK; tok0 += 8 * nb * NW) {
        float lg[8][4];
#pragma unroll
        for (int k = 0; k < 8; ++k) { const int tok = tok0 + k * nb * NW; const int tc = tok < MTOK ? tok : tok0;
#pragma unroll
            for (int r = 0; r < 4; ++r) lg[k][r] = LOG[(size_t)tc * 256 + r * 64 + lane]; }
#pragma unroll
        for (int k = 0; k < 8; ++k) {
            const int tok = tok0 + k * nb * NW;
            if (tok < MTOK) {
                float sv[4], cv[4], gs[4];
#pragma unroll
                for (int r = 0; r < 4; ++r) { sv[r] = sigm(lg[k][r]); cv[r] = sv[r] + bias[r]; gs[r] = half_top2_sum(cv[r]); }
                float gsc = -INF;
#pragma unroll
                for (int r = 0; r < 4; ++r) {
                    const float ga = __builtin_bit_cast(float, __builtin_amdgcn_readlane(__builtin_bit_cast(int, gs[r]), 31));
                    const float gb = __builtin_bit_cast(float, __builtin_amdgcn_readlane(__builtin_bit_cast(int, gs[r]), 63));
                    gsc = lane == 2 * r ? ga : gsc; gsc = lane == 2 * r + 1 ? gb : gsc;
                }
                int grank = 0;
#pragma unroll
                for (int g2 = 0; g2 < 8; ++g2) { const float v2 = __builtin_bit_cast(float, __builtin_amdgcn_readlane(__builtin_bit_cast(int, gsc), g2)); grank += ((v2 > gsc) || (v2 == gsc && g2 < lane)) ? 1 : 0; }
                const unsigned long long gmask = __ballot((lane < 8) && (grank < 4));
#pragma unroll
                for (int r = 0; r < 4; ++r) cv[r] = ((gmask >> (2 * r + (lane >> 5))) & 1ull) ? cv[r] : -INF;
                int my_e = 0; float my_s = 0.f;
#pragma unroll
                for (int kk = 0; kk < 8; ++kk) {
                    float bv = cv[0]; int bi = lane;
                    if (cv[1] > bv) { bv = cv[1]; bi = 64 + lane; }
                    if (cv[2] > bv) { bv = cv[2]; bi = 128 + lane; }
                    if (cv[3] > bv) { bv = cv[3]; bi = 192 + lane; }
                    const float mx = wave_max_f(bv);
                    const int sel = wave_min_i(bv == mx ? bi : 0x7fffffff);
                    const int sr = sel >> 6;
                    const float mine = sr == 0 ? sv[0] : sr == 1 ? sv[1] : sr == 2 ? sv[2] : sv[3];
                    const float ssel = __builtin_bit_cast(float, __builtin_amdgcn_readlane(__builtin_bit_cast(int, mine), sel & 63));
                    if (lane == (sel & 63)) { cv[0] = sr == 0 ? -INF : cv[0]; cv[1] = sr == 1 ? -INF : cv[1]; cv[2] = sr == 2 ? -INF : cv[2]; cv[3] = sr == 3 ? -INF : cv[3]; }
                    if (lane == kk) { my_e = sel; my_s = ssel; }
                }
                const float ssum = wave_sum(lane < 8 ? my_s : 0.f);
                if (lane < 8) {
                    const int ps = atomicAdd(&lhist[my_e], 1);
                    EID[tok * 8 + lane] = my_e; POS[tok * 8 + lane] = ps; WGT[tok * 8 + lane] = 2.5f * my_s / ssum;
                }
            }
        }
    }
    __syncthreads();
    if (tid_ < 256) cnt[bid * 256 + tid_] = (unsigned)lhist[tid_];
}

__device__ __forceinline__ void expert_tables(const Params& p, int* off, int* tp, int shift = 6) {
    const unsigned* cnt = (const unsigned*)(p.ws + WS_CTL) + CW_CNT;
    __syncthreads();
    if (threadIdx.x < 64) {
        const int l = threadIdx.x; const int rnd = (1 << shift) - 1;
        const u32x4 c4 = *(const u32x4*)(cnt + 4 * l);
        const int c0 = (int)c4[0], c1 = (int)c4[1], c2 = (int)c4[2], c3 = (int)c4[3];
        const int t0 = (c0 + rnd) >> shift, t1 = (c1 + rnd) >> shift, t2 = (c2 + rnd) >> shift, t3 = (c3 + rnd) >> shift;
        const int so = c0 + c1 + c2 + c3, st = t0 + t1 + t2 + t3;
        int io = so, it = st;
#pragma unroll
        for (int d = 1; d < 64; d <<= 1) { const int uo = __shfl_up(io, d), ut = __shfl_up(it, d); if (l >= d) { io += uo; it += ut; } }
        const int eo = io - so, et = it - st;
        off[4 * l] = eo; off[4 * l + 1] = eo + c0; off[4 * l + 2] = eo + c0 + c1; off[4 * l + 3] = eo + c0 + c1 + c2;
        tp[4 * l] = et; tp[4 * l + 1] = et + t0; tp[4 * l + 2] = et + t0 + t1; tp[4 * l + 3] = et + t0 + t1 + t2;
        if (l == 63) { off[256] = io; tp[256] = it; tp[257] = it + (MTOK >> shift); }
    }
    __syncthreads();
}

__device__ __forceinline__ void phase9(const Params& p, int bid, int nb, float* smem) {
    int* off = (int*)smem; int* blkoff = off + 272; int* tot = off + 528; int* ptot = off + 1024; int* ppre = off + 3072;
    const unsigned* HIST = (const unsigned*)(p.ws + WS_HIST);
    unsigned* cnt = (unsigned*)(p.ws + WS_CTL) + CW_CNT;
    int tid_ = threadIdx.x; asm volatile("" : "+v"(tid_));
    const int tid = tid_;
    __syncthreads();
    {
        const int e4 = tid & 63, bg = tid >> 6, gsz = (nb + 7) >> 3, b0 = bg * gsz, b1 = (b0 + gsz) < nb ? (b0 + gsz) : nb;
        int t0 = 0, t1 = 0, t2 = 0, t3 = 0, q0 = 0, q1 = 0, q2 = 0, q3 = 0;
#pragma unroll 16
        for (int bb = b0; bb < b1; ++bb) {
            const u32x4 h = *(const u32x4*)(HIST + (size_t)bb * 256 + 4 * e4); const bool pre = bb < bid;
            t0 += (int)h[0]; t1 += (int)h[1]; t2 += (int)h[2]; t3 += (int)h[3];
            q0 += pre ? (int)h[0] : 0; q1 += pre ? (int)h[1] : 0; q2 += pre ? (int)h[2] : 0; q3 += pre ? (int)h[3] : 0;
        }
        int* pt = ptot + bg * 256 + 4 * e4; int* pq = ppre + bg * 256 + 4 * e4;
        pt[0] = t0; pt[1] = t1; pt[2] = t2; pt[3] = t3; pq[0] = q0; pq[1] = q1; pq[2] = q2; pq[3] = q3;
        __syncthreads();
        if (tid < 256) {
            int total = 0, pre = 0;
#pragma unroll
            for (int g = 0; g < 8; ++g) { total += ptot[g * 256 + tid]; pre += ppre[g * 256 + tid]; }
            tot[tid] = total; blkoff[tid] = pre; if (bid == 0) cnt[tid] = (unsigned)total;
        }
    }
    __syncthreads();
    if (tid < 64) {
        const int c0 = tot[4 * tid], c1 = tot[4 * tid + 1], c2 = tot[4 * tid + 2], c3 = tot[4 * tid + 3];
        const int so = c0 + c1 + c2 + c3; int io = so;
#pragma unroll
        for (int d = 1; d < 64; d <<= 1) { const int uo = __shfl_up(io, d); if (tid >= d) io += uo; }
        const int eo = io - so;
        off[4 * tid] = eo; off[4 * tid + 1] = eo + c0; off[4 * tid + 2] = eo + c0 + c1; off[4 * tid + 3] = eo + c0 + c1 + c2;
    }
    __syncthreads();
    const int* EID = (const int*)(p.ws + WS_EID); const int* POS = (const int*)(p.ws + WS_POS); const float* WGT = (const float*)(p.ws + WS_WGT);
    int* ST = (int*)(p.ws + WS_SLOTTOK); float* SW = (float*)(p.ws + WS_SLOTW); int* SOF = (int*)(p.ws + WS_SLOTOF);
    const int wave = tid >> 6, lane = tid & 63;
    for (int tok0 = bid * NW + wave; tok0 < MTOK; tok0 += 8 * nb * NW) {
        const int tok = tok0 + (lane >> 3) * nb * NW;
        if (tok < MTOK) {
            const int idx = tok * 8 + (lane & 7); const int e = EID[idx];
            const int slot = off[e] + blkoff[e] + POS[idx];
            ST[slot] = tok; SW[slot] = WGT[idx]; SOF[idx] = slot;
        }
    }
}

__device__ __forceinline__ int find_expert(const int* tp, int rt) {
    int lo = 0, hi = 256;
    while (lo < hi) { const int mid = (lo + hi + 1) >> 1; if (tp[mid] <= rt) lo = mid; else hi = mid - 1; }
    return lo;
}

__device__ __forceinline__ void phase7_mfma(const Params& p, int bid, int nb, LAS unsigned char* lds) {
    const unsigned char* H2b = p.ws + WS_H2B; const float* wr = p.in[23];
    float* LOG = (float*)(p.ws + WS_LOGITS);
    const XcdDeal dl = xcd_deal(64 * 2, lds, nb);
    const bf16_t* wrb = (const bf16_t*)(p.ws + WS_WRB);
    gemm_stream<false, 1, 0, false, true>(lds, H2b, dl.n, 16, 256,
        [&](int ps, int r) { const int u = dl.lo + ps * dl.step; return (size_t)((u >> 1) * 256 + r) * 2048; },
        [&](int ps, int n4) -> const bf16_t* { const int u = dl.lo + ps * dl.step; return wrb + (u & 1) * 128 + n4 * 4; },
        [&](int) { return 256; },
        [&](int ps, int r, int n, f32x4 v) { const int u = dl.lo + ps * dl.step; *(f32x4*)(LOG + (size_t)((u >> 1) * 256 + r) * 256 + (u & 1) * 128 + n) = v; });
}

#define ETAB_OFF 24576
#define EDESC_OFF (ETAB_OFF + 1024)
__device__ __forceinline__ int expert_passes(const Params& p, int bid, int nb, const LAS unsigned char* lds, float* smem, int nct, int& npass) {
    int* off = (int*)(smem + ETAB_OFF); int* tp = off + 272; int* desc = (int*)(smem + EDESC_OFF);
    expert_tables(p, off, tp, 8);
    const unsigned* cnt = (const unsigned*)(p.ws + WS_CTL) + CW_CNT;
    const XcdDeal dl = xcd_deal(tp[257] * nct, lds, nb);
    npass = dl.n;
    for (int ps = threadIdx.x; ps < npass; ps += NT) {
        const int u = dl.lo + ps * dl.step;
        const int e = find_expert(tp, u / nct);
        const int nte = tp[e + 1] - tp[e], v = u - tp[e] * nct, ct = v / nte, rtl = v - ct * nte;
        const int rows_e = e < 256 ? (int)cnt[e] : MTOK;
        const int r0 = rtl * 256;
        desc[ps * 4 + 0] = (e < 256 ? off[e] : NK) + r0;
        desc[ps * 4 + 1] = (rows_e - r0) < 256 ? (rows_e - r0) : 256;
        desc[ps * 4 + 2] = e; desc[ps * 4 + 3] = ct;
    }
    __syncthreads();
    return dl.lo;
}

__device__ __forceinline__ void phase10_mfma(const Params& p, int bid, int nb, LAS unsigned char* lds, float* smem) {
    int npass; expert_passes(p, bid, nb, lds, smem, 4, npass);
    const LAS int* desc = (const LAS int*)(lds + EDESC_OFF * 4);
    const unsigned char* H2b = p.ws + WS_H2B; const int* ST = (const int*)(p.ws + WS_SLOTTOK);
    bf16_t* HIDB = (bf16_t*)(p.ws + WS_HIDB);
    const float* W1g = p.in[25]; const float* W3g = p.in[26]; const float* W1s = p.in[28]; const float* W3s = p.in[29];
    const float* SW = (const float*)(p.ws + WS_SLOTW);
    gemm_stream_ws(lds, H2b, npass, 16, 256,
        [&](int ps, int r) { const int slot0 = desc[ps * 4], mr = desc[ps * 4 + 1]; const int rr = r < mr ? r : mr - 1; const int slot = slot0 + rr;
                             const int tok = slot < NK ? ST[slot] : slot - NK; return (size_t)tok * 2048; },
        [&](int ps, int n4) -> const float* { const int e = desc[ps * 4 + 2], hc0 = desc[ps * 4 + 3] * 64; const int n = n4 * 4;
                             const int hc = hc0 + (n >> 6) * 32 + ((n >> 2) & 3) * 8 + ((n >> 4) & 1) * 4;
                             const float* W = ((n >> 5) & 1) ? (e < 256 ? W3g + (size_t)e * 262144 : W3s) : (e < 256 ? W1g + (size_t)e * 262144 : W1s); return W + hc; },
        [&](int ps) { return desc[ps * 4 + 1]; },
        [&](int ps, int rbase, int nbase, int mr, f32x4 (&acc)[8][4]) {
            const int slot0 = desc[ps * 4] + rbase, hc = desc[ps * 4 + 3] * 64 + (nbase >> 6) * 32 + ((nbase >> 2) & 3) * 8;
            float wv[8];
#pragma unroll
            for (int mi = 0; mi < 8; ++mi) { const int slot = slot0 + mi * 16; const float wl = SW[slot < NK ? slot : 0]; wv[mi] = slot < NK ? wl : 1.f; }
#pragma unroll
            for (int mi = 0; mi < 8; ++mi) {
                if (rbase + mi * 16 < mr) {
                    float h[8];
#pragma unroll
                    for (int ni = 0; ni < 2; ++ni) {
                        const f32x4 a = acc[mi][ni], bq = acc[mi][ni + 2];
#pragma unroll
                        for (int jj = 0; jj < 4; ++jj) h[ni * 4 + jj] = a[jj] * __builtin_amdgcn_rcpf(1.f + ex2(-a[jj] * LOG2E)) * bq[jj] * wv[mi];
                    }
                    u32x4 w; w[0] = pk_bf16(h[0], h[1]); w[1] = pk_bf16(h[2], h[3]); w[2] = pk_bf16(h[4], h[5]); w[3] = pk_bf16(h[6], h[7]);
                    *(u32x4*)(HIDB + (size_t)(slot0 + mi * 16) * 256 + hc) = w;
                }
            } });
}

__device__ __forceinline__ void phase11_mfma(const Params& p, int bid, int nb, LAS unsigned char* lds, float* smem) {
    int npass; expert_passes(p, bid, nb, lds, smem, 8, npass);
    const LAS int* desc = (const LAS int*)(lds + EDESC_OFF * 4);
    const unsigned char* HIDB = p.ws + WS_HIDB; const float* SW = (const float*)(p.ws + WS_SLOTW);
    bf16_t* SO = (bf16_t*)(p.ws + WS_SLOTOUT);
    const float* W2g = p.in[27]; const float* W2s = p.in[30];
    gemm_stream_ws(lds, HIDB, npass, 4, 1024,
        [&](int ps, int r) { const int slot0 = desc[ps * 4], mr = desc[ps * 4 + 1]; const int rr = r < mr ? r : mr - 1; return (size_t)(slot0 + rr) * 512; },
        [&](int ps, int n4) -> const float* { const int e = desc[ps * 4 + 2], n0 = desc[ps * 4 + 3] * 128; const int src4 = (n4 & ~7) + 2 * (n4 & 3) + ((n4 >> 2) & 1);
                                              return (e < 256 ? W2g + (size_t)e * 262144 : W2s) + n0 + src4 * 4; },
        [&](int ps) { return desc[ps * 4 + 1]; },
        [&](int ps, int rbase, int nbase, int mr, f32x4 (&acc)[8][4]) {
            const int slot0 = desc[ps * 4] + rbase, c0 = desc[ps * 4 + 3] * 128 + (nbase >> 6) * 64 + ((nbase >> 2) & 3) * 8;
#pragma unroll
            for (int mi = 0; mi < 8; ++mi) {
                if (rbase + mi * 16 < mr) {
                    bf16_t* op = SO + (size_t)(slot0 + mi * 16) * 1024 + c0;
#pragma unroll
                    for (int np = 0; np < 2; ++np) {
                        const f32x4 v0 = acc[mi][2 * np], v1 = acc[mi][2 * np + 1];
                        u32x4 o; o[0] = pk_bf16(v0[0], v0[1]); o[1] = pk_bf16(v0[2], v0[3]); o[2] = pk_bf16(v1[0], v1[1]); o[3] = pk_bf16(v1[2], v1[3]);
                        *(u32x4*)(op + np * 32) = o;
                    }
                }
            } });
}

__device__ __forceinline__ void phase12_mfma(const Params& p, int bid, int nb) {
    const bf16_t* X1 = (const bf16_t*)(p.ws + WS_X1); const bf16_t* SO = (const bf16_t*)(p.ws + WS_SLOTOUT); const int* SOF = (const int*)(p.ws + WS_SLOTOF);
    const float* mod = (const float*)(p.ws + WS_MOD); const float* fw = p.in[31];
    int tid_ = threadIdx.x; asm volatile("" : "+v"(tid_));
    const int wave = tid_ >> 6, lane = tid_ & 63;
    const int RS = nb * NW;
    f32x4 wv[4];
#pragma unroll
    for (int i4 = 0; i4 < 4; ++i4) wv[i4] = *(const f32x4*)(fw + lane * 16 + i4 * 4);
    for (int row0 = bid * NW + wave; row0 < MTOK; row0 += 2 * RS) {
        int slots[2];
#pragma unroll
        for (int k = 0; k < 2; ++k) { const int row = row0 + k * RS; const int rc = row < MTOK ? row : row0; slots[k] = lane < 8 ? SOF[rc * 8 + lane] : NK + rc; }
        u32x4 w0[2][9], w1[2][9], xa[2], xb[2];
#pragma unroll
        for (int k = 0; k < 2; ++k) {
            const int row = row0 + k * RS; const int rc = row < MTOK ? row : row0;
#pragma unroll
            for (int q = 0; q < 9; ++q) {
                const int slot = __builtin_amdgcn_readlane(slots[k], q);
                const u32x4* rp = (const u32x4*)(SO + (size_t)slot * 1024 + lane * 16);
                w0[k][q] = rp[0]; w1[k][q] = rp[1];
            }
            const u32x4* xp = (const u32x4*)(X1 + (size_t)rc * 1024 + lane * 16);
            xa[k] = xp[0]; xb[k] = xp[1];
        }
#pragma unroll
        for (int k = 0; k < 2; ++k) {
            const int row = row0 + k * RS;
            if (row < MTOK) {
                const int b = row >> 13;
                float acc[16];
#pragma unroll
                for (int i = 0; i < 16; ++i) acc[i] = 0.f;
#pragma unroll
                for (int q = 0; q < 9; ++q) {
#pragma unroll
                    for (int j = 0; j < 4; ++j) {
                        acc[2 * j] += __uint_as_float(w0[k][q][j] << 16); acc[2 * j + 1] += __uint_as_float(w0[k][q][j] & 0xffff0000u);
                        acc[8 + 2 * j] += __uint_as_float(w1[k][q][j] << 16); acc[8 + 2 * j + 1] += __uint_as_float(w1[k][q][j] & 0xffff0000u);
                    }
                }
                float xv[16];
#pragma unroll
                for (int j = 0; j < 4; ++j) { xv[2 * j] = __uint_as_float(xa[k][j] << 16); xv[2 * j + 1] = __uint_as_float(xa[k][j] & 0xffff0000u);
                                              xv[8 + 2 * j] = __uint_as_float(xb[k][j] << 16); xv[8 + 2 * j + 1] = __uint_as_float(xb[k][j] & 0xffff0000u); }
                float v[16]; float ss = 0.f;
#pragma unroll
                for (int i4 = 0; i4 < 4; ++i4) {
                    const f32x4 gv = *(const f32x4*)(mod + b * 6144 + 5120 + lane * 16 + i4 * 4);
#pragma unroll
                    for (int j = 0; j < 4; ++j) { v[i4 * 4 + j] = xv[i4 * 4 + j] + gv[j] * acc[i4 * 4 + j]; ss += v[i4 * 4 + j] * v[i4 * 4 + j]; }
                }
                ss = wave_sum(ss);
                const float rstd = __builtin_amdgcn_rsqf(ss * (1.f / 1024.f) + 1e-6f);
#pragma unroll
                for (int i4 = 0; i4 < 4; ++i4) {
                    f32x4 o;
#pragma unroll
                    for (int j = 0; j < 4; ++j) o[j] = v[i4 * 4 + j] * rstd * wv[i4][j];
                    *(f32x4*)(p.out + (size_t)row * 1024 + lane * 16 + i4 * 4) = o;
                }
            }
        }
    }
}

__global__ void __launch_bounds__(NT, 2) k_fused(Params p) {
    extern __shared__ __attribute__((aligned(16))) unsigned char lds_raw[];
    LAS unsigned char* lds = (LAS unsigned char*)lds_raw;
    float* smem = (float*)lds_raw;
    if (threadIdx.x == 0) { *(LAS u32x4*)(lds + LDS_MISC) = (u32x4){0u, 0u, 0u, 0u}; }
    __syncthreads();
    XcdBarrier bar = xcd_barrier_post((unsigned*)(p.ws + WS_CTL), (volatile LAS unsigned*)(lds + LDS_MISC));
    if (threadIdx.x == 0) ((LAS int*)(lds + TOPO_OFF))[2] = (int)xb_add((unsigned*)(p.ws + WS_CTL) + CW_RANK + 64 * bar.x, 1u);
    const int bid = blockIdx.x, nb = gridDim.x;
#define PH(stmt) { stmt; xcd_barrier(bar); }
#define PHR(bit, stmt) { stmt; xcd_barrier(bar); if (REP & (bit)) { stmt; xcd_barrier(bar); } }
    PHR(8192, phase0(p, bid, nb, smem, lds))
    if (threadIdx.x == 0) {
        int pre = 0, mine = 0;
        for (unsigned j = 0; j < 16; ++j) { const int c = (int)xb_ld((unsigned*)(p.ws + WS_CTL) + XB_XCNT(j)); if (j < bar.x) pre += c; if (j == bar.x) mine = c; }
        ((LAS int*)(lds + TOPO_OFF))[0] = pre; ((LAS int*)(lds + TOPO_OFF))[1] = mine > 0 ? mine : 1;
    }
    __syncthreads();
    PHR(128, phase_modnorm<false>(p, bid, nb, p.in[0], p.in[4], 0, 1024, (bf16_t*)(p.ws + WS_H1B)))
    PHR(1, phase2_e(p, bid, nb, lds))
    PHR(2, phase3_mfma(p, bid, nb, lds))
    PHR(4, phase3b_new(p, bid, nb, smem))
    PH(phase4_mfma(p.ws, bid, nb, lds))
    PHR(8, phase4b_new(p, bid, nb, smem))
    PHR(512, phase5_e(p, bid, nb, lds))
    PHR(16384, phase_modnorm<true>(p, bid, nb, p.ws + WS_X1, p.in[22], 3072, 4096, (bf16_t*)(p.ws + WS_H2B)))
    PHR(1024, phase7_mfma(p, bid, nb, lds))
    PH(phase8(p, bid, nb, smem))
    PH(phase9(p, bid, nb, smem))
    if (REP & 256) { PH(phase8(p, bid, nb, smem)) PH(phase9(p, bid, nb, smem)) }
    PHR(16, phase10_mfma(p, bid, nb, lds, smem))
    PHR(32, phase11_mfma(p, bid, nb, lds, smem))
    phase12_mfma(p, bid, nb);
    if (REP & 2048) { xcd_barrier(bar); phase12_mfma(p, bid, nb); }
    if (REP & 4096) { for (int i = 0; i < 20; ++i) xcd_barrier(bar); }
#undef PH
#undef PHR
}

extern "C" void kernel_launch(void* const* d_in, const int* in_sizes, int n_in, void* d_out, int out_size, void* d_ws, size_t ws_size, hipStream_t stream) {
    static int grid = 0;
    if (!grid) {
        int dev = 0, cus = 0;
        (void)hipGetDevice(&dev);
        (void)hipDeviceGetAttribute(&cus, hipDeviceAttributeMultiprocessorCount, dev);
        (void)hipFuncSetAttribute((const void*)k_fused, hipFuncAttributeMaxDynamicSharedMemorySize, LDS_BYTES);
        if (cus < 1) cus = 256;
        grid = cus;
    }
    Params p{};
    for (int i = 0; i < 32; ++i) p.in[i] = (const float*)d_in[i];
    p.out = (float*)d_out; p.ws = (unsigned char*)d_ws;
    (void)hipMemsetAsync((char*)d_ws + WS_CTL, 0, CTL_BYTES, stream);
    hipLaunchKernelGGL(k_fused, dim3(grid), dim3(NT), LDS_BYTES, stream, p);
}
```

```cpp
#include <hip/hip_runtime.h>
#include <stdint.h>
#include <type_traits>


#define MTOK 16384
#define SEQ 8192
#define SEQP 8195
#define DM 1024
#define NCOLS 2328
#define COL_KC 512
#define COL_KS 768
#define COL_VS 896
#define COL_KW 1024
#define COL_VW 1152
#define COL_G 1280
#define COL_XR 1304
#define COL_GR 1816
#define NCMP 511
#define NEXP 256
#define NK 131072

#define MiB (1048576ull)
#define WS_CTL 0ull
#define CTL_BYTES (1 * MiB)
#define CW_CNT 8192
#define CW_RANK 12288
#define WS_MOD (1 * MiB)
#define WS_LUT (1 * MiB + 65536)
#define WS_KC (2 * MiB)
#define WS_VC (3 * MiB)
#define WS_AEND (4 * MiB)
#define WS_HEND (5 * MiB)
#define WS_EID (6 * MiB)
#define WS_POS (7 * MiB)
#define WS_WGT (8 * MiB)
#define WS_SLOTTOK (9 * MiB)
#define WS_SLOTW (10 * MiB)
#define WS_CARRY (11 * MiB)
#define WS_SLOTOF (12 * MiB)
#define WS_HIST (13 * MiB)
#define WS_LOGITS (16 * MiB)
#define WS_H1 (32 * MiB)
#define WS_PROJ (96 * MiB)
#define WS_HL (256 * MiB)
#define WS_AP (288 * MiB)
#define WS_ACC (320 * MiB)
#define WS_HID (384 * MiB)
#define WS_Y (528 * MiB)
#define WS_H2 (592 * MiB)
#define WS_X1 (656 * MiB)
#define WS_H1B (720 * MiB)
#define WS_YB (752 * MiB)
#define WS_H2B (784 * MiB)
#define WS_HIDB (816 * MiB)
#define WS_QB (896 * MiB)
#define WS_KV6 (912 * MiB)
#define WS_GATE (936 * MiB)
#define WS_KCB (938 * MiB)
#define WS_VCB (939 * MiB)
#define WS_OATT (940 * MiB)
#define WS_BG (14 * MiB)
#define WS_GBIAS (15 * MiB)
#define WS_CBIAS (15 * MiB + 8192)
#define WS_XRB (972 * MiB)
#define WS_GRG (990 * MiB)
#define WS_CPART (1007 * MiB)
#define WS_ALRU (256 * MiB)
#define WS_ULRU (288 * MiB)
#define WS_WINB (1012 * MiB)
#define WS_WOUTB (1017 * MiB)
#define WS_WRB (1020 * MiB)
#define WS_WINT (1012 * MiB)
#define WS_WOUTT (1017 * MiB)
#define WS_WRT (1019 * MiB)
#define WS_SLOTOUT (32 * MiB)

#ifndef REP
#define REP 0
#endif
#ifndef USE_MFMA
#define USE_MFMA 31
#endif

struct Params {
    const float* in[32];
    float* out;
    unsigned char* ws;
};

#define NT 512
#define NW 8
#define LDS_BYTES 151552
#define LDS_MISC 131072
#define INF __builtin_huge_valf()
#define LOG2E 1.4426950408889634f

__device__ __forceinline__ float wave_sum(float v) {
#define WS_DPP(ctrl, rmask) __builtin_bit_cast(float, __builtin_amdgcn_update_dpp(0, __builtin_bit_cast(int, v), (ctrl), (rmask), 0xf, true))
    v += WS_DPP(0x111, 0xf);
    v += WS_DPP(0x112, 0xf);
    v += WS_DPP(0x114, 0xf);
    v += WS_DPP(0x118, 0xf);
    v += WS_DPP(0x142, 0xa);
    v += WS_DPP(0x143, 0xc);
#undef WS_DPP
    return __builtin_bit_cast(float, __builtin_amdgcn_readlane(__builtin_bit_cast(int, v), 63));
}
__device__ __forceinline__ float wave_max(float v) {
#pragma unroll
    for (int o = 32; o; o >>= 1) v = fmaxf(v, __shfl_xor(v, o));
    return v;
}
__device__ __forceinline__ float wave_max_f(float v) {
#define WM_DPP(ctrl, rmask) __builtin_bit_cast(float, __builtin_amdgcn_update_dpp(__builtin_bit_cast(int, -INF), __builtin_bit_cast(int, v), (ctrl), (rmask), 0xf, false))
    v = fmaxf(v, WM_DPP(0x111, 0xf)); v = fmaxf(v, WM_DPP(0x112, 0xf)); v = fmaxf(v, WM_DPP(0x114, 0xf)); v = fmaxf(v, WM_DPP(0x118, 0xf));
    v = fmaxf(v, WM_DPP(0x142, 0xa)); v = fmaxf(v, WM_DPP(0x143, 0xc));
#undef WM_DPP
    return __builtin_bit_cast(float, __builtin_amdgcn_readlane(__builtin_bit_cast(int, v), 63));
}
__device__ __forceinline__ int wave_min_i(int v) {
#define WM_DPP(ctrl, rmask) __builtin_amdgcn_update_dpp(0x7fffffff, v, (ctrl), (rmask), 0xf, false)
    v = min(v, WM_DPP(0x111, 0xf)); v = min(v, WM_DPP(0x112, 0xf)); v = min(v, WM_DPP(0x114, 0xf)); v = min(v, WM_DPP(0x118, 0xf));
    v = min(v, WM_DPP(0x142, 0xa)); v = min(v, WM_DPP(0x143, 0xc));
#undef WM_DPP
    return __builtin_amdgcn_readlane(v, 63);
}
__device__ __forceinline__ float half_top2_sum(float v) {
    float m1 = v, m2 = -INF;
#define T2_STEP(ctrl, rmask) { const float p1 = __builtin_bit_cast(float, __builtin_amdgcn_update_dpp(__builtin_bit_cast(int, -INF), __builtin_bit_cast(int, m1), (ctrl), (rmask), 0xf, false)); \
                               const float p2 = __builtin_bit_cast(float, __builtin_amdgcn_update_dpp(__builtin_bit_cast(int, -INF), __builtin_bit_cast(int, m2), (ctrl), (rmask), 0xf, false)); \
                               const float n2 = fmaxf(fminf(m1, p1), fmaxf(m2, p2)); m1 = fmaxf(m1, p1); m2 = n2; }
    T2_STEP(0x111, 0xf) T2_STEP(0x112, 0xf) T2_STEP(0x114, 0xf) T2_STEP(0x118, 0xf) T2_STEP(0x142, 0xa)
#undef T2_STEP
    return m1 + m2;
}
__device__ __forceinline__ float sigm(float x) { return __builtin_amdgcn_rcpf(1.f + __builtin_amdgcn_exp2f(-1.4426950408889634f * x)); }
__device__ __forceinline__ float tanh_fast(float x) { return 1.f - 2.f * __builtin_amdgcn_rcpf(1.f + __builtin_amdgcn_exp2f(2.8853900817779268f * x)); }
__device__ __forceinline__ float gelu_t(float x) { return 0.5f * x * (1.f + tanh_fast(0.7978845608028654f * (x + 0.044715f * x * x * x))); }
__device__ __forceinline__ float softplus_(float z) { return fmaxf(z, 0.f) + log1pf(expf(-fabsf(z))); }


#define XB_TMO      128
#define XB_XCNT(j)  (256  + 64 * (j))
#define XB_XSUB(j)  (1280 + 64 * (j))
#define XB_XGEN(j)  (2304 + 64 * (j))
#define XB_TOP      3328
#define XB_TOPGEN   3392
#define XCD_BAR_WORDS 3456
#define XB_SPIN_CAP (1u << 18)
#define LAS __attribute__((address_space(3)))

__device__ __forceinline__ unsigned xb_ld(unsigned* p)              { return __hip_atomic_load(p, __ATOMIC_RELAXED, __HIP_MEMORY_SCOPE_AGENT); }
__device__ __forceinline__ unsigned xb_add(unsigned* p, unsigned v) { return __hip_atomic_fetch_add(p, v, __ATOMIC_RELAXED, __HIP_MEMORY_SCOPE_AGENT); }
__device__ __forceinline__ unsigned xb_xcc_id() { return (unsigned)__builtin_amdgcn_s_getreg((3 << 11) | 20) & 0xFu; }
#define XB_SPIN(cond, bar) do { unsigned _sp = 0; while (cond) { __builtin_amdgcn_s_sleep(1); \
    if ((++_sp & 255u) == 0u) { if (xb_ld(&(bar)[XB_TMO])) break; if (_sp > XB_SPIN_CAP) { atomicAdd(&(bar)[XB_TMO], 1u); break; } } } } while (0)

struct XcdBarrier {
    unsigned* bar; unsigned x;
    volatile LAS unsigned* st;
};
__device__ __forceinline__ XcdBarrier xcd_barrier_post(unsigned* bar, volatile LAS unsigned* st) {
    XcdBarrier b; b.bar = bar; b.x = xb_xcc_id(); b.st = st;
    if (threadIdx.x == 0) (void)xb_add(&bar[XB_XCNT(b.x)], 1u);
    return b;
}
__device__ __forceinline__ void xcd_barrier_complete(unsigned* bar, unsigned x, unsigned& nloc, unsigned& nx) {
    const unsigned G = gridDim.x * gridDim.y * gridDim.z;
    unsigned sum, cnt, mine, sp = 0u;
    for (;;) {
        sum = 0u; cnt = 0u; mine = 0u;
#pragma unroll
        for (unsigned j = 0; j < 16; ++j) { const unsigned c = xb_ld(&bar[XB_XCNT(j)]); sum += c; cnt += (c > 0u) ? 1u : 0u; mine = (j == x) ? c : mine; }
        if (sum == G) break;
        __builtin_amdgcn_s_sleep(1);
        if ((++sp & 255u) == 0u) { if (xb_ld(&bar[XB_TMO])) break; if (sp > XB_SPIN_CAP) { atomicAdd(&bar[XB_TMO], 1u); break; } }
    }
    nloc = mine > 0u ? mine : 1u; nx = cnt > 0u ? cnt : 1u;
}
__device__ __forceinline__ void xcd_barrier(const XcdBarrier& b) {
    asm volatile("s_waitcnt vmcnt(0)" ::: "memory");
    __syncthreads();
    if (threadIdx.x == 0) {
        unsigned* bar = b.bar;
        __builtin_amdgcn_s_waitcnt(0);
        unsigned nloc = b.st[0], nx = b.st[1];
        if (nloc == 0u) { xcd_barrier_complete(bar, b.x, nloc, nx); b.st[0] = nloc; b.st[1] = nx; }
        const unsigned old = xb_add(&bar[XB_XSUB(b.x)], 1u);
        const unsigned gen = old / nloc;
        if (old + 1u == (gen + 1u) * nloc) {
            __builtin_amdgcn_fence(__ATOMIC_RELEASE, "agent");
            asm volatile("s_waitcnt vmcnt(0)" ::: "memory");
            const unsigned og = xb_add(&bar[XB_TOP], 1u);
            const unsigned tg = og / nx;
            if (og + 1u == (tg + 1u) * nx) xb_add(&bar[XB_TOPGEN], 1u);
            else XB_SPIN(xb_ld(&bar[XB_TOPGEN]) == tg, bar);
            __builtin_amdgcn_fence(__ATOMIC_ACQUIRE, "agent");
            xb_add(&bar[XB_XGEN(b.x)], 1u);
            asm volatile("s_waitcnt vmcnt(0)" ::: "memory");
        } else {
            XB_SPIN(xb_ld(&bar[XB_XGEN(b.x)]) == gen, bar);
            __builtin_amdgcn_fence(__ATOMIC_ACQUIRE, "agent");
            asm volatile("s_waitcnt vmcnt(0)" ::: "memory");
        }
    }
    __syncthreads();
}

typedef short bf16x8 __attribute__((ext_vector_type(8)));
typedef short s16x4 __attribute__((ext_vector_type(4)));
typedef short v4i16_t __attribute__((ext_vector_type(4)));
typedef float f32x4 __attribute__((ext_vector_type(4)));
typedef float f32x2 __attribute__((ext_vector_type(2)));
typedef __bf16 bf16x2_t __attribute__((ext_vector_type(2)));
typedef unsigned short bf16_t;
typedef unsigned u32x2 __attribute__((ext_vector_type(2)));
typedef unsigned u32x4 __attribute__((ext_vector_type(4)));
__device__ __forceinline__ unsigned pk_bf16(float lo, float hi) { return __builtin_bit_cast(unsigned, __builtin_convertvector((f32x2){lo, hi}, bf16x2_t)); }
__device__ __forceinline__ float bf2f(bf16_t v) { return __uint_as_float(((unsigned)v) << 16); }

__device__ __forceinline__ f32x4 bf4_f32(u32x2 w) { f32x4 r; r[0] = __uint_as_float(w.x << 16); r[1] = __uint_as_float(w.x & 0xffff0000u); r[2] = __uint_as_float(w.y << 16); r[3] = __uint_as_float(w.y & 0xffff0000u); return r; }
__device__ __forceinline__ s16x4 tr_read(LAS unsigned char* pa) { s16x4 r; asm volatile("ds_read_b64_tr_b16 %0, %1" : "=v"(r) : "v"(pa) : "memory"); return r; }
#define TR_WAIT8(a0, a1, a2, a3, a4, a5, a6, a7) asm volatile("s_waitcnt lgkmcnt(0)" : "+v"(a0), "+v"(a1), "+v"(a2), "+v"(a3), "+v"(a4), "+v"(a5), "+v"(a6), "+v"(a7) :: "memory")

#define GEMM_LDS_A 0
#define GEMM_LDS_B 65536
template <bool PAIR, int DEPTH, int MODE = 0, bool TILE_EPI = false, bool BBF16 = false, class ARow, class BCol, class MRows, class Epi>
__device__ __forceinline__ void gemm_stream(LAS unsigned char* lds, const unsigned char* Abase, int npass, int nk, int ldb, ARow arow, BCol bcol, MRows mrowsf, Epi epi) {
    int tid_ = threadIdx.x; asm volatile("" : "+v"(tid_));
    const int tid = tid_, wid = __builtin_amdgcn_readfirstlane(tid >> 6), lane = tid & 63;
    const int wr = wid >> 1, wc = wid & 1, fr = lane & 15, fq = lane >> 4;
    if (npass <= 0) return;
    const int S = npass * nk;
    const int Ccol = ((wid & 1) * 32 + 8 * ((lane & 3) ^ ((lane >> 5) << 1))) * 2;
    const int Rbase = 16 * (wid >> 1) + (lane >> 2);
    unsigned asrc[4];
    const int n4 = tid & 31, kb = tid >> 5;
    typedef typename std::conditional<BBF16, const bf16_t*, const float*>::type bptr_t;
    bptr_t bp;
    const int fB = ((kb & 3) << 2) | ((kb >> 2) & 3);
    const int bwoff = 256 * kb + 16 * ((n4 >> 1) ^ fB) + 8 * (n4 & 1);
    const int aoff = wr * 8192 + ((fr * 64 + fq * 16) ^ ((fr >> 3) << 5));
    const int q = (lane >> 2) & 3, pp = lane & 3;
    const int b0 = (wc * 8 + (pp >> 1)) ^ ((q << 2) | (2 * (fq & 1)));
    const int browoff = 256 * (fq * 8 + q) + 8 * (pp & 1);
#define GS_BOFF(v) (browoff + 16 * (b0 ^ (v)))
    f32x4 acc[4][4];
#pragma unroll
    for (int i = 0; i < 4; ++i)
#pragma unroll
        for (int j = 0; j < 4; ++j) acc[i][j] = (f32x4){0.f, 0.f, 0.f, 0.f};
    float4 bregX[4], bregY[4];
    int aP = 0, aK = 0, bP = 0, bK = 0;
#define GS_SETA() do { _Pragma("unroll") for (int _i = 0; _i < 4; ++_i) asrc[_i] = (unsigned)(arow(aP, Rbase + 64 * _i) + Ccol); } while (0)
#define GS_ISSUE_A(buf) do { _Pragma("unroll") for (int _i = 0; _i < 4; ++_i) \
        __builtin_amdgcn_global_load_lds((const unsigned*)(Abase + (size_t)asrc[_i] + (size_t)aK * 128), (LAS unsigned*)(lds + GEMM_LDS_A + (buf) * 32768 + _i * 8192 + wid * 1024), 16, 0, 0); \
        if (++aK == nk) { aK = 0; ++aP; if (aP < npass) GS_SETA(); } } while (0)
#define GS_LOAD_B(breg) do { _Pragma("unroll") for (int _i = 0; _i < 4; ++_i) { \
            if constexpr (BBF16) { const u32x2 _t = *(const u32x2*)(bp + (size_t)(bK * 64 + kb + 16 * _i) * ldb); breg[_i].x = __uint_as_float(_t.x); breg[_i].y = __uint_as_float(_t.y); } \
            else breg[_i] = *(const float4*)(bp + (size_t)(bK * 64 + kb + 16 * _i) * ldb); } \
        if (++bK == nk) { bK = 0; ++bP; if (bP < npass) bp = bcol(bP, n4); } } while (0)
#define GS_WRITE_B(breg, buf) do { _Pragma("unroll") for (int _i = 0; _i < 4; ++_i) { u32x2 _w; \
            if constexpr (BBF16) { _w.x = __float_as_uint(breg[_i].x); _w.y = __float_as_uint(breg[_i].y); } \
            else { _w.x = pk_bf16(breg[_i].x, breg[_i].y); _w.y = pk_bf16(breg[_i].z, breg[_i].w); } \
        *(LAS u32x2*)(lds + GEMM_LDS_B + (buf) * 16384 + bwoff + 4096 * _i) = _w; } } while (0)
#define GS_COMPUTE(buf) do { _Pragma("unroll") for (int ks = 0; ks < 2; ++ks) { \
            bf16x8 af[4]; s16x4 tl0, tl1, tl2, tl3, th0, th1, th2, th3; \
            LAS unsigned char* bb_ = lds + GEMM_LDS_B + (buf) * 16384 + ks * 8192; \
            tl0 = tr_read(bb_ + GS_BOFF(0)); th0 = tr_read(bb_ + 1024 + GS_BOFF(1)); tl1 = tr_read(bb_ + GS_BOFF(2)); th1 = tr_read(bb_ + 1024 + GS_BOFF(3)); \
            tl2 = tr_read(bb_ + GS_BOFF(4)); th2 = tr_read(bb_ + 1024 + GS_BOFF(5)); tl3 = tr_read(bb_ + GS_BOFF(6)); th3 = tr_read(bb_ + 1024 + GS_BOFF(7)); \
            _Pragma("unroll") for (int mi = 0; mi < 4; ++mi) af[mi] = *(const LAS bf16x8*)(lds + GEMM_LDS_A + (buf) * 32768 + aoff + mi * 2048 + ks * 1024); \
            TR_WAIT8(tl0, th0, tl1, th1, tl2, th2, tl3, th3); \
            bf16x8 bfr[4]; \
            bfr[0] = (bf16x8){tl0[0], tl0[1], tl0[2], tl0[3], th0[0], th0[1], th0[2], th0[3]}; bfr[1] = (bf16x8){tl1[0], tl1[1], tl1[2], tl1[3], th1[0], th1[1], th1[2], th1[3]}; \
            bfr[2] = (bf16x8){tl2[0], tl2[1], tl2[2], tl2[3], th2[0], th2[1], th2[2], th2[3]}; bfr[3] = (bf16x8){tl3[0], tl3[1], tl3[2], tl3[3], th3[0], th3[1], th3[2], th3[3]}; \
            _Pragma("unroll") for (int mi = 0; mi < 4; ++mi) _Pragma("unroll") for (int ni = 0; ni < 4; ++ni) \
                acc[mi][ni] = __builtin_amdgcn_mfma_f32_16x16x32_bf16(bfr[ni], af[mi], acc[mi][ni], 0, 0, 0); } } while (0)
#define GS_STEP(CUR, NXT, BREG_LD, BREG_WR) do { \
        if (MODE != 2 && s + DEPTH < S) GS_LOAD_B(BREG_LD); \
        if (MODE != 3 && s + 1 < S) GS_ISSUE_A(NXT); \
        __builtin_amdgcn_sched_barrier(0); \
        if (MODE != 1 && active) GS_COMPUTE(CUR); \
        __builtin_amdgcn_sched_barrier(0); \
        if (s + 1 < S) GS_WRITE_B(BREG_WR, NXT); \
        const bool pass_end = (cK + 1 == nk); \
        if (++cK == nk) { \
            if constexpr (TILE_EPI) { if (active) epi(cP, wr * 64 + fr, wc * 64 + fq * 4, cm, acc); } else \
            if (active) { \
                _Pragma("unroll") for (int mi = 0; mi < 4; ++mi) { const int r = wr * 64 + mi * 16 + fr; \
                    if (r < cm) { \
                        if constexpr (PAIR) { _Pragma("unroll") for (int ni = 0; ni < 2; ++ni) { epi(cP, r, wc * 64 + ni * 16 + fq * 4, acc[mi][ni], acc[mi][ni + 2]); } } \
                        else { _Pragma("unroll") for (int ni = 0; ni < 4; ++ni) { epi(cP, r, wc * 64 + ni * 16 + fq * 4, acc[mi][ni]); } } } } } \
            _Pragma("unroll") for (int i = 0; i < 4; ++i) _Pragma("unroll") for (int j = 0; j < 4; ++j) acc[i][j] = (f32x4){0.f, 0.f, 0.f, 0.f}; \
            cK = 0; ++cP; if (cP < npass) { cm = mrowsf(cP); active = (wr * 64) < cm; } \
        } \
        asm volatile("s_waitcnt lgkmcnt(0)" ::: "memory"); \
        if (DEPTH >= 2 && (s + DEPTH < S) && !pass_end) asm volatile("s_waitcnt vmcnt(4)" ::: "memory"); else asm volatile("s_waitcnt vmcnt(0)" ::: "memory"); \
        asm volatile("" ::: "memory"); __builtin_amdgcn_s_barrier(); asm volatile("" ::: "memory"); ++s; } while (0)
    int cP = 0, cK = 0, cm = mrowsf(0);
    bool active = (wr * 64) < cm;
    GS_SETA(); bp = bcol(0, n4);
    GS_ISSUE_A(0); GS_LOAD_B(bregX);
    GS_WRITE_B(bregX, 0);
    if constexpr (DEPTH >= 2) { if (1 < S) GS_LOAD_B(bregY); }
    static_assert(DEPTH == 1 || DEPTH == 2, "B prefetch depth");
    asm volatile("s_waitcnt lgkmcnt(0)" ::: "memory");
    asm volatile("s_waitcnt vmcnt(%0)" :: "n"((DEPTH - 1) * 4) : "memory");
    __syncthreads();
    int s = 0;
    if constexpr (DEPTH == 1) {
        while (s < S) { GS_STEP(0, 1, bregX, bregX); if (s >= S) break; GS_STEP(1, 0, bregX, bregX); }
    } else if constexpr (DEPTH == 2) {
        while (s < S) { GS_STEP(0, 1, bregX, bregY); if (s >= S) break; GS_STEP(1, 0, bregY, bregX); }
    }
#undef GS_SETA
#undef GS_BOFF
#undef GS_ISSUE_A
#undef GS_LOAD_B
#undef GS_WRITE_B
#undef GS_COMPUTE
#undef GS_STEP
}


template <class ARow, class BCol, class MRows, class Epi>
__device__ __forceinline__ void gemm_stream_rs(LAS unsigned char* lds, const unsigned char* Abase, int npass, int nk, int ldb, ARow arow, BCol bcol, MRows mrowsf, Epi epi) {
    int tid_ = threadIdx.x; asm volatile("" : "+v"(tid_));
    const int tid = tid_, wid = __builtin_amdgcn_readfirstlane(tid >> 6), lane = tid & 63;
    const int wr = wid >> 1, wc = wid & 1, fr = lane & 15, fq = lane >> 4;
    if (npass <= 0) return;
    const int S = npass * nk;
    const int Ccol = ((wid & 1) * 32 + 8 * ((lane & 3) ^ ((lane >> 5) << 1))) * 2;
    const int Rbase = 16 * (wid >> 1) + (lane >> 2);
    unsigned asrc[4];
    const int n4 = tid & 31, kb = tid >> 5;
    const float* bp;
    const int fB = ((kb & 3) << 2) | ((kb >> 2) & 3);
    const int bwoff = 256 * kb + 16 * ((n4 >> 1) ^ fB) + 8 * (n4 & 1);
    const int awoff = wid * 1024 + lane * 16;
    const int aoff = wr * 8192 + ((fr * 64 + fq * 16) ^ ((fr >> 3) << 5));
    const int q = (lane >> 2) & 3, pp = lane & 3;
    const int b0 = (wc * 8 + (pp >> 1)) ^ ((q << 2) | (2 * (fq & 1)));
    const int browoff = 256 * (fq * 8 + q) + 8 * (pp & 1);
#define RS_BOFF(v) (browoff + 16 * (b0 ^ (v)))
    f32x4 acc[4][4];
#pragma unroll
    for (int i = 0; i < 4; ++i)
#pragma unroll
        for (int j = 0; j < 4; ++j) acc[i][j] = (f32x4){0.f, 0.f, 0.f, 0.f};
    f32x4 bX[4], bY[4]; u32x4 aX[4], aY[4];
    int aP = 0, aK = 0, bP = 0, bK = 0;
#define RS_SETA() do { _Pragma("unroll") for (int _i = 0; _i < 4; ++_i) asrc[_i] = (unsigned)(arow(aP, Rbase + 64 * _i) + Ccol); } while (0)
#define RS_LOAD(AR, BR) do { \
        _Pragma("unroll") for (int _i = 0; _i < 4; ++_i) AR[_i] = *(const u32x4*)(Abase + (size_t)asrc[_i] + (size_t)aK * 128); \
        _Pragma("unroll") for (int _i = 0; _i < 4; ++_i) BR[_i] = *(const f32x4*)(bp + (size_t)(bK * 64 + kb + 16 * _i) * ldb); \
        if (++aK == nk) { aK = 0; if (aP + 1 < npass) { ++aP; RS_SETA(); } } \
        if (++bK == nk) { bK = 0; if (bP + 1 < npass) { ++bP; bp = bcol(bP, n4); } } } while (0)
#define RS_WRITE(AR, BR, buf) do { \
        _Pragma("unroll") for (int _i = 0; _i < 4; ++_i) *(LAS u32x4*)(lds + GEMM_LDS_A + (buf) * 32768 + _i * 8192 + awoff) = AR[_i]; \
        _Pragma("unroll") for (int _i = 0; _i < 4; ++_i) { u32x2 _w; _w.x = pk_bf16(BR[_i][0], BR[_i][1]); _w.y = pk_bf16(BR[_i][2], BR[_i][3]); \
            *(LAS u32x2*)(lds + GEMM_LDS_B + (buf) * 16384 + bwoff + 4096 * _i) = _w; } } while (0)
#define RS_COMPUTE(buf) do { _Pragma("unroll") for (int ks = 0; ks < 2; ++ks) { \
            bf16x8 af[4]; s16x4 tl0, tl1, tl2, tl3, th0, th1, th2, th3; \
            LAS unsigned char* bb_ = lds + GEMM_LDS_B + (buf) * 16384 + ks * 8192; \
            tl0 = tr_read(bb_ + RS_BOFF(0)); th0 = tr_read(bb_ + 1024 + RS_BOFF(1)); tl1 = tr_read(bb_ + RS_BOFF(2)); th1 = tr_read(bb_ + 1024 + RS_BOFF(3)); \
            tl2 = tr_read(bb_ + RS_BOFF(4)); th2 = tr_read(bb_ + 1024 + RS_BOFF(5)); tl3 = tr_read(bb_ + RS_BOFF(6)); th3 = tr_read(bb_ + 1024 + RS_BOFF(7)); \
            _Pragma("unroll") for (int mi = 0; mi < 4; ++mi) af[mi] = *(const LAS bf16x8*)(lds + GEMM_LDS_A + (buf) * 32768 + aoff + mi * 2048 + ks * 1024); \
            TR_WAIT8(tl0, th0, tl1, th1, tl2, th2, tl3, th3); \
            bf16x8 bfr[4]; \
            bfr[0] = (bf16x8){tl0[0], tl0[1], tl0[2], tl0[3], th0[0], th0[1], th0[2], th0[3]}; bfr[1] = (bf16x8){tl1[0], tl1[1], tl1[2], tl1[3], th1[0], th1[1], th1[2], th1[3]}; \
            bfr[2] = (bf16x8){tl2[0], tl2[1], tl2[2], tl2[3], th2[0], th2[1], th2[2], th2[3]}; bfr[3] = (bf16x8){tl3[0], tl3[1], tl3[2], tl3[3], th3[0], th3[1], th3[2], th3[3]}; \
            _Pragma("unroll") for (int mi = 0; mi < 4; ++mi) _Pragma("unroll") for (int ni = 0; ni < 4; ++ni) \
                acc[mi][ni] = __builtin_amdgcn_mfma_f32_16x16x32_bf16(bfr[ni], af[mi], acc[mi][ni], 0, 0, 0); } } while (0)
#define RS_STEP(CUR, NXT, A_LD, B_LD, A_WR, B_WR) do { \
        RS_LOAD(A_LD, B_LD); \
        __builtin_amdgcn_sched_barrier(0); \
        if (active) RS_COMPUTE(CUR); \
        __builtin_amdgcn_sched_barrier(0); \
        RS_WRITE(A_WR, B_WR, NXT); \
        if (++cK == nk) { \
            if (active) epi(cP, wr * 64 + fr, wc * 64 + fq * 4, cm, acc); \
            _Pragma("unroll") for (int i = 0; i < 4; ++i) _Pragma("unroll") for (int j = 0; j < 4; ++j) acc[i][j] = (f32x4){0.f, 0.f, 0.f, 0.f}; \
            cK = 0; ++cP; if (cP < npass) { cm = mrowsf(cP); active = (wr * 64) < cm; } \
        } \
        asm volatile("s_waitcnt lgkmcnt(0)" ::: "memory"); \
        asm volatile("" ::: "memory"); __builtin_amdgcn_s_barrier(); asm volatile("" ::: "memory"); ++s; } while (0)
    int cP = 0, cK = 0, cm = mrowsf(0);
    bool active = (wr * 64) < cm;
    RS_SETA(); bp = bcol(0, n4);
    RS_LOAD(aX, bX); RS_WRITE(aX, bX, 0);
    RS_LOAD(aY, bY);
    asm volatile("s_waitcnt lgkmcnt(0)" ::: "memory");
    __syncthreads();
    int s = 0;
    while (s < S) { RS_STEP(0, 1, aX, bX, aY, bY); if (s >= S) break; RS_STEP(1, 0, aY, bY, aX, bX); }
#undef RS_BOFF
#undef RS_SETA
#undef RS_LOAD
#undef RS_WRITE
#undef RS_COMPUTE
#undef RS_STEP
}

namespace pg8 {
#define PG8_LAS __attribute__((address_space(3)))
typedef unsigned short bf16_t;
typedef short bf16x8 __attribute__((ext_vector_type(8)));
typedef float f32x4 __attribute__((ext_vector_type(4)));
typedef unsigned u32x4 __attribute__((ext_vector_type(4)));
constexpr int BM = 256, BK = 64, HALF = 128, HTB = HALF * BK * 2  , STAGE_BYTES = 8 * HTB, NXCD = 8, WGM = 8;

__host__ __device__ __forceinline__ int lds_byte(int r, int c) { const int st = (r >> 4) * 2 + (c >> 5), rr = r & 15, cc = c & 31, ob = rr * 64 + cc * 2; return st * 1024 + (ob ^ (((ob >> 9) & 1) << 5)); }
__host__ __device__ __forceinline__ void stage_rc(int b, int& R, int& C) { const int st = b / 1024, sb = b % 1024, swz = sb ^ (((sb >> 9) & 1) << 5); R = (st >> 1) * 16 + swz / 64; C = (st & 1) * 32 + (swz % 64) / 2; }
__host__ __device__ __forceinline__ int perm32(int rho) { const int n = rho >> 4, i = rho & 15; return 8 * (i >> 2) + 4 * n + (i & 3); }

struct Unit { int pm, pn; };
struct Gemm { const bf16_t* A; const bf16_t* Bt; int M, N, K; };

struct StaticOrder {
    int nM, nN, nwg, G, c;
    __host__ __device__ void init(int M, int N, int G_, int c_) { nM = M / BM; nN = N / BM; nwg = nM * nN; G = G_; c = c_; }
    __host__ __device__ bool next(int i, Unit& u) const {
        const long L = (long)i * G + c; if (L >= nwg) return false;
        int wgid = (int)L; { const int q = nwg / NXCD, r = nwg % NXCD, xcd = wgid % NXCD, off = wgid / NXCD; wgid = (xcd < r ? xcd * (q + 1) : r * (q + 1) + (xcd - r) * q) + off; }
        const int nig = WGM * nN, gid = wgid / nig, fm = gid * WGM, gsz = (nM - fm) < WGM ? (nM - fm) : WGM;
        u.pm = fm + ((wgid % nig) % gsz); u.pn = (wgid % nig) / gsz; return true;
    }
    __device__ __forceinline__ void a_ready(const Unit&) const {}
    __device__ __forceinline__ void done(const Unit&) const {}
};
template <class Epi, class Sched>
__device__ __forceinline__ void gemm_phase(PG8_LAS unsigned char* lds, const Gemm g, const Sched& S, const Epi& E) {
    int tid_l = threadIdx.x; asm volatile("" : "+v"(tid_l));
    const int tid = tid_l, wid = __builtin_amdgcn_readfirstlane(tid >> 6), lane = tid & 63, wr = wid >> 2, wc = wid & 3, fr = lane & 15, fq = lane >> 4;
    const int K = g.K, nt = K / BK;

    unsigned voffA[2], voffB[2];
#pragma unroll
    for (int i = 0; i < 2; ++i) { int R, C; stage_rc(tid * 16 + i * 8192, R, C); const int Rb = Epi::PERM ? ((R & ~31) + perm32(R & 31)) : R;
        voffA[i] = (unsigned)(R * K + C) * 2u; voffB[i] = (unsigned)(Rb * K + C) * 2u; }
    const size_t kstep = (size_t)(BK * 2);
    const size_t hstep = (size_t)HALF * K * 2;
    const size_t tstep = 2 * hstep;
    const unsigned ldsw = (unsigned)wid * 1024u;
    const int aoff = lds_byte(wr * 64 + fr, fq * 8), boff = lds_byte(wc * 32 + fr, fq * 8);
#define PG8_SA(b, h) (((b) * 2 + (h)) * HTB)
#define PG8_SB(b, h) ((4 + (b) * 2 + (h)) * HTB)
#define PG8_STAGE(bufoff, gbase, voff) do { _Pragma("unroll") for (int _i = 0; _i < 2; ++_i) \
        __builtin_amdgcn_global_load_lds((const unsigned*)((const char*)(gbase) + (voff)[_i]), (PG8_LAS unsigned*)(lds + (bufoff) + ldsw + _i * 8192), 16, 0, 0); } while (0)
#define PG8_LDA(dst, b, h) do { _Pragma("unroll") for (int m = 0; m < 4; ++m) _Pragma("unroll") for (int k = 0; k < 2; ++k) dst[m][k] = *(const PG8_LAS bf16x8*)(lds + PG8_SA(b, h) + aoff + m * 2048 + k * 1024); } while (0)
#define PG8_LDB(dst, b, h) do { _Pragma("unroll") for (int n = 0; n < 2; ++n) _Pragma("unroll") for (int k = 0; k < 2; ++k) dst[n][k] = *(const PG8_LAS bf16x8*)(lds + PG8_SB(b, h) + boff + n * 2048 + k * 1024); } while (0)
#define PG8_MMA(ai, bj, At, Bt) do { __builtin_amdgcn_s_setprio(1); _Pragma("unroll") for (int m = 0; m < 4; ++m) _Pragma("unroll") for (int n = 0; n < 2; ++n) _Pragma("unroll") for (int k = 0; k < 2; ++k) \
        acc[ai][bj][m][n] = __builtin_amdgcn_mfma_f32_16x16x32_bf16(Bt[n][k], At[m][k], acc[ai][bj][m][n], 0, 0, 0); __builtin_amdgcn_s_setprio(0); } while (0)
#define PG8_WAIT_V(n) asm volatile("s_waitcnt vmcnt(" #n ")" ::: "memory")
#define PG8_WAIT_L(n) asm volatile("s_waitcnt lgkmcnt(" #n ")" ::: "memory")
#define PG8_BAR __builtin_amdgcn_s_barrier()
#define PG8_SCHED __builtin_amdgcn_sched_barrier(0)
    Unit cur, nxt; int ui = 0;
    if (!S.next(0, cur)) return;
    f32x4 acc[2][2][4][2];
#pragma unroll
    for (int a = 0; a < 2; ++a)
#pragma unroll
        for (int b = 0; b < 2; ++b)
#pragma unroll
            for (int m = 0; m < 4; ++m)
#pragma unroll
                for (int n = 0; n < 2; ++n) acc[a][b][m][n] = (f32x4){0.f, 0.f, 0.f, 0.f};
    bf16x8 At[4][2], B0[2][2], B1[2][2];
    const char* cA = (const char*)g.A + (size_t)cur.pm * tstep; const char* cB = (const char*)g.Bt + (size_t)cur.pn * tstep;
    S.a_ready(cur);
    PG8_STAGE(PG8_SB(0, 0), cB, voffB); PG8_STAGE(PG8_SA(0, 0), cA, voffA); PG8_STAGE(PG8_SB(0, 1), cB + hstep, voffB); PG8_STAGE(PG8_SA(0, 1), cA + hstep, voffA);
    if (wr == 1) PG8_BAR;
    PG8_WAIT_V(4); PG8_BAR;
    PG8_STAGE(PG8_SB(1, 0), cB + kstep, voffB); PG8_STAGE(PG8_SA(1, 0), cA + kstep, voffA); PG8_STAGE(PG8_SB(1, 1), cB + hstep + kstep, voffB);
    PG8_WAIT_V(6); PG8_BAR;

    for (;;) {
        const bool has_next = S.next(ui + 1, nxt);
        const char* nA = has_next ? (const char*)g.A + (size_t)nxt.pm * tstep : cA; const char* nB = has_next ? (const char*)g.Bt + (size_t)nxt.pn * tstep : cB;
        for (int t = 0; t < nt; t += 2) {
            const bool last = (t == nt - 2);
            const char* a1 = cA + (size_t)(t + 1) * kstep;
            const char* a2 = last ? nA : cA + (size_t)(t + 2) * kstep; const char* b2 = last ? nB : cB + (size_t)(t + 2) * kstep;
            const char* a3 = a2 + kstep; const char* b3 = b2 + kstep;
            if (last && has_next) S.a_ready(nxt);
            PG8_LDB(B0, 0, 0); PG8_SCHED; PG8_LDA(At, 0, 0); PG8_STAGE(PG8_SA(1, 1), a1 + hstep, voffA);
            PG8_WAIT_L(8); PG8_BAR; PG8_WAIT_L(0); PG8_MMA(0, 0, At, B0); PG8_BAR; PG8_SCHED;
            PG8_LDB(B1, 0, 1); PG8_STAGE(PG8_SB(0, 0), b2, voffB);
            PG8_BAR; PG8_WAIT_L(0); PG8_MMA(0, 1, At, B1); PG8_BAR;
            PG8_LDA(At, 0, 1); PG8_STAGE(PG8_SA(0, 0), a2, voffA);
            PG8_BAR; PG8_WAIT_L(0); PG8_MMA(1, 0, At, B0); PG8_BAR; PG8_SCHED;
            PG8_STAGE(PG8_SB(0, 1), b2 + hstep, voffB);
            PG8_WAIT_V(6); PG8_BAR; PG8_MMA(1, 1, At, B1); PG8_BAR;
            PG8_LDB(B0, 1, 0); PG8_SCHED; PG8_LDA(At, 1, 0); PG8_STAGE(PG8_SA(0, 1), a2 + hstep, voffA);
            PG8_WAIT_L(8); PG8_BAR; PG8_WAIT_L(0); PG8_MMA(0, 0, At, B0); PG8_BAR; PG8_SCHED;
            PG8_LDB(B1, 1, 1); PG8_STAGE(PG8_SB(1, 0), b3, voffB);
            PG8_BAR; PG8_WAIT_L(0); PG8_MMA(0, 1, At, B1); PG8_BAR;
            PG8_LDA(At, 1, 1); PG8_STAGE(PG8_SA(1, 0), a3, voffA);
            PG8_BAR; PG8_WAIT_L(0); PG8_MMA(1, 0, At, B0); PG8_BAR; PG8_SCHED;
            PG8_STAGE(PG8_SB(1, 1), b3 + hstep, voffB);
            PG8_WAIT_V(6); PG8_BAR; PG8_MMA(1, 1, At, B1); PG8_BAR;
        }

        if constexpr (!Epi::AFTER_DRAIN) { E(acc, cur, wr, wc, fr, fq); S.done(cur); }

        if (!has_next) break;
#pragma unroll
        for (int a = 0; a < 2; ++a)
#pragma unroll
            for (int b = 0; b < 2; ++b)
#pragma unroll
                for (int m = 0; m < 4; ++m)
#pragma unroll
                    for (int n = 0; n < 2; ++n) acc[a][b][m][n] = (f32x4){0.f, 0.f, 0.f, 0.f};
        cur = nxt; cA = nA; cB = nB; ++ui;
    }
    PG8_WAIT_V(0);
    if (wr == 0) PG8_BAR;
    PG8_BAR;
    if constexpr (Epi::AFTER_DRAIN) { E.fused(acc, cur, wr, wc, fr, fq, lds, wid, lane); S.done(cur); }

#undef PG8_SA
#undef PG8_SB
#undef PG8_STAGE
#undef PG8_LDA
#undef PG8_LDB
#undef PG8_MMA
#undef PG8_WAIT_V
#undef PG8_WAIT_L
#undef PG8_BAR
#undef PG8_SCHED
}
}
template <class F> struct EpiWrap {
    static constexpr bool PERM = false, AFTER_DRAIN = false; F f;
    __device__ __forceinline__ void operator()(const f32x4 (&acc)[2][2][4][2], const pg8::Unit& u, int wr, int wc, int fr, int fq) const { f(acc, u, wr, wc, fr, fq); }
};
template <class F> __device__ __forceinline__ EpiWrap<F> make_epi(F f) { return EpiWrap<F>{f}; }
template <class F> struct EpiWrapP {
    static constexpr bool PERM = true, AFTER_DRAIN = false; F f;
    __device__ __forceinline__ void operator()(const f32x4 (&acc)[2][2][4][2], const pg8::Unit& u, int wr, int wc, int fr, int fq) const { f(acc, u, wr, wc, fr, fq); }
};
template <class F> __device__ __forceinline__ EpiWrapP<F> make_epi_p(F f) { return EpiWrapP<F>{f}; }

__device__ __forceinline__ void transpose_item(const float* W, int K, int N, int Npad, bf16_t* WT, LAS float* scr, int item, int lane) {
    const int nblk = Npad / 32, kb = item / nblk, nb_ = item % nblk, k0 = 64 * kb, n0 = 32 * nb_;
#pragma unroll 8
    for (int i = 0; i < 32; ++i) { const int kk = 2 * i + (lane >> 5), n = n0 + (lane & 31); scr[kk * 33 + (lane & 31)] = n < N ? W[(size_t)(k0 + kk) * N + n] : 0.f; }
    asm volatile("s_waitcnt lgkmcnt(0)" ::: "memory");
    const int c = lane & 7;
#pragma unroll
    for (int j = 0; j < 4; ++j) { const int n = (lane >> 3) + 8 * j; const LAS float* sp = scr + (8 * c) * 33 + n;
        u32x4 o; o[0] = pk_bf16(sp[0 * 33], sp[1 * 33]); o[1] = pk_bf16(sp[2 * 33], sp[3 * 33]); o[2] = pk_bf16(sp[4 * 33], sp[5 * 33]); o[3] = pk_bf16(sp[6 * 33], sp[7 * 33]);
        *(u32x4*)(WT + (size_t)(n0 + n) * K + k0 + 8 * c) = o; }
    asm volatile("s_waitcnt lgkmcnt(0)" ::: "memory");
}

template <class ARow, class BCol, class MRows, class Epi>
__device__ __forceinline__ void gemm_stream_ws(LAS unsigned char* lds, const unsigned char* Abase, int npass, int nk, int ldb, ARow arow, BCol bcol, MRows mrowsf, Epi epi) {
    int tid_ = threadIdx.x; asm volatile("" : "+v"(tid_));
    const int tid = tid_, wid = __builtin_amdgcn_readfirstlane(tid >> 6), lane = tid & 63;
    if (npass <= 0) return;
    const int S = npass * nk;
#define WS_BAR() do { asm volatile("s_waitcnt lgkmcnt(0)" ::: "memory"); __builtin_amdgcn_s_barrier(); asm volatile("" ::: "memory"); } while (0)
    if (wid < 4) {
        const int wr2 = wid >> 1, wc = wid & 1, fr = lane & 15, fq = lane >> 4;
        const int aoff = wr2 * 16384 + ((fr * 64 + fq * 16) ^ ((fr >> 3) << 5));
        const int q = (lane >> 2) & 3, pp = lane & 3;
        const int b0 = (wc * 8 + (pp >> 1)) ^ ((q << 2) | (2 * (fq & 1)));
        const int browoff = 256 * (fq * 8 + q) + 8 * (pp & 1);
#define WS_BOFF(v) (browoff + 16 * (b0 ^ (v)))
        f32x4 acc[8][4];
#pragma unroll
        for (int i = 0; i < 8; ++i)
#pragma unroll
            for (int j = 0; j < 4; ++j) acc[i][j] = (f32x4){0.f, 0.f, 0.f, 0.f};
        int cP = 0, cK = 0, cm = mrowsf(0);
        bool active = (wr2 * 128) < cm;
#define WS_COMPUTE(buf) do { _Pragma("unroll") for (int ks = 0; ks < 2; ++ks) { \
            bf16x8 af[8]; s16x4 tl0, tl1, tl2, tl3, th0, th1, th2, th3; \
            LAS unsigned char* bb_ = lds + GEMM_LDS_B + (buf) * 16384 + ks * 8192; \
            tl0 = tr_read(bb_ + WS_BOFF(0)); th0 = tr_read(bb_ + 1024 + WS_BOFF(1)); tl1 = tr_read(bb_ + WS_BOFF(2)); th1 = tr_read(bb_ + 1024 + WS_BOFF(3)); \
            tl2 = tr_read(bb_ + WS_BOFF(4)); th2 = tr_read(bb_ + 1024 + WS_BOFF(5)); tl3 = tr_read(bb_ + WS_BOFF(6)); th3 = tr_read(bb_ + 1024 + WS_BOFF(7)); \
            _Pragma("unroll") for (int mi = 0; mi < 8; ++mi) af[mi] = *(const LAS bf16x8*)(lds + GEMM_LDS_A + (buf) * 32768 + aoff + mi * 2048 + ks * 1024); \
            TR_WAIT8(tl0, th0, tl1, th1, tl2, th2, tl3, th3); \
            bf16x8 bfr[4]; \
            bfr[0] = (bf16x8){tl0[0], tl0[1], tl0[2], tl0[3], th0[0], th0[1], th0[2], th0[3]}; bfr[1] = (bf16x8){tl1[0], tl1[1], tl1[2], tl1[3], th1[0], th1[1], th1[2], th1[3]}; \
            bfr[2] = (bf16x8){tl2[0], tl2[1], tl2[2], tl2[3], th2[0], th2[1], th2[2], th2[3]}; bfr[3] = (bf16x8){tl3[0], tl3[1], tl3[2], tl3[3], th3[0], th3[1], th3[2], th3[3]}; \
            _Pragma("unroll") for (int mi = 0; mi < 8; ++mi) _Pragma("unroll") for (int ni = 0; ni < 4; ++ni) \
                acc[mi][ni] = __builtin_amdgcn_mfma_f32_16x16x32_bf16(bfr[ni], af[mi], acc[mi][ni], 0, 0, 0); } } while (0)
#define WS_CSTEP(CUR) do { \
            if (active) WS_COMPUTE(CUR); \
            if (++cK == nk) { \
                if (active) epi(cP, wr2 * 128 + fr, wc * 64 + fq * 4, cm, acc); \
                _Pragma("unroll") for (int i = 0; i < 8; ++i) _Pragma("unroll") for (int j = 0; j < 4; ++j) acc[i][j] = (f32x4){0.f, 0.f, 0.f, 0.f}; \
                cK = 0; ++cP; if (cP < npass) { cm = mrowsf(cP); active = (wr2 * 128) < cm; } \
            } \
            WS_BAR(); ++s; } while (0)
        WS_BAR();
        int s = 0;
        while (s < S) { WS_CSTEP(0); if (s >= S) break; WS_CSTEP(1); }
#undef WS_BOFF
#undef WS_COMPUTE
#undef WS_CSTEP
    } else {
        const int pt = tid - 256;
        const int Ccol = (((pt >> 6) & 1) * 32 + 8 * ((lane & 3) ^ ((lane >> 5) << 1))) * 2;
        const int Rbase = 16 * (pt >> 7) + (lane >> 2);
        unsigned asrc[8];
        const int n4 = pt & 31, kb8 = pt >> 5;
        const float* bp;
        int bwoff[2];
#pragma unroll
        for (int par = 0; par < 2; ++par) { const int row = kb8 + 8 * par; const int fB = ((row & 3) << 2) | ((row >> 2) & 3); bwoff[par] = 256 * row + 16 * ((n4 >> 1) ^ fB) + 8 * (n4 & 1); }
        const int awoff = pt * 16;
        f32x4 bX[8], bY[8]; u32x4 aX[8], aY[8];
        int aP = 0, aK = 0, bP = 0, bK = 0;
#define WS_SETA() do { _Pragma("unroll") for (int _i = 0; _i < 8; ++_i) asrc[_i] = (unsigned)(arow(aP, Rbase + 32 * _i) + Ccol); } while (0)
#define WS_LOAD(AR, BR) do { \
            _Pragma("unroll") for (int _i = 0; _i < 8; ++_i) AR[_i] = *(const u32x4*)(Abase + (size_t)asrc[_i] + (size_t)aK * 128); \
            _Pragma("unroll") for (int _i = 0; _i < 8; ++_i) BR[_i] = *(const f32x4*)(bp + (size_t)(bK * 64 + kb8 + 8 * _i) * ldb); \
            if (++aK == nk) { aK = 0; if (aP + 1 < npass) { ++aP; WS_SETA(); } } \
            if (++bK == nk) { bK = 0; if (bP + 1 < npass) { ++bP; bp = bcol(bP, n4); } } } while (0)
#define WS_WRITE(AR, BR, buf) do { \
            _Pragma("unroll") for (int _i = 0; _i < 8; ++_i) *(LAS u32x4*)(lds + GEMM_LDS_A + (buf) * 32768 + _i * 4096 + awoff) = AR[_i]; \
            _Pragma("unroll") for (int _i = 0; _i < 8; ++_i) { u32x2 _w; _w.x = pk_bf16(BR[_i][0], BR[_i][1]); _w.y = pk_bf16(BR[_i][2], BR[_i][3]); \
                *(LAS u32x2*)(lds + GEMM_LDS_B + (buf) * 16384 + bwoff[_i & 1] + 4096 * (_i >> 1)) = _w; } } while (0)
#define WS_PSTEP(NXT, A_LD, B_LD, A_WR, B_WR) do { WS_LOAD(A_LD, B_LD); WS_WRITE(A_WR, B_WR, NXT); WS_BAR(); ++s; } while (0)
        WS_SETA(); bp = bcol(0, n4);
        WS_LOAD(aX, bX); WS_WRITE(aX, bX, 0);
        WS_LOAD(aY, bY);
        WS_BAR();
        int s = 0;
        while (s < S) { WS_PSTEP(1, aX, bX, aY, bY); if (s >= S) break; WS_PSTEP(0, aY, bY, aX, bX); }
#undef WS_SETA
#undef WS_LOAD
#undef WS_WRITE
#undef WS_PSTEP
    }
#undef WS_BAR
}

struct XcdDeal { int lo, step, n; };
#define TOPO_OFF (LDS_MISC + 16)
__device__ __forceinline__ XcdDeal xcd_deal(int U, const LAS unsigned char* lds, int nb) {
    const LAS int* tp_ = (const LAS int*)(lds + TOPO_OFF);
    const int px = tp_[0], cx = tp_[1], rank = tp_[2];
    XcdDeal d;
    const int xlo = (int)((long)px * U / nb), xhi = (int)((long)(px + cx) * U / nb);
    d.lo = xlo + rank; d.step = cx; d.n = (xhi - xlo - rank + cx - 1) / cx; if (d.n < 0) d.n = 0;
    return d;
}

__device__ __forceinline__ void phase0(const Params& p, int bid, int nb, float* smem, LAS unsigned char* smem_las) {
    const float* c = p.in[1]; const float* w_ada = p.in[2]; const float* b_ada = p.in[3];
    float* mod = (float*)(p.ws + WS_MOD);
    const int tid = threadIdx.x;
    float* sc = smem;
    float* red = smem + 2048;
    for (int i = tid; i < 2048; i += NT) { const float cv = c[i]; sc[i] = cv / (1.f + expf(-cv)); }
    __syncthreads();
    {
        const int cq = tid & 7, kg = tid >> 3;
        for (int u = bid; u < 192; u += nb) {
            const float* wp = w_ada + (size_t)(kg * 16) * 6144 + u * 32 + cq * 4;
            f32x4 wv[16];
#pragma unroll
            for (int i = 0; i < 16; ++i) wv[i] = *(const f32x4*)(wp + (size_t)i * 6144);
            f32x4 a0 = (f32x4){0.f, 0.f, 0.f, 0.f}, a1 = (f32x4){0.f, 0.f, 0.f, 0.f};
#pragma unroll
            for (int i = 0; i < 16; ++i) { a0 += sc[kg * 16 + i] * wv[i]; a1 += sc[1024 + kg * 16 + i] * wv[i]; }
            *(f32x4*)(red + (kg * 2 + 0) * 32 + cq * 4) = a0; *(f32x4*)(red + (kg * 2 + 1) * 32 + cq * 4) = a1;
            __syncthreads();
            if (tid < 64) {
                const int bb = tid >> 5, col = tid & 31; float sacc = 0.f;
#pragma unroll 16
                for (int g2 = 0; g2 < 64; ++g2) sacc += red[(g2 * 2 + bb) * 32 + col];
                mod[bb * 6144 + u * 32 + col] = sacc + b_ada[u * 32 + col];
            }
            __syncthreads();
        }
    }
    {
        const float* conv_w = p.in[12]; const float* conv_b = p.in[13]; const float* wa = p.in[14]; const float* ba = p.in[15]; const float* wx = p.in[16]; const float* bx = p.in[17];
        float* BG = (float*)(p.ws + WS_BG); float* GB = (float*)(p.ws + WS_GBIAS);
        for (int idx = bid * NT + tid; idx < 8 * 256 * 128; idx += nb * NT) {
            const int n = idx & 127, k = (idx >> 7) & 255, hb = idx >> 15;
            const int w = k >> 6, i = k & 63, j = (n >> 6) * 32 + ((n >> 2) & 3) * 8 + ((n >> 4) & 1) * 4 + (n & 3);
            const float* W = ((n >> 5) & 1) ? wx : wa;
            BG[idx] = conv_w[w * 512 + hb * 64 + i] * W[(hb * 64 + i) * 64 + j];
        }
        for (int idx = bid * NT + tid; idx < 8 * 128; idx += nb * NT) {
            const int n = idx & 127, hb = idx >> 7, j = (n >> 6) * 32 + ((n >> 2) & 3) * 8 + ((n >> 4) & 1) * 4 + (n & 3);
            const bool isx = (n >> 5) & 1; const float* W = isx ? wx : wa;
            float acc = isx ? bx[hb * 64 + j] : ba[hb * 64 + j];
            for (int i = 0; i < 64; ++i) acc += conv_b[hb * 64 + i] * W[(hb * 64 + i) * 64 + j];
            GB[idx] = acc;
        }
        float* CB = (float*)(p.ws + WS_CBIAS); const float* pos = p.in[6];
        for (int idx = bid * NW + (tid >> 6); idx < 128; idx += nb * NW) {
            const int kv = idx >> 6, j = idx & 63; const float* w1 = kv ? p.in[9] : p.in[7];
            float acc = 0.f;
#pragma unroll 8
            for (int k = (tid & 63); k < 2048; k += 64) acc += pos[k] * w1[(size_t)k * 64 + j];
            acc = wave_sum(acc);
            if ((tid & 63) == 0) CB[idx] = acc;
        }
        bf16_t* XRB = (bf16_t*)(p.ws + WS_XRB);
        for (int idx = bid * NT + tid; idx < 16 * 3 * 64; idx += nb * NT) { const int sq = idx / 192, rem = idx % 192; XRB[(size_t)sq * SEQP * 64 + rem] = 0; }
    }
    {
        const f32x4* sp = (const f32x4*)p.in[23]; u32x2* dp = (u32x2*)(p.ws + WS_WRB);
        for (int i = bid * NT + tid; i < 1024 * 256 / 4; i += nb * NT) { const f32x4 v = sp[i]; u32x2 w; w.x = pk_bf16(v[0], v[1]); w.y = pk_bf16(v[2], v[3]); dp[i] = w; }
    }
    {
        LAS float* scr = (LAS float*)((LAS unsigned char*)smem_las + 16384 + (tid >> 6) * 8704);
        const int gw = bid * NW + (tid >> 6), ngw = nb * NW, lane_ = tid & 63;
        const int I1 = 16 * 80, I2 = 16 * 32;
        for (int it = gw; it < I1 + I2; it += ngw) {
            if (it < I1) transpose_item(p.in[5], 1024, NCOLS, 2560, (bf16_t*)(p.ws + WS_WINT), scr, it, lane_);
            else transpose_item(p.in[21], 1024, 1024, 1024, (bf16_t*)(p.ws + WS_WOUTT), scr, it - I1, lane_);
        }
    }
    float* lut = (float*)(p.ws + WS_LUT); const float* rel = p.in[11];
    for (int idx = bid * NT + tid; idx < 8 * 1024; idx += nb * NT) {
        const int h = idx >> 10, d = idx & 1023;
        int bucket;
        if (d < 16) bucket = d;
        else { const int l = 16 + (int)(logf((float)d / 16.0f) / 4.1588830833596715f * 16.0f); bucket = l < 31 ? l : 31; }
        lut[idx] = rel[bucket * 8 + h];
    }
}

template <bool SRC_BF16>
__device__ __forceinline__ void phase_modnorm(const Params& p, int bid, int nb, const void* src_, const float* nw, int sh_off, int sc_off, bf16_t* dstb) {
    const float* mod = (const float*)(p.ws + WS_MOD);
    int tid_ = threadIdx.x; asm volatile("" : "+v"(tid_));
    const int wave = tid_ >> 6, lane = tid_ & 63;
    const int RS = nb * NW;
    f32x4 w4[4];
#pragma unroll
    for (int i = 0; i < 4; ++i) w4[i] = *(const f32x4*)(nw + lane * 16 + 4 * i);
    for (int row0 = bid * NW + wave; row0 < MTOK; row0 += 4 * RS) {
        f32x4 v[4][4];
#pragma unroll
        for (int k = 0; k < 4; ++k) {
            const int row = row0 + k * RS; const int rc = row < MTOK ? row : row0;
            if constexpr (SRC_BF16) {
                const u32x4* xr = (const u32x4*)((const bf16_t*)src_ + (size_t)rc * 1024 + lane * 16);
                const u32x4 r0 = xr[0], r1 = xr[1];
#pragma unroll
                for (int j = 0; j < 4; ++j) { v[k][j >> 1][(j & 1) * 2] = __uint_as_float(r0[j] << 16); v[k][j >> 1][(j & 1) * 2 + 1] = __uint_as_float(r0[j] & 0xffff0000u);
                                              v[k][2 + (j >> 1)][(j & 1) * 2] = __uint_as_float(r1[j] << 16); v[k][2 + (j >> 1)][(j & 1) * 2 + 1] = __uint_as_float(r1[j] & 0xffff0000u); }
            } else {
                const float* xr = (const float*)src_ + (size_t)rc * 1024 + lane * 16;
#pragma unroll
                for (int i = 0; i < 4; ++i) v[k][i] = *(const f32x4*)(xr + 4 * i);
            }
        }
#pragma unroll
        for (int k = 0; k < 4; ++k) {
            const int row = row0 + k * RS;
            if (row < MTOK) {
                const int b = row >> 13;
                float ss = 0.f;
#pragma unroll
                for (int i = 0; i < 4; ++i) ss += (v[k][i][0] * v[k][i][0] + v[k][i][1] * v[k][i][1]) + (v[k][i][2] * v[k][i][2] + v[k][i][3] * v[k][i][3]);
                ss = wave_sum(ss);
                const float rstd = __builtin_amdgcn_rsqf(ss * (1.f / 1024.f) + 1e-6f);
                u32x4 o[2];
#pragma unroll
                for (int i = 0; i < 4; ++i) {
                    const int ci = lane * 16 + 4 * i;
                    const f32x4 sh = *(const f32x4*)(mod + b * 6144 + sh_off + ci), sc = *(const f32x4*)(mod + b * 6144 + sc_off + ci);
                    f32x4 h;
#pragma unroll
                    for (int j = 0; j < 4; ++j) h[j] = v[k][i][j] * rstd * w4[i][j] * (1.f + sc[j]) + sh[j];
                    o[i >> 1][(i & 1) * 2 + 0] = pk_bf16(h[0], h[1]); o[i >> 1][(i & 1) * 2 + 1] = pk_bf16(h[2], h[3]);
                }
                *(u32x4*)(dstb + (size_t)row * 1024 + lane * 16) = o[0];
                *(u32x4*)(dstb + (size_t)row * 1024 + lane * 16 + 8) = o[1];
            }
        }
    }
}

__device__ __forceinline__ void phase2_e(const Params& p, int bid, int nb, LAS unsigned char* lds) {
    bf16_t* QB = (bf16_t*)(p.ws + WS_QB); bf16_t* KV6 = (bf16_t*)(p.ws + WS_KV6); float* GATE = (float*)(p.ws + WS_GATE);
    bf16_t* XRB = (bf16_t*)(p.ws + WS_XRB); bf16_t* GRG = (bf16_t*)(p.ws + WS_GRG);
    pg8::Gemm g{(const pg8::bf16_t*)(p.ws + WS_H1B), (const pg8::bf16_t*)(p.ws + WS_WINT), MTOK, 2560, 1024};
    pg8::StaticOrder S; S.init(MTOK, 2560, nb, bid);
    auto E = make_epi_p([=](const f32x4 (&acc)[2][2][4][2], const pg8::Unit& u, int wr, int wc, int fr, int fq) {
#pragma unroll
        for (int ai = 0; ai < 2; ++ai)
#pragma unroll
            for (int mm = 0; mm < 4; ++mm) {
                const int m = u.pm * 256 + ai * 128 + wr * 64 + mm * 16 + fr;
#pragma unroll
                for (int bj = 0; bj < 2; ++bj) {
                    const int col = u.pn * 256 + bj * 128 + wc * 32 + fq * 8;
                    const f32x4 v0 = acc[ai][bj][mm][0], v1 = acc[ai][bj][mm][1];
                    if (col >= NCOLS) continue;
                    if (col < 512) {
                        const float sc = 0.125f * LOG2E; u32x4 w; w[0] = pk_bf16(v0[0] * sc, v0[1] * sc); w[1] = pk_bf16(v0[2] * sc, v0[3] * sc); w[2] = pk_bf16(v1[0] * sc, v1[1] * sc); w[3] = pk_bf16(v1[2] * sc, v1[3] * sc);
                        *(u32x4*)(QB + (size_t)m * 512 + col) = w;
                    } else if (col >= 1280 && col < 1304) {
                        f32x4 g0, g1;
#pragma unroll
                        for (int j = 0; j < 4; ++j) { g0[j] = sigm(v0[j]); g1[j] = sigm(v1[j]); }
                        *(f32x4*)(GATE + (size_t)m * 24 + (col - 1280)) = g0; *(f32x4*)(GATE + (size_t)m * 24 + (col - 1280) + 4) = g1;
                    } else if (col < 1280) {
                        const int c2 = col - 512, j6 = c2 >> 7, gg = (c2 >> 6) & 1, d = c2 & 63, bb = m >> 13, t = m & 8191;
                        u32x4 w; w[0] = pk_bf16(v0[0], v0[1]); w[1] = pk_bf16(v0[2], v0[3]); w[2] = pk_bf16(v1[0], v1[1]); w[3] = pk_bf16(v1[2], v1[3]);
                        *(u32x4*)(KV6 + (size_t)j6 * 2097152 + ((size_t)((bb * 2 + gg) * SEQ + t)) * 64 + d) = w;
                    } else if (col < 1816) {
                        const int c = col - 1304, hb = c >> 6, bb = m >> 13, t = m & 8191;
                        u32x4 w; w[0] = pk_bf16(v0[0], v0[1]); w[1] = pk_bf16(v0[2], v0[3]); w[2] = pk_bf16(v1[0], v1[1]); w[3] = pk_bf16(v1[2], v1[3]);
                        *(u32x4*)(XRB + ((size_t)(bb * 8 + hb) * SEQP + 3 + t) * 64 + (c & 63)) = w;
                    } else {
                        u32x4 w; w[0] = pk_bf16(gelu_t(v0[0]), gelu_t(v0[1])); w[1] = pk_bf16(gelu_t(v0[2]), gelu_t(v0[3])); w[2] = pk_bf16(gelu_t(v1[0]), gelu_t(v1[1])); w[3] = pk_bf16(gelu_t(v1[2]), gelu_t(v1[3]));
                        *(u32x4*)(GRG + (size_t)m * 512 + (col - 1816)) = w;
                    }
                }
            }
    });
    pg8::gemm_phase(lds, g, S, E);
}

__device__ __forceinline__ void phase5_e(const Params& p, int bid, int nb, LAS unsigned char* lds) {
    const float* x = p.in[0]; const float* mod = (const float*)(p.ws + WS_MOD); bf16_t* X1 = (bf16_t*)(p.ws + WS_X1);
    pg8::Gemm g{(const pg8::bf16_t*)(p.ws + WS_YB), (const pg8::bf16_t*)(p.ws + WS_WOUTT), MTOK, 1024, 1024};
    pg8::StaticOrder S; S.init(MTOK, 1024, nb, bid);
    auto E = make_epi_p([=](const f32x4 (&acc)[2][2][4][2], const pg8::Unit& u, int wr, int wc, int fr, int fq) {
        const int c0 = u.pn * 256 + wc * 32 + fq * 8;
        const int bb = (u.pm * 256) >> 13;
        f32x4 gv[2][2];
#pragma unroll
        for (int bj = 0; bj < 2; ++bj)
#pragma unroll
            for (int nn = 0; nn < 2; ++nn) gv[bj][nn] = *(const f32x4*)(mod + bb * 6144 + 2048 + c0 + bj * 128 + nn * 4);
#pragma unroll
        for (int ai = 0; ai < 2; ++ai)
#pragma unroll
            for (int mm = 0; mm < 4; ++mm) {
                const size_t o = (size_t)(u.pm * 256 + ai * 128 + wr * 64 + mm * 16 + fr) * 1024 + c0;
                f32x4 xv[2][2];
#pragma unroll
                for (int bj = 0; bj < 2; ++bj)
#pragma unroll
                    for (int nn = 0; nn < 2; ++nn) xv[bj][nn] = *(const f32x4*)(x + o + bj * 128 + nn * 4);
#pragma unroll
                for (int bj = 0; bj < 2; ++bj) {
                    const f32x4 r0 = xv[bj][0] + gv[bj][0] * acc[ai][bj][mm][0], r1 = xv[bj][1] + gv[bj][1] * acc[ai][bj][mm][1];
                    u32x4 w; w[0] = pk_bf16(r0[0], r0[1]); w[1] = pk_bf16(r0[2], r0[3]); w[2] = pk_bf16(r1[0], r1[1]); w[3] = pk_bf16(r1[2], r1[3]);
                    *(u32x4*)(X1 + o + bj * 128) = w;
                }
            }
    });
    pg8::gemm_phase(lds, g, S, E);
}

#ifndef A4_PROBE_MASK
#define A4_PROBE_MASK 7
#endif
#define A4_KV 0
#define A4_SCORE 65536
#define A4_LUT 131200
#define LUTP 1156
#define A4_SELM 149760
__device__ __forceinline__ float ex2(float x) { return __builtin_amdgcn_exp2f(x); }

__device__ __forceinline__ float xmax_16_32(float v) {
    { auto r = __builtin_amdgcn_permlane16_swap(__float_as_uint(v), __float_as_uint(v), false, false); v = fmaxf(__uint_as_float(r[0]), __uint_as_float(r[1])); }
    { auto r = __builtin_amdgcn_permlane32_swap(__float_as_uint(v), __float_as_uint(v), false, false); v = fmaxf(__uint_as_float(r[0]), __uint_as_float(r[1])); }
    return v;
}
__device__ __forceinline__ float xsum_16_32(float v) {
    { auto r = __builtin_amdgcn_permlane16_swap(__float_as_uint(v), __float_as_uint(v), false, false); v = __uint_as_float(r[0]) + __uint_as_float(r[1]); }
    { auto r = __builtin_amdgcn_permlane32_swap(__float_as_uint(v), __float_as_uint(v), false, false); v = __uint_as_float(r[0]) + __uint_as_float(r[1]); }
    return v;
}


__device__ __forceinline__ void phase4_mfma(unsigned char* ws, int bid, int nb, LAS unsigned char* lds) {
    int tid_ = threadIdx.x; asm volatile("" : "+v"(tid_));
    const int tid = tid_, wid = __builtin_amdgcn_readfirstlane(tid >> 6), lane = tid & 63;
    const int col = lane & 15, tl = col >> 2, hd = col & 3, g4 = lane >> 4, fr = col;
    const bf16_t* QB = (const bf16_t*)(ws + WS_QB);
    const unsigned char* KV6 = ws + WS_KV6;
    const unsigned char* KCB = ws + WS_KCB; const unsigned char* VCB = ws + WS_VCB;
    const float* lutg = (const float*)(ws + WS_LUT);
    const float* GATE = (const float*)(ws + WS_GATE);
    float* OATT = (float*)(ws + WS_OATT);
    LAS float* lutl = (LAS float*)(lds + A4_LUT);
    LAS float* score = (LAS float*)(lds + A4_SCORE);
    LAS unsigned* selm = (LAS unsigned*)(lds + A4_SELM);
    const int koff0 = fr * 128 + 16 * ((g4) ^ (fr & 7)), koff1 = fr * 128 + 16 * ((4 + g4) ^ (fr & 7));
    const int q4 = (lane >> 2) & 3, pp = lane & 3, xk = (g4 & 1) * 4 + q4;
    int voff[4];
#pragma unroll
    for (int db = 0; db < 4; ++db) voff[db] = (g4 * 4 + q4) * 128 + 16 * ((db * 2 + (pp >> 1)) ^ xk) + 8 * (pp & 1);
    const int dr = tid >> 3, dsrc = dr * 128 + (((tid & 7) ^ (dr & 7)) * 16);

#define A4_ISSUE(kbase, vbase, stage) do { \
        __builtin_amdgcn_global_load_lds((const unsigned*)((kbase) + dsrc), (LAS unsigned*)(lds + A4_KV + (stage) * 16384 + wid * 1024), 16, 0, 0); \
        if (vbase) __builtin_amdgcn_global_load_lds((const unsigned*)((vbase) + dsrc), (LAS unsigned*)(lds + A4_KV + (stage) * 16384 + 8192 + wid * 1024), 16, 0, 0); } while (0)
#define A4_SYNC() do { asm volatile("s_waitcnt vmcnt(0)" ::: "memory"); __syncthreads(); } while (0)
#define A4_SYNC_RING(issued) do { asm volatile("s_waitcnt lgkmcnt(0)" ::: "memory"); if (issued) asm volatile("s_waitcnt vmcnt(2)" ::: "memory"); else asm volatile("s_waitcnt vmcnt(0)" ::: "memory"); \
        asm volatile("" ::: "memory"); __builtin_amdgcn_s_barrier(); asm volatile("" ::: "memory"); } while (0)

    for (int u2 = bid; u2 < 256; u2 += nb)
    for (int hf = 0; hf < 2; ++hf)
    for (int rep4 = 0; rep4 < ((REP & 64) ? 2 : 1); ++rep4) {
        const bool probe = rep4 > 0; const int amask = probe ? A4_PROBE_MASK : 7;
        const int bg = u2 >> 6, b = bg >> 1, g = bg & 1;
        const int T = hf ? 127 - (u2 & 63) : (u2 & 63);
        const int t0 = T * 64;
        const size_t seqbase = (size_t)(b * 2 + g) * SEQ;
        __syncthreads();
        for (int i = tid; i < 4 * 1152; i += NT) { const int hh = i / 1152, dd = i - hh * 1152; lutl[hh * LUTP + dd] = lutg[(g * 4 + hh) * 1024 + (dd < 1023 ? dd : 1023)] * LOG2E; }
        if (!probe) for (int i = tid; i < 8192; i += NT) score[i] = 0.f;
        int tq[2]; tq[0] = t0 + 8 * wid + tl; tq[1] = tq[0] + 4;
        bf16x8 qf[2][2];
#pragma unroll
        for (int ct = 0; ct < 2; ++ct) {
            const size_t m = (size_t)b * SEQ + tq[ct];
#pragma unroll
            for (int h2 = 0; h2 < 2; ++h2) qf[ct][h2] = *(const bf16x8*)(QB + m * 512 + (g * 4 + hd) * 64 + h2 * 32 + g4 * 8);
        }
#define A4_GATEV(ct, br) (GATE[((size_t)b * SEQ + tq[ct]) * 24 + (g * 4 + hd) * 3 + (br)])
        __syncthreads();

        float mrun[2], lrun[2];
        f32x4 O[2][4];
        bf16x8 kf[4][2];
        f32x4 sv[4];
#define A4_LOADK(stage) do { _Pragma("unroll") for (int kt = 0; kt < 4; ++kt) { \
            kf[kt][0] = *(const LAS bf16x8*)(lds + A4_KV + (stage) * 16384 + kt * 2048 + koff0); \
            kf[kt][1] = *(const LAS bf16x8*)(lds + A4_KV + (stage) * 16384 + kt * 2048 + koff1); } } while (0)
#define A4_SCORES(ct) do { _Pragma("unroll") for (int kt = 0; kt < 4; ++kt) { \
            sv[kt] = __builtin_amdgcn_mfma_f32_16x16x32_bf16(kf[kt][0], qf[ct][0], (f32x4){0.f, 0.f, 0.f, 0.f}, 0, 0, 0); \
            sv[kt] = __builtin_amdgcn_mfma_f32_16x16x32_bf16(kf[kt][1], qf[ct][1], sv[kt], 0, 0, 0); } } while (0)
#define A4_VREADS(stage, a, l0, h0, l1, h1, l2, h2, l3, h3) do { \
            LAS unsigned char* vb_ = lds + A4_KV + (stage) * 16384 + 8192 + (a) * 4096; \
            l0 = tr_read(vb_ + voff[0]); h0 = tr_read(vb_ + 2048 + voff[0]); l1 = tr_read(vb_ + voff[1]); h1 = tr_read(vb_ + 2048 + voff[1]); \
            l2 = tr_read(vb_ + voff[2]); h2 = tr_read(vb_ + 2048 + voff[2]); l3 = tr_read(vb_ + voff[3]); h3 = tr_read(vb_ + 2048 + voff[3]); } while (0)
#define A4_PVMMA(ct, a, l0, h0, l1, h1, l2, h2, l3, h3) do { \
            u32x4 pw; pw[0] = pk_bf16(sv[2 * (a)][0], sv[2 * (a)][1]); pw[1] = pk_bf16(sv[2 * (a)][2], sv[2 * (a)][3]); \
            pw[2] = pk_bf16(sv[2 * (a) + 1][0], sv[2 * (a) + 1][1]); pw[3] = pk_bf16(sv[2 * (a) + 1][2], sv[2 * (a) + 1][3]); \
            const bf16x8 pf = __builtin_bit_cast(bf16x8, pw); \
            O[ct][0] = __builtin_amdgcn_mfma_f32_16x16x32_bf16((bf16x8){l0[0], l0[1], l0[2], l0[3], h0[0], h0[1], h0[2], h0[3]}, pf, O[ct][0], 0, 0, 0); \
            O[ct][1] = __builtin_amdgcn_mfma_f32_16x16x32_bf16((bf16x8){l1[0], l1[1], l1[2], l1[3], h1[0], h1[1], h1[2], h1[3]}, pf, O[ct][1], 0, 0, 0); \
            O[ct][2] = __builtin_amdgcn_mfma_f32_16x16x32_bf16((bf16x8){l2[0], l2[1], l2[2], l2[3], h2[0], h2[1], h2[2], h2[3]}, pf, O[ct][2], 0, 0, 0); \
            O[ct][3] = __builtin_amdgcn_mfma_f32_16x16x32_bf16((bf16x8){l3[0], l3[1], l3[2], l3[3], h3[0], h3[1], h3[2], h3[3]}, pf, O[ct][3], 0, 0, 0); } while (0)
#define A4_ONLINE_PV(ct, stage) do { \
            s16x4 va0, va1, va2, va3, va4, va5, va6, va7; \
            A4_VREADS(stage, 0, va0, va1, va2, va3, va4, va5, va6, va7); \
            float mx = fmaxf(fmaxf(sv[0][0], sv[0][1]), fmaxf(sv[0][2], sv[0][3])); \
            _Pragma("unroll") for (int kt = 1; kt < 4; ++kt) _Pragma("unroll") for (int j = 0; j < 4; ++j) mx = fmaxf(mx, sv[kt][j]); \
            mx = xmax_16_32(mx); \
            const float mnew = fmaxf(mrun[ct], mx); const float muse = (mnew == -INF) ? 0.f : mnew; \
            const float scl = ex2(mrun[ct] - muse); mrun[ct] = mnew; \
            const float nmu = -muse; \
            _Pragma("unroll") for (int kt = 0; kt < 4; ++kt) { sv[kt] += nmu; _Pragma("unroll") for (int j = 0; j < 4; ++j) sv[kt][j] = ex2(sv[kt][j]); } \
            const f32x4 ls4 = (sv[0] + sv[1]) + (sv[2] + sv[3]); const float ls = (ls4[0] + ls4[1]) + (ls4[2] + ls4[3]); \
            lrun[ct] = lrun[ct] * scl + ls; \
            if (__builtin_amdgcn_ballot_w64(scl != 1.f) != 0ull) { _Pragma("unroll") for (int db = 0; db < 4; ++db) O[ct][db] *= scl; } \
            TR_WAIT8(va0, va1, va2, va3, va4, va5, va6, va7); \
            s16x4 vb0, vb1, vb2, vb3, vb4, vb5, vb6, vb7; \
            A4_VREADS(stage, 1, vb0, vb1, vb2, vb3, vb4, vb5, vb6, vb7); \
            A4_PVMMA(ct, 0, va0, va1, va2, va3, va4, va5, va6, va7); \
            TR_WAIT8(vb0, vb1, vb2, vb3, vb4, vb5, vb6, vb7); \
            A4_PVMMA(ct, 1, vb0, vb1, vb2, vb3, vb4, vb5, vb6, vb7); } while (0)
#define A4_PV(ct, stage) do { \
            s16x4 va0, va1, va2, va3, va4, va5, va6, va7; \
            A4_VREADS(stage, 0, va0, va1, va2, va3, va4, va5, va6, va7); \
            TR_WAIT8(va0, va1, va2, va3, va4, va5, va6, va7); \
            A4_PVMMA(ct, 0, va0, va1, va2, va3, va4, va5, va6, va7); \
            A4_VREADS(stage, 1, va0, va1, va2, va3, va4, va5, va6, va7); \
            TR_WAIT8(va0, va1, va2, va3, va4, va5, va6, va7); \
            A4_PVMMA(ct, 1, va0, va1, va2, va3, va4, va5, va6, va7); } while (0)
#define A4_RESET() do { _Pragma("unroll") for (int ct = 0; ct < 2; ++ct) { mrun[ct] = -INF; lrun[ct] = 0.f; \
            _Pragma("unroll") for (int db = 0; db < 4; ++db) O[ct][db] = (f32x4){0.f, 0.f, 0.f, 0.f}; } } while (0)
#define A4_FINISH(br, first) do { _Pragma("unroll") for (int ct = 0; ct < 2; ++ct) { \
            float lt = lrun[ct]; lt = xsum_16_32(lt); \
            const float wv = A4_GATEV(ct, br) / fmaxf(lt, 1e-30f); \
            float* op = OATT + ((size_t)b * SEQ + tq[ct]) * 512 + (g * 4 + hd) * 64 + g4 * 4; \
            _Pragma("unroll") for (int db = 0; db < 4; ++db) { f32x4 r = O[ct][db] * wv; if (!(first)) r += *(const f32x4*)(op + db * 16); *(f32x4*)(op + db * 16) = r; } } } while (0)

        if (amask & 1) {
            const unsigned char* KW = KV6 + (size_t)4 * 4194304 + seqbase * 128; const unsigned char* VW = KV6 + (size_t)5 * 4194304 + seqbase * 128;
            A4_RESET();
            const int s0 = T >= 8 ? 0 : 8 - T;
            { const int jb = T - 8 + s0; A4_ISSUE(KW + (size_t)jb * 8192, VW + (size_t)jb * 8192, 0);
              if (s0 < 8) { A4_ISSUE(KW + (size_t)(jb + 1) * 8192, VW + (size_t)(jb + 1) * 8192, 1); asm volatile("s_waitcnt vmcnt(2)" ::: "memory"); } else asm volatile("s_waitcnt vmcnt(0)" ::: "memory");
              __syncthreads(); }
            int stage = 0;
            for (int s = s0; s <= 8; ++s) {
                const int jb = T - 8 + s;
                const bool iss = (s + 2 <= 8);
                if (iss) { const int st2 = stage >= 1 ? stage - 1 : 2; const unsigned char* kn = KW + (size_t)(jb + 2) * 8192; const unsigned char* vn = VW + (size_t)(jb + 2) * 8192; A4_ISSUE(kn, vn, st2); }
#pragma unroll
                for (int ct = 0; ct < 2; ++ct) {
                    A4_LOADK(stage);
                    A4_SCORES(ct);
                    __builtin_amdgcn_sched_barrier(0);
                    const int t = tq[ct];
                    {
                        const int base = t - jb * 64 - g4 * 4;
                        const LAS float* lp = lutl + hd * LUTP + base - 51;
                        const bool edge = (s == 0) || (s == 8);
#pragma unroll
                        for (int kt = 0; kt < 4; ++kt) {
                            f32x4 bs;
#pragma unroll
                            for (int j = 0; j < 4; ++j) bs[j] = lp[51 - kt * 16 - j];
                            asm volatile("" : "+v"(bs));
                            sv[kt] += bs;
                        }
                        if (edge) {
#pragma unroll
                            for (int kt = 0; kt < 4; ++kt)
#pragma unroll
                                for (int j = 0; j < 4; ++j) { const int dist = base - kt * 16 - j; sv[kt][j] = ((dist >= 0) && (dist < 512)) ? sv[kt][j] : -INF; }
                        }
                    }
                    A4_ONLINE_PV(ct, stage);
                    __builtin_amdgcn_sched_barrier(0);
                }
                A4_SYNC_RING(iss);
                stage = stage == 2 ? 0 : stage + 1;
            }
            if (!probe) A4_FINISH(2, true);
        }
        if (amask & 2) {
            const unsigned char* KC = KCB + (size_t)(b * 2 + g) * 512 * 128; const unsigned char* VC = VCB + (size_t)(b * 2 + g) * 512 * 128;
            int ncmp = 4 * T + 3; if (ncmp > NCMP) ncmp = NCMP;
            const int nblk = (ncmp + 63) >> 6;
            A4_RESET();
            A4_ISSUE(KC, (const unsigned char*)nullptr, 0);
            A4_SYNC();
            for (int s = 0; s < nblk; ++s) {
                const int stage = s & 1;
                if (s + 1 < nblk) A4_ISSUE(KC + (size_t)(s + 1) * 8192, (const unsigned char*)nullptr, stage ^ 1);
#pragma unroll
                for (int ct = 0; ct < 2; ++ct) {
                    A4_LOADK(stage);
                    A4_SCORES(ct);
                    __builtin_amdgcn_sched_barrier(0);
                    const int t = tq[ct];
                    float mx = -INF;
#pragma unroll
                    for (int kt = 0; kt < 4; ++kt) {
                        f32x4 bs;
#pragma unroll
                        for (int j = 0; j < 4; ++j) { int dist = t - (16 * (s * 64 + kt * 16 + g4 * 4 + j) + 31); dist = dist < 1023 ? dist : 1023; bs[j] = lutl[hd * LUTP + (dist & 1023)]; }
                        asm volatile("" : "+v"(bs));
#pragma unroll
                        for (int j = 0; j < 4; ++j) {
                            const int n = s * 64 + kt * 16 + g4 * 4 + j; const int dist = t - (16 * n + 31);
                            const bool ok = (dist >= 0) && (n < NCMP);
                            sv[kt][j] = ok ? sv[kt][j] + bs[j] : -INF; mx = fmaxf(mx, sv[kt][j]);
                        }
                    }
                    mx = xmax_16_32(mx);
                    const float mnew = fmaxf(mrun[ct], mx); const float muse = (mnew == -INF) ? 0.f : mnew;
                    const float scl = ex2(mrun[ct] - muse); mrun[ct] = mnew;
                    float ls = 0.f;
#pragma unroll
                    for (int kt = 0; kt < 4; ++kt)
#pragma unroll
                        for (int j = 0; j < 4; ++j) ls += ex2(sv[kt][j] - muse);
                    lrun[ct] = lrun[ct] * scl + ls;
                    __builtin_amdgcn_sched_barrier(0);
                }
                A4_SYNC();
            }
            float mfin[2], linv[2];
#pragma unroll
            for (int ct = 0; ct < 2; ++ct) {
                float lt = lrun[ct]; lt = xsum_16_32(lt);
                linv[ct] = 1.f / fmaxf(lt, 1e-30f); mfin[ct] = (mrun[ct] == -INF) ? 0.f : mrun[ct];
            }
            A4_ISSUE(KC, VC, 0);
            A4_SYNC();
            for (int s = 0; s < nblk; ++s) {
                const int stage = s & 1;
                if (s + 1 < nblk) { const unsigned char* kn = KC + (size_t)(s + 1) * 8192; const unsigned char* vn = VC + (size_t)(s + 1) * 8192; A4_ISSUE(kn, vn, stage ^ 1); }
#pragma unroll
                for (int ct = 0; ct < 2; ++ct) {
                    A4_LOADK(stage);
                    A4_SCORES(ct);
                    __builtin_amdgcn_sched_barrier(0);
                    const int t = tq[ct];
#pragma unroll
                    for (int kt = 0; kt < 4; ++kt) {
                        f32x4 bs;
#pragma unroll
                        for (int j = 0; j < 4; ++j) { int dist = t - (16 * (s * 64 + kt * 16 + g4 * 4 + j) + 31); dist = dist < 1023 ? dist : 1023; bs[j] = lutl[hd * LUTP + (dist & 1023)]; }
                        asm volatile("" : "+v"(bs));
#pragma unroll
                        for (int j = 0; j < 4; ++j) {
                            const int n = s * 64 + kt * 16 + g4 * 4 + j; const int dist = t - (16 * n + 31);
                            const bool ok = (dist >= 0) && (n < NCMP);
                            sv[kt][j] = ok ? ex2(sv[kt][j] + bs[j] - mfin[ct]) * linv[ct] : 0.f;
                        }
                        float s4 = (sv[kt][0] + sv[kt][1]) + (sv[kt][2] + sv[kt][3]); float s3 = sv[kt][3];
                        s4 += __shfl_xor(s4, 1); s4 += __shfl_xor(s4, 2); s3 += __shfl_xor(s3, 1); s3 += __shfl_xor(s3, 2);
                        const int a = s * 16 + kt * 4 + g4;
                        if (hd == 0 && !probe) {
                            LAS float* sp = score + (8 * wid + 4 * ct + tl) * 128 + a;
                            atomicAdd((float*)sp, s4);
                            if (a + 1 < 128) atomicAdd((float*)(sp + 1), s3);
                        }
                    }
                    A4_PV(ct, stage);
                    __builtin_amdgcn_sched_barrier(0);
                }
                A4_SYNC();
            }
            if (!probe)
#pragma unroll
            for (int ct = 0; ct < 2; ++ct) {
                float* op = OATT + ((size_t)b * SEQ + tq[ct]) * 512 + (g * 4 + hd) * 64 + g4 * 4;
#pragma unroll
                for (int db = 0; db < 4; ++db) { const float gcv = A4_GATEV(ct, 0); f32x4 r = O[ct][db] * gcv; r += *(const f32x4*)(op + db * 16); *(f32x4*)(op + db * 16) = r; }
            }
        }
        __syncthreads();
        if (!probe)
        for (int tt = 0; tt < 8; ++tt) {
            const int ti = 8 * wid + tt;
            const int j0 = lane, j1 = lane + 64;
            bool sel0, sel1;
            if (T <= 15) { sel0 = j0 <= T; sel1 = false; }
            else {
                const bool c0 = (j0 >= 1) && (j0 <= T - 2), c1 = (j1 <= T - 2);
                const float s0 = c0 ? score[ti * 128 + j0] : -INF, s1 = c1 ? score[ti * 128 + j1] : -INF;
                int r0 = 0, r1 = 0;
                for (int j2 = 1; j2 <= T - 2; ++j2) { const float v = score[ti * 128 + j2]; r0 += (v > s0) || (v == s0 && j2 < j0); r1 += (v > s1) || (v == s1 && j2 < j1); }
                sel0 = (c0 && r0 < 13) || (j0 == 0) || (j0 == T) || (j0 == T - 1);
                sel1 = (c1 && r1 < 13) || (j1 == T) || (j1 == T - 1);
            }
            const unsigned long long b0 = __ballot(sel0), b1 = __ballot(sel1);
            if (lane == 0) { selm[ti * 4 + 0] = (unsigned)b0; selm[ti * 4 + 1] = (unsigned)(b0 >> 32); selm[ti * 4 + 2] = (unsigned)b1; selm[ti * 4 + 3] = (unsigned)(b1 >> 32); }
        }
        __builtin_amdgcn_wave_barrier();
        asm volatile("s_waitcnt lgkmcnt(0)" ::: "memory");
        if (amask & 4) {
            const unsigned char* KS = KV6 + (size_t)2 * 4194304 + seqbase * 128; const unsigned char* VS = KV6 + (size_t)3 * 4194304 + seqbase * 128;
            unsigned un[2][4];
#pragma unroll
            for (int ct = 0; ct < 2; ++ct)
#pragma unroll
                for (int w = 0; w < 4; ++w) {
                    unsigned uu = selm[(8 * wid + 4 * ct + 0) * 4 + w] | selm[(8 * wid + 4 * ct + 1) * 4 + w] | selm[(8 * wid + 4 * ct + 2) * 4 + w] | selm[(8 * wid + 4 * ct + 3) * 4 + w];
                    un[ct][w] = __builtin_amdgcn_readfirstlane(uu);
                }
            A4_RESET();
            const float cbfar = lutl[hd * LUTP + 1023];
            __syncthreads();
#pragma unroll
            for (int bq = 0; bq < 4; ++bq) if (bq <= T) { const unsigned char* kn = KS + (size_t)bq * 8192; const unsigned char* vn = VS + (size_t)bq * 8192; A4_ISSUE(kn, vn, bq); }
            A4_SYNC();
#pragma unroll
            for (int w = 0; w < 4; ++w) {
                const unsigned selw0 = selm[(8 * wid + tl) * 4 + w], selw1 = selm[(8 * wid + 4 + tl) * 4 + w];
                for (int gg = 0; gg < 8; ++gg) {
                    const int j0 = w * 32 + gg * 4;
                    if (j0 > T) break;
#pragma unroll
                    for (int bq = 0; bq < 4; ++bq) { const int jn = j0 + 4 + bq; if (jn <= T) { const unsigned char* kn = KS + (size_t)jn * 8192; const unsigned char* vn = VS + (size_t)jn * 8192; A4_ISSUE(kn, vn, (jn & 7)); } }
                    for (int bq = 0; bq < 4; ++bq) {
                        const int j = j0 + bq;
                        if (j > T) break;
                        const int jb = gg * 4 + bq, stage = j & 7;
                        const bool need0 = (un[0][w] >> jb) & 1u, need1 = (un[1][w] >> jb) & 1u;
                        if (need0 || need1) {
#pragma unroll
                            for (int ct = 0; ct < 2; ++ct) {
                                if (ct == 0 ? need0 : need1) {
                                    A4_LOADK(stage);
                                    A4_SCORES(ct);
                                    __builtin_amdgcn_sched_barrier(0);
                                    const int t = tq[ct];
                                    const bool csel = ((ct == 0 ? selw0 : selw1) >> jb) & 1u;
                                    if (j * 64 + 63 + 1023 <= t0) {
                                        const float cb = csel ? cbfar : -INF;
#pragma unroll
                                        for (int kt = 0; kt < 4; ++kt)
#pragma unroll
                                            for (int jj = 0; jj < 4; ++jj) sv[kt][jj] += cb;
                                    } else {
                                        const int base = t - j * 64 - g4 * 4;
                                        const LAS float* lp = lutl + hd * LUTP + base - 51;
                                        const float msk = csel ? 0.f : -INF;
#pragma unroll
                                        for (int kt = 0; kt < 4; ++kt) {
                                            f32x4 bs;
#pragma unroll
                                            for (int jj = 0; jj < 4; ++jj) bs[jj] = lp[51 - kt * 16 - jj];
                                            asm volatile("" : "+v"(bs));
                                            sv[kt] += bs + msk;
                                        }
                                        if (j == T) {
#pragma unroll
                                            for (int kt = 0; kt < 4; ++kt)
#pragma unroll
                                                for (int jj = 0; jj < 4; ++jj) { const int dist = base - kt * 16 - jj; sv[kt][jj] = (dist >= 0) ? sv[kt][jj] : -INF; }
                                        }
                                    }
                                    A4_ONLINE_PV(ct, stage);
                                    __builtin_amdgcn_sched_barrier(0);
                                }
                            }
                        }
                    }
                    A4_SYNC();
                }
            }
            if (!probe) A4_FINISH(1, false);
        }
    }
#undef A4_ISSUE
#undef A4_SYNC
#undef A4_SYNC_RING
#undef A4_LOADK
#undef A4_SCORES
#undef A4_ONLINE_PV
#undef A4_PV
#undef A4_VREADS
#undef A4_PVMMA
#undef A4_RESET
#undef A4_FINISH
#undef A4_GATEV
}

__device__ __forceinline__ void phase3_mfma(const Params& p, int bid, int nb, LAS unsigned char* lds) {
    {
        const unsigned char* XRBb = p.ws + WS_XRB; const bf16_t* XRB = (const bf16_t*)(p.ws + WS_XRB);
        const float* BG = (const float*)(p.ws + WS_BG); const float* GB = (const float*)(p.ws + WS_GBIAS);
        const float* conv_w = p.in[12]; const float* conv_b = p.in[13]; const float* lam = p.in[18];
        bf16_t* AL = (bf16_t*)(p.ws + WS_ALRU); bf16_t* UL = (bf16_t*)(p.ws + WS_ULRU);
        const XcdDeal dl = xcd_deal(512, lds, nb);
        gemm_stream<true, 1, 0, true>(lds, XRBb, dl.n, 4, 128,
            [&](int ps, int r) { const int u = dl.lo + ps * dl.step; return ((size_t)(u >> 5) * SEQP + (u & 31) * 256 + r) * 128; },
            [&](int ps, int n4) -> const float* { const int u = dl.lo + ps * dl.step; return BG + ((u >> 5) & 7) * 32768 + n4 * 4; },
            [&](int) { return 256; },
            [&](int ps, int rbase, int nbase, int, f32x4 (&acc)[4][4]) {
                const int u = dl.lo + ps * dl.step, sq = u >> 5, hb = sq & 7, bb = sq >> 3, t0 = (u & 31) * 256 + rbase;
                const int j8 = (nbase >> 6) * 32 + ((nbase >> 2) & 3) * 8, c = hb * 64 + j8;
                f32x4 cw[4][2], cbv[2], ga[2], gx[2], spl[2];
#pragma unroll
                for (int h2 = 0; h2 < 2; ++h2) {
#pragma unroll
                    for (int w = 0; w < 4; ++w) cw[w][h2] = *(const f32x4*)(conv_w + w * 512 + c + 4 * h2);
                    cbv[h2] = *(const f32x4*)(conv_b + c + 4 * h2);
                    ga[h2] = *(const f32x4*)(GB + hb * 128 + nbase + 16 * h2); gx[h2] = *(const f32x4*)(GB + hb * 128 + nbase + 16 * h2 + 32);
                    const f32x4 lm = *(const f32x4*)(lam + c + 4 * h2);
#pragma unroll
                    for (int jj = 0; jj < 4; ++jj) spl[h2][jj] = -8.0f * softplus_(-lm[jj]);
                }
#pragma unroll
                for (int mh = 0; mh < 2; ++mh) {
                u32x4 xw[4][4];
#pragma unroll
                for (int mi = 2 * mh; mi < 2 * mh + 2; ++mi)
#pragma unroll
                    for (int w = 0; w < 4; ++w) xw[mi][w] = *(const u32x4*)(XRB + ((size_t)sq * SEQP + t0 + mi * 16 + w) * 64 + j8);
#pragma unroll
                for (int mi = 2 * mh; mi < 2 * mh + 2; ++mi) {
                    f32x4 xc[2] = {cbv[0], cbv[1]};
#pragma unroll
                    for (int w = 0; w < 4; ++w) {
                        xc[0][0] += cw[w][0][0] * __uint_as_float(xw[mi][w][0] << 16); xc[0][1] += cw[w][0][1] * __uint_as_float(xw[mi][w][0] & 0xffff0000u);
                        xc[0][2] += cw[w][0][2] * __uint_as_float(xw[mi][w][1] << 16); xc[0][3] += cw[w][0][3] * __uint_as_float(xw[mi][w][1] & 0xffff0000u);
                        xc[1][0] += cw[w][1][0] * __uint_as_float(xw[mi][w][2] << 16); xc[1][1] += cw[w][1][1] * __uint_as_float(xw[mi][w][2] & 0xffff0000u);
                        xc[1][2] += cw[w][1][2] * __uint_as_float(xw[mi][w][3] << 16); xc[1][3] += cw[w][1][3] * __uint_as_float(xw[mi][w][3] & 0xffff0000u);
                    }
                    f32x4 dv[2], uv[2];
#pragma unroll
                    for (int ni = 0; ni < 2; ++ni)
#pragma unroll
                        for (int jj = 0; jj < 4; ++jj) {
                            const float r_ = sigm(acc[mi][ni][jj] + ga[ni][jj]), ig = sigm(acc[mi][ni + 2][jj] + gx[ni][jj]);
                            const float la = r_ * spl[ni][jj];
                            const float a1 = __builtin_amdgcn_exp2f(la * 1.4426950408889634f);
                            dv[ni][jj] = 1.f - a1; uv[ni][jj] = __builtin_amdgcn_sqrtf(fmaxf(1.f - a1 * a1, 0.f)) * (ig * xc[ni][jj]);
                        }
                    const size_t o = ((size_t)bb * SEQ + t0 + mi * 16) * 512 + c;
                    u32x4 wd, wu;
                    wd[0] = pk_bf16(dv[0][0], dv[0][1]); wd[1] = pk_bf16(dv[0][2], dv[0][3]); wd[2] = pk_bf16(dv[1][0], dv[1][1]); wd[3] = pk_bf16(dv[1][2], dv[1][3]);
                    wu[0] = pk_bf16(uv[0][0], uv[0][1]); wu[1] = pk_bf16(uv[0][2], uv[0][3]); wu[2] = pk_bf16(uv[1][0], uv[1][1]); wu[3] = pk_bf16(uv[1][2], uv[1][3]);
                    *(u32x4*)(AL + o) = wd; *(u32x4*)(UL + o) = wu;
                }
                __builtin_amdgcn_sched_barrier(0);
                } });
    }
    {
        const unsigned char* KV6 = p.ws + WS_KV6; float* CP = (float*)(p.ws + WS_CPART);
        const float* W1k = p.in[7]; const float* W1v = p.in[9];
        const XcdDeal dl = xcd_deal(64, lds, nb);
        gemm_stream<false, 1>(lds, KV6, dl.n, 8, 64,
            [&](int ps, int r) { const int u = dl.lo + ps * dl.step, ks = u >> 4, kv = (u >> 3) & 1, R = (u & 7) * 256 + r;
                                 return (size_t)kv * 4194304 + ((size_t)(R >> 9) * SEQ + 16 * (R & 511)) * 128 + (size_t)ks * 1024; },
            [&](int ps, int n4) -> const float* { const int u = dl.lo + ps * dl.step, ks = u >> 4, kv = (u >> 3) & 1; return (kv ? W1v : W1k) + (size_t)ks * 512 * 64 + ((n4 * 4) & 63); },
            [&](int) { return 256; },
            [&](int ps, int r, int n, f32x4 v) { if (n < 64) { const int u = dl.lo + ps * dl.step; *(f32x4*)(CP + ((size_t)(u >> 3) * 2048 + (u & 7) * 256 + r) * 64 + n) = v; } });
    }
}

__device__ __forceinline__ void phase3b_new(const Params& p, int bid, int nb, float* smem) {
    const int tid = threadIdx.x;
    {
        const bf16_t* AL = (const bf16_t*)(p.ws + WS_ALRU); const bf16_t* UL = (const bf16_t*)(p.ws + WS_ULRU);
        float* AEND = (float*)(p.ws + WS_AEND); float* HEND = (float*)(p.ws + WS_HEND);
        const int cg = tid & 127, sg = tid >> 7;
        f32x4* summA = (f32x4*)smem; f32x4* summH = summA + 512;
        for (int u = bid; u < 256; u += nb) {
            const size_t base = ((size_t)(u >> 7) * SEQ + (u & 127) * 64 + sg * 16) * 512 + 4 * cg;
            u32x2 ar[16], ur[16];
#pragma unroll
            for (int tt = 0; tt < 16; ++tt) { ar[tt] = *(const u32x2*)(AL + base + (size_t)tt * 512); ur[tt] = *(const u32x2*)(UL + base + (size_t)tt * 512); }
            f32x4 A = (f32x4){1.f, 1.f, 1.f, 1.f}, H = (f32x4){0.f, 0.f, 0.f, 0.f};
#pragma unroll
            for (int tt = 0; tt < 16; ++tt) { const f32x4 a_ = 1.f - bf4_f32(ar[tt]); H = a_ * H + bf4_f32(ur[tt]); A = A * a_; }
            __syncthreads();
            summA[sg * 128 + cg] = A; summH[sg * 128 + cg] = H;
            __syncthreads();
            if (sg == 0) {
#pragma unroll
                for (int j = 1; j < 4; ++j) { const f32x4 a2 = summA[j * 128 + cg], h2 = summH[j * 128 + cg]; H = a2 * H + h2; A = A * a2; }
                *(f32x4*)(AEND + (size_t)u * 512 + 4 * cg) = A; *(f32x4*)(HEND + (size_t)u * 512 + 4 * cg) = H;
            }
        }
        __syncthreads();
    }
    {
        const float* CP = (const float*)(p.ws + WS_CPART); const float* CB = (const float*)(p.ws + WS_CBIAS);
        float* hid = smem;
        for (int u = bid; u < 64; u += nb) {
            const int kv = u >> 5, R0 = (u & 31) * 64;
            const float* w2 = kv ? p.in[10] : p.in[8];
            bf16_t* ob = (bf16_t*)(p.ws + (kv ? WS_VCB : WS_KCB));
            __syncthreads();
            for (int i = tid; i < 64 * 64; i += NT) {
                const int r = i >> 6, c = i & 63; const size_t o = ((size_t)kv * 2048 + R0 + r) * 64 + c;
                const float v = ((CP[o] + CP[o + 262144]) + (CP[o + 524288] + CP[o + 786432])) + CB[kv * 64 + c];
                hid[r * 65 + c] = gelu_t(v);
            }
            __syncthreads();
            for (int i = tid; i < 64 * 64; i += NT) {
                const int r = i >> 6, j = i & 63; float acc = 0.f;
#pragma unroll 8
                for (int k = 0; k < 64; ++k) acc += hid[r * 65 + k] * w2[k * 64 + j];
                const int R = R0 + r;
                if ((R & 511) == 511) acc = 0.f;
                ob[(size_t)R * 64 + j] = (bf16_t)(pk_bf16(acc, acc) & 0xffffu);
            }
        }
    }
}

__device__ __forceinline__ void phase4b_new(const Params& p, int bid, int nb, float* smem) {
    const bf16_t* AL = (const bf16_t*)(p.ws + WS_ALRU); const bf16_t* UL = (const bf16_t*)(p.ws + WS_ULRU);
    const float* AEND = (const float*)(p.ws + WS_AEND); const float* HEND = (const float*)(p.ws + WS_HEND);
    const bf16_t* GRG = (const bf16_t*)(p.ws + WS_GRG); const float* OATT = (const float*)(p.ws + WS_OATT);
    const float* gaw = p.in[19]; const float* grw = p.in[20];
    bf16_t* YB = (bf16_t*)(p.ws + WS_YB);
    const int tid = threadIdx.x, lane = tid & 63;
    const int cg = tid & 127, sg = tid >> 7, wsub = (tid >> 6) & 1;
    f32x4* summA = (f32x4*)smem;
    f32x4* summH = summA + 512;
    float* ssr = smem + 4096;
    float* ssa = ssr + 128;
    const f32x4 gr_w = *(const f32x4*)(grw + 4 * cg), ga_w = *(const f32x4*)(gaw + 4 * cg);
    for (int u = bid; u < 256; u += nb) {
        const int b = u >> 7, chunk = u & 127;
        f32x4 carry = (f32x4){0.f, 0.f, 0.f, 0.f};
        {
            const size_t cb = (size_t)(b * 128) * 512 + 4 * cg;
#pragma unroll 16
            for (int k = 0; k < chunk; ++k) carry = *(const f32x4*)(AEND + cb + (size_t)k * 512) * carry + *(const f32x4*)(HEND + cb + (size_t)k * 512);
        }
        const size_t tok0 = (size_t)b * SEQ + chunk * 64 + sg * 16;
        f32x4 av[16], uv[16];
#pragma unroll
        for (int tt = 0; tt < 16; ++tt) { const size_t o = (tok0 + tt) * 512 + 4 * cg; av[tt] = 1.f - bf4_f32(*(const u32x2*)(AL + o)); uv[tt] = bf4_f32(*(const u32x2*)(UL + o)); }
        f32x4 A = (f32x4){1.f, 1.f, 1.f, 1.f}, H = (f32x4){0.f, 0.f, 0.f, 0.f};
#pragma unroll
        for (int tt = 0; tt < 16; ++tt) { H = av[tt] * H + uv[tt]; A = A * av[tt]; }
        __syncthreads();
        summA[sg * 128 + cg] = A; summH[sg * 128 + cg] = H;
        __syncthreads();
#pragma unroll
        for (int j = 0; j < 3; ++j) if (j < sg) carry = summA[j * 128 + cg] * carry + summH[j * 128 + cg];
        f32x4 h = carry;
#pragma unroll
        for (int tt = 0; tt < 16; ++tt) {
            const size_t o = (tok0 + tt) * 512 + 4 * cg;
            h = av[tt] * h + uv[tt];
            const u32x2 gw = *(const u32x2*)(GRG + o);
            f32x4 v; v[0] = h[0] * __uint_as_float(gw.x << 16); v[1] = h[1] * __uint_as_float(gw.x & 0xffff0000u); v[2] = h[2] * __uint_as_float(gw.y << 16); v[3] = h[3] * __uint_as_float(gw.y & 0xffff0000u);
            uv[tt] = v;
            const float sq = wave_sum((v[0] * v[0] + v[1] * v[1]) + (v[2] * v[2] + v[3] * v[3]));
            const f32x4 oa = *(const f32x4*)(OATT + o);
            av[tt] = oa;
            const float sqa = wave_sum((oa[0] * oa[0] + oa[1] * oa[1]) + (oa[2] * oa[2] + oa[3] * oa[3]));
            if (lane == 0) { ssr[(sg * 16 + tt) * 2 + wsub] = sq; ssa[(sg * 16 + tt) * 2 + wsub] = sqa; }
        }
        __syncthreads();
#pragma unroll
        for (int tt = 0; tt < 16; ++tt) {
            const int ti = sg * 16 + tt;
            const float s1 = ssr[ti * 2] + ssr[ti * 2 + 1], s2 = ssa[ti * 2] + ssa[ti * 2 + 1];
            const float rs1 = __builtin_amdgcn_rsqf(s1 * (1.f / 512.f) + 1e-6f), rs2 = __builtin_amdgcn_rsqf(s2 * (1.f / 512.f) + 1e-6f);
            const f32x4 ya = av[tt] * rs2 * ga_w, yr = uv[tt] * rs1 * gr_w;
            u32x2 wa, wr_; wa.x = pk_bf16(ya[0], ya[1]); wa.y = pk_bf16(ya[2], ya[3]); wr_.x = pk_bf16(yr[0], yr[1]); wr_.y = pk_bf16(yr[2], yr[3]);
            *(u32x2*)(YB + (tok0 + tt) * 1024 + 4 * cg) = wa;
            *(u32x2*)(YB + (tok0 + tt) * 1024 + 512 + 4 * cg) = wr_;
        }
    }
}

__device__ __forceinline__ void phase8(const Params& p, int bid, int nb, float* smem) {
    const float* LOG = (const float*)(p.ws + WS_LOGITS); const float* brt = p.in[24];
    unsigned* cnt = (unsigned*)(p.ws + WS_HIST);
    int* EID = (int*)(p.ws + WS_EID); int* POS = (int*)(p.ws + WS_POS); float* WGT = (float*)(p.ws + WS_WGT);
    int tid_ = threadIdx.x; asm volatile("" : "+v"(tid_));
    const int wave = tid_ >> 6, lane = tid_ & 63;
    int* lhist = (int*)smem;
    if (tid_ < 256) lhist[tid_] = 0;
    __syncthreads();
    float bias[4];
#pragma unroll
    for (int r = 0; r < 4; ++r) bias[r] = brt[r * 64 + lane];
    for (int tok0 = bid * NW + wave; tok0 < MTOK; tok0 += 8 * nb * NW) {
        float lg[8][4];
#pragma unroll
        for (int k = 0; k < 8; ++k) { const int tok = tok0 + k * nb * NW; const int tc = tok < MTOK ? tok : tok0;
#pragma unroll
            for (int r = 0; r < 4; ++r) lg[k][r] = LOG[(size_t)tc * 256 + r * 64 + lane]; }
#pragma unroll
        for (int k = 0; k < 8; ++k) {
            const int tok = tok0 + k * nb * NW;
            if (tok < MTOK) {
                float sv[4], cv[4], gs[4];
#pragma unroll
                for (int r = 0; r < 4; ++r) { sv[r] = sigm(lg[k][r]); cv[r] = sv[r] + bias[r]; gs[r] = half_top2_sum(cv[r]); }
                float gsc = -INF;
#pragma unroll
                for (int r = 0; r < 4; ++r) {
                    const float ga = __builtin_bit_cast(float, __builtin_amdgcn_readlane(__builtin_bit_cast(int, gs[r]), 31));
                    const float gb = __builtin_bit_cast(float, __builtin_amdgcn_readlane(__builtin_bit_cast(int, gs[r]), 63));
                    gsc = lane == 2 * r ? ga : gsc; gsc = lane == 2 * r + 1 ? gb : gsc;
                }
                int grank = 0;
#pragma unroll
                for (int g2 = 0; g2 < 8; ++g2) { const float v2 = __builtin_bit_cast(float, __builtin_amdgcn_readlane(__builtin_bit_cast(int, gsc), g2)); grank += ((v2 > gsc) || (v2 == gsc && g2 < lane)) ? 1 : 0; }
                const unsigned long long gmask = __ballot((lane < 8) && (grank < 4));
#pragma unroll
                for (int r = 0; r < 4; ++r) cv[r] = ((gmask >> (2 * r + (lane >> 5))) & 1ull) ? cv[r] : -INF;
                int my_e = 0; float my_s = 0.f;
#pragma unroll
                for (int kk = 0; kk < 8; ++kk) {
                    float bv = cv[0]; int bi = lane;
                    if (cv[1] > bv) { bv = cv[1]; bi = 64 + lane; }
                    if (cv[2] > bv) { bv = cv[2]; bi = 128 + lane; }
                    if (cv[3] > bv) { bv = cv[3]; bi = 192 + lane; }
                    const float mx = wave_max_f(bv);
                    const int sel = wave_min_i(bv == mx ? bi : 0x7fffffff);
                    const int sr = sel >> 6;
                    const float mine = sr == 0 ? sv[0] : sr == 1 ? sv[1] : sr == 2 ? sv[2] : sv[3];
                    const float ssel = __builtin_bit_cast(float, __builtin_amdgcn_readlane(__builtin_bit_cast(int, mine), sel & 63));
                    if (lane == (sel & 63)) { cv[0] = sr == 0 ? -INF : cv[0]; cv[1] = sr == 1 ? -INF : cv[1]; cv[2] = sr == 2 ? -INF : cv[2]; cv[3] = sr == 3 ? -INF : cv[3]; }
                    if (lane == kk) { my_e = sel; my_s = ssel; }
                }
                const float ssum = wave_sum(lane < 8 ? my_s : 0.f);
                if (lane < 8) {
                    const int ps = atomicAdd(&lhist[my_e], 1);
                    EID[tok * 8 + lane] = my_e; POS[tok * 8 + lane] = ps; WGT[tok * 8 + lane] = 2.5f * my_s / ssum;
                }
            }
        }
    }
    __syncthreads();
    if (tid_ < 256) cnt[bid * 256 + tid_] = (unsigned)lhist[tid_];
}

__device__ __forceinline__ void expert_tables(const Params& p, int* off, int* tp, int shift = 6) {
    const unsigned* cnt = (const unsigned*)(p.ws + WS_CTL) + CW_CNT;
    __syncthreads();
    if (threadIdx.x < 64) {
        const int l = threadIdx.x; const int rnd = (1 << shift) - 1;
        const u32x4 c4 = *(const u32x4*)(cnt + 4 * l);
        const int c0 = (int)c4[0], c1 = (int)c4[1], c2 = (int)c4[2], c3 = (int)c4[3];
        const int t0 = (c0 + rnd) >> shift, t1 = (c1 + rnd) >> shift, t2 = (c2 + rnd) >> shift, t3 = (c3 + rnd) >> shift;
        const int so = c0 + c1 + c2 + c3, st = t0 + t1 + t2 + t3;
        int io = so, it = st;
#pragma unroll
        for (int d = 1; d < 64; d <<= 1) { const int uo = __shfl_up(io, d), ut = __shfl_up(it, d); if (l >= d) { io += uo; it += ut; } }
        const int eo = io - so, et = it - st;
        off[4 * l] = eo; off[4 * l + 1] = eo + c0; off[4 * l + 2] = eo + c0 + c1; off[4 * l + 3] = eo + c0 + c1 + c2;
        tp[4 * l] = et; tp[4 * l + 1] = et + t0; tp[4 * l + 2] = et + t0 + t1; tp[4 * l + 3] = et + t0 + t1 + t2;
        if (l == 63) { off[256] = io; tp[256] = it; tp[257] = it + (MTOK >> shift); }
    }
    __syncthreads();
}

__device__ __forceinline__ void phase9(const Params& p, int bid, int nb, float* smem) {
    int* off = (int*)smem; int* blkoff = off + 272; int* tot = off + 528; int* ptot = off + 1024; int* ppre = off + 3072;
    const unsigned* HIST = (const unsigned*)(p.ws + WS_HIST);
    unsigned* cnt = (unsigned*)(p.ws + WS_CTL) + CW_CNT;
    int tid_ = threadIdx.x; asm volatile("" : "+v"(tid_));
    const int tid = tid_;
    __syncthreads();
    {
        const int e4 = tid & 63, bg = tid >> 6, gsz = (nb + 7) >> 3, b0 = bg * gsz, b1 = (b0 + gsz) < nb ? (b0 + gsz) : nb;
        int t0 = 0, t1 = 0, t2 = 0, t3 = 0, q0 = 0, q1 = 0, q2 = 0, q3 = 0;
#pragma unroll 16
        for (int bb = b0; bb < b1; ++bb) {
            const u32x4 h = *(const u32x4*)(HIST + (size_t)bb * 256 + 4 * e4); const bool pre = bb < bid;
            t0 += (int)h[0]; t1 += (int)h[1]; t2 += (int)h[2]; t3 += (int)h[3];
            q0 += pre ? (int)h[0] : 0; q1 += pre ? (int)h[1] : 0; q2 += pre ? (int)h[2] : 0; q3 += pre ? (int)h[3] : 0;
        }
        int* pt = ptot + bg * 256 + 4 * e4; int* pq = ppre + bg * 256 + 4 * e4;
        pt[0] = t0; pt[1] = t1; pt[2] = t2; pt[3] = t3; pq[0] = q0; pq[1] = q1; pq[2] = q2; pq[3] = q3;
        __syncthreads();
        if (tid < 256) {
            int total = 0, pre = 0;
#pragma unroll
            for (int g = 0; g < 8; ++g) { total += ptot[g * 256 + tid]; pre += ppre[g * 256 + tid]; }
            tot[tid] = total; blkoff[tid] = pre; if (bid == 0) cnt[tid] = (unsigned)total;
        }
    }
    __syncthreads();
    if (tid < 64) {
        const int c0 = tot[4 * tid], c1 = tot[4 * tid + 1], c2 = tot[4 * tid + 2], c3 = tot[4 * tid + 3];
        const int so = c0 + c1 + c2 + c3; int io = so;
#pragma unroll
        for (int d = 1; d < 64; d <<= 1) { const int uo = __shfl_up(io, d); if (tid >= d) io += uo; }
        const int eo = io - so;
        off[4 * tid] = eo; off[4 * tid + 1] = eo + c0; off[4 * tid + 2] = eo + c0 + c1; off[4 * tid + 3] = eo + c0 + c1 + c2;
    }
    __syncthreads();
    const int* EID = (const int*)(p.ws + WS_EID); const int* POS = (const int*)(p.ws + WS_POS); const float* WGT = (const float*)(p.ws + WS_WGT);
    int* ST = (int*)(p.ws + WS_SLOTTOK); float* SW = (float*)(p.ws + WS_SLOTW); int* SOF = (int*)(p.ws + WS_SLOTOF);
    const int wave = tid >> 6, lane = tid & 63;
    for (int tok0 = bid * NW + wave; tok0 < MTOK; tok0 += 8 * nb * NW) {
        const int tok = tok0 + (lane >> 3) * nb * NW;
        if (tok < MTOK) {
            const int idx = tok * 8 + (lane & 7); const int e = EID[idx];
            const int slot = off[e] + blkoff[e] + POS[idx];
            ST[slot] = tok; SW[slot] = WGT[idx]; SOF[idx] = slot;
        }
    }
}

__device__ __forceinline__ int find_expert(const int* tp, int rt) {
    int lo = 0, hi = 256;
    while (lo < hi) { const int mid = (lo + hi + 1) >> 1; if (tp[mid] <= rt) lo = mid; else hi = mid - 1; }
    return lo;
}

__device__ __forceinline__ void phase7_mfma(const Params& p, int bid, int nb, LAS unsigned char* lds) {
    const unsigned char* H2b = p.ws + WS_H2B; const float* wr = p.in[23];
    float* LOG = (float*)(p.ws + WS_LOGITS);
    const XcdDeal dl = xcd_deal(64 * 2, lds, nb);
    const bf16_t* wrb = (const bf16_t*)(p.ws + WS_WRB);
    gemm_stream<false, 1, 0, false, true>(lds, H2b, dl.n, 16, 256,
        [&](int ps, int r) { const int u = dl.lo + ps * dl.step; return (size_t)((u >> 1) * 256 + r) * 2048; },
        [&](int ps, int n4) -> const bf16_t* { const int u = dl.lo + ps * dl.step; return wrb + (u & 1) * 128 + n4 * 4; },
        [&](int) { return 256; },
        [&](int ps, int r, int n, f32x4 v) { const int u = dl.lo + ps * dl.step; *(f32x4*)(LOG + (size_t)((u >> 1) * 256 + r) * 256 + (u & 1) * 128 + n) = v; });
}

#define ETAB_OFF 24576
#define EDESC_OFF (ETAB_OFF + 1024)
__device__ __forceinline__ int expert_passes(const Params& p, int bid, int nb, const LAS unsigned char* lds, float* smem, int nct, int& npass) {
    int* off = (int*)(smem + ETAB_OFF); int* tp = off + 272; int* desc = (int*)(smem + EDESC_OFF);
    expert_tables(p, off, tp, 8);
    const unsigned* cnt = (const unsigned*)(p.ws + WS_CTL) + CW_CNT;
    const XcdDeal dl = xcd_deal(tp[257] * nct, lds, nb);
    npass = dl.n;
    for (int ps = threadIdx.x; ps < npass; ps += NT) {
        const int u = dl.lo + ps * dl.step;
        const int e = find_expert(tp, u / nct);
        const int nte = tp[e + 1] - tp[e], v = u - tp[e] * nct, ct = v / nte, rtl = v - ct * nte;
        const int rows_e = e < 256 ? (int)cnt[e] : MTOK;
        const int r0 = rtl * 256;
        desc[ps * 4 + 0] = (e < 256 ? off[e] : NK) + r0;
        desc[ps * 4 + 1] = (rows_e - r0) < 256 ? (rows_e - r0) : 256;
        desc[ps * 4 + 2] = e; desc[ps * 4 + 3] = ct;
    }
    __syncthreads();
    return dl.lo;
}

__device__ __forceinline__ void phase10_mfma(const Params& p, int bid, int nb, LAS unsigned char* lds, float* smem) {
    int npass; expert_passes(p, bid, nb, lds, smem, 4, npass);
    const LAS int* desc = (const LAS int*)(lds + EDESC_OFF * 4);
    const unsigned char* H2b = p.ws + WS_H2B; const int* ST = (const int*)(p.ws + WS_SLOTTOK);
    bf16_t* HIDB = (bf16_t*)(p.ws + WS_HIDB);
    const float* W1g = p.in[25]; const float* W3g = p.in[26]; const float* W1s = p.in[28]; const float* W3s = p.in[29];
    const float* SW = (const float*)(p.ws + WS_SLOTW);
    gemm_stream_ws(lds, H2b, npass, 16, 256,
        [&](int ps, int r) { const int slot0 = desc[ps * 4], mr = desc[ps * 4 + 1]; const int rr = r < mr ? r : mr - 1; const int slot = slot0 + rr;
                             const int tok = slot < NK ? ST[slot] : slot - NK; return (size_t)tok * 2048; },
        [&](int ps, int n4) -> const float* { const int e = desc[ps * 4 + 2], hc0 = desc[ps * 4 + 3] * 64; const int n = n4 * 4;
                             const int hc = hc0 + (n >> 6) * 32 + ((n >> 2) & 3) * 8 + ((n >> 4) & 1) * 4;
                             const float* W = ((n >> 5) & 1) ? (e < 256 ? W3g + (size_t)e * 262144 : W3s) : (e < 256 ? W1g + (size_t)e * 262144 : W1s); return W + hc; },
        [&](int ps) { return desc[ps * 4 + 1]; },
        [&](int ps, int rbase, int nbase, int mr, f32x4 (&acc)[8][4]) {
            const int slot0 = desc[ps * 4] + rbase, hc = desc[ps * 4 + 3] * 64 + (nbase >> 6) * 32 + ((nbase >> 2) & 3) * 8;
            float wv[8];
#pragma unroll
            for (int mi = 0; mi < 8; ++mi) { const int slot = slot0 + mi * 16; const float wl = SW[slot < NK ? slot : 0]; wv[mi] = slot < NK ? wl : 1.f; }
#pragma unroll
            for (int mi = 0; mi < 8; ++mi) {
                if (rbase + mi * 16 < mr) {
                    float h[8];
#pragma unroll
                    for (int ni = 0; ni < 2; ++ni) {
                        const f32x4 a = acc[mi][ni], bq = acc[mi][ni + 2];
#pragma unroll
                        for (int jj = 0; jj < 4; ++jj) h[ni * 4 + jj] = a[jj] * __builtin_amdgcn_rcpf(1.f + ex2(-a[jj] * LOG2E)) * bq[jj] * wv[mi];
                    }
                    u32x4 w; w[0] = pk_bf16(h[0], h[1]); w[1] = pk_bf16(h[2], h[3]); w[2] = pk_bf16(h[4], h[5]); w[3] = pk_bf16(h[6], h[7]);
                    *(u32x4*)(HIDB + (size_t)(slot0 + mi * 16) * 256 + hc) = w;
                }
            } });
}

__device__ __forceinline__ void phase11_mfma(const Params& p, int bid, int nb, LAS unsigned char* lds, float* smem) {
    int npass; expert_passes(p, bid, nb, lds, smem, 8, npass);
    const LAS int* desc = (const LAS int*)(lds + EDESC_OFF * 4);
    const unsigned char* HIDB = p.ws + WS_HIDB; const float* SW = (const float*)(p.ws + WS_SLOTW);
    bf16_t* SO = (bf16_t*)(p.ws + WS_SLOTOUT);
    const float* W2g = p.in[27]; const float* W2s = p.in[30];
    gemm_stream_ws(lds, HIDB, npass, 4, 1024,
        [&](int ps, int r) { const int slot0 = desc[ps * 4], mr = desc[ps * 4 + 1]; const int rr = r < mr ? r : mr - 1; return (size_t)(slot0 + rr) * 512; },
        [&](int ps, int n4) -> const float* { const int e = desc[ps * 4 + 2], n0 = desc[ps * 4 + 3] * 128; const int src4 = (n4 & ~7) + 2 * (n4 & 3) + ((n4 >> 2) & 1);
                                              return (e < 256 ? W2g + (size_t)e * 262144 : W2s) + n0 + src4 * 4; },
        [&](int ps) { return desc[ps * 4 + 1]; },
        [&](int ps, int rbase, int nbase, int mr, f32x4 (&acc)[8][4]) {
            const int slot0 = desc[ps * 4] + rbase, c0 = desc[ps * 4 + 3] * 128 + (nbase >> 6) * 64 + ((nbase >> 2) & 3) * 8;
#pragma unroll
            for (int mi = 0; mi < 8; ++mi) {
                if (rbase + mi * 16 < mr) {
                    bf16_t* op = SO + (size_t)(slot0 + mi * 16) * 1024 + c0;
#pragma unroll
                    for (int np = 0; np < 2; ++np) {
                        const f32x4 v0 = acc[mi][2 * np], v1 = acc[mi][2 * np + 1];
                        u32x4 o; o[0] = pk_bf16(v0[0], v0[1]); o[1] = pk_bf16(v0[2], v0[3]); o[2] = pk_bf16(v1[0], v1[1]); o[3] = pk_bf16(v1[2], v1[3]);
                        *(u32x4*)(op + np * 32) = o;
                    }
                }
            } });
}

__device__ __forceinline__ void phase12_mfma(const Params& p, int bid, int nb) {
    const bf16_t* X1 = (const bf16_t*)(p.ws + WS_X1); const bf16_t* SO = (const bf16_t*)(p.ws + WS_SLOTOUT); const int* SOF = (const int*)(p.ws + WS_SLOTOF);
    const float* mod = (const float*)(p.ws + WS_MOD); const float* fw = p.in[31];
    int tid_ = threadIdx.x; asm volatile("" : "+v"(tid_));
    const int wave = tid_ >> 6, lane = tid_ & 63;
    const int RS = nb * NW;
    f32x4 wv[4];
#pragma unroll
    for (int i4 = 0; i4 < 4; ++i4) wv[i4] = *(const f32x4*)(fw + lane * 16 + i4 * 4);
    for (int row0 = bid * NW + wave; row0 < MTOK; row0 += 2 * RS) {
        int slots[2];
#pragma unroll
        for (int k = 0; k < 2; ++k) { const int row = row0 + k * RS; const int rc = row < MTOK ? row : row0; slots[k] = lane < 8 ? SOF[rc * 8 + lane] : NK + rc; }
        u32x4 w0[2][9], w1[2][9], xa[2], xb[2];
#pragma unroll
        for (int k = 0; k < 2; ++k) {
            const int row = row0 + k * RS; const int rc = row < MTOK ? row : row0;
#pragma unroll
            for (int q = 0; q < 9; ++q) {
                const int slot = __builtin_amdgcn_readlane(slots[k], q);
                const u32x4* rp = (const u32x4*)(SO + (size_t)slot * 1024 + lane * 16);
                w0[k][q] = rp[0]; w1[k][q] = rp[1];
            }
            const u32x4* xp = (const u32x4*)(X1 + (size_t)rc * 1024 + lane * 16);
            xa[k] = xp[0]; xb[k] = xp[1];
        }
#pragma unroll
        for (int k = 0; k < 2; ++k) {
            const int row = row0 + k * RS;
            if (row < MTOK) {
                const int b = row >> 13;
                float acc[16];
#pragma unroll
                for (int i = 0; i < 16; ++i) acc[i] = 0.f;
#pragma unroll
                for (int q = 0; q < 9; ++q) {
#pragma unroll
                    for (int j = 0; j < 4; ++j) {
                        acc[2 * j] += __uint_as_float(w0[k][q][j] << 16); acc[2 * j + 1] += __uint_as_float(w0[k][q][j] & 0xffff0000u);
                        acc[8 + 2 * j] += __uint_as_float(w1[k][q][j] << 16); acc[8 + 2 * j + 1] += __uint_as_float(w1[k][q][j] & 0xffff0000u);
                    }
                }
                float xv[16];
#pragma unroll
                for (int j = 0; j < 4; ++j) { xv[2 * j] = __uint_as_float(xa[k][j] << 16); xv[2 * j + 1] = __uint_as_float(xa[k][j] & 0xffff0000u);
                                              xv[8 + 2 * j] = __uint_as_float(xb[k][j] << 16); xv[8 + 2 * j + 1] = __uint_as_float(xb[k][j] & 0xffff0000u); }
                float v[16]; float ss = 0.f;
#pragma unroll
                for (int i4 = 0; i4 < 4; ++i4) {
                    const f32x4 gv = *(const f32x4*)(mod + b * 6144 + 5120 + lane * 16 + i4 * 4);
#pragma unroll
                    for (int j = 0; j < 4; ++j) { v[i4 * 4 + j] = xv[i4 * 4 + j] + gv[j] * acc[i4 * 4 + j]; ss += v[i4 * 4 + j] * v[i4 * 4 + j]; }
                }
                ss = wave_sum(ss);
                const float rstd = __builtin_amdgcn_rsqf(ss * (1.f / 1024.f) + 1e-6f);
#pragma unroll
                for (int i4 = 0; i4 < 4; ++i4) {
                    f32x4 o;
#pragma unroll
                    for (int j = 0; j < 4; ++j) o[j] = v[i4 * 4 + j] * rstd * wv[i4][j];
                    *(f32x4*)(p.out + (size_t)row * 1024 + lane * 16 + i4 * 4) = o;
                }
            }
        }
    }
}

__global__ void __launch_bounds__(NT, 2) k_fused(Params p) {
    extern __shared__ __attribute__((aligned(16))) unsigned char lds_raw[];
    LAS unsigned char* lds = (LAS unsigned char*)lds_raw;
    float* smem = (float*)lds_raw;
    if (threadIdx.x == 0) { *(LAS u32x4*)(lds + LDS_MISC) = (u32x4){0u, 0u, 0u, 0u}; }
    __syncthreads();
    XcdBarrier bar = xcd_barrier_post((unsigned*)(p.ws + WS_CTL), (volatile LAS unsigned*)(lds + LDS_MISC));
    if (threadIdx.x == 0) ((LAS int*)(lds + TOPO_OFF))[2] = (int)xb_add((unsigned*)(p.ws + WS_CTL) + CW_RANK + 64 * bar.x, 1u);
    const int bid = blockIdx.x, nb = gridDim.x;
#define PH(stmt) { stmt; xcd_barrier(bar); }
#define PHR(bit, stmt) { stmt; xcd_barrier(bar); if (REP & (bit)) { stmt; xcd_barrier(bar); } }
    PHR(8192, phase0(p, bid, nb, smem, lds))
    if (threadIdx.x == 0) {
        int pre = 0, mine = 0;
        for (unsigned j = 0; j < 16; ++j) { const int c = (int)xb_ld((unsigned*)(p.ws + WS_CTL) + XB_XCNT(j)); if (j < bar.x) pre += c; if (j == bar.x) mine = c; }
        ((LAS int*)(lds + TOPO_OFF))[0] = pre; ((LAS int*)(lds + TOPO_OFF))[1] = mine > 0 ? mine : 1;
    }
    __syncthreads();
    PHR(128, phase_modnorm<false>(p, bid, nb, p.in[0], p.in[4], 0, 1024, (bf16_t*)(p.ws + WS_H1B)))
    PHR(1, phase2_e(p, bid, nb, lds))
    PHR(2, phase3_mfma(p, bid, nb, lds))
    PHR(4, phase3b_new(p, bid, nb, smem))
    PH(phase4_mfma(p.ws, bid, nb, lds))
    PHR(8, phase4b_new(p, bid, nb, smem))
    PHR(512, phase5_e(p, bid, nb, lds))
    PHR(16384, phase_modnorm<true>(p, bid, nb, p.ws + WS_X1, p.in[22], 3072, 4096, (bf16_t*)(p.ws + WS_H2B)))
    PHR(1024, phase7_mfma(p, bid, nb, lds))
    PH(phase8(p, bid, nb, smem))
    PH(phase9(p, bid, nb, smem))
    if (REP & 256) { PH(phase8(p, bid, nb, smem)) PH(phase9(p, bid, nb, smem)) }
    PHR(16, phase10_mfma(p, bid, nb, lds, smem))
    PHR(32, phase11_mfma(p, bid, nb, lds, smem))
    phase12_mfma(p, bid, nb);
    if (REP & 2048) { xcd_barrier(bar); phase12_mfma(p, bid, nb); }
    if (REP & 4096) { for (int i = 0; i < 20; ++i) xcd_barrier(bar); }
#undef PH
#undef PHR
}

extern "C" void kernel_launch(void* const* d_in, const int* in_sizes, int n_in, void* d_out, int out_size, void* d_ws, size_t ws_size, hipStream_t stream) {
    static int grid = 0;
    if (!grid) {
        int dev = 0, cus = 0;
        (void)hipGetDevice(&dev);
        (void)hipDeviceGetAttribute(&cus, hipDeviceAttributeMultiprocessorCount, dev);
        (void)hipFuncSetAttribute((const void*)k_fused, hipFuncAttributeMaxDynamicSharedMemorySize, LDS_BYTES);
        if (cus < 1) cus = 256;
        grid = cus;
    }
    Params p{};
    for (int i = 0; i < 32; ++i) p.in[i] = (const float*)d_in[i];
    p.out = (float*)d_out; p.ws = (unsigned char*)d_ws;
    (void)hipMemsetAsync((char*)d_ws + WS_CTL, 0, CTL_BYTES, stream);
    hipLaunchKernelGGL(k_fused, dim3(grid), dim3(NT), LDS_BYTES, stream, p);
}
```

```cpp
#include <hip/hip_runtime.h>
#include <stdint.h>
#include <type_traits>


#define MTOK 16384
#define SEQ 8192
#define SEQP 8195
#define DM 1024
#define NCOLS 2328
#define COL_KC 512
#define COL_KS 768
#define COL_VS 896
#define COL_KW 1024
#define COL_VW 1152
#define COL_G 1280
#define COL_XR 1304
#define COL_GR 1816
#define NCMP 511
#define NEXP 256
#define NK 131072

#define MiB (1048576ull)
#define WS_CTL 0ull
#define CTL_BYTES (1 * MiB)
#define CW_CNT 8192
#define CW_RANK 12288
#define WS_MOD (1 * MiB)
#define WS_LUT (1 * MiB + 65536)
#define WS_KC (2 * MiB)
#define WS_VC (3 * MiB)
#define WS_AEND (4 * MiB)
#define WS_HEND (5 * MiB)
#define WS_EID (6 * MiB)
#define WS_POS (7 * MiB)
#define WS_WGT (8 * MiB)
#define WS_SLOTTOK (9 * MiB)
#define WS_SLOTW (10 * MiB)
#define WS_CARRY (11 * MiB)
#define WS_SLOTOF (12 * MiB)
#define WS_HIST (13 * MiB)
#define WS_LOGITS (16 * MiB)
#define WS_H1 (32 * MiB)
#define WS_PROJ (96 * MiB)
#define WS_HL (256 * MiB)
#define WS_AP (288 * MiB)
#define WS_ACC (320 * MiB)
#define WS_HID (384 * MiB)
#define WS_Y (528 * MiB)
#define WS_H2 (592 * MiB)
#define WS_X1 (656 * MiB)
#define WS_H1B (720 * MiB)
#define WS_YB (752 * MiB)
#define WS_H2B (784 * MiB)
#define WS_HIDB (816 * MiB)
#define WS_QB (896 * MiB)
#define WS_KV6 (912 * MiB)
#define WS_GATE (936 * MiB)
#define WS_KCB (938 * MiB)
#define WS_VCB (939 * MiB)
#define WS_OATT (940 * MiB)
#define WS_BG (14 * MiB)
#define WS_GBIAS (15 * MiB)
#define WS_CBIAS (15 * MiB + 8192)
#define WS_XRB (972 * MiB)
#define WS_GRG (990 * MiB)
#define WS_CPART (96 * MiB)
#define WS_ALRU (256 * MiB)
#define WS_ULRU (288 * MiB)
#define WS_WINB (1012 * MiB)
#define WS_WOUTB (1017 * MiB)
#define WS_WRB (1020 * MiB)
#define WS_WINT (1012 * MiB)
#define WS_WOUTT (1017 * MiB)
#define WS_WRT (1019 * MiB)
#define WS_SLOTOUT (32 * MiB)

#ifndef REP
#define REP 0
#endif
#ifndef USE_MFMA
#define USE_MFMA 31
#endif

struct Params {
    const float* in[32];
    float* out;
    unsigned char* ws;
};

#define NT 512
#define NW 8
#define LDS_BYTES 151552
#define LDS_MISC 131072
#define INF __builtin_huge_valf()
#define LOG2E 1.4426950408889634f

__device__ __forceinline__ float wave_sum(float v) {
#define WS_DPP(ctrl, rmask) __builtin_bit_cast(float, __builtin_amdgcn_update_dpp(0, __builtin_bit_cast(int, v), (ctrl), (rmask), 0xf, true))
    v += WS_DPP(0x111, 0xf);
    v += WS_DPP(0x112, 0xf);
    v += WS_DPP(0x114, 0xf);
    v += WS_DPP(0x118, 0xf);
    v += WS_DPP(0x142, 0xa);
    v += WS_DPP(0x143, 0xc);
#undef WS_DPP
    return __builtin_bit_cast(float, __builtin_amdgcn_readlane(__builtin_bit_cast(int, v), 63));
}
__device__ __forceinline__ float wave_max(float v) {
#pragma unroll
    for (int o = 32; o; o >>= 1) v = fmaxf(v, __shfl_xor(v, o));
    return v;
}
__device__ __forceinline__ float wave_max_f(float v) {
#define WM_DPP(ctrl, rmask) __builtin_bit_cast(float, __builtin_amdgcn_update_dpp(__builtin_bit_cast(int, -INF), __builtin_bit_cast(int, v), (ctrl), (rmask), 0xf, false))
    v = fmaxf(v, WM_DPP(0x111, 0xf)); v = fmaxf(v, WM_DPP(0x112, 0xf)); v = fmaxf(v, WM_DPP(0x114, 0xf)); v = fmaxf(v, WM_DPP(0x118, 0xf));
    v = fmaxf(v, WM_DPP(0x142, 0xa)); v = fmaxf(v, WM_DPP(0x143, 0xc));
#undef WM_DPP
    return __builtin_bit_cast(float, __builtin_amdgcn_readlane(__builtin_bit_cast(int, v), 63));
}
__device__ __forceinline__ int wave_min_i(int v) {
#define WM_DPP(ctrl, rmask) __builtin_amdgcn_update_dpp(0x7fffffff, v, (ctrl), (rmask), 0xf, false)
    v = min(v, WM_DPP(0x111, 0xf)); v = min(v, WM_DPP(0x112, 0xf)); v = min(v, WM_DPP(0x114, 0xf)); v = min(v, WM_DPP(0x118, 0xf));
    v = min(v, WM_DPP(0x142, 0xa)); v = min(v, WM_DPP(0x143, 0xc));
#undef WM_DPP
    return __builtin_amdgcn_readlane(v, 63);
}
__device__ __forceinline__ float half_top2_sum(float v) {
    float m1 = v, m2 = -INF;
#define T2_STEP(ctrl, rmask) { const float p1 = __builtin_bit_cast(float, __builtin_amdgcn_update_dpp(__builtin_bit_cast(int, -INF), __builtin_bit_cast(int, m1), (ctrl), (rmask), 0xf, false)); \
                               const float p2 = __builtin_bit_cast(float, __builtin_amdgcn_update_dpp(__builtin_bit_cast(int, -INF), __builtin_bit_cast(int, m2), (ctrl), (rmask), 0xf, false)); \
                               const float n2 = fmaxf(fminf(m1, p1), fmaxf(m2, p2)); m1 = fmaxf(m1, p1); m2 = n2; }
    T2_STEP(0x111, 0xf) T2_STEP(0x112, 0xf) T2_STEP(0x114, 0xf) T2_STEP(0x118, 0xf) T2_STEP(0x142, 0xa)
#undef T2_STEP
    return m1 + m2;
}
__device__ __forceinline__ float sigm(float x) { return __builtin_amdgcn_rcpf(1.f + __builtin_amdgcn_exp2f(-1.4426950408889634f * x)); }
__device__ __forceinline__ float tanh_fast(float x) { return 1.f - 2.f * __builtin_amdgcn_rcpf(1.f + __builtin_amdgcn_exp2f(2.8853900817779268f * x)); }
__device__ __forceinline__ float gelu_t(float x) { return 0.5f * x * (1.f + tanh_fast(0.7978845608028654f * (x + 0.044715f * x * x * x))); }
__device__ __forceinline__ float softplus_(float z) { return fmaxf(z, 0.f) + log1pf(expf(-fabsf(z))); }


#define XB_TMO      128
#define XB_XCNT(j)  (256  + 64 * (j))
#define XB_XSUB(j)  (1280 + 64 * (j))
#define XB_XGEN(j)  (2304 + 64 * (j))
#define XB_TOP      3328
#define XB_TOPGEN   3392
#define XCD_BAR_WORDS 3456
#define XB_SPIN_CAP (1u << 18)
#define LAS __attribute__((address_space(3)))

__device__ __forceinline__ unsigned xb_ld(unsigned* p)              { return __hip_atomic_load(p, __ATOMIC_RELAXED, __HIP_MEMORY_SCOPE_AGENT); }
__device__ __forceinline__ unsigned xb_add(unsigned* p, unsigned v) { return __hip_atomic_fetch_add(p, v, __ATOMIC_RELAXED, __HIP_MEMORY_SCOPE_AGENT); }
__device__ __forceinline__ unsigned xb_xcc_id() { return (unsigned)__builtin_amdgcn_s_getreg((3 << 11) | 20) & 0xFu; }
#define XB_SPIN(cond, bar) do { unsigned _sp = 0; while (cond) { __builtin_amdgcn_s_sleep(1); \
    if ((++_sp & 255u) == 0u) { if (xb_ld(&(bar)[XB_TMO])) break; if (_sp > XB_SPIN_CAP) { atomicAdd(&(bar)[XB_TMO], 1u); break; } } } } while (0)

struct XcdBarrier {
    unsigned* bar; unsigned x;
    volatile LAS unsigned* st;
};
__device__ __forceinline__ XcdBarrier xcd_barrier_post(unsigned* bar, volatile LAS unsigned* st) {
    XcdBarrier b; b.bar = bar; b.x = xb_xcc_id(); b.st = st;
    if (threadIdx.x == 0) (void)xb_add(&bar[XB_XCNT(b.x)], 1u);
    return b;
}
__device__ __forceinline__ void xcd_barrier_complete(unsigned* bar, unsigned x, unsigned& nloc, unsigned& nx) {
    const unsigned G = gridDim.x * gridDim.y * gridDim.z;
    unsigned sum, cnt, mine, sp = 0u;
    for (;;) {
        sum = 0u; cnt = 0u; mine = 0u;
#pragma unroll
        for (unsigned j = 0; j < 16; ++j) { const unsigned c = xb_ld(&bar[XB_XCNT(j)]); sum += c; cnt += (c > 0u) ? 1u : 0u; mine = (j == x) ? c : mine; }
        if (sum == G) break;
        __builtin_amdgcn_s_sleep(1);
        if ((++sp & 255u) == 0u) { if (xb_ld(&bar[XB_TMO])) break; if (sp > XB_SPIN_CAP) { atomicAdd(&bar[XB_TMO], 1u); break; } }
    }
    nloc = mine > 0u ? mine : 1u; nx = cnt > 0u ? cnt : 1u;
}
__device__ __forceinline__ void xcd_barrier(const XcdBarrier& b) {
    asm volatile("s_waitcnt vmcnt(0)" ::: "memory");
    __syncthreads();
    if (threadIdx.x == 0) {
        unsigned* bar = b.bar;
        __builtin_amdgcn_s_waitcnt(0);
        unsigned nloc = b.st[0], nx = b.st[1];
        if (nloc == 0u) { xcd_barrier_complete(bar, b.x, nloc, nx); b.st[0] = nloc; b.st[1] = nx; }
        const unsigned old = xb_add(&bar[XB_XSUB(b.x)], 1u);
        const unsigned gen = old / nloc;
        if (old + 1u == (gen + 1u) * nloc) {
            __builtin_amdgcn_fence(__ATOMIC_RELEASE, "agent");
            asm volatile("s_waitcnt vmcnt(0)" ::: "memory");
            const unsigned og = xb_add(&bar[XB_TOP], 1u);
            const unsigned tg = og / nx;
            if (og + 1u == (tg + 1u) * nx) xb_add(&bar[XB_TOPGEN], 1u);
            else XB_SPIN(xb_ld(&bar[XB_TOPGEN]) == tg, bar);
            __builtin_amdgcn_fence(__ATOMIC_ACQUIRE, "agent");
            xb_add(&bar[XB_XGEN(b.x)], 1u);
            asm volatile("s_waitcnt vmcnt(0)" ::: "memory");
        } else {
            XB_SPIN(xb_ld(&bar[XB_XGEN(b.x)]) == gen, bar);
            __builtin_amdgcn_fence(__ATOMIC_ACQUIRE, "agent");
            asm volatile("s_waitcnt vmcnt(0)" ::: "memory");
        }
    }
    __syncthreads();
}

typedef short bf16x8 __attribute__((ext_vector_type(8)));
typedef short s16x4 __attribute__((ext_vector_type(4)));
typedef short v4i16_t __attribute__((ext_vector_type(4)));
typedef float f32x4 __attribute__((ext_vector_type(4)));
typedef float f32x2 __attribute__((ext_vector_type(2)));
typedef __bf16 bf16x2_t __attribute__((ext_vector_type(2)));
typedef unsigned short bf16_t;
typedef unsigned u32x2 __attribute__((ext_vector_type(2)));
typedef unsigned u32x4 __attribute__((ext_vector_type(4)));
__device__ __forceinline__ unsigned pk_bf16(float lo, float hi) { return __builtin_bit_cast(unsigned, __builtin_convertvector((f32x2){lo, hi}, bf16x2_t)); }
__device__ __forceinline__ float bf2f(bf16_t v) { return __uint_as_float(((unsigned)v) << 16); }

__device__ __forceinline__ f32x4 bf4_f32(u32x2 w) { f32x4 r; r[0] = __uint_as_float(w.x << 16); r[1] = __uint_as_float(w.x & 0xffff0000u); r[2] = __uint_as_float(w.y << 16); r[3] = __uint_as_float(w.y & 0xffff0000u); return r; }
__device__ __forceinline__ s16x4 tr_read(LAS unsigned char* pa) { s16x4 r; asm volatile("ds_read_b64_tr_b16 %0, %1" : "=v"(r) : "v"(pa) : "memory"); return r; }
#define TR_WAIT8(a0, a1, a2, a3, a4, a5, a6, a7) asm volatile("s_waitcnt lgkmcnt(0)" : "+v"(a0), "+v"(a1), "+v"(a2), "+v"(a3), "+v"(a4), "+v"(a5), "+v"(a6), "+v"(a7) :: "memory")

#define GEMM_LDS_A 0
#define GEMM_LDS_B 65536
template <bool PAIR, int DEPTH, int MODE = 0, bool TILE_EPI = false, bool BBF16 = false, class ARow, class BCol, class MRows, class Epi>
__device__ __forceinline__ void gemm_stream(LAS unsigned char* lds, const unsigned char* Abase, int npass, int nk, int ldb, ARow arow, BCol bcol, MRows mrowsf, Epi epi) {
    int tid_ = threadIdx.x; asm volatile("" : "+v"(tid_));
    const int tid = tid_, wid = __builtin_amdgcn_readfirstlane(tid >> 6), lane = tid & 63;
    const int wr = wid >> 1, wc = wid & 1, fr = lane & 15, fq = lane >> 4;
    if (npass <= 0) return;
    const int S = npass * nk;
    const int Ccol = ((wid & 1) * 32 + 8 * ((lane & 3) ^ ((lane >> 5) << 1))) * 2;
    const int Rbase = 16 * (wid >> 1) + (lane >> 2);
    unsigned asrc[4];
    const int n4 = tid & 31, kb = tid >> 5;
    typedef typename std::conditional<BBF16, const bf16_t*, const float*>::type bptr_t;
    bptr_t bp;
    const int fB = ((kb & 3) << 2) | ((kb >> 2) & 3);
    const int bwoff = 256 * kb + 16 * ((n4 >> 1) ^ fB) + 8 * (n4 & 1);
    const int aoff = wr * 8192 + ((fr * 64 + fq * 16) ^ ((fr >> 3) << 5));
    const int q = (lane >> 2) & 3, pp = lane & 3;
    const int b0 = (wc * 8 + (pp >> 1)) ^ ((q << 2) | (2 * (fq & 1)));
    const int browoff = 256 * (fq * 8 + q) + 8 * (pp & 1);
#define GS_BOFF(v) (browoff + 16 * (b0 ^ (v)))
    f32x4 acc[4][4];
#pragma unroll
    for (int i = 0; i < 4; ++i)
#pragma unroll
        for (int j = 0; j < 4; ++j) acc[i][j] = (f32x4){0.f, 0.f, 0.f, 0.f};
    float4 bregX[4], bregY[4];
    int aP = 0, aK = 0, bP = 0, bK = 0;
#define GS_SETA() do { _Pragma("unroll") for (int _i = 0; _i < 4; ++_i) asrc[_i] = (unsigned)(arow(aP, Rbase + 64 * _i) + Ccol); } while (0)
#define GS_ISSUE_A(buf) do { _Pragma("unroll") for (int _i = 0; _i < 4; ++_i) \
        __builtin_amdgcn_global_load_lds((const unsigned*)(Abase + (size_t)asrc[_i] + (size_t)aK * 128), (LAS unsigned*)(lds + GEMM_LDS_A + (buf) * 32768 + _i * 8192 + wid * 1024), 16, 0, 0); \
        if (++aK == nk) { aK = 0; ++aP; if (aP < npass) GS_SETA(); } } while (0)
#define GS_LOAD_B(breg) do { _Pragma("unroll") for (int _i = 0; _i < 4; ++_i) { \
            if constexpr (BBF16) { const u32x2 _t = *(const u32x2*)(bp + (size_t)(bK * 64 + kb + 16 * _i) * ldb); breg[_i].x = __uint_as_float(_t.x); breg[_i].y = __uint_as_float(_t.y); } \
            else breg[_i] = *(const float4*)(bp + (size_t)(bK * 64 + kb + 16 * _i) * ldb); } \
        if (++bK == nk) { bK = 0; ++bP; if (bP < npass) bp = bcol(bP, n4); } } while (0)
#define GS_WRITE_B(breg, buf) do { _Pragma("unroll") for (int _i = 0; _i < 4; ++_i) { u32x2 _w; \
            if constexpr (BBF16) { _w.x = __float_as_uint(breg[_i].x); _w.y = __float_as_uint(breg[_i].y); } \
            else { _w.x = pk_bf16(breg[_i].x, breg[_i].y); _w.y = pk_bf16(breg[_i].z, breg[_i].w); } \
        *(LAS u32x2*)(lds + GEMM_LDS_B + (buf) * 16384 + bwoff + 4096 * _i) = _w; } } while (0)
#define GS_COMPUTE(buf) do { _Pragma("unroll") for (int ks = 0; ks < 2; ++ks) { \
            bf16x8 af[4]; s16x4 tl0, tl1, tl2, tl3, th0, th1, th2, th3; \
            LAS unsigned char* bb_ = lds + GEMM_LDS_B + (buf) * 16384 + ks * 8192; \
            tl0 = tr_read(bb_ + GS_BOFF(0)); th0 = tr_read(bb_ + 1024 + GS_BOFF(1)); tl1 = tr_read(bb_ + GS_BOFF(2)); th1 = tr_read(bb_ + 1024 + GS_BOFF(3)); \
            tl2 = tr_read(bb_ + GS_BOFF(4)); th2 = tr_read(bb_ + 1024 + GS_BOFF(5)); tl3 = tr_read(bb_ + GS_BOFF(6)); th3 = tr_read(bb_ + 1024 + GS_BOFF(7)); \
            _Pragma("unroll") for (int mi = 0; mi < 4; ++mi) af[mi] = *(const LAS bf16x8*)(lds + GEMM_LDS_A + (buf) * 32768 + aoff + mi * 2048 + ks * 1024); \
            TR_WAIT8(tl0, th0, tl1, th1, tl2, th2, tl3, th3); \
            bf16x8 bfr[4]; \
            bfr[0] = (bf16x8){tl0[0], tl0[1], tl0[2], tl0[3], th0[0], th0[1], th0[2], th0[3]}; bfr[1] = (bf16x8){tl1[0], tl1[1], tl1[2], tl1[3], th1[0], th1[1], th1[2], th1[3]}; \
            bfr[2] = (bf16x8){tl2[0], tl2[1], tl2[2], tl2[3], th2[0], th2[1], th2[2], th2[3]}; bfr[3] = (bf16x8){tl3[0], tl3[1], tl3[2], tl3[3], th3[0], th3[1], th3[2], th3[3]}; \
            _Pragma("unroll") for (int mi = 0; mi < 4; ++mi) _Pragma("unroll") for (int ni = 0; ni < 4; ++ni) \
                acc[mi][ni] = __builtin_amdgcn_mfma_f32_16x16x32_bf16(bfr[ni], af[mi], acc[mi][ni], 0, 0, 0); } } while (0)
#define GS_STEP(CUR, NXT, BREG_LD, BREG_WR) do { \
        if (MODE != 2 && s + DEPTH < S) GS_LOAD_B(BREG_LD); \
        if (MODE != 3 && s + 1 < S) GS_ISSUE_A(NXT); \
        __builtin_amdgcn_sched_barrier(0); \
        if (MODE != 1 && active) GS_COMPUTE(CUR); \
        __builtin_amdgcn_sched_barrier(0); \
        if (s + 1 < S) GS_WRITE_B(BREG_WR, NXT); \
        const bool pass_end = (cK + 1 == nk); \
        if (++cK == nk) { \
            if constexpr (TILE_EPI) { if (active) epi(cP, wr * 64 + fr, wc * 64 + fq * 4, cm, acc); } else \
            if (active) { \
                _Pragma("unroll") for (int mi = 0; mi < 4; ++mi) { const int r = wr * 64 + mi * 16 + fr; \
                    if (r < cm) { \
                        if constexpr (PAIR) { _Pragma("unroll") for (int ni = 0; ni < 2; ++ni) { epi(cP, r, wc * 64 + ni * 16 + fq * 4, acc[mi][ni], acc[mi][ni + 2]); } } \
                        else { _Pragma("unroll") for (int ni = 0; ni < 4; ++ni) { epi(cP, r, wc * 64 + ni * 16 + fq * 4, acc[mi][ni]); } } } } } \
            _Pragma("unroll") for (int i = 0; i < 4; ++i) _Pragma("unroll") for (int j = 0; j < 4; ++j) acc[i][j] = (f32x4){0.f, 0.f, 0.f, 0.f}; \
            cK = 0; ++cP; if (cP < npass) { cm = mrowsf(cP); active = (wr * 64) < cm; } \
        } \
        asm volatile("s_waitcnt lgkmcnt(0)" ::: "memory"); \
        if (DEPTH >= 2 && (s + DEPTH < S) && !pass_end) asm volatile("s_waitcnt vmcnt(4)" ::: "memory"); else asm volatile("s_waitcnt vmcnt(0)" ::: "memory"); \
        asm volatile("" ::: "memory"); __builtin_amdgcn_s_barrier(); asm volatile("" ::: "memory"); ++s; } while (0)
    int cP = 0, cK = 0, cm = mrowsf(0);
    bool active = (wr * 64) < cm;
    GS_SETA(); bp = bcol(0, n4);
    GS_ISSUE_A(0); GS_LOAD_B(bregX);
    GS_WRITE_B(bregX, 0);
    if constexpr (DEPTH >= 2) { if (1 < S) GS_LOAD_B(bregY); }
    static_assert(DEPTH == 1 || DEPTH == 2, "B prefetch depth");
    asm volatile("s_waitcnt lgkmcnt(0)" ::: "memory");
    asm volatile("s_waitcnt vmcnt(%0)" :: "n"((DEPTH - 1) * 4) : "memory");
    __syncthreads();
    int s = 0;
    if constexpr (DEPTH == 1) {
        while (s < S) { GS_STEP(0, 1, bregX, bregX); if (s >= S) break; GS_STEP(1, 0, bregX, bregX); }
    } else if constexpr (DEPTH == 2) {
        while (s < S) { GS_STEP(0, 1, bregX, bregY); if (s >= S) break; GS_STEP(1, 0, bregY, bregX); }
    }
#undef GS_SETA
#undef GS_BOFF
#undef GS_ISSUE_A
#undef GS_LOAD_B
#undef GS_WRITE_B
#undef GS_COMPUTE
#undef GS_STEP
}


template <class ARow, class BCol, class MRows, class Epi>
__device__ __forceinline__ void gemm_stream_rs(LAS unsigned char* lds, const unsigned char* Abase, int npass, int nk, int ldb, ARow arow, BCol bcol, MRows mrowsf, Epi epi) {
    int tid_ = threadIdx.x; asm volatile("" : "+v"(tid_));
    const int tid = tid_, wid = __builtin_amdgcn_readfirstlane(tid >> 6), lane = tid & 63;
    const int wr = wid >> 1, wc = wid & 1, fr = lane & 15, fq = lane >> 4;
    if (npass <= 0) return;
    const int S = npass * nk;
    const int Ccol = ((wid & 1) * 32 + 8 * ((lane & 3) ^ ((lane >> 5) << 1))) * 2;
    const int Rbase = 16 * (wid >> 1) + (lane >> 2);
    unsigned asrc[4];
    const int n4 = tid & 31, kb = tid >> 5;
    const float* bp;
    const int fB = ((kb & 3) << 2) | ((kb >> 2) & 3);
    const int bwoff = 256 * kb + 16 * ((n4 >> 1) ^ fB) + 8 * (n4 & 1);
    const int awoff = wid * 1024 + lane * 16;
    const int aoff = wr * 8192 + ((fr * 64 + fq * 16) ^ ((fr >> 3) << 5));
    const int q = (lane >> 2) & 3, pp = lane & 3;
    const int b0 = (wc * 8 + (pp >> 1)) ^ ((q << 2) | (2 * (fq & 1)));
    const int browoff = 256 * (fq * 8 + q) + 8 * (pp & 1);
#define RS_BOFF(v) (browoff + 16 * (b0 ^ (v)))
    f32x4 acc[4][4];
#pragma unroll
    for (int i = 0; i < 4; ++i)
#pragma unroll
        for (int j = 0; j < 4; ++j) acc[i][j] = (f32x4){0.f, 0.f, 0.f, 0.f};
    f32x4 bX[4], bY[4]; u32x4 aX[4], aY[4];
    int aP = 0, aK = 0, bP = 0, bK = 0;
#define RS_SETA() do { _Pragma("unroll") for (int _i = 0; _i < 4; ++_i) asrc[_i] = (unsigned)(arow(aP, Rbase + 64 * _i) + Ccol); } while (0)
#define RS_LOAD(AR, BR) do { \
        _Pragma("unroll") for (int _i = 0; _i < 4; ++_i) AR[_i] = *(const u32x4*)(Abase + (size_t)asrc[_i] + (size_t)aK * 128); \
        _Pragma("unroll") for (int _i = 0; _i < 4; ++_i) BR[_i] = *(const f32x4*)(bp + (size_t)(bK * 64 + kb + 16 * _i) * ldb); \
        if (++aK == nk) { aK = 0; if (aP + 1 < npass) { ++aP; RS_SETA(); } } \
        if (++bK == nk) { bK = 0; if (bP + 1 < npass) { ++bP; bp = bcol(bP, n4); } } } while (0)
#define RS_WRITE(AR, BR, buf) do { \
        _Pragma("unroll") for (int _i = 0; _i < 4; ++_i) *(LAS u32x4*)(lds + GEMM_LDS_A + (buf) * 32768 + _i * 8192 + awoff) = AR[_i]; \
        _Pragma("unroll") for (int _i = 0; _i < 4; ++_i) { u32x2 _w; _w.x = pk_bf16(BR[_i][0], BR[_i][1]); _w.y = pk_bf16(BR[_i][2], BR[_i][3]); \
            *(LAS u32x2*)(lds + GEMM_LDS_B + (buf) * 16384 + bwoff + 4096 * _i) = _w; } } while (0)
#define RS_COMPUTE(buf) do { _Pragma("unroll") for (int ks = 0; ks < 2; ++ks) { \
            bf16x8 af[4]; s16x4 tl0, tl1, tl2, tl3, th0, th1, th2, th3; \
            LAS unsigned char* bb_ = lds + GEMM_LDS_B + (buf) * 16384 + ks * 8192; \
            tl0 = tr_read(bb_ + RS_BOFF(0)); th0 = tr_read(bb_ + 1024 + RS_BOFF(1)); tl1 = tr_read(bb_ + RS_BOFF(2)); th1 = tr_read(bb_ + 1024 + RS_BOFF(3)); \
            tl2 = tr_read(bb_ + RS_BOFF(4)); th2 = tr_read(bb_ + 1024 + RS_BOFF(5)); tl3 = tr_read(bb_ + RS_BOFF(6)); th3 = tr_read(bb_ + 1024 + RS_BOFF(7)); \
            _Pragma("unroll") for (int mi = 0; mi < 4; ++mi) af[mi] = *(const LAS bf16x8*)(lds + GEMM_LDS_A + (buf) * 32768 + aoff + mi * 2048 + ks * 1024); \
            TR_WAIT8(tl0, th0, tl1, th1, tl2, th2, tl3, th3); \
            bf16x8 bfr[4]; \
            bfr[0] = (bf16x8){tl0[0], tl0[1], tl0[2], tl0[3], th0[0], th0[1], th0[2], th0[3]}; bfr[1] = (bf16x8){tl1[0], tl1[1], tl1[2], tl1[3], th1[0], th1[1], th1[2], th1[3]}; \
            bfr[2] = (bf16x8){tl2[0], tl2[1], tl2[2], tl2[3], th2[0], th2[1], th2[2], th2[3]}; bfr[3] = (bf16x8){tl3[0], tl3[1], tl3[2], tl3[3], th3[0], th3[1], th3[2], th3[3]}; \
            _Pragma("unroll") for (int mi = 0; mi < 4; ++mi) _Pragma("unroll") for (int ni = 0; ni < 4; ++ni) \
                acc[mi][ni] = __builtin_amdgcn_mfma_f32_16x16x32_bf16(bfr[ni], af[mi], acc[mi][ni], 0, 0, 0); } } while (0)
#define RS_STEP(CUR, NXT, A_LD, B_LD, A_WR, B_WR) do { \
        RS_LOAD(A_LD, B_LD); \
        __builtin_amdgcn_sched_barrier(0); \
        if (active) RS_COMPUTE(CUR); \
        __builtin_amdgcn_sched_barrier(0); \
        RS_WRITE(A_WR, B_WR, NXT); \
        if (++cK == nk) { \
            if (active) epi(cP, wr * 64 + fr, wc * 64 + fq * 4, cm, acc); \
            _Pragma("unroll") for (int i = 0; i < 4; ++i) _Pragma("unroll") for (int j = 0; j < 4; ++j) acc[i][j] = (f32x4){0.f, 0.f, 0.f, 0.f}; \
            cK = 0; ++cP; if (cP < npass) { cm = mrowsf(cP); active = (wr * 64) < cm; } \
        } \
        asm volatile("s_waitcnt lgkmcnt(0)" ::: "memory"); \
        asm volatile("" ::: "memory"); __builtin_amdgcn_s_barrier(); asm volatile("" ::: "memory"); ++s; } while (0)
    int cP = 0, cK = 0, cm = mrowsf(0);
    bool active = (wr * 64) < cm;
    RS_SETA(); bp = bcol(0, n4);
    RS_LOAD(aX, bX); RS_WRITE(aX, bX, 0);
    RS_LOAD(aY, bY);
    asm volatile("s_waitcnt lgkmcnt(0)" ::: "memory");
    __syncthreads();
    int s = 0;
    while (s < S) { RS_STEP(0, 1, aX, bX, aY, bY); if (s >= S) break; RS_STEP(1, 0, aY, bY, aX, bX); }
#undef RS_BOFF
#undef RS_SETA
#undef RS_LOAD
#undef RS_WRITE
#undef RS_COMPUTE
#undef RS_STEP
}

namespace pg8 {
#define PG8_LAS __attribute__((address_space(3)))
typedef unsigned short bf16_t;
typedef short bf16x8 __attribute__((ext_vector_type(8)));
typedef float f32x4 __attribute__((ext_vector_type(4)));
typedef unsigned u32x4 __attribute__((ext_vector_type(4)));
constexpr int BM = 256, BK = 64, HALF = 128, HTB = HALF * BK * 2  , STAGE_BYTES = 8 * HTB, NXCD = 8, WGM = 8;

__host__ __device__ __forceinline__ int lds_byte(int r, int c) { const int st = (r >> 4) * 2 + (c >> 5), rr = r & 15, cc = c & 31, ob = rr * 64 + cc * 2; return st * 1024 + (ob ^ (((ob >> 9) & 1) << 5)); }
__host__ __device__ __forceinline__ void stage_rc(int b, int& R, int& C) { const int st = b / 1024, sb = b % 1024, swz = sb ^ (((sb >> 9) & 1) << 5); R = (st >> 1) * 16 + swz / 64; C = (st & 1) * 32 + (swz % 64) / 2; }
__host__ __device__ __forceinline__ int perm32(int rho) { const int n = rho >> 4, i = rho & 15; return 8 * (i >> 2) + 4 * n + (i & 3); }

struct Unit { int pm, pn; };
struct Gemm { const bf16_t* A; const bf16_t* Bt; int M, N, K; };

struct StaticOrder {
    int nM, nN, nwg, G, c;
    __host__ __device__ void init(int M, int N, int G_, int c_) { nM = M / BM; nN = N / BM; nwg = nM * nN; G = G_; c = c_; }
    __host__ __device__ bool next(int i, Unit& u) const {
        const long L = (long)i * G + c; if (L >= nwg) return false;
        int wgid = (int)L; { const int q = nwg / NXCD, r = nwg % NXCD, xcd = wgid % NXCD, off = wgid / NXCD; wgid = (xcd < r ? xcd * (q + 1) : r * (q + 1) + (xcd - r) * q) + off; }
        const int nig = WGM * nN, gid = wgid / nig, fm = gid * WGM, gsz = (nM - fm) < WGM ? (nM - fm) : WGM;
        u.pm = fm + ((wgid % nig) % gsz); u.pn = (wgid % nig) / gsz; return true;
    }
    __device__ __forceinline__ void a_ready(const Unit&) const {}
    __device__ __forceinline__ void done(const Unit&) const {}
};
template <class Epi, class Sched>
__device__ __forceinline__ void gemm_phase(PG8_LAS unsigned char* lds, const Gemm g, const Sched& S, const Epi& E) {
    int tid_l = threadIdx.x; asm volatile("" : "+v"(tid_l));
    const int tid = tid_l, wid = __builtin_amdgcn_readfirstlane(tid >> 6), lane = tid & 63, wr = wid >> 2, wc = wid & 3, fr = lane & 15, fq = lane >> 4;
    const int K = g.K, nt = K / BK;

    unsigned voffA[2], voffB[2];
#pragma unroll
    for (int i = 0; i < 2; ++i) { int R, C; stage_rc(tid * 16 + i * 8192, R, C); const int Rb = Epi::PERM ? ((R & ~31) + perm32(R & 31)) : R;
        voffA[i] = (unsigned)(R * K + C) * 2u; voffB[i] = (unsigned)(Rb * K + C) * 2u; }
    const size_t kstep = (size_t)(BK * 2);
    const size_t hstep = (size_t)HALF * K * 2;
    const size_t tstep = 2 * hstep;
    const unsigned ldsw = (unsigned)wid * 1024u;
    const int aoff = lds_byte(wr * 64 + fr, fq * 8), boff = lds_byte(wc * 32 + fr, fq * 8);
#define PG8_SA(b, h) (((b) * 2 + (h)) * HTB)
#define PG8_SB(b, h) ((4 + (b) * 2 + (h)) * HTB)
#define PG8_STAGE(bufoff, gbase, voff) do { _Pragma("unroll") for (int _i = 0; _i < 2; ++_i) \
        __builtin_amdgcn_global_load_lds((const unsigned*)((const char*)(gbase) + (voff)[_i]), (PG8_LAS unsigned*)(lds + (bufoff) + ldsw + _i * 8192), 16, 0, 0); } while (0)
#define PG8_LDA(dst, b, h) do { _Pragma("unroll") for (int m = 0; m < 4; ++m) _Pragma("unroll") for (int k = 0; k < 2; ++k) dst[m][k] = *(const PG8_LAS bf16x8*)(lds + PG8_SA(b, h) + aoff + m * 2048 + k * 1024); } while (0)
#define PG8_LDB(dst, b, h) do { _Pragma("unroll") for (int n = 0; n < 2; ++n) _Pragma("unroll") for (int k = 0; k < 2; ++k) dst[n][k] = *(const PG8_LAS bf16x8*)(lds + PG8_SB(b, h) + boff + n * 2048 + k * 1024); } while (0)
#define PG8_MMA(ai, bj, At, Bt) do { __builtin_amdgcn_s_setprio(1); _Pragma("unroll") for (int m = 0; m < 4; ++m) _Pragma("unroll") for (int n = 0; n < 2; ++n) _Pragma("unroll") for (int k = 0; k < 2; ++k) \
        acc[ai][bj][m][n] = __builtin_amdgcn_mfma_f32_16x16x32_bf16(Bt[n][k], At[m][k], acc[ai][bj][m][n], 0, 0, 0); __builtin_amdgcn_s_setprio(0); } while (0)
#define PG8_WAIT_V(n) asm volatile("s_waitcnt vmcnt(" #n ")" ::: "memory")
#define PG8_WAIT_L(n) asm volatile("s_waitcnt lgkmcnt(" #n ")" ::: "memory")
#define PG8_BAR __builtin_amdgcn_s_barrier()
#define PG8_SCHED __builtin_amdgcn_sched_barrier(0)
    Unit cur, nxt; int ui = 0;
    if (!S.next(0, cur)) return;
    f32x4 acc[2][2][4][2];
#pragma unroll
    for (int a = 0; a < 2; ++a)
#pragma unroll
        for (int b = 0; b < 2; ++b)
#pragma unroll
            for (int m = 0; m < 4; ++m)
#pragma unroll
                for (int n = 0; n < 2; ++n) acc[a][b][m][n] = (f32x4){0.f, 0.f, 0.f, 0.f};
    bf16x8 At[4][2], B0[2][2], B1[2][2];
    const char* cA = (const char*)g.A + (size_t)cur.pm * tstep; const char* cB = (const char*)g.Bt + (size_t)cur.pn * tstep;
    S.a_ready(cur);
    PG8_STAGE(PG8_SB(0, 0), cB, voffB); PG8_STAGE(PG8_SA(0, 0), cA, voffA); PG8_STAGE(PG8_SB(0, 1), cB + hstep, voffB); PG8_STAGE(PG8_SA(0, 1), cA + hstep, voffA);
    if (wr == 1) PG8_BAR;
    PG8_WAIT_V(4); PG8_BAR;
    PG8_STAGE(PG8_SB(1, 0), cB + kstep, voffB); PG8_STAGE(PG8_SA(1, 0), cA + kstep, voffA); PG8_STAGE(PG8_SB(1, 1), cB + hstep + kstep, voffB);
    PG8_WAIT_V(6); PG8_BAR;

    for (;;) {
        const bool has_next = S.next(ui + 1, nxt);
        const char* nA = has_next ? (const char*)g.A + (size_t)nxt.pm * tstep : cA; const char* nB = has_next ? (const char*)g.Bt + (size_t)nxt.pn * tstep : cB;
        for (int t = 0; t < nt; t += 2) {
            const bool last = (t == nt - 2);
            const char* a1 = cA + (size_t)(t + 1) * kstep;
            const char* a2 = last ? nA : cA + (size_t)(t + 2) * kstep; const char* b2 = last ? nB : cB + (size_t)(t + 2) * kstep;
            const char* a3 = a2 + kstep; const char* b3 = b2 + kstep;
            if (last && has_next) S.a_ready(nxt);
            PG8_LDB(B0, 0, 0); PG8_SCHED; PG8_LDA(At, 0, 0); PG8_STAGE(PG8_SA(1, 1), a1 + hstep, voffA);
            PG8_WAIT_L(8); PG8_BAR; PG8_WAIT_L(0); PG8_MMA(0, 0, At, B0); PG8_BAR; PG8_SCHED;
            PG8_LDB(B1, 0, 1); PG8_STAGE(PG8_SB(0, 0), b2, voffB);
            PG8_BAR; PG8_WAIT_L(0); PG8_MMA(0, 1, At, B1); PG8_BAR;
            PG8_LDA(At, 0, 1); PG8_STAGE(PG8_SA(0, 0), a2, voffA);
            PG8_BAR; PG8_WAIT_L(0); PG8_MMA(1, 0, At, B0); PG8_BAR; PG8_SCHED;
            PG8_STAGE(PG8_SB(0, 1), b2 + hstep, voffB);
            PG8_WAIT_V(6); PG8_BAR; PG8_MMA(1, 1, At, B1); PG8_BAR;
            PG8_LDB(B0, 1, 0); PG8_SCHED; PG8_LDA(At, 1, 0); PG8_STAGE(PG8_SA(0, 1), a2 + hstep, voffA);
            PG8_WAIT_L(8); PG8_BAR; PG8_WAIT_L(0); PG8_MMA(0, 0, At, B0); PG8_BAR; PG8_SCHED;
            PG8_LDB(B1, 1, 1); PG8_STAGE(PG8_SB(1, 0), b3, voffB);
            PG8_BAR; PG8_WAIT_L(0); PG8_MMA(0, 1, At, B1); PG8_BAR;
            PG8_LDA(At, 1, 1); PG8_STAGE(PG8_SA(1, 0), a3, voffA);
            PG8_BAR; PG8_WAIT_L(0); PG8_MMA(1, 0, At, B0); PG8_BAR; PG8_SCHED;
            PG8_STAGE(PG8_SB(1, 1), b3 + hstep, voffB);
            PG8_WAIT_V(6); PG8_BAR; PG8_MMA(1, 1, At, B1); PG8_BAR;
        }

        if constexpr (!Epi::AFTER_DRAIN) { E(acc, cur, wr, wc, fr, fq); S.done(cur); }

        if (!has_next) break;
#pragma unroll
        for (int a = 0; a < 2; ++a)
#pragma unroll
            for (int b = 0; b < 2; ++b)
#pragma unroll
                for (int m = 0; m < 4; ++m)
#pragma unroll
                    for (int n = 0; n < 2; ++n) acc[a][b][m][n] = (f32x4){0.f, 0.f, 0.f, 0.f};
        cur = nxt; cA = nA; cB = nB; ++ui;
    }
    PG8_WAIT_V(0);
    if (wr == 0) PG8_BAR;
    PG8_BAR;
    if constexpr (Epi::AFTER_DRAIN) { E.fused(acc, cur, wr, wc, fr, fq, lds, wid, lane); S.done(cur); }

#undef PG8_SA
#undef PG8_SB
#undef PG8_STAGE
#undef PG8_LDA
#undef PG8_LDB
#undef PG8_MMA
#undef PG8_WAIT_V
#undef PG8_WAIT_L
#undef PG8_BAR
#undef PG8_SCHED
}
}
template <class F> struct EpiWrap {
    static constexpr bool PERM = false, AFTER_DRAIN = false; F f;
    __device__ __forceinline__ void operator()(const f32x4 (&acc)[2][2][4][2], const pg8::Unit& u, int wr, int wc, int fr, int fq) const { f(acc, u, wr, wc, fr, fq); }
};
template <class F> __device__ __forceinline__ EpiWrap<F> make_epi(F f) { return EpiWrap<F>{f}; }
template <class F> struct EpiWrapP {
    static constexpr bool PERM = true, AFTER_DRAIN = false; F f;
    __device__ __forceinline__ void operator()(const f32x4 (&acc)[2][2][4][2], const pg8::Unit& u, int wr, int wc, int fr, int fq) const { f(acc, u, wr, wc, fr, fq); }
};
template <class F> __device__ __forceinline__ EpiWrapP<F> make_epi_p(F f) { return EpiWrapP<F>{f}; }

__device__ __forceinline__ void transpose_item(const float* W, int K, int N, int Npad, bf16_t* WT, LAS float* scr, int item, int lane) {
    const int nblk = Npad / 32, kb = item / nblk, nb_ = item % nblk, k0 = 64 * kb, n0 = 32 * nb_;
#pragma unroll 8
    for (int i = 0; i < 32; ++i) { const int kk = 2 * i + (lane >> 5), n = n0 + (lane & 31); scr[kk * 33 + (lane & 31)] = n < N ? W[(size_t)(k0 + kk) * N + n] : 0.f; }
    asm volatile("s_waitcnt lgkmcnt(0)" ::: "memory");
    const int c = lane & 7;
#pragma unroll
    for (int j = 0; j < 4; ++j) { const int n = (lane >> 3) + 8 * j; const LAS float* sp = scr + (8 * c) * 33 + n;
        u32x4 o; o[0] = pk_bf16(sp[0 * 33], sp[1 * 33]); o[1] = pk_bf16(sp[2 * 33], sp[3 * 33]); o[2] = pk_bf16(sp[4 * 33], sp[5 * 33]); o[3] = pk_bf16(sp[6 * 33], sp[7 * 33]);
        *(u32x4*)(WT + (size_t)(n0 + n) * K + k0 + 8 * c) = o; }
    asm volatile("s_waitcnt lgkmcnt(0)" ::: "memory");
}

template <class ARow, class BCol, class MRows, class Epi>
__device__ __forceinline__ void gemm_stream_ws(LAS unsigned char* lds, const unsigned char* Abase, int npass, int nk, int ldb, ARow arow, BCol bcol, MRows mrowsf, Epi epi) {
    int tid_ = threadIdx.x; asm volatile("" : "+v"(tid_));
    const int tid = tid_, wid = __builtin_amdgcn_readfirstlane(tid >> 6), lane = tid & 63;
    if (npass <= 0) return;
    const int S = npass * nk;
#define WS_BAR() do { asm volatile("s_waitcnt lgkmcnt(0)" ::: "memory"); __builtin_amdgcn_s_barrier(); asm volatile("" ::: "memory"); } while (0)
    if (wid < 4) {
        const int wr2 = wid >> 1, wc = wid & 1, fr = lane & 15, fq = lane >> 4;
        const int aoff = wr2 * 16384 + ((fr * 64 + fq * 16) ^ ((fr >> 3) << 5));
        const int q = (lane >> 2) & 3, pp = lane & 3;
        const int b0 = (wc * 8 + (pp >> 1)) ^ ((q << 2) | (2 * (fq & 1)));
        const int browoff = 256 * (fq * 8 + q) + 8 * (pp & 1);
#define WS_BOFF(v) (browoff + 16 * (b0 ^ (v)))
        f32x4 acc[8][4];
#pragma unroll
        for (int i = 0; i < 8; ++i)
#pragma unroll
            for (int j = 0; j < 4; ++j) acc[i][j] = (f32x4){0.f, 0.f, 0.f, 0.f};
        int cP = 0, cK = 0, cm = mrowsf(0);
        bool active = (wr2 * 128) < cm;
#define WS_COMPUTE(buf) do { _Pragma("unroll") for (int ks = 0; ks < 2; ++ks) { \
            bf16x8 af[8]; s16x4 tl0, tl1, tl2, tl3, th0, th1, th2, th3; \
            LAS unsigned char* bb_ = lds + GEMM_LDS_B + (buf) * 16384 + ks * 8192; \
            tl0 = tr_read(bb_ + WS_BOFF(0)); th0 = tr_read(bb_ + 1024 + WS_BOFF(1)); tl1 = tr_read(bb_ + WS_BOFF(2)); th1 = tr_read(bb_ + 1024 + WS_BOFF(3)); \
            tl2 = tr_read(bb_ + WS_BOFF(4)); th2 = tr_read(bb_ + 1024 + WS_BOFF(5)); tl3 = tr_read(bb_ + WS_BOFF(6)); th3 = tr_read(bb_ + 1024 + WS_BOFF(7)); \
            _Pragma("unroll") for (int mi = 0; mi < 8; ++mi) af[mi] = *(const LAS bf16x8*)(lds + GEMM_LDS_A + (buf) * 32768 + aoff + mi * 2048 + ks * 1024); \
            TR_WAIT8(tl0, th0, tl1, th1, tl2, th2, tl3, th3); \
            bf16x8 bfr[4]; \
            bfr[0] = (bf16x8){tl0[0], tl0[1], tl0[2], tl0[3], th0[0], th0[1], th0[2], th0[3]}; bfr[1] = (bf16x8){tl1[0], tl1[1], tl1[2], tl1[3], th1[0], th1[1], th1[2], th1[3]}; \
            bfr[2] = (bf16x8){tl2[0], tl2[1], tl2[2], tl2[3], th2[0], th2[1], th2[2], th2[3]}; bfr[3] = (bf16x8){tl3[0], tl3[1], tl3[2], tl3[3], th3[0], th3[1], th3[2], th3[3]}; \
            _Pragma("unroll") for (int mi = 0; mi < 8; ++mi) _Pragma("unroll") for (int ni = 0; ni < 4; ++ni) \
                acc[mi][ni] = __builtin_amdgcn_mfma_f32_16x16x32_bf16(bfr[ni], af[mi], acc[mi][ni], 0, 0, 0); } } while (0)
#define WS_CSTEP(CUR) do { \
            if (active) WS_COMPUTE(CUR); \
            if (++cK == nk) { \
                if (active) epi(cP, wr2 * 128 + fr, wc * 64 + fq * 4, cm, acc); \
                _Pragma("unroll") for (int i = 0; i < 8; ++i) _Pragma("unroll") for (int j = 0; j < 4; ++j) acc[i][j] = (f32x4){0.f, 0.f, 0.f, 0.f}; \
                cK = 0; ++cP; if (cP < npass) { cm = mrowsf(cP); active = (wr2 * 128) < cm; } \
            } \
            WS_BAR(); ++s; } while (0)
        WS_BAR();
        int s = 0;
        while (s < S) { WS_CSTEP(0); if (s >= S) break; WS_CSTEP(1); }
#undef WS_BOFF
#undef WS_COMPUTE
#undef WS_CSTEP
    } else {
        const int pt = tid - 256;
        const int Ccol = (((pt >> 6) & 1) * 32 + 8 * ((lane & 3) ^ ((lane >> 5) << 1))) * 2;
        const int Rbase = 16 * (pt >> 7) + (lane >> 2);
        unsigned asrc[8];
        const int n4 = pt & 31, kb8 = pt >> 5;
        const float* bp;
        int bwoff[2];
#pragma unroll
        for (int par = 0; par < 2; ++par) { const int row = kb8 + 8 * par; const int fB = ((row & 3) << 2) | ((row >> 2) & 3); bwoff[par] = 256 * row + 16 * ((n4 >> 1) ^ fB) + 8 * (n4 & 1); }
        const int awoff = pt * 16;
        f32x4 bX[8], bY[8]; u32x4 aX[8], aY[8];
        int aP = 0, aK = 0, bP = 0, bK = 0;
#define WS_SETA() do { _Pragma("unroll") for (int _i = 0; _i < 8; ++_i) asrc[_i] = (unsigned)(arow(aP, Rbase + 32 * _i) + Ccol); } while (0)
#define WS_LOAD(AR, BR) do { \
            _Pragma("unroll") for (int _i = 0; _i < 8; ++_i) AR[_i] = *(const u32x4*)(Abase + (size_t)asrc[_i] + (size_t)aK * 128); \
            _Pragma("unroll") for (int _i = 0; _i < 8; ++_i) BR[_i] = *(const f32x4*)(bp + (size_t)(bK * 64 + kb8 + 8 * _i) * ldb); \
            if (++aK == nk) { aK = 0; if (aP + 1 < npass) { ++aP; WS_SETA(); } } \
            if (++bK == nk) { bK = 0; if (bP + 1 < npass) { ++bP; bp = bcol(bP, n4); } } } while (0)
#define WS_WRITE(AR, BR, buf) do { \
            _Pragma("unroll") for (int _i = 0; _i < 8; ++_i) *(LAS u32x4*)(lds + GEMM_LDS_A + (buf) * 32768 + _i * 4096 + awoff) = AR[_i]; \
            _Pragma("unroll") for (int _i = 0; _i < 8; ++_i) { u32x2 _w; _w.x = pk_bf16(BR[_i][0], BR[_i][1]); _w.y = pk_bf16(BR[_i][2], BR[_i][3]); \
                *(LAS u32x2*)(lds + GEMM_LDS_B + (buf) * 16384 + bwoff[_i & 1] + 4096 * (_i >> 1)) = _w; } } while (0)
#define WS_PSTEP(NXT, A_LD, B_LD, A_WR, B_WR) do { WS_LOAD(A_LD, B_LD); WS_WRITE(A_WR, B_WR, NXT); WS_BAR(); ++s; } while (0)
        WS_SETA(); bp = bcol(0, n4);
        WS_LOAD(aX, bX); WS_WRITE(aX, bX, 0);
        WS_LOAD(aY, bY);
        WS_BAR();
        int s = 0;
        while (s < S) { WS_PSTEP(1, aX, bX, aY, bY); if (s >= S) break; WS_PSTEP(0, aY, bY, aX, bX); }
#undef WS_SETA
#undef WS_LOAD
#undef WS_WRITE
#undef WS_PSTEP
    }
#undef WS_BAR
}

struct XcdDeal { int lo, step, n; };
#define TOPO_OFF (LDS_MISC + 16)
__device__ __forceinline__ XcdDeal xcd_deal(int U, const LAS unsigned char* lds, int nb) {
    const LAS int* tp_ = (const LAS int*)(lds + TOPO_OFF);
    const int px = tp_[0], cx = tp_[1], rank = tp_[2];
    XcdDeal d;
    const int xlo = (int)((long)px * U / nb), xhi = (int)((long)(px + cx) * U / nb);
    d.lo = xlo + rank; d.step = cx; d.n = (xhi - xlo - rank + cx - 1) / cx; if (d.n < 0) d.n = 0;
    return d;
}

__device__ __forceinline__ void phase0(const Params& p, int bid, int nb, float* smem, LAS unsigned char* smem_las) {
    const float* c = p.in[1]; const float* w_ada = p.in[2]; const float* b_ada = p.in[3];
    float* mod = (float*)(p.ws + WS_MOD);
    const int tid = threadIdx.x;
    float* sc = smem;
    float* red = smem + 2048;
    for (int i = tid; i < 2048; i += NT) { const float cv = c[i]; sc[i] = cv / (1.f + expf(-cv)); }
    __syncthreads();
    {
        const int cq = tid & 7, kg = tid >> 3;
        for (int u = bid; u < 192; u += nb) {
            const float* wp = w_ada + (size_t)(kg * 16) * 6144 + u * 32 + cq * 4;
            f32x4 wv[16];
#pragma unroll
            for (int i = 0; i < 16; ++i) wv[i] = *(const f32x4*)(wp + (size_t)i * 6144);
            f32x4 a0 = (f32x4){0.f, 0.f, 0.f, 0.f}, a1 = (f32x4){0.f, 0.f, 0.f, 0.f};
#pragma unroll
            for (int i = 0; i < 16; ++i) { a0 += sc[kg * 16 + i] * wv[i]; a1 += sc[1024 + kg * 16 + i] * wv[i]; }
            *(f32x4*)(red + (kg * 2 + 0) * 32 + cq * 4) = a0; *(f32x4*)(red + (kg * 2 + 1) * 32 + cq * 4) = a1;
            __syncthreads();
            if (tid < 64) {
                const int bb = tid >> 5, col = tid & 31; float sacc = 0.f;
#pragma unroll 16
                for (int g2 = 0; g2 < 64; ++g2) sacc += red[(g2 * 2 + bb) * 32 + col];
                mod[bb * 6144 + u * 32 + col] = sacc + b_ada[u * 32 + col];
            }
            __syncthreads();
        }
    }
    {
        const float* conv_w = p.in[12]; const float* conv_b = p.in[13]; const float* wa = p.in[14]; const float* ba = p.in[15]; const float* wx = p.in[16]; const float* bx = p.in[17];
        float* BG = (float*)(p.ws + WS_BG); float* GB = (float*)(p.ws + WS_GBIAS);
        for (int idx = bid * NT + tid; idx < 8 * 256 * 128; idx += nb * NT) {
            const int n = idx & 127, k = (idx >> 7) & 255, hb = idx >> 15;
            const int w = k >> 6, i = k & 63, j = (n >> 6) * 32 + ((n >> 2) & 3) * 8 + ((n >> 4) & 1) * 4 + (n & 3);
            const float* W = ((n >> 5) & 1) ? wx : wa;
            BG[idx] = conv_w[w * 512 + hb * 64 + i] * W[(hb * 64 + i) * 64 + j];
        }
        for (int idx = bid * NT + tid; idx < 8 * 128; idx += nb * NT) {
            const int n = idx & 127, hb = idx >> 7, j = (n >> 6) * 32 + ((n >> 2) & 3) * 8 + ((n >> 4) & 1) * 4 + (n & 3);
            const bool isx = (n >> 5) & 1; const float* W = isx ? wx : wa;
            float acc = isx ? bx[hb * 64 + j] : ba[hb * 64 + j];
            for (int i = 0; i < 64; ++i) acc += conv_b[hb * 64 + i] * W[(hb * 64 + i) * 64 + j];
            GB[idx] = acc;
        }
        float* CB = (float*)(p.ws + WS_CBIAS); const float* pos = p.in[6];
        for (int idx = bid * NW + (tid >> 6); idx < 128; idx += nb * NW) {
            const int kv = idx >> 6, j = idx & 63; const float* w1 = kv ? p.in[9] : p.in[7];
            float acc = 0.f;
#pragma unroll 8
            for (int k = (tid & 63); k < 2048; k += 64) acc += pos[k] * w1[(size_t)k * 64 + j];
            acc = wave_sum(acc);
            if ((tid & 63) == 0) CB[idx] = acc;
        }
        bf16_t* XRB = (bf16_t*)(p.ws + WS_XRB);
        for (int idx = bid * NT + tid; idx < 16 * 3 * 64; idx += nb * NT) { const int sq = idx / 192, rem = idx % 192; XRB[(size_t)sq * SEQP * 64 + rem] = 0; }
    }
    {
        const f32x4* sp = (const f32x4*)p.in[23]; u32x2* dp = (u32x2*)(p.ws + WS_WRB);
        for (int i = bid * NT + tid; i < 1024 * 256 / 4; i += nb * NT) { const f32x4 v = sp[i]; u32x2 w; w.x = pk_bf16(v[0], v[1]); w.y = pk_bf16(v[2], v[3]); dp[i] = w; }
    }
    {
        LAS float* scr = (LAS float*)((LAS unsigned char*)smem_las + 16384 + (tid >> 6) * 8704);
        const int gw = bid * NW + (tid >> 6), ngw = nb * NW, lane_ = tid & 63;
        const int I1 = 16 * 80, I2 = 16 * 32;
        for (int it = gw; it < I1 + I2; it += ngw) {
            if (it < I1) transpose_item(p.in[5], 1024, NCOLS, 2560, (bf16_t*)(p.ws + WS_WINT), scr, it, lane_);
            else transpose_item(p.in[21], 1024, 1024, 1024, (bf16_t*)(p.ws + WS_WOUTT), scr, it - I1, lane_);
        }
    }
    float* lut = (float*)(p.ws + WS_LUT); const float* rel = p.in[11];
    for (int idx = bid * NT + tid; idx < 8 * 1024; idx += nb * NT) {
        const int h = idx >> 10, d = idx & 1023;
        int bucket;
        if (d < 16) bucket = d;
        else { const int l = 16 + (int)(logf((float)d / 16.0f) / 4.1588830833596715f * 16.0f); bucket = l < 31 ? l : 31; }
        lut[idx] = rel[bucket * 8 + h];
    }
}

template <bool SRC_BF16>
__device__ __forceinline__ void phase_modnorm(const Params& p, int bid, int nb, const void* src_, const float* nw, int sh_off, int sc_off, bf16_t* dstb) {
    const float* mod = (const float*)(p.ws + WS_MOD);
    int tid_ = threadIdx.x; asm volatile("" : "+v"(tid_));
    const int wave = tid_ >> 6, lane = tid_ & 63;
    const int RS = nb * NW;
    f32x4 w4[4];
#pragma unroll
    for (int i = 0; i < 4; ++i) w4[i] = *(const f32x4*)(nw + lane * 16 + 4 * i);
    for (int row0 = bid * NW + wave; row0 < MTOK; row0 += 4 * RS) {
        f32x4 v[4][4];
#pragma unroll
        for (int k = 0; k < 4; ++k) {
            const int row = row0 + k * RS; const int rc = row < MTOK ? row : row0;
            if constexpr (SRC_BF16) {
                const u32x4* xr = (const u32x4*)((const bf16_t*)src_ + (size_t)rc * 1024 + lane * 16);
                const u32x4 r0 = xr[0], r1 = xr[1];
#pragma unroll
                for (int j = 0; j < 4; ++j) { v[k][j >> 1][(j & 1) * 2] = __uint_as_float(r0[j] << 16); v[k][j >> 1][(j & 1) * 2 + 1] = __uint_as_float(r0[j] & 0xffff0000u);
                                              v[k][2 + (j >> 1)][(j & 1) * 2] = __uint_as_float(r1[j] << 16); v[k][2 + (j >> 1)][(j & 1) * 2 + 1] = __uint_as_float(r1[j] & 0xffff0000u); }
            } else {
                const float* xr = (const float*)src_ + (size_t)rc * 1024 + lane * 16;
#pragma unroll
                for (int i = 0; i < 4; ++i) v[k][i] = *(const f32x4*)(xr + 4 * i);
            }
        }
#pragma unroll
        for (int k = 0; k < 4; ++k) {
            const int row = row0 + k * RS;
            if (row < MTOK) {
                const int b = row >> 13;
                float ss = 0.f;
#pragma unroll
                for (int i = 0; i < 4; ++i) ss += (v[k][i][0] * v[k][i][0] + v[k][i][1] * v[k][i][1]) + (v[k][i][2] * v[k][i][2] + v[k][i][3] * v[k][i][3]);
                ss = wave_sum(ss);
                const float rstd = __builtin_amdgcn_rsqf(ss * (1.f / 1024.f) + 1e-6f);
                u32x4 o[2];
#pragma unroll
                for (int i = 0; i < 4; ++i) {
                    const int ci = lane * 16 + 4 * i;
                    const f32x4 sh = *(const f32x4*)(mod + b * 6144 + sh_off + ci), sc = *(const f32x4*)(mod + b * 6144 + sc_off + ci);
                    f32x4 h;
#pragma unroll
                    for (int j = 0; j < 4; ++j) h[j] = v[k][i][j] * rstd * w4[i][j] * (1.f + sc[j]) + sh[j];
                    o[i >> 1][(i & 1) * 2 + 0] = pk_bf16(h[0], h[1]); o[i >> 1][(i & 1) * 2 + 1] = pk_bf16(h[2], h[3]);
                }
                *(u32x4*)(dstb + (size_t)row * 1024 + lane * 16) = o[0];
                *(u32x4*)(dstb + (size_t)row * 1024 + lane * 16 + 8) = o[1];
            }
        }
    }
}

__device__ __forceinline__ void phase2_e(const Params& p, int bid, int nb, LAS unsigned char* lds) {
    bf16_t* QB = (bf16_t*)(p.ws + WS_QB); bf16_t* KV6 = (bf16_t*)(p.ws + WS_KV6); float* GATE = (float*)(p.ws + WS_GATE);
    bf16_t* XRB = (bf16_t*)(p.ws + WS_XRB); bf16_t* GRG = (bf16_t*)(p.ws + WS_GRG);
    pg8::Gemm g{(const pg8::bf16_t*)(p.ws + WS_H1B), (const pg8::bf16_t*)(p.ws + WS_WINT), MTOK, 2560, 1024};
    pg8::StaticOrder S; S.init(MTOK, 2560, nb, bid);
    auto E = make_epi_p([=](const f32x4 (&acc)[2][2][4][2], const pg8::Unit& u, int wr, int wc, int fr, int fq) {
#pragma unroll
        for (int ai = 0; ai < 2; ++ai)
#pragma unroll
            for (int mm = 0; mm < 4; ++mm) {
                const int m = u.pm * 256 + ai * 128 + wr * 64 + mm * 16 + fr;
#pragma unroll
                for (int bj = 0; bj < 2; ++bj) {
                    const int col = u.pn * 256 + bj * 128 + wc * 32 + fq * 8;
                    const f32x4 v0 = acc[ai][bj][mm][0], v1 = acc[ai][bj][mm][1];
                    if (col >= NCOLS) continue;
                    if (col < 512) {
                        const float sc = 0.125f * LOG2E; u32x4 w; w[0] = pk_bf16(v0[0] * sc, v0[1] * sc); w[1] = pk_bf16(v0[2] * sc, v0[3] * sc); w[2] = pk_bf16(v1[0] * sc, v1[1] * sc); w[3] = pk_bf16(v1[2] * sc, v1[3] * sc);
                        *(u32x4*)(QB + (size_t)m * 512 + col) = w;
                    } else if (col >= 1280 && col < 1304) {
                        f32x4 g0, g1;
#pragma unroll
                        for (int j = 0; j < 4; ++j) { g0[j] = sigm(v0[j]); g1[j] = sigm(v1[j]); }
                        *(f32x4*)(GATE + (size_t)m * 24 + (col - 1280)) = g0; *(f32x4*)(GATE + (size_t)m * 24 + (col - 1280) + 4) = g1;
                    } else if (col < 1280) {
                        const int c2 = col - 512, j6 = c2 >> 7, gg = (c2 >> 6) & 1, d = c2 & 63, bb = m >> 13, t = m & 8191;
                        u32x4 w; w[0] = pk_bf16(v0[0], v0[1]); w[1] = pk_bf16(v0[2], v0[3]); w[2] = pk_bf16(v1[0], v1[1]); w[3] = pk_bf16(v1[2], v1[3]);
                        *(u32x4*)(KV6 + (size_t)j6 * 2097152 + ((size_t)((bb * 2 + gg) * SEQ + t)) * 64 + d) = w;
                    } else if (col < 1816) {
                        const int c = col - 1304, hb = c >> 6, bb = m >> 13, t = m & 8191;
                        u32x4 w; w[0] = pk_bf16(v0[0], v0[1]); w[1] = pk_bf16(v0[2], v0[3]); w[2] = pk_bf16(v1[0], v1[1]); w[3] = pk_bf16(v1[2], v1[3]);
                        *(u32x4*)(XRB + ((size_t)(bb * 8 + hb) * SEQP + 3 + t) * 64 + (c & 63)) = w;
                    } else {
                        u32x4 w; w[0] = pk_bf16(gelu_t(v0[0]), gelu_t(v0[1])); w[1] = pk_bf16(gelu_t(v0[2]), gelu_t(v0[3])); w[2] = pk_bf16(gelu_t(v1[0]), gelu_t(v1[1])); w[3] = pk_bf16(gelu_t(v1[2]), gelu_t(v1[3]));
                        *(u32x4*)(GRG + (size_t)m * 512 + (col - 1816)) = w;
                    }
                }
            }
    });
    pg8::gemm_phase(lds, g, S, E);
}

__device__ __forceinline__ void phase5_e(const Params& p, int bid, int nb, LAS unsigned char* lds) {
    const float* x = p.in[0]; const float* mod = (const float*)(p.ws + WS_MOD); bf16_t* X1 = (bf16_t*)(p.ws + WS_X1);
    pg8::Gemm g{(const pg8::bf16_t*)(p.ws + WS_YB), (const pg8::bf16_t*)(p.ws + WS_WOUTT), MTOK, 1024, 1024};
    pg8::StaticOrder S; S.init(MTOK, 1024, nb, bid);
    auto E = make_epi_p([=](const f32x4 (&acc)[2][2][4][2], const pg8::Unit& u, int wr, int wc, int fr, int fq) {
        const int c0 = u.pn * 256 + wc * 32 + fq * 8;
        const int bb = (u.pm * 256) >> 13;
        f32x4 gv[2][2];
#pragma unroll
        for (int bj = 0; bj < 2; ++bj)
#pragma unroll
            for (int nn = 0; nn < 2; ++nn) gv[bj][nn] = *(const f32x4*)(mod + bb * 6144 + 2048 + c0 + bj * 128 + nn * 4);
#pragma unroll
        for (int ai = 0; ai < 2; ++ai)
#pragma unroll
            for (int mm = 0; mm < 4; ++mm) {
                const size_t o = (size_t)(u.pm * 256 + ai * 128 + wr * 64 + mm * 16 + fr) * 1024 + c0;
                f32x4 xv[2][2];
#pragma unroll
                for (int bj = 0; bj < 2; ++bj)
#pragma unroll
                    for (int nn = 0; nn < 2; ++nn) xv[bj][nn] = *(const f32x4*)(x + o + bj * 128 + nn * 4);
#pragma unroll
                for (int bj = 0; bj < 2; ++bj) {
                    const f32x4 r0 = xv[bj][0] + gv[bj][0] * acc[ai][bj][mm][0], r1 = xv[bj][1] + gv[bj][1] * acc[ai][bj][mm][1];
                    u32x4 w; w[0] = pk_bf16(r0[0], r0[1]); w[1] = pk_bf16(r0[2], r0[3]); w[2] = pk_bf16(r1[0], r1[1]); w[3] = pk_bf16(r1[2], r1[3]);
                    *(u32x4*)(X1 + o + bj * 128) = w;
                }
            }
    });
    pg8::gemm_phase(lds, g, S, E);
}

#ifndef A4_PROBE_MASK
#define A4_PROBE_MASK 7
#endif
#define A4_KV 0
#define A4_SCORE 65536
#define A4_LUT 131200
#define LUTP 1156
#define A4_SELM 149760
__device__ __forceinline__ float ex2(float x) { return __builtin_amdgcn_exp2f(x); }

__device__ __forceinline__ float xmax_16_32(float v) {
    { auto r = __builtin_amdgcn_permlane16_swap(__float_as_uint(v), __float_as_uint(v), false, false); v = fmaxf(__uint_as_float(r[0]), __uint_as_float(r[1])); }
    { auto r = __builtin_amdgcn_permlane32_swap(__float_as_uint(v), __float_as_uint(v), false, false); v = fmaxf(__uint_as_float(r[0]), __uint_as_float(r[1])); }
    return v;
}
__device__ __forceinline__ float xsum_16_32(float v) {
    { auto r = __builtin_amdgcn_permlane16_swap(__float_as_uint(v), __float_as_uint(v), false, false); v = __uint_as_float(r[0]) + __uint_as_float(r[1]); }
    { auto r = __builtin_amdgcn_permlane32_swap(__float_as_uint(v), __float_as_uint(v), false, false); v = __uint_as_float(r[0]) + __uint_as_float(r[1]); }
    return v;
}


__device__ __forceinline__ void phase4_mfma(unsigned char* ws, int bid, int nb, LAS unsigned char* lds) {
    int tid_ = threadIdx.x; asm volatile("" : "+v"(tid_));
    const int tid = tid_, wid = __builtin_amdgcn_readfirstlane(tid >> 6), lane = tid & 63;
    const int col = lane & 15, tl = col >> 2, hd = col & 3, g4 = lane >> 4, fr = col;
    const bf16_t* QB = (const bf16_t*)(ws + WS_QB);
    const unsigned char* KV6 = ws + WS_KV6;
    const unsigned char* KCB = ws + WS_KCB; const unsigned char* VCB = ws + WS_VCB;
    const float* lutg = (const float*)(ws + WS_LUT);
    const float* GATE = (const float*)(ws + WS_GATE);
    float* OATT = (float*)(ws + WS_OATT);
    LAS float* lutl = (LAS float*)(lds + A4_LUT);
    LAS float* score = (LAS float*)(lds + A4_SCORE);
    LAS unsigned* selm = (LAS unsigned*)(lds + A4_SELM);
    const int koff0 = fr * 128 + 16 * ((g4) ^ (fr & 7)), koff1 = fr * 128 + 16 * ((4 + g4) ^ (fr & 7));
    const int q4 = (lane >> 2) & 3, pp = lane & 3, xk = (g4 & 1) * 4 + q4;
    int voff[4];
#pragma unroll
    for (int db = 0; db < 4; ++db) voff[db] = (g4 * 4 + q4) * 128 + 16 * ((db * 2 + (pp >> 1)) ^ xk) + 8 * (pp & 1);
    const int dr = tid >> 3, dsrc = dr * 128 + (((tid & 7) ^ (dr & 7)) * 16);

#define A4_ISSUE(kbase, vbase, stage) do { \
        __builtin_amdgcn_global_load_lds((const unsigned*)((kbase) + dsrc), (LAS unsigned*)(lds + A4_KV + (stage) * 16384 + wid * 1024), 16, 0, 0); \
        if (vbase) __builtin_amdgcn_global_load_lds((const unsigned*)((vbase) + dsrc), (LAS unsigned*)(lds + A4_KV + (stage) * 16384 + 8192 + wid * 1024), 16, 0, 0); } while (0)
#define A4_SYNC() do { asm volatile("s_waitcnt vmcnt(0)" ::: "memory"); __syncthreads(); } while (0)
#define A4_SYNC_RING(issued) do { asm volatile("s_waitcnt lgkmcnt(0)" ::: "memory"); if (issued) asm volatile("s_waitcnt vmcnt(2)" ::: "memory"); else asm volatile("s_waitcnt vmcnt(0)" ::: "memory"); \
        asm volatile("" ::: "memory"); __builtin_amdgcn_s_barrier(); asm volatile("" ::: "memory"); } while (0)

    for (int u2 = bid; u2 < 256; u2 += nb)
    for (int hf = 0; hf < 2; ++hf)
    for (int rep4 = 0; rep4 < ((REP & 64) ? 2 : 1); ++rep4) {
        const bool probe = rep4 > 0; const int amask = probe ? A4_PROBE_MASK : 7;
        const int bg = u2 >> 6, b = bg >> 1, g = bg & 1;
        const int T = hf ? 127 - (u2 & 63) : (u2 & 63);
        const int t0 = T * 64;
        const size_t seqbase = (size_t)(b * 2 + g) * SEQ;
        __syncthreads();
        for (int i = tid; i < 4 * 1152; i += NT) { const int hh = i / 1152, dd = i - hh * 1152; lutl[hh * LUTP + dd] = lutg[(g * 4 + hh) * 1024 + (dd < 1023 ? dd : 1023)] * LOG2E; }
        if (!probe) for (int i = tid; i < 8192; i += NT) score[i] = 0.f;
        int tq[2]; tq[0] = t0 + 8 * wid + tl; tq[1] = tq[0] + 4;
        bf16x8 qf[2][2];
#pragma unroll
        for (int ct = 0; ct < 2; ++ct) {
            const size_t m = (size_t)b * SEQ + tq[ct];
#pragma unroll
            for (int h2 = 0; h2 < 2; ++h2) qf[ct][h2] = *(const bf16x8*)(QB + m * 512 + (g * 4 + hd) * 64 + h2 * 32 + g4 * 8);
        }
#define A4_GATEV(ct, br) (GATE[((size_t)b * SEQ + tq[ct]) * 24 + (g * 4 + hd) * 3 + (br)])
        __syncthreads();

        float mrun[2], lrun[2];
        f32x4 O[2][4];
        bf16x8 kf[4][2];
        f32x4 sv[4];
#define A4_LOADK(stage) do { _Pragma("unroll") for (int kt = 0; kt < 4; ++kt) { \
            kf[kt][0] = *(const LAS bf16x8*)(lds + A4_KV + (stage) * 16384 + kt * 2048 + koff0); \
            kf[kt][1] = *(const LAS bf16x8*)(lds + A4_KV + (stage) * 16384 + kt * 2048 + koff1); } } while (0)
#define A4_SCORES(ct) do { _Pragma("unroll") for (int kt = 0; kt < 4; ++kt) { \
            sv[kt] = __builtin_amdgcn_mfma_f32_16x16x32_bf16(kf[kt][0], qf[ct][0], (f32x4){0.f, 0.f, 0.f, 0.f}, 0, 0, 0); \
            sv[kt] = __builtin_amdgcn_mfma_f32_16x16x32_bf16(kf[kt][1], qf[ct][1], sv[kt], 0, 0, 0); } } while (0)
#define A4_VREADS(stage, a, l0, h0, l1, h1, l2, h2, l3, h3) do { \
            LAS unsigned char* vb_ = lds + A4_KV + (stage) * 16384 + 8192 + (a) * 4096; \
            l0 = tr_read(vb_ + voff[0]); h0 = tr_read(vb_ + 2048 + voff[0]); l1 = tr_read(vb_ + voff[1]); h1 = tr_read(vb_ + 2048 + voff[1]); \
            l2 = tr_read(vb_ + voff[2]); h2 = tr_read(vb_ + 2048 + voff[2]); l3 = tr_read(vb_ + voff[3]); h3 = tr_read(vb_ + 2048 + voff[3]); } while (0)
#define A4_PVMMA(ct, a, l0, h0, l1, h1, l2, h2, l3, h3) do { \
            u32x4 pw; pw[0] = pk_bf16(sv[2 * (a)][0], sv[2 * (a)][1]); pw[1] = pk_bf16(sv[2 * (a)][2], sv[2 * (a)][3]); \
            pw[2] = pk_bf16(sv[2 * (a) + 1][0], sv[2 * (a) + 1][1]); pw[3] = pk_bf16(sv[2 * (a) + 1][2], sv[2 * (a) + 1][3]); \
            const bf16x8 pf = __builtin_bit_cast(bf16x8, pw); \
            O[ct][0] = __builtin_amdgcn_mfma_f32_16x16x32_bf16((bf16x8){l0[0], l0[1], l0[2], l0[3], h0[0], h0[1], h0[2], h0[3]}, pf, O[ct][0], 0, 0, 0); \
            O[ct][1] = __builtin_amdgcn_mfma_f32_16x16x32_bf16((bf16x8){l1[0], l1[1], l1[2], l1[3], h1[0], h1[1], h1[2], h1[3]}, pf, O[ct][1], 0, 0, 0); \
            O[ct][2] = __builtin_amdgcn_mfma_f32_16x16x32_bf16((bf16x8){l2[0], l2[1], l2[2], l2[3], h2[0], h2[1], h2[2], h2[3]}, pf, O[ct][2], 0, 0, 0); \
            O[ct][3] = __builtin_amdgcn_mfma_f32_16x16x32_bf16((bf16x8){l3[0], l3[1], l3[2], l3[3], h3[0], h3[1], h3[2], h3[3]}, pf, O[ct][3], 0, 0, 0); } while (0)
#define A4_ONLINE_PV(ct, stage) do { \
            s16x4 va0, va1, va2, va3, va4, va5, va6, va7; \
            A4_VREADS(stage, 0, va0, va1, va2, va3, va4, va5, va6, va7); \
            float mx = fmaxf(fmaxf(sv[0][0], sv[0][1]), fmaxf(sv[0][2], sv[0][3])); \
            _Pragma("unroll") for (int kt = 1; kt < 4; ++kt) _Pragma("unroll") for (int j = 0; j < 4; ++j) mx = fmaxf(mx, sv[kt][j]); \
            mx = xmax_16_32(mx); \
            const float mnew = fmaxf(mrun[ct], mx); const float muse = (mnew == -INF) ? 0.f : mnew; \
            const float scl = ex2(mrun[ct] - muse); mrun[ct] = mnew; \
            const float nmu = -muse; \
            _Pragma("unroll") for (int kt = 0; kt < 4; ++kt) { sv[kt] += nmu; _Pragma("unroll") for (int j = 0; j < 4; ++j) sv[kt][j] = ex2(sv[kt][j]); } \
            const f32x4 ls4 = (sv[0] + sv[1]) + (sv[2] + sv[3]); const float ls = (ls4[0] + ls4[1]) + (ls4[2] + ls4[3]); \
            lrun[ct] = lrun[ct] * scl + ls; \
            if (__builtin_amdgcn_ballot_w64(scl != 1.f) != 0ull) { _Pragma("unroll") for (int db = 0; db < 4; ++db) O[ct][db] *= scl; } \
            TR_WAIT8(va0, va1, va2, va3, va4, va5, va6, va7); \
            s16x4 vb0, vb1, vb2, vb3, vb4, vb5, vb6, vb7; \
            A4_VREADS(stage, 1, vb0, vb1, vb2, vb3, vb4, vb5, vb6, vb7); \
            A4_PVMMA(ct, 0, va0, va1, va2, va3, va4, va5, va6, va7); \
            TR_WAIT8(vb0, vb1, vb2, vb3, vb4, vb5, vb6, vb7); \
            A4_PVMMA(ct, 1, vb0, vb1, vb2, vb3, vb4, vb5, vb6, vb7); } while (0)
#define A4_PV(ct, stage) do { \
            s16x4 va0, va1, va2, va3, va4, va5, va6, va7; \
            A4_VREADS(stage, 0, va0, va1, va2, va3, va4, va5, va6, va7); \
            TR_WAIT8(va0, va1, va2, va3, va4, va5, va6, va7); \
            A4_PVMMA(ct, 0, va0, va1, va2, va3, va4, va5, va6, va7); \
            A4_VREADS(stage, 1, va0, va1, va2, va3, va4, va5, va6, va7); \
            TR_WAIT8(va0, va1, va2, va3, va4, va5, va6, va7); \
            A4_PVMMA(ct, 1, va0, va1, va2, va3, va4, va5, va6, va7); } while (0)
#define A4_RESET() do { _Pragma("unroll") for (int ct = 0; ct < 2; ++ct) { mrun[ct] = -INF; lrun[ct] = 0.f; \
            _Pragma("unroll") for (int db = 0; db < 4; ++db) O[ct][db] = (f32x4){0.f, 0.f, 0.f, 0.f}; } } while (0)
#define A4_FINISH(br, first) do { _Pragma("unroll") for (int ct = 0; ct < 2; ++ct) { \
            float lt = lrun[ct]; lt = xsum_16_32(lt); \
            const float wv = A4_GATEV(ct, br) / fmaxf(lt, 1e-30f); \
            float* op = OATT + ((size_t)b * SEQ + tq[ct]) * 512 + (g * 4 + hd) * 64 + g4 * 4; \
            _Pragma("unroll") for (int db = 0; db < 4; ++db) { f32x4 r = O[ct][db] * wv; if (!(first)) r += *(const f32x4*)(op + db * 16); *(f32x4*)(op + db * 16) = r; } } } while (0)

        if (amask & 1) {
            const unsigned char* KW = KV6 + (size_t)4 * 4194304 + seqbase * 128; const unsigned char* VW = KV6 + (size_t)5 * 4194304 + seqbase * 128;
            A4_RESET();
            const int s0 = T >= 8 ? 0 : 8 - T;
            { const int jb = T - 8 + s0; A4_ISSUE(KW + (size_t)jb * 8192, VW + (size_t)jb * 8192, 0);
              if (s0 < 8) { A4_ISSUE(KW + (size_t)(jb + 1) * 8192, VW + (size_t)(jb + 1) * 8192, 1); asm volatile("s_waitcnt vmcnt(2)" ::: "memory"); } else asm volatile("s_waitcnt vmcnt(0)" ::: "memory");
              __syncthreads(); }
            int stage = 0;
            for (int s = s0; s <= 8; ++s) {
                const int jb = T - 8 + s;
                const bool iss = (s + 2 <= 8);
                if (iss) { const int st2 = stage >= 1 ? stage - 1 : 2; const unsigned char* kn = KW + (size_t)(jb + 2) * 8192; const unsigned char* vn = VW + (size_t)(jb + 2) * 8192; A4_ISSUE(kn, vn, st2); }
#pragma unroll
                for (int ct = 0; ct < 2; ++ct) {
                    A4_LOADK(stage);
                    A4_SCORES(ct);
                    __builtin_amdgcn_sched_barrier(0);
                    const int t = tq[ct];
                    {
                        const int base = t - jb * 64 - g4 * 4;
                        const LAS float* lp = lutl + hd * LUTP + base - 51;
                        const bool edge = (s == 0) || (s == 8);
#pragma unroll
                        for (int kt = 0; kt < 4; ++kt) {
                            f32x4 bs;
#pragma unroll
                            for (int j = 0; j < 4; ++j) bs[j] = lp[51 - kt * 16 - j];
                            asm volatile("" : "+v"(bs));
                            sv[kt] += bs;
                        }
                        if (edge) {
#pragma unroll
                            for (int kt = 0; kt < 4; ++kt)
#pragma unroll
                                for (int j = 0; j < 4; ++j) { const int dist = base - kt * 16 - j; sv[kt][j] = ((dist >= 0) && (dist < 512)) ? sv[kt][j] : -INF; }
                        }
                    }
                    A4_ONLINE_PV(ct, stage);
                    __builtin_amdgcn_sched_barrier(0);
                }
                A4_SYNC_RING(iss);
                stage = stage == 2 ? 0 : stage + 1;
            }
            if (!probe) A4_FINISH(2, true);
        }
        if (amask & 2) {
            const unsigned char* KC = KCB + (size_t)(b * 2 + g) * 512 * 128; const unsigned char* VC = VCB + (size_t)(b * 2 + g) * 512 * 128;
            int ncmp = 4 * T + 3; if (ncmp > NCMP) ncmp = NCMP;
            const int nblk = (ncmp + 63) >> 6;
            A4_RESET();
            A4_ISSUE(KC, (const unsigned char*)nullptr, 0);
            A4_SYNC();
            for (int s = 0; s < nblk; ++s) {
                const int stage = s & 1;
                if (s + 1 < nblk) A4_ISSUE(KC + (size_t)(s + 1) * 8192, (const unsigned char*)nullptr, stage ^ 1);
#pragma unroll
                for (int ct = 0; ct < 2; ++ct) {
                    A4_LOADK(stage);
                    A4_SCORES(ct);
                    __builtin_amdgcn_sched_barrier(0);
                    const int t = tq[ct];
                    float mx = -INF;
#pragma unroll
                    for (int kt = 0; kt < 4; ++kt) {
                        f32x4 bs;
#pragma unroll
                        for (int j = 0; j < 4; ++j) { int dist = t - (16 * (s * 64 + kt * 16 + g4 * 4 + j) + 31); dist = dist < 1023 ? dist : 1023; bs[j] = lutl[hd * LUTP + (dist & 1023)]; }
                        asm volatile("" : "+v"(bs));
#pragma unroll
                        for (int j = 0; j < 4; ++j) {
                            const int n = s * 64 + kt * 16 + g4 * 4 + j; const int dist = t - (16 * n + 31);
                            const bool ok = (dist >= 0) && (n < NCMP);
                            sv[kt][j] = ok ? sv[kt][j] + bs[j] : -INF; mx = fmaxf(mx, sv[kt][j]);
                        }
                    }
                    mx = xmax_16_32(mx);
                    const float mnew = fmaxf(mrun[ct], mx); const float muse = (mnew == -INF) ? 0.f : mnew;
                    const float scl = ex2(mrun[ct] - muse); mrun[ct] = mnew;
                    float ls = 0.f;
#pragma unroll
                    for (int kt = 0; kt < 4; ++kt)
#pragma unroll
                        for (int j = 0; j < 4; ++j) ls += ex2(sv[kt][j] - muse);
                    lrun[ct] = lrun[ct] * scl + ls;
                    __builtin_amdgcn_sched_barrier(0);
                }
                A4_SYNC();
            }
            float mfin[2], linv[2];
#pragma unroll
            for (int ct = 0; ct < 2; ++ct) {
                float lt = lrun[ct]; lt = xsum_16_32(lt);
                linv[ct] = 1.f / fmaxf(lt, 1e-30f); mfin[ct] = (mrun[ct] == -INF) ? 0.f : mrun[ct];
            }
            A4_ISSUE(KC, VC, 0);
            A4_SYNC();
            for (int s = 0; s < nblk; ++s) {
                const int stage = s & 1;
                if (s + 1 < nblk) { const unsigned char* kn = KC + (size_t)(s + 1) * 8192; const unsigned char* vn = VC + (size_t)(s + 1) * 8192; A4_ISSUE(kn, vn, stage ^ 1); }
#pragma unroll
                for (int ct = 0; ct < 2; ++ct) {
                    A4_LOADK(stage);
                    A4_SCORES(ct);
                    __builtin_amdgcn_sched_barrier(0);
                    const int t = tq[ct];
#pragma unroll
                    for (int kt = 0; kt < 4; ++kt) {
                        f32x4 bs;
#pragma unroll
                        for (int j = 0; j < 4; ++j) { int dist = t - (16 * (s * 64 + kt * 16 + g4 * 4 + j) + 31); dist = dist < 1023 ? dist : 1023; bs[j] = lutl[hd * LUTP + (dist & 1023)]; }
                        asm volatile("" : "+v"(bs));
#pragma unroll
                        for (int j = 0; j < 4; ++j) {
                            const int n = s * 64 + kt * 16 + g4 * 4 + j; const int dist = t - (16 * n + 31);
                            const bool ok = (dist >= 0) && (n < NCMP);
                            sv[kt][j] = ok ? ex2(sv[kt][j] + bs[j] - mfin[ct]) * linv[ct] : 0.f;
                        }
                        float s4 = (sv[kt][0] + sv[kt][1]) + (sv[kt][2] + sv[kt][3]); float s3 = sv[kt][3];
                        s4 += __shfl_xor(s4, 1); s4 += __shfl_xor(s4, 2); s3 += __shfl_xor(s3, 1); s3 += __shfl_xor(s3, 2);
                        const int a = s * 16 + kt * 4 + g4;
                        if (hd == 0 && !probe) {
                            LAS float* sp = score + (8 * wid + 4 * ct + tl) * 128 + a;
                            atomicAdd((float*)sp, s4);
                            if (a + 1 < 128) atomicAdd((float*)(sp + 1), s3);
                        }
                    }
                    A4_PV(ct, stage);
                    __builtin_amdgcn_sched_barrier(0);
                }
                A4_SYNC();
            }
            if (!probe)
#pragma unroll
            for (int ct = 0; ct < 2; ++ct) {
                float* op = OATT + ((size_t)b * SEQ + tq[ct]) * 512 + (g * 4 + hd) * 64 + g4 * 4;
#pragma unroll
                for (int db = 0; db < 4; ++db) { const float gcv = A4_GATEV(ct, 0); f32x4 r = O[ct][db] * gcv; r += *(const f32x4*)(op + db * 16); *(f32x4*)(op + db * 16) = r; }
            }
        }
        __syncthreads();
        if (!probe)
        for (int tt = 0; tt < 8; ++tt) {
            const int ti = 8 * wid + tt;
            const int j0 = lane, j1 = lane + 64;
            bool sel0, sel1;
            if (T <= 15) { sel0 = j0 <= T; sel1 = false; }
            else {
                const bool c0 = (j0 >= 1) && (j0 <= T - 2), c1 = (j1 <= T - 2);
                const float s0 = c0 ? score[ti * 128 + j0] : -INF, s1 = c1 ? score[ti * 128 + j1] : -INF;
                int r0 = 0, r1 = 0;
                for (int j2 = 1; j2 <= T - 2; ++j2) { const float v = score[ti * 128 + j2]; r0 += (v > s0) || (v == s0 && j2 < j0); r1 += (v > s1) || (v == s1 && j2 < j1); }
                sel0 = (c0 && r0 < 13) || (j0 == 0) || (j0 == T) || (j0 == T - 1);
                sel1 = (c1 && r1 < 13) || (j1 == T) || (j1 == T - 1);
            }
            const unsigned long long b0 = __ballot(sel0), b1 = __ballot(sel1);
            if (lane == 0) { selm[ti * 4 + 0] = (unsigned)b0; selm[ti * 4 + 1] = (unsigned)(b0 >> 32); selm[ti * 4 + 2] = (unsigned)b1; selm[ti * 4 + 3] = (unsigned)(b1 >> 32); }
        }
        __builtin_amdgcn_wave_barrier();
        asm volatile("s_waitcnt lgkmcnt(0)" ::: "memory");
        if (amask & 4) {
            const unsigned char* KS = KV6 + (size_t)2 * 4194304 + seqbase * 128; const unsigned char* VS = KV6 + (size_t)3 * 4194304 + seqbase * 128;
            unsigned un[2][4];
#pragma unroll
            for (int ct = 0; ct < 2; ++ct)
#pragma unroll
                for (int w = 0; w < 4; ++w) {
                    unsigned uu = selm[(8 * wid + 4 * ct + 0) * 4 + w] | selm[(8 * wid + 4 * ct + 1) * 4 + w] | selm[(8 * wid + 4 * ct + 2) * 4 + w] | selm[(8 * wid + 4 * ct + 3) * 4 + w];
                    un[ct][w] = __builtin_amdgcn_readfirstlane(uu);
                }
            A4_RESET();
            const float cbfar = lutl[hd * LUTP + 1023];
            __syncthreads();
#pragma unroll
            for (int bq = 0; bq < 4; ++bq) if (bq <= T) { const unsigned char* kn = KS + (size_t)bq * 8192; const unsigned char* vn = VS + (size_t)bq * 8192; A4_ISSUE(kn, vn, bq); }
            A4_SYNC();
#pragma unroll
            for (int w = 0; w < 4; ++w) {
                const unsigned selw0 = selm[(8 * wid + tl) * 4 + w], selw1 = selm[(8 * wid + 4 + tl) * 4 + w];
                for (int gg = 0; gg < 8; ++gg) {
                    const int j0 = w * 32 + gg * 4;
                    if (j0 > T) break;
#pragma unroll
                    for (int bq = 0; bq < 4; ++bq) { const int jn = j0 + 4 + bq; if (jn <= T) { const unsigned char* kn = KS + (size_t)jn * 8192; const unsigned char* vn = VS + (size_t)jn * 8192; A4_ISSUE(kn, vn, (jn & 7)); } }
                    for (int bq = 0; bq < 4; ++bq) {
                        const int j = j0 + bq;
                        if (j > T) break;
                        const int jb = gg * 4 + bq, stage = j & 7;
                        const bool need0 = (un[0][w] >> jb) & 1u, need1 = (un[1][w] >> jb) & 1u;
                        if (need0 || need1) {
#pragma unroll
                            for (int ct = 0; ct < 2; ++ct) {
                                if (ct == 0 ? need0 : need1) {
                                    A4_LOADK(stage);
                                    A4_SCORES(ct);
                                    __builtin_amdgcn_sched_barrier(0);
                                    const int t = tq[ct];
                                    const bool csel = ((ct == 0 ? selw0 : selw1) >> jb) & 1u;
                                    if (j * 64 + 63 + 1023 <= t0) {
                                        const float cb = csel ? cbfar : -INF;
#pragma unroll
                                        for (int kt = 0; kt < 4; ++kt)
#pragma unroll
                                            for (int jj = 0; jj < 4; ++jj) sv[kt][jj] += cb;
                                    } else {
                                        const int base = t - j * 64 - g4 * 4;
                                        const LAS float* lp = lutl + hd * LUTP + base - 51;
                                        const float msk = csel ? 0.f : -INF;
#pragma unroll
                                        for (int kt = 0; kt < 4; ++kt) {
                                            f32x4 bs;
#pragma unroll
                                            for (int jj = 0; jj < 4; ++jj) bs[jj] = lp[51 - kt * 16 - jj];
                                            asm volatile("" : "+v"(bs));
                                            sv[kt] += bs + msk;
                                        }
                                        if (j == T) {
#pragma unroll
                                            for (int kt = 0; kt < 4; ++kt)
#pragma unroll
                                                for (int jj = 0; jj < 4; ++jj) { const int dist = base - kt * 16 - jj; sv[kt][jj] = (dist >= 0) ? sv[kt][jj] : -INF; }
                                        }
                                    }
                                    A4_ONLINE_PV(ct, stage);
                                    __builtin_amdgcn_sched_barrier(0);
                                }
                            }
                        }
                    }
                    A4_SYNC();
                }
            }
            if (!probe) A4_FINISH(1, false);
        }
    }
#undef A4_ISSUE
#undef A4_SYNC
#undef A4_SYNC_RING
#undef A4_LOADK
#undef A4_SCORES
#undef A4_ONLINE_PV
#undef A4_PV
#undef A4_VREADS
#undef A4_PVMMA
#undef A4_RESET
#undef A4_FINISH
#undef A4_GATEV
}

__device__ __forceinline__ void phase3_mfma(const Params& p, int bid, int nb, LAS unsigned char* lds) {
    {
        const unsigned char* XRBb = p.ws + WS_XRB; const bf16_t* XRB = (const bf16_t*)(p.ws + WS_XRB);
        const float* BG = (const float*)(p.ws + WS_BG); const float* GB = (const float*)(p.ws + WS_GBIAS);
        const float* conv_w = p.in[12]; const float* conv_b = p.in[13]; const float* lam = p.in[18];
        bf16_t* AL = (bf16_t*)(p.ws + WS_ALRU); bf16_t* UL = (bf16_t*)(p.ws + WS_ULRU);
        const XcdDeal dl = xcd_deal(512, lds, nb);
        gemm_stream<true, 1, 0, true>(lds, XRBb, dl.n, 4, 128,
            [&](int ps, int r) { const int u = dl.lo + ps * dl.step; return ((size_t)(u >> 5) * SEQP + (u & 31) * 256 + r) * 128; },
            [&](int ps, int n4) -> const float* { const int u = dl.lo + ps * dl.step; return BG + ((u >> 5) & 7) * 32768 + n4 * 4; },
            [&](int) { return 256; },
            [&](int ps, int rbase, int nbase, int, f32x4 (&acc)[4][4]) {
                const int u = dl.lo + ps * dl.step, sq = u >> 5, hb = sq & 7, bb = sq >> 3, t0 = (u & 31) * 256 + rbase;
                const int j8 = (nbase >> 6) * 32 + ((nbase >> 2) & 3) * 8, c = hb * 64 + j8;
                f32x4 cw[4][2], cbv[2], ga[2], gx[2], spl[2];
#pragma unroll
                for (int h2 = 0; h2 < 2; ++h2) {
#pragma unroll
                    for (int w = 0; w < 4; ++w) cw[w][h2] = *(const f32x4*)(conv_w + w * 512 + c + 4 * h2);
                    cbv[h2] = *(const f32x4*)(conv_b + c + 4 * h2);
                    ga[h2] = *(const f32x4*)(GB + hb * 128 + nbase + 16 * h2); gx[h2] = *(const f32x4*)(GB + hb * 128 + nbase + 16 * h2 + 32);
                    const f32x4 lm = *(const f32x4*)(lam + c + 4 * h2);
#pragma unroll
                    for (int jj = 0; jj < 4; ++jj) spl[h2][jj] = -8.0f * softplus_(-lm[jj]);
                }
#pragma unroll
                for (int mh = 0; mh < 2; ++mh) {
                u32x4 xw[4][4];
#pragma unroll
                for (int mi = 2 * mh; mi < 2 * mh + 2; ++mi)
#pragma unroll
                    for (int w = 0; w < 4; ++w) xw[mi][w] = *(const u32x4*)(XRB + ((size_t)sq * SEQP + t0 + mi * 16 + w) * 64 + j8);
#pragma unroll
                for (int mi = 2 * mh; mi < 2 * mh + 2; ++mi) {
                    f32x4 xc[2] = {cbv[0], cbv[1]};
#pragma unroll
                    for (int w = 0; w < 4; ++w) {
                        xc[0][0] += cw[w][0][0] * __uint_as_float(xw[mi][w][0] << 16); xc[0][1] += cw[w][0][1] * __uint_as_float(xw[mi][w][0] & 0xffff0000u);
                        xc[0][2] += cw[w][0][2] * __uint_as_float(xw[mi][w][1] << 16); xc[0][3] += cw[w][0][3] * __uint_as_float(xw[mi][w][1] & 0xffff0000u);
                        xc[1][0] += cw[w][1][0] * __uint_as_float(xw[mi][w][2] << 16); xc[1][1] += cw[w][1][1] * __uint_as_float(xw[mi][w][2] & 0xffff0000u);
                        xc[1][2] += cw[w][1][2] * __uint_as_float(xw[mi][w][3] << 16); xc[1][3] += cw[w][1][3] * __uint_as_float(xw[mi][w][3] & 0xffff0000u);
                    }
                    f32x4 dv[2], uv[2];
#pragma unroll
                    for (int ni = 0; ni < 2; ++ni)
#pragma unroll
                        for (int jj = 0; jj < 4; ++jj) {
                            const float r_ = sigm(acc[mi][ni][jj] + ga[ni][jj]), ig = sigm(acc[mi][ni + 2][jj] + gx[ni][jj]);
                            const float la = r_ * spl[ni][jj];
                            const float a1 = __builtin_amdgcn_exp2f(la * 1.4426950408889634f);
                            dv[ni][jj] = 1.f - a1; uv[ni][jj] = __builtin_amdgcn_sqrtf(fmaxf(1.f - a1 * a1, 0.f)) * (ig * xc[ni][jj]);
                        }
                    const size_t o = ((size_t)bb * SEQ + t0 + mi * 16) * 512 + c;
                    u32x4 wd, wu;
                    wd[0] = pk_bf16(dv[0][0], dv[0][1]); wd[1] = pk_bf16(dv[0][2], dv[0][3]); wd[2] = pk_bf16(dv[1][0], dv[1][1]); wd[3] = pk_bf16(dv[1][2], dv[1][3]);
                    wu[0] = pk_bf16(uv[0][0], uv[0][1]); wu[1] = pk_bf16(uv[0][2], uv[0][3]); wu[2] = pk_bf16(uv[1][0], uv[1][1]); wu[3] = pk_bf16(uv[1][2], uv[1][3]);
                    *(u32x4*)(AL + o) = wd; *(u32x4*)(UL + o) = wu;
                }
                __builtin_amdgcn_sched_barrier(0);
                } });
    }
    {
        const unsigned char* KV6 = p.ws + WS_KV6; float* CP = (float*)(p.ws + WS_CPART);
        const float* W1k = p.in[7]; const float* W1v = p.in[9];
        const XcdDeal dl = xcd_deal(256, lds, nb);
        gemm_stream<false, 1>(lds, KV6, dl.n, 2, 64,
            [&](int ps, int r) { const int u = dl.lo + ps * dl.step, ks = u >> 4, kv = (u >> 3) & 1, R = (u & 7) * 256 + r;
                                 return (size_t)kv * 4194304 + ((size_t)(R >> 9) * SEQ + 16 * (R & 511)) * 128 + (size_t)ks * 256; },
            [&](int ps, int n4) -> const float* { const int u = dl.lo + ps * dl.step, ks = u >> 4, kv = (u >> 3) & 1; return (kv ? W1v : W1k) + (size_t)ks * 128 * 64 + ((n4 * 4) & 63); },
            [&](int) { return 256; },
            [&](int ps, int r, int n, f32x4 v) { if (n < 64) { const int u = dl.lo + ps * dl.step; *(f32x4*)(CP + ((size_t)(u >> 3) * 2048 + (u & 7) * 256 + r) * 64 + n) = v; } });
    }
}

__device__ __forceinline__ void phase3b_new(const Params& p, int bid, int nb, float* smem) {
    const int tid = threadIdx.x;
    {
        const bf16_t* AL = (const bf16_t*)(p.ws + WS_ALRU); const bf16_t* UL = (const bf16_t*)(p.ws + WS_ULRU);
        float* AEND = (float*)(p.ws + WS_AEND); float* HEND = (float*)(p.ws + WS_HEND);
        const int cg = tid & 127, sg = tid >> 7;
        f32x4* summA = (f32x4*)smem; f32x4* summH = summA + 512;
        for (int u = bid; u < 256; u += nb) {
            const size_t base = ((size_t)(u >> 7) * SEQ + (u & 127) * 64 + sg * 16) * 512 + 4 * cg;
            u32x2 ar[16], ur[16];
#pragma unroll
            for (int tt = 0; tt < 16; ++tt) { ar[tt] = *(const u32x2*)(AL + base + (size_t)tt * 512); ur[tt] = *(const u32x2*)(UL + base + (size_t)tt * 512); }
            f32x4 A = (f32x4){1.f, 1.f, 1.f, 1.f}, H = (f32x4){0.f, 0.f, 0.f, 0.f};
#pragma unroll
            for (int tt = 0; tt < 16; ++tt) { const f32x4 a_ = 1.f - bf4_f32(ar[tt]); H = a_ * H + bf4_f32(ur[tt]); A = A * a_; }
            __syncthreads();
            summA[sg * 128 + cg] = A; summH[sg * 128 + cg] = H;
            __syncthreads();
            if (sg == 0) {
#pragma unroll
                for (int j = 1; j < 4; ++j) { const f32x4 a2 = summA[j * 128 + cg], h2 = summH[j * 128 + cg]; H = a2 * H + h2; A = A * a2; }
                *(f32x4*)(AEND + (size_t)u * 512 + 4 * cg) = A; *(f32x4*)(HEND + (size_t)u * 512 + 4 * cg) = H;
            }
        }
        __syncthreads();
    }
    {
        const float* CP = (const float*)(p.ws + WS_CPART); const float* CB = (const float*)(p.ws + WS_CBIAS);
        float* hid = smem;
        for (int u = bid; u < 64; u += nb) {
            const int kv = u >> 5, R0 = (u & 31) * 64;
            const float* w2 = kv ? p.in[10] : p.in[8];
            bf16_t* ob = (bf16_t*)(p.ws + (kv ? WS_VCB : WS_KCB));
            __syncthreads();
            for (int i = tid; i < 64 * 64; i += NT) {
                const int r = i >> 6, c = i & 63; const size_t o = ((size_t)kv * 2048 + R0 + r) * 64 + c;
                float v = CB[kv * 64 + c];
#pragma unroll
                for (int ks = 0; ks < 16; ++ks) v += CP[o + (size_t)ks * 262144];
                hid[r * 65 + c] = gelu_t(v);
            }
            __syncthreads();
            for (int i = tid; i < 64 * 64; i += NT) {
                const int r = i >> 6, j = i & 63; float acc = 0.f;
#pragma unroll 8
                for (int k = 0; k < 64; ++k) acc += hid[r * 65 + k] * w2[k * 64 + j];
                const int R = R0 + r;
                if ((R & 511) == 511) acc = 0.f;
                ob[(size_t)R * 64 + j] = (bf16_t)(pk_bf16(acc, acc) & 0xffffu);
            }
        }
    }
}

__device__ __forceinline__ void phase4b_new(const Params& p, int bid, int nb, float* smem) {
    const bf16_t* AL = (const bf16_t*)(p.ws + WS_ALRU); const bf16_t* UL = (const bf16_t*)(p.ws + WS_ULRU);
    const float* AEND = (const float*)(p.ws + WS_AEND); const float* HEND = (const float*)(p.ws + WS_HEND);
    const bf16_t* GRG = (const bf16_t*)(p.ws + WS_GRG); const float* OATT = (const float*)(p.ws + WS_OATT);
    const float* gaw = p.in[19]; const float* grw = p.in[20];
    bf16_t* YB = (bf16_t*)(p.ws + WS_YB);
    const int tid = threadIdx.x, lane = tid & 63;
    const int cg = tid & 127, sg = tid >> 7, wsub = (tid >> 6) & 1;
    f32x4* summA = (f32x4*)smem;
    f32x4* summH = summA + 512;
    float* ssr = smem + 4096;
    float* ssa = ssr + 128;
    const f32x4 gr_w = *(const f32x4*)(grw + 4 * cg), ga_w = *(const f32x4*)(gaw + 4 * cg);
    for (int u = bid; u < 256; u += nb) {
        const int b = u >> 7, chunk = u & 127;
        f32x4 carry = (f32x4){0.f, 0.f, 0.f, 0.f};
        {
            const size_t cb = (size_t)(b * 128) * 512 + 4 * cg;
#pragma unroll 16
            for (int k = 0; k < chunk; ++k) carry = *(const f32x4*)(AEND + cb + (size_t)k * 512) * carry + *(const f32x4*)(HEND + cb + (size_t)k * 512);
        }
        const size_t tok0 = (size_t)b * SEQ + chunk * 64 + sg * 16;
        f32x4 av[16], uv[16];
#pragma unroll
        for (int tt = 0; tt < 16; ++tt) { const size_t o = (tok0 + tt) * 512 + 4 * cg; av[tt] = 1.f - bf4_f32(*(const u32x2*)(AL + o)); uv[tt] = bf4_f32(*(const u32x2*)(UL + o)); }
        f32x4 A = (f32x4){1.f, 1.f, 1.f, 1.f}, H = (f32x4){0.f, 0.f, 0.f, 0.f};
#pragma unroll
        for (int tt = 0; tt < 16; ++tt) { H = av[tt] * H + uv[tt]; A = A * av[tt]; }
        __syncthreads();
        summA[sg * 128 + cg] = A; summH[sg * 128 + cg] = H;
        __syncthreads();
#pragma unroll
        for (int j = 0; j < 3; ++j) if (j < sg) carry = summA[j * 128 + cg] * carry + summH[j * 128 + cg];
        f32x4 h = carry;
#pragma unroll
        for (int tt = 0; tt < 16; ++tt) {
            const size_t o = (tok0 + tt) * 512 + 4 * cg;
            h = av[tt] * h + uv[tt];
            const u32x2 gw = *(const u32x2*)(GRG + o);
            f32x4 v; v[0] = h[0] * __uint_as_float(gw.x << 16); v[1] = h[1] * __uint_as_float(gw.x & 0xffff0000u); v[2] = h[2] * __uint_as_float(gw.y << 16); v[3] = h[3] * __uint_as_float(gw.y & 0xffff0000u);
            uv[tt] = v;
            const float sq = wave_sum((v[0] * v[0] + v[1] * v[1]) + (v[2] * v[2] + v[3] * v[3]));
            const f32x4 oa = *(const f32x4*)(OATT + o);
            av[tt] = oa;
            const float sqa = wave_sum((oa[0] * oa[0] + oa[1] * oa[1]) + (oa[2] * oa[2] + oa[3] * oa[3]));
            if (lane == 0) { ssr[(sg * 16 + tt) * 2 + wsub] = sq; ssa[(sg * 16 + tt) * 2 + wsub] = sqa; }
        }
        __syncthreads();
#pragma unroll
        for (int tt = 0; tt < 16; ++tt) {
            const int ti = sg * 16 + tt;
            const float s1 = ssr[ti * 2] + ssr[ti * 2 + 1], s2 = ssa[ti * 2] + ssa[ti * 2 + 1];
            const float rs1 = __builtin_amdgcn_rsqf(s1 * (1.f / 512.f) + 1e-6f), rs2 = __builtin_amdgcn_rsqf(s2 * (1.f / 512.f) + 1e-6f);
            const f32x4 ya = av[tt] * rs2 * ga_w, yr = uv[tt] * rs1 * gr_w;
            u32x2 wa, wr_; wa.x = pk_bf16(ya[0], ya[1]); wa.y = pk_bf16(ya[2], ya[3]); wr_.x = pk_bf16(yr[0], yr[1]); wr_.y = pk_bf16(yr[2], yr[3]);
            *(u32x2*)(YB + (tok0 + tt) * 1024 + 4 * cg) = wa;
            *(u32x2*)(YB + (tok0 + tt) * 1024 + 512 + 4 * cg) = wr_;
        }
    }
}

__device__ __forceinline__ void phase8(const Params& p, int bid, int nb, float* smem) {
    const float* LOG = (const float*)(p.ws + WS_LOGITS); const float* brt = p.in[24];
    unsigned* cnt = (unsigned*)(p.ws + WS_HIST);
    int* EID = (int*)(p.ws + WS_EID); int* POS = (int*)(p.ws + WS_POS); float* WGT = (float*)(p.ws + WS_WGT);
    int tid_ = threadIdx.x; asm volatile("" : "+v"(tid_));
    const int wave = tid_ >> 6, lane = tid_ & 63;
    int* lhist = (int*)smem;
    if (tid_ < 256) lhist[tid_] = 0;
    __syncthreads();
    float bias[4];
#pragma unroll
    for (int r = 0; r < 4; ++r) bias[r] = brt[r * 64 + lane];
    for (int tok0 = bid * NW + wave; tok0 < MTOK; tok0 += 8 * nb * NW) {
        float lg[8][4];
#pragma unroll
        for (int k = 0; k < 8; ++k) { const int tok = tok0 + k * nb * NW; const int tc = tok < MTOK ? tok : tok0;
#pragma unroll
            for (int r = 0; r < 4; ++r) lg[k][r] = LOG[(size_t)tc * 256 + r * 64 + lane] + LOG[(size_t)MTOK * 256 + (size_t)tc * 256 + r * 64 + lane]; }
#pragma unroll
        for (int k = 0; k < 8; ++k) {
            const int tok = tok0 + k * nb * NW;
            if (tok < MTOK) {
                float sv[4], cv[4], gs[4];
#pragma unroll
                for (int r = 0; r < 4; ++r) { sv[r] = sigm(lg[k][r]); cv[r] = sv[r] + bias[r]; gs[r] = half_top2_sum(cv[r]); }
                float gsc = -INF;
#pragma unroll
                for (int r = 0; r < 4; ++r) {
                    const float ga = __builtin_bit_cast(float, __builtin_amdgcn_readlane(__builtin_bit_cast(int, gs[r]), 31));
                    const float gb = __builtin_bit_cast(float, __builtin_amdgcn_readlane(__builtin_bit_cast(int, gs[r]), 63));
                    gsc = lane == 2 * r ? ga : gsc; gsc = lane == 2 * r + 1 ? gb : gsc;
                }
                int grank = 0;
#pragma unroll
                for (int g2 = 0; g2 < 8; ++g2) { const float v2 = __builtin_bit_cast(float, __builtin_amdgcn_readlane(__builtin_bit_cast(int, gsc), g2)); grank += ((v2 > gsc) || (v2 == gsc && g2 < lane)) ? 1 : 0; }
                const unsigned long long gmask = __ballot((lane < 8) && (grank < 4));
#pragma unroll
                for (int r = 0; r < 4; ++r) cv[r] = ((gmask >> (2 * r + (lane >> 5))) & 1ull) ? cv[r] : -INF;
                int my_e = 0; float my_s = 0.f;
#pragma unroll
                for (int kk = 0; kk < 8; ++kk) {
                    float bv = cv[0]; int bi = lane;
                    if (cv[1] > bv) { bv = cv[1]; bi = 64 + lane; }
                    if (cv[2] > bv) { bv = cv[2]; bi = 128 + lane; }
                    if (cv[3] > bv) { bv = cv[3]; bi = 192 + lane; }
                    const float mx = wave_max_f(bv);
                    const int sel = wave_min_i(bv == mx ? bi : 0x7fffffff);
                    const int sr = sel >> 6;
                    const float mine = sr == 0 ? sv[0] : sr == 1 ? sv[1] : sr == 2 ? sv[2] : sv[3];
                    const float ssel = __builtin_bit_cast(float, __builtin_amdgcn_readlane(__builtin_bit_cast(int, mine), sel & 63));
                    if (lane == (sel & 63)) { cv[0] = sr == 0 ? -INF : cv[0]; cv[1] = sr == 1 ? -INF : cv[1]; cv[2] = sr == 2 ? -INF : cv[2]; cv[3] = sr == 3 ? -INF : cv[3]; }
                    if (lane == kk) { my_e = sel; my_s = ssel; }
                }
                const float ssum = wave_sum(lane < 8 ? my_s : 0.f);
                if (lane < 8) {
                    const int ps = atomicAdd(&lhist[my_e], 1);
                    EID[tok * 8 + lane] = my_e; POS[tok * 8 + lane] = ps; WGT[tok * 8 + lane] = 2.5f * my_s / ssum;
                }
            }
        }
    }
    __syncthreads();
    if (tid_ < 256) cnt[bid * 256 + tid_] = (unsigned)lhist[tid_];
}

__device__ __forceinline__ void expert_tables(const Params& p, int* off, int* tp, int shift = 6) {
    const unsigned* cnt = (const unsigned*)(p.ws + WS_CTL) + CW_CNT;
    __syncthreads();
    if (threadIdx.x < 64) {
        const int l = threadIdx.x; const int rnd = (1 << shift) - 1;
        const u32x4 c4 = *(const u32x4*)(cnt + 4 * l);
        const int c0 = (int)c4[0], c1 = (int)c4[1], c2 = (int)c4[2], c3 = (int)c4[3];
        const int t0 = (c0 + rnd) >> shift, t1 = (c1 + rnd) >> shift, t2 = (c2 + rnd) >> shift, t3 = (c3 + rnd) >> shift;
        const int so = c0 + c1 + c2 + c3, st = t0 + t1 + t2 + t3;
        int io = so, it = st;
#pragma unroll
        for (int d = 1; d < 64; d <<= 1) { const int uo = __shfl_up(io, d), ut = __shfl_up(it, d); if (l >= d) { io += uo; it += ut; } }
        const int eo = io - so, et = it - st;
        off[4 * l] = eo; off[4 * l + 1] = eo + c0; off[4 * l + 2] = eo + c0 + c1; off[4 * l + 3] = eo + c0 + c1 + c2;
        tp[4 * l] = et; tp[4 * l + 1] = et + t0; tp[4 * l + 2] = et + t0 + t1; tp[4 * l + 3] = et + t0 + t1 + t2;
        if (l == 63) { off[256] = io; tp[256] = it; tp[257] = it + (MTOK >> shift); }
    }
    __syncthreads();
}

__device__ __forceinline__ void phase9(const Params& p, int bid, int nb, float* smem) {
    int* off = (int*)smem; int* blkoff = off + 272; int* tot = off + 528; int* ptot = off + 1024; int* ppre = off + 3072;
    const unsigned* HIST = (const unsigned*)(p.ws + WS_HIST);
    unsigned* cnt = (unsigned*)(p.ws + WS_CTL) + CW_CNT;
    int tid_ = threadIdx.x; asm volatile("" : "+v"(tid_));
    const int tid = tid_;
    __syncthreads();
    {
        const int e4 = tid & 63, bg = tid >> 6, gsz = (nb + 7) >> 3, b0 = bg * gsz, b1 = (b0 + gsz) < nb ? (b0 + gsz) : nb;
        int t0 = 0, t1 = 0, t2 = 0, t3 = 0, q0 = 0, q1 = 0, q2 = 0, q3 = 0;
#pragma unroll 16
        for (int bb = b0; bb < b1; ++bb) {
            const u32x4 h = *(const u32x4*)(HIST + (size_t)bb * 256 + 4 * e4); const bool pre = bb < bid;
            t0 += (int)h[0]; t1 += (int)h[1]; t2 += (int)h[2]; t3 += (int)h[3];
            q0 += pre ? (int)h[0] : 0; q1 += pre ? (int)h[1] : 0; q2 += pre ? (int)h[2] : 0; q3 += pre ? (int)h[3] : 0;
        }
        int* pt = ptot + bg * 256 + 4 * e4; int* pq = ppre + bg * 256 + 4 * e4;
        pt[0] = t0; pt[1] = t1; pt[2] = t2; pt[3] = t3; pq[0] = q0; pq[1] = q1; pq[2] = q2; pq[3] = q3;
        __syncthreads();
        if (tid < 256) {
            int total = 0, pre = 0;
#pragma unroll
            for (int g = 0; g < 8; ++g) { total += ptot[g * 256 + tid]; pre += ppre[g * 256 + tid]; }
            tot[tid] = total; blkoff[tid] = pre; if (bid == 0) cnt[tid] = (unsigned)total;
        }
    }
    __syncthreads();
    if (tid < 64) {
        const int c0 = tot[4 * tid], c1 = tot[4 * tid + 1], c2 = tot[4 * tid + 2], c3 = tot[4 * tid + 3];
        const int so = c0 + c1 + c2 + c3; int io = so;
#pragma unroll
        for (int d = 1; d < 64; d <<= 1) { const int uo = __shfl_up(io, d); if (tid >= d) io += uo; }
        const int eo = io - so;
        off[4 * tid] = eo; off[4 * tid + 1] = eo + c0; off[4 * tid + 2] = eo + c0 + c1; off[4 * tid + 3] = eo + c0 + c1 + c2;
    }
    __syncthreads();
    const int* EID = (const int*)(p.ws + WS_EID); const int* POS = (const int*)(p.ws + WS_POS); const float* WGT = (const float*)(p.ws + WS_WGT);
    int* ST = (int*)(p.ws + WS_SLOTTOK); float* SW = (float*)(p.ws + WS_SLOTW); int* SOF = (int*)(p.ws + WS_SLOTOF);
    const int wave = tid >> 6, lane = tid & 63;
    for (int tok0 = bid * NW + wave; tok0 < MTOK; tok0 += 8 * nb * NW) {
        const int tok = tok0 + (lane >> 3) * nb * NW;
        if (tok < MTOK) {
            const int idx = tok * 8 + (lane & 7); const int e = EID[idx];
            const int slot = off[e] + blkoff[e] + POS[idx];
            ST[slot] = tok; SW[slot] = WGT[idx]; SOF[idx] = slot;
        }
    }
}

__device__ __forceinline__ int find_expert(const int* tp, int rt) {
    int lo = 0, hi = 256;
    while (lo < hi) { const int mid = (lo + hi + 1) >> 1; if (tp[mid] <= rt) lo = mid; else hi = mid - 1; }
    return lo;
}

__device__ __forceinline__ void phase7_mfma(const Params& p, int bid, int nb, LAS unsigned char* lds) {
    const unsigned char* H2b = p.ws + WS_H2B;
    float* LOG = (float*)(p.ws + WS_LOGITS);
    const XcdDeal dl = xcd_deal(64 * 2 * 2, lds, nb);
    const bf16_t* wrb = (const bf16_t*)(p.ws + WS_WRB);
    gemm_stream<false, 1, 0, false, true>(lds, H2b, dl.n, 8, 256,
        [&](int ps, int r) { const int u = dl.lo + ps * dl.step; return (size_t)((u >> 2) * 256 + r) * 2048 + (size_t)(u & 1) * 1024; },
        [&](int ps, int n4) -> const bf16_t* { const int u = dl.lo + ps * dl.step; return wrb + (size_t)(u & 1) * 512 * 256 + ((u >> 1) & 1) * 128 + n4 * 4; },
        [&](int) { return 256; },
        [&](int ps, int r, int n, f32x4 v) { const int u = dl.lo + ps * dl.step; *(f32x4*)(LOG + (size_t)(u & 1) * (MTOK * 256) + (size_t)((u >> 2) * 256 + r) * 256 + ((u >> 1) & 1) * 128 + n) = v; });
}

#define ETAB_OFF 24576
#define EDESC_OFF (ETAB_OFF + 1024)
__device__ __forceinline__ int expert_passes(const Params& p, int bid, int nb, const LAS unsigned char* lds, float* smem, int nct, int& npass) {
    int* off = (int*)(smem + ETAB_OFF); int* tp = off + 272; int* desc = (int*)(smem + EDESC_OFF);
    expert_tables(p, off, tp, 8);
    const unsigned* cnt = (const unsigned*)(p.ws + WS_CTL) + CW_CNT;
    const XcdDeal dl = xcd_deal(tp[257] * nct, lds, nb);
    npass = dl.n;
    for (int ps = threadIdx.x; ps < npass; ps += NT) {
        const int u = dl.lo + ps * dl.step;
        const int e = find_expert(tp, u / nct);
        const int nte = tp[e + 1] - tp[e], v = u - tp[e] * nct, ct = v / nte, rtl = v - ct * nte;
        const int rows_e = e < 256 ? (int)cnt[e] : MTOK;
        const int r0 = rtl * 256;
        desc[ps * 4 + 0] = (e < 256 ? off[e] : NK) + r0;
        desc[ps * 4 + 1] = (rows_e - r0) < 256 ? (rows_e - r0) : 256;
        desc[ps * 4 + 2] = e; desc[ps * 4 + 3] = ct;
    }
    __syncthreads();
    return dl.lo;
}

__device__ __forceinline__ void phase10_mfma(const Params& p, int bid, int nb, LAS unsigned char* lds, float* smem) {
    int npass; expert_passes(p, bid, nb, lds, smem, 4, npass);
    const LAS int* desc = (const LAS int*)(lds + EDESC_OFF * 4);
    const unsigned char* H2b = p.ws + WS_H2B; const int* ST = (const int*)(p.ws + WS_SLOTTOK);
    bf16_t* HIDB = (bf16_t*)(p.ws + WS_HIDB);
    const float* W1g = p.in[25]; const float* W3g = p.in[26]; const float* W1s = p.in[28]; const float* W3s = p.in[29];
    const float* SW = (const float*)(p.ws + WS_SLOTW);
    gemm_stream_ws(lds, H2b, npass, 16, 256,
        [&](int ps, int r) { const int slot0 = desc[ps * 4], mr = desc[ps * 4 + 1]; const int rr = r < mr ? r : mr - 1; const int slot = slot0 + rr;
                             const int tok = slot < NK ? ST[slot] : slot - NK; return (size_t)tok * 2048; },
        [&](int ps, int n4) -> const float* { const int e = desc[ps * 4 + 2], hc0 = desc[ps * 4 + 3] * 64; const int n = n4 * 4;
                             const int hc = hc0 + (n >> 6) * 32 + ((n >> 2) & 3) * 8 + ((n >> 4) & 1) * 4;
                             const float* W = ((n >> 5) & 1) ? (e < 256 ? W3g + (size_t)e * 262144 : W3s) : (e < 256 ? W1g + (size_t)e * 262144 : W1s); return W + hc; },
        [&](int ps) { return desc[ps * 4 + 1]; },
        [&](int ps, int rbase, int nbase, int mr, f32x4 (&acc)[8][4]) {
            const int slot0 = desc[ps * 4] + rbase, hc = desc[ps * 4 + 3] * 64 + (nbase >> 6) * 32 + ((nbase >> 2) & 3) * 8;
            float wv[8];
#pragma unroll
            for (int mi = 0; mi < 8; ++mi) { const int slot = slot0 + mi * 16; const float wl = SW[slot < NK ? slot : 0]; wv[mi] = slot < NK ? wl : 1.f; }
#pragma unroll
            for (int mi = 0; mi < 8; ++mi)
#pragma unroll
                for (int ni = 0; ni < 2; ++ni)
#pragma unroll
                    for (int jj = 0; jj < 4; ++jj) { const float a = acc[mi][ni][jj]; acc[mi][ni][jj] = a * __builtin_amdgcn_rcpf(1.f + ex2(-a * LOG2E)) * acc[mi][ni + 2][jj]; }
#pragma unroll
            for (int mi = 0; mi < 8; ++mi) {
                if (rbase + mi * 16 < mr) {
                    const f32x4 h0 = acc[mi][0] * wv[mi], h1 = acc[mi][1] * wv[mi];
                    u32x4 w; w[0] = pk_bf16(h0[0], h0[1]); w[1] = pk_bf16(h0[2], h0[3]); w[2] = pk_bf16(h1[0], h1[1]); w[3] = pk_bf16(h1[2], h1[3]);
                    *(u32x4*)(HIDB + (size_t)(slot0 + mi * 16) * 256 + hc) = w;
                }
            } });
}

__device__ __forceinline__ void phase11_mfma(const Params& p, int bid, int nb, LAS unsigned char* lds, float* smem) {
    int npass; expert_passes(p, bid, nb, lds, smem, 8, npass);
    const LAS int* desc = (const LAS int*)(lds + EDESC_OFF * 4);
    const unsigned char* HIDB = p.ws + WS_HIDB; const float* SW = (const float*)(p.ws + WS_SLOTW);
    bf16_t* SO = (bf16_t*)(p.ws + WS_SLOTOUT);
    const float* W2g = p.in[27]; const float* W2s = p.in[30];
    gemm_stream_ws(lds, HIDB, npass, 4, 1024,
        [&](int ps, int r) { const int slot0 = desc[ps * 4], mr = desc[ps * 4 + 1]; const int rr = r < mr ? r : mr - 1; return (size_t)(slot0 + rr) * 512; },
        [&](int ps, int n4) -> const float* { const int e = desc[ps * 4 + 2], n0 = desc[ps * 4 + 3] * 128; const int src4 = (n4 & ~7) + 2 * (n4 & 3) + ((n4 >> 2) & 1);
                                              return (e < 256 ? W2g + (size_t)e * 262144 : W2s) + n0 + src4 * 4; },
        [&](int ps) { return desc[ps * 4 + 1]; },
        [&](int ps, int rbase, int nbase, int mr, f32x4 (&acc)[8][4]) {
            const int slot0 = desc[ps * 4] + rbase, c0 = desc[ps * 4 + 3] * 128 + (nbase >> 6) * 64 + ((nbase >> 2) & 3) * 8;
#pragma unroll
            for (int mi = 0; mi < 8; ++mi) {
                if (rbase + mi * 16 < mr) {
                    bf16_t* op = SO + (size_t)(slot0 + mi * 16) * 1024 + c0;
#pragma unroll
                    for (int np = 0; np < 2; ++np) {
                        const f32x4 v0 = acc[mi][2 * np], v1 = acc[mi][2 * np + 1];
                        u32x4 o; o[0] = pk_bf16(v0[0], v0[1]); o[1] = pk_bf16(v0[2], v0[3]); o[2] = pk_bf16(v1[0], v1[1]); o[3] = pk_bf16(v1[2], v1[3]);
                        *(u32x4*)(op + np * 32) = o;
                    }
                }
            } });
}

__device__ __forceinline__ void phase12_mfma(const Params& p, int bid, int nb) {
    const bf16_t* X1 = (const bf16_t*)(p.ws + WS_X1); const bf16_t* SO = (const bf16_t*)(p.ws + WS_SLOTOUT); const int* SOF = (const int*)(p.ws + WS_SLOTOF);
    const float* mod = (const float*)(p.ws + WS_MOD); const float* fw = p.in[31];
    int tid_ = threadIdx.x; asm volatile("" : "+v"(tid_));
    const int wave = tid_ >> 6, lane = tid_ & 63;
    const int RS = nb * NW;
    f32x4 wv[4];
#pragma unroll
    for (int i4 = 0; i4 < 4; ++i4) wv[i4] = *(const f32x4*)(fw + lane * 16 + i4 * 4);
    for (int row0 = bid * NW + wave; row0 < MTOK; row0 += 2 * RS) {
        int slots[2];
#pragma unroll
        for (int k = 0; k < 2; ++k) { const int row = row0 + k * RS; const int rc = row < MTOK ? row : row0; slots[k] = lane < 8 ? SOF[rc * 8 + lane] : NK + rc; }
        u32x4 w0[2][9], w1[2][9], xa[2], xb[2];
#pragma unroll
        for (int k = 0; k < 2; ++k) {
            const int row = row0 + k * RS; const int rc = row < MTOK ? row : row0;
#pragma unroll
            for (int q = 0; q < 9; ++q) {
                const int slot = __builtin_amdgcn_readlane(slots[k], q);
                const u32x4* rp = (const u32x4*)(SO + (size_t)slot * 1024 + lane * 16);
                w0[k][q] = rp[0]; w1[k][q] = rp[1];
            }
            const u32x4* xp = (const u32x4*)(X1 + (size_t)rc * 1024 + lane * 16);
            xa[k] = xp[0]; xb[k] = xp[1];
        }
#pragma unroll
        for (int k = 0; k < 2; ++k) {
            const int row = row0 + k * RS;
            if (row < MTOK) {
                const int b = row >> 13;
                float acc[16];
#pragma unroll
                for (int i = 0; i < 16; ++i) acc[i] = 0.f;
#pragma unroll
                for (int q = 0; q < 9; ++q) {
#pragma unroll
                    for (int j = 0; j < 4; ++j) {
                        acc[2 * j] += __uint_as_float(w0[k][q][j] << 16); acc[2 * j + 1] += __uint_as_float(w0[k][q][j] & 0xffff0000u);
                        acc[8 + 2 * j] += __uint_as_float(w1[k][q][j] << 16); acc[8 + 2 * j + 1] += __uint_as_float(w1[k][q][j] & 0xffff0000u);
                    }
                }
                float xv[16];
#pragma unroll
                for (int j = 0; j < 4; ++j) { xv[2 * j] = __uint_as_float(xa[k][j] << 16); xv[2 * j + 1] = __uint_as_float(xa[k][j] & 0xffff0000u);
                                              xv[8 + 2 * j] = __uint_as_float(xb[k][j] << 16); xv[8 + 2 * j + 1] = __uint_as_float(xb[k][j] & 0xffff0000u); }
                float v[16]; float ss = 0.f;
#pragma unroll
                for (int i4 = 0; i4 < 4; ++i4) {
                    const f32x4 gv = *(const f32x4*)(mod + b * 6144 + 5120 + lane * 16 + i4 * 4);
#pragma unroll
                    for (int j = 0; j < 4; ++j) { v[i4 * 4 + j] = xv[i4 * 4 + j] + gv[j] * acc[i4 * 4 + j]; ss += v[i4 * 4 + j] * v[i4 * 4 + j]; }
                }
                ss = wave_sum(ss);
                const float rstd = __builtin_amdgcn_rsqf(ss * (1.f / 1024.f) + 1e-6f);
#pragma unroll
                for (int i4 = 0; i4 < 4; ++i4) {
                    f32x4 o;
#pragma unroll
                    for (int j = 0; j < 4; ++j) o[j] = v[i4 * 4 + j] * rstd * wv[i4][j];
                    *(f32x4*)(p.out + (size_t)row * 1024 + lane * 16 + i4 * 4) = o;
                }
            }
        }
    }
}

__global__ void __launch_bounds__(NT, 2) k_fused(Params p) {
    extern __shared__ __attribute__((aligned(16))) unsigned char lds_raw[];
    LAS unsigned char* lds = (LAS unsigned char*)lds_raw;
    float* smem = (float*)lds_raw;
    if (threadIdx.x == 0) { *(LAS u32x4*)(lds + LDS_MISC) = (u32x4){0u, 0u, 0u, 0u}; }
    __syncthreads();
    XcdBarrier bar = xcd_barrier_post((unsigned*)(p.ws + WS_CTL), (volatile LAS unsigned*)(lds + LDS_MISC));
    if (threadIdx.x == 0) ((LAS int*)(lds + TOPO_OFF))[2] = (int)xb_add((unsigned*)(p.ws + WS_CTL) + CW_RANK + 64 * bar.x, 1u);
    const int bid = blockIdx.x, nb = gridDim.x;
#define PH(stmt) { stmt; xcd_barrier(bar); }
#define PHR(bit, stmt) { stmt; xcd_barrier(bar); if (REP & (bit)) { stmt; xcd_barrier(bar); } }
    PHR(8192, phase0(p, bid, nb, smem, lds))
    if (threadIdx.x == 0) {
        int pre = 0, mine = 0;
        for (unsigned j = 0; j < 16; ++j) { const int c = (int)xb_ld((unsigned*)(p.ws + WS_CTL) + XB_XCNT(j)); if (j < bar.x) pre += c; if (j == bar.x) mine = c; }
        ((LAS int*)(lds + TOPO_OFF))[0] = pre; ((LAS int*)(lds + TOPO_OFF))[1] = mine > 0 ? mine : 1;
    }
    __syncthreads();
    PHR(128, phase_modnorm<false>(p, bid, nb, p.in[0], p.in[4], 0, 1024, (bf16_t*)(p.ws + WS_H1B)))
    PHR(1, phase2_e(p, bid, nb, lds))
    PHR(2, phase3_mfma(p, bid, nb, lds))
    PHR(4, phase3b_new(p, bid, nb, smem))
    PH(phase4_mfma(p.ws, bid, nb, lds))
    PHR(8, phase4b_new(p, bid, nb, smem))
    PHR(512, phase5_e(p, bid, nb, lds))
    PHR(16384, phase_modnorm<true>(p, bid, nb, p.ws + WS_X1, p.in[22], 3072, 4096, (bf16_t*)(p.ws + WS_H2B)))
    PHR(1024, phase7_mfma(p, bid, nb, lds))
    PH(phase8(p, bid, nb, smem))
    PH(phase9(p, bid, nb, smem))
    if (REP & 256) { PH(phase8(p, bid, nb, smem)) PH(phase9(p, bid, nb, smem)) }
    PHR(16, phase10_mfma(p, bid, nb, lds, smem))
    PHR(32, phase11_mfma(p, bid, nb, lds, smem))
    phase12_mfma(p, bid, nb);
    if (REP & 2048) { xcd_barrier(bar); phase12_mfma(p, bid, nb); }
    if (REP & 4096) { for (int i = 0; i < 20; ++i) xcd_barrier(bar); }
#undef PH
#undef PHR
}

extern "C" void kernel_launch(void* const* d_in, const int* in_sizes, int n_in, void* d_out, int out_size, void* d_ws, size_t ws_size, hipStream_t stream) {
    static int grid = 0;
    if (!grid) {
        int dev = 0, cus = 0;
        (void)hipGetDevice(&dev);
        (void)hipDeviceGetAttribute(&cus, hipDeviceAttributeMultiprocessorCount, dev);
        (void)hipFuncSetAttribute((const void*)k_fused, hipFuncAttributeMaxDynamicSharedMemorySize, LDS_BYTES);
        if (cus < 1) cus = 256;
        grid = cus;
    }
    Params p{};
    for (int i = 0; i < 32; ++i) p.in[i] = (const float*)d_in[i];
    p.out = (float*)d_out; p.ws = (unsigned char*)d_ws;
    (void)hipMemsetAsync((char*)d_ws + WS_CTL, 0, CTL_BYTES, stream);
    hipLaunchKernelGGL(k_fused, dim3(grid), dim3(NT), LDS_BYTES, stream, p);
}
```

```cpp
#include <hip/hip_runtime.h>
#include <stdint.h>
#include <type_traits>


#define MTOK 16384
#define SEQ 8192
#define SEQP 8195
#define DM 1024
#define NCOLS 2328
#define COL_KC 512
#define COL_KS 768
#define COL_VS 896
#define COL_KW 1024
#define COL_VW 1152
#define COL_G 1280
#define COL_XR 1304
#define COL_GR 1816
#define NCMP 511
#define NEXP 256
#define NK 131072

#define MiB (1048576ull)
#define WS_CTL 0ull
#define CTL_BYTES (1 * MiB)
#define CW_CNT 8192
#define CW_RANK 12288
#define WS_MOD (1 * MiB)
#define WS_LUT (1 * MiB + 65536)
#define WS_KC (2 * MiB)
#define WS_VC (3 * MiB)
#define WS_AEND (4 * MiB)
#define WS_HEND (5 * MiB)
#define WS_EID (6 * MiB)
#define WS_POS (7 * MiB)
#define WS_WGT (8 * MiB)
#define WS_SLOTTOK (9 * MiB)
#define WS_SLOTW (10 * MiB)
#define WS_CARRY (11 * MiB)
#define WS_SLOTOF (12 * MiB)
#define WS_HIST (13 * MiB)
#define WS_LOGITS (16 * MiB)
#define WS_H1 (32 * MiB)
#define WS_PROJ (96 * MiB)
#define WS_HL (256 * MiB)
#define WS_AP (288 * MiB)
#define WS_ACC (320 * MiB)
#define WS_HID (384 * MiB)
#define WS_Y (528 * MiB)
#define WS_H2 (592 * MiB)
#define WS_X1 (656 * MiB)
#define WS_H1B (720 * MiB)
#define WS_YB (752 * MiB)
#define WS_H2B (784 * MiB)
#define WS_HIDB (816 * MiB)
#define WS_QB (896 * MiB)
#define WS_KV6 (912 * MiB)
#define WS_GATE (936 * MiB)
#define WS_KCB (938 * MiB)
#define WS_VCB (939 * MiB)
#define WS_OATT (940 * MiB)
#define WS_BG (14 * MiB)
#define WS_GBIAS (15 * MiB)
#define WS_CBIAS (15 * MiB + 8192)
#define WS_XRB (972 * MiB)
#define WS_GRG (990 * MiB)
#define WS_CPART (96 * MiB)
#define WS_ALRU (256 * MiB)
#define WS_ULRU (288 * MiB)
#define WS_WINB (1012 * MiB)
#define WS_WOUTB (1017 * MiB)
#define WS_WRB (1020 * MiB)
#define WS_WINT (1012 * MiB)
#define WS_WOUTT (1017 * MiB)
#define WS_WRT (1019 * MiB)
#define WS_SLOTOUT (32 * MiB)

#ifndef REP
#define REP 0
#endif
#ifndef USE_MFMA
#define USE_MFMA 31
#endif

struct Params {
    const float* in[32];
    float* out;
    unsigned char* ws;
};

#define NT 512
#define NW 8
#define LDS_BYTES 151552
#define LDS_MISC 131072
#define INF __builtin_huge_valf()
#define LOG2E 1.4426950408889634f

__device__ __forceinline__ float wave_sum(float v) {
#define WS_DPP(ctrl, rmask) __builtin_bit_cast(float, __builtin_amdgcn_update_dpp(0, __builtin_bit_cast(int, v), (ctrl), (rmask), 0xf, true))
    v += WS_DPP(0x111, 0xf);
    v += WS_DPP(0x112, 0xf);
    v += WS_DPP(0x114, 0xf);
    v += WS_DPP(0x118, 0xf);
    v += WS_DPP(0x142, 0xa);
    v += WS_DPP(0x143, 0xc);
#undef WS_DPP
    return __builtin_bit_cast(float, __builtin_amdgcn_readlane(__builtin_bit_cast(int, v), 63));
}
__device__ __forceinline__ float wave_max(float v) {
#pragma unroll
    for (int o = 32; o; o >>= 1) v = fmaxf(v, __shfl_xor(v, o));
    return v;
}
__device__ __forceinline__ float wave_max_f(float v) {
#define WM_DPP(ctrl, rmask) __builtin_bit_cast(float, __builtin_amdgcn_update_dpp(__builtin_bit_cast(int, -INF), __builtin_bit_cast(int, v), (ctrl), (rmask), 0xf, false))
    v = fmaxf(v, WM_DPP(0x111, 0xf)); v = fmaxf(v, WM_DPP(0x112, 0xf)); v = fmaxf(v, WM_DPP(0x114, 0xf)); v = fmaxf(v, WM_DPP(0x118, 0xf));
    v = fmaxf(v, WM_DPP(0x142, 0xa)); v = fmaxf(v, WM_DPP(0x143, 0xc));
#undef WM_DPP
    return __builtin_bit_cast(float, __builtin_amdgcn_readlane(__builtin_bit_cast(int, v), 63));
}
__device__ __forceinline__ int wave_min_i(int v) {
#define WM_DPP(ctrl, rmask) __builtin_amdgcn_update_dpp(0x7fffffff, v, (ctrl), (rmask), 0xf, false)
    v = min(v, WM_DPP(0x111, 0xf)); v = min(v, WM_DPP(0x112, 0xf)); v = min(v, WM_DPP(0x114, 0xf)); v = min(v, WM_DPP(0x118, 0xf));
    v = min(v, WM_DPP(0x142, 0xa)); v = min(v, WM_DPP(0x143, 0xc));
#undef WM_DPP
    return __builtin_amdgcn_readlane(v, 63);
}
__device__ __forceinline__ float half_top2_sum(float v) {
    float m1 = v, m2 = -INF;
#define T2_STEP(ctrl, rmask) { const float p1 = __builtin_bit_cast(float, __builtin_amdgcn_update_dpp(__builtin_bit_cast(int, -INF), __builtin_bit_cast(int, m1), (ctrl), (rmask), 0xf, false)); \
                               const float p2 = __builtin_bit_cast(float, __builtin_amdgcn_update_dpp(__builtin_bit_cast(int, -INF), __builtin_bit_cast(int, m2), (ctrl), (rmask), 0xf, false)); \
                               const float n2 = fmaxf(fminf(m1, p1), fmaxf(m2, p2)); m1 = fmaxf(m1, p1); m2 = n2; }
    T2_STEP(0x111, 0xf) T2_STEP(0x112, 0xf) T2_STEP(0x114, 0xf) T2_STEP(0x118, 0xf) T2_STEP(0x142, 0xa)
#undef T2_STEP
    return m1 + m2;
}
__device__ __forceinline__ float sigm(float x) { return __builtin_amdgcn_rcpf(1.f + __builtin_amdgcn_exp2f(-1.4426950408889634f * x)); }
__device__ __forceinline__ float tanh_fast(float x) { return 1.f - 2.f * __builtin_amdgcn_rcpf(1.f + __builtin_amdgcn_exp2f(2.8853900817779268f * x)); }
__device__ __forceinline__ float gelu_t(float x) { return 0.5f * x * (1.f + tanh_fast(0.7978845608028654f * (x + 0.044715f * x * x * x))); }
__device__ __forceinline__ float softplus_(float z) { return fmaxf(z, 0.f) + log1pf(expf(-fabsf(z))); }


#define XB_TMO      128
#define XB_XCNT(j)  (256  + 64 * (j))
#define XB_XSUB(j)  (1280 + 64 * (j))
#define XB_XGEN(j)  (2304 + 64 * (j))
#define XB_TOP      3328
#define XB_TOPGEN   3392
#define XCD_BAR_WORDS 3456
#define XB_SPIN_CAP (1u << 18)
#define LAS __attribute__((address_space(3)))

__device__ __forceinline__ unsigned xb_ld(unsigned* p)              { return __hip_atomic_load(p, __ATOMIC_RELAXED, __HIP_MEMORY_SCOPE_AGENT); }
__device__ __forceinline__ unsigned xb_add(unsigned* p, unsigned v) { return __hip_atomic_fetch_add(p, v, __ATOMIC_RELAXED, __HIP_MEMORY_SCOPE_AGENT); }
__device__ __forceinline__ unsigned xb_xcc_id() { return (unsigned)__builtin_amdgcn_s_getreg((3 << 11) | 20) & 0xFu; }
#define XB_SPIN(cond, bar) do { unsigned _sp = 0; while (cond) { __builtin_amdgcn_s_sleep(1); \
    if ((++_sp & 255u) == 0u) { if (xb_ld(&(bar)[XB_TMO])) break; if (_sp > XB_SPIN_CAP) { atomicAdd(&(bar)[XB_TMO], 1u); break; } } } } while (0)

struct XcdBarrier {
    unsigned* bar; unsigned x;
    volatile LAS unsigned* st;
};
__device__ __forceinline__ XcdBarrier xcd_barrier_post(unsigned* bar, volatile LAS unsigned* st) {
    XcdBarrier b; b.bar = bar; b.x = xb_xcc_id(); b.st = st;
    if (threadIdx.x == 0) (void)xb_add(&bar[XB_XCNT(b.x)], 1u);
    return b;
}
__device__ __forceinline__ void xcd_barrier_complete(unsigned* bar, unsigned x, unsigned& nloc, unsigned& nx) {
    const unsigned G = gridDim.x * gridDim.y * gridDim.z;
    unsigned sum, cnt, mine, sp = 0u;
    for (;;) {
        sum = 0u; cnt = 0u; mine = 0u;
#pragma unroll
        for (unsigned j = 0; j < 16; ++j) { const unsigned c = xb_ld(&bar[XB_XCNT(j)]); sum += c; cnt += (c > 0u) ? 1u : 0u; mine = (j == x) ? c : mine; }
        if (sum == G) break;
        __builtin_amdgcn_s_sleep(1);
        if ((++sp & 255u) == 0u) { if (xb_ld(&bar[XB_TMO])) break; if (sp > XB_SPIN_CAP) { atomicAdd(&bar[XB_TMO], 1u); break; } }
    }
    nloc = mine > 0u ? mine : 1u; nx = cnt > 0u ? cnt : 1u;
}
__device__ __forceinline__ void xcd_barrier(const XcdBarrier& b) {
    asm volatile("s_waitcnt vmcnt(0)" ::: "memory");
    __syncthreads();
    if (threadIdx.x == 0) {
        unsigned* bar = b.bar;
        __builtin_amdgcn_s_waitcnt(0);
        unsigned nloc = b.st[0], nx = b.st[1];
        if (nloc == 0u) { xcd_barrier_complete(bar, b.x, nloc, nx); b.st[0] = nloc; b.st[1] = nx; }
        const unsigned old = xb_add(&bar[XB_XSUB(b.x)], 1u);
        const unsigned gen = old / nloc;
        if (old + 1u == (gen + 1u) * nloc) {
            __builtin_amdgcn_fence(__ATOMIC_RELEASE, "agent");
            asm volatile("s_waitcnt vmcnt(0)" ::: "memory");
            const unsigned og = xb_add(&bar[XB_TOP], 1u);
            const unsigned tg = og / nx;
            if (og + 1u == (tg + 1u) * nx) xb_add(&bar[XB_TOPGEN], 1u);
            else XB_SPIN(xb_ld(&bar[XB_TOPGEN]) == tg, bar);
            __builtin_amdgcn_fence(__ATOMIC_ACQUIRE, "agent");
            xb_add(&bar[XB_XGEN(b.x)], 1u);
            asm volatile("s_waitcnt vmcnt(0)" ::: "memory");
        } else {
            XB_SPIN(xb_ld(&bar[XB_XGEN(b.x)]) == gen, bar);
            __builtin_amdgcn_fence(__ATOMIC_ACQUIRE, "agent");
            asm volatile("s_waitcnt vmcnt(0)" ::: "memory");
        }
    }
    __syncthreads();
}

typedef short bf16x8 __attribute__((ext_vector_type(8)));
typedef short s16x4 __attribute__((ext_vector_type(4)));
typedef short v4i16_t __attribute__((ext_vector_type(4)));
typedef float f32x4 __attribute__((ext_vector_type(4)));
typedef float f32x2 __attribute__((ext_vector_type(2)));
typedef __bf16 bf16x2_t __attribute__((ext_vector_type(2)));
typedef unsigned short bf16_t;
typedef unsigned u32x2 __attribute__((ext_vector_type(2)));
typedef unsigned u32x4 __attribute__((ext_vector_type(4)));
__device__ __forceinline__ unsigned pk_bf16(float lo, float hi) { return __builtin_bit_cast(unsigned, __builtin_convertvector((f32x2){lo, hi}, bf16x2_t)); }
__device__ __forceinline__ float bf2f(bf16_t v) { return __uint_as_float(((unsigned)v) << 16); }

__device__ __forceinline__ f32x4 bf4_f32(u32x2 w) { f32x4 r; r[0] = __uint_as_float(w.x << 16); r[1] = __uint_as_float(w.x & 0xffff0000u); r[2] = __uint_as_float(w.y << 16); r[3] = __uint_as_float(w.y & 0xffff0000u); return r; }
__device__ __forceinline__ s16x4 tr_read(LAS unsigned char* pa) { s16x4 r; asm volatile("ds_read_b64_tr_b16 %0, %1" : "=v"(r) : "v"(pa) : "memory"); return r; }
#define TR_WAIT8(a0, a1, a2, a3, a4, a5, a6, a7) asm volatile("s_waitcnt lgkmcnt(0)" : "+v"(a0), "+v"(a1), "+v"(a2), "+v"(a3), "+v"(a4), "+v"(a5), "+v"(a6), "+v"(a7) :: "memory")

#define GEMM_LDS_A 0
#define GEMM_LDS_B 65536
template <bool PAIR, int DEPTH, int MODE = 0, bool TILE_EPI = false, bool BBF16 = false, class ARow, class BCol, class MRows, class Epi>
__device__ __forceinline__ void gemm_stream(LAS unsigned char* lds, const unsigned char* Abase, int npass, int nk, int ldb, ARow arow, BCol bcol, MRows mrowsf, Epi epi) {
    int tid_ = threadIdx.x; asm volatile("" : "+v"(tid_));
    const int tid = tid_, wid = __builtin_amdgcn_readfirstlane(tid >> 6), lane = tid & 63;
    const int wr = wid >> 1, wc = wid & 1, fr = lane & 15, fq = lane >> 4;
    if (npass <= 0) return;
    const int S = npass * nk;
    const int Ccol = ((wid & 1) * 32 + 8 * ((lane & 3) ^ ((lane >> 5) << 1))) * 2;
    const int Rbase = 16 * (wid >> 1) + (lane >> 2);
    unsigned asrc[4];
    const int n4 = tid & 31, kb = tid >> 5;
    typedef typename std::conditional<BBF16, const bf16_t*, const float*>::type bptr_t;
    bptr_t bp;
    const int fB = ((kb & 3) << 2) | ((kb >> 2) & 3);
    const int bwoff = 256 * kb + 16 * ((n4 >> 1) ^ fB) + 8 * (n4 & 1);
    const int aoff = wr * 8192 + ((fr * 64 + fq * 16) ^ ((fr >> 3) << 5));
    const int q = (lane >> 2) & 3, pp = lane & 3;
    const int b0 = (wc * 8 + (pp >> 1)) ^ ((q << 2) | (2 * (fq & 1)));
    const int browoff = 256 * (fq * 8 + q) + 8 * (pp & 1);
#define GS_BOFF(v) (browoff + 16 * (b0 ^ (v)))
    f32x4 acc[4][4];
#pragma unroll
    for (int i = 0; i < 4; ++i)
#pragma unroll
        for (int j = 0; j < 4; ++j) acc[i][j] = (f32x4){0.f, 0.f, 0.f, 0.f};
    float4 bregX[4], bregY[4];
    int aP = 0, aK = 0, bP = 0, bK = 0;
#define GS_SETA() do { _Pragma("unroll") for (int _i = 0; _i < 4; ++_i) asrc[_i] = (unsigned)(arow(aP, Rbase + 64 * _i) + Ccol); } while (0)
#define GS_ISSUE_A(buf) do { _Pragma("unroll") for (int _i = 0; _i < 4; ++_i) \
        __builtin_amdgcn_global_load_lds((const unsigned*)(Abase + (size_t)asrc[_i] + (size_t)aK * 128), (LAS unsigned*)(lds + GEMM_LDS_A + (buf) * 32768 + _i * 8192 + wid * 1024), 16, 0, 0); \
        if (++aK == nk) { aK = 0; ++aP; if (aP < npass) GS_SETA(); } } while (0)
#define GS_LOAD_B(breg) do { _Pragma("unroll") for (int _i = 0; _i < 4; ++_i) { \
            if constexpr (BBF16) { const u32x2 _t = *(const u32x2*)(bp + (size_t)(bK * 64 + kb + 16 * _i) * ldb); breg[_i].x = __uint_as_float(_t.x); breg[_i].y = __uint_as_float(_t.y); } \
            else breg[_i] = *(const float4*)(bp + (size_t)(bK * 64 + kb + 16 * _i) * ldb); } \
        if (++bK == nk) { bK = 0; ++bP; if (bP < npass) bp = bcol(bP, n4); } } while (0)
#define GS_WRITE_B(breg, buf) do { _Pragma("unroll") for (int _i = 0; _i < 4; ++_i) { u32x2 _w; \
            if constexpr (BBF16) { _w.x = __float_as_uint(breg[_i].x); _w.y = __float_as_uint(breg[_i].y); } \
            else { _w.x = pk_bf16(breg[_i].x, breg[_i].y); _w.y = pk_bf16(breg[_i].z, breg[_i].w); } \
        *(LAS u32x2*)(lds + GEMM_LDS_B + (buf) * 16384 + bwoff + 4096 * _i) = _w; } } while (0)
#define GS_COMPUTE(buf) do { _Pragma("unroll") for (int ks = 0; ks < 2; ++ks) { \
            bf16x8 af[4]; s16x4 tl0, tl1, tl2, tl3, th0, th1, th2, th3; \
            LAS unsigned char* bb_ = lds + GEMM_LDS_B + (buf) * 16384 + ks * 8192; \
            tl0 = tr_read(bb_ + GS_BOFF(0)); th0 = tr_read(bb_ + 1024 + GS_BOFF(1)); tl1 = tr_read(bb_ + GS_BOFF(2)); th1 = tr_read(bb_ + 1024 + GS_BOFF(3)); \
            tl2 = tr_read(bb_ + GS_BOFF(4)); th2 = tr_read(bb_ + 1024 + GS_BOFF(5)); tl3 = tr_read(bb_ + GS_BOFF(6)); th3 = tr_read(bb_ + 1024 + GS_BOFF(7)); \
            _Pragma("unroll") for (int mi = 0; mi < 4; ++mi) af[mi] = *(const LAS bf16x8*)(lds + GEMM_LDS_A + (buf) * 32768 + aoff + mi * 2048 + ks * 1024); \
            TR_WAIT8(tl0, th0, tl1, th1, tl2, th2, tl3, th3); \
            bf16x8 bfr[4]; \
            bfr[0] = (bf16x8){tl0[0], tl0[1], tl0[2], tl0[3], th0[0], th0[1], th0[2], th0[3]}; bfr[1] = (bf16x8){tl1[0], tl1[1], tl1[2], tl1[3], th1[0], th1[1], th1[2], th1[3]}; \
            bfr[2] = (bf16x8){tl2[0], tl2[1], tl2[2], tl2[3], th2[0], th2[1], th2[2], th2[3]}; bfr[3] = (bf16x8){tl3[0], tl3[1], tl3[2], tl3[3], th3[0], th3[1], th3[2], th3[3]}; \
            _Pragma("unroll") for (int mi = 0; mi < 4; ++mi) _Pragma("unroll") for (int ni = 0; ni < 4; ++ni) \
                acc[mi][ni] = __builtin_amdgcn_mfma_f32_16x16x32_bf16(bfr[ni], af[mi], acc[mi][ni], 0, 0, 0); } } while (0)
#define GS_STEP(CUR, NXT, BREG_LD, BREG_WR) do { \
        if (MODE != 2 && s + DEPTH < S) GS_LOAD_B(BREG_LD); \
        if (MODE != 3 && s + 1 < S) GS_ISSUE_A(NXT); \
        __builtin_amdgcn_sched_barrier(0); \
        if (MODE != 1 && active) GS_COMPUTE(CUR); \
        __builtin_amdgcn_sched_barrier(0); \
        if (s + 1 < S) GS_WRITE_B(BREG_WR, NXT); \
        const bool pass_end = (cK + 1 == nk); \
        if (++cK == nk) { \
            if constexpr (TILE_EPI) { if (active) epi(cP, wr * 64 + fr, wc * 64 + fq * 4, cm, acc); } else \
            if (active) { \
                _Pragma("unroll") for (int mi = 0; mi < 4; ++mi) { const int r = wr * 64 + mi * 16 + fr; \
                    if (r < cm) { \
                        if constexpr (PAIR) { _Pragma("unroll") for (int ni = 0; ni < 2; ++ni) { epi(cP, r, wc * 64 + ni * 16 + fq * 4, acc[mi][ni], acc[mi][ni + 2]); } } \
                        else { _Pragma("unroll") for (int ni = 0; ni < 4; ++ni) { epi(cP, r, wc * 64 + ni * 16 + fq * 4, acc[mi][ni]); } } } } } \
            _Pragma("unroll") for (int i = 0; i < 4; ++i) _Pragma("unroll") for (int j = 0; j < 4; ++j) acc[i][j] = (f32x4){0.f, 0.f, 0.f, 0.f}; \
            cK = 0; ++cP; if (cP < npass) { cm = mrowsf(cP); active = (wr * 64) < cm; } \
        } \
        asm volatile("s_waitcnt lgkmcnt(0)" ::: "memory"); \
        if (DEPTH >= 2 && (s + DEPTH < S) && !pass_end) asm volatile("s_waitcnt vmcnt(4)" ::: "memory"); else asm volatile("s_waitcnt vmcnt(0)" ::: "memory"); \
        asm volatile("" ::: "memory"); __builtin_amdgcn_s_barrier(); asm volatile("" ::: "memory"); ++s; } while (0)
    int cP = 0, cK = 0, cm = mrowsf(0);
    bool active = (wr * 64) < cm;
    GS_SETA(); bp = bcol(0, n4);
    GS_ISSUE_A(0); GS_LOAD_B(bregX);
    GS_WRITE_B(bregX, 0);
    if constexpr (DEPTH >= 2) { if (1 < S) GS_LOAD_B(bregY); }
    static_assert(DEPTH == 1 || DEPTH == 2, "B prefetch depth");
    asm volatile("s_waitcnt lgkmcnt(0)" ::: "memory");
    asm volatile("s_waitcnt vmcnt(%0)" :: "n"((DEPTH - 1) * 4) : "memory");
    __syncthreads();
    int s = 0;
    if constexpr (DEPTH == 1) {
        while (s < S) { GS_STEP(0, 1, bregX, bregX); if (s >= S) break; GS_STEP(1, 0, bregX, bregX); }
    } else if constexpr (DEPTH == 2) {
        while (s < S) { GS_STEP(0, 1, bregX, bregY); if (s >= S) break; GS_STEP(1, 0, bregY, bregX); }
    }
#undef GS_SETA
#undef GS_BOFF
#undef GS_ISSUE_A
#undef GS_LOAD_B
#undef GS_WRITE_B
#undef GS_COMPUTE
#undef GS_STEP
}


template <class ARow, class BCol, class MRows, class Epi>
__device__ __forceinline__ void gemm_stream_rs(LAS unsigned char* lds, const unsigned char* Abase, int npass, int nk, int ldb, ARow arow, BCol bcol, MRows mrowsf, Epi epi) {
    int tid_ = threadIdx.x; asm volatile("" : "+v"(tid_));
    const int tid = tid_, wid = __builtin_amdgcn_readfirstlane(tid >> 6), lane = tid & 63;
    const int wr = wid >> 1, wc = wid & 1, fr = lane & 15, fq = lane >> 4;
    if (npass <= 0) return;
    const int S = npass * nk;
    const int Ccol = ((wid & 1) * 32 + 8 * ((lane & 3) ^ ((lane >> 5) << 1))) * 2;
    const int Rbase = 16 * (wid >> 1) + (lane >> 2);
    unsigned asrc[4];
    const int n4 = tid & 31, kb = tid >> 5;
    const float* bp;
    const int fB = ((kb & 3) << 2) | ((kb >> 2) & 3);
    const int bwoff = 256 * kb + 16 * ((n4 >> 1) ^ fB) + 8 * (n4 & 1);
    const int awoff = wid * 1024 + lane * 16;
    const int aoff = wr * 8192 + ((fr * 64 + fq * 16) ^ ((fr >> 3) << 5));
    const int q = (lane >> 2) & 3, pp = lane & 3;
    const int b0 = (wc * 8 + (pp >> 1)) ^ ((q << 2) | (2 * (fq & 1)));
    const int browoff = 256 * (fq * 8 + q) + 8 * (pp & 1);
#define RS_BOFF(v) (browoff + 16 * (b0 ^ (v)))
    f32x4 acc[4][4];
#pragma unroll
    for (int i = 0; i < 4; ++i)
#pragma unroll
        for (int j = 0; j < 4; ++j) acc[i][j] = (f32x4){0.f, 0.f, 0.f, 0.f};
    f32x4 bX[4], bY[4]; u32x4 aX[4], aY[4];
    int aP = 0, aK = 0, bP = 0, bK = 0;
#define RS_SETA() do { _Pragma("unroll") for (int _i = 0; _i < 4; ++_i) asrc[_i] = (unsigned)(arow(aP, Rbase + 64 * _i) + Ccol); } while (0)
#define RS_LOAD(AR, BR) do { \
        _Pragma("unroll") for (int _i = 0; _i < 4; ++_i) AR[_i] = *(const u32x4*)(Abase + (size_t)asrc[_i] + (size_t)aK * 128); \
        _Pragma("unroll") for (int _i = 0; _i < 4; ++_i) BR[_i] = *(const f32x4*)(bp + (size_t)(bK * 64 + kb + 16 * _i) * ldb); \
        if (++aK == nk) { aK = 0; if (aP + 1 < npass) { ++aP; RS_SETA(); } } \
        if (++bK == nk) { bK = 0; if (bP + 1 < npass) { ++bP; bp = bcol(bP, n4); } } } while (0)
#define RS_WRITE(AR, BR, buf) do { \
        _Pragma("unroll") for (int _i = 0; _i < 4; ++_i) *(LAS u32x4*)(lds + GEMM_LDS_A + (buf) * 32768 + _i * 8192 + awoff) = AR[_i]; \
        _Pragma("unroll") for (int _i = 0; _i < 4; ++_i) { u32x2 _w; _w.x = pk_bf16(BR[_i][0], BR[_i][1]); _w.y = pk_bf16(BR[_i][2], BR[_i][3]); \
            *(LAS u32x2*)(lds + GEMM_LDS_B + (buf) * 16384 + bwoff + 4096 * _i) = _w; } } while (0)
#define RS_COMPUTE(buf) do { _Pragma("unroll") for (int ks = 0; ks < 2; ++ks) { \
            bf16x8 af[4]; s16x4 tl0, tl1, tl2, tl3, th0, th1, th2, th3; \
            LAS unsigned char* bb_ = lds + GEMM_LDS_B + (buf) * 16384 + ks * 8192; \
            tl0 = tr_read(bb_ + RS_BOFF(0)); th0 = tr_read(bb_ + 1024 + RS_BOFF(1)); tl1 = tr_read(bb_ + RS_BOFF(2)); th1 = tr_read(bb_ + 1024 + RS_BOFF(3)); \
            tl2 = tr_read(bb_ + RS_BOFF(4)); th2 = tr_read(bb_ + 1024 + RS_BOFF(5)); tl3 = tr_read(bb_ + RS_BOFF(6)); th3 = tr_read(bb_ + 1024 + RS_BOFF(7)); \
            _Pragma("unroll") for (int mi = 0; mi < 4; ++mi) af[mi] = *(const LAS bf16x8*)(lds + GEMM_LDS_A + (buf) * 32768 + aoff + mi * 2048 + ks * 1024); \
            TR_WAIT8(tl0, th0, tl1, th1, tl2, th2, tl3, th3); \
            bf16x8 bfr[4]; \
            bfr[0] = (bf16x8){tl0[0], tl0[1], tl0[2], tl0[3], th0[0], th0[1], th0[2], th0[3]}; bfr[1] = (bf16x8){tl1[0], tl1[1], tl1[2], tl1[3], th1[0], th1[1], th1[2], th1[3]}; \
            bfr[2] = (bf16x8){tl2[0], tl2[1], tl2[2], tl2[3], th2[0], th2[1], th2[2], th2[3]}; bfr[3] = (bf16x8){tl3[0], tl3[1], tl3[2], tl3[3], th3[0], th3[1], th3[2], th3[3]}; \
            _Pragma("unroll") for (int mi = 0; mi < 4; ++mi) _Pragma("unroll") for (int ni = 0; ni < 4; ++ni) \
                acc[mi][ni] = __builtin_amdgcn_mfma_f32_16x16x32_bf16(bfr[ni], af[mi], acc[mi][ni], 0, 0, 0); } } while (0)
#define RS_STEP(CUR, NXT, A_LD, B_LD, A_WR, B_WR) do { \
        RS_LOAD(A_LD, B_LD); \
        __builtin_amdgcn_sched_barrier(0); \
        if (active) RS_COMPUTE(CUR); \
        __builtin_amdgcn_sched_barrier(0); \
        RS_WRITE(A_WR, B_WR, NXT); \
        if (++cK == nk) { \
            if (active) epi(cP, wr * 64 + fr, wc * 64 + fq * 4, cm, acc); \
            _Pragma("unroll") for (int i = 0; i < 4; ++i) _Pragma("unroll") for (int j = 0; j < 4; ++j) acc[i][j] = (f32x4){0.f, 0.f, 0.f, 0.f}; \
            cK = 0; ++cP; if (cP < npass) { cm = mrowsf(cP); active = (wr * 64) < cm; } \
        } \
        asm volatile("s_waitcnt lgkmcnt(0)" ::: "memory"); \
        asm volatile("" ::: "memory"); __builtin_amdgcn_s_barrier(); asm volatile("" ::: "memory"); ++s; } while (0)
    int cP = 0, cK = 0, cm = mrowsf(0);
    bool active = (wr * 64) < cm;
    RS_SETA(); bp = bcol(0, n4);
    RS_LOAD(aX, bX); RS_WRITE(aX, bX, 0);
    RS_LOAD(aY, bY);
    asm volatile("s_waitcnt lgkmcnt(0)" ::: "memory");
    __syncthreads();
    int s = 0;
    while (s < S) { RS_STEP(0, 1, aX, bX, aY, bY); if (s >= S) break; RS_STEP(1, 0, aY, bY, aX, bX); }
#undef RS_BOFF
#undef RS_SETA
#undef RS_LOAD
#undef RS_WRITE
#undef RS_COMPUTE
#undef RS_STEP
}

namespace pg8 {
#define PG8_LAS __attribute__((address_space(3)))
typedef unsigned short bf16_t;
typedef short bf16x8 __attribute__((ext_vector_type(8)));
typedef float f32x4 __attribute__((ext_vector_type(4)));
typedef unsigned u32x4 __attribute__((ext_vector_type(4)));
constexpr int BM = 256, BK = 64, HALF = 128, HTB = HALF * BK * 2  , STAGE_BYTES = 8 * HTB, NXCD = 8, WGM = 8;

__host__ __device__ __forceinline__ int lds_byte(int r, int c) { const int st = (r >> 4) * 2 + (c >> 5), rr = r & 15, cc = c & 31, ob = rr * 64 + cc * 2; return st * 1024 + (ob ^ (((ob >> 9) & 1) << 5)); }
__host__ __device__ __forceinline__ void stage_rc(int b, int& R, int& C) { const int st = b / 1024, sb = b % 1024, swz = sb ^ (((sb >> 9) & 1) << 5); R = (st >> 1) * 16 + swz / 64; C = (st & 1) * 32 + (swz % 64) / 2; }
__host__ __device__ __forceinline__ int perm32(int rho) { const int n = rho >> 4, i = rho & 15; return 8 * (i >> 2) + 4 * n + (i & 3); }

struct Unit { int pm, pn; };
struct Gemm { const bf16_t* A; const bf16_t* Bt; int M, N, K; };

struct StaticOrder {
    int nM, nN, nwg, G, c;
    __host__ __device__ void init(int M, int N, int G_, int c_) { nM = M / BM; nN = N / BM; nwg = nM * nN; G = G_; c = c_; }
    __host__ __device__ bool next(int i, Unit& u) const {
        const long L = (long)i * G + c; if (L >= nwg) return false;
        int wgid = (int)L; { const int q = nwg / NXCD, r = nwg % NXCD, xcd = wgid % NXCD, off = wgid / NXCD; wgid = (xcd < r ? xcd * (q + 1) : r * (q + 1) + (xcd - r) * q) + off; }
        const int nig = WGM * nN, gid = wgid / nig, fm = gid * WGM, gsz = (nM - fm) < WGM ? (nM - fm) : WGM;
        u.pm = fm + ((wgid % nig) % gsz); u.pn = (wgid % nig) / gsz; return true;
    }
    __device__ __forceinline__ void a_ready(const Unit&) const {}
    __device__ __forceinline__ void done(const Unit&) const {}
};
template <class Epi, class Sched>
__device__ __forceinline__ void gemm_phase(PG8_LAS unsigned char* lds, const Gemm g, const Sched& S, const Epi& E) {
    int tid_l = threadIdx.x; asm volatile("" : "+v"(tid_l));
    const int tid = tid_l, wid = __builtin_amdgcn_readfirstlane(tid >> 6), lane = tid & 63, wr = wid >> 2, wc = wid & 3, fr = lane & 15, fq = lane >> 4;
    const int K = g.K, nt = K / BK;

    unsigned voffA[2], voffB[2];
#pragma unroll
    for (int i = 0; i < 2; ++i) { int R, C; stage_rc(tid * 16 + i * 8192, R, C); const int Rb = Epi::PERM ? ((R & ~31) + perm32(R & 31)) : R;
        voffA[i] = (unsigned)(R * K + C) * 2u; voffB[i] = (unsigned)(Rb * K + C) * 2u; }
    const size_t kstep = (size_t)(BK * 2);
    const size_t hstep = (size_t)HALF * K * 2;
    const size_t tstep = 2 * hstep;
    const unsigned ldsw = (unsigned)wid * 1024u;
    const int aoff = lds_byte(wr * 64 + fr, fq * 8), boff = lds_byte(wc * 32 + fr, fq * 8);
#define PG8_SA(b, h) (((b) * 2 + (h)) * HTB)
#define PG8_SB(b, h) ((4 + (b) * 2 + (h)) * HTB)
#define PG8_STAGE(bufoff, gbase, voff) do { _Pragma("unroll") for (int _i = 0; _i < 2; ++_i) \
        __builtin_amdgcn_global_load_lds((const unsigned*)((const char*)(gbase) + (voff)[_i]), (PG8_LAS unsigned*)(lds + (bufoff) + ldsw + _i * 8192), 16, 0, 0); } while (0)
#define PG8_LDA(dst, b, h) do { _Pragma("unroll") for (int m = 0; m < 4; ++m) _Pragma("unroll") for (int k = 0; k < 2; ++k) dst[m][k] = *(const PG8_LAS bf16x8*)(lds + PG8_SA(b, h) + aoff + m * 2048 + k * 1024); } while (0)
#define PG8_LDB(dst, b, h) do { _Pragma("unroll") for (int n = 0; n < 2; ++n) _Pragma("unroll") for (int k = 0; k < 2; ++k) dst[n][k] = *(const PG8_LAS bf16x8*)(lds + PG8_SB(b, h) + boff + n * 2048 + k * 1024); } while (0)
#define PG8_MMA(ai, bj, At, Bt) do { __builtin_amdgcn_s_setprio(1); _Pragma("unroll") for (int m = 0; m < 4; ++m) _Pragma("unroll") for (int n = 0; n < 2; ++n) _Pragma("unroll") for (int k = 0; k < 2; ++k) \
        acc[ai][bj][m][n] = __builtin_amdgcn_mfma_f32_16x16x32_bf16(Bt[n][k], At[m][k], acc[ai][bj][m][n], 0, 0, 0); __builtin_amdgcn_s_setprio(0); } while (0)
#define PG8_WAIT_V(n) asm volatile("s_waitcnt vmcnt(" #n ")" ::: "memory")
#define PG8_WAIT_L(n) asm volatile("s_waitcnt lgkmcnt(" #n ")" ::: "memory")
#define PG8_BAR __builtin_amdgcn_s_barrier()
#define PG8_SCHED __builtin_amdgcn_sched_barrier(0)
    Unit cur, nxt; int ui = 0;
    if (!S.next(0, cur)) return;
    f32x4 acc[2][2][4][2];
#pragma unroll
    for (int a = 0; a < 2; ++a)
#pragma unroll
        for (int b = 0; b < 2; ++b)
#pragma unroll
            for (int m = 0; m < 4; ++m)
#pragma unroll
                for (int n = 0; n < 2; ++n) acc[a][b][m][n] = (f32x4){0.f, 0.f, 0.f, 0.f};
    bf16x8 At[4][2], B0[2][2], B1[2][2];
    const char* cA = (const char*)g.A + (size_t)cur.pm * tstep; const char* cB = (const char*)g.Bt + (size_t)cur.pn * tstep;
    S.a_ready(cur);
    PG8_STAGE(PG8_SB(0, 0), cB, voffB); PG8_STAGE(PG8_SA(0, 0), cA, voffA); PG8_STAGE(PG8_SB(0, 1), cB + hstep, voffB); PG8_STAGE(PG8_SA(0, 1), cA + hstep, voffA);
    if (wr == 1) PG8_BAR;
    PG8_WAIT_V(4); PG8_BAR;
    PG8_STAGE(PG8_SB(1, 0), cB + kstep, voffB); PG8_STAGE(PG8_SA(1, 0), cA + kstep, voffA); PG8_STAGE(PG8_SB(1, 1), cB + hstep + kstep, voffB);
    PG8_WAIT_V(6); PG8_BAR;

    for (;;) {
        const bool has_next = S.next(ui + 1, nxt);
        const char* nA = has_next ? (const char*)g.A + (size_t)nxt.pm * tstep : cA; const char* nB = has_next ? (const char*)g.Bt + (size_t)nxt.pn * tstep : cB;
        for (int t = 0; t < nt; t += 2) {
            const bool last = (t == nt - 2);
            const char* a1 = cA + (size_t)(t + 1) * kstep;
            const char* a2 = last ? nA : cA + (size_t)(t + 2) * kstep; const char* b2 = last ? nB : cB + (size_t)(t + 2) * kstep;
            const char* a3 = a2 + kstep; const char* b3 = b2 + kstep;
            if (last && has_next) S.a_ready(nxt);
            PG8_LDB(B0, 0, 0); PG8_SCHED; PG8_LDA(At, 0, 0); PG8_STAGE(PG8_SA(1, 1), a1 + hstep, voffA);
            PG8_WAIT_L(8); PG8_BAR; PG8_WAIT_L(0); PG8_MMA(0, 0, At, B0); PG8_BAR; PG8_SCHED;
            PG8_LDB(B1, 0, 1); PG8_STAGE(PG8_SB(0, 0), b2, voffB);
            PG8_BAR; PG8_WAIT_L(0); PG8_MMA(0, 1, At, B1); PG8_BAR;
            PG8_LDA(At, 0, 1); PG8_STAGE(PG8_SA(0, 0), a2, voffA);
            PG8_BAR; PG8_WAIT_L(0); PG8_MMA(1, 0, At, B0); PG8_BAR; PG8_SCHED;
            PG8_STAGE(PG8_SB(0, 1), b2 + hstep, voffB);
            PG8_WAIT_V(6); PG8_BAR; PG8_MMA(1, 1, At, B1); PG8_BAR;
            PG8_LDB(B0, 1, 0); PG8_SCHED; PG8_LDA(At, 1, 0); PG8_STAGE(PG8_SA(0, 1), a2 + hstep, voffA);
            PG8_WAIT_L(8); PG8_BAR; PG8_WAIT_L(0); PG8_MMA(0, 0, At, B0); PG8_BAR; PG8_SCHED;
            PG8_LDB(B1, 1, 1); PG8_STAGE(PG8_SB(1, 0), b3, voffB);
            PG8_BAR; PG8_WAIT_L(0); PG8_MMA(0, 1, At, B1); PG8_BAR;
            PG8_LDA(At, 1, 1); PG8_STAGE(PG8_SA(1, 0), a3, voffA);
            PG8_BAR; PG8_WAIT_L(0); PG8_MMA(1, 0, At, B0); PG8_BAR; PG8_SCHED;
            PG8_STAGE(PG8_SB(1, 1), b3 + hstep, voffB);
            PG8_WAIT_V(6); PG8_BAR; PG8_MMA(1, 1, At, B1); PG8_BAR;
        }

        if constexpr (!Epi::AFTER_DRAIN) { E(acc, cur, wr, wc, fr, fq); S.done(cur); }

        if (!has_next) break;
#pragma unroll
        for (int a = 0; a < 2; ++a)
#pragma unroll
            for (int b = 0; b < 2; ++b)
#pragma unroll
                for (int m = 0; m < 4; ++m)
#pragma unroll
                    for (int n = 0; n < 2; ++n) acc[a][b][m][n] = (f32x4){0.f, 0.f, 0.f, 0.f};
        cur = nxt; cA = nA; cB = nB; ++ui;
    }
    PG8_WAIT_V(0);
    if (wr == 0) PG8_BAR;
    PG8_BAR;
    if constexpr (Epi::AFTER_DRAIN) { E.fused(acc, cur, wr, wc, fr, fq, lds, wid, lane); S.done(cur); }

#undef PG8_SA
#undef PG8_SB
#undef PG8_STAGE
#undef PG8_LDA
#undef PG8_LDB
#undef PG8_MMA
#undef PG8_WAIT_V
#undef PG8_WAIT_L
#undef PG8_BAR
#undef PG8_SCHED
}
}
template <class F> struct EpiWrap {
    static constexpr bool PERM = false, AFTER_DRAIN = false; F f;
    __device__ __forceinline__ void operator()(const f32x4 (&acc)[2][2][4][2], const pg8::Unit& u, int wr, int wc, int fr, int fq) const { f(acc, u, wr, wc, fr, fq); }
};
template <class F> __device__ __forceinline__ EpiWrap<F> make_epi(F f) { return EpiWrap<F>{f}; }
template <class F> struct EpiWrapP {
    static constexpr bool PERM = true, AFTER_DRAIN = false; F f;
    __device__ __forceinline__ void operator()(const f32x4 (&acc)[2][2][4][2], const pg8::Unit& u, int wr, int wc, int fr, int fq) const { f(acc, u, wr, wc, fr, fq); }
};
template <class F> __device__ __forceinline__ EpiWrapP<F> make_epi_p(F f) { return EpiWrapP<F>{f}; }

__device__ __forceinline__ void transpose_item(const float* W, int K, int N, int Npad, bf16_t* WT, LAS float* scr, int item, int lane) {
    const int nblk = Npad / 32, kb = item / nblk, nb_ = item % nblk, k0 = 64 * kb, n0 = 32 * nb_;
#pragma unroll 8
    for (int i = 0; i < 32; ++i) { const int kk = 2 * i + (lane >> 5), n = n0 + (lane & 31); scr[kk * 33 + (lane & 31)] = n < N ? W[(size_t)(k0 + kk) * N + n] : 0.f; }
    asm volatile("s_waitcnt lgkmcnt(0)" ::: "memory");
    const int c = lane & 7;
#pragma unroll
    for (int j = 0; j < 4; ++j) { const int n = (lane >> 3) + 8 * j; const LAS float* sp = scr + (8 * c) * 33 + n;
        u32x4 o; o[0] = pk_bf16(sp[0 * 33], sp[1 * 33]); o[1] = pk_bf16(sp[2 * 33], sp[3 * 33]); o[2] = pk_bf16(sp[4 * 33], sp[5 * 33]); o[3] = pk_bf16(sp[6 * 33], sp[7 * 33]);
        *(u32x4*)(WT + (size_t)(n0 + n) * K + k0 + 8 * c) = o; }
    asm volatile("s_waitcnt lgkmcnt(0)" ::: "memory");
}

template <class ARow, class BCol, class MRows, class Epi>
__device__ __forceinline__ void gemm_stream_ws(LAS unsigned char* lds, const unsigned char* Abase, int npass, int nk, int ldb, ARow arow, BCol bcol, MRows mrowsf, Epi epi) {
    int tid_ = threadIdx.x; asm volatile("" : "+v"(tid_));
    const int tid = tid_, wid = __builtin_amdgcn_readfirstlane(tid >> 6), lane = tid & 63;
    if (npass <= 0) return;
    const int S = npass * nk;
#define WS_BAR() do { asm volatile("s_waitcnt lgkmcnt(0)" ::: "memory"); __builtin_amdgcn_s_barrier(); asm volatile("" ::: "memory"); } while (0)
    if (wid < 4) {
        const int wr2 = wid >> 1, wc = wid & 1, fr = lane & 15, fq = lane >> 4;
        const int aoff = wr2 * 16384 + ((fr * 64 + fq * 16) ^ ((fr >> 3) << 5));
        const int q = (lane >> 2) & 3, pp = lane & 3;
        const int b0 = (wc * 8 + (pp >> 1)) ^ ((q << 2) | (2 * (fq & 1)));
        const int browoff = 256 * (fq * 8 + q) + 8 * (pp & 1);
#define WS_BOFF(v) (browoff + 16 * (b0 ^ (v)))
        f32x4 acc[8][4];
#pragma unroll
        for (int i = 0; i < 8; ++i)
#pragma unroll
            for (int j = 0; j < 4; ++j) acc[i][j] = (f32x4){0.f, 0.f, 0.f, 0.f};
        int cP = 0, cK = 0, cm = mrowsf(0);
        bool active = (wr2 * 128) < cm;
#define WS_COMPUTE(buf) do { _Pragma("unroll") for (int ks = 0; ks < 2; ++ks) { \
            bf16x8 af[8]; s16x4 tl0, tl1, tl2, tl3, th0, th1, th2, th3; \
            LAS unsigned char* bb_ = lds + GEMM_LDS_B + (buf) * 16384 + ks * 8192; \
            tl0 = tr_read(bb_ + WS_BOFF(0)); th0 = tr_read(bb_ + 1024 + WS_BOFF(1)); tl1 = tr_read(bb_ + WS_BOFF(2)); th1 = tr_read(bb_ + 1024 + WS_BOFF(3)); \
            tl2 = tr_read(bb_ + WS_BOFF(4)); th2 = tr_read(bb_ + 1024 + WS_BOFF(5)); tl3 = tr_read(bb_ + WS_BOFF(6)); th3 = tr_read(bb_ + 1024 + WS_BOFF(7)); \
            _Pragma("unroll") for (int mi = 0; mi < 8; ++mi) af[mi] = *(const LAS bf16x8*)(lds + GEMM_LDS_A + (buf) * 32768 + aoff + mi * 2048 + ks * 1024); \
            TR_WAIT8(tl0, th0, tl1, th1, tl2, th2, tl3, th3); \
            bf16x8 bfr[4]; \
            bfr[0] = (bf16x8){tl0[0], tl0[1], tl0[2], tl0[3], th0[0], th0[1], th0[2], th0[3]}; bfr[1] = (bf16x8){tl1[0], tl1[1], tl1[2], tl1[3], th1[0], th1[1], th1[2], th1[3]}; \
            bfr[2] = (bf16x8){tl2[0], tl2[1], tl2[2], tl2[3], th2[0], th2[1], th2[2], th2[3]}; bfr[3] = (bf16x8){tl3[0], tl3[1], tl3[2], tl3[3], th3[0], th3[1], th3[2], th3[3]}; \
            _Pragma("unroll") for (int mi = 0; mi < 8; ++mi) _Pragma("unroll") for (int ni = 0; ni < 4; ++ni) \
                acc[mi][ni] = __builtin_amdgcn_mfma_f32_16x16x32_bf16(bfr[ni], af[mi], acc[mi][ni], 0, 0, 0); } } while (0)
#define WS_CSTEP(CUR) do { \
            if (active) WS_COMPUTE(CUR); \
            if (++cK == nk) { \
                if (active) epi(cP, wr2 * 128 + fr, wc * 64 + fq * 4, cm, acc); \
                _Pragma("unroll") for (int i = 0; i < 8; ++i) _Pragma("unroll") for (int j = 0; j < 4; ++j) acc[i][j] = (f32x4){0.f, 0.f, 0.f, 0.f}; \
                cK = 0; ++cP; if (cP < npass) { cm = mrowsf(cP); active = (wr2 * 128) < cm; } \
            } \
            WS_BAR(); ++s; } while (0)
        WS_BAR();
        int s = 0;
        while (s < S) { WS_CSTEP(0); if (s >= S) break; WS_CSTEP(1); }
#undef WS_BOFF
#undef WS_COMPUTE
#undef WS_CSTEP
    } else {
        const int pt = tid - 256;
        const int Ccol = (((pt >> 6) & 1) * 32 + 8 * ((lane & 3) ^ ((lane >> 5) << 1))) * 2;
        const int Rbase = 16 * (pt >> 7) + (lane >> 2);
        unsigned asrc[8];
        const int n4 = pt & 31, kb8 = pt >> 5;
        const float* bp;
        int bwoff[2];
#pragma unroll
        for (int par = 0; par < 2; ++par) { const int row = kb8 + 8 * par; const int fB = ((row & 3) << 2) | ((row >> 2) & 3); bwoff[par] = 256 * row + 16 * ((n4 >> 1) ^ fB) + 8 * (n4 & 1); }
        const int awoff = pt * 16;
        f32x4 bX[8], bY[8]; u32x4 aX[8], aY[8];
        int aP = 0, aK = 0, bP = 0, bK = 0;
#define WS_SETA() do { _Pragma("unroll") for (int _i = 0; _i < 8; ++_i) asrc[_i] = (unsigned)(arow(aP, Rbase + 32 * _i) + Ccol); } while (0)
#define WS_LOAD(AR, BR) do { \
            _Pragma("unroll") for (int _i = 0; _i < 8; ++_i) AR[_i] = *(const u32x4*)(Abase + (size_t)asrc[_i] + (size_t)aK * 128); \
            _Pragma("unroll") for (int _i = 0; _i < 8; ++_i) BR[_i] = *(const f32x4*)(bp + (size_t)(bK * 64 + kb8 + 8 * _i) * ldb); \
            if (++aK == nk) { aK = 0; if (aP + 1 < npass) { ++aP; WS_SETA(); } } \
            if (++bK == nk) { bK = 0; if (bP + 1 < npass) { ++bP; bp = bcol(bP, n4); } } } while (0)
#define WS_WRITE(AR, BR, buf) do { \
            _Pragma("unroll") for (int _i = 0; _i < 8; ++_i) *(LAS u32x4*)(lds + GEMM_LDS_A + (buf) * 32768 + _i * 4096 + awoff) = AR[_i]; \
            _Pragma("unroll") for (int _i = 0; _i < 8; ++_i) { u32x2 _w; _w.x = pk_bf16(BR[_i][0], BR[_i][1]); _w.y = pk_bf16(BR[_i][2], BR[_i][3]); \
                *(LAS u32x2*)(lds + GEMM_LDS_B + (buf) * 16384 + bwoff[_i & 1] + 4096 * (_i >> 1)) = _w; } } while (0)
#define WS_PSTEP(NXT, A_LD, B_LD, A_WR, B_WR) do { WS_LOAD(A_LD, B_LD); WS_WRITE(A_WR, B_WR, NXT); WS_BAR(); ++s; } while (0)
        WS_SETA(); bp = bcol(0, n4);
        WS_LOAD(aX, bX); WS_WRITE(aX, bX, 0);
        WS_LOAD(aY, bY);
        WS_BAR();
        int s = 0;
        while (s < S) { WS_PSTEP(1, aX, bX, aY, bY); if (s >= S) break; WS_PSTEP(0, aY, bY, aX, bX); }
#undef WS_SETA
#undef WS_LOAD
#undef WS_WRITE
#undef WS_PSTEP
    }
#undef WS_BAR
}

struct XcdDeal { int lo, step, n; };
#define TOPO_OFF (LDS_MISC + 16)
__device__ __forceinline__ XcdDeal xcd_deal(int U, const LAS unsigned char* lds, int nb) {
    const LAS int* tp_ = (const LAS int*)(lds + TOPO_OFF);
    const int px = tp_[0], cx = tp_[1], rank = tp_[2];
    XcdDeal d;
    const int xlo = (int)((long)px * U / nb), xhi = (int)((long)(px + cx) * U / nb);
    d.lo = xlo + rank; d.step = cx; d.n = (xhi - xlo - rank + cx - 1) / cx; if (d.n < 0) d.n = 0;
    return d;
}

__device__ __forceinline__ void phase0(const Params& p, int bid, int nb, float* smem, LAS unsigned char* smem_las) {
    const float* c = p.in[1]; const float* w_ada = p.in[2]; const float* b_ada = p.in[3];
    float* mod = (float*)(p.ws + WS_MOD);
    const int tid = threadIdx.x;
    float* sc = smem;
    float* red = smem + 2048;
    for (int i = tid; i < 2048; i += NT) { const float cv = c[i]; sc[i] = cv / (1.f + expf(-cv)); }
    __syncthreads();
    {
        const int cq = tid & 7, kg = tid >> 3;
        for (int u = bid; u < 192; u += nb) {
            const float* wp = w_ada + (size_t)(kg * 16) * 6144 + u * 32 + cq * 4;
            f32x4 wv[16];
#pragma unroll
            for (int i = 0; i < 16; ++i) wv[i] = *(const f32x4*)(wp + (size_t)i * 6144);
            f32x4 a0 = (f32x4){0.f, 0.f, 0.f, 0.f}, a1 = (f32x4){0.f, 0.f, 0.f, 0.f};
#pragma unroll
            for (int i = 0; i < 16; ++i) { a0 += sc[kg * 16 + i] * wv[i]; a1 += sc[1024 + kg * 16 + i] * wv[i]; }
            *(f32x4*)(red + (kg * 2 + 0) * 32 + cq * 4) = a0; *(f32x4*)(red + (kg * 2 + 1) * 32 + cq * 4) = a1;
            __syncthreads();
            if (tid < 64) {
                const int bb = tid >> 5, col = tid & 31; float sacc = 0.f;
#pragma unroll 16
                for (int g2 = 0; g2 < 64; ++g2) sacc += red[(g2 * 2 + bb) * 32 + col];
                mod[bb * 6144 + u * 32 + col] = sacc + b_ada[u * 32 + col];
            }
            __syncthreads();
        }
    }
    {
        const float* conv_w = p.in[12]; const float* conv_b = p.in[13]; const float* wa = p.in[14]; const float* ba = p.in[15]; const float* wx = p.in[16]; const float* bx = p.in[17];
        float* BG = (float*)(p.ws + WS_BG); float* GB = (float*)(p.ws + WS_GBIAS);
        for (int idx = bid * NT + tid; idx < 8 * 256 * 128; idx += nb * NT) {
            const int n = idx & 127, k = (idx >> 7) & 255, hb = idx >> 15;
            const int w = k >> 6, i = k & 63, j = (n >> 6) * 32 + ((n >> 2) & 3) * 8 + ((n >> 4) & 1) * 4 + (n & 3);
            const float* W = ((n >> 5) & 1) ? wx : wa;
            BG[idx] = conv_w[w * 512 + hb * 64 + i] * W[(hb * 64 + i) * 64 + j];
        }
        for (int idx = ((bid + nb - (208 % nb)) % nb) * NT + tid; idx < 8 * 128; idx += nb * NT) {
            const int n = idx & 127, hb = idx >> 7, j = (n >> 6) * 32 + ((n >> 2) & 3) * 8 + ((n >> 4) & 1) * 4 + (n & 3);
            const bool isx = (n >> 5) & 1; const float* W = isx ? wx : wa;
            float acc = isx ? bx[hb * 64 + j] : ba[hb * 64 + j];
            for (int i = 0; i < 64; ++i) acc += conv_b[hb * 64 + i] * W[(hb * 64 + i) * 64 + j];
            GB[idx] = acc;
        }
        float* CB = (float*)(p.ws + WS_CBIAS); const float* pos = p.in[6];
        for (int idx = ((bid + nb - (192 % nb)) % nb) * NW + (tid >> 6); idx < 128; idx += nb * NW) {
            const int kv = idx >> 6, j = idx & 63; const float* w1 = kv ? p.in[9] : p.in[7];
            float acc = 0.f;
#pragma unroll 16
            for (int k = (tid & 63); k < 2048; k += 64) acc += pos[k] * w1[(size_t)k * 64 + j];
            acc = wave_sum(acc);
            if ((tid & 63) == 0) CB[idx] = acc;
        }
        bf16_t* XRB = (bf16_t*)(p.ws + WS_XRB);
        for (int idx = bid * NT + tid; idx < 16 * 3 * 64; idx += nb * NT) { const int sq = idx / 192, rem = idx % 192; XRB[(size_t)sq * SEQP * 64 + rem] = 0; }
    }
    {
        const f32x4* sp = (const f32x4*)p.in[23]; u32x2* dp = (u32x2*)(p.ws + WS_WRB);
        for (int i = bid * NT + tid; i < 1024 * 256 / 4; i += nb * NT) { const f32x4 v = sp[i]; u32x2 w; w.x = pk_bf16(v[0], v[1]); w.y = pk_bf16(v[2], v[3]); dp[i] = w; }
    }
    {
        LAS float* scr = (LAS float*)((LAS unsigned char*)smem_las + 16384 + (tid >> 6) * 8704);
        const int gw = bid * NW + (tid >> 6), ngw = nb * NW, lane_ = tid & 63;
        const int I1 = 16 * 80, I2 = 16 * 32;
        for (int it = gw; it < I1 + I2; it += ngw) {
            if (it < I1) transpose_item(p.in[5], 1024, NCOLS, 2560, (bf16_t*)(p.ws + WS_WINT), scr, it, lane_);
            else transpose_item(p.in[21], 1024, 1024, 1024, (bf16_t*)(p.ws + WS_WOUTT), scr, it - I1, lane_);
        }
    }
    float* lut = (float*)(p.ws + WS_LUT); const float* rel = p.in[11];
    for (int idx = bid * NT + tid; idx < 8 * 1024; idx += nb * NT) {
        const int h = idx >> 10, d = idx & 1023;
        int bucket;
        if (d < 16) bucket = d;
        else { const int l = 16 + (int)(logf((float)d / 16.0f) / 4.1588830833596715f * 16.0f); bucket = l < 31 ? l : 31; }
        lut[idx] = rel[bucket * 8 + h];
    }
}

template <bool SRC_BF16>
__device__ __forceinline__ void phase_modnorm(const Params& p, int bid, int nb, const void* src_, const float* nw, int sh_off, int sc_off, bf16_t* dstb) {
    const float* mod = (const float*)(p.ws + WS_MOD);
    int tid_ = threadIdx.x; asm volatile("" : "+v"(tid_));
    const int wave = tid_ >> 6, lane = tid_ & 63;
    const int RS = nb * NW;
    f32x4 w4[4];
#pragma unroll
    for (int i = 0; i < 4; ++i) w4[i] = *(const f32x4*)(nw + lane * 16 + 4 * i);
    for (int row0 = bid * NW + wave; row0 < MTOK; row0 += 4 * RS) {
        f32x4 v[4][4];
#pragma unroll
        for (int k = 0; k < 4; ++k) {
            const int row = row0 + k * RS; const int rc = row < MTOK ? row : row0;
            if constexpr (SRC_BF16) {
                const u32x4* xr = (const u32x4*)((const bf16_t*)src_ + (size_t)rc * 1024 + lane * 16);
                const u32x4 r0 = xr[0], r1 = xr[1];
#pragma unroll
                for (int j = 0; j < 4; ++j) { v[k][j >> 1][(j & 1) * 2] = __uint_as_float(r0[j] << 16); v[k][j >> 1][(j & 1) * 2 + 1] = __uint_as_float(r0[j] & 0xffff0000u);
                                              v[k][2 + (j >> 1)][(j & 1) * 2] = __uint_as_float(r1[j] << 16); v[k][2 + (j >> 1)][(j & 1) * 2 + 1] = __uint_as_float(r1[j] & 0xffff0000u); }
            } else {
                const float* xr = (const float*)src_ + (size_t)rc * 1024 + lane * 16;
#pragma unroll
                for (int i = 0; i < 4; ++i) v[k][i] = *(const f32x4*)(xr + 4 * i);
            }
        }
#pragma unroll
        for (int k = 0; k < 4; ++k) {
            const int row = row0 + k * RS;
            if (row < MTOK) {
                const int b = row >> 13;
                float ss = 0.f;
#pragma unroll
                for (int i = 0; i < 4; ++i) ss += (v[k][i][0] * v[k][i][0] + v[k][i][1] * v[k][i][1]) + (v[k][i][2] * v[k][i][2] + v[k][i][3] * v[k][i][3]);
                ss = wave_sum(ss);
                const float rstd = __builtin_amdgcn_rsqf(ss * (1.f / 1024.f) + 1e-6f);
                u32x4 o[2];
#pragma unroll
                for (int i = 0; i < 4; ++i) {
                    const int ci = lane * 16 + 4 * i;
                    const f32x4 sh = *(const f32x4*)(mod + b * 6144 + sh_off + ci), sc = *(const f32x4*)(mod + b * 6144 + sc_off + ci);
                    f32x4 h;
#pragma unroll
                    for (int j = 0; j < 4; ++j) h[j] = v[k][i][j] * rstd * w4[i][j] * (1.f + sc[j]) + sh[j];
                    o[i >> 1][(i & 1) * 2 + 0] = pk_bf16(h[0], h[1]); o[i >> 1][(i & 1) * 2 + 1] = pk_bf16(h[2], h[3]);
                }
                *(u32x4*)(dstb + (size_t)row * 1024 + lane * 16) = o[0];
                *(u32x4*)(dstb + (size_t)row * 1024 + lane * 16 + 8) = o[1];
            }
        }
    }
}

__device__ __forceinline__ void phase2_e(const Params& p, int bid, int nb, LAS unsigned char* lds) {
    bf16_t* QB = (bf16_t*)(p.ws + WS_QB); bf16_t* KV6 = (bf16_t*)(p.ws + WS_KV6); float* GATE = (float*)(p.ws + WS_GATE);
    bf16_t* XRB = (bf16_t*)(p.ws + WS_XRB); bf16_t* GRG = (bf16_t*)(p.ws + WS_GRG);
    pg8::Gemm g{(const pg8::bf16_t*)(p.ws + WS_H1B), (const pg8::bf16_t*)(p.ws + WS_WINT), MTOK, 2560, 1024};
    pg8::StaticOrder S; S.init(MTOK, 2560, nb, bid);
    auto E = make_epi_p([=](const f32x4 (&acc)[2][2][4][2], const pg8::Unit& u, int wr, int wc, int fr, int fq) {
#pragma unroll
        for (int ai = 0; ai < 2; ++ai)
#pragma unroll
            for (int mm = 0; mm < 4; ++mm) {
                const int m = u.pm * 256 + ai * 128 + wr * 64 + mm * 16 + fr;
#pragma unroll
                for (int bj = 0; bj < 2; ++bj) {
                    const int col = u.pn * 256 + bj * 128 + wc * 32 + fq * 8;
                    const f32x4 v0 = acc[ai][bj][mm][0], v1 = acc[ai][bj][mm][1];
                    if (col >= NCOLS) continue;
                    if (col < 512) {
                        const float sc = 0.125f * LOG2E; u32x4 w; w[0] = pk_bf16(v0[0] * sc, v0[1] * sc); w[1] = pk_bf16(v0[2] * sc, v0[3] * sc); w[2] = pk_bf16(v1[0] * sc, v1[1] * sc); w[3] = pk_bf16(v1[2] * sc, v1[3] * sc);
                        *(u32x4*)(QB + (size_t)m * 512 + col) = w;
                    } else if (col >= 1280 && col < 1304) {
                        f32x4 g0, g1;
#pragma unroll
                        for (int j = 0; j < 4; ++j) { g0[j] = sigm(v0[j]); g1[j] = sigm(v1[j]); }
                        *(f32x4*)(GATE + (size_t)m * 24 + (col - 1280)) = g0; *(f32x4*)(GATE + (size_t)m * 24 + (col - 1280) + 4) = g1;
                    } else if (col < 1280) {
                        const int c2 = col - 512, j6 = c2 >> 7, gg = (c2 >> 6) & 1, d = c2 & 63, bb = m >> 13, t = m & 8191;
                        u32x4 w; w[0] = pk_bf16(v0[0], v0[1]); w[1] = pk_bf16(v0[2], v0[3]); w[2] = pk_bf16(v1[0], v1[1]); w[3] = pk_bf16(v1[2], v1[3]);
                        *(u32x4*)(KV6 + (size_t)j6 * 2097152 + ((size_t)((bb * 2 + gg) * SEQ + t)) * 64 + d) = w;
                    } else if (col < 1816) {
                        const int c = col - 1304, hb = c >> 6, bb = m >> 13, t = m & 8191;
                        u32x4 w; w[0] = pk_bf16(v0[0], v0[1]); w[1] = pk_bf16(v0[2], v0[3]); w[2] = pk_bf16(v1[0], v1[1]); w[3] = pk_bf16(v1[2], v1[3]);
                        *(u32x4*)(XRB + ((size_t)(bb * 8 + hb) * SEQP + 3 + t) * 64 + (c & 63)) = w;
                    } else {
                        u32x4 w; w[0] = pk_bf16(gelu_t(v0[0]), gelu_t(v0[1])); w[1] = pk_bf16(gelu_t(v0[2]), gelu_t(v0[3])); w[2] = pk_bf16(gelu_t(v1[0]), gelu_t(v1[1])); w[3] = pk_bf16(gelu_t(v1[2]), gelu_t(v1[3]));
                        *(u32x4*)(GRG + (size_t)m * 512 + (col - 1816)) = w;
                    }
                }
            }
    });
    pg8::gemm_phase(lds, g, S, E);
}

__device__ __forceinline__ void phase5_e(const Params& p, int bid, int nb, LAS unsigned char* lds) {
    const float* x = p.in[0]; const float* mod = (const float*)(p.ws + WS_MOD); bf16_t* X1 = (bf16_t*)(p.ws + WS_X1);
    pg8::Gemm g{(const pg8::bf16_t*)(p.ws + WS_YB), (const pg8::bf16_t*)(p.ws + WS_WOUTT), MTOK, 1024, 1024};
    pg8::StaticOrder S; S.init(MTOK, 1024, nb, bid);
    auto E = make_epi_p([=](const f32x4 (&acc)[2][2][4][2], const pg8::Unit& u, int wr, int wc, int fr, int fq) {
        const int c0 = u.pn * 256 + wc * 32 + fq * 8;
        const int bb = (u.pm * 256) >> 13;
        f32x4 gv[2][2];
#pragma unroll
        for (int bj = 0; bj < 2; ++bj)
#pragma unroll
            for (int nn = 0; nn < 2; ++nn) gv[bj][nn] = *(const f32x4*)(mod + bb * 6144 + 2048 + c0 + bj * 128 + nn * 4);
#pragma unroll
        for (int ai = 0; ai < 2; ++ai)
#pragma unroll
            for (int mm = 0; mm < 4; ++mm) {
                const size_t o = (size_t)(u.pm * 256 + ai * 128 + wr * 64 + mm * 16 + fr) * 1024 + c0;
                f32x4 xv[2][2];
#pragma unroll
                for (int bj = 0; bj < 2; ++bj)
#pragma unroll
                    for (int nn = 0; nn < 2; ++nn) xv[bj][nn] = *(const f32x4*)(x + o + bj * 128 + nn * 4);
#pragma unroll
                for (int bj = 0; bj < 2; ++bj) {
                    const f32x4 r0 = xv[bj][0] + gv[bj][0] * acc[ai][bj][mm][0], r1 = xv[bj][1] + gv[bj][1] * acc[ai][bj][mm][1];
                    u32x4 w; w[0] = pk_bf16(r0[0], r0[1]); w[1] = pk_bf16(r0[2], r0[3]); w[2] = pk_bf16(r1[0], r1[1]); w[3] = pk_bf16(r1[2], r1[3]);
                    *(u32x4*)(X1 + o + bj * 128) = w;
                }
            }
    });
    pg8::gemm_phase(lds, g, S, E);
}

#ifndef A4_PROBE_MASK
#define A4_PROBE_MASK 7
#endif
#define A4_KV 0
#define A4_SCORE 65536
#define A4_LUT 131200
#define LUTP 1156
#define A4_SELM 149760
__device__ __forceinline__ float ex2(float x) { return __builtin_amdgcn_exp2f(x); }

__device__ __forceinline__ float xmax_16_32(float v) {
    { auto r = __builtin_amdgcn_permlane16_swap(__float_as_uint(v), __float_as_uint(v), false, false); v = fmaxf(__uint_as_float(r[0]), __uint_as_float(r[1])); }
    { auto r = __builtin_amdgcn_permlane32_swap(__float_as_uint(v), __float_as_uint(v), false, false); v = fmaxf(__uint_as_float(r[0]), __uint_as_float(r[1])); }
    return v;
}
__device__ __forceinline__ float xsum_16_32(float v) {
    { auto r = __builtin_amdgcn_permlane16_swap(__float_as_uint(v), __float_as_uint(v), false, false); v = __uint_as_float(r[0]) + __uint_as_float(r[1]); }
    { auto r = __builtin_amdgcn_permlane32_swap(__float_as_uint(v), __float_as_uint(v), false, false); v = __uint_as_float(r[0]) + __uint_as_float(r[1]); }
    return v;
}


__device__ __forceinline__ void phase4_mfma(unsigned char* ws, int bid, int nb, LAS unsigned char* lds) {
    int tid_ = threadIdx.x; asm volatile("" : "+v"(tid_));
    const int tid = tid_, wid = __builtin_amdgcn_readfirstlane(tid >> 6), lane = tid & 63;
    const int col = lane & 15, tl = col >> 2, hd = col & 3, g4 = lane >> 4, fr = col;
    const bf16_t* QB = (const bf16_t*)(ws + WS_QB);
    const unsigned char* KV6 = ws + WS_KV6;
    const unsigned char* KCB = ws + WS_KCB; const unsigned char* VCB = ws + WS_VCB;
    const float* lutg = (const float*)(ws + WS_LUT);
    const float* GATE = (const float*)(ws + WS_GATE);
    float* OATT = (float*)(ws + WS_OATT);
    LAS float* lutl = (LAS float*)(lds + A4_LUT);
    LAS float* score = (LAS float*)(lds + A4_SCORE);
    LAS unsigned* selm = (LAS unsigned*)(lds + A4_SELM);
    const int koff0 = fr * 128 + 16 * ((g4) ^ (fr & 7)), koff1 = fr * 128 + 16 * ((4 + g4) ^ (fr & 7));
    const int q4 = (lane >> 2) & 3, pp = lane & 3, xk = (g4 & 1) * 4 + q4;
    int voff[4];
#pragma unroll
    for (int db = 0; db < 4; ++db) voff[db] = (g4 * 4 + q4) * 128 + 16 * ((db * 2 + (pp >> 1)) ^ xk) + 8 * (pp & 1);
    const int dr = tid >> 3, dsrc = dr * 128 + (((tid & 7) ^ (dr & 7)) * 16);

#define A4_ISSUE(kbase, vbase, stage) do { \
        __builtin_amdgcn_global_load_lds((const unsigned*)((kbase) + dsrc), (LAS unsigned*)(lds + A4_KV + (stage) * 16384 + wid * 1024), 16, 0, 0); \
        if (vbase) __builtin_amdgcn_global_load_lds((const unsigned*)((vbase) + dsrc), (LAS unsigned*)(lds + A4_KV + (stage) * 16384 + 8192 + wid * 1024), 16, 0, 0); } while (0)
#define A4_SYNC() do { asm volatile("s_waitcnt vmcnt(0)" ::: "memory"); __syncthreads(); } while (0)
#define A4_SYNC_RING(issued) do { asm volatile("s_waitcnt lgkmcnt(0)" ::: "memory"); if (issued) asm volatile("s_waitcnt vmcnt(2)" ::: "memory"); else asm volatile("s_waitcnt vmcnt(0)" ::: "memory"); \
        asm volatile("" ::: "memory"); __builtin_amdgcn_s_barrier(); asm volatile("" ::: "memory"); } while (0)

    for (int u2 = bid; u2 < 256; u2 += nb)
    for (int hf = 0; hf < 2; ++hf)
    for (int rep4 = 0; rep4 < ((REP & 64) ? 2 : 1); ++rep4) {
        const bool probe = rep4 > 0; const int amask = probe ? A4_PROBE_MASK : 7;
        const int bg = u2 >> 6, b = bg >> 1, g = bg & 1;
        const int T = hf ? 127 - (u2 & 63) : (u2 & 63);
        const int t0 = T * 64;
        const size_t seqbase = (size_t)(b * 2 + g) * SEQ;
        __syncthreads();
        for (int i = tid; i < 4 * 1152; i += NT) { const int hh = i / 1152, dd = i - hh * 1152; lutl[hh * LUTP + dd] = lutg[(g * 4 + hh) * 1024 + (dd < 1023 ? dd : 1023)] * LOG2E; }
        if (!probe) for (int i = tid; i < 8192; i += NT) score[i] = 0.f;
        int tq[2]; tq[0] = t0 + 8 * wid + tl; tq[1] = tq[0] + 4;
        bf16x8 qf[2][2];
#pragma unroll
        for (int ct = 0; ct < 2; ++ct) {
            const size_t m = (size_t)b * SEQ + tq[ct];
#pragma unroll
            for (int h2 = 0; h2 < 2; ++h2) qf[ct][h2] = *(const bf16x8*)(QB + m * 512 + (g * 4 + hd) * 64 + h2 * 32 + g4 * 8);
        }
#define A4_GATEV(ct, br) (GATE[((size_t)b * SEQ + tq[ct]) * 24 + (g * 4 + hd) * 3 + (br)])
        __syncthreads();

        float mrun[2], lrun[2];
        f32x4 O[2][4];
        bf16x8 kf[4][2];
        f32x4 sv[4];
#define A4_LOADK(stage) do { _Pragma("unroll") for (int kt = 0; kt < 4; ++kt) { \
            kf[kt][0] = *(const LAS bf16x8*)(lds + A4_KV + (stage) * 16384 + kt * 2048 + koff0); \
            kf[kt][1] = *(const LAS bf16x8*)(lds + A4_KV + (stage) * 16384 + kt * 2048 + koff1); } } while (0)
#define A4_SCORES(ct) do { _Pragma("unroll") for (int kt = 0; kt < 4; ++kt) { \
            sv[kt] = __builtin_amdgcn_mfma_f32_16x16x32_bf16(kf[kt][0], qf[ct][0], (f32x4){0.f, 0.f, 0.f, 0.f}, 0, 0, 0); \
            sv[kt] = __builtin_amdgcn_mfma_f32_16x16x32_bf16(kf[kt][1], qf[ct][1], sv[kt], 0, 0, 0); } } while (0)
#define A4_VREADS(stage, a, l0, h0, l1, h1, l2, h2, l3, h3) do { \
            LAS unsigned char* vb_ = lds + A4_KV + (stage) * 16384 + 8192 + (a) * 4096; \
            l0 = tr_read(vb_ + voff[0]); h0 = tr_read(vb_ + 2048 + voff[0]); l1 = tr_read(vb_ + voff[1]); h1 = tr_read(vb_ + 2048 + voff[1]); \
            l2 = tr_read(vb_ + voff[2]); h2 = tr_read(vb_ + 2048 + voff[2]); l3 = tr_read(vb_ + voff[3]); h3 = tr_read(vb_ + 2048 + voff[3]); } while (0)
#define A4_PVMMA(ct, a, l0, h0, l1, h1, l2, h2, l3, h3) do { \
            u32x4 pw; pw[0] = pk_bf16(sv[2 * (a)][0], sv[2 * (a)][1]); pw[1] = pk_bf16(sv[2 * (a)][2], sv[2 * (a)][3]); \
            pw[2] = pk_bf16(sv[2 * (a) + 1][0], sv[2 * (a) + 1][1]); pw[3] = pk_bf16(sv[2 * (a) + 1][2], sv[2 * (a) + 1][3]); \
            const bf16x8 pf = __builtin_bit_cast(bf16x8, pw); \
            O[ct][0] = __builtin_amdgcn_mfma_f32_16x16x32_bf16((bf16x8){l0[0], l0[1], l0[2], l0[3], h0[0], h0[1], h0[2], h0[3]}, pf, O[ct][0], 0, 0, 0); \
            O[ct][1] = __builtin_amdgcn_mfma_f32_16x16x32_bf16((bf16x8){l1[0], l1[1], l1[2], l1[3], h1[0], h1[1], h1[2], h1[3]}, pf, O[ct][1], 0, 0, 0); \
            O[ct][2] = __builtin_amdgcn_mfma_f32_16x16x32_bf16((bf16x8){l2[0], l2[1], l2[2], l2[3], h2[0], h2[1], h2[2], h2[3]}, pf, O[ct][2], 0, 0, 0); \
            O[ct][3] = __builtin_amdgcn_mfma_f32_16x16x32_bf16((bf16x8){l3[0], l3[1], l3[2], l3[3], h3[0], h3[1], h3[2], h3[3]}, pf, O[ct][3], 0, 0, 0); } while (0)
#define A4_ONLINE_PV(ct, stage) do { \
            s16x4 va0, va1, va2, va3, va4, va5, va6, va7; \
            A4_VREADS(stage, 0, va0, va1, va2, va3, va4, va5, va6, va7); \
            float mx = fmaxf(fmaxf(sv[0][0], sv[0][1]), fmaxf(sv[0][2], sv[0][3])); \
            _Pragma("unroll") for (int kt = 1; kt < 4; ++kt) _Pragma("unroll") for (int j = 0; j < 4; ++j) mx = fmaxf(mx, sv[kt][j]); \
            mx = xmax_16_32(mx); \
            const float mnew = fmaxf(mrun[ct], mx); const float muse = (mnew == -INF) ? 0.f : mnew; \
            const float scl = ex2(mrun[ct] - muse); mrun[ct] = mnew; \
            const float nmu = -muse; \
            _Pragma("unroll") for (int kt = 0; kt < 4; ++kt) { sv[kt] += nmu; _Pragma("unroll") for (int j = 0; j < 4; ++j) sv[kt][j] = ex2(sv[kt][j]); } \
            const f32x4 ls4 = (sv[0] + sv[1]) + (sv[2] + sv[3]); const float ls = (ls4[0] + ls4[1]) + (ls4[2] + ls4[3]); \
            lrun[ct] = lrun[ct] * scl + ls; \
            if (__builtin_amdgcn_ballot_w64(scl != 1.f) != 0ull) { _Pragma("unroll") for (int db = 0; db < 4; ++db) O[ct][db] *= scl; } \
            TR_WAIT8(va0, va1, va2, va3, va4, va5, va6, va7); \
            s16x4 vb0, vb1, vb2, vb3, vb4, vb5, vb6, vb7; \
            A4_VREADS(stage, 1, vb0, vb1, vb2, vb3, vb4, vb5, vb6, vb7); \
            A4_PVMMA(ct, 0, va0, va1, va2, va3, va4, va5, va6, va7); \
            TR_WAIT8(vb0, vb1, vb2, vb3, vb4, vb5, vb6, vb7); \
            A4_PVMMA(ct, 1, vb0, vb1, vb2, vb3, vb4, vb5, vb6, vb7); } while (0)
#define A4_PV(ct, stage) do { \
            s16x4 va0, va1, va2, va3, va4, va5, va6, va7; \
            A4_VREADS(stage, 0, va0, va1, va2, va3, va4, va5, va6, va7); \
            TR_WAIT8(va0, va1, va2, va3, va4, va5, va6, va7); \
            A4_PVMMA(ct, 0, va0, va1, va2, va3, va4, va5, va6, va7); \
            A4_VREADS(stage, 1, va0, va1, va2, va3, va4, va5, va6, va7); \
            TR_WAIT8(va0, va1, va2, va3, va4, va5, va6, va7); \
            A4_PVMMA(ct, 1, va0, va1, va2, va3, va4, va5, va6, va7); } while (0)
#define A4_RESET() do { _Pragma("unroll") for (int ct = 0; ct < 2; ++ct) { mrun[ct] = -INF; lrun[ct] = 0.f; \
            _Pragma("unroll") for (int db = 0; db < 4; ++db) O[ct][db] = (f32x4){0.f, 0.f, 0.f, 0.f}; } } while (0)
#define A4_FINISH(br, first) do { _Pragma("unroll") for (int ct = 0; ct < 2; ++ct) { \
            float lt = lrun[ct]; lt = xsum_16_32(lt); \
            const float wv = A4_GATEV(ct, br) / fmaxf(lt, 1e-30f); \
            float* op = OATT + ((size_t)b * SEQ + tq[ct]) * 512 + (g * 4 + hd) * 64 + g4 * 4; \
            _Pragma("unroll") for (int db = 0; db < 4; ++db) { f32x4 r = O[ct][db] * wv; if (!(first)) r += *(const f32x4*)(op + db * 16); *(f32x4*)(op + db * 16) = r; } } } while (0)

        if (amask & 1) {
            const unsigned char* KW = KV6 + (size_t)4 * 4194304 + seqbase * 128; const unsigned char* VW = KV6 + (size_t)5 * 4194304 + seqbase * 128;
            A4_RESET();
            const int s0 = T >= 8 ? 0 : 8 - T;
            { const int jb = T - 8 + s0; A4_ISSUE(KW + (size_t)jb * 8192, VW + (size_t)jb * 8192, 0);
              if (s0 < 8) { A4_ISSUE(KW + (size_t)(jb + 1) * 8192, VW + (size_t)(jb + 1) * 8192, 1); asm volatile("s_waitcnt vmcnt(2)" ::: "memory"); } else asm volatile("s_waitcnt vmcnt(0)" ::: "memory");
              __syncthreads(); }
            int stage = 0;
            for (int s = s0; s <= 8; ++s) {
                const int jb = T - 8 + s;
                const bool iss = (s + 2 <= 8);
                if (iss) { const int st2 = stage >= 1 ? stage - 1 : 2; const unsigned char* kn = KW + (size_t)(jb + 2) * 8192; const unsigned char* vn = VW + (size_t)(jb + 2) * 8192; A4_ISSUE(kn, vn, st2); }
#pragma unroll
                for (int ct = 0; ct < 2; ++ct) {
                    A4_LOADK(stage);
                    A4_SCORES(ct);
                    __builtin_amdgcn_sched_barrier(0);
                    const int t = tq[ct];
                    {
                        const int base = t - jb * 64 - g4 * 4;
                        const LAS float* lp = lutl + hd * LUTP + base - 51;
                        const bool edge = (s == 0) || (s == 8);
#pragma unroll
                        for (int kt = 0; kt < 4; ++kt) {
                            f32x4 bs;
#pragma unroll
                            for (int j = 0; j < 4; ++j) bs[j] = lp[51 - kt * 16 - j];
                            asm volatile("" : "+v"(bs));
                            sv[kt] += bs;
                        }
                        if (edge) {
#pragma unroll
                            for (int kt = 0; kt < 4; ++kt)
#pragma unroll
                                for (int j = 0; j < 4; ++j) { const int dist = base - kt * 16 - j; sv[kt][j] = ((dist >= 0) && (dist < 512)) ? sv[kt][j] : -INF; }
                        }
                    }
                    A4_ONLINE_PV(ct, stage);
                    __builtin_amdgcn_sched_barrier(0);
                }
                A4_SYNC_RING(iss);
                stage = stage == 2 ? 0 : stage + 1;
            }
            if (!probe) A4_FINISH(2, true);
        }
        if (amask & 2) {
            const unsigned char* KC = KCB + (size_t)(b * 2 + g) * 512 * 128; const unsigned char* VC = VCB + (size_t)(b * 2 + g) * 512 * 128;
            int ncmp = 4 * T + 3; if (ncmp > NCMP) ncmp = NCMP;
            const int nblk = (ncmp + 63) >> 6;
            A4_RESET();
            A4_ISSUE(KC, (const unsigned char*)nullptr, 0);
            A4_SYNC();
            for (int s = 0; s < nblk; ++s) {
                const int stage = s & 1;
                if (s + 1 < nblk) A4_ISSUE(KC + (size_t)(s + 1) * 8192, (const unsigned char*)nullptr, stage ^ 1);
#pragma unroll
                for (int ct = 0; ct < 2; ++ct) {
                    A4_LOADK(stage);
                    A4_SCORES(ct);
                    __builtin_amdgcn_sched_barrier(0);
                    const int t = tq[ct];
                    float mx = -INF;
#pragma unroll
                    for (int kt = 0; kt < 4; ++kt) {
                        f32x4 bs;
#pragma unroll
                        for (int j = 0; j < 4; ++j) { int dist = t - (16 * (s * 64 + kt * 16 + g4 * 4 + j) + 31); dist = dist < 1023 ? dist : 1023; bs[j] = lutl[hd * LUTP + (dist & 1023)]; }
                        asm volatile("" : "+v"(bs));
#pragma unroll
                        for (int j = 0; j < 4; ++j) {
                            const int n = s * 64 + kt * 16 + g4 * 4 + j; const int dist = t - (16 * n + 31);
                            const bool ok = (dist >= 0) && (n < NCMP);
                            sv[kt][j] = ok ? sv[kt][j] + bs[j] : -INF; mx = fmaxf(mx, sv[kt][j]);
                        }
                    }
                    mx = xmax_16_32(mx);
                    const float mnew = fmaxf(mrun[ct], mx); const float muse = (mnew == -INF) ? 0.f : mnew;
                    const float scl = ex2(mrun[ct] - muse); mrun[ct] = mnew;
                    float ls = 0.f;
#pragma unroll
                    for (int kt = 0; kt < 4; ++kt)
#pragma unroll
                        for (int j = 0; j < 4; ++j) ls += ex2(sv[kt][j] - muse);
                    lrun[ct] = lrun[ct] * scl + ls;
                    __builtin_amdgcn_sched_barrier(0);
                }
                A4_SYNC();
            }
            float mfin[2], linv[2];
#pragma unroll
            for (int ct = 0; ct < 2; ++ct) {
                float lt = lrun[ct]; lt = xsum_16_32(lt);
                linv[ct] = 1.f / fmaxf(lt, 1e-30f); mfin[ct] = (mrun[ct] == -INF) ? 0.f : mrun[ct];
            }
            A4_ISSUE(KC, VC, 0);
            A4_SYNC();
            for (int s = 0; s < nblk; ++s) {
                const int stage = s & 1;
                if (s + 1 < nblk) { const unsigned char* kn = KC + (size_t)(s + 1) * 8192; const unsigned char* vn = VC + (size_t)(s + 1) * 8192; A4_ISSUE(kn, vn, stage ^ 1); }
#pragma unroll
                for (int ct = 0; ct < 2; ++ct) {
                    A4_LOADK(stage);
                    A4_SCORES(ct);
                    __builtin_amdgcn_sched_barrier(0);
                    const int t = tq[ct];
#pragma unroll
                    for (int kt = 0; kt < 4; ++kt) {
                        f32x4 bs;
#pragma unroll
                        for (int j = 0; j < 4; ++j) { int dist = t - (16 * (s * 64 + kt * 16 + g4 * 4 + j) + 31); dist = dist < 1023 ? dist : 1023; bs[j] = lutl[hd * LUTP + (dist & 1023)]; }
                        asm volatile("" : "+v"(bs));
#pragma unroll
                        for (int j = 0; j < 4; ++j) {
                            const int n = s * 64 + kt * 16 + g4 * 4 + j; const int dist = t - (16 * n + 31);
                            const bool ok = (dist >= 0) && (n < NCMP);
                            sv[kt][j] = ok ? ex2(sv[kt][j] + bs[j] - mfin[ct]) * linv[ct] : 0.f;
                        }
                        float s4 = (sv[kt][0] + sv[kt][1]) + (sv[kt][2] + sv[kt][3]); float s3 = sv[kt][3];
                        s4 += __shfl_xor(s4, 1); s4 += __shfl_xor(s4, 2); s3 += __shfl_xor(s3, 1); s3 += __shfl_xor(s3, 2);
                        const int a = s * 16 + kt * 4 + g4;
                        if (hd == 0 && !probe) {
                            LAS float* sp = score + (8 * wid + 4 * ct + tl) * 128 + a;
                            atomicAdd((float*)sp, s4);
                            if (a + 1 < 128) atomicAdd((float*)(sp + 1), s3);
                        }
                    }
                    A4_PV(ct, stage);
                    __builtin_amdgcn_sched_barrier(0);
                }
                A4_SYNC();
            }
            if (!probe)
#pragma unroll
            for (int ct = 0; ct < 2; ++ct) {
                float* op = OATT + ((size_t)b * SEQ + tq[ct]) * 512 + (g * 4 + hd) * 64 + g4 * 4;
#pragma unroll
                for (int db = 0; db < 4; ++db) { const float gcv = A4_GATEV(ct, 0); f32x4 r = O[ct][db] * gcv; r += *(const f32x4*)(op + db * 16); *(f32x4*)(op + db * 16) = r; }
            }
        }
        __syncthreads();
        if (!probe)
        for (int tt = 0; tt < 8; ++tt) {
            const int ti = 8 * wid + tt;
            const int j0 = lane, j1 = lane + 64;
            bool sel0, sel1;
            if (T <= 15) { sel0 = j0 <= T; sel1 = false; }
            else {
                const bool c0 = (j0 >= 1) && (j0 <= T - 2), c1 = (j1 <= T - 2);
                const float s0 = c0 ? score[ti * 128 + j0] : -INF, s1 = c1 ? score[ti * 128 + j1] : -INF;
                int r0 = 0, r1 = 0;
                for (int j2 = 1; j2 <= T - 2; ++j2) { const float v = score[ti * 128 + j2]; r0 += (v > s0) || (v == s0 && j2 < j0); r1 += (v > s1) || (v == s1 && j2 < j1); }
                sel0 = (c0 && r0 < 13) || (j0 == 0) || (j0 == T) || (j0 == T - 1);
                sel1 = (c1 && r1 < 13) || (j1 == T) || (j1 == T - 1);
            }
            const unsigned long long b0 = __ballot(sel0), b1 = __ballot(sel1);
            if (lane == 0) { selm[ti * 4 + 0] = (unsigned)b0; selm[ti * 4 + 1] = (unsigned)(b0 >> 32); selm[ti * 4 + 2] = (unsigned)b1; selm[ti * 4 + 3] = (unsigned)(b1 >> 32); }
        }
        __builtin_amdgcn_wave_barrier();
        asm volatile("s_waitcnt lgkmcnt(0)" ::: "memory");
        if (amask & 4) {
            const unsigned char* KS = KV6 + (size_t)2 * 4194304 + seqbase * 128; const unsigned char* VS = KV6 + (size_t)3 * 4194304 + seqbase * 128;
            unsigned un[2][4];
#pragma unroll
            for (int ct = 0; ct < 2; ++ct)
#pragma unroll
                for (int w = 0; w < 4; ++w) {
                    unsigned uu = selm[(8 * wid + 4 * ct + 0) * 4 + w] | selm[(8 * wid + 4 * ct + 1) * 4 + w] | selm[(8 * wid + 4 * ct + 2) * 4 + w] | selm[(8 * wid + 4 * ct + 3) * 4 + w];
                    un[ct][w] = __builtin_amdgcn_readfirstlane(uu);
                }
            A4_RESET();
            const float cbfar = lutl[hd * LUTP + 1023];
            __syncthreads();
#pragma unroll
            for (int bq = 0; bq < 4; ++bq) if (bq <= T) { const unsigned char* kn = KS + (size_t)bq * 8192; const unsigned char* vn = VS + (size_t)bq * 8192; A4_ISSUE(kn, vn, bq); }
            A4_SYNC();
#pragma unroll
            for (int w = 0; w < 4; ++w) {
                const unsigned selw0 = selm[(8 * wid + tl) * 4 + w], selw1 = selm[(8 * wid + 4 + tl) * 4 + w];
                for (int gg = 0; gg < 8; ++gg) {
                    const int j0 = w * 32 + gg * 4;
                    if (j0 > T) break;
#pragma unroll
                    for (int bq = 0; bq < 4; ++bq) { const int jn = j0 + 4 + bq; if (jn <= T) { const unsigned char* kn = KS + (size_t)jn * 8192; const unsigned char* vn = VS + (size_t)jn * 8192; A4_ISSUE(kn, vn, (jn & 7)); } }
                    for (int bq = 0; bq < 4; ++bq) {
                        const int j = j0 + bq;
                        if (j > T) break;
                        const int jb = gg * 4 + bq, stage = j & 7;
                        const bool need0 = (un[0][w] >> jb) & 1u, need1 = (un[1][w] >> jb) & 1u;
                        if (need0 || need1) {
#pragma unroll
                            for (int ct = 0; ct < 2; ++ct) {
                                if (ct == 0 ? need0 : need1) {
                                    A4_LOADK(stage);
                                    A4_SCORES(ct);
                                    __builtin_amdgcn_sched_barrier(0);
                                    const int t = tq[ct];
                                    const bool csel = ((ct == 0 ? selw0 : selw1) >> jb) & 1u;
                                    if (j * 64 + 63 + 1023 <= t0) {
                                        const float cb = csel ? cbfar : -INF;
#pragma unroll
                                        for (int kt = 0; kt < 4; ++kt)
#pragma unroll
                                            for (int jj = 0; jj < 4; ++jj) sv[kt][jj] += cb;
                                    } else {
                                        const int base = t - j * 64 - g4 * 4;
                                        const LAS float* lp = lutl + hd * LUTP + base - 51;
                                        const float msk = csel ? 0.f : -INF;
#pragma unroll
                                        for (int kt = 0; kt < 4; ++kt) {
                                            f32x4 bs;
#pragma unroll
                                            for (int jj = 0; jj < 4; ++jj) bs[jj] = lp[51 - kt * 16 - jj];
                                            asm volatile("" : "+v"(bs));
                                            sv[kt] += bs + msk;
                                        }
                                        if (j == T) {
#pragma unroll
                                            for (int kt = 0; kt < 4; ++kt)
#pragma unroll
                                                for (int jj = 0; jj < 4; ++jj) { const int dist = base - kt * 16 - jj; sv[kt][jj] = (dist >= 0) ? sv[kt][jj] : -INF; }
                                        }
                                    }
                                    A4_ONLINE_PV(ct, stage);
                                    __builtin_amdgcn_sched_barrier(0);
                                }
                            }
                        }
                    }
                    A4_SYNC();
                }
            }
            if (!probe) A4_FINISH(1, false);
        }
    }
#undef A4_ISSUE
#undef A4_SYNC
#undef A4_SYNC_RING
#undef A4_LOADK
#undef A4_SCORES
#undef A4_ONLINE_PV
#undef A4_PV
#undef A4_VREADS
#undef A4_PVMMA
#undef A4_RESET
#undef A4_FINISH
#undef A4_GATEV
}

__device__ __forceinline__ void phase3_mfma(const Params& p, int bid, int nb, LAS unsigned char* lds) {
    {
        const unsigned char* XRBb = p.ws + WS_XRB; const bf16_t* XRB = (const bf16_t*)(p.ws + WS_XRB);
        const float* BG = (const float*)(p.ws + WS_BG); const float* GB = (const float*)(p.ws + WS_GBIAS);
        const float* conv_w = p.in[12]; const float* conv_b = p.in[13]; const float* lam = p.in[18];
        bf16_t* AL = (bf16_t*)(p.ws + WS_ALRU); bf16_t* UL = (bf16_t*)(p.ws + WS_ULRU);
        const XcdDeal dl = xcd_deal(512, lds, nb);
        gemm_stream<true, 1, 0, true>(lds, XRBb, dl.n, 4, 128,
            [&](int ps, int r) { const int u = dl.lo + ps * dl.step; return ((size_t)(u >> 5) * SEQP + (u & 31) * 256 + r) * 128; },
            [&](int ps, int n4) -> const float* { const int u = dl.lo + ps * dl.step; return BG + ((u >> 5) & 7) * 32768 + n4 * 4; },
            [&](int) { return 256; },
            [&](int ps, int rbase, int nbase, int, f32x4 (&acc)[4][4]) {
                const int u = dl.lo + ps * dl.step, sq = u >> 5, hb = sq & 7, bb = sq >> 3, t0 = (u & 31) * 256 + rbase;
                const int j8 = (nbase >> 6) * 32 + ((nbase >> 2) & 3) * 8, c = hb * 64 + j8;
                f32x4 cw[4][2], cbv[2], ga[2], gx[2], spl[2];
#pragma unroll
                for (int h2 = 0; h2 < 2; ++h2) {
#pragma unroll
                    for (int w = 0; w < 4; ++w) cw[w][h2] = *(const f32x4*)(conv_w + w * 512 + c + 4 * h2);
                    cbv[h2] = *(const f32x4*)(conv_b + c + 4 * h2);
                    ga[h2] = *(const f32x4*)(GB + hb * 128 + nbase + 16 * h2); gx[h2] = *(const f32x4*)(GB + hb * 128 + nbase + 16 * h2 + 32);
                    const f32x4 lm = *(const f32x4*)(lam + c + 4 * h2);
#pragma unroll
                    for (int jj = 0; jj < 4; ++jj) spl[h2][jj] = -8.0f * softplus_(-lm[jj]);
                }
#pragma unroll
                for (int mh = 0; mh < 2; ++mh) {
                u32x4 xw[4][4];
#pragma unroll
                for (int mi = 2 * mh; mi < 2 * mh + 2; ++mi)
#pragma unroll
                    for (int w = 0; w < 4; ++w) xw[mi][w] = *(const u32x4*)(XRB + ((size_t)sq * SEQP + t0 + mi * 16 + w) * 64 + j8);
#pragma unroll
                for (int mi = 2 * mh; mi < 2 * mh + 2; ++mi) {
                    f32x4 xc[2] = {cbv[0], cbv[1]};
#pragma unroll
                    for (int w = 0; w < 4; ++w) {
                        xc[0][0] += cw[w][0][0] * __uint_as_float(xw[mi][w][0] << 16); xc[0][1] += cw[w][0][1] * __uint_as_float(xw[mi][w][0] & 0xffff0000u);
                        xc[0][2] += cw[w][0][2] * __uint_as_float(xw[mi][w][1] << 16); xc[0][3] += cw[w][0][3] * __uint_as_float(xw[mi][w][1] & 0xffff0000u);
                        xc[1][0] += cw[w][1][0] * __uint_as_float(xw[mi][w][2] << 16); xc[1][1] += cw[w][1][1] * __uint_as_float(xw[mi][w][2] & 0xffff0000u);
                        xc[1][2] += cw[w][1][2] * __uint_as_float(xw[mi][w][3] << 16); xc[1][3] += cw[w][1][3] * __uint_as_float(xw[mi][w][3] & 0xffff0000u);
                    }
                    f32x4 dv[2], uv[2];
#pragma unroll
                    for (int ni = 0; ni < 2; ++ni)
#pragma unroll
                        for (int jj = 0; jj < 4; ++jj) {
                            const float r_ = sigm(acc[mi][ni][jj] + ga[ni][jj]), ig = sigm(acc[mi][ni + 2][jj] + gx[ni][jj]);
                            const float la = r_ * spl[ni][jj];
                            const float a1 = __builtin_amdgcn_exp2f(la * 1.4426950408889634f);
                            dv[ni][jj] = 1.f - a1; uv[ni][jj] = __builtin_amdgcn_sqrtf(fmaxf(1.f - a1 * a1, 0.f)) * (ig * xc[ni][jj]);
                        }
                    const size_t o = ((size_t)bb * SEQ + t0 + mi * 16) * 512 + c;
                    u32x4 wd, wu;
                    wd[0] = pk_bf16(dv[0][0], dv[0][1]); wd[1] = pk_bf16(dv[0][2], dv[0][3]); wd[2] = pk_bf16(dv[1][0], dv[1][1]); wd[3] = pk_bf16(dv[1][2], dv[1][3]);
                    wu[0] = pk_bf16(uv[0][0], uv[0][1]); wu[1] = pk_bf16(uv[0][2], uv[0][3]); wu[2] = pk_bf16(uv[1][0], uv[1][1]); wu[3] = pk_bf16(uv[1][2], uv[1][3]);
                    *(u32x4*)(AL + o) = wd; *(u32x4*)(UL + o) = wu;
                }
                __builtin_amdgcn_sched_barrier(0);
                } });
    }
    {
        const unsigned char* KV6 = p.ws + WS_KV6; float* CP = (float*)(p.ws + WS_CPART);
        const float* W1k = p.in[7]; const float* W1v = p.in[9];
        const XcdDeal dl = xcd_deal(256, lds, nb);
        gemm_stream<false, 1>(lds, KV6, dl.n, 2, 64,
            [&](int ps, int r) { const int u = dl.lo + ps * dl.step, ks = u >> 4, kv = (u >> 3) & 1, R = (u & 7) * 256 + r;
                                 return (size_t)kv * 4194304 + ((size_t)(R >> 9) * SEQ + 16 * (R & 511)) * 128 + (size_t)ks * 256; },
            [&](int ps, int n4) -> const float* { const int u = dl.lo + ps * dl.step, ks = u >> 4, kv = (u >> 3) & 1; return (kv ? W1v : W1k) + (size_t)ks * 128 * 64 + ((n4 * 4) & 63); },
            [&](int) { return 256; },
            [&](int ps, int r, int n, f32x4 v) { if (n < 64) { const int u = dl.lo + ps * dl.step; *(f32x4*)(CP + ((size_t)(u >> 3) * 2048 + (u & 7) * 256 + r) * 64 + n) = v; } });
    }
}

__device__ __forceinline__ void phase3b_new(const Params& p, int bid, int nb, float* smem) {
    const int tid = threadIdx.x;
    {
        const bf16_t* AL = (const bf16_t*)(p.ws + WS_ALRU); const bf16_t* UL = (const bf16_t*)(p.ws + WS_ULRU);
        float* AEND = (float*)(p.ws + WS_AEND); float* HEND = (float*)(p.ws + WS_HEND);
        const int cg = tid & 127, sg = tid >> 7;
        f32x4* summA = (f32x4*)smem; f32x4* summH = summA + 512;
        for (int u = bid; u < 256; u += nb) {
            const size_t base = ((size_t)(u >> 7) * SEQ + (u & 127) * 64 + sg * 16) * 512 + 4 * cg;
            u32x2 ar[16], ur[16];
#pragma unroll
            for (int tt = 0; tt < 16; ++tt) { ar[tt] = *(const u32x2*)(AL + base + (size_t)tt * 512); ur[tt] = *(const u32x2*)(UL + base + (size_t)tt * 512); }
            f32x4 A = (f32x4){1.f, 1.f, 1.f, 1.f}, H = (f32x4){0.f, 0.f, 0.f, 0.f};
#pragma unroll
            for (int tt = 0; tt < 16; ++tt) { const f32x4 a_ = 1.f - bf4_f32(ar[tt]); H = a_ * H + bf4_f32(ur[tt]); A = A * a_; }
            __syncthreads();
            summA[sg * 128 + cg] = A; summH[sg * 128 + cg] = H;
            __syncthreads();
            if (sg == 0) {
#pragma unroll
                for (int j = 1; j < 4; ++j) { const f32x4 a2 = summA[j * 128 + cg], h2 = summH[j * 128 + cg]; H = a2 * H + h2; A = A * a2; }
                *(f32x4*)(AEND + (size_t)u * 512 + 4 * cg) = A; *(f32x4*)(HEND + (size_t)u * 512 + 4 * cg) = H;
            }
        }
        __syncthreads();
    }
    {
        const float* CP = (const float*)(p.ws + WS_CPART); const float* CB = (const float*)(p.ws + WS_CBIAS);
        float* hid = smem;
        for (int u = bid; u < 64; u += nb) {
            const int kv = u >> 5, R0 = (u & 31) * 64;
            const float* w2 = kv ? p.in[10] : p.in[8];
            bf16_t* ob = (bf16_t*)(p.ws + (kv ? WS_VCB : WS_KCB));
            __syncthreads();
            for (int i = tid; i < 64 * 64; i += NT) {
                const int r = i >> 6, c = i & 63; const size_t o = ((size_t)kv * 2048 + R0 + r) * 64 + c;
                float v = CB[kv * 64 + c];
#pragma unroll
                for (int ks = 0; ks < 16; ++ks) v += CP[o + (size_t)ks * 262144];
                hid[r * 65 + c] = gelu_t(v);
            }
            __syncthreads();
            for (int i = tid; i < 64 * 64; i += NT) {
                const int r = i >> 6, j = i & 63; float acc = 0.f;
#pragma unroll 8
                for (int k = 0; k < 64; ++k) acc += hid[r * 65 + k] * w2[k * 64 + j];
                const int R = R0 + r;
                if ((R & 511) == 511) acc = 0.f;
                ob[(size_t)R * 64 + j] = (bf16_t)(pk_bf16(acc, acc) & 0xffffu);
            }
        }
    }
}

__device__ __forceinline__ void phase4b_new(const Params& p, int bid, int nb, float* smem) {
    const bf16_t* AL = (const bf16_t*)(p.ws + WS_ALRU); const bf16_t* UL = (const bf16_t*)(p.ws + WS_ULRU);
    const float* AEND = (const float*)(p.ws + WS_AEND); const float* HEND = (const float*)(p.ws + WS_HEND);
    const bf16_t* GRG = (const bf16_t*)(p.ws + WS_GRG); const float* OATT = (const float*)(p.ws + WS_OATT);
    const float* gaw = p.in[19]; const float* grw = p.in[20];
    bf16_t* YB = (bf16_t*)(p.ws + WS_YB);
    int tid_ = threadIdx.x; asm volatile("" : "+v"(tid_));
    const int tid = tid_, lane = tid & 63;
    const int cg = tid & 127, sg = tid >> 7, wsub = (tid >> 6) & 1;
    f32x4* summA = (f32x4*)smem;
    f32x4* summH = summA + 512;
    float* ssr = smem + 4096;
    float* ssa = ssr + 128;
    const f32x4 gr_w = *(const f32x4*)(grw + 4 * cg), ga_w = *(const f32x4*)(gaw + 4 * cg);
    for (int u = bid; u < 256; u += nb) {
        const int b = u >> 7, chunk = u & 127;
        f32x4 carry = (f32x4){0.f, 0.f, 0.f, 0.f};
        {
            const size_t cb = (size_t)(b * 128) * 512 + 4 * cg;
            const int k0 = sg * 32, k1 = (k0 + 32) < chunk ? (k0 + 32) : chunk;
            f32x4 pa = (f32x4){1.f, 1.f, 1.f, 1.f}, ph = (f32x4){0.f, 0.f, 0.f, 0.f};
#pragma unroll 8
            for (int k = k0; k < k1; ++k) { const f32x4 a_ = *(const f32x4*)(AEND + cb + (size_t)k * 512); ph = a_ * ph + *(const f32x4*)(HEND + cb + (size_t)k * 512); pa = pa * a_; }
            __syncthreads();
            summA[sg * 128 + cg] = pa; summH[sg * 128 + cg] = ph;
            __syncthreads();
#pragma unroll
            for (int j = 0; j < 4; ++j) carry = summA[j * 128 + cg] * carry + summH[j * 128 + cg];
        }
        __builtin_amdgcn_sched_barrier(0);
        const size_t tok0 = (size_t)b * SEQ + chunk * 64 + sg * 16;
        u32x2 dr[16], ur[16], gw[16]; f32x4 oa[16];
#pragma unroll
        for (int tt = 0; tt < 16; ++tt) {
            const size_t o = (tok0 + tt) * 512 + 4 * cg;
            dr[tt] = *(const u32x2*)(AL + o); ur[tt] = *(const u32x2*)(UL + o); gw[tt] = *(const u32x2*)(GRG + o); if (tt < 8) oa[tt] = *(const f32x4*)(OATT + o);
        }
        f32x4 A = (f32x4){1.f, 1.f, 1.f, 1.f}, H = (f32x4){0.f, 0.f, 0.f, 0.f};
#pragma unroll
        for (int tt = 0; tt < 16; ++tt) { const f32x4 a_ = 1.f - bf4_f32(dr[tt]); H = a_ * H + bf4_f32(ur[tt]); A = A * a_; }
        __syncthreads();
        summA[sg * 128 + cg] = A; summH[sg * 128 + cg] = H;
        __syncthreads();
#pragma unroll
        for (int j = 0; j < 3; ++j) if (j < sg) carry = summA[j * 128 + cg] * carry + summH[j * 128 + cg];
#pragma unroll
        for (int tt = 8; tt < 16; ++tt) oa[tt] = *(const f32x4*)(OATT + (tok0 + tt) * 512 + 4 * cg);
        f32x4 h = carry; u32x2 vv[16];
#pragma unroll
        for (int tt = 0; tt < 16; ++tt) {
            asm volatile("" : "+v"(dr[tt]), "+v"(ur[tt]));
            const f32x4 a_ = 1.f - bf4_f32(dr[tt]);
            h = a_ * h + bf4_f32(ur[tt]);
            const f32x4 v = h * bf4_f32(gw[tt]);
            vv[tt].x = pk_bf16(v[0], v[1]); vv[tt].y = pk_bf16(v[2], v[3]);
            const float sq = wave_sum((v[0] * v[0] + v[1] * v[1]) + (v[2] * v[2] + v[3] * v[3]));
            const float sqa = wave_sum((oa[tt][0] * oa[tt][0] + oa[tt][1] * oa[tt][1]) + (oa[tt][2] * oa[tt][2] + oa[tt][3] * oa[tt][3]));
            if (lane == 0) { ssr[(sg * 16 + tt) * 2 + wsub] = sq; ssa[(sg * 16 + tt) * 2 + wsub] = sqa; }
        }
        __syncthreads();
#pragma unroll
        for (int tt = 0; tt < 16; ++tt) {
            const int ti = sg * 16 + tt;
            const float s1 = ssr[ti * 2] + ssr[ti * 2 + 1], s2 = ssa[ti * 2] + ssa[ti * 2 + 1];
            const float rs1 = __builtin_amdgcn_rsqf(s1 * (1.f / 512.f) + 1e-6f), rs2 = __builtin_amdgcn_rsqf(s2 * (1.f / 512.f) + 1e-6f);
            const f32x4 ya = oa[tt] * rs2 * ga_w, yr = bf4_f32(vv[tt]) * rs1 * gr_w;
            u32x2 wa, wr_; wa.x = pk_bf16(ya[0], ya[1]); wa.y = pk_bf16(ya[2], ya[3]); wr_.x = pk_bf16(yr[0], yr[1]); wr_.y = pk_bf16(yr[2], yr[3]);
            *(u32x2*)(YB + (tok0 + tt) * 1024 + 4 * cg) = wa;
            *(u32x2*)(YB + (tok0 + tt) * 1024 + 512 + 4 * cg) = wr_;
        }
    }
}

__device__ __forceinline__ void phase8(const Params& p, int bid, int nb, float* smem) {
    const float* LOG = (const float*)(p.ws + WS_LOGITS); const float* brt = p.in[24];
    unsigned* cnt = (unsigned*)(p.ws + WS_HIST);
    int* EID = (int*)(p.ws + WS_EID); int* POS = (int*)(p.ws + WS_POS); float* WGT = (float*)(p.ws + WS_WGT);
    int tid_ = threadIdx.x; asm volatile("" : "+v"(tid_));
    const int wave = tid_ >> 6, lane = tid_ & 63;
    int* lhist = (int*)smem;
    if (tid_ < 256) lhist[tid_] = 0;
    __syncthreads();
    float bias[4];
#pragma unroll
    for (int r = 0; r < 4; ++r) bias[r] = brt[r * 64 + lane];
    for (int tok0 = bid * NW + wave; tok0 < MTOK; tok0 += 8 * nb * NW) {
        float lg[8][4];
#pragma unroll
        for (int k = 0; k < 8; ++k) { const int tok = tok0 + k * nb * NW; const int tc = tok < MTOK ? tok : tok0;
#pragma unroll
            for (int r = 0; r < 4; ++r) lg[k][r] = LOG[(size_t)tc * 256 + r * 64 + lane] + LOG[(size_t)MTOK * 256 + (size_t)tc * 256 + r * 64 + lane]; }
#pragma unroll
        for (int k = 0; k < 8; ++k) {
            const int tok = tok0 + k * nb * NW;
            if (tok < MTOK) {
                float sv[4], cv[4], gs[4];
#pragma unroll
                for (int r = 0; r < 4; ++r) { sv[r] = sigm(lg[k][r]); cv[r] = sv[r] + bias[r]; gs[r] = half_top2_sum(cv[r]); }
                float gsc = -INF;
#pragma unroll
                for (int r = 0; r < 4; ++r) {
                    const float ga = __builtin_bit_cast(float, __builtin_amdgcn_readlane(__builtin_bit_cast(int, gs[r]), 31));
                    const float gb = __builtin_bit_cast(float, __builtin_amdgcn_readlane(__builtin_bit_cast(int, gs[r]), 63));
                    gsc = lane == 2 * r ? ga : gsc; gsc = lane == 2 * r + 1 ? gb : gsc;
                }
                int grank = 0;
#pragma unroll
                for (int g2 = 0; g2 < 8; ++g2) { const float v2 = __builtin_bit_cast(float, __builtin_amdgcn_readlane(__builtin_bit_cast(int, gsc), g2)); grank += ((v2 > gsc) || (v2 == gsc && g2 < lane)) ? 1 : 0; }
                const unsigned long long gmask = __ballot((lane < 8) && (grank < 4));
#pragma unroll
                for (int r = 0; r < 4; ++r) cv[r] = ((gmask >> (2 * r + (lane >> 5))) & 1ull) ? cv[r] : -INF;
                int my_e = 0; float my_s = 0.f;
#pragma unroll
                for (int kk = 0; kk < 8; ++kk) {
                    float bv = cv[0]; int bi = lane;
                    if (cv[1] > bv) { bv = cv[1]; bi = 64 + lane; }
                    if (cv[2] > bv) { bv = cv[2]; bi = 128 + lane; }
                    if (cv[3] > bv) { bv = cv[3]; bi = 192 + lane; }
                    const float mx = wave_max_f(bv);
                    const int sel = wave_min_i(bv == mx ? bi : 0x7fffffff);
                    const int sr = sel >> 6;
                    const float mine = sr == 0 ? sv[0] : sr == 1 ? sv[1] : sr == 2 ? sv[2] : sv[3];
                    const float ssel = __builtin_bit_cast(float, __builtin_amdgcn_readlane(__builtin_bit_cast(int, mine), sel & 63));
                    if (lane == (sel & 63)) { cv[0] = sr == 0 ? -INF : cv[0]; cv[1] = sr == 1 ? -INF : cv[1]; cv[2] = sr == 2 ? -INF : cv[2]; cv[3] = sr == 3 ? -INF : cv[3]; }
                    if (lane == kk) { my_e = sel; my_s = ssel; }
                }
                const float ssum = wave_sum(lane < 8 ? my_s : 0.f);
                if (lane < 8) {
                    const int ps = atomicAdd(&lhist[my_e], 1);
                    EID[tok * 8 + lane] = my_e; POS[tok * 8 + lane] = ps; WGT[tok * 8 + lane] = 2.5f * my_s / ssum;
                }
            }
        }
    }
    __syncthreads();
    if (tid_ < 256) cnt[bid * 256 + tid_] = (unsigned)lhist[tid_];
}

__device__ __forceinline__ void expert_tables(const Params& p, int* off, int* tp, int shift = 6) {
    const unsigned* cnt = (const unsigned*)(p.ws + WS_CTL) + CW_CNT;
    __syncthreads();
    if (threadIdx.x < 64) {
        const int l = threadIdx.x; const int rnd = (1 << shift) - 1;
        const u32x4 c4 = *(const u32x4*)(cnt + 4 * l);
        const int c0 = (int)c4[0], c1 = (int)c4[1], c2 = (int)c4[2], c3 = (int)c4[3];
        const int t0 = (c0 + rnd) >> shift, t1 = (c1 + rnd) >> shift, t2 = (c2 + rnd) >> shift, t3 = (c3 + rnd) >> shift;
        const int so = c0 + c1 + c2 + c3, st = t0 + t1 + t2 + t3;
        int io = so, it = st;
#pragma unroll
        for (int d = 1; d < 64; d <<= 1) { const int uo = __shfl_up(io, d), ut = __shfl_up(it, d); if (l >= d) { io += uo; it += ut; } }
        const int eo = io - so, et = it - st;
        off[4 * l] = eo; off[4 * l + 1] = eo + c0; off[4 * l + 2] = eo + c0 + c1; off[4 * l + 3] = eo + c0 + c1 + c2;
        tp[4 * l] = et; tp[4 * l + 1] = et + t0; tp[4 * l + 2] = et + t0 + t1; tp[4 * l + 3] = et + t0 + t1 + t2;
        if (l == 63) { off[256] = io; tp[256] = it; tp[257] = it + (MTOK >> shift); }
    }
    __syncthreads();
}

__device__ __forceinline__ void phase9(const Params& p, int bid, int nb, float* smem) {
    int* off = (int*)smem; int* blkoff = off + 272; int* tot = off + 528; int* ptot = off + 1024; int* ppre = off + 3072;
    const unsigned* HIST = (const unsigned*)(p.ws + WS_HIST);
    unsigned* cnt = (unsigned*)(p.ws + WS_CTL) + CW_CNT;
    int tid_ = threadIdx.x; asm volatile("" : "+v"(tid_));
    const int tid = tid_;
    __syncthreads();
    {
        const int e4 = tid & 63, bg = tid >> 6, gsz = (nb + 7) >> 3, b0 = bg * gsz, b1 = (b0 + gsz) < nb ? (b0 + gsz) : nb;
        int t0 = 0, t1 = 0, t2 = 0, t3 = 0, q0 = 0, q1 = 0, q2 = 0, q3 = 0;
#pragma unroll 16
        for (int bb = b0; bb < b1; ++bb) {
            const u32x4 h = *(const u32x4*)(HIST + (size_t)bb * 256 + 4 * e4); const bool pre = bb < bid;
            t0 += (int)h[0]; t1 += (int)h[1]; t2 += (int)h[2]; t3 += (int)h[3];
            q0 += pre ? (int)h[0] : 0; q1 += pre ? (int)h[1] : 0; q2 += pre ? (int)h[2] : 0; q3 += pre ? (int)h[3] : 0;
        }
        int* pt = ptot + bg * 256 + 4 * e4; int* pq = ppre + bg * 256 + 4 * e4;
        pt[0] = t0; pt[1] = t1; pt[2] = t2; pt[3] = t3; pq[0] = q0; pq[1] = q1; pq[2] = q2; pq[3] = q3;
        __syncthreads();
        if (tid < 256) {
            int total = 0, pre = 0;
#pragma unroll
            for (int g = 0; g < 8; ++g) { total += ptot[g * 256 + tid]; pre += ppre[g * 256 + tid]; }
            tot[tid] = total; blkoff[tid] = pre; if (bid == 0) cnt[tid] = (unsigned)total;
        }
    }
    __syncthreads();
    if (tid < 64) {
        const int c0 = tot[4 * tid], c1 = tot[4 * tid + 1], c2 = tot[4 * tid + 2], c3 = tot[4 * tid + 3];
        const int so = c0 + c1 + c2 + c3; int io = so;
#pragma unroll
        for (int d = 1; d < 64; d <<= 1) { const int uo = __shfl_up(io, d); if (tid >= d) io += uo; }
        const int eo = io - so;
        off[4 * tid] = eo; off[4 * tid + 1] = eo + c0; off[4 * tid + 2] = eo + c0 + c1; off[4 * tid + 3] = eo + c0 + c1 + c2;
    }
    __syncthreads();
    const int* EID = (const int*)(p.ws + WS_EID); const int* POS = (const int*)(p.ws + WS_POS); const float* WGT = (const float*)(p.ws + WS_WGT);
    int* ST = (int*)(p.ws + WS_SLOTTOK); float* SW = (float*)(p.ws + WS_SLOTW); int* SOF = (int*)(p.ws + WS_SLOTOF);
    const int wave = tid >> 6, lane = tid & 63;
    for (int tok0 = bid * NW + wave; tok0 < MTOK; tok0 += 8 * nb * NW) {
        const int tok = tok0 + (lane >> 3) * nb * NW;
        if (tok < MTOK) {
            const int idx = tok * 8 + (lane & 7); const int e = EID[idx];
            const int slot = off[e] + blkoff[e] + POS[idx];
            ST[slot] = tok; SW[slot] = WGT[idx]; SOF[idx] = slot;
        }
    }
}

__device__ __forceinline__ int find_expert(const int* tp, int rt) {
    int lo = 0, hi = 256;
    while (lo < hi) { const int mid = (lo + hi + 1) >> 1; if (tp[mid] <= rt) lo = mid; else hi = mid - 1; }
    return lo;
}

__device__ __forceinline__ void phase7_mfma(const Params& p, int bid, int nb, LAS unsigned char* lds) {
    const unsigned char* H2b = p.ws + WS_H2B;
    float* LOG = (float*)(p.ws + WS_LOGITS);
    const XcdDeal dl = xcd_deal(64 * 2 * 2, lds, nb);
    const bf16_t* wrb = (const bf16_t*)(p.ws + WS_WRB);
    gemm_stream<false, 1, 0, false, true>(lds, H2b, dl.n, 8, 256,
        [&](int ps, int r) { const int u = dl.lo + ps * dl.step; return (size_t)((u >> 2) * 256 + r) * 2048 + (size_t)(u & 1) * 1024; },
        [&](int ps, int n4) -> const bf16_t* { const int u = dl.lo + ps * dl.step; return wrb + (size_t)(u & 1) * 512 * 256 + ((u >> 1) & 1) * 128 + n4 * 4; },
        [&](int) { return 256; },
        [&](int ps, int r, int n, f32x4 v) { const int u = dl.lo + ps * dl.step; *(f32x4*)(LOG + (size_t)(u & 1) * (MTOK * 256) + (size_t)((u >> 2) * 256 + r) * 256 + ((u >> 1) & 1) * 128 + n) = v; });
}

#define ETAB_OFF 24576
#define EDESC_OFF (ETAB_OFF + 1024)
__device__ __forceinline__ int expert_passes(const Params& p, int bid, int nb, const LAS unsigned char* lds, float* smem, int nct, int& npass) {
    int* off = (int*)(smem + ETAB_OFF); int* tp = off + 272; int* desc = (int*)(smem + EDESC_OFF);
    expert_tables(p, off, tp, 8);
    const unsigned* cnt = (const unsigned*)(p.ws + WS_CTL) + CW_CNT;
    const XcdDeal dl = xcd_deal(tp[257] * nct, lds, nb);
    npass = dl.n;
    for (int ps = threadIdx.x; ps < npass; ps += NT) {
        const int u = dl.lo + ps * dl.step;
        const int e = find_expert(tp, u / nct);
        const int nte = tp[e + 1] - tp[e], v = u - tp[e] * nct, ct = v / nte, rtl = v - ct * nte;
        const int rows_e = e < 256 ? (int)cnt[e] : MTOK;
        const int r0 = rtl * 256;
        desc[ps * 4 + 0] = (e < 256 ? off[e] : NK) + r0;
        desc[ps * 4 + 1] = (rows_e - r0) < 256 ? (rows_e - r0) : 256;
        desc[ps * 4 + 2] = e; desc[ps * 4 + 3] = ct;
    }
    __syncthreads();
    return dl.lo;
}

__device__ __forceinline__ void phase10_mfma(const Params& p, int bid, int nb, LAS unsigned char* lds, float* smem) {
    int npass; expert_passes(p, bid, nb, lds, smem, 4, npass);
    const LAS int* desc = (const LAS int*)(lds + EDESC_OFF * 4);
    const unsigned char* H2b = p.ws + WS_H2B; const int* ST = (const int*)(p.ws + WS_SLOTTOK);
    bf16_t* HIDB = (bf16_t*)(p.ws + WS_HIDB);
    const float* W1g = p.in[25]; const float* W3g = p.in[26]; const float* W1s = p.in[28]; const float* W3s = p.in[29];
    const float* SW = (const float*)(p.ws + WS_SLOTW);
    gemm_stream_ws(lds, H2b, npass, 16, 256,
        [&](int ps, int r) { const int slot0 = desc[ps * 4], mr = desc[ps * 4 + 1]; const int rr = r < mr ? r : mr - 1; const int slot = slot0 + rr;
                             const int tok = slot < NK ? ST[slot] : slot - NK; return (size_t)tok * 2048; },
        [&](int ps, int n4) -> const float* { const int e = desc[ps * 4 + 2], hc0 = desc[ps * 4 + 3] * 64; const int n = n4 * 4;
                             const int hc = hc0 + (n >> 6) * 32 + ((n >> 2) & 3) * 8 + ((n >> 4) & 1) * 4;
                             const float* W = ((n >> 5) & 1) ? (e < 256 ? W3g + (size_t)e * 262144 : W3s) : (e < 256 ? W1g + (size_t)e * 262144 : W1s); return W + hc; },
        [&](int ps) { return desc[ps * 4 + 1]; },
        [&](int ps, int rbase, int nbase, int mr, f32x4 (&acc)[8][4]) {
            const int slot0 = desc[ps * 4] + rbase, hc = desc[ps * 4 + 3] * 64 + (nbase >> 6) * 32 + ((nbase >> 2) & 3) * 8;
            float wv[8];
#pragma unroll
            for (int mi = 0; mi < 8; ++mi) { const int slot = slot0 + mi * 16; const float wl = SW[slot < NK ? slot : 0]; wv[mi] = slot < NK ? wl : 1.f; }
#pragma unroll
            for (int mi = 0; mi < 8; ++mi)
#pragma unroll
                for (int ni = 0; ni < 2; ++ni)
#pragma unroll
                    for (int jj = 0; jj < 4; ++jj) { const float a = acc[mi][ni][jj]; acc[mi][ni][jj] = a * __builtin_amdgcn_rcpf(1.f + ex2(-a * LOG2E)) * acc[mi][ni + 2][jj]; }
#pragma unroll
            for (int mi = 0; mi < 8; ++mi) {
                if (rbase + mi * 16 < mr) {
                    const f32x4 h0 = acc[mi][0] * wv[mi], h1 = acc[mi][1] * wv[mi];
                    u32x4 w; w[0] = pk_bf16(h0[0], h0[1]); w[1] = pk_bf16(h0[2], h0[3]); w[2] = pk_bf16(h1[0], h1[1]); w[3] = pk_bf16(h1[2], h1[3]);
                    *(u32x4*)(HIDB + (size_t)(slot0 + mi * 16) * 256 + hc) = w;
                }
            } });
}

__device__ __forceinline__ void phase11_mfma(const Params& p, int bid, int nb, LAS unsigned char* lds, float* smem) {
    int npass; expert_passes(p, bid, nb, lds, smem, 8, npass);
    const LAS int* desc = (const LAS int*)(lds + EDESC_OFF * 4);
    const unsigned char* HIDB = p.ws + WS_HIDB; const float* SW = (const float*)(p.ws + WS_SLOTW);
    bf16_t* SO = (bf16_t*)(p.ws + WS_SLOTOUT);
    const float* W2g = p.in[27]; const float* W2s = p.in[30];
    gemm_stream_ws(lds, HIDB, npass, 4, 1024,
        [&](int ps, int r) { const int slot0 = desc[ps * 4], mr = desc[ps * 4 + 1]; const int rr = r < mr ? r : mr - 1; return (size_t)(slot0 + rr) * 512; },
        [&](int ps, int n4) -> const float* { const int e = desc[ps * 4 + 2], n0 = desc[ps * 4 + 3] * 128; const int src4 = (n4 & ~7) + 2 * (n4 & 3) + ((n4 >> 2) & 1);
                                              return (e < 256 ? W2g + (size_t)e * 262144 : W2s) + n0 + src4 * 4; },
        [&](int ps) { return desc[ps * 4 + 1]; },
        [&](int ps, int rbase, int nbase, int mr, f32x4 (&acc)[8][4]) {
            const int slot0 = desc[ps * 4] + rbase, c0 = desc[ps * 4 + 3] * 128 + (nbase >> 6) * 64 + ((nbase >> 2) & 3) * 8;
#pragma unroll
            for (int mi = 0; mi < 8; ++mi) {
                if (rbase + mi * 16 < mr) {
                    bf16_t* op = SO + (size_t)(slot0 + mi * 16) * 1024 + c0;
#pragma unroll
                    for (int np = 0; np < 2; ++np) {
                        const f32x4 v0 = acc[mi][2 * np], v1 = acc[mi][2 * np + 1];
                        u32x4 o; o[0] = pk_bf16(v0[0], v0[1]); o[1] = pk_bf16(v0[2], v0[3]); o[2] = pk_bf16(v1[0], v1[1]); o[3] = pk_bf16(v1[2], v1[3]);
                        *(u32x4*)(op + np * 32) = o;
                    }
                }
            } });
}

__device__ __forceinline__ void phase12_mfma(const Params& p, int bid, int nb) {
    const bf16_t* X1 = (const bf16_t*)(p.ws + WS_X1); const bf16_t* SO = (const bf16_t*)(p.ws + WS_SLOTOUT); const int* SOF = (const int*)(p.ws + WS_SLOTOF);
    const float* mod = (const float*)(p.ws + WS_MOD); const float* fw = p.in[31];
    int tid_ = threadIdx.x; asm volatile("" : "+v"(tid_));
    const int wave = tid_ >> 6, lane = tid_ & 63;
    const int RS = nb * NW;
    f32x4 wv[4];
#pragma unroll
    for (int i4 = 0; i4 < 4; ++i4) wv[i4] = *(const f32x4*)(fw + lane * 16 + i4 * 4);
    for (int row0 = bid * NW + wave; row0 < MTOK; row0 += 2 * RS) {
        int slots[2];
#pragma unroll
        for (int k = 0; k < 2; ++k) { const int row = row0 + k * RS; const int rc = row < MTOK ? row : row0; slots[k] = lane < 8 ? SOF[rc * 8 + lane] : NK + rc; }
        u32x4 w0[2][9], w1[2][9], xa[2], xb[2];
#pragma unroll
        for (int k = 0; k < 2; ++k) {
            const int row = row0 + k * RS; const int rc = row < MTOK ? row : row0;
#pragma unroll
            for (int q = 0; q < 9; ++q) {
                const int slot = __builtin_amdgcn_readlane(slots[k], q);
                const u32x4* rp = (const u32x4*)(SO + (size_t)slot * 1024 + lane * 16);
                w0[k][q] = rp[0]; w1[k][q] = rp[1];
            }
            const u32x4* xp = (const u32x4*)(X1 + (size_t)rc * 1024 + lane * 16);
            xa[k] = xp[0]; xb[k] = xp[1];
        }
#pragma unroll
        for (int k = 0; k < 2; ++k) {
            const int row = row0 + k * RS;
            if (row < MTOK) {
                const int b = row >> 13;
                float acc[16];
#pragma unroll
                for (int i = 0; i < 16; ++i) acc[i] = 0.f;
#pragma unroll
                for (int q = 0; q < 9; ++q) {
#pragma unroll
                    for (int j = 0; j < 4; ++j) {
                        acc[2 * j] += __uint_as_float(w0[k][q][j] << 16); acc[2 * j + 1] += __uint_as_float(w0[k][q][j] & 0xffff0000u);
                        acc[8 + 2 * j] += __uint_as_float(w1[k][q][j] << 16); acc[8 + 2 * j + 1] += __uint_as_float(w1[k][q][j] & 0xffff0000u);
                    }
                }
                float xv[16];
#pragma unroll
                for (int j = 0; j < 4; ++j) { xv[2 * j] = __uint_as_float(xa[k][j] << 16); xv[2 * j + 1] = __uint_as_float(xa[k][j] & 0xffff0000u);
                                              xv[8 + 2 * j] = __uint_as_float(xb[k][j] << 16); xv[8 + 2 * j + 1] = __uint_as_float(xb[k][j] & 0xffff0000u); }
                float v[16]; float ss = 0.f;
#pragma unroll
                for (int i4 = 0; i4 < 4; ++i4) {
                    const f32x4 gv = *(const f32x4*)(mod + b * 6144 + 5120 + lane * 16 + i4 * 4);
#pragma unroll
                    for (int j = 0; j < 4; ++j) { v[i4 * 4 + j] = xv[i4 * 4 + j] + gv[j] * acc[i4 * 4 + j]; ss += v[i4 * 4 + j] * v[i4 * 4 + j]; }
                }
                ss = wave_sum(ss);
                const float rstd = __builtin_amdgcn_rsqf(ss * (1.f / 1024.f) + 1e-6f);
#pragma unroll
                for (int i4 = 0; i4 < 4; ++i4) {
                    f32x4 o;
#pragma unroll
                    for (int j = 0; j < 4; ++j) o[j] = v[i4 * 4 + j] * rstd * wv[i4][j];
                    *(f32x4*)(p.out + (size_t)row * 1024 + lane * 16 + i4 * 4) = o;
                }
            }
        }
    }
}

__global__ void __launch_bounds__(NT, 2) k_fused(Params p) {
    extern __shared__ __attribute__((aligned(16))) unsigned char lds_raw[];
    LAS unsigned char* lds = (LAS unsigned char*)lds_raw;
    float* smem = (float*)lds_raw;
    if (threadIdx.x == 0) { *(LAS u32x4*)(lds + LDS_MISC) = (u32x4){0u, 0u, 0u, 0u}; }
    __syncthreads();
    XcdBarrier bar = xcd_barrier_post((unsigned*)(p.ws + WS_CTL), (volatile LAS unsigned*)(lds + LDS_MISC));
    if (threadIdx.x == 0) ((LAS int*)(lds + TOPO_OFF))[2] = (int)xb_add((unsigned*)(p.ws + WS_CTL) + CW_RANK + 64 * bar.x, 1u);
    const int bid = blockIdx.x, nb = gridDim.x;
#define PH(stmt) { stmt; xcd_barrier(bar); }
#define PHR(bit, stmt) { stmt; xcd_barrier(bar); if (REP & (bit)) { stmt; xcd_barrier(bar); } }
    PHR(8192, phase0(p, bid, nb, smem, lds))
    if (threadIdx.x == 0) {
        int pre = 0, mine = 0;
        for (unsigned j = 0; j < 16; ++j) { const int c = (int)xb_ld((unsigned*)(p.ws + WS_CTL) + XB_XCNT(j)); if (j < bar.x) pre += c; if (j == bar.x) mine = c; }
        ((LAS int*)(lds + TOPO_OFF))[0] = pre; ((LAS int*)(lds + TOPO_OFF))[1] = mine > 0 ? mine : 1;
    }
    __syncthreads();
    PHR(128, phase_modnorm<false>(p, bid, nb, p.in[0], p.in[4], 0, 1024, (bf16_t*)(p.ws + WS_H1B)))
    PHR(1, phase2_e(p, bid, nb, lds))
    PHR(2, phase3_mfma(p, bid, nb, lds))
    PHR(4, phase3b_new(p, bid, nb, smem))
    PH(phase4_mfma(p.ws, bid, nb, lds))
    PHR(8, phase4b_new(p, bid, nb, smem))
    PHR(512, phase5_e(p, bid, nb, lds))
    PHR(16384, phase_modnorm<true>(p, bid, nb, p.ws + WS_X1, p.in[22], 3072, 4096, (bf16_t*)(p.ws + WS_H2B)))
    PHR(1024, phase7_mfma(p, bid, nb, lds))
    PH(phase8(p, bid, nb, smem))
    PH(phase9(p, bid, nb, smem))
    if (REP & 256) { PH(phase8(p, bid, nb, smem)) PH(phase9(p, bid, nb, smem)) }
    PHR(16, phase10_mfma(p, bid, nb, lds, smem))
    PHR(32, phase11_mfma(p, bid, nb, lds, smem))
    phase12_mfma(p, bid, nb);
    if (REP & 2048) { xcd_barrier(bar); phase12_mfma(p, bid, nb); }
    if (REP & 4096) { for (int i = 0; i < 20; ++i) xcd_barrier(bar); }
#undef PH
#undef PHR
}

extern "C" void kernel_launch(void* const* d_in, const int* in_sizes, int n_in, void* d_out, int out_size, void* d_ws, size_t ws_size, hipStream_t stream) {
    static int grid = 0;
    if (!grid) {
        int dev = 0, cus = 0;
        (void)hipGetDevice(&dev);
        (void)hipDeviceGetAttribute(&cus, hipDeviceAttributeMultiprocessorCount, dev);
        (void)hipFuncSetAttribute((const void*)k_fused, hipFuncAttributeMaxDynamicSharedMemorySize, LDS_BYTES);
        if (cus < 1) cus = 256;
        grid = cus;
    }
    Params p{};
    for (int i = 0; i < 32; ++i) p.in[i] = (const float*)d_in[i];
    p.out = (float*)d_out; p.ws = (unsigned char*)d_ws;
    (void)hipMemsetAsync((char*)d_ws + WS_CTL, 0, CTL_BYTES, stream);
    hipLaunchKernelGGL(k_fused, dim3(grid), dim3(NT), LDS_BYTES, stream, p);
}
```

```cpp
#include <hip/hip_runtime.h>
#include <stdint.h>
#include <type_traits>


#define MTOK 16384
#define SEQ 8192
#define SEQP 8195
#define DM 1024
#define NCOLS 2328
#define COL_KC 512
#define COL_KS 768
#define COL_VS 896
#define COL_KW 1024
#define COL_VW 1152
#define COL_G 1280
#define COL_XR 1304
#define COL_GR 1816
#define NCMP 511
#define NEXP 256
#define NK 131072

#define MiB (1048576ull)
#define WS_CTL 0ull
#define CTL_BYTES (1 * MiB)
#define CW_CNT 8192
#define CW_RANK 12288
#define WS_MOD (1 * MiB)
#define WS_LUT (1 * MiB + 65536)
#define WS_KC (2 * MiB)
#define WS_VC (3 * MiB)
#define WS_AEND (4 * MiB)
#define WS_HEND (5 * MiB)
#define WS_EID (6 * MiB)
#define WS_POS (7 * MiB)
#define WS_WGT (8 * MiB)
#define WS_SLOTTOK (9 * MiB)
#define WS_SLOTW (10 * MiB)
#define WS_CARRY (11 * MiB)
#define WS_SLOTOF (12 * MiB)
#define WS_HIST (13 * MiB)
#define WS_LOGITS (16 * MiB)
#define WS_H1 (32 * MiB)
#define WS_PROJ (96 * MiB)
#define WS_HL (256 * MiB)
#define WS_AP (288 * MiB)
#define WS_ACC (320 * MiB)
#define WS_HID (384 * MiB)
#define WS_Y (528 * MiB)
#define WS_H2 (592 * MiB)
#define WS_X1 (656 * MiB)
#define WS_H1B (720 * MiB)
#define WS_YB (752 * MiB)
#define WS_H2B (784 * MiB)
#define WS_HIDB (816 * MiB)
#define WS_QB (896 * MiB)
#define WS_KV6 (912 * MiB)
#define WS_GATE (936 * MiB)
#define WS_KCB (938 * MiB)
#define WS_VCB (939 * MiB)
#define WS_OATT (940 * MiB)
#define WS_BG (14 * MiB)
#define WS_GBIAS (15 * MiB)
#define WS_CBIAS (15 * MiB + 8192)
#define WS_XRB (972 * MiB)
#define WS_GRG (990 * MiB)
#define WS_CPART (96 * MiB)
#define WS_ALRU (256 * MiB)
#define WS_ULRU (288 * MiB)
#define WS_WINB (1012 * MiB)
#define WS_WOUTB (1017 * MiB)
#define WS_WRB (1020 * MiB)
#define WS_WINT (1012 * MiB)
#define WS_WOUTT (1017 * MiB)
#define WS_WRT (1019 * MiB)
#define WS_SLOTOUT (32 * MiB)

#ifndef REP
#define REP 0
#endif
#ifndef USE_MFMA
#define USE_MFMA 31
#endif

struct Params {
    const float* in[32];
    float* out;
    unsigned char* ws;
};

#define NT 512
#define NW 8
#define LDS_BYTES 151552
#define LDS_MISC 131072
#define INF __builtin_huge_valf()
#define LOG2E 1.4426950408889634f

__device__ __forceinline__ float wave_sum(float v) {
#define WS_DPP(ctrl, rmask) __builtin_bit_cast(float, __builtin_amdgcn_update_dpp(0, __builtin_bit_cast(int, v), (ctrl), (rmask), 0xf, true))
    v += WS_DPP(0x111, 0xf);
    v += WS_DPP(0x112, 0xf);
    v += WS_DPP(0x114, 0xf);
    v += WS_DPP(0x118, 0xf);
    v += WS_DPP(0x142, 0xa);
    v += WS_DPP(0x143, 0xc);
#undef WS_DPP
    return __builtin_bit_cast(float, __builtin_amdgcn_readlane(__builtin_bit_cast(int, v), 63));
}
__device__ __forceinline__ float wave_max(float v) {
#pragma unroll
    for (int o = 32; o; o >>= 1) v = fmaxf(v, __shfl_xor(v, o));
    return v;
}
__device__ __forceinline__ float wave_max_f(float v) {
    asm volatile("s_nop 1\n\tv_max_f32_dpp %0, %0, %0 row_shr:1 row_mask:0xf bank_mask:0xf\n\ts_nop 1\n\tv_max_f32_dpp %0, %0, %0 row_shr:2 row_mask:0xf bank_mask:0xf\n\t"
                 "s_nop 1\n\tv_max_f32_dpp %0, %0, %0 row_shr:4 row_mask:0xf bank_mask:0xf\n\ts_nop 1\n\tv_max_f32_dpp %0, %0, %0 row_shr:8 row_mask:0xf bank_mask:0xf\n\t"
                 "s_nop 1\n\tv_max_f32_dpp %0, %0, %0 row_bcast:15 row_mask:0xa bank_mask:0xf\n\ts_nop 1\n\tv_max_f32_dpp %0, %0, %0 row_bcast:31 row_mask:0xc bank_mask:0xf\n\ts_nop 1" : "+v"(v));
    return __builtin_bit_cast(float, __builtin_amdgcn_readlane(__builtin_bit_cast(int, v), 63));
}
__device__ __forceinline__ int wave_min_i(int v) {
    asm volatile("s_nop 1\n\tv_min_i32_dpp %0, %0, %0 row_shr:1 row_mask:0xf bank_mask:0xf\n\ts_nop 1\n\tv_min_i32_dpp %0, %0, %0 row_shr:2 row_mask:0xf bank_mask:0xf\n\t"
                 "s_nop 1\n\tv_min_i32_dpp %0, %0, %0 row_shr:4 row_mask:0xf bank_mask:0xf\n\ts_nop 1\n\tv_min_i32_dpp %0, %0, %0 row_shr:8 row_mask:0xf bank_mask:0xf\n\t"
                 "s_nop 1\n\tv_min_i32_dpp %0, %0, %0 row_bcast:15 row_mask:0xa bank_mask:0xf\n\ts_nop 1\n\tv_min_i32_dpp %0, %0, %0 row_bcast:31 row_mask:0xc bank_mask:0xf\n\ts_nop 1" : "+v"(v));
    return __builtin_amdgcn_readlane(v, 63);
}
__device__ __forceinline__ float half_top2_sum(float v) {
    float m1 = v, m2 = -INF, t, u;
#define T2_STEP(ctl) asm volatile("v_mov_b32 %2, 0xff800000\n\tv_mov_b32 %3, %1\n\ts_nop 0\n\t" \
                                  "v_min_f32_dpp %2, %0, %0 " ctl " bank_mask:0xf\n\tv_max_f32_dpp %3, %1, %1 " ctl " bank_mask:0xf\n\tv_max_f32_dpp %0, %0, %0 " ctl " bank_mask:0xf\n\t" \
                                  "v_max_f32 %1, %2, %3\n\ts_nop 1" : "+v"(m1), "+v"(m2), "=&v"(t), "=&v"(u));
    asm volatile("s_nop 1" ::: );
    T2_STEP("row_shr:1 row_mask:0xf") T2_STEP("row_shr:2 row_mask:0xf") T2_STEP("row_shr:4 row_mask:0xf") T2_STEP("row_shr:8 row_mask:0xf") T2_STEP("row_bcast:15 row_mask:0xa")
#undef T2_STEP
    return m1 + m2;
}
__device__ __forceinline__ float quad_xor1(float v) { return __builtin_bit_cast(float, __builtin_amdgcn_mov_dpp(__builtin_bit_cast(int, v), 0xB1, 0xf, 0xf, true)); }
__device__ __forceinline__ float quad_xor2(float v) { return __builtin_bit_cast(float, __builtin_amdgcn_mov_dpp(__builtin_bit_cast(int, v), 0x4E, 0xf, 0xf, true)); }
__device__ __forceinline__ float sigm(float x) { return __builtin_amdgcn_rcpf(1.f + __builtin_amdgcn_exp2f(-1.4426950408889634f * x)); }
__device__ __forceinline__ float tanh_fast(float x) { return 1.f - 2.f * __builtin_amdgcn_rcpf(1.f + __builtin_amdgcn_exp2f(2.8853900817779268f * x)); }
__device__ __forceinline__ float gelu_t(float x) { return 0.5f * x * (1.f + tanh_fast(0.7978845608028654f * (x + 0.044715f * x * x * x))); }
__device__ __forceinline__ float softplus_(float z) { return fmaxf(z, 0.f) + log1pf(expf(-fabsf(z))); }


#define XB_TMO      128
#define XB_XCNT(j)  (256  + 64 * (j))
#define XB_XSUB(j)  (1280 + 64 * (j))
#define XB_XGEN(j)  (2304 + 64 * (j))
#define XB_TOP      3328
#define XB_TOPGEN   3392
#define XCD_BAR_WORDS 3456
#define XB_SPIN_CAP (1u << 18)
#define LAS __attribute__((address_space(3)))

__device__ __forceinline__ unsigned xb_ld(unsigned* p)              { return __hip_atomic_load(p, __ATOMIC_RELAXED, __HIP_MEMORY_SCOPE_AGENT); }
__device__ __forceinline__ unsigned xb_add(unsigned* p, unsigned v) { return __hip_atomic_fetch_add(p, v, __ATOMIC_RELAXED, __HIP_MEMORY_SCOPE_AGENT); }
__device__ __forceinline__ unsigned xb_xcc_id() { return (unsigned)__builtin_amdgcn_s_getreg((3 << 11) | 20) & 0xFu; }
#define XB_SPIN(cond, bar) do { unsigned _sp = 0; while (cond) { __builtin_amdgcn_s_sleep(1); \
    if ((++_sp & 255u) == 0u) { if (xb_ld(&(bar)[XB_TMO])) break; if (_sp > XB_SPIN_CAP) { atomicAdd(&(bar)[XB_TMO], 1u); break; } } } } while (0)

struct XcdBarrier {
    unsigned* bar; unsigned x;
    volatile LAS unsigned* st;
};
__device__ __forceinline__ XcdBarrier xcd_barrier_post(unsigned* bar, volatile LAS unsigned* st) {
    XcdBarrier b; b.bar = bar; b.x = xb_xcc_id(); b.st = st;
    if (threadIdx.x == 0) (void)xb_add(&bar[XB_XCNT(b.x)], 1u);
    return b;
}
__device__ __forceinline__ void xcd_barrier_complete(unsigned* bar, unsigned x, unsigned& nloc, unsigned& nx) {
    const unsigned G = gridDim.x * gridDim.y * gridDim.z;
    unsigned sum, cnt, mine, sp = 0u;
    for (;;) {
        sum = 0u; cnt = 0u; mine = 0u;
#pragma unroll
        for (unsigned j = 0; j < 16; ++j) { const unsigned c = xb_ld(&bar[XB_XCNT(j)]); sum += c; cnt += (c > 0u) ? 1u : 0u; mine = (j == x) ? c : mine; }
        if (sum == G) break;
        __builtin_amdgcn_s_sleep(1);
        if ((++sp & 255u) == 0u) { if (xb_ld(&bar[XB_TMO])) break; if (sp > XB_SPIN_CAP) { atomicAdd(&bar[XB_TMO], 1u); break; } }
    }
    nloc = mine > 0u ? mine : 1u; nx = cnt > 0u ? cnt : 1u;
}
__device__ __forceinline__ void xcd_barrier(const XcdBarrier& b) {
    asm volatile("s_waitcnt vmcnt(0)" ::: "memory");
    __syncthreads();
    if (threadIdx.x == 0) {
        unsigned* bar = b.bar;
        __builtin_amdgcn_s_waitcnt(0);
        unsigned nloc = b.st[0], nx = b.st[1];
        if (nloc == 0u) { xcd_barrier_complete(bar, b.x, nloc, nx); b.st[0] = nloc; b.st[1] = nx; }
        const unsigned old = xb_add(&bar[XB_XSUB(b.x)], 1u);
        const unsigned gen = old / nloc;
        if (old + 1u == (gen + 1u) * nloc) {
            __builtin_amdgcn_fence(__ATOMIC_RELEASE, "agent");
            asm volatile("s_waitcnt vmcnt(0)" ::: "memory");
            const unsigned og = xb_add(&bar[XB_TOP], 1u);
            const unsigned tg = og / nx;
            if (og + 1u == (tg + 1u) * nx) xb_add(&bar[XB_TOPGEN], 1u);
            else XB_SPIN(xb_ld(&bar[XB_TOPGEN]) == tg, bar);
            __builtin_amdgcn_fence(__ATOMIC_ACQUIRE, "agent");
            xb_add(&bar[XB_XGEN(b.x)], 1u);
            asm volatile("s_waitcnt vmcnt(0)" ::: "memory");
        } else {
            XB_SPIN(xb_ld(&bar[XB_XGEN(b.x)]) == gen, bar);
            __builtin_amdgcn_fence(__ATOMIC_ACQUIRE, "agent");
            asm volatile("s_waitcnt vmcnt(0)" ::: "memory");
        }
    }
    __syncthreads();
}

typedef short bf16x8 __attribute__((ext_vector_type(8)));
typedef short s16x4 __attribute__((ext_vector_type(4)));
typedef short v4i16_t __attribute__((ext_vector_type(4)));
typedef float f32x4 __attribute__((ext_vector_type(4)));
typedef float f32x2 __attribute__((ext_vector_type(2)));
typedef __bf16 bf16x2_t __attribute__((ext_vector_type(2)));
typedef unsigned short bf16_t;
typedef unsigned u32x2 __attribute__((ext_vector_type(2)));
typedef unsigned u32x4 __attribute__((ext_vector_type(4)));
__device__ __forceinline__ unsigned pk_bf16(float lo, float hi) { return __builtin_bit_cast(unsigned, __builtin_convertvector((f32x2){lo, hi}, bf16x2_t)); }
__device__ __forceinline__ float bf2f(bf16_t v) { return __uint_as_float(((unsigned)v) << 16); }

__device__ __forceinline__ f32x4 bf4_f32(u32x2 w) { f32x4 r; r[0] = __uint_as_float(w.x << 16); r[1] = __uint_as_float(w.x & 0xffff0000u); r[2] = __uint_as_float(w.y << 16); r[3] = __uint_as_float(w.y & 0xffff0000u); return r; }
__device__ __forceinline__ s16x4 tr_read(LAS unsigned char* pa) { s16x4 r; asm volatile("ds_read_b64_tr_b16 %0, %1" : "=v"(r) : "v"(pa) : "memory"); return r; }
template <int OFF> __device__ __forceinline__ s16x4 tr_read_i(LAS unsigned char* pa) { s16x4 r; asm volatile("ds_read_b64_tr_b16 %0, %1 offset:%2" : "=v"(r) : "v"(pa), "n"(OFF) : "memory"); return r; }
__device__ __forceinline__ float max3f(float a, float b, float c) { float r; asm("v_max3_f32 %0, %1, %2, %3" : "=v"(r) : "v"(a), "v"(b), "v"(c)); return r; }
#define TR_WAIT8(a0, a1, a2, a3, a4, a5, a6, a7) asm volatile("s_waitcnt lgkmcnt(0)" : "+v"(a0), "+v"(a1), "+v"(a2), "+v"(a3), "+v"(a4), "+v"(a5), "+v"(a6), "+v"(a7) :: "memory")

#define GEMM_LDS_A 0
#define GEMM_LDS_B 65536
template <bool PAIR, int DEPTH, int MODE = 0, bool TILE_EPI = false, bool BBF16 = false, class ARow, class BCol, class MRows, class Epi>
__device__ __forceinline__ void gemm_stream(LAS unsigned char* lds, const unsigned char* Abase, int npass, int nk, int ldb, ARow arow, BCol bcol, MRows mrowsf, Epi epi) {
    int tid_ = threadIdx.x; asm volatile("" : "+v"(tid_));
    const int tid = tid_, wid = __builtin_amdgcn_readfirstlane(tid >> 6), lane = tid & 63;
    const int wr = wid >> 1, wc = wid & 1, fr = lane & 15, fq = lane >> 4;
    if (npass <= 0) return;
    const int S = npass * nk;
    const int Ccol = ((wid & 1) * 32 + 8 * ((lane & 3) ^ ((lane >> 5) << 1))) * 2;
    const int Rbase = 16 * (wid >> 1) + (lane >> 2);
    unsigned asrc[4];
    const int n4 = tid & 31, kb = tid >> 5;
    typedef typename std::conditional<BBF16, const bf16_t*, const float*>::type bptr_t;
    bptr_t bp;
    const int fB = ((kb & 3) << 2) | ((kb >> 2) & 3);
    const int bwoff = 256 * kb + 16 * ((n4 >> 1) ^ fB) + 8 * (n4 & 1);
    const int aoff = wr * 8192 + ((fr * 64 + fq * 16) ^ ((fr >> 3) << 5));
    const int q = (lane >> 2) & 3, pp = lane & 3;
    const int b0 = (wc * 8 + (pp >> 1)) ^ ((q << 2) | (2 * (fq & 1)));
    const int browoff = 256 * (fq * 8 + q) + 8 * (pp & 1);
#define GS_BOFF(v) (browoff + 16 * (b0 ^ (v)))
    f32x4 acc[4][4];
#pragma unroll
    for (int i = 0; i < 4; ++i)
#pragma unroll
        for (int j = 0; j < 4; ++j) acc[i][j] = (f32x4){0.f, 0.f, 0.f, 0.f};
    float4 bregX[4], bregY[4];
    int aP = 0, aK = 0, bP = 0, bK = 0;
#define GS_SETA() do { _Pragma("unroll") for (int _i = 0; _i < 4; ++_i) asrc[_i] = (unsigned)(arow(aP, Rbase + 64 * _i) + Ccol); } while (0)
#define GS_ISSUE_A(buf) do { _Pragma("unroll") for (int _i = 0; _i < 4; ++_i) \
        __builtin_amdgcn_global_load_lds((const unsigned*)(Abase + (size_t)asrc[_i] + (size_t)aK * 128), (LAS unsigned*)(lds + GEMM_LDS_A + (buf) * 32768 + _i * 8192 + wid * 1024), 16, 0, 0); \
        if (++aK == nk) { aK = 0; ++aP; if (aP < npass) GS_SETA(); } } while (0)
#define GS_LOAD_B(breg) do { _Pragma("unroll") for (int _i = 0; _i < 4; ++_i) { \
            if constexpr (BBF16) { const u32x2 _t = *(const u32x2*)(bp + (size_t)(bK * 64 + kb + 16 * _i) * ldb); breg[_i].x = __uint_as_float(_t.x); breg[_i].y = __uint_as_float(_t.y); } \
            else breg[_i] = *(const float4*)(bp + (size_t)(bK * 64 + kb + 16 * _i) * ldb); } \
        if (++bK == nk) { bK = 0; ++bP; if (bP < npass) bp = bcol(bP, n4); } } while (0)
#define GS_WRITE_B(breg, buf) do { _Pragma("unroll") for (int _i = 0; _i < 4; ++_i) { u32x2 _w; \
            if constexpr (BBF16) { _w.x = __float_as_uint(breg[_i].x); _w.y = __float_as_uint(breg[_i].y); } \
            else { _w.x = pk_bf16(breg[_i].x, breg[_i].y); _w.y = pk_bf16(breg[_i].z, breg[_i].w); } \
        *(LAS u32x2*)(lds + GEMM_LDS_B + (buf) * 16384 + bwoff + 4096 * _i) = _w; } } while (0)
#define GS_COMPUTE(buf) do { _Pragma("unroll") for (int ks = 0; ks < 2; ++ks) { \
            bf16x8 af[4]; s16x4 tl0, tl1, tl2, tl3, th0, th1, th2, th3; \
            LAS unsigned char* bb_ = lds + GEMM_LDS_B + (buf) * 16384 + ks * 8192; \
            tl0 = tr_read(bb_ + GS_BOFF(0)); th0 = tr_read(bb_ + 1024 + GS_BOFF(1)); tl1 = tr_read(bb_ + GS_BOFF(2)); th1 = tr_read(bb_ + 1024 + GS_BOFF(3)); \
            tl2 = tr_read(bb_ + GS_BOFF(4)); th2 = tr_read(bb_ + 1024 + GS_BOFF(5)); tl3 = tr_read(bb_ + GS_BOFF(6)); th3 = tr_read(bb_ + 1024 + GS_BOFF(7)); \
            _Pragma("unroll") for (int mi = 0; mi < 4; ++mi) af[mi] = *(const LAS bf16x8*)(lds + GEMM_LDS_A + (buf) * 32768 + aoff + mi * 2048 + ks * 1024); \
            TR_WAIT8(tl0, th0, tl1, th1, tl2, th2, tl3, th3); \
            bf16x8 bfr[4]; \
            bfr[0] = (bf16x8){tl0[0], tl0[1], tl0[2], tl0[3], th0[0], th0[1], th0[2], th0[3]}; bfr[1] = (bf16x8){tl1[0], tl1[1], tl1[2], tl1[3], th1[0], th1[1], th1[2], th1[3]}; \
            bfr[2] = (bf16x8){tl2[0], tl2[1], tl2[2], tl2[3], th2[0], th2[1], th2[2], th2[3]}; bfr[3] = (bf16x8){tl3[0], tl3[1], tl3[2], tl3[3], th3[0], th3[1], th3[2], th3[3]}; \
            _Pragma("unroll") for (int mi = 0; mi < 4; ++mi) _Pragma("unroll") for (int ni = 0; ni < 4; ++ni) \
                acc[mi][ni] = __builtin_amdgcn_mfma_f32_16x16x32_bf16(bfr[ni], af[mi], acc[mi][ni], 0, 0, 0); } } while (0)
#define GS_STEP(CUR, NXT, BREG_LD, BREG_WR) do { \
        if (MODE != 2 && s + DEPTH < S) GS_LOAD_B(BREG_LD); \
        if (MODE != 3 && s + 1 < S) GS_ISSUE_A(NXT); \
        __builtin_amdgcn_sched_barrier(0); \
        if (MODE != 1 && active) GS_COMPUTE(CUR); \
        __builtin_amdgcn_sched_barrier(0); \
        if (s + 1 < S) GS_WRITE_B(BREG_WR, NXT); \
        const bool pass_end = (cK + 1 == nk); \
        if (++cK == nk) { \
            if constexpr (TILE_EPI) { if (active) epi(cP, wr * 64 + fr, wc * 64 + fq * 4, cm, acc); } else \
            if (active) { \
                _Pragma("unroll") for (int mi = 0; mi < 4; ++mi) { const int r = wr * 64 + mi * 16 + fr; \
                    if (r < cm) { \
                        if constexpr (PAIR) { _Pragma("unroll") for (int ni = 0; ni < 2; ++ni) { epi(cP, r, wc * 64 + ni * 16 + fq * 4, acc[mi][ni], acc[mi][ni + 2]); } } \
                        else { _Pragma("unroll") for (int ni = 0; ni < 4; ++ni) { epi(cP, r, wc * 64 + ni * 16 + fq * 4, acc[mi][ni]); } } } } } \
            _Pragma("unroll") for (int i = 0; i < 4; ++i) _Pragma("unroll") for (int j = 0; j < 4; ++j) acc[i][j] = (f32x4){0.f, 0.f, 0.f, 0.f}; \
            cK = 0; ++cP; if (cP < npass) { cm = mrowsf(cP); active = (wr * 64) < cm; } \
        } \
        asm volatile("s_waitcnt lgkmcnt(0)" ::: "memory"); \
        if (DEPTH >= 2 && (s + DEPTH < S) && !pass_end) asm volatile("s_waitcnt vmcnt(4)" ::: "memory"); else asm volatile("s_waitcnt vmcnt(0)" ::: "memory"); \
        asm volatile("" ::: "memory"); __builtin_amdgcn_s_barrier(); asm volatile("" ::: "memory"); ++s; } while (0)
    int cP = 0, cK = 0, cm = mrowsf(0);
    bool active = (wr * 64) < cm;
    GS_SETA(); bp = bcol(0, n4);
    GS_ISSUE_A(0); GS_LOAD_B(bregX);
    GS_WRITE_B(bregX, 0);
    if constexpr (DEPTH >= 2) { if (1 < S) GS_LOAD_B(bregY); }
    static_assert(DEPTH == 1 || DEPTH == 2, "B prefetch depth");
    asm volatile("s_waitcnt lgkmcnt(0)" ::: "memory");
    asm volatile("s_waitcnt vmcnt(%0)" :: "n"((DEPTH - 1) * 4) : "memory");
    __syncthreads();
    int s = 0;
    if constexpr (DEPTH == 1) {
        while (s < S) { GS_STEP(0, 1, bregX, bregX); if (s >= S) break; GS_STEP(1, 0, bregX, bregX); }
    } else if constexpr (DEPTH == 2) {
        while (s < S) { GS_STEP(0, 1, bregX, bregY); if (s >= S) break; GS_STEP(1, 0, bregY, bregX); }
    }
#undef GS_SETA
#undef GS_BOFF
#undef GS_ISSUE_A
#undef GS_LOAD_B
#undef GS_WRITE_B
#undef GS_COMPUTE
#undef GS_STEP
}


template <class ARow, class BCol, class MRows, class Epi>
__device__ __forceinline__ void gemm_stream_rs(LAS unsigned char* lds, const unsigned char* Abase, int npass, int nk, int ldb, ARow arow, BCol bcol, MRows mrowsf, Epi epi) {
    int tid_ = threadIdx.x; asm volatile("" : "+v"(tid_));
    const int tid = tid_, wid = __builtin_amdgcn_readfirstlane(tid >> 6), lane = tid & 63;
    const int wr = wid >> 1, wc = wid & 1, fr = lane & 15, fq = lane >> 4;
    if (npass <= 0) return;
    const int S = npass * nk;
    const int Ccol = ((wid & 1) * 32 + 8 * ((lane & 3) ^ ((lane >> 5) << 1))) * 2;
    const int Rbase = 16 * (wid >> 1) + (lane >> 2);
    unsigned asrc[4];
    const int n4 = tid & 31, kb = tid >> 5;
    const float* bp;
    const int fB = ((kb & 3) << 2) | ((kb >> 2) & 3);
    const int bwoff = 256 * kb + 16 * ((n4 >> 1) ^ fB) + 8 * (n4 & 1);
    const int awoff = wid * 1024 + lane * 16;
    const int aoff = wr * 8192 + ((fr * 64 + fq * 16) ^ ((fr >> 3) << 5));
    const int q = (lane >> 2) & 3, pp = lane & 3;
    const int b0 = (wc * 8 + (pp >> 1)) ^ ((q << 2) | (2 * (fq & 1)));
    const int browoff = 256 * (fq * 8 + q) + 8 * (pp & 1);
#define RS_BOFF(v) (browoff + 16 * (b0 ^ (v)))
    f32x4 acc[4][4];
#pragma unroll
    for (int i = 0; i < 4; ++i)
#pragma unroll
        for (int j = 0; j < 4; ++j) acc[i][j] = (f32x4){0.f, 0.f, 0.f, 0.f};
    f32x4 bX[4], bY[4]; u32x4 aX[4], aY[4];
    int aP = 0, aK = 0, bP = 0, bK = 0;
#define RS_SETA() do { _Pragma("unroll") for (int _i = 0; _i < 4; ++_i) asrc[_i] = (unsigned)(arow(aP, Rbase + 64 * _i) + Ccol); } while (0)
#define RS_LOAD(AR, BR) do { \
        _Pragma("unroll") for (int _i = 0; _i < 4; ++_i) AR[_i] = *(const u32x4*)(Abase + (size_t)asrc[_i] + (size_t)aK * 128); \
        _Pragma("unroll") for (int _i = 0; _i < 4; ++_i) BR[_i] = *(const f32x4*)(bp + (size_t)(bK * 64 + kb + 16 * _i) * ldb); \
        if (++aK == nk) { aK = 0; if (aP + 1 < npass) { ++aP; RS_SETA(); } } \
        if (++bK == nk) { bK = 0; if (bP + 1 < npass) { ++bP; bp = bcol(bP, n4); } } } while (0)
#define RS_WRITE(AR, BR, buf) do { \
        _Pragma("unroll") for (int _i = 0; _i < 4; ++_i) *(LAS u32x4*)(lds + GEMM_LDS_A + (buf) * 32768 + _i * 8192 + awoff) = AR[_i]; \
        _Pragma("unroll") for (int _i = 0; _i < 4; ++_i) { u32x2 _w; _w.x = pk_bf16(BR[_i][0], BR[_i][1]); _w.y = pk_bf16(BR[_i][2], BR[_i][3]); \
            *(LAS u32x2*)(lds + GEMM_LDS_B + (buf) * 16384 + bwoff + 4096 * _i) = _w; } } while (0)
#define RS_COMPUTE(buf) do { _Pragma("unroll") for (int ks = 0; ks < 2; ++ks) { \
            bf16x8 af[4]; s16x4 tl0, tl1, tl2, tl3, th0, th1, th2, th3; \
            LAS unsigned char* bb_ = lds + GEMM_LDS_B + (buf) * 16384 + ks * 8192; \
            tl0 = tr_read(bb_ + RS_BOFF(0)); th0 = tr_read(bb_ + 1024 + RS_BOFF(1)); tl1 = tr_read(bb_ + RS_BOFF(2)); th1 = tr_read(bb_ + 1024 + RS_BOFF(3)); \
            tl2 = tr_read(bb_ + RS_BOFF(4)); th2 = tr_read(bb_ + 1024 + RS_BOFF(5)); tl3 = tr_read(bb_ + RS_BOFF(6)); th3 = tr_read(bb_ + 1024 + RS_BOFF(7)); \
            _Pragma("unroll") for (int mi = 0; mi < 4; ++mi) af[mi] = *(const LAS bf16x8*)(lds + GEMM_LDS_A + (buf) * 32768 + aoff + mi * 2048 + ks * 1024); \
            TR_WAIT8(tl0, th0, tl1, th1, tl2, th2, tl3, th3); \
            bf16x8 bfr[4]; \
            bfr[0] = (bf16x8){tl0[0], tl0[1], tl0[2], tl0[3], th0[0], th0[1], th0[2], th0[3]}; bfr[1] = (bf16x8){tl1[0], tl1[1], tl1[2], tl1[3], th1[0], th1[1], th1[2], th1[3]}; \
            bfr[2] = (bf16x8){tl2[0], tl2[1], tl2[2], tl2[3], th2[0], th2[1], th2[2], th2[3]}; bfr[3] = (bf16x8){tl3[0], tl3[1], tl3[2], tl3[3], th3[0], th3[1], th3[2], th3[3]}; \
            _Pragma("unroll") for (int mi = 0; mi < 4; ++mi) _Pragma("unroll") for (int ni = 0; ni < 4; ++ni) \
                acc[mi][ni] = __builtin_amdgcn_mfma_f32_16x16x32_bf16(bfr[ni], af[mi], acc[mi][ni], 0, 0, 0); } } while (0)
#define RS_STEP(CUR, NXT, A_LD, B_LD, A_WR, B_WR) do { \
        RS_LOAD(A_LD, B_LD); \
        __builtin_amdgcn_sched_barrier(0); \
        if (active) RS_COMPUTE(CUR); \
        __builtin_amdgcn_sched_barrier(0); \
        RS_WRITE(A_WR, B_WR, NXT); \
        if (++cK == nk) { \
            if (active) epi(cP, wr * 64 + fr, wc * 64 + fq * 4, cm, acc); \
            _Pragma("unroll") for (int i = 0; i < 4; ++i) _Pragma("unroll") for (int j = 0; j < 4; ++j) acc[i][j] = (f32x4){0.f, 0.f, 0.f, 0.f}; \
            cK = 0; ++cP; if (cP < npass) { cm = mrowsf(cP); active = (wr * 64) < cm; } \
        } \
        asm volatile("s_waitcnt lgkmcnt(0)" ::: "memory"); \
        asm volatile("" ::: "memory"); __builtin_amdgcn_s_barrier(); asm volatile("" ::: "memory"); ++s; } while (0)
    int cP = 0, cK = 0, cm = mrowsf(0);
    bool active = (wr * 64) < cm;
    RS_SETA(); bp = bcol(0, n4);
    RS_LOAD(aX, bX); RS_WRITE(aX, bX, 0);
    RS_LOAD(aY, bY);
    asm volatile("s_waitcnt lgkmcnt(0)" ::: "memory");
    __syncthreads();
    int s = 0;
    while (s < S) { RS_STEP(0, 1, aX, bX, aY, bY); if (s >= S) break; RS_STEP(1, 0, aY, bY, aX, bX); }
#undef RS_BOFF
#undef RS_SETA
#undef RS_LOAD
#undef RS_WRITE
#undef RS_COMPUTE
#undef RS_STEP
}

namespace pg8 {
#define PG8_LAS __attribute__((address_space(3)))
typedef unsigned short bf16_t;
typedef short bf16x8 __attribute__((ext_vector_type(8)));
typedef float f32x4 __attribute__((ext_vector_type(4)));
typedef unsigned u32x4 __attribute__((ext_vector_type(4)));
constexpr int BM = 256, BK = 64, HALF = 128, HTB = HALF * BK * 2  , STAGE_BYTES = 8 * HTB, NXCD = 8, WGM = 8;

__host__ __device__ __forceinline__ int lds_byte(int r, int c) { const int st = (r >> 4) * 2 + (c >> 5), rr = r & 15, cc = c & 31, ob = rr * 64 + cc * 2; return st * 1024 + (ob ^ (((ob >> 9) & 1) << 5)); }
__host__ __device__ __forceinline__ void stage_rc(int b, int& R, int& C) { const int st = b / 1024, sb = b % 1024, swz = sb ^ (((sb >> 9) & 1) << 5); R = (st >> 1) * 16 + swz / 64; C = (st & 1) * 32 + (swz % 64) / 2; }
__host__ __device__ __forceinline__ int perm32(int rho) { const int n = rho >> 4, i = rho & 15; return 8 * (i >> 2) + 4 * n + (i & 3); }

struct Unit { int pm, pn; };
struct Gemm { const bf16_t* A; const bf16_t* Bt; int M, N, K; };

struct StaticOrder {
    int nM, nN, nwg, G, c;
    __host__ __device__ void init(int M, int N, int G_, int c_) { nM = M / BM; nN = N / BM; nwg = nM * nN; G = G_; c = c_; }
    __host__ __device__ bool next(int i, Unit& u) const {
        const long L = (long)i * G + c; if (L >= nwg) return false;
        int wgid = (int)L; { const int q = nwg / NXCD, r = nwg % NXCD, xcd = wgid % NXCD, off = wgid / NXCD; wgid = (xcd < r ? xcd * (q + 1) : r * (q + 1) + (xcd - r) * q) + off; }
        const int nig = WGM * nN, gid = wgid / nig, fm = gid * WGM, gsz = (nM - fm) < WGM ? (nM - fm) : WGM;
        u.pm = fm + ((wgid % nig) % gsz); u.pn = (wgid % nig) / gsz; return true;
    }
    __device__ __forceinline__ void a_ready(const Unit&) const {}
    __device__ __forceinline__ void done(const Unit&) const {}
};
template <class Epi, class Sched>
__device__ __forceinline__ void gemm_phase(PG8_LAS unsigned char* lds, const Gemm g, const Sched& S, const Epi& E) {
    int tid_l = threadIdx.x; asm volatile("" : "+v"(tid_l));
    const int tid = tid_l, wid = __builtin_amdgcn_readfirstlane(tid >> 6), lane = tid & 63, wr = wid >> 2, wc = wid & 3, fr = lane & 15, fq = lane >> 4;
    const int K = g.K, nt = K / BK;

    unsigned voffA[2], voffB[2];
#pragma unroll
    for (int i = 0; i < 2; ++i) { int R, C; stage_rc(tid * 16 + i * 8192, R, C); const int Rb = Epi::PERM ? ((R & ~31) + perm32(R & 31)) : R;
        voffA[i] = (unsigned)(R * K + C) * 2u; voffB[i] = (unsigned)(Rb * K + C) * 2u; }
    const size_t kstep = (size_t)(BK * 2);
    const size_t hstep = (size_t)HALF * K * 2;
    const size_t tstep = 2 * hstep;
    const unsigned ldsw = (unsigned)wid * 1024u;
    const int aoff = lds_byte(wr * 64 + fr, fq * 8), boff = lds_byte(wc * 32 + fr, fq * 8);
#define PG8_SA(b, h) (((b) * 2 + (h)) * HTB)
#define PG8_SB(b, h) ((4 + (b) * 2 + (h)) * HTB)
#define PG8_STAGE(bufoff, gbase, voff) do { _Pragma("unroll") for (int _i = 0; _i < 2; ++_i) \
        __builtin_amdgcn_global_load_lds((const unsigned*)((const char*)(gbase) + (voff)[_i]), (PG8_LAS unsigned*)(lds + (bufoff) + ldsw + _i * 8192), 16, 0, 0); } while (0)
#define PG8_LDA(dst, b, h) do { _Pragma("unroll") for (int m = 0; m < 4; ++m) _Pragma("unroll") for (int k = 0; k < 2; ++k) dst[m][k] = *(const PG8_LAS bf16x8*)(lds + PG8_SA(b, h) + aoff + m * 2048 + k * 1024); } while (0)
#define PG8_LDB(dst, b, h) do { _Pragma("unroll") for (int n = 0; n < 2; ++n) _Pragma("unroll") for (int k = 0; k < 2; ++k) dst[n][k] = *(const PG8_LAS bf16x8*)(lds + PG8_SB(b, h) + boff + n * 2048 + k * 1024); } while (0)
#define PG8_MMA(ai, bj, At, Bt) do { __builtin_amdgcn_s_setprio(1); _Pragma("unroll") for (int m = 0; m < 4; ++m) _Pragma("unroll") for (int n = 0; n < 2; ++n) _Pragma("unroll") for (int k = 0; k < 2; ++k) \
        acc[ai][bj][m][n] = __builtin_amdgcn_mfma_f32_16x16x32_bf16(Bt[n][k], At[m][k], acc[ai][bj][m][n], 0, 0, 0); __builtin_amdgcn_s_setprio(0); } while (0)
#define PG8_WAIT_V(n) asm volatile("s_waitcnt vmcnt(" #n ")" ::: "memory")
#define PG8_WAIT_L(n) asm volatile("s_waitcnt lgkmcnt(" #n ")" ::: "memory")
#define PG8_BAR __builtin_amdgcn_s_barrier()
#define PG8_SCHED __builtin_amdgcn_sched_barrier(0)
    Unit cur, nxt; int ui = 0;
    if (!S.next(0, cur)) return;
    f32x4 acc[2][2][4][2];
#pragma unroll
    for (int a = 0; a < 2; ++a)
#pragma unroll
        for (int b = 0; b < 2; ++b)
#pragma unroll
            for (int m = 0; m < 4; ++m)
#pragma unroll
                for (int n = 0; n < 2; ++n) acc[a][b][m][n] = (f32x4){0.f, 0.f, 0.f, 0.f};
    bf16x8 At[4][2], B0[2][2], B1[2][2];
    const char* cA = (const char*)g.A + (size_t)cur.pm * tstep; const char* cB = (const char*)g.Bt + (size_t)cur.pn * tstep;
    S.a_ready(cur);
    PG8_STAGE(PG8_SB(0, 0), cB, voffB); PG8_STAGE(PG8_SA(0, 0), cA, voffA); PG8_STAGE(PG8_SB(0, 1), cB + hstep, voffB); PG8_STAGE(PG8_SA(0, 1), cA + hstep, voffA);
    if (wr == 1) PG8_BAR;
    PG8_WAIT_V(4); PG8_BAR;
    PG8_STAGE(PG8_SB(1, 0), cB + kstep, voffB); PG8_STAGE(PG8_SA(1, 0), cA + kstep, voffA); PG8_STAGE(PG8_SB(1, 1), cB + hstep + kstep, voffB);
    PG8_WAIT_V(6); PG8_BAR;

    for (;;) {
        const bool has_next = S.next(ui + 1, nxt);
        const char* nA = has_next ? (const char*)g.A + (size_t)nxt.pm * tstep : cA; const char* nB = has_next ? (const char*)g.Bt + (size_t)nxt.pn * tstep : cB;
        for (int t = 0; t < nt; t += 2) {
            const bool last = (t == nt - 2);
            const char* a1 = cA + (size_t)(t + 1) * kstep;
            const char* a2 = last ? nA : cA + (size_t)(t + 2) * kstep; const char* b2 = last ? nB : cB + (size_t)(t + 2) * kstep;
            const char* a3 = a2 + kstep; const char* b3 = b2 + kstep;
            if (last && has_next) S.a_ready(nxt);
            PG8_LDB(B0, 0, 0); PG8_SCHED; PG8_LDA(At, 0, 0); PG8_STAGE(PG8_SA(1, 1), a1 + hstep, voffA);
            PG8_WAIT_L(8); PG8_BAR; PG8_WAIT_L(0); PG8_MMA(0, 0, At, B0); PG8_BAR; PG8_SCHED;
            PG8_LDB(B1, 0, 1); PG8_STAGE(PG8_SB(0, 0), b2, voffB);
            PG8_BAR; PG8_WAIT_L(0); PG8_MMA(0, 1, At, B1); PG8_BAR;
            PG8_LDA(At, 0, 1); PG8_STAGE(PG8_SA(0, 0), a2, voffA);
            PG8_BAR; PG8_WAIT_L(0); PG8_MMA(1, 0, At, B0); PG8_BAR; PG8_SCHED;
            PG8_STAGE(PG8_SB(0, 1), b2 + hstep, voffB);
            PG8_WAIT_V(6); PG8_BAR; PG8_MMA(1, 1, At, B1); PG8_BAR;
            PG8_LDB(B0, 1, 0); PG8_SCHED; PG8_LDA(At, 1, 0); PG8_STAGE(PG8_SA(0, 1), a2 + hstep, voffA);
            PG8_WAIT_L(8); PG8_BAR; PG8_WAIT_L(0); PG8_MMA(0, 0, At, B0); PG8_BAR; PG8_SCHED;
            PG8_LDB(B1, 1, 1); PG8_STAGE(PG8_SB(1, 0), b3, voffB);
            PG8_BAR; PG8_WAIT_L(0); PG8_MMA(0, 1, At, B1); PG8_BAR;
            PG8_LDA(At, 1, 1); PG8_STAGE(PG8_SA(1, 0), a3, voffA);
            PG8_BAR; PG8_WAIT_L(0); PG8_MMA(1, 0, At, B0); PG8_BAR; PG8_SCHED;
            PG8_STAGE(PG8_SB(1, 1), b3 + hstep, voffB);
            PG8_WAIT_V(6); PG8_BAR; PG8_MMA(1, 1, At, B1); PG8_BAR;
        }

        if constexpr (!Epi::AFTER_DRAIN) { E(acc, cur, wr, wc, fr, fq); S.done(cur); }

        if (!has_next) break;
#pragma unroll
        for (int a = 0; a < 2; ++a)
#pragma unroll
            for (int b = 0; b < 2; ++b)
#pragma unroll
                for (int m = 0; m < 4; ++m)
#pragma unroll
                    for (int n = 0; n < 2; ++n) acc[a][b][m][n] = (f32x4){0.f, 0.f, 0.f, 0.f};
        cur = nxt; cA = nA; cB = nB; ++ui;
    }
    PG8_WAIT_V(0);
    if (wr == 0) PG8_BAR;
    PG8_BAR;
    if constexpr (Epi::AFTER_DRAIN) { E.fused(acc, cur, wr, wc, fr, fq, lds, wid, lane); S.done(cur); }

#undef PG8_SA
#undef PG8_SB
#undef PG8_STAGE
#undef PG8_LDA
#undef PG8_LDB
#undef PG8_MMA
#undef PG8_WAIT_V
#undef PG8_WAIT_L
#undef PG8_BAR
#undef PG8_SCHED
}
}
template <class F> struct EpiWrap {
    static constexpr bool PERM = false, AFTER_DRAIN = false; F f;
    __device__ __forceinline__ void operator()(const f32x4 (&acc)[2][2][4][2], const pg8::Unit& u, int wr, int wc, int fr, int fq) const { f(acc, u, wr, wc, fr, fq); }
};
template <class F> __device__ __forceinline__ EpiWrap<F> make_epi(F f) { return EpiWrap<F>{f}; }
template <class F> struct EpiWrapP {
    static constexpr bool PERM = true, AFTER_DRAIN = false; F f;
    __device__ __forceinline__ void operator()(const f32x4 (&acc)[2][2][4][2], const pg8::Unit& u, int wr, int wc, int fr, int fq) const { f(acc, u, wr, wc, fr, fq); }
};
template <class F> __device__ __forceinline__ EpiWrapP<F> make_epi_p(F f) { return EpiWrapP<F>{f}; }

__device__ __forceinline__ void transpose_item(const float* W, int K, int N, int Npad, bf16_t* WT, LAS float* scr, int item, int lane) {
    const int nblk = Npad / 32, kb = item / nblk, nb_ = item % nblk, k0 = 64 * kb, n0 = 32 * nb_;
#pragma unroll 8
    for (int i = 0; i < 32; ++i) { const int kk = 2 * i + (lane >> 5), n = n0 + (lane & 31); scr[kk * 33 + (lane & 31)] = n < N ? W[(size_t)(k0 + kk) * N + n] : 0.f; }
    asm volatile("s_waitcnt lgkmcnt(0)" ::: "memory");
    const int c = lane & 7;
#pragma unroll
    for (int j = 0; j < 4; ++j) { const int n = (lane >> 3) + 8 * j; const LAS float* sp = scr + (8 * c) * 33 + n;
        u32x4 o; o[0] = pk_bf16(sp[0 * 33], sp[1 * 33]); o[1] = pk_bf16(sp[2 * 33], sp[3 * 33]); o[2] = pk_bf16(sp[4 * 33], sp[5 * 33]); o[3] = pk_bf16(sp[6 * 33], sp[7 * 33]);
        *(u32x4*)(WT + (size_t)(n0 + n) * K + k0 + 8 * c) = o; }
    asm volatile("s_waitcnt lgkmcnt(0)" ::: "memory");
}

template <class ARow, class BCol, class MRows, class Epi>
__device__ __forceinline__ void gemm_stream_ws(LAS unsigned char* lds, const unsigned char* Abase, int npass, int nk, int ldb, ARow arow, BCol bcol, MRows mrowsf, Epi epi) {
    int tid_ = threadIdx.x; asm volatile("" : "+v"(tid_));
    const int tid = tid_, wid = __builtin_amdgcn_readfirstlane(tid >> 6), lane = tid & 63;
    if (npass <= 0) return;
    const int S = npass * nk;
#define WS_BAR() do { asm volatile("s_waitcnt lgkmcnt(0)" ::: "memory"); __builtin_amdgcn_s_barrier(); asm volatile("" ::: "memory"); } while (0)
    if (wid < 4) {
        const int wr2 = wid >> 1, wc = wid & 1, fr = lane & 15, fq = lane >> 4;
        const int aoff = wr2 * 16384 + ((fr * 64 + fq * 16) ^ ((fr >> 3) << 5));
        const int q = (lane >> 2) & 3, pp = lane & 3;
        const int b0 = (wc * 8 + (pp >> 1)) ^ ((q << 2) | (2 * (fq & 1)));
        const int browoff = 256 * (fq * 8 + q) + 8 * (pp & 1);
#define WS_BOFF(v) (browoff + 16 * (b0 ^ (v)))
        f32x4 acc[8][4];
#pragma unroll
        for (int i = 0; i < 8; ++i)
#pragma unroll
            for (int j = 0; j < 4; ++j) acc[i][j] = (f32x4){0.f, 0.f, 0.f, 0.f};
        int cP = 0, cK = 0, cm = mrowsf(0);
        bool active = (wr2 * 128) < cm;
#define WS_COMPUTE(buf) do { _Pragma("unroll") for (int ks = 0; ks < 2; ++ks) { \
            bf16x8 af[8]; s16x4 tl0, tl1, tl2, tl3, th0, th1, th2, th3; \
            LAS unsigned char* bb_ = lds + GEMM_LDS_B + (buf) * 16384 + ks * 8192; \
            tl0 = tr_read(bb_ + WS_BOFF(0)); th0 = tr_read(bb_ + 1024 + WS_BOFF(1)); tl1 = tr_read(bb_ + WS_BOFF(2)); th1 = tr_read(bb_ + 1024 + WS_BOFF(3)); \
            tl2 = tr_read(bb_ + WS_BOFF(4)); th2 = tr_read(bb_ + 1024 + WS_BOFF(5)); tl3 = tr_read(bb_ + WS_BOFF(6)); th3 = tr_read(bb_ + 1024 + WS_BOFF(7)); \
            _Pragma("unroll") for (int mi = 0; mi < 8; ++mi) af[mi] = *(const LAS bf16x8*)(lds + GEMM_LDS_A + (buf) * 32768 + aoff + mi * 2048 + ks * 1024); \
            TR_WAIT8(tl0, th0, tl1, th1, tl2, th2, tl3, th3); \
            bf16x8 bfr[4]; \
            bfr[0] = (bf16x8){tl0[0], tl0[1], tl0[2], tl0[3], th0[0], th0[1], th0[2], th0[3]}; bfr[1] = (bf16x8){tl1[0], tl1[1], tl1[2], tl1[3], th1[0], th1[1], th1[2], th1[3]}; \
            bfr[2] = (bf16x8){tl2[0], tl2[1], tl2[2], tl2[3], th2[0], th2[1], th2[2], th2[3]}; bfr[3] = (bf16x8){tl3[0], tl3[1], tl3[2], tl3[3], th3[0], th3[1], th3[2], th3[3]}; \
            _Pragma("unroll") for (int mi = 0; mi < 8; ++mi) _Pragma("unroll") for (int ni = 0; ni < 4; ++ni) \
                acc[mi][ni] = __builtin_amdgcn_mfma_f32_16x16x32_bf16(bfr[ni], af[mi], acc[mi][ni], 0, 0, 0); } } while (0)
#define WS_CSTEP(CUR) do { \
            if (active) WS_COMPUTE(CUR); \
            if (++cK == nk) { \
                if (active) epi(cP, wr2 * 128 + fr, wc * 64 + fq * 4, cm, acc); \
                _Pragma("unroll") for (int i = 0; i < 8; ++i) _Pragma("unroll") for (int j = 0; j < 4; ++j) acc[i][j] = (f32x4){0.f, 0.f, 0.f, 0.f}; \
                cK = 0; ++cP; if (cP < npass) { cm = mrowsf(cP); active = (wr2 * 128) < cm; } \
            } \
            WS_BAR(); ++s; } while (0)
        WS_BAR();
        int s = 0;
        while (s < S) { WS_CSTEP(0); if (s >= S) break; WS_CSTEP(1); }
#undef WS_BOFF
#undef WS_COMPUTE
#undef WS_CSTEP
    } else {
        const int pt = tid - 256;
        const int wv_ = pt >> 6, q_ = lane & 3, r8_ = (lane >> 2) & 7, hb_ = lane >> 5;
        const int Ccol = (hb_ * 4 + q_) * 16;
        const int Rbase = 8 * wv_ + r8_;
        unsigned asrc[8];
        const int n4 = pt & 31, kb8 = pt >> 5;
        const float* bp;
        int bwoff[2];
#pragma unroll
        for (int par = 0; par < 2; ++par) { const int row = kb8 + 8 * par; const int fB = ((row & 3) << 2) | ((row >> 2) & 3); bwoff[par] = 256 * row + 16 * ((n4 >> 1) ^ fB) + 8 * (n4 & 1); }
        const int awoff = (wv_ >> 1) * 2048 + hb_ * 1024 + (((((wv_ & 1) * 8 + r8_) * 64) + q_ * 16) ^ ((wv_ & 1) << 5));
        f32x4 bX[8], bY[8]; u32x4 aX[8], aY[8];
        int aP = 0, aK = 0, bP = 0, bK = 0;
#define WS_SETA() do { _Pragma("unroll") for (int _i = 0; _i < 8; ++_i) asrc[_i] = (unsigned)(arow(aP, Rbase + 32 * _i) + Ccol); } while (0)
#define WS_LOAD(AR, BR) do { \
            _Pragma("unroll") for (int _i = 0; _i < 8; ++_i) AR[_i] = *(const u32x4*)(Abase + (size_t)asrc[_i] + (size_t)aK * 128); \
            _Pragma("unroll") for (int _i = 0; _i < 8; ++_i) BR[_i] = *(const f32x4*)(bp + (size_t)(bK * 64 + kb8 + 8 * _i) * ldb); \
            if (++aK == nk) { aK = 0; if (aP + 1 < npass) { ++aP; WS_SETA(); } } \
            if (++bK == nk) { bK = 0; if (bP + 1 < npass) { ++bP; bp = bcol(bP, n4); } } } while (0)
#define WS_WRITE(AR, BR, buf) do { \
            _Pragma("unroll") for (int _i = 0; _i < 8; ++_i) *(LAS u32x4*)(lds + GEMM_LDS_A + (buf) * 32768 + _i * 4096 + awoff) = AR[_i]; \
            _Pragma("unroll") for (int _i = 0; _i < 8; ++_i) { u32x2 _w; _w.x = pk_bf16(BR[_i][0], BR[_i][1]); _w.y = pk_bf16(BR[_i][2], BR[_i][3]); \
                *(LAS u32x2*)(lds + GEMM_LDS_B + (buf) * 16384 + bwoff[_i & 1] + 4096 * (_i >> 1)) = _w; } } while (0)
#define WS_PSTEP(NXT, A_LD, B_LD, A_WR, B_WR) do { WS_LOAD(A_LD, B_LD); WS_WRITE(A_WR, B_WR, NXT); WS_BAR(); ++s; } while (0)
        WS_SETA(); bp = bcol(0, n4);
        WS_LOAD(aX, bX); WS_WRITE(aX, bX, 0);
        WS_LOAD(aY, bY);
        WS_BAR();
        int s = 0;
        while (s < S) { WS_PSTEP(1, aX, bX, aY, bY); if (s >= S) break; WS_PSTEP(0, aY, bY, aX, bX); }
#undef WS_SETA
#undef WS_LOAD
#undef WS_WRITE
#undef WS_PSTEP
    }
#undef WS_BAR
}

struct XcdDeal { int lo, step, n; };
#define TOPO_OFF (LDS_MISC + 16)
__device__ __forceinline__ XcdDeal xcd_deal(int U, const LAS unsigned char* lds, int nb) {
    const LAS int* tp_ = (const LAS int*)(lds + TOPO_OFF);
    const int px = tp_[0], cx = tp_[1], rank = tp_[2];
    XcdDeal d;
    const int xlo = (int)((long)px * U / nb), xhi = (int)((long)(px + cx) * U / nb);
    d.lo = xlo + rank; d.step = cx; d.n = (xhi - xlo - rank + cx - 1) / cx; if (d.n < 0) d.n = 0;
    return d;
}

__device__ __forceinline__ void phase0(const Params& p, int bid, int nb, float* smem, LAS unsigned char* smem_las) {
    const float* c = p.in[1]; const float* w_ada = p.in[2]; const float* b_ada = p.in[3];
    float* mod = (float*)(p.ws + WS_MOD);
    int tid_ = threadIdx.x; asm volatile("" : "+v"(tid_));
    const int tid = tid_;
    float* sc = smem;
    float* red = smem + 2048;
    for (int i = tid; i < 2048; i += NT) { const float cv = c[i]; sc[i] = cv / (1.f + expf(-cv)); }
    __syncthreads();
    {
        const int cq = tid & 7, kg = tid >> 3;
        for (int u = bid; u < 192; u += nb) {
            const float* wp = w_ada + (size_t)(kg * 16) * 6144 + u * 32 + cq * 4;
            f32x4 wv[16];
#pragma unroll
            for (int i = 0; i < 16; ++i) wv[i] = *(const f32x4*)(wp + (size_t)i * 6144);
            f32x4 a0 = (f32x4){0.f, 0.f, 0.f, 0.f}, a1 = (f32x4){0.f, 0.f, 0.f, 0.f};
#pragma unroll
            for (int i = 0; i < 16; ++i) { a0 += sc[kg * 16 + i] * wv[i]; a1 += sc[1024 + kg * 16 + i] * wv[i]; }
            *(f32x4*)(red + (kg * 2 + 0) * 32 + cq * 4) = a0; *(f32x4*)(red + (kg * 2 + 1) * 32 + cq * 4) = a1;
            __syncthreads();
            if (tid < 64) {
                const int bb = tid >> 5, col = tid & 31; float sacc = 0.f;
#pragma unroll 16
                for (int g2 = 0; g2 < 64; ++g2) sacc += red[(g2 * 2 + bb) * 32 + col];
                mod[bb * 6144 + u * 32 + col] = sacc + b_ada[u * 32 + col];
            }
            __syncthreads();
        }
    }
    {
        const float* conv_w = p.in[12]; const float* conv_b = p.in[13]; const float* wa = p.in[14]; const float* ba = p.in[15]; const float* wx = p.in[16]; const float* bx = p.in[17];
        float* BG = (float*)(p.ws + WS_BG); float* GB = (float*)(p.ws + WS_GBIAS);
        for (int idx = bid * NT + tid; idx < 8 * 256 * 128; idx += nb * NT) {
            const int n = idx & 127, k = (idx >> 7) & 255, hb = idx >> 15;
            const int w = k >> 6, i = k & 63, j = (n >> 6) * 32 + ((n >> 2) & 3) * 8 + ((n >> 4) & 1) * 4 + (n & 3);
            const float* W = ((n >> 5) & 1) ? wx : wa;
            BG[idx] = conv_w[w * 512 + hb * 64 + i] * W[(hb * 64 + i) * 64 + j];
        }
        for (int idx = ((bid + nb - (208 % nb)) % nb) * NT + tid; idx < 8 * 128; idx += nb * NT) {
            const int n = idx & 127, hb = idx >> 7, j = (n >> 6) * 32 + ((n >> 2) & 3) * 8 + ((n >> 4) & 1) * 4 + (n & 3);
            const bool isx = (n >> 5) & 1; const float* W = isx ? wx : wa;
            float acc = isx ? bx[hb * 64 + j] : ba[hb * 64 + j];
            for (int i = 0; i < 64; ++i) acc += conv_b[hb * 64 + i] * W[(hb * 64 + i) * 64 + j];
            GB[idx] = acc;
        }
        float* CB = (float*)(p.ws + WS_CBIAS); const float* pos = p.in[6];
        for (int idx = ((bid + nb - (192 % nb)) % nb) * NW + (tid >> 6); idx < 128; idx += nb * NW) {
            const int kv = idx >> 6, j = idx & 63; const float* w1 = kv ? p.in[9] : p.in[7];
            float acc = 0.f;
#pragma unroll 16
            for (int k = (tid & 63); k < 2048; k += 64) acc += pos[k] * w1[(size_t)k * 64 + j];
            acc = wave_sum(acc);
            if ((tid & 63) == 0) CB[idx] = acc;
        }
        bf16_t* XRB = (bf16_t*)(p.ws + WS_XRB);
        for (int idx = bid * NT + tid; idx < 16 * 3 * 64; idx += nb * NT) { const int sq = idx / 192, rem = idx % 192; XRB[(size_t)sq * SEQP * 64 + rem] = 0; }
    }
    {
        const f32x4* sp = (const f32x4*)p.in[23]; u32x2* dp = (u32x2*)(p.ws + WS_WRB);
        for (int i = bid * NT + tid; i < 1024 * 256 / 4; i += nb * NT) { const f32x4 v = sp[i]; u32x2 w; w.x = pk_bf16(v[0], v[1]); w.y = pk_bf16(v[2], v[3]); dp[i] = w; }
    }
    {
        LAS float* scr = (LAS float*)((LAS unsigned char*)smem_las + 16384 + (tid >> 6) * 8704);
        const int gw = bid * NW + (tid >> 6), ngw = nb * NW, lane_ = tid & 63;
        const int I1 = 16 * 80, I2 = 16 * 32;
        for (int it = gw; it < I1 + I2; it += ngw) {
            if (it < I1) transpose_item(p.in[5], 1024, NCOLS, 2560, (bf16_t*)(p.ws + WS_WINT), scr, it, lane_);
            else transpose_item(p.in[21], 1024, 1024, 1024, (bf16_t*)(p.ws + WS_WOUTT), scr, it - I1, lane_);
        }
    }
    float* lut = (float*)(p.ws + WS_LUT); const float* rel = p.in[11];
    for (int idx = bid * NT + tid; idx < 8 * 1024; idx += nb * NT) {
        const int h = idx >> 10, d = idx & 1023;
        int bucket;
        if (d < 16) bucket = d;
        else { const int l = 16 + (int)(logf((float)d / 16.0f) / 4.1588830833596715f * 16.0f); bucket = l < 31 ? l : 31; }
        lut[idx] = rel[bucket * 8 + h];
    }
}

template <bool SRC_BF16>
__device__ __forceinline__ void phase_modnorm(const Params& p, int bid, int nb, const void* src_, const float* nw, int sh_off, int sc_off, bf16_t* dstb) {
    const float* mod = (const float*)(p.ws + WS_MOD);
    int tid_ = threadIdx.x; asm volatile("" : "+v"(tid_));
    const int wave = tid_ >> 6, lane = tid_ & 63;
    const int RS = nb * NW;
    f32x4 w4[4];
#define MN_COL(i) (SRC_BF16 ? ((i) >> 1) * 512 + lane * 8 + ((i) & 1) * 4 : (i) * 256 + lane * 4)
#pragma unroll
    for (int i = 0; i < 4; ++i) w4[i] = *(const f32x4*)(nw + MN_COL(i));
    for (int row0 = bid * NW + wave; row0 < MTOK; row0 += 4 * RS) {
        f32x4 v[4][4];
#pragma unroll
        for (int k = 0; k < 4; ++k) {
            const int row = row0 + k * RS; const int rc = row < MTOK ? row : row0;
            if constexpr (SRC_BF16) {
                const u32x4* xr = (const u32x4*)((const bf16_t*)src_ + (size_t)rc * 1024) + lane;
                const u32x4 r0 = xr[0], r1 = xr[64];
#pragma unroll
                for (int j = 0; j < 4; ++j) { v[k][j >> 1][(j & 1) * 2] = __uint_as_float(r0[j] << 16); v[k][j >> 1][(j & 1) * 2 + 1] = __uint_as_float(r0[j] & 0xffff0000u);
                                              v[k][2 + (j >> 1)][(j & 1) * 2] = __uint_as_float(r1[j] << 16); v[k][2 + (j >> 1)][(j & 1) * 2 + 1] = __uint_as_float(r1[j] & 0xffff0000u); }
            } else {
                const float* xr = (const float*)src_ + (size_t)rc * 1024;
#pragma unroll
                for (int i = 0; i < 4; ++i) v[k][i] = *(const f32x4*)(xr + MN_COL(i));
            }
        }
#pragma unroll
        for (int k = 0; k < 4; ++k) {
            const int row = row0 + k * RS;
            if (row < MTOK) {
                const int b = row >> 13;
                float ss = 0.f;
#pragma unroll
                for (int i = 0; i < 4; ++i) ss += (v[k][i][0] * v[k][i][0] + v[k][i][1] * v[k][i][1]) + (v[k][i][2] * v[k][i][2] + v[k][i][3] * v[k][i][3]);
                ss = wave_sum(ss);
                const float rstd = __builtin_amdgcn_rsqf(ss * (1.f / 1024.f) + 1e-6f);
                u32x4 o[2];
#pragma unroll
                for (int i = 0; i < 4; ++i) {
                    const int ci = MN_COL(i);
                    const f32x4 sh = *(const f32x4*)(mod + b * 6144 + sh_off + ci), sc = *(const f32x4*)(mod + b * 6144 + sc_off + ci);
                    f32x4 h;
#pragma unroll
                    for (int j = 0; j < 4; ++j) h[j] = v[k][i][j] * rstd * w4[i][j] * (1.f + sc[j]) + sh[j];
                    o[i >> 1][(i & 1) * 2 + 0] = pk_bf16(h[0], h[1]); o[i >> 1][(i & 1) * 2 + 1] = pk_bf16(h[2], h[3]);
                }
                if constexpr (SRC_BF16) {
                    *(u32x4*)(dstb + (size_t)row * 1024 + lane * 8) = o[0];
                    *(u32x4*)(dstb + (size_t)row * 1024 + 512 + lane * 8) = o[1];
                } else {
#pragma unroll
                    for (int i = 0; i < 4; ++i) { u32x2 w; w.x = o[i >> 1][(i & 1) * 2]; w.y = o[i >> 1][(i & 1) * 2 + 1]; *(u32x2*)(dstb + (size_t)row * 1024 + MN_COL(i)) = w; }
                }
            }
        }
    }
#undef MN_COL
}

__device__ __forceinline__ void phase2_e(const Params& p, int bid, int nb, LAS unsigned char* lds) {
    bf16_t* QB = (bf16_t*)(p.ws + WS_QB); bf16_t* KV6 = (bf16_t*)(p.ws + WS_KV6); float* GATE = (float*)(p.ws + WS_GATE);
    bf16_t* XRB = (bf16_t*)(p.ws + WS_XRB); bf16_t* GRG = (bf16_t*)(p.ws + WS_GRG);
    pg8::Gemm g{(const pg8::bf16_t*)(p.ws + WS_H1B), (const pg8::bf16_t*)(p.ws + WS_WINT), MTOK, 2560, 1024};
    pg8::StaticOrder S; S.init(MTOK, 2560, nb, bid);
    auto E = make_epi_p([=](const f32x4 (&acc)[2][2][4][2], const pg8::Unit& u, int wr, int wc, int fr, int fq) {
#pragma unroll
        for (int ai = 0; ai < 2; ++ai)
#pragma unroll
            for (int mm = 0; mm < 4; ++mm) {
                const int m = u.pm * 256 + ai * 128 + wr * 64 + mm * 16 + fr;
#pragma unroll
                for (int bj = 0; bj < 2; ++bj) {
                    const int col = u.pn * 256 + bj * 128 + wc * 32 + fq * 8;
                    const f32x4 v0 = acc[ai][bj][mm][0], v1 = acc[ai][bj][mm][1];
                    if (col >= NCOLS) continue;
                    if (col < 512) {
                        const float sc = 0.125f * LOG2E; u32x4 w; w[0] = pk_bf16(v0[0] * sc, v0[1] * sc); w[1] = pk_bf16(v0[2] * sc, v0[3] * sc); w[2] = pk_bf16(v1[0] * sc, v1[1] * sc); w[3] = pk_bf16(v1[2] * sc, v1[3] * sc);
                        *(u32x4*)(QB + (size_t)m * 512 + col) = w;
                    } else if (col >= 1280 && col < 1304) {
                        f32x4 g0, g1;
#pragma unroll
                        for (int j = 0; j < 4; ++j) { g0[j] = sigm(v0[j]); g1[j] = sigm(v1[j]); }
                        *(f32x4*)(GATE + (size_t)m * 24 + (col - 1280)) = g0; *(f32x4*)(GATE + (size_t)m * 24 + (col - 1280) + 4) = g1;
                    } else if (col < 1280) {
                        const int c2 = col - 512, j6 = c2 >> 7, gg = (c2 >> 6) & 1, d = c2 & 63, bb = m >> 13, t = m & 8191;
                        u32x4 w; w[0] = pk_bf16(v0[0], v0[1]); w[1] = pk_bf16(v0[2], v0[3]); w[2] = pk_bf16(v1[0], v1[1]); w[3] = pk_bf16(v1[2], v1[3]);
                        *(u32x4*)(KV6 + (size_t)j6 * 2097152 + ((size_t)((bb * 2 + gg) * SEQ + t)) * 64 + d) = w;
                    } else if (col < 1816) {
                        const int c = col - 1304, hb = c >> 6, bb = m >> 13, t = m & 8191;
                        u32x4 w; w[0] = pk_bf16(v0[0], v0[1]); w[1] = pk_bf16(v0[2], v0[3]); w[2] = pk_bf16(v1[0], v1[1]); w[3] = pk_bf16(v1[2], v1[3]);
                        *(u32x4*)(XRB + ((size_t)(bb * 8 + hb) * SEQP + 3 + t) * 64 + (c & 63)) = w;
                    } else {
                        u32x4 w; w[0] = pk_bf16(gelu_t(v0[0]), gelu_t(v0[1])); w[1] = pk_bf16(gelu_t(v0[2]), gelu_t(v0[3])); w[2] = pk_bf16(gelu_t(v1[0]), gelu_t(v1[1])); w[3] = pk_bf16(gelu_t(v1[2]), gelu_t(v1[3]));
                        *(u32x4*)(GRG + (size_t)m * 512 + (col - 1816)) = w;
                    }
                }
            }
    });
    pg8::gemm_phase(lds, g, S, E);
}

__device__ __forceinline__ void phase5_e(const Params& p, int bid, int nb, LAS unsigned char* lds) {
    const float* x = p.in[0]; const float* mod = (const float*)(p.ws + WS_MOD); bf16_t* X1 = (bf16_t*)(p.ws + WS_X1);
    pg8::Gemm g{(const pg8::bf16_t*)(p.ws + WS_YB), (const pg8::bf16_t*)(p.ws + WS_WOUTT), MTOK, 1024, 1024};
    pg8::StaticOrder S; S.init(MTOK, 1024, nb, bid);
    auto E = make_epi_p([=](const f32x4 (&acc)[2][2][4][2], const pg8::Unit& u, int wr, int wc, int fr, int fq) {
        const int c0 = u.pn * 256 + wc * 32 + fq * 8;
        const int bb = (u.pm * 256) >> 13;
        f32x4 gv[2][2];
#pragma unroll
        for (int bj = 0; bj < 2; ++bj)
#pragma unroll
            for (int nn = 0; nn < 2; ++nn) gv[bj][nn] = *(const f32x4*)(mod + bb * 6144 + 2048 + c0 + bj * 128 + nn * 4);
#pragma unroll
        for (int ai = 0; ai < 2; ++ai) {
            f32x4 xv[4][2][2];
#pragma unroll
            for (int mm = 0; mm < 4; ++mm) {
                const size_t o = (size_t)(u.pm * 256 + ai * 128 + wr * 64 + mm * 16 + fr) * 1024 + c0;
#pragma unroll
                for (int bj = 0; bj < 2; ++bj)
#pragma unroll
                    for (int nn = 0; nn < 2; ++nn) xv[mm][bj][nn] = *(const f32x4*)(x + o + bj * 128 + nn * 4);
            }
#pragma unroll
            for (int mm = 0; mm < 4; ++mm) {
                const size_t o = (size_t)(u.pm * 256 + ai * 128 + wr * 64 + mm * 16 + fr) * 1024 + c0;
#pragma unroll
                for (int bj = 0; bj < 2; ++bj) {
                    const f32x4 r0 = xv[mm][bj][0] + gv[bj][0] * acc[ai][bj][mm][0], r1 = xv[mm][bj][1] + gv[bj][1] * acc[ai][bj][mm][1];
                    u32x4 w; w[0] = pk_bf16(r0[0], r0[1]); w[1] = pk_bf16(r0[2], r0[3]); w[2] = pk_bf16(r1[0], r1[1]); w[3] = pk_bf16(r1[2], r1[3]);
                    *(u32x4*)(X1 + o + bj * 128) = w;
                }
            }
        }
    });
    pg8::gemm_phase(lds, g, S, E);
}

#ifndef A4_PROBE_MASK
#define A4_PROBE_MASK 7
#endif
#define A4_KV 0
#define A4_SCORE 65536
#define A4_LUT 131200
#define LUTP 1156
#define A4_SELM 149760
__device__ __forceinline__ float ex2(float x) { return __builtin_amdgcn_exp2f(x); }

__device__ __forceinline__ float xmax_16_32(float v) {
    { auto r = __builtin_amdgcn_permlane16_swap(__float_as_uint(v), __float_as_uint(v), false, false); v = fmaxf(__uint_as_float(r[0]), __uint_as_float(r[1])); }
    { auto r = __builtin_amdgcn_permlane32_swap(__float_as_uint(v), __float_as_uint(v), false, false); v = fmaxf(__uint_as_float(r[0]), __uint_as_float(r[1])); }
    return v;
}
__device__ __forceinline__ float xsum_16_32(float v) {
    { auto r = __builtin_amdgcn_permlane16_swap(__float_as_uint(v), __float_as_uint(v), false, false); v = __uint_as_float(r[0]) + __uint_as_float(r[1]); }
    { auto r = __builtin_amdgcn_permlane32_swap(__float_as_uint(v), __float_as_uint(v), false, false); v = __uint_as_float(r[0]) + __uint_as_float(r[1]); }
    return v;
}


__device__ __forceinline__ void phase4_mfma(unsigned char* ws, int bid, int nb, LAS unsigned char* lds) {
    int tid_ = threadIdx.x; asm volatile("" : "+v"(tid_));
    const int tid = tid_, wid = __builtin_amdgcn_readfirstlane(tid >> 6), lane = tid & 63;
    const int col = lane & 15, tl = col >> 2, hd = col & 3, g4 = lane >> 4, fr = col;
    const bf16_t* QB = (const bf16_t*)(ws + WS_QB);
    const unsigned char* KV6 = ws + WS_KV6;
    const unsigned char* KCB = ws + WS_KCB; const unsigned char* VCB = ws + WS_VCB;
    const float* lutg = (const float*)(ws + WS_LUT);
    const float* GATE = (const float*)(ws + WS_GATE);
    float* OATT = (float*)(ws + WS_OATT);
    LAS float* lutl = (LAS float*)(lds + A4_LUT);
    LAS float* score = (LAS float*)(lds + A4_SCORE);
    LAS unsigned* selm = (LAS unsigned*)(lds + A4_SELM);
    const int koff0 = fr * 128 + 16 * ((g4) ^ (fr & 7)), koff1 = fr * 128 + 16 * ((4 + g4) ^ (fr & 7));
    const int q4 = (lane >> 2) & 3, pp = lane & 3, xk = (g4 & 1) * 4 + q4;
    int voff[4];
#pragma unroll
    for (int db = 0; db < 4; ++db) voff[db] = (g4 * 4 + q4) * 128 + 16 * ((db * 2 + (pp >> 1)) ^ xk) + 8 * (pp & 1);
    const int dr = tid >> 3, dsrc = dr * 128 + (((tid & 7) ^ (dr & 7)) * 16);

  \
#define A4_ISSUE(kbase, vbase, stage) do { int d_ = dsrc; asm volatile("" : "+v"(d_)); \
        __builtin_amdgcn_global_load_lds((const unsigned*)((kbase) + d_), (LAS unsigned*)(lds + A4_KV + (stage) * 16384 + wid * 1024), 16, 0, 0); \
        if (vbase) __builtin_amdgcn_global_load_lds((const unsigned*)((vbase) + d_), (LAS unsigned*)(lds + A4_KV + (stage) * 16384 + 8192 + wid * 1024), 16, 0, 0); } while (0)
#define A4_SYNC() do { asm volatile("s_waitcnt vmcnt(0)" ::: "memory"); __syncthreads(); } while (0)
#define A4_SYNC_RING(issued) do { asm volatile("s_waitcnt lgkmcnt(0)" ::: "memory"); if (issued) asm volatile("s_waitcnt vmcnt(2)" ::: "memory"); else asm volatile("s_waitcnt vmcnt(0)" ::: "memory"); \
        asm volatile("" ::: "memory"); __builtin_amdgcn_s_barrier(); asm volatile("" ::: "memory"); } while (0)

    for (int u2 = bid; u2 < 256; u2 += nb)
    for (int hf = 0; hf < 2; ++hf)
    for (int rep4 = 0; rep4 < ((REP & 64) ? 2 : 1); ++rep4) {
        const bool probe = rep4 > 0; const int amask = probe ? A4_PROBE_MASK : 7;
        const int bg = u2 >> 6, b = bg >> 1, g = bg & 1;
        const int T = hf ? 127 - (u2 & 63) : (u2 & 63);
        const int t0 = T * 64;
        const size_t seqbase = (size_t)(b * 2 + g) * SEQ;
        __syncthreads();
        {
#pragma unroll 1
            for (int hh = 0; hh < 4; ++hh) {
                float lv[3];
#pragma unroll
                for (int k = 0; k < 3; ++k) { const int dd = tid + k * NT; const int dc = dd < 1023 ? dd : 1023; lv[k] = lutg[(g * 4 + hh) * 1024 + dc]; }
#pragma unroll
                for (int k = 0; k < 3; ++k) { const int dd = tid + k * NT; if (dd < 1152) lutl[hh * LUTP + dd] = lv[k] * LOG2E; }
            }
        }
        if (!probe) for (int i = tid; i < 8192; i += NT) score[i] = 0.f;
        int tq[2]; tq[0] = t0 + 8 * wid + tl; tq[1] = tq[0] + 4;
        bf16x8 qf[2][2];
#pragma unroll
        for (int ct = 0; ct < 2; ++ct) {
            const size_t m = (size_t)b * SEQ + tq[ct];
#pragma unroll
            for (int h2 = 0; h2 < 2; ++h2) qf[ct][h2] = *(const bf16x8*)(QB + m * 512 + (g * 4 + hd) * 64 + h2 * 32 + g4 * 8);
        }
#define A4_GATEV(ct, br) (GATE[((size_t)b * SEQ + tq[ct]) * 24 + (g * 4 + hd) * 3 + (br)])
        __syncthreads();

        float mrun[2], lrun[2];
        f32x4 O[2][4];
        bf16x8 kf[4][2];
        f32x4 sv[4];
#define A4_LOADK(stage) do { _Pragma("unroll") for (int kt = 0; kt < 4; ++kt) { \
            kf[kt][0] = *(const LAS bf16x8*)(lds + A4_KV + (stage) * 16384 + kt * 2048 + koff0); \
            kf[kt][1] = *(const LAS bf16x8*)(lds + A4_KV + (stage) * 16384 + kt * 2048 + koff1); } } while (0)
#define A4_SCORES_I(ct, iv) do { _Pragma("unroll") for (int kt = 0; kt < 4; ++kt) { \
            sv[kt] = __builtin_amdgcn_mfma_f32_16x16x32_bf16(kf[kt][0], qf[ct][0], (f32x4){iv, iv, iv, iv}, 0, 0, 0); \
            sv[kt] = __builtin_amdgcn_mfma_f32_16x16x32_bf16(kf[kt][1], qf[ct][1], sv[kt], 0, 0, 0); } } while (0)
#define A4_SCORES(ct) do { _Pragma("unroll") for (int kt = 0; kt < 4; ++kt) { \
            sv[kt] = __builtin_amdgcn_mfma_f32_16x16x32_bf16(kf[kt][0], qf[ct][0], (f32x4){0.f, 0.f, 0.f, 0.f}, 0, 0, 0); \
            sv[kt] = __builtin_amdgcn_mfma_f32_16x16x32_bf16(kf[kt][1], qf[ct][1], sv[kt], 0, 0, 0); } } while (0)
#define A4_VREADS(stage, a, l0, h0, l1, h1, l2, h2, l3, h3) do { \
            LAS unsigned char* vb_ = lds + A4_KV + (stage) * 16384;        \
            l0 = tr_read_i<8192 + (a) * 4096>(vb_ + voff[0]); h0 = tr_read_i<8192 + (a) * 4096 + 2048>(vb_ + voff[0]); l1 = tr_read_i<8192 + (a) * 4096>(vb_ + voff[1]); h1 = tr_read_i<8192 + (a) * 4096 + 2048>(vb_ + voff[1]); \
            l2 = tr_read_i<8192 + (a) * 4096>(vb_ + voff[2]); h2 = tr_read_i<8192 + (a) * 4096 + 2048>(vb_ + voff[2]); l3 = tr_read_i<8192 + (a) * 4096>(vb_ + voff[3]); h3 = tr_read_i<8192 + (a) * 4096 + 2048>(vb_ + voff[3]); } while (0)
#define A4_PVMMA(ct, a, l0, h0, l1, h1, l2, h2, l3, h3) do { \
            u32x4 pw; pw[0] = pk_bf16(sv[2 * (a)][0], sv[2 * (a)][1]); pw[1] = pk_bf16(sv[2 * (a)][2], sv[2 * (a)][3]); \
            pw[2] = pk_bf16(sv[2 * (a) + 1][0], sv[2 * (a) + 1][1]); pw[3] = pk_bf16(sv[2 * (a) + 1][2], sv[2 * (a) + 1][3]); \
            const bf16x8 pf = __builtin_bit_cast(bf16x8, pw); \
            O[ct][0] = __builtin_amdgcn_mfma_f32_16x16x32_bf16((bf16x8){l0[0], l0[1], l0[2], l0[3], h0[0], h0[1], h0[2], h0[3]}, pf, O[ct][0], 0, 0, 0); \
            O[ct][1] = __builtin_amdgcn_mfma_f32_16x16x32_bf16((bf16x8){l1[0], l1[1], l1[2], l1[3], h1[0], h1[1], h1[2], h1[3]}, pf, O[ct][1], 0, 0, 0); \
            O[ct][2] = __builtin_amdgcn_mfma_f32_16x16x32_bf16((bf16x8){l2[0], l2[1], l2[2], l2[3], h2[0], h2[1], h2[2], h2[3]}, pf, O[ct][2], 0, 0, 0); \
            O[ct][3] = __builtin_amdgcn_mfma_f32_16x16x32_bf16((bf16x8){l3[0], l3[1], l3[2], l3[3], h3[0], h3[1], h3[2], h3[3]}, pf, O[ct][3], 0, 0, 0); } while (0)
#define A4_ONLINE_PV(ct, stage) do { \
            s16x4 va0, va1, va2, va3, va4, va5, va6, va7; \
            A4_VREADS(stage, 0, va0, va1, va2, va3, va4, va5, va6, va7); \
            s16x4 vb0, vb1, vb2, vb3, vb4, vb5, vb6, vb7; \
            A4_VREADS(stage, 1, vb0, vb1, vb2, vb3, vb4, vb5, vb6, vb7); \
            const float lmx = max3f(max3f(max3f(sv[0][0], sv[0][1], sv[0][2]), max3f(sv[0][3], sv[1][0], sv[1][1]), sv[3][3]), \
                                    max3f(sv[1][2], sv[1][3], sv[2][0]), max3f(max3f(sv[2][1], sv[2][2], sv[2][3]), max3f(sv[3][0], sv[3][1], sv[3][2]), -INF)); \
            const bool fresh_ = (mrun[ct] == -INF); \
            if (__builtin_amdgcn_ballot_w64((lmx > 8.0f) || fresh_) != 0ull) { \
                const float cmx = xmax_16_32(lmx); \
                const bool mv_ = ((cmx > 8.0f) || fresh_) && (cmx != -INF); \
                const float dl_ = mv_ ? cmx : 0.f; \
                const float scl = (mv_ && !fresh_) ? ex2(-cmx) : 1.f; \
                mrun[ct] = mv_ ? ((fresh_ ? 0.f : mrun[ct]) + cmx) : mrun[ct]; \
                _Pragma("unroll") for (int kt = 0; kt < 4; ++kt) sv[kt] -= dl_; \
                lrun[ct] *= scl; \
                if (__builtin_amdgcn_ballot_w64(scl != 1.f) != 0ull) { _Pragma("unroll") for (int db = 0; db < 4; ++db) O[ct][db] *= scl; } \
            } \
            _Pragma("unroll") for (int kt = 0; kt < 4; ++kt) { _Pragma("unroll") for (int j = 0; j < 4; ++j) sv[kt][j] = ex2(sv[kt][j]); } \
            const f32x4 ls4 = (sv[0] + sv[1]) + (sv[2] + sv[3]); const float ls = (ls4[0] + ls4[1]) + (ls4[2] + ls4[3]); \
            lrun[ct] += ls; \
            TR_WAIT8(va0, va1, va2, va3, va4, va5, va6, va7); \
            A4_PVMMA(ct, 0, va0, va1, va2, va3, va4, va5, va6, va7); \
            TR_WAIT8(vb0, vb1, vb2, vb3, vb4, vb5, vb6, vb7); \
            A4_PVMMA(ct, 1, vb0, vb1, vb2, vb3, vb4, vb5, vb6, vb7); } while (0)
#define A4_MF(a_, b_, c_) __builtin_amdgcn_mfma_f32_16x16x32_bf16(a_, b_, c_, 0, 0, 0)
#define A4_SB() __builtin_amdgcn_sched_barrier(0)
#define A4_SCORES_V(ct, iv, stage) \
            s16x4 va0, va1, va2, va3, va4, va5, va6, va7, vb0, vb1, vb2, vb3, vb4, vb5, vb6, vb7; \
            { LAS unsigned char* vb_ = lds + A4_KV + (stage) * 16384; const f32x4 i4_ = (f32x4){iv, iv, iv, iv}; \
              sv[0] = A4_MF(kf[0][0], qf[ct][0], i4_); va0 = tr_read_i<8192>(vb_ + voff[0]); va1 = tr_read_i<8192 + 2048>(vb_ + voff[0]); A4_SB(); \
              sv[1] = A4_MF(kf[1][0], qf[ct][0], i4_); va2 = tr_read_i<8192>(vb_ + voff[1]); va3 = tr_read_i<8192 + 2048>(vb_ + voff[1]); A4_SB(); \
              sv[2] = A4_MF(kf[2][0], qf[ct][0], i4_); va4 = tr_read_i<8192>(vb_ + voff[2]); va5 = tr_read_i<8192 + 2048>(vb_ + voff[2]); A4_SB(); \
              sv[3] = A4_MF(kf[3][0], qf[ct][0], i4_); va6 = tr_read_i<8192>(vb_ + voff[3]); va7 = tr_read_i<8192 + 2048>(vb_ + voff[3]); A4_SB(); \
              sv[0] = A4_MF(kf[0][1], qf[ct][1], sv[0]); vb0 = tr_read_i<12288>(vb_ + voff[0]); vb1 = tr_read_i<12288 + 2048>(vb_ + voff[0]); A4_SB(); \
              sv[1] = A4_MF(kf[1][1], qf[ct][1], sv[1]); vb2 = tr_read_i<12288>(vb_ + voff[1]); vb3 = tr_read_i<12288 + 2048>(vb_ + voff[1]); A4_SB(); \
              sv[2] = A4_MF(kf[2][1], qf[ct][1], sv[2]); vb4 = tr_read_i<12288>(vb_ + voff[2]); vb5 = tr_read_i<12288 + 2048>(vb_ + voff[2]); A4_SB(); \
              sv[3] = A4_MF(kf[3][1], qf[ct][1], sv[3]); vb6 = tr_read_i<12288>(vb_ + voff[3]); vb7 = tr_read_i<12288 + 2048>(vb_ + voff[3]); A4_SB(); }
#define A4_V8(l_, h_) ((bf16x8){l_[0], l_[1], l_[2], l_[3], h_[0], h_[1], h_[2], h_[3]})
#define A4_KLD(kns, kt, off) (*(const LAS bf16x8*)(lds + A4_KV + (kns) * 16384 + (kt) * 2048 + (off)))
#define A4_SOFTMAX_PV_K(ct, kns) do { \
            const float lmx = max3f(max3f(max3f(sv[0][0], sv[0][1], sv[0][2]), max3f(sv[0][3], sv[1][0], sv[1][1]), sv[3][3]), \
                                    max3f(sv[1][2], sv[1][3], sv[2][0]), max3f(max3f(sv[2][1], sv[2][2], sv[2][3]), max3f(sv[3][0], sv[3][1], sv[3][2]), -INF)); \
            const bool fresh_ = (mrun[ct] == -INF); \
            if (__builtin_amdgcn_ballot_w64((lmx > 8.0f) || fresh_) != 0ull) { \
                const float cmx = xmax_16_32(lmx); \
                const bool mv_ = ((cmx > 8.0f) || fresh_) && (cmx != -INF); \
                const float dl_ = mv_ ? cmx : 0.f; \
                const float scl = (mv_ && !fresh_) ? ex2(-cmx) : 1.f; \
                mrun[ct] = mv_ ? ((fresh_ ? 0.f : mrun[ct]) + cmx) : mrun[ct]; \
                _Pragma("unroll") for (int kt = 0; kt < 4; ++kt) sv[kt] -= dl_; \
                lrun[ct] *= scl; \
                if (__builtin_amdgcn_ballot_w64(scl != 1.f) != 0ull) { _Pragma("unroll") for (int db = 0; db < 4; ++db) O[ct][db] *= scl; } \
            } \
              \
            _Pragma("unroll") for (int kt = 0; kt < 2; ++kt) { _Pragma("unroll") for (int j = 0; j < 4; ++j) sv[kt][j] = ex2(sv[kt][j]); \
                if ((kns) >= 0) { kf[kt][0] = A4_KLD(kns, kt, koff0); kf[kt][1] = A4_KLD(kns, kt, koff1); } A4_SB(); } \
            u32x4 pwa, pwb; \
            pwa[0] = pk_bf16(sv[0][0], sv[0][1]); pwa[1] = pk_bf16(sv[0][2], sv[0][3]); pwa[2] = pk_bf16(sv[1][0], sv[1][1]); pwa[3] = pk_bf16(sv[1][2], sv[1][3]); \
            const bf16x8 pfa = __builtin_bit_cast(bf16x8, pwa); \
            asm volatile("s_waitcnt lgkmcnt(0)" : "+v"(va0), "+v"(va1), "+v"(va2), "+v"(va3), "+v"(va4), "+v"(va5), "+v"(va6), "+v"(va7), \
                         "+v"(vb0), "+v"(vb1), "+v"(vb2), "+v"(vb3), "+v"(vb4), "+v"(vb5), "+v"(vb6), "+v"(vb7) :: "memory"); \
            A4_SB(); \
            O[ct][0] = A4_MF(A4_V8(va0, va1), pfa, O[ct][0]); sv[2][0] = ex2(sv[2][0]); sv[2][1] = ex2(sv[2][1]); asm volatile("" : "+v"(sv[2])); if ((kns) >= 0) kf[2][0] = A4_KLD(kns, 2, koff0); A4_SB(); \
            O[ct][1] = A4_MF(A4_V8(va2, va3), pfa, O[ct][1]); sv[2][2] = ex2(sv[2][2]); sv[2][3] = ex2(sv[2][3]); asm volatile("" : "+v"(sv[2])); if ((kns) >= 0) kf[2][1] = A4_KLD(kns, 2, koff1); A4_SB(); \
            O[ct][2] = A4_MF(A4_V8(va4, va5), pfa, O[ct][2]); sv[3][0] = ex2(sv[3][0]); sv[3][1] = ex2(sv[3][1]); asm volatile("" : "+v"(sv[3])); if ((kns) >= 0) kf[3][0] = A4_KLD(kns, 3, koff0); A4_SB(); \
            O[ct][3] = A4_MF(A4_V8(va6, va7), pfa, O[ct][3]); sv[3][2] = ex2(sv[3][2]); sv[3][3] = ex2(sv[3][3]); asm volatile("" : "+v"(sv[3])); if ((kns) >= 0) kf[3][1] = A4_KLD(kns, 3, koff1); A4_SB(); \
            pwb[0] = pk_bf16(sv[2][0], sv[2][1]); pwb[1] = pk_bf16(sv[2][2], sv[2][3]); pwb[2] = pk_bf16(sv[3][0], sv[3][1]); pwb[3] = pk_bf16(sv[3][2], sv[3][3]); \
            const bf16x8 pfb = __builtin_bit_cast(bf16x8, pwb); \
            const f32x4 ls4 = (sv[0] + sv[1]) + (sv[2] + sv[3]); const float ls = (ls4[0] + ls4[1]) + (ls4[2] + ls4[3]); \
            lrun[ct] += ls; \
            O[ct][0] = A4_MF(A4_V8(vb0, vb1), pfb, O[ct][0]); \
            O[ct][1] = A4_MF(A4_V8(vb2, vb3), pfb, O[ct][1]); \
            O[ct][2] = A4_MF(A4_V8(vb4, vb5), pfb, O[ct][2]); \
            O[ct][3] = A4_MF(A4_V8(vb6, vb7), pfb, O[ct][3]); A4_SB(); } while (0)
#define A4_PV(ct, stage) do { \
            s16x4 va0, va1, va2, va3, va4, va5, va6, va7; \
            A4_VREADS(stage, 0, va0, va1, va2, va3, va4, va5, va6, va7); \
            TR_WAIT8(va0, va1, va2, va3, va4, va5, va6, va7); \
            A4_PVMMA(ct, 0, va0, va1, va2, va3, va4, va5, va6, va7); \
            A4_VREADS(stage, 1, va0, va1, va2, va3, va4, va5, va6, va7); \
            TR_WAIT8(va0, va1, va2, va3, va4, va5, va6, va7); \
            A4_PVMMA(ct, 1, va0, va1, va2, va3, va4, va5, va6, va7); } while (0)
#define A4_RESET() do { _Pragma("unroll") for (int ct = 0; ct < 2; ++ct) { mrun[ct] = -INF; lrun[ct] = 0.f; \
            _Pragma("unroll") for (int db = 0; db < 4; ++db) O[ct][db] = (f32x4){0.f, 0.f, 0.f, 0.f}; } } while (0)
#define A4_FINISH(br, first) do { float gv_[2]; f32x4 pv_[2][4]; float* op_[2]; \
          \
          \
          \
        const int odd_ = hd & 1; \
        _Pragma("unroll") for (int ct = 0; ct < 2; ++ct) { gv_[ct] = A4_GATEV(ct, br); op_[ct] = OATT + ((size_t)b * SEQ + tq[ct]) * 512 + (g * 4 + (hd & ~1)) * 64 + odd_ * 16 + g4 * 4; \
            if (!(first)) { _Pragma("unroll") for (int dp = 0; dp < 2; ++dp) { pv_[ct][2 * dp] = *(const f32x4*)(op_[ct] + dp * 32); pv_[ct][2 * dp + 1] = *(const f32x4*)(op_[ct] + dp * 32 + 64); } } } \
        _Pragma("unroll") for (int ct = 0; ct < 2; ++ct) { \
            float lt = lrun[ct]; lt = xsum_16_32(lt); \
            const float wv = gv_[ct] / fmaxf(lt, 1e-30f); \
            _Pragma("unroll") for (int dp = 0; dp < 2; ++dp) { const f32x4 r0 = O[ct][2 * dp] * wv, r1 = O[ct][2 * dp + 1] * wv; f32x4 dA, dB; \
                _Pragma("unroll") for (int j = 0; j < 4; ++j) { const float snd = odd_ ? r0[j] : r1[j]; const float rcv = quad_xor1(snd); dA[j] = odd_ ? rcv : r0[j]; dB[j] = odd_ ? r1[j] : rcv; } \
                if (!(first)) { dA += pv_[ct][2 * dp]; dB += pv_[ct][2 * dp + 1]; } \
                *(f32x4*)(op_[ct] + dp * 32) = dA; *(f32x4*)(op_[ct] + dp * 32 + 64) = dB; } } } while (0)

        if (amask & 1) {
            const unsigned char* KW = KV6 + (size_t)4 * 4194304 + seqbase * 128; const unsigned char* VW = KV6 + (size_t)5 * 4194304 + seqbase * 128;
            A4_RESET();
            const int s0 = T >= 8 ? 0 : 8 - T;
            { const int jb = T - 8 + s0; A4_ISSUE(KW + (size_t)jb * 8192, VW + (size_t)jb * 8192, 0);
              if (s0 < 8) { A4_ISSUE(KW + (size_t)(jb + 1) * 8192, VW + (size_t)(jb + 1) * 8192, 1); asm volatile("s_waitcnt vmcnt(2)" ::: "memory"); } else asm volatile("s_waitcnt vmcnt(0)" ::: "memory");
              __syncthreads(); }
            int stage = 0;
            for (int s = s0; s <= 8; ++s) {
                const int jb = T - 8 + s;
                const bool iss = (s + 2 <= 8);
                if (iss) { const int st2 = stage >= 1 ? stage - 1 : 2; const unsigned char* kn = KW + (size_t)(jb + 2) * 8192; const unsigned char* vn = VW + (size_t)(jb + 2) * 8192; A4_ISSUE(kn, vn, st2); }
                A4_LOADK(stage);
#pragma unroll
                for (int ct = 0; ct < 2; ++ct) {
                    { const float rf_ = (mrun[ct] == -INF) ? 0.f : mrun[ct]; A4_SCORES_I(ct, -rf_); }
                    __builtin_amdgcn_sched_barrier(0);
                    const int t = tq[ct];
                    {
                        const int base = t - jb * 64 - g4 * 4;
                        const LAS float* lp = lutl + hd * LUTP + base - 51;
                        const bool edge = (s == 0) || (s == 8);
                        f32x4 bs[4];
#pragma unroll
                        for (int kt = 0; kt < 4; ++kt)
#pragma unroll
                            for (int j = 0; j < 4; ++j) bs[kt][j] = lp[51 - kt * 16 - j];
                        asm volatile("" : "+v"(bs[0]), "+v"(bs[1]), "+v"(bs[2]), "+v"(bs[3]));
#pragma unroll
                        for (int kt = 0; kt < 4; ++kt) sv[kt] += bs[kt];
                        if (edge) {
#pragma unroll
                            for (int kt = 0; kt < 4; ++kt)
#pragma unroll
                                for (int j = 0; j < 4; ++j) { const int dist = base - kt * 16 - j; sv[kt][j] = ((dist >= 0) && (dist < 512)) ? sv[kt][j] : -INF; }
                        }
                    }
                    A4_ONLINE_PV(ct, stage);
                    __builtin_amdgcn_sched_barrier(0);
                }
                A4_SYNC_RING(iss);
                stage = stage == 2 ? 0 : stage + 1;
            }
            if (!probe) A4_FINISH(2, true);
        }
        if (amask & 2) {
            const unsigned char* KC = KCB + (size_t)(b * 2 + g) * 512 * 128; const unsigned char* VC = VCB + (size_t)(b * 2 + g) * 512 * 128;
            int ncmp = 4 * T + 3; if (ncmp > NCMP) ncmp = NCMP;
            const int nblk = (ncmp + 63) >> 6;
            A4_RESET();
            A4_ISSUE(KC, (const unsigned char*)nullptr, 0);
            A4_SYNC();
            for (int s = 0; s < nblk; ++s) {
                const int stage = s & 1;
                if (s + 1 < nblk) A4_ISSUE(KC + (size_t)(s + 1) * 8192, (const unsigned char*)nullptr, stage ^ 1);
                A4_LOADK(stage);
#pragma unroll
                for (int ct = 0; ct < 2; ++ct) {
                    A4_SCORES(ct);
                    __builtin_amdgcn_sched_barrier(0);
                    const int t = tq[ct];
                    float mx = -INF;
                    f32x4 bsa[4];
#pragma unroll
                    for (int kt = 0; kt < 4; ++kt)
#pragma unroll
                        for (int j = 0; j < 4; ++j) { int dist = t - (16 * (s * 64 + kt * 16 + g4 * 4 + j) + 31); dist = dist < 1023 ? dist : 1023; bsa[kt][j] = lutl[hd * LUTP + (dist & 1023)]; }
                    asm volatile("" : "+v"(bsa[0]), "+v"(bsa[1]), "+v"(bsa[2]), "+v"(bsa[3]));
#pragma unroll
                    for (int kt = 0; kt < 4; ++kt) {
#pragma unroll
                        for (int j = 0; j < 4; ++j) {
                            const int n = s * 64 + kt * 16 + g4 * 4 + j; const int dist = t - (16 * n + 31);
                            const bool ok = (dist >= 0) && (n < NCMP);
                            sv[kt][j] = ok ? sv[kt][j] + bsa[kt][j] : -INF; mx = fmaxf(mx, sv[kt][j]);
                        }
                    }
                    mx = xmax_16_32(mx);
                    const float mnew = fmaxf(mrun[ct], mx); const float muse = (mnew == -INF) ? 0.f : mnew;
                    const float scl = ex2(mrun[ct] - muse); mrun[ct] = mnew;
                    float ls = 0.f;
#pragma unroll
                    for (int kt = 0; kt < 4; ++kt)
#pragma unroll
                        for (int j = 0; j < 4; ++j) ls += ex2(sv[kt][j] - muse);
                    lrun[ct] = lrun[ct] * scl + ls;
                    __builtin_amdgcn_sched_barrier(0);
                }
                A4_SYNC();
            }
            float mfin[2], linv[2];
#pragma unroll
            for (int ct = 0; ct < 2; ++ct) {
                float lt = lrun[ct]; lt = xsum_16_32(lt);
                linv[ct] = 1.f / fmaxf(lt, 1e-30f); mfin[ct] = (mrun[ct] == -INF) ? 0.f : mrun[ct];
            }
            A4_ISSUE(KC, VC, 0);
            A4_SYNC();
            for (int s = 0; s < nblk; ++s) {
                const int stage = s & 1;
                if (s + 1 < nblk) { const unsigned char* kn = KC + (size_t)(s + 1) * 8192; const unsigned char* vn = VC + (size_t)(s + 1) * 8192; A4_ISSUE(kn, vn, stage ^ 1); }
                A4_LOADK(stage);
#pragma unroll
                for (int ct = 0; ct < 2; ++ct) {
                    A4_SCORES(ct);
                    __builtin_amdgcn_sched_barrier(0);
                    const int t = tq[ct];
                    f32x4 bsa[4];
#pragma unroll
                    for (int kt = 0; kt < 4; ++kt)
#pragma unroll
                        for (int j = 0; j < 4; ++j) { int dist = t - (16 * (s * 64 + kt * 16 + g4 * 4 + j) + 31); dist = dist < 1023 ? dist : 1023; bsa[kt][j] = lutl[hd * LUTP + (dist & 1023)]; }
                    asm volatile("" : "+v"(bsa[0]), "+v"(bsa[1]), "+v"(bsa[2]), "+v"(bsa[3]));
#pragma unroll
                    for (int kt = 0; kt < 4; ++kt) {
#pragma unroll
                        for (int j = 0; j < 4; ++j) {
                            const int n = s * 64 + kt * 16 + g4 * 4 + j; const int dist = t - (16 * n + 31);
                            const bool ok = (dist >= 0) && (n < NCMP);
                            sv[kt][j] = ok ? ex2(sv[kt][j] + bsa[kt][j] - mfin[ct]) * linv[ct] : 0.f;
                        }
                        float s4 = (sv[kt][0] + sv[kt][1]) + (sv[kt][2] + sv[kt][3]); float s3 = sv[kt][3];
                        s4 += quad_xor1(s4); s4 += quad_xor2(s4); s3 += quad_xor1(s3); s3 += quad_xor2(s3);
                        const int a = s * 16 + kt * 4 + g4;
                        if (hd == 0 && !probe) {
                            LAS float* sp = score + (8 * wid + 4 * ct + tl) * 128 + a;
                            (void)__hip_atomic_fetch_add(sp, s4, __ATOMIC_RELAXED, __HIP_MEMORY_SCOPE_WORKGROUP);
                            if (a + 1 < 128) (void)__hip_atomic_fetch_add(sp + 1, s3, __ATOMIC_RELAXED, __HIP_MEMORY_SCOPE_WORKGROUP);
                        }
                    }
                    A4_PV(ct, stage);
                    __builtin_amdgcn_sched_barrier(0);
                }
                A4_SYNC();
            }
            if (!probe) {
                float gv_[2]; f32x4 pv_[2][4]; float* op_[2];
#pragma unroll
                for (int ct = 0; ct < 2; ++ct) {
                    gv_[ct] = A4_GATEV(ct, 0); op_[ct] = OATT + ((size_t)b * SEQ + tq[ct]) * 512 + (g * 4 + hd) * 64 + g4 * 4;
#pragma unroll
                    for (int db = 0; db < 4; ++db) pv_[ct][db] = *(const f32x4*)(op_[ct] + db * 16);
                }
#pragma unroll
                for (int ct = 0; ct < 2; ++ct)
#pragma unroll
                    for (int db = 0; db < 4; ++db) *(f32x4*)(op_[ct] + db * 16) = O[ct][db] * gv_[ct] + pv_[ct][db];
            }
        }
        __syncthreads();
        if (!probe)
        for (int tt = 0; tt < 8; ++tt) {
            const int ti = 8 * wid + tt;
            const int j0 = lane, j1 = lane + 64;
            bool sel0, sel1;
            if (T <= 15) { sel0 = j0 <= T; sel1 = false; }
            else {
                const bool c0 = (j0 >= 1) && (j0 <= T - 2), c1 = (j1 <= T - 2);
                const float s0 = c0 ? score[ti * 128 + j0] : -INF, s1 = c1 ? score[ti * 128 + j1] : -INF;
                const unsigned u0 = c0 ? __float_as_uint(s0) : 0u, u1 = c1 ? __float_as_uint(s1) : 0u;
                unsigned thr = 0u;
#pragma unroll
                for (int bit = 30; bit >= 0; --bit) {
                    const unsigned cand = thr | (1u << bit);
                    const int cnt = __builtin_popcountll(__ballot(u0 >= cand)) + __builtin_popcountll(__ballot(u1 >= cand));
                    thr = cnt >= 13 ? cand : thr;
                }
                bool f0 = c0 && u0 >= thr, f1 = c1 && u1 >= thr;
                if (__builtin_popcountll(__ballot(f0)) + __builtin_popcountll(__ballot(f1)) > 13) {
                    int r0 = 0, r1 = 0;
                    for (int j2 = 1; j2 <= T - 2; ++j2) { const float v = score[ti * 128 + j2]; r0 += (v > s0) || (v == s0 && j2 < j0); r1 += (v > s1) || (v == s1 && j2 < j1); }
                    f0 = c0 && r0 < 13; f1 = c1 && r1 < 13;
                }
                sel0 = f0 || (j0 == 0) || (j0 == T) || (j0 == T - 1);
                sel1 = f1 || (j1 == T) || (j1 == T - 1);
            }
            const unsigned long long b0 = __ballot(sel0), b1 = __ballot(sel1);
            if (lane == 0) { selm[ti * 4 + 0] = (unsigned)b0; selm[ti * 4 + 1] = (unsigned)(b0 >> 32); selm[ti * 4 + 2] = (unsigned)b1; selm[ti * 4 + 3] = (unsigned)(b1 >> 32); }
        }
        __builtin_amdgcn_wave_barrier();
        asm volatile("s_waitcnt lgkmcnt(0)" ::: "memory");
        if (amask & 4) {
            const unsigned char* KS = KV6 + (size_t)2 * 4194304 + seqbase * 128; const unsigned char* VS = KV6 + (size_t)3 * 4194304 + seqbase * 128;
            unsigned un[2][4];
#pragma unroll
            for (int ct = 0; ct < 2; ++ct)
#pragma unroll
                for (int w = 0; w < 4; ++w) {
                    unsigned uu = selm[(8 * wid + 4 * ct + 0) * 4 + w] | selm[(8 * wid + 4 * ct + 1) * 4 + w] | selm[(8 * wid + 4 * ct + 2) * 4 + w] | selm[(8 * wid + 4 * ct + 3) * 4 + w];
                    un[ct][w] = __builtin_amdgcn_readfirstlane(uu);
                }
            A4_RESET();
            const float cbfar = lutl[hd * LUTP + 1023];
            __syncthreads();
#pragma unroll
            for (int bq = 0; bq < 4; ++bq) if (bq <= T) { const unsigned char* kn = KS + (size_t)bq * 8192; const unsigned char* vn = VS + (size_t)bq * 8192; A4_ISSUE(kn, vn, bq); }
            A4_SYNC();
#pragma unroll
            for (int w = 0; w < 4; ++w) {
                const unsigned selw0 = selm[(8 * wid + tl) * 4 + w], selw1 = selm[(8 * wid + 4 + tl) * 4 + w];
                for (int gg = 0; gg < 8; ++gg) {
                    const int j0 = w * 32 + gg * 4;
                    if (j0 > T) break;
#pragma unroll
                    for (int bq = 0; bq < 4; ++bq) { const int jn = j0 + 4 + bq; if (jn <= T) { const unsigned char* kn = KS + (size_t)jn * 8192; const unsigned char* vn = VS + (size_t)jn * 8192; A4_ISSUE(kn, vn, (jn & 7)); } }
                    const int nvalid = (T - j0 + 1) < 4 ? (T - j0 + 1) : 4;
                    const unsigned vmk = (1u << nvalid) - 1u, n0 = (un[0][w] >> (gg * 4)) & vmk, n1 = (un[1][w] >> (gg * 4)) & vmk;
                    unsigned m8 = 0u;
#pragma unroll
                    for (int bq = 0; bq < 4; ++bq) m8 |= (((n0 >> bq) & 1u) << (2 * bq)) | (((n1 >> bq) & 1u) << (2 * bq + 1));
                    if (m8) { const int fb = __builtin_ctz(m8) >> 1; const int fs = (j0 + fb) & 7; A4_LOADK(fs); }
#pragma unroll
                    for (int bq = 0; bq < 4; ++bq) {
                        const int j = j0 + bq;
                        const int jb = gg * 4 + bq, stage = j & 7;
#pragma unroll
                        for (int ct = 0; ct < 2; ++ct) {
                            if ((m8 >> (2 * bq + ct)) & 1u) {
                                const int t = tq[ct];
                                const bool csel = ((ct == 0 ? selw0 : selw1) >> jb) & 1u;
                                const bool farb = j * 64 + 63 + 1023 <= t0;
                                const float rf_ = (mrun[ct] == -INF) ? 0.f : mrun[ct];
                                const float sinit = csel ? ((farb ? cbfar : 0.f) - rf_) : -INF;
                                A4_SCORES_V(ct, sinit, stage);
                                const unsigned rest = (2 * bq + ct + 1) < 8 ? (m8 >> (2 * bq + ct + 1)) : 0u;
                                const int kns = rest ? ((j0 + ((__builtin_ctz(rest) + 2 * bq + ct + 1) >> 1)) & 7) : stage;
                                if (!farb) {
                                    const int base = t - j * 64 - g4 * 4;
                                    const LAS float* lp = lutl + hd * LUTP + base - 51;
                                    f32x4 bs[4];
#pragma unroll
                                    for (int kt = 0; kt < 4; ++kt)
#pragma unroll
                                        for (int jj = 0; jj < 4; ++jj) bs[kt][jj] = lp[51 - kt * 16 - jj];
                                    asm volatile("" : "+v"(bs[0]), "+v"(bs[1]), "+v"(bs[2]), "+v"(bs[3]));
#pragma unroll
                                    for (int kt = 0; kt < 4; ++kt) sv[kt] += bs[kt];
                                    if (j == T) {
#pragma unroll
                                        for (int kt = 0; kt < 4; ++kt)
#pragma unroll
                                            for (int jj = 0; jj < 4; ++jj) { const int dist = base - kt * 16 - jj; sv[kt][jj] = (dist >= 0) ? sv[kt][jj] : -INF; }
                                    }
                                }
                                A4_SOFTMAX_PV_K(ct, kns);
                                __builtin_amdgcn_sched_barrier(0);
                            }
                        }
                    }
                    A4_SYNC();
                }
            }
            if (!probe) A4_FINISH(1, false);
        }
    }
#undef A4_ISSUE
#undef A4_SYNC
#undef A4_SYNC_RING
#undef A4_LOADK
#undef A4_SCORES
#undef A4_ONLINE_PV
#undef A4_PV
#undef A4_VREADS
#undef A4_PVMMA
#undef A4_RESET
#undef A4_FINISH
#undef A4_GATEV
}

__device__ __forceinline__ void phase3_mfma(const Params& p, int bid, int nb, LAS unsigned char* lds) {
    {
        const unsigned char* XRBb = p.ws + WS_XRB; const bf16_t* XRB = (const bf16_t*)(p.ws + WS_XRB);
        const float* BG = (const float*)(p.ws + WS_BG); const float* GB = (const float*)(p.ws + WS_GBIAS);
        const float* conv_w = p.in[12]; const float* conv_b = p.in[13]; const float* lam = p.in[18];
        bf16_t* AL = (bf16_t*)(p.ws + WS_ALRU); bf16_t* UL = (bf16_t*)(p.ws + WS_ULRU);
        const XcdDeal dl = xcd_deal(512, lds, nb);
        gemm_stream<true, 1, 0, true>(lds, XRBb, dl.n, 4, 128,
            [&](int ps, int r) { const int u = dl.lo + ps * dl.step; return ((size_t)(u >> 5) * SEQP + (u & 31) * 256 + r) * 128; },
            [&](int ps, int n4) -> const float* { const int u = dl.lo + ps * dl.step; return BG + ((u >> 5) & 7) * 32768 + n4 * 4; },
            [&](int) { return 256; },
            [&](int ps, int rbase, int nbase, int, f32x4 (&acc)[4][4]) {
                const int u = dl.lo + ps * dl.step, sq = u >> 5, hb = sq & 7, bb = sq >> 3, t0 = (u & 31) * 256 + rbase;
                const int j8 = (nbase >> 6) * 32 + ((nbase >> 2) & 3) * 8, c = hb * 64 + j8;
                f32x4 cw[4][2], cbv[2], ga[2], gx[2], spl[2];
#pragma unroll
                for (int h2 = 0; h2 < 2; ++h2) {
#pragma unroll
                    for (int w = 0; w < 4; ++w) cw[w][h2] = *(const f32x4*)(conv_w + w * 512 + c + 4 * h2);
                    cbv[h2] = *(const f32x4*)(conv_b + c + 4 * h2);
                    ga[h2] = *(const f32x4*)(GB + hb * 128 + nbase + 16 * h2); gx[h2] = *(const f32x4*)(GB + hb * 128 + nbase + 16 * h2 + 32);
                    const f32x4 lm = *(const f32x4*)(lam + c + 4 * h2);
#pragma unroll
                    for (int jj = 0; jj < 4; ++jj) spl[h2][jj] = -8.0f * softplus_(-lm[jj]);
                }
#pragma unroll
                for (int mh = 0; mh < 2; ++mh) {
                u32x4 xw[4][4];
#pragma unroll
                for (int mi = 2 * mh; mi < 2 * mh + 2; ++mi)
#pragma unroll
                    for (int w = 0; w < 4; ++w) xw[mi][w] = *(const u32x4*)(XRB + ((size_t)sq * SEQP + t0 + mi * 16 + w) * 64 + j8);
#pragma unroll
                for (int mi = 2 * mh; mi < 2 * mh + 2; ++mi) {
                    f32x4 xc[2] = {cbv[0], cbv[1]};
#pragma unroll
                    for (int w = 0; w < 4; ++w) {
                        xc[0][0] += cw[w][0][0] * __uint_as_float(xw[mi][w][0] << 16); xc[0][1] += cw[w][0][1] * __uint_as_float(xw[mi][w][0] & 0xffff0000u);
                        xc[0][2] += cw[w][0][2] * __uint_as_float(xw[mi][w][1] << 16); xc[0][3] += cw[w][0][3] * __uint_as_float(xw[mi][w][1] & 0xffff0000u);
                        xc[1][0] += cw[w][1][0] * __uint_as_float(xw[mi][w][2] << 16); xc[1][1] += cw[w][1][1] * __uint_as_float(xw[mi][w][2] & 0xffff0000u);
                        xc[1][2] += cw[w][1][2] * __uint_as_float(xw[mi][w][3] << 16); xc[1][3] += cw[w][1][3] * __uint_as_float(xw[mi][w][3] & 0xffff0000u);
                    }
                    f32x4 dv[2], uv[2];
#pragma unroll
                    for (int ni = 0; ni < 2; ++ni)
#pragma unroll
                        for (int jj = 0; jj < 4; ++jj) {
                            const float r_ = sigm(acc[mi][ni][jj] + ga[ni][jj]), ig = sigm(acc[mi][ni + 2][jj] + gx[ni][jj]);
                            const float la = r_ * spl[ni][jj];
                            const float a1 = __builtin_amdgcn_exp2f(la * 1.4426950408889634f);
                            dv[ni][jj] = 1.f - a1; uv[ni][jj] = __builtin_amdgcn_sqrtf(fmaxf(1.f - a1 * a1, 0.f)) * (ig * xc[ni][jj]);
                        }
                    const size_t o = ((size_t)bb * SEQ + t0 + mi * 16) * 512 + c;
                    u32x4 wd, wu;
                    wd[0] = pk_bf16(dv[0][0], dv[0][1]); wd[1] = pk_bf16(dv[0][2], dv[0][3]); wd[2] = pk_bf16(dv[1][0], dv[1][1]); wd[3] = pk_bf16(dv[1][2], dv[1][3]);
                    wu[0] = pk_bf16(uv[0][0], uv[0][1]); wu[1] = pk_bf16(uv[0][2], uv[0][3]); wu[2] = pk_bf16(uv[1][0], uv[1][1]); wu[3] = pk_bf16(uv[1][2], uv[1][3]);
                    *(u32x4*)(AL + o) = wd; *(u32x4*)(UL + o) = wu;
                }
                __builtin_amdgcn_sched_barrier(0);
                } });
    }
    {
        const unsigned char* KV6 = p.ws + WS_KV6; float* CP = (float*)(p.ws + WS_CPART);
        const float* W1k = p.in[7]; const float* W1v = p.in[9];
        const XcdDeal dl = xcd_deal(256, lds, nb);
        gemm_stream<false, 1>(lds, KV6, dl.n, 2, 64,
            [&](int ps, int r) { const int u = dl.lo + ps * dl.step, ks = u >> 4, kv = (u >> 3) & 1, R = (u & 7) * 256 + r;
                                 return (size_t)kv * 4194304 + ((size_t)(R >> 9) * SEQ + 16 * (R & 511)) * 128 + (size_t)ks * 256; },
            [&](int ps, int n4) -> const float* { const int u = dl.lo + ps * dl.step, ks = u >> 4, kv = (u >> 3) & 1; return (kv ? W1v : W1k) + (size_t)ks * 128 * 64 + ((n4 * 4) & 63); },
            [&](int) { return 256; },
            [&](int ps, int r, int n, f32x4 v) { if (n < 64) { const int u = dl.lo + ps * dl.step; *(f32x4*)(CP + ((size_t)(u >> 3) * 2048 + (u & 7) * 256 + r) * 64 + n) = v; } });
    }
}

__device__ __forceinline__ void phase3b_new(const Params& p, int bid, int nb, float* smem) {
    int tid_ = threadIdx.x; asm volatile("" : "+v"(tid_));
    const int tid = tid_;
    {
        const bf16_t* AL = (const bf16_t*)(p.ws + WS_ALRU); const bf16_t* UL = (const bf16_t*)(p.ws + WS_ULRU);
        float* AEND = (float*)(p.ws + WS_AEND); float* HEND = (float*)(p.ws + WS_HEND);
        const int cg = tid & 127, sg = tid >> 7;
        f32x4* summA = (f32x4*)smem; f32x4* summH = summA + 512;
        for (int u = bid; u < 256; u += nb) {
            const size_t base = ((size_t)(u >> 7) * SEQ + (u & 127) * 64 + sg * 16) * 512 + 4 * cg;
            u32x2 ar[16], ur[16];
#pragma unroll
            for (int tt = 0; tt < 16; ++tt) { ar[tt] = *(const u32x2*)(AL + base + (size_t)tt * 512); ur[tt] = *(const u32x2*)(UL + base + (size_t)tt * 512); }
            f32x4 A = (f32x4){1.f, 1.f, 1.f, 1.f}, H = (f32x4){0.f, 0.f, 0.f, 0.f};
#pragma unroll
            for (int tt = 0; tt < 16; ++tt) { const f32x4 a_ = 1.f - bf4_f32(ar[tt]); H = a_ * H + bf4_f32(ur[tt]); A = A * a_; }
            __syncthreads();
            summA[sg * 128 + cg] = A; summH[sg * 128 + cg] = H;
            __syncthreads();
            if (sg == 0) {
#pragma unroll
                for (int j = 1; j < 4; ++j) { const f32x4 a2 = summA[j * 128 + cg], h2 = summH[j * 128 + cg]; H = a2 * H + h2; A = A * a2; }
                *(f32x4*)(AEND + (size_t)u * 512 + 4 * cg) = A; *(f32x4*)(HEND + (size_t)u * 512 + 4 * cg) = H;
            }
        }
        __syncthreads();
    }
    {
        const float* CP = (const float*)(p.ws + WS_CPART); const float* CB = (const float*)(p.ws + WS_CBIAS);
        float* hid = smem;
        for (int u = bid; u < 256; u += nb) {
            const int kv = u >> 7, R0 = (u & 127) * 16;
            const float* w2 = kv ? p.in[10] : p.in[8];
            bf16_t* ob = (bf16_t*)(p.ws + (kv ? WS_VCB : WS_KCB));
            __syncthreads();
            float* w2l = smem + 2048;
            for (int i = tid; i < 64 * 64 / 4; i += NT) *(f32x4*)(w2l + 4 * i) = *(const f32x4*)(w2 + 4 * i);
            for (int i = tid; i < 16 * 64; i += NT) {
                const int r = i >> 6, c = i & 63; const size_t o = ((size_t)kv * 2048 + R0 + r) * 64 + c;
                float v = CB[kv * 64 + c];
#pragma unroll
                for (int ks = 0; ks < 16; ++ks) v += CP[o + (size_t)ks * 262144];
                hid[r * 65 + c] = gelu_t(v);
            }
            __syncthreads();
            for (int i = tid; i < 16 * 64; i += NT) {
                const int r = i >> 6, j = i & 63; float acc = 0.f;
#pragma unroll 16
                for (int k = 0; k < 64; ++k) acc += hid[r * 65 + k] * w2l[k * 64 + j];
                const int R = R0 + r;
                if ((R & 511) == 511) acc = 0.f;
                ob[(size_t)R * 64 + j] = (bf16_t)(pk_bf16(acc, acc) & 0xffffu);
            }
        }
    }
}

__device__ __forceinline__ void phase4b_new(const Params& p, int bid, int nb, float* smem) {
    const bf16_t* AL = (const bf16_t*)(p.ws + WS_ALRU); const bf16_t* UL = (const bf16_t*)(p.ws + WS_ULRU);
    const float* AEND = (const float*)(p.ws + WS_AEND); const float* HEND = (const float*)(p.ws + WS_HEND);
    const bf16_t* GRG = (const bf16_t*)(p.ws + WS_GRG); const float* OATT = (const float*)(p.ws + WS_OATT);
    const float* gaw = p.in[19]; const float* grw = p.in[20];
    bf16_t* YB = (bf16_t*)(p.ws + WS_YB);
    int tid_ = threadIdx.x; asm volatile("" : "+v"(tid_));
    const int tid = tid_, lane = tid & 63;
    const int cg = tid & 127, sg = tid >> 7, wsub = (tid >> 6) & 1;
    f32x4* summA = (f32x4*)smem;
    f32x4* summH = summA + 512;
    float* ssr = smem + 4096;
    float* ssa = ssr + 128;
    const f32x4 gr_w = *(const f32x4*)(grw + 4 * cg), ga_w = *(const f32x4*)(gaw + 4 * cg);
    for (int u = bid; u < 256; u += nb) {
        const int b = u >> 7, chunk = u & 127;
        f32x4 carry = (f32x4){0.f, 0.f, 0.f, 0.f};
        {
            const size_t cb = (size_t)(b * 128) * 512 + 4 * cg;
            const int k0 = sg * 32, k1 = (k0 + 32) < chunk ? (k0 + 32) : chunk;
            f32x4 pa = (f32x4){1.f, 1.f, 1.f, 1.f}, ph = (f32x4){0.f, 0.f, 0.f, 0.f};
#pragma unroll 8
            for (int k = k0; k < k1; ++k) { const f32x4 a_ = *(const f32x4*)(AEND + cb + (size_t)k * 512); ph = a_ * ph + *(const f32x4*)(HEND + cb + (size_t)k * 512); pa = pa * a_; }
            __syncthreads();
            summA[sg * 128 + cg] = pa; summH[sg * 128 + cg] = ph;
            __syncthreads();
#pragma unroll
            for (int j = 0; j < 4; ++j) carry = summA[j * 128 + cg] * carry + summH[j * 128 + cg];
        }
        __builtin_amdgcn_sched_barrier(0);
        const size_t tok0 = (size_t)b * SEQ + chunk * 64 + sg * 16;
        u32x2 dr[16], ur[16], gw[16]; f32x4 oa[16];
#pragma unroll
        for (int tt = 0; tt < 16; ++tt) {
            const size_t o = (tok0 + tt) * 512 + 4 * cg;
            dr[tt] = *(const u32x2*)(AL + o); ur[tt] = *(const u32x2*)(UL + o); gw[tt] = *(const u32x2*)(GRG + o); if (tt < 8) oa[tt] = *(const f32x4*)(OATT + o);
        }
        f32x4 A = (f32x4){1.f, 1.f, 1.f, 1.f}, H = (f32x4){0.f, 0.f, 0.f, 0.f};
#pragma unroll
        for (int tt = 0; tt < 16; ++tt) { const f32x4 a_ = 1.f - bf4_f32(dr[tt]); H = a_ * H + bf4_f32(ur[tt]); A = A * a_; }
        __syncthreads();
        summA[sg * 128 + cg] = A; summH[sg * 128 + cg] = H;
        __syncthreads();
#pragma unroll
        for (int j = 0; j < 3; ++j) if (j < sg) carry = summA[j * 128 + cg] * carry + summH[j * 128 + cg];
#pragma unroll
        for (int tt = 8; tt < 16; ++tt) oa[tt] = *(const f32x4*)(OATT + (tok0 + tt) * 512 + 4 * cg);
        f32x4 h = carry; u32x2 vv[16];
#pragma unroll
        for (int tt = 0; tt < 16; ++tt) {
            asm volatile("" : "+v"(dr[tt]), "+v"(ur[tt]));
            const f32x4 a_ = 1.f - bf4_f32(dr[tt]);
            h = a_ * h + bf4_f32(ur[tt]);
            const f32x4 v = h * bf4_f32(gw[tt]);
            vv[tt].x = pk_bf16(v[0], v[1]); vv[tt].y = pk_bf16(v[2], v[3]);
            const float sq = wave_sum((v[0] * v[0] + v[1] * v[1]) + (v[2] * v[2] + v[3] * v[3]));
            const float sqa = wave_sum((oa[tt][0] * oa[tt][0] + oa[tt][1] * oa[tt][1]) + (oa[tt][2] * oa[tt][2] + oa[tt][3] * oa[tt][3]));
            if (lane == 0) { ssr[(sg * 16 + tt) * 2 + wsub] = sq; ssa[(sg * 16 + tt) * 2 + wsub] = sqa; }
        }
        __syncthreads();
#pragma unroll
        for (int tt = 0; tt < 16; ++tt) {
            const int ti = sg * 16 + tt;
            const float s1 = ssr[ti * 2] + ssr[ti * 2 + 1], s2 = ssa[ti * 2] + ssa[ti * 2 + 1];
            const float rs1 = __builtin_amdgcn_rsqf(s1 * (1.f / 512.f) + 1e-6f), rs2 = __builtin_amdgcn_rsqf(s2 * (1.f / 512.f) + 1e-6f);
            const f32x4 ya = oa[tt] * rs2 * ga_w, yr = bf4_f32(vv[tt]) * rs1 * gr_w;
            u32x2 wa, wr_; wa.x = pk_bf16(ya[0], ya[1]); wa.y = pk_bf16(ya[2], ya[3]); wr_.x = pk_bf16(yr[0], yr[1]); wr_.y = pk_bf16(yr[2], yr[3]);
            *(u32x2*)(YB + (tok0 + tt) * 1024 + 4 * cg) = wa;
            *(u32x2*)(YB + (tok0 + tt) * 1024 + 512 + 4 * cg) = wr_;
        }
    }
}

__device__ __forceinline__ void phase8(const Params& p, int bid, int nb, float* smem) {
    const float* LOG = (const float*)(p.ws + WS_LOGITS); const float* brt = p.in[24];
    unsigned* cnt = (unsigned*)(p.ws + WS_HIST);
    int* EID = (int*)(p.ws + WS_EID); int* POS = (int*)(p.ws + WS_POS); float* WGT = (float*)(p.ws + WS_WGT);
    int tid_ = threadIdx.x; asm volatile("" : "+v"(tid_));
    const int wave = tid_ >> 6, lane = tid_ & 63;
    int* lhist = (int*)smem;
    if (tid_ < 256) lhist[tid_] = 0;
    __syncthreads();
    float bias[4];
#pragma unroll
    for (int r = 0; r < 4; ++r) bias[r] = brt[r * 64 + lane];
    for (int tok0 = bid * NW + wave; tok0 < MTOK; tok0 += 8 * nb * NW) {
        float lg[8][4];
#pragma unroll
        for (int k = 0; k < 8; ++k) { const int tok = tok0 + k * nb * NW; const int tc = tok < MTOK ? tok : tok0;
#pragma unroll
            for (int r = 0; r < 4; ++r) lg[k][r] = LOG[(size_t)tc * 256 + r * 64 + lane] + LOG[(size_t)MTOK * 256 + (size_t)tc * 256 + r * 64 + lane]; }
#pragma unroll
        for (int k = 0; k < 8; ++k) {
            const int tok = tok0 + k * nb * NW;
            if (tok < MTOK) {
                float sv[4], cv[4], gs[4];
#pragma unroll
                for (int r = 0; r < 4; ++r) { sv[r] = sigm(lg[k][r]); cv[r] = sv[r] + bias[r]; gs[r] = half_top2_sum(cv[r]); }
                float gsc = -INF;
#pragma unroll
                for (int r = 0; r < 4; ++r) {
                    const float ga = __builtin_bit_cast(float, __builtin_amdgcn_readlane(__builtin_bit_cast(int, gs[r]), 31));
                    const float gb = __builtin_bit_cast(float, __builtin_amdgcn_readlane(__builtin_bit_cast(int, gs[r]), 63));
                    gsc = lane == 2 * r ? ga : gsc; gsc = lane == 2 * r + 1 ? gb : gsc;
                }
                int grank = 0;
#pragma unroll
                for (int g2 = 0; g2 < 8; ++g2) { const float v2 = __builtin_bit_cast(float, __builtin_amdgcn_readlane(__builtin_bit_cast(int, gsc), g2)); grank += ((v2 > gsc) || (v2 == gsc && g2 < lane)) ? 1 : 0; }
                const unsigned long long gmask = __ballot((lane < 8) && (grank < 4));
#pragma unroll
                for (int r = 0; r < 4; ++r) cv[r] = ((gmask >> (2 * r + (lane >> 5))) & 1ull) ? cv[r] : -INF;
                int my_e = 0; float my_s = 0.f;
#pragma unroll
                for (int kk = 0; kk < 8; ++kk) {
                    float bv = cv[0]; int bi = lane;
                    if (cv[1] > bv) { bv = cv[1]; bi = 64 + lane; }
                    if (cv[2] > bv) { bv = cv[2]; bi = 128 + lane; }
                    if (cv[3] > bv) { bv = cv[3]; bi = 192 + lane; }
                    const float mx = wave_max_f(bv);
                    const int sel = wave_min_i(bv == mx ? bi : 0x7fffffff);
                    const int sr = sel >> 6;
                    const float mine = sr == 0 ? sv[0] : sr == 1 ? sv[1] : sr == 2 ? sv[2] : sv[3];
                    const float ssel = __builtin_bit_cast(float, __builtin_amdgcn_readlane(__builtin_bit_cast(int, mine), sel & 63));
                    if (lane == (sel & 63)) { cv[0] = sr == 0 ? -INF : cv[0]; cv[1] = sr == 1 ? -INF : cv[1]; cv[2] = sr == 2 ? -INF : cv[2]; cv[3] = sr == 3 ? -INF : cv[3]; }
                    if (lane == kk) { my_e = sel; my_s = ssel; }
                }
                const float ssum = wave_sum(lane < 8 ? my_s : 0.f);
                if (lane < 8) {
                    const int ps = atomicAdd(&lhist[my_e], 1);
                    EID[tok * 8 + lane] = my_e; POS[tok * 8 + lane] = ps; WGT[tok * 8 + lane] = 2.5f * my_s / ssum;
                }
            }
        }
    }
    __syncthreads();
    if (tid_ < 256) cnt[bid * 256 + tid_] = (unsigned)lhist[tid_];
}

__device__ __forceinline__ void expert_tables(const Params& p, int* off, int* tp, int shift = 6) {
    const unsigned* cnt = (const unsigned*)(p.ws + WS_CTL) + CW_CNT;
    int tx_ = threadIdx.x; asm volatile("" : "+v"(tx_));
    __syncthreads();
    if (tx_ < 64) {
        const int l = tx_; const int rnd = (1 << shift) - 1;
        const u32x4 c4 = *(const u32x4*)(cnt + 4 * l);
        const int c0 = (int)c4[0], c1 = (int)c4[1], c2 = (int)c4[2], c3 = (int)c4[3];
        const int t0 = (c0 + rnd) >> shift, t1 = (c1 + rnd) >> shift, t2 = (c2 + rnd) >> shift, t3 = (c3 + rnd) >> shift;
        const int so = c0 + c1 + c2 + c3, st = t0 + t1 + t2 + t3;
        int io = so, it = st;
#pragma unroll
        for (int d = 1; d < 64; d <<= 1) { const int uo = __shfl_up(io, d), ut = __shfl_up(it, d); if (l >= d) { io += uo; it += ut; } }
        const int eo = io - so, et = it - st;
        off[4 * l] = eo; off[4 * l + 1] = eo + c0; off[4 * l + 2] = eo + c0 + c1; off[4 * l + 3] = eo + c0 + c1 + c2;
        tp[4 * l] = et; tp[4 * l + 1] = et + t0; tp[4 * l + 2] = et + t0 + t1; tp[4 * l + 3] = et + t0 + t1 + t2;
        if (l == 63) { off[256] = io; tp[256] = it; tp[257] = it + (MTOK >> shift); }
    }
    __syncthreads();
}

__device__ __forceinline__ void phase9(const Params& p, int bid, int nb, float* smem) {
    int* off = (int*)smem; int* blkoff = off + 272; int* tot = off + 528; int* ptot = off + 1024; int* ppre = off + 3072;
    const unsigned* HIST = (const unsigned*)(p.ws + WS_HIST);
    unsigned* cnt = (unsigned*)(p.ws + WS_CTL) + CW_CNT;
    int tid_ = threadIdx.x; asm volatile("" : "+v"(tid_));
    const int tid = tid_;
    __syncthreads();
    {
        const int e4 = tid & 63, bg = tid >> 6, gsz = (nb + 7) >> 3, b0 = bg * gsz, b1 = (b0 + gsz) < nb ? (b0 + gsz) : nb;
        int t0 = 0, t1 = 0, t2 = 0, t3 = 0, q0 = 0, q1 = 0, q2 = 0, q3 = 0;
#pragma unroll 16
        for (int bb = b0; bb < b1; ++bb) {
            const u32x4 h = *(const u32x4*)(HIST + (size_t)bb * 256 + 4 * e4); const bool pre = bb < bid;
            t0 += (int)h[0]; t1 += (int)h[1]; t2 += (int)h[2]; t3 += (int)h[3];
            q0 += pre ? (int)h[0] : 0; q1 += pre ? (int)h[1] : 0; q2 += pre ? (int)h[2] : 0; q3 += pre ? (int)h[3] : 0;
        }
        int* pt = ptot + bg * 256 + 4 * e4; int* pq = ppre + bg * 256 + 4 * e4;
        pt[0] = t0; pt[1] = t1; pt[2] = t2; pt[3] = t3; pq[0] = q0; pq[1] = q1; pq[2] = q2; pq[3] = q3;
        __syncthreads();
        if (tid < 256) {
            int total = 0, pre = 0;
#pragma unroll
            for (int g = 0; g < 8; ++g) { total += ptot[g * 256 + tid]; pre += ppre[g * 256 + tid]; }
            tot[tid] = total; blkoff[tid] = pre; if (bid == 0) cnt[tid] = (unsigned)total;
        }
    }
    __syncthreads();
    if (tid < 64) {
        const int c0 = tot[4 * tid], c1 = tot[4 * tid + 1], c2 = tot[4 * tid + 2], c3 = tot[4 * tid + 3];
        const int so = c0 + c1 + c2 + c3; int io = so;
#pragma unroll
        for (int d = 1; d < 64; d <<= 1) { const int uo = __shfl_up(io, d); if (tid >= d) io += uo; }
        const int eo = io - so;
        off[4 * tid] = eo; off[4 * tid + 1] = eo + c0; off[4 * tid + 2] = eo + c0 + c1; off[4 * tid + 3] = eo + c0 + c1 + c2;
    }
    __syncthreads();
    const int* EID = (const int*)(p.ws + WS_EID); const int* POS = (const int*)(p.ws + WS_POS); const float* WGT = (const float*)(p.ws + WS_WGT);
    int* ST = (int*)(p.ws + WS_SLOTTOK); float* SW = (float*)(p.ws + WS_SLOTW); int* SOF = (int*)(p.ws + WS_SLOTOF);
    const int wave = tid >> 6, lane = tid & 63;
    for (int tok0 = bid * NW + wave; tok0 < MTOK; tok0 += 8 * nb * NW) {
        const int tok = tok0 + (lane >> 3) * nb * NW;
        if (tok < MTOK) {
            const int idx = tok * 8 + (lane & 7); const int e = EID[idx];
            const int slot = off[e] + blkoff[e] + POS[idx];
            ST[slot] = tok; SW[slot] = WGT[idx]; SOF[idx] = slot;
        }
    }
}

__device__ __forceinline__ int find_expert(const int* tp, int rt) {
    int lo = 0, hi = 256;
    while (lo < hi) { const int mid = (lo + hi + 1) >> 1; if (tp[mid] <= rt) lo = mid; else hi = mid - 1; }
    return lo;
}

__device__ __forceinline__ void phase7_mfma(const Params& p, int bid, int nb, LAS unsigned char* lds) {
    const unsigned char* H2b = p.ws + WS_H2B;
    float* LOG = (float*)(p.ws + WS_LOGITS);
    const XcdDeal dl = xcd_deal(64 * 2 * 2, lds, nb);
    const bf16_t* wrb = (const bf16_t*)(p.ws + WS_WRB);
    gemm_stream<false, 1, 0, false, true>(lds, H2b, dl.n, 8, 256,
        [&](int ps, int r) { const int u = dl.lo + ps * dl.step; return (size_t)((u >> 2) * 256 + r) * 2048 + (size_t)(u & 1) * 1024; },
        [&](int ps, int n4) -> const bf16_t* { const int u = dl.lo + ps * dl.step; return wrb + (size_t)(u & 1) * 512 * 256 + ((u >> 1) & 1) * 128 + n4 * 4; },
        [&](int) { return 256; },
        [&](int ps, int r, int n, f32x4 v) { const int u = dl.lo + ps * dl.step; *(f32x4*)(LOG + (size_t)(u & 1) * (MTOK * 256) + (size_t)((u >> 2) * 256 + r) * 256 + ((u >> 1) & 1) * 128 + n) = v; });
}

#define ETAB_OFF 24576
#define EDESC_OFF (ETAB_OFF + 1024)
__device__ __forceinline__ int expert_passes(const Params& p, int bid, int nb, const LAS unsigned char* lds, float* smem, int nct, int& npass) {
    int* off = (int*)(smem + ETAB_OFF); int* tp = off + 272; int* desc = (int*)(smem + EDESC_OFF);
    expert_tables(p, off, tp, 8);
    const unsigned* cnt = (const unsigned*)(p.ws + WS_CTL) + CW_CNT;
    const XcdDeal dl = xcd_deal(tp[257] * nct, lds, nb);
    npass = dl.n;
    int tx_ = threadIdx.x; asm volatile("" : "+v"(tx_));
    for (int ps = tx_; ps < npass; ps += NT) {
        const int u = dl.lo + ps * dl.step;
        const int e = find_expert(tp, u / nct);
        const int nte = tp[e + 1] - tp[e], v = u - tp[e] * nct, ct = v / nte, rtl = v - ct * nte;
        const int rows_e = e < 256 ? (int)cnt[e] : MTOK;
        const int r0 = rtl * 256;
        desc[ps * 4 + 0] = (e < 256 ? off[e] : NK) + r0;
        desc[ps * 4 + 1] = (rows_e - r0) < 256 ? (rows_e - r0) : 256;
        desc[ps * 4 + 2] = e; desc[ps * 4 + 3] = ct;
    }
    __syncthreads();
    return dl.lo;
}

__device__ __forceinline__ void phase10_mfma(const Params& p, int bid, int nb, LAS unsigned char* lds, float* smem) {
    int npass; expert_passes(p, bid, nb, lds, smem, 4, npass);
    const LAS int* desc = (const LAS int*)(lds + EDESC_OFF * 4);
    const unsigned char* H2b = p.ws + WS_H2B; const int* ST = (const int*)(p.ws + WS_SLOTTOK);
    bf16_t* HIDB = (bf16_t*)(p.ws + WS_HIDB);
    const float* W1g = p.in[25]; const float* W3g = p.in[26]; const float* W1s = p.in[28]; const float* W3s = p.in[29];
    const float* SW = (const float*)(p.ws + WS_SLOTW);
    gemm_stream_ws(lds, H2b, npass, 16, 256,
        [&](int ps, int r) { const int slot0 = desc[ps * 4], mr = desc[ps * 4 + 1]; const int rr = r < mr ? r : mr - 1; const int slot = slot0 + rr;
                             const int tok = slot < NK ? ST[slot] : slot - NK; return (size_t)tok * 2048; },
        [&](int ps, int n4) -> const float* { const int e = desc[ps * 4 + 2], hc0 = desc[ps * 4 + 3] * 64; const int n = n4 * 4;
                             const int hc = hc0 + (n >> 6) * 32 + ((n >> 2) & 3) * 8 + ((n >> 4) & 1) * 4;
                             const float* W = ((n >> 5) & 1) ? (e < 256 ? W3g + (size_t)e * 262144 : W3s) : (e < 256 ? W1g + (size_t)e * 262144 : W1s); return W + hc; },
        [&](int ps) { return desc[ps * 4 + 1]; },
        [&](int ps, int rbase, int nbase, int mr, f32x4 (&acc)[8][4]) {
            const int slot0 = desc[ps * 4] + rbase, hc = desc[ps * 4 + 3] * 64 + (nbase >> 6) * 32 + ((nbase >> 2) & 3) * 8;
            float wv[8];
#pragma unroll
            for (int mi = 0; mi < 8; ++mi) { const int slot = slot0 + mi * 16; const float wl = SW[slot < NK ? slot : 0]; wv[mi] = slot < NK ? wl : 1.f; }
#pragma unroll
            for (int mi = 0; mi < 8; ++mi)
#pragma unroll
                for (int ni = 0; ni < 2; ++ni)
#pragma unroll
                    for (int jj = 0; jj < 4; ++jj) { const float a = acc[mi][ni][jj]; acc[mi][ni][jj] = a * __builtin_amdgcn_rcpf(1.f + ex2(-a * LOG2E)) * acc[mi][ni + 2][jj]; }
#pragma unroll
            for (int mi = 0; mi < 8; ++mi) {
                if (rbase + mi * 16 < mr) {
                    const f32x4 h0 = acc[mi][0] * wv[mi], h1 = acc[mi][1] * wv[mi];
                    u32x4 w; w[0] = pk_bf16(h0[0], h0[1]); w[1] = pk_bf16(h0[2], h0[3]); w[2] = pk_bf16(h1[0], h1[1]); w[3] = pk_bf16(h1[2], h1[3]);
                    *(u32x4*)(HIDB + (size_t)(slot0 + mi * 16) * 256 + hc) = w;
                }
            } });
}

__device__ __forceinline__ void phase11_mfma(const Params& p, int bid, int nb, LAS unsigned char* lds, float* smem) {
    int npass; expert_passes(p, bid, nb, lds, smem, 8, npass);
    const LAS int* desc = (const LAS int*)(lds + EDESC_OFF * 4);
    const unsigned char* HIDB = p.ws + WS_HIDB; const float* SW = (const float*)(p.ws + WS_SLOTW);
    bf16_t* SO = (bf16_t*)(p.ws + WS_SLOTOUT);
    const float* W2g = p.in[27]; const float* W2s = p.in[30];
    gemm_stream_ws(lds, HIDB, npass, 4, 1024,
        [&](int ps, int r) { const int slot0 = desc[ps * 4], mr = desc[ps * 4 + 1]; const int rr = r < mr ? r : mr - 1; return (size_t)(slot0 + rr) * 512; },
        [&](int ps, int n4) -> const float* { const int e = desc[ps * 4 + 2], n0 = desc[ps * 4 + 3] * 128; const int src4 = (n4 & ~7) + 2 * (n4 & 3) + ((n4 >> 2) & 1);
                                              return (e < 256 ? W2g + (size_t)e * 262144 : W2s) + n0 + src4 * 4; },
        [&](int ps) { return desc[ps * 4 + 1]; },
        [&](int ps, int rbase, int nbase, int mr, f32x4 (&acc)[8][4]) {
            const int odd = rbase & 1, rA = rbase & ~1, rB = rbase | 1;
            const int c0 = desc[ps * 4 + 3] * 128 + (nbase >> 6) * 64 + ((nbase >> 2) & 3) * 8 + odd * 32;
            bf16_t* ob = SO + (size_t)desc[ps * 4] * 1024 + c0;
#pragma unroll
            for (int mi = 0; mi < 8; ++mi) {
                u32x4 o0, o1, dA, dB;
                { const f32x4 v0 = acc[mi][0], v1 = acc[mi][1]; o0[0] = pk_bf16(v0[0], v0[1]); o0[1] = pk_bf16(v0[2], v0[3]); o0[2] = pk_bf16(v1[0], v1[1]); o0[3] = pk_bf16(v1[2], v1[3]); }
                { const f32x4 v0 = acc[mi][2], v1 = acc[mi][3]; o1[0] = pk_bf16(v0[0], v0[1]); o1[1] = pk_bf16(v0[2], v0[3]); o1[2] = pk_bf16(v1[0], v1[1]); o1[3] = pk_bf16(v1[2], v1[3]); }
#pragma unroll
                for (int j = 0; j < 4; ++j) {
                    const unsigned snd = odd ? o0[j] : o1[j];
                    const unsigned rcv = (unsigned)__builtin_amdgcn_mov_dpp((int)snd, 0xB1, 0xf, 0xf, true);
                    dA[j] = odd ? rcv : o0[j]; dB[j] = odd ? o1[j] : rcv;
                }
                int ra_ = rA + mi * 16; asm volatile("" : "+v"(ra_));
                if (ra_ < mr) *(u32x4*)(ob + (size_t)ra_ * 1024) = dA;
                if (ra_ + 1 < mr) *(u32x4*)(ob + (size_t)ra_ * 1024 + 1024) = dB;
            } });
}

__device__ __forceinline__ void phase12_mfma(const Params& p, int bid, int nb) {
    const bf16_t* X1 = (const bf16_t*)(p.ws + WS_X1); const bf16_t* SO = (const bf16_t*)(p.ws + WS_SLOTOUT); const int* SOF = (const int*)(p.ws + WS_SLOTOF);
    const float* mod = (const float*)(p.ws + WS_MOD); const float* fw = p.in[31];
    int tid_ = threadIdx.x; asm volatile("" : "+v"(tid_));
    const int wave = tid_ >> 6, lane = tid_ & 63;
    const int RS = nb * NW;
    f32x4 wv[4];
#pragma unroll
    for (int i4 = 0; i4 < 4; ++i4) wv[i4] = *(const f32x4*)(fw + (i4 >> 1) * 512 + lane * 8 + (i4 & 1) * 4);
    for (int row0 = bid * NW + wave; row0 < MTOK; row0 += 2 * RS) {
        int slots[2];
#pragma unroll
        for (int k = 0; k < 2; ++k) { const int row = row0 + k * RS; const int rc = row < MTOK ? row : row0; slots[k] = lane < 8 ? SOF[rc * 8 + lane] : NK + rc; }
        u32x4 w0[2][9], w1[2][9], xa[2], xb[2];
#pragma unroll
        for (int k = 0; k < 2; ++k) {
            const int row = row0 + k * RS; const int rc = row < MTOK ? row : row0;
#pragma unroll
            for (int q = 0; q < 9; ++q) {
                const int slot = __builtin_amdgcn_readlane(slots[k], q);
                const u32x4* rp = (const u32x4*)(SO + (size_t)slot * 1024) + lane;
                w0[k][q] = rp[0]; w1[k][q] = rp[64];
            }
            const u32x4* xp = (const u32x4*)(X1 + (size_t)rc * 1024) + lane;
            xa[k] = xp[0]; xb[k] = xp[64];
        }
#pragma unroll
        for (int k = 0; k < 2; ++k) {
            const int row = row0 + k * RS;
            if (row < MTOK) {
                const int b = row >> 13;
                float acc[16];
#pragma unroll
                for (int i = 0; i < 16; ++i) acc[i] = 0.f;
#pragma unroll
                for (int q = 0; q < 9; ++q) {
#pragma unroll
                    for (int j = 0; j < 4; ++j) {
                        acc[2 * j] += __uint_as_float(w0[k][q][j] << 16); acc[2 * j + 1] += __uint_as_float(w0[k][q][j] & 0xffff0000u);
                        acc[8 + 2 * j] += __uint_as_float(w1[k][q][j] << 16); acc[8 + 2 * j + 1] += __uint_as_float(w1[k][q][j] & 0xffff0000u);
                    }
                }
                float xv[16];
#pragma unroll
                for (int j = 0; j < 4; ++j) { xv[2 * j] = __uint_as_float(xa[k][j] << 16); xv[2 * j + 1] = __uint_as_float(xa[k][j] & 0xffff0000u);
                                              xv[8 + 2 * j] = __uint_as_float(xb[k][j] << 16); xv[8 + 2 * j + 1] = __uint_as_float(xb[k][j] & 0xffff0000u); }
                float v[16]; float ss = 0.f;
#pragma unroll
                for (int i4 = 0; i4 < 4; ++i4) {
                    const f32x4 gv = *(const f32x4*)(mod + b * 6144 + 5120 + (i4 >> 1) * 512 + lane * 8 + (i4 & 1) * 4);
#pragma unroll
                    for (int j = 0; j < 4; ++j) { v[i4 * 4 + j] = xv[i4 * 4 + j] + gv[j] * acc[i4 * 4 + j]; ss += v[i4 * 4 + j] * v[i4 * 4 + j]; }
                }
                ss = wave_sum(ss);
                const float rstd = __builtin_amdgcn_rsqf(ss * (1.f / 1024.f) + 1e-6f);
#pragma unroll
                for (int i4 = 0; i4 < 4; ++i4) {
                    f32x4 o;
#pragma unroll
                    for (int j = 0; j < 4; ++j) o[j] = v[i4 * 4 + j] * rstd * wv[i4][j];
                    *(f32x4*)(p.out + (size_t)row * 1024 + (i4 >> 1) * 512 + lane * 8 + (i4 & 1) * 4) = o;
                }
            }
        }
    }
}

typedef const __attribute__((address_space(4))) Params* kparams_t;
__device__ __forceinline__ const Params& kparams() { kparams_t k = (kparams_t)__builtin_amdgcn_kernarg_segment_ptr(); asm volatile("" : "+s"(k)); return *(const Params*)k; }
__global__ void __launch_bounds__(NT, 2) k_fused(Params p_unused) {
    (void)p_unused;
#define p kparams()
    extern __shared__ __attribute__((aligned(16))) unsigned char lds_raw[];
    LAS unsigned char* lds = (LAS unsigned char*)lds_raw;
    float* smem = (float*)lds_raw;
    if (threadIdx.x == 0) { *(LAS u32x4*)(lds + LDS_MISC) = (u32x4){0u, 0u, 0u, 0u}; }
    __syncthreads();
    XcdBarrier bar = xcd_barrier_post((unsigned*)(p.ws + WS_CTL), (volatile LAS unsigned*)(lds + LDS_MISC));
    if (threadIdx.x == 0) ((LAS int*)(lds + TOPO_OFF))[2] = (int)xb_add((unsigned*)(p.ws + WS_CTL) + CW_RANK + 64 * bar.x, 1u);
    const int bid = blockIdx.x, nb = gridDim.x;
#define PH(stmt) { stmt; xcd_barrier(bar); }
#define PHR(bit, stmt) { stmt; xcd_barrier(bar); if (REP & (bit)) { stmt; xcd_barrier(bar); } }
    PHR(8192, phase0(p, bid, nb, smem, lds))
    if (threadIdx.x == 0) {
        int pre = 0, mine = 0;
        for (unsigned j = 0; j < 16; ++j) { const int c = (int)xb_ld((unsigned*)(p.ws + WS_CTL) + XB_XCNT(j)); if (j < bar.x) pre += c; if (j == bar.x) mine = c; }
        ((LAS int*)(lds + TOPO_OFF))[0] = pre; ((LAS int*)(lds + TOPO_OFF))[1] = mine > 0 ? mine : 1;
    }
    __syncthreads();
    PHR(128, phase_modnorm<false>(p, bid, nb, p.in[0], p.in[4], 0, 1024, (bf16_t*)(p.ws + WS_H1B)))
    PHR(1, phase2_e(p, bid, nb, lds))
    PHR(2, phase3_mfma(p, bid, nb, lds))
    PHR(4, phase3b_new(p, bid, nb, smem))
    PH(phase4_mfma(p.ws, bid, nb, lds))
    PHR(8, phase4b_new(p, bid, nb, smem))
    PHR(512, phase5_e(p, bid, nb, lds))
    PHR(16384, phase_modnorm<true>(p, bid, nb, p.ws + WS_X1, p.in[22], 3072, 4096, (bf16_t*)(p.ws + WS_H2B)))
    PHR(1024, phase7_mfma(p, bid, nb, lds))
    PH(phase8(p, bid, nb, smem))
    PH(phase9(p, bid, nb, smem))
    if (REP & 256) { PH(phase8(p, bid, nb, smem)) PH(phase9(p, bid, nb, smem)) }
    PHR(16, phase10_mfma(p, bid, nb, lds, smem))
    PHR(32, phase11_mfma(p, bid, nb, lds, smem))
    phase12_mfma(p, bid, nb);
    if (REP & 2048) { xcd_barrier(bar); phase12_mfma(p, bid, nb); }
    if (REP & 4096) { for (int i = 0; i < 20; ++i) xcd_barrier(bar); }
#undef PH
#undef PHR
#undef p
}

extern "C" void kernel_launch(void* const* d_in, const int* in_sizes, int n_in, void* d_out, int out_size, void* d_ws, size_t ws_size, hipStream_t stream) {
    static int grid = 0;
    if (!grid) {
        int dev = 0, cus = 0;
        (void)hipGetDevice(&dev);
        (void)hipDeviceGetAttribute(&cus, hipDeviceAttributeMultiprocessorCount, dev);
        (void)hipFuncSetAttribute((const void*)k_fused, hipFuncAttributeMaxDynamicSharedMemorySize, LDS_BYTES);
        if (cus < 1) cus = 256;
        grid = cus;
    }
    Params p{};
    for (int i = 0; i < 32; ++i) p.in[i] = (const float*)d_in[i];
    p.out = (float*)d_out; p.ws = (unsigned char*)d_ws;
    (void)hipMemsetAsync((char*)d_ws + WS_CTL, 0, CTL_BYTES, stream);
    hipLaunchKernelGGL(k_fused, dim3(grid), dim3(NT), LDS_BYTES, stream, p);
}
```
